# Optimizing an MI355X kernel written in HIP

```python
import math
import jax, jax.numpy as jnp
from jax import lax
import numpy as np

D_MODEL = 1024
BATCH = 4
SEQ = 8192
DEPTH = 2

CHUNK = 64
EPS = 1e-6
F32 = jnp.float32
NEG_INF_SCORE = -1e30

SSM_WIDTH = 256
SSM_GROUP = 16
SSM_GROUPS = SSM_WIDTH // SSM_GROUP
SSM_STATE = 64
SSM_DT_MIN = 1e-3
SSM_DT_MAX = 1e-1

DSA_HEADS = 6
DSA_HEAD_DIM = 64
DSA_WIDTH = DSA_HEADS * DSA_HEAD_DIM
IDX_HEADS = 4
IDX_DIM = 32
DSA_TOPK = 256
Q_BLOCK = 128
ROPE_THETA = 500000.0
ROPE_FRACTION = 4

RET_HEADS = 4
RET_QK_DIM = 48
RET_V_DIM = 96
RET_WIDTH = RET_HEADS * RET_V_DIM
RET_THETA = 10000.0

N_BRANCHES = 3
D_FF = 4 * D_MODEL

IN_SIZES = (
    SSM_WIDTH,
    DSA_WIDTH,
    DSA_HEAD_DIM,
    DSA_HEAD_DIM,
    IDX_HEADS * IDX_DIM,
    IDX_DIM,
    IDX_HEADS,
    RET_HEADS * RET_QK_DIM,
    RET_HEADS * RET_QK_DIM,
    RET_WIDTH,
    RET_WIDTH,
    N_BRANCHES * D_MODEL,
)
IN_DIM = sum(IN_SIZES)

kernel_name = 'hybrid_s5_dsa_retention_block'


def rms_norm(x, g):
    xf = x.astype(F32)
    y = xf * lax.rsqrt(jnp.mean(xf * xf, axis=-1, keepdims=True) + EPS)
    return (y * g.astype(F32)).astype(x.dtype)


def rope(x, positions, rot_dim, theta):
    half = rot_dim // 2
    inv = jnp.exp(-math.log(theta) * jnp.arange(half, dtype=F32) * (2.0 / rot_dim))
    ang = positions.astype(F32)[:, :, None, None] * inv
    cos, sin = jnp.cos(ang), jnp.sin(ang)
    xf = x.astype(F32)
    x1 = xf[..., :half]
    x2 = xf[..., half:rot_dim]
    out = jnp.concatenate([x1 * cos - x2 * sin, x2 * cos + x1 * sin, xf[..., rot_dim:]], axis=-1)
    return out.astype(x.dtype)


def split_cols(z):
    parts = []
    off = 0
    for n in IN_SIZES:
        parts.append(z[..., off:off + n])
        off += n
    return parts


def s5_mixer(u, lam_re, lam_im, log_step, b_re, b_im, c_re, c_im, d_skip, glu_w, glu_b):
    bsz, seq_len, _ = u.shape
    uf = u.astype(F32).reshape(bsz, seq_len, SSM_GROUPS, SSM_GROUP)
    lam_re = lam_re.astype(F32)
    lam_im = lam_im.astype(F32)
    step = jnp.exp(log_step.astype(F32))[:, None]
    mag = jnp.exp(lam_re * step)
    lb_re = mag * jnp.cos(lam_im * step)
    lb_im = mag * jnp.sin(lam_im * step)
    den = lam_re * lam_re + lam_im * lam_im
    f_re = ((lb_re - 1.0) * lam_re + lb_im * lam_im) / den
    f_im = (lb_im * lam_re - (lb_re - 1.0) * lam_im) / den
    b_re = b_re.astype(F32)
    b_im = b_im.astype(F32)
    bb_re = f_re[..., None] * b_re - f_im[..., None] * b_im
    bb_im = f_re[..., None] * b_im + f_im[..., None] * b_re
    bu_re = jnp.einsum('blgc,gpc->blgp', uf, bb_re)
    bu_im = jnp.einsum('blgc,gpc->blgp', uf, bb_im)
    a_re = jnp.broadcast_to(lb_re[None, None], (1, seq_len, SSM_GROUPS, SSM_STATE))
    a_im = jnp.broadcast_to(lb_im[None, None], (1, seq_len, SSM_GROUPS, SSM_STATE))

    def combine(ei, ej):
        ar_i, ai_i, br_i, bi_i = ei
        ar_j, ai_j, br_j, bi_j = ej
        ar = ar_j * ar_i - ai_j * ai_i
        ai = ar_j * ai_i + ai_j * ar_i
        br = ar_j * br_i - ai_j * bi_i + br_j
        bi = ar_j * bi_i + ai_j * br_i + bi_j
        return (ar, ai, br, bi)

    _, _, x_re, x_im = lax.associative_scan(combine, (a_re, a_im, bu_re, bu_im), axis=1)
    y = (jnp.einsum('blgp,gcp->blgc', x_re, c_re.astype(F32))
         - jnp.einsum('blgp,gcp->blgc', x_im, c_im.astype(F32))
         + d_skip.astype(F32) * uf)
    y = jax.nn.gelu(y.reshape(bsz, seq_len, SSM_WIDTH))
    y = y * jax.nn.sigmoid(y @ glu_w.astype(F32) + glu_b.astype(F32))
    return y.astype(u.dtype)


def dsa_mixer(q, k, v, q_idx, k_idx, w_idx):
    bsz, seq_len = q.shape[:2]
    topk = min(DSA_TOPK, seq_len // 4)
    nblk = seq_len // Q_BLOCK
    key_pos = jnp.arange(seq_len)
    kif = k_idx.astype(F32)

    def to_blocks(a):
        return a.reshape((bsz, nblk, Q_BLOCK) + a.shape[2:]).swapaxes(0, 1)

    def block(args):
        qb, qib, wb, start = args
        qpos = start + jnp.arange(Q_BLOCK)
        visible_end = (qpos // CHUNK + 1) * CHUNK
        allowed = key_pos[None, :] < visible_end[:, None]
        logits = jnp.einsum('bqhd,bsd->bqhs', qib.astype(F32), kif) * (IDX_DIM ** -0.5)
        score = jnp.einsum('bqhs,bqh->bqs', jax.nn.relu(logits), wb.astype(F32) * (IDX_HEADS ** -0.5))
        score = jnp.where(allowed[None], score, -jnp.inf)
        top_val, top_idx = lax.top_k(score, topk)
        valid = top_val > -jnp.inf
        kg = jax.vmap(lambda a, i: a[i])(k, top_idx)
        vg = jax.vmap(lambda a, i: a[i])(v, top_idx)
        s = jnp.einsum('bqhd,bqkd->bqhk', qb, kg).astype(F32) * (DSA_HEAD_DIM ** -0.5)
        s = jnp.where(valid[:, :, None, :], s, NEG_INF_SCORE)
        p = jax.nn.softmax(s, axis=-1).astype(vg.dtype)
        return jnp.einsum('bqhk,bqkd->bqhd', p, vg)

    starts = jnp.arange(nblk) * Q_BLOCK
    out = lax.map(block, (to_blocks(q), to_blocks(q_idx), to_blocks(w_idx), starts))
    return out.swapaxes(0, 1).reshape(bsz, seq_len, DSA_WIDTH)


def retention_mixer(q, k, v, gate, norm_g):
    bsz, seq_len = q.shape[:2]
    nc = seq_len // CHUNK
    qf = q.astype(F32)
    kf = k.astype(F32) * (RET_QK_DIM ** -0.5)
    vf = v.astype(F32)

    def to_chunks(a):
        return a.reshape(bsz, nc, CHUNK, RET_HEADS, a.shape[-1]).transpose(1, 0, 3, 2, 4)

    log_g = jnp.log1p(-jnp.exp2(-5.0 - jnp.arange(RET_HEADS, dtype=F32)))
    pos = jnp.arange(CHUNK, dtype=F32)
    diff = pos[:, None] - pos[None, :]
    intra = jnp.where(diff >= 0, jnp.exp(log_g[:, None, None] * jnp.maximum(diff, 0.0)), 0.0)
    q_dec = jnp.exp(log_g[:, None] * (pos + 1.0))[None, :, :, None]
    k_dec = jnp.exp(log_g[:, None] * (CHUNK - 1.0 - pos))[None, :, :, None]
    c_dec = jnp.exp(log_g * CHUNK)[None, :, None, None]

    def step(state, inp):
        qc, kc, vc = inp
        inner = jnp.einsum('bhcm,bhme->bhce', jnp.einsum('bhcd,bhmd->bhcm', qc, kc) * intra, vc)
        cross = jnp.einsum('bhcd,bhde->bhce', qc, state) * q_dec
        state = state * c_dec + jnp.einsum('bhmd,bhme->bhde', kc * k_dec, vc)
        return state, inner + cross

    init = jnp.zeros((bsz, RET_HEADS, RET_QK_DIM, RET_V_DIM), F32)
    _, ys = lax.scan(step, init, (to_chunks(qf), to_chunks(kf), to_chunks(vf)))
    y = ys.transpose(1, 0, 3, 2, 4).reshape(bsz, seq_len, RET_HEADS, RET_V_DIM)
    mu = jnp.mean(y, axis=-1, keepdims=True)
    var = jnp.mean(jnp.square(y - mu), axis=-1, keepdims=True)
    yn = ((y - mu) * lax.rsqrt(var + EPS)).reshape(bsz, seq_len, RET_WIDTH) * norm_g.astype(F32)
    return (jax.nn.silu(gate.astype(F32)) * yn).astype(gate.dtype)


def setup_inputs(seed: int = 0) -> dict:
    key = jax.random.key(seed)
    ks = jax.random.split(key, 24)

    def nrm(k, shape, scale):
        return jax.random.normal(k, shape, F32) * scale

    x = nrm(ks[0], (BATCH, SEQ, D_MODEL), 1.0)
    start = jax.random.randint(ks[1], (BATCH, 1), 0, 64, dtype=jnp.int32) * CHUNK
    positions = (start + jnp.arange(SEQ, dtype=jnp.int32)[None, :]).astype(jnp.int32)
    norm1_g = 1.0 + nrm(ks[2], (DEPTH, D_MODEL), 0.02)
    w_in = nrm(ks[3], (DEPTH, D_MODEL, IN_DIM), D_MODEL ** -0.5)
    ssm_lambda_re = -0.5 + nrm(ks[4], (DEPTH, SSM_GROUPS, SSM_STATE), 0.01)
    ssm_lambda_im = jnp.broadcast_to(math.pi * jnp.arange(SSM_STATE, dtype=F32), (DEPTH, SSM_GROUPS, SSM_STATE))
    ssm_log_step = jax.random.uniform(ks[5], (DEPTH, SSM_GROUPS), F32, math.log(SSM_DT_MIN), math.log(SSM_DT_MAX))
    ssm_b_re = nrm(ks[6], (DEPTH, SSM_GROUPS, SSM_STATE, SSM_GROUP), (2 * SSM_GROUP) ** -0.5)
    ssm_b_im = nrm(ks[7], (DEPTH, SSM_GROUPS, SSM_STATE, SSM_GROUP), (2 * SSM_GROUP) ** -0.5)
    ssm_c_re = nrm(ks[8], (DEPTH, SSM_GROUPS, SSM_GROUP, SSM_STATE), SSM_STATE ** -0.5)
    ssm_c_im = nrm(ks[9], (DEPTH, SSM_GROUPS, SSM_GROUP, SSM_STATE), SSM_STATE ** -0.5)
    ssm_d = nrm(ks[10], (DEPTH, SSM_GROUPS, SSM_GROUP), 1.0)
    ssm_glu_w = nrm(ks[11], (DEPTH, SSM_WIDTH, SSM_WIDTH), SSM_WIDTH ** -0.5)
    ssm_glu_b = nrm(ks[12], (DEPTH, SSM_WIDTH), 0.02)
    ret_norm_g = 1.0 + nrm(ks[13], (DEPTH, RET_WIDTH), 0.02)
    w_proj_a = nrm(ks[14], (DEPTH, SSM_WIDTH, D_MODEL), SSM_WIDTH ** -0.5)
    w_proj_b = nrm(ks[15], (DEPTH, DSA_WIDTH, D_MODEL), DSA_WIDTH ** -0.5)
    w_proj_c = nrm(ks[16], (DEPTH, RET_WIDTH, D_MODEL), RET_WIDTH ** -0.5)
    w_out = nrm(ks[17], (DEPTH, D_MODEL, D_MODEL), D_MODEL ** -0.5)
    norm2_g = 1.0 + nrm(ks[18], (DEPTH, D_MODEL), 0.02)
    w_ff1 = nrm(ks[19], (DEPTH, D_MODEL, D_FF), D_MODEL ** -0.5)
    w_ff2 = nrm(ks[20], (DEPTH, D_FF, D_MODEL), D_FF ** -0.5)
    final_norm_g = 1.0 + nrm(ks[21], (D_MODEL,), 0.02)
    return {'x': x, 'positions': positions, 'norm1_g': norm1_g, 'w_in': w_in,
            'ssm_lambda_re': ssm_lambda_re, 'ssm_lambda_im': ssm_lambda_im, 'ssm_log_step': ssm_log_step,
            'ssm_b_re': ssm_b_re, 'ssm_b_im': ssm_b_im, 'ssm_c_re': ssm_c_re, 'ssm_c_im': ssm_c_im,
            'ssm_d': ssm_d, 'ssm_glu_w': ssm_glu_w, 'ssm_glu_b': ssm_glu_b, 'ret_norm_g': ret_norm_g,
            'w_proj_a': w_proj_a, 'w_proj_b': w_proj_b, 'w_proj_c': w_proj_c, 'w_out': w_out,
            'norm2_g': norm2_g, 'w_ff1': w_ff1, 'w_ff2': w_ff2, 'final_norm_g': final_norm_g}


def reference(x, positions, norm1_g, w_in, ssm_lambda_re, ssm_lambda_im, ssm_log_step,
              ssm_b_re, ssm_b_im, ssm_c_re, ssm_c_im, ssm_d, ssm_glu_w, ssm_glu_b, ret_norm_g,
              w_proj_a, w_proj_b, w_proj_c, w_out, norm2_g, w_ff1, w_ff2, final_norm_g):
    bsz, seq_len, _ = x.shape
    for l in range(DEPTH):
        h = rms_norm(x, norm1_g[l])
        z = h @ w_in[l]
        (u_ssm, dq, dk, dv, iq, ik, iw, rq, rk, rv, rg, gates) = split_cols(z)

        ya = s5_mixer(u_ssm, ssm_lambda_re[l], ssm_lambda_im[l], ssm_log_step[l], ssm_b_re[l], ssm_b_im[l],
                      ssm_c_re[l], ssm_c_im[l], ssm_d[l], ssm_glu_w[l], ssm_glu_b[l])

        dq = rope(dq.reshape(bsz, seq_len, DSA_HEADS, DSA_HEAD_DIM), positions, DSA_HEAD_DIM // ROPE_FRACTION, ROPE_THETA)
        dk = rope(dk.reshape(bsz, seq_len, 1, DSA_HEAD_DIM), positions, DSA_HEAD_DIM // ROPE_FRACTION, ROPE_THETA)[:, :, 0]
        iq = rope(iq.reshape(bsz, seq_len, IDX_HEADS, IDX_DIM), positions, IDX_DIM // ROPE_FRACTION, ROPE_THETA)
        ik = rope(ik.reshape(bsz, seq_len, 1, IDX_DIM), positions, IDX_DIM // ROPE_FRACTION, ROPE_THETA)[:, :, 0]
        yb = dsa_mixer(dq, dk, dv, iq, ik, iw)

        rq = rope(rq.reshape(bsz, seq_len, RET_HEADS, RET_QK_DIM), positions, RET_QK_DIM, RET_THETA)
        rk = rope(rk.reshape(bsz, seq_len, RET_HEADS, RET_QK_DIM), positions, RET_QK_DIM, RET_THETA)
        yc = retention_mixer(rq, rk, rv.reshape(bsz, seq_len, RET_HEADS, RET_V_DIM), rg, ret_norm_g[l])

        g = jax.nn.sigmoid(gates)
        merged = (g[..., :D_MODEL] * (ya @ w_proj_a[l])
                  + g[..., D_MODEL:2 * D_MODEL] * (yb @ w_proj_b[l])
                  + g[..., 2 * D_MODEL:] * (yc @ w_proj_c[l]))
        x = x + merged @ w_out[l]

        h2 = rms_norm(x, norm2_g[l])
        x = x + jnp.square(jax.nn.relu(h2 @ w_ff1[l])) @ w_ff2[l]
    return rms_norm(x, final_norm_g)
```

```cpp
#include <hip/hip_runtime.h>
#include <hip/hip_cooperative_groups.h>
#include <cstdio>
#include <cstdint>
namespace cg = cooperative_groups;

#define LAS __attribute__((address_space(3)))
#define GAS __attribute__((address_space(1)))
typedef unsigned short bf16_t;
typedef short bf16x8 __attribute__((ext_vector_type(8)));
typedef float f32x4 __attribute__((ext_vector_type(4)));
typedef float f32x2 __attribute__((ext_vector_type(2)));
typedef unsigned u32x4 __attribute__((ext_vector_type(4)));
typedef unsigned u32x2 __attribute__((ext_vector_type(2)));

constexpr int NB = 4, SEQ = 8192, T = NB * SEQ, DM = 1024, DEPTH = 2, FF = 4096;
constexpr int NIN = 5156, NINP = 5376;
constexpr int ZSW = 2112, GW = 3072;
constexpr int ZU = 0, ZDQ = 256, ZDK = 640, ZDV = 704, ZIQ = 768, ZIK = 896, ZIWC = 928, ZRQ = 960, ZRK = 1152, ZRV = 1344, ZRG = 1728, ZGATE = 2112, ZEND = 5184;
constexpr int NFREQ = 36;
constexpr float EPS = 1e-6f;

constexpr size_t MiB = 1u << 20;
constexpr size_t WS_CTL = 0, CTL_ZERO_BYTES = 64 * 1024;
constexpr size_t WS_IW = 1 * MiB;
constexpr size_t WS_SP = 1 * MiB + 512 * 1024;
constexpr size_t WS_ROPE = 2 * MiB;
constexpr size_t WS_S5E = 11 * MiB;
constexpr size_t WS_RST = 15 * MiB;
constexpr size_t WS_W = 51 * MiB;
constexpr size_t WO_IN = 0, WO_ABC = WO_IN + (size_t)NINP * DM * 2, WO_OUT = WO_ABC + (size_t)DM * DM * 2, WO_W1 = WO_OUT + (size_t)DM * DM * 2,
                 WO_W2 = WO_W1 + (size_t)FF * DM * 2, WO_GLU = WO_W2 + (size_t)FF * DM * 2, WO_END = WO_GLU + 256 * 256 * 2;
static_assert(WO_END <= 31 * MiB, "weights");
constexpr size_t WS_H = 82 * MiB;
constexpr size_t WS_ZS = 146 * MiB;
constexpr size_t WS_G = 278 * MiB;
constexpr size_t WS_END = 470 * MiB;
static_assert(WS_ZS + (size_t)T * ZSW * 2 <= WS_G && WS_G + (size_t)T * GW * 2 <= WS_END && WS_ZS + (size_t)T * FF * 2 <= WS_END, "ws map");
constexpr int CW_BAR = 1024;

constexpr int LDS_BYTES = 160 * 1024;
constexpr int RING_BYTES = 131072;
constexpr int MISC_OFF = LDS_BYTES - 256;

__device__ __forceinline__ unsigned f2bf(float f) { unsigned u = __builtin_bit_cast(unsigned, f); return (u + 0x7fffu + ((u >> 16) & 1u)) >> 16; }
__device__ __forceinline__ unsigned pk2(float lo, float hi) { unsigned r; asm("v_cvt_pk_bf16_f32 %0, %1, %2" : "=v"(r) : "v"(lo), "v"(hi)); return r; }
__device__ __forceinline__ float bf2f(unsigned short v) { return __builtin_bit_cast(float, (unsigned)v << 16); }
__device__ __forceinline__ float bflo(unsigned w) { return __builtin_bit_cast(float, w << 16); }
__device__ __forceinline__ float bfhi(unsigned w) { return __builtin_bit_cast(float, w & 0xffff0000u); }
__device__ __forceinline__ float sigmoidf_(float x) { return 1.0f / (1.0f + __expf(-x)); }
__device__ __forceinline__ float wave_sum(float v) {
#pragma unroll
    for (int o = 1; o < 64; o <<= 1) v += __shfl_xor(v, o);
    return v;
}
__device__ __forceinline__ float wave_max(float v) {
#pragma unroll
    for (int o = 1; o < 64; o <<= 1) v = fmaxf(v, __shfl_xor(v, o));
    return v;
}

#define XB_TMO      128
#define XB_XCNT(j)  (256  + 64 * (j))
#define XB_XSUB(j)  (1280 + 64 * (j))
#define XB_XGEN(j)  (2304 + 64 * (j))
#define XB_TOP      3328
#define XB_TOPGEN   3392
#define XCD_BAR_WORDS 3456
#define XB_SPIN_CAP (1u << 18)
__device__ __forceinline__ unsigned xb_ld(unsigned* p)              { return __hip_atomic_load(p, __ATOMIC_RELAXED, __HIP_MEMORY_SCOPE_AGENT); }
__device__ __forceinline__ unsigned xb_add(unsigned* p, unsigned v) { return __hip_atomic_fetch_add(p, v, __ATOMIC_RELAXED, __HIP_MEMORY_SCOPE_AGENT); }
__device__ __forceinline__ unsigned xb_xcc_id() { return (unsigned)__builtin_amdgcn_s_getreg((3 << 11) | 20) & 0xFu; }
#define XB_SPIN(cond, bar) do { unsigned _sp = 0; while (cond) { __builtin_amdgcn_s_sleep(1); \
    if ((++_sp & 255u) == 0u) { if (xb_ld(&(bar)[XB_TMO])) break; if (_sp > XB_SPIN_CAP) { atomicAdd(&(bar)[XB_TMO], 1u); break; } } } } while (0)
struct XcdBarrier { unsigned* bar; unsigned x; volatile LAS unsigned* st; };
__device__ __forceinline__ XcdBarrier xcd_barrier_post(unsigned* bar, volatile LAS unsigned* st) {
    XcdBarrier b; b.bar = bar; b.x = xb_xcc_id(); b.st = st;
    if (threadIdx.x == 0) (void)xb_add(&bar[XB_XCNT(b.x)], 1u);
    return b;
}
__device__ __forceinline__ void xcd_barrier_complete(unsigned* bar, unsigned x, unsigned& nloc, unsigned& nx) {
    const unsigned G = gridDim.x * gridDim.y * gridDim.z;
    unsigned sum, cnt, mine, sp = 0u;
    for (;;) {
        sum = 0u; cnt = 0u; mine = 0u;
#pragma unroll
        for (unsigned j = 0; j < 16; ++j) { const unsigned c = xb_ld(&bar[XB_XCNT(j)]); sum += c; cnt += (c > 0u) ? 1u : 0u; mine = (j == x) ? c : mine; }
        if (sum == G) break;
        __builtin_amdgcn_s_sleep(1);
        if ((++sp & 255u) == 0u) { if (xb_ld(&bar[XB_TMO])) break; if (sp > XB_SPIN_CAP) { atomicAdd(&bar[XB_TMO], 1u); break; } }
    }
    nloc = mine > 0u ? mine : 1u; nx = cnt > 0u ? cnt : 1u;
}
__device__ __forceinline__ void xcd_barrier(const XcdBarrier& b) {
    asm volatile("s_waitcnt vmcnt(0)" ::: "memory");
    __syncthreads();
    if (threadIdx.x == 0) {
        unsigned* bar = b.bar; unsigned bx = b.x;
        asm volatile("" : "+s"(bar), "+s"(bx));
        __builtin_amdgcn_s_waitcnt(0);
        unsigned nloc = b.st[0], nx = b.st[1];
        if (nloc == 0u) { xcd_barrier_complete(bar, bx, nloc, nx); b.st[0] = nloc; b.st[1] = nx; }
        const unsigned old = xb_add(&bar[XB_XSUB(bx)], 1u);
        const unsigned gen = old / nloc;
        if (old + 1u == (gen + 1u) * nloc) {
            __builtin_amdgcn_fence(__ATOMIC_RELEASE, "agent");
            asm volatile("s_waitcnt vmcnt(0)" ::: "memory");
            const unsigned og = xb_add(&bar[XB_TOP], 1u);
            const unsigned tg = og / nx;
            if (og + 1u == (tg + 1u) * nx) xb_add(&bar[XB_TOPGEN], 1u);
            else XB_SPIN(xb_ld(&bar[XB_TOPGEN]) == tg, bar);
            __builtin_amdgcn_fence(__ATOMIC_ACQUIRE, "agent");
            xb_add(&bar[XB_XGEN(bx)], 1u);
            asm volatile("s_waitcnt vmcnt(0)" ::: "memory");
        } else {
            XB_SPIN(xb_ld(&bar[XB_XGEN(bx)]) == gen, bar);
            __builtin_amdgcn_fence(__ATOMIC_ACQUIRE, "agent");
            asm volatile("s_waitcnt vmcnt(0)" ::: "memory");
        }
    }
    __syncthreads();
}

namespace pg8 {
constexpr int BM = 256, BK = 64, HALF = 128, HTB = HALF * BK * 2, STAGE_BYTES = 8 * HTB, NXCD = 8, WGM = 8;
__host__ __device__ __forceinline__ int lds_byte(int r, int c) { const int st = (r >> 4) * 2 + (c >> 5), rr = r & 15, cc = c & 31, ob = rr * 64 + cc * 2; return st * 1024 + (ob ^ (((ob >> 9) & 1) << 5)); }
__host__ __device__ __forceinline__ void stage_rc(int b, int& R, int& C) { const int st = b / 1024, sb = b % 1024, swz = sb ^ (((sb >> 9) & 1) << 5); R = (st >> 1) * 16 + swz / 64; C = (st & 1) * 32 + (swz % 64) / 2; }
__host__ __device__ __forceinline__ int perm32(int rho) { const int n = rho >> 4, i = rho & 15; return 8 * (i >> 2) + 4 * n + (i & 3); }

struct Unit { int pm, pn; };
struct Gemm { const bf16_t* A; const bf16_t* Bt; };

template <int M, int N> struct StaticOrder {
    static constexpr int nM = M / BM, nN = N / BM, nwg = nM * nN;
    int G, c;
    __host__ __device__ void init(int G_, int c_) { G = G_; c = c_; }
    __host__ __device__ bool next(int i, Unit& u) const {
        const long L = (long)i * G + c; if (L >= nwg) return false;
        int wgid = (int)L; { constexpr int q = nwg / NXCD, r = nwg % NXCD; const int xcd = wgid % NXCD, off = wgid / NXCD; wgid = (xcd < r ? xcd * (q + 1) : r * (q + 1) + (xcd - r) * q) + off; }
        constexpr int nig = WGM * nN; const int gid = wgid / nig, fm = gid * WGM, gsz = (nM - fm) < WGM ? (nM - fm) : WGM;
        u.pm = fm + ((wgid % nig) % gsz); u.pn = (wgid % nig) / gsz; return true;
    }
};

template <class F, int FENCE = 0> struct EpiGen {
    static constexpr bool PERM = true;
    F f;
    __device__ __forceinline__ void operator()(const f32x4 (&acc)[2][2][4][2], const Unit& u, int wr, int wc, int fr, int fq) const {
        const int row0 = u.pm * BM + wr * 64 + fr, col0 = u.pn * BM + wc * 32 + 8 * fq;
#pragma unroll
        for (int ai = 0; ai < 2; ++ai)
#pragma unroll
            for (int m = 0; m < 4; ++m)
#pragma unroll
                for (int bj = 0; bj < 2; ++bj) { f(row0 + ai * HALF + m * 16, col0 + bj * HALF, acc[ai][bj][m][0], acc[ai][bj][m][1]);
                    if constexpr (FENCE > 0) { if (((ai * 4 + m) * 2 + bj) % FENCE == FENCE - 1) asm volatile("" ::: "memory"); } }
    }
};

template <int M, int N, int K, int LDA, int LDB, class Epi, bool ALIGN_EPI = true>
__device__ __forceinline__ void gemm_phase(LAS unsigned char* lds, const Gemm g, const StaticOrder<M, N>& S, const Epi& E) {
    int tid = threadIdx.x; asm volatile("" : "+v"(tid));
    const int wid = __builtin_amdgcn_readfirstlane(tid >> 6), lane = tid & 63, wr = wid >> 2, wc = wid & 3, fr = lane & 15, fq = lane >> 4;
    constexpr int nt = K / BK;
    unsigned voffA[2], voffB[2];
#pragma unroll
    for (int i = 0; i < 2; ++i) { int R, C; stage_rc(tid * 16 + i * 8192, R, C); const int Rb = Epi::PERM ? ((R & ~31) + perm32(R & 31)) : R;
        voffA[i] = (unsigned)(R * LDA + C) * 2u; voffB[i] = (unsigned)(Rb * LDB + C) * 2u; }
    constexpr size_t kstep = (size_t)(BK * 2);
    constexpr size_t hstepA = (size_t)HALF * LDA * 2, hstepB = (size_t)HALF * LDB * 2;
    constexpr size_t tstepA = 2 * hstepA, tstepB = 2 * hstepB;
    const unsigned ldsw = (unsigned)wid * 1024u;
    const int aoff = lds_byte(wr * 64 + fr, fq * 8), boff = lds_byte(wc * 32 + fr, fq * 8);
#define PG8_SA(b, h) (((b) * 2 + (h)) * HTB)
#define PG8_SB(b, h) ((4 + (b) * 2 + (h)) * HTB)
#define PG8_STAGE(bufoff, gbase, voff) do { _Pragma("unroll") for (int _i = 0; _i < 2; ++_i) \
        __builtin_amdgcn_global_load_lds((const unsigned*)((const char*)(gbase) + (voff)[_i]), (LAS unsigned*)(lds + (bufoff) + ldsw + _i * 8192), 16, 0, 0); } while (0)
#define PG8_LDA(dst, b, h) do { _Pragma("unroll") for (int m = 0; m < 4; ++m) _Pragma("unroll") for (int k = 0; k < 2; ++k) dst[m][k] = *(const LAS bf16x8*)(lds + PG8_SA(b, h) + aoff + m * 2048 + k * 1024); } while (0)
#define PG8_LDB(dst, b, h) do { _Pragma("unroll") for (int n = 0; n < 2; ++n) _Pragma("unroll") for (int k = 0; k < 2; ++k) dst[n][k] = *(const LAS bf16x8*)(lds + PG8_SB(b, h) + boff + n * 2048 + k * 1024); } while (0)
#define PG8_MMA(ai, bj, At, Bt) do { __builtin_amdgcn_s_setprio(1); _Pragma("unroll") for (int m = 0; m < 4; ++m) _Pragma("unroll") for (int n = 0; n < 2; ++n) _Pragma("unroll") for (int k = 0; k < 2; ++k) \
        acc[ai][bj][m][n] = __builtin_amdgcn_mfma_f32_16x16x32_bf16(Bt[n][k], At[m][k], acc[ai][bj][m][n], 0, 0, 0); __builtin_amdgcn_s_setprio(0); } while (0)
#define PG8_WAIT_V(n) asm volatile("s_waitcnt vmcnt(" #n ")" ::: "memory")
#define PG8_WAIT_L(n) asm volatile("s_waitcnt lgkmcnt(" #n ")" ::: "memory")
#define PG8_BAR __builtin_amdgcn_s_barrier()
#define PG8_SCHED __builtin_amdgcn_sched_barrier(0)
    Unit cur, nxt; int ui = 0;
    if (!S.next(0, cur)) return;
    f32x4 acc[2][2][4][2];
#pragma unroll
    for (int a = 0; a < 2; ++a)
#pragma unroll
        for (int b = 0; b < 2; ++b)
#pragma unroll
            for (int m = 0; m < 4; ++m)
#pragma unroll
                for (int n = 0; n < 2; ++n) acc[a][b][m][n] = (f32x4){0.f, 0.f, 0.f, 0.f};
    bf16x8 At[4][2], B0[2][2], B1[2][2];
    const char* cA = (const char*)g.A + (size_t)cur.pm * tstepA; const char* cB = (const char*)g.Bt + (size_t)cur.pn * tstepB;
    PG8_STAGE(PG8_SB(0, 0), cB, voffB); PG8_STAGE(PG8_SB(0, 1), cB + hstepB, voffB); PG8_STAGE(PG8_SA(0, 0), cA, voffA); PG8_STAGE(PG8_SA(0, 1), cA + hstepA, voffA);
    if (wr == 1) PG8_BAR;
    PG8_WAIT_V(2); PG8_BAR;
    PG8_STAGE(PG8_SB(1, 0), cB + kstep, voffB); PG8_STAGE(PG8_SA(1, 0), cA + kstep, voffA); PG8_STAGE(PG8_SB(1, 1), cB + hstepB + kstep, voffB);
    PG8_WAIT_V(6); PG8_BAR;
    for (;;) {
        const bool has_next = S.next(ui + 1, nxt);
        const char* nA = has_next ? (const char*)g.A + (size_t)nxt.pm * tstepA : cA; const char* nB = has_next ? (const char*)g.Bt + (size_t)nxt.pn * tstepB : cB;
#pragma unroll 1
        for (int t = 0; t < nt; t += 2) {
            const bool last = (t == nt - 2);
            const char* a1 = cA + (size_t)(t + 1) * kstep;
            const char* a2 = last ? nA : cA + (size_t)(t + 2) * kstep; const char* b2 = last ? nB : cB + (size_t)(t + 2) * kstep;
            const char* a3 = a2 + kstep; const char* b3 = b2 + kstep;
            PG8_LDB(B0, 0, 0); PG8_LDB(B1, 0, 1); PG8_SCHED; PG8_LDA(At, 0, 0); PG8_STAGE(PG8_SA(1, 1), a1 + hstepA, voffA);
            PG8_WAIT_V(8); PG8_WAIT_L(0); PG8_BAR; PG8_MMA(0, 0, At, B0); PG8_MMA(0, 1, At, B1); PG8_BAR; PG8_SCHED;
            PG8_LDA(At, 0, 1); PG8_STAGE(PG8_SB(0, 0), b2, voffB); PG8_STAGE(PG8_SB(0, 1), b2 + hstepB, voffB); PG8_STAGE(PG8_SA(0, 0), a2, voffA);
            PG8_WAIT_V(8); PG8_WAIT_L(0); PG8_BAR; PG8_MMA(1, 0, At, B0); PG8_MMA(1, 1, At, B1); PG8_BAR; PG8_SCHED;
            PG8_LDB(B0, 1, 0); PG8_LDB(B1, 1, 1); PG8_SCHED; PG8_LDA(At, 1, 0); PG8_STAGE(PG8_SA(0, 1), a2 + hstepA, voffA);
            PG8_WAIT_V(8); PG8_WAIT_L(0); PG8_BAR; PG8_MMA(0, 0, At, B0); PG8_MMA(0, 1, At, B1); PG8_BAR; PG8_SCHED;
            PG8_LDA(At, 1, 1); PG8_STAGE(PG8_SB(1, 0), b3, voffB); PG8_STAGE(PG8_SB(1, 1), b3 + hstepB, voffB); PG8_STAGE(PG8_SA(1, 0), a3, voffA);
            PG8_WAIT_V(8); PG8_WAIT_L(0); PG8_BAR; PG8_MMA(1, 0, At, B0); PG8_MMA(1, 1, At, B1); PG8_BAR; PG8_SCHED;
        }
        if constexpr (ALIGN_EPI) { if (wr == 0) PG8_BAR; }
        E(acc, cur, wr, wc, fr, fq);
        if (!has_next) break;
#pragma unroll
        for (int a = 0; a < 2; ++a)
#pragma unroll
            for (int b = 0; b < 2; ++b)
#pragma unroll
                for (int m = 0; m < 4; ++m)
#pragma unroll
                    for (int n = 0; n < 2; ++n) acc[a][b][m][n] = (f32x4){0.f, 0.f, 0.f, 0.f};
        cur = nxt; cA = nA; cB = nB; ++ui;
        if constexpr (ALIGN_EPI) { if (wr == 1) PG8_BAR; }
    }
    PG8_WAIT_V(0);
    if constexpr (!ALIGN_EPI) { if (wr == 0) PG8_BAR; }
    PG8_BAR;
#undef PG8_SA
#undef PG8_SB
#undef PG8_STAGE
#undef PG8_LDA
#undef PG8_LDB
#undef PG8_MMA
#undef PG8_WAIT_V
#undef PG8_WAIT_L
#undef PG8_BAR
#undef PG8_SCHED
}
}

constexpr int NWAVES = 8, NTHREADS = 512;
struct Args { const void* in[23]; float* out; unsigned char* ws; int ph_lo, ph_hi; };
struct Frame {
    LAS unsigned char* lds;
    int tid, lane, wave, G, bid;
    unsigned char* ws;
    __device__ __forceinline__ float* IW() const { return (float*)(ws + WS_IW); }
    __device__ __forceinline__ float* SP() const { return (float*)(ws + WS_SP); }
    __device__ __forceinline__ f32x2* ROPE() const { return (f32x2*)(ws + WS_ROPE); }
    __device__ __forceinline__ f32x2* S5E() const { return (f32x2*)(ws + WS_S5E); }
    __device__ __forceinline__ float* RST() const { return (float*)(ws + WS_RST); }
    __device__ __forceinline__ bf16_t* Win_t() const { return (bf16_t*)(ws + WS_W + WO_IN); }
    __device__ __forceinline__ bf16_t* Wabc_t() const { return (bf16_t*)(ws + WS_W + WO_ABC); }
    __device__ __forceinline__ bf16_t* Wout_t() const { return (bf16_t*)(ws + WS_W + WO_OUT); }
    __device__ __forceinline__ bf16_t* W1_t() const { return (bf16_t*)(ws + WS_W + WO_W1); }
    __device__ __forceinline__ bf16_t* W2_t() const { return (bf16_t*)(ws + WS_W + WO_W2); }
    __device__ __forceinline__ bf16_t* Wglu_t() const { return (bf16_t*)(ws + WS_W + WO_GLU); }
    __device__ __forceinline__ bf16_t* H() const { return (bf16_t*)(ws + WS_H); }
    __device__ __forceinline__ bf16_t* ZS() const { return (bf16_t*)(ws + WS_ZS); }
    __device__ __forceinline__ bf16_t* GB() const { return (bf16_t*)(ws + WS_G); }
    __device__ __forceinline__ bf16_t* MG() const { return (bf16_t*)(ws + WS_ZS); }
    __device__ __forceinline__ bf16_t* FB() const { return (bf16_t*)(ws + WS_ZS); }
};
constexpr int SP_LB = 0, SP_L64 = 2048, SP_BBR = 4096, SP_BBI = 4096 + 16384;

__device__ __forceinline__ int ropeperm(int j, int r) { const int half = r >> 1; return (j < r) ? ((j & 1) ? half + (j >> 1) : (j >> 1)) : j; }
__device__ __forceinline__ int zmap(int n) {
    if (n < ZDQ) return n;
    if (n < ZDK) { const int q = n - ZDQ, h = q >> 6, hc = q & 63; return 256 + h * 64 + ropeperm(hc, 16); }
    if (n < ZDV) return 640 + ropeperm(n - ZDK, 16);
    if (n < ZIQ) return 704 + (n - ZDV);
    if (n < ZIK) { const int q = n - ZIQ, h = q >> 5, hc = q & 31; return 768 + h * 32 + ropeperm(hc, 8); }
    if (n < ZIWC) return 896 + ropeperm(n - ZIK, 8);
    if (n < ZRQ) return (n - ZIWC) < 4 ? 928 + (n - ZIWC) : -1;
    if (n < ZRK) { const int q = n - ZRQ, h = q / 48, hc = q % 48; return 932 + h * 48 + ropeperm(hc, 48); }
    if (n < ZRV) { const int q = n - ZRK, h = q / 48, hc = q % 48; return 1124 + h * 48 + ropeperm(hc, 48); }
    if (n < ZRG) return 1316 + (n - ZRV);
    if (n < ZGATE) return 1700 + (n - ZRG);
    if (n < ZEND) return 2084 + (n - ZGATE);
    return -1;
}

__device__ __forceinline__ void tr_item(const float* W, int N, int kb, int nb, bf16_t* WT, int ldd, int koff, bool mapped, LAS float* scr, int lane) {
    const int k0 = 64 * kb, n0 = 32 * nb;
    const int c32 = lane & 31; int sc = n0 + c32; if (mapped) sc = zmap(sc);
#pragma unroll 8
    for (int i = 0; i < 32; ++i) { const int kk = 2 * i + (lane >> 5); scr[kk * 33 + c32] = (sc >= 0) ? W[(size_t)(k0 + kk) * N + sc] : 0.f; }
    asm volatile("s_waitcnt lgkmcnt(0)" ::: "memory");
    const int c = lane & 7;
#pragma unroll
    for (int j = 0; j < 4; ++j) { const int n = (lane >> 3) + 8 * j; const LAS float* s = scr + (8 * c) * 33 + n;
        u32x4 o; o.x = pk2(s[0 * 33], s[1 * 33]); o.y = pk2(s[2 * 33], s[3 * 33]); o.z = pk2(s[4 * 33], s[5 * 33]); o.w = pk2(s[6 * 33], s[7 * 33]);
        *(u32x4*)(WT + (size_t)(n0 + n) * ldd + koff + k0 + 8 * c) = o; }
    asm volatile("s_waitcnt lgkmcnt(0)" ::: "memory");
}

__device__ __forceinline__ void rms_row_bf16(const float* xrow, const float* gain, bf16_t* orow, int lane) {
    const f32x4* xr = (const f32x4*)xrow + lane; const f32x4* gr = (const f32x4*)gain + lane;
    f32x4 v[4]; float s = 0.f;
#pragma unroll
    for (int j = 0; j < 4; ++j) { v[j] = xr[64 * j]; s += (v[j].x * v[j].x + v[j].y * v[j].y) + (v[j].z * v[j].z + v[j].w * v[j].w); }
    const float rstd = rsqrtf(wave_sum(s) * (1.f / DM) + EPS);
    u32x2* o8 = (u32x2*)orow + lane;
#pragma unroll
    for (int j = 0; j < 4; ++j) { const f32x4 gg = gr[64 * j]; u32x2 w; w.x = pk2(v[j].x * rstd * gg.x, v[j].y * rstd * gg.y); w.y = pk2(v[j].z * rstd * gg.z, v[j].w * rstd * gg.w); o8[64 * j] = w; }
}
__device__ __forceinline__ void rms_row_f32(const float* xrow, const float* gain, float* orow, int lane) {
    const f32x4* xr = (const f32x4*)xrow + lane; const f32x4* gr = (const f32x4*)gain + lane;
    f32x4 v[4]; float s = 0.f;
#pragma unroll
    for (int j = 0; j < 4; ++j) { v[j] = xr[64 * j]; s += (v[j].x * v[j].x + v[j].y * v[j].y) + (v[j].z * v[j].z + v[j].w * v[j].w); }
    const float rstd = rsqrtf(wave_sum(s) * (1.f / DM) + EPS);
    f32x4* o = (f32x4*)orow + lane;
#pragma unroll
    for (int j = 0; j < 4; ++j) { const f32x4 gg = gr[64 * j]; o[64 * j] = v[j] * rstd * gg; }
}


__device__ __forceinline__ void phase_rope(Frame& F, const int* pos) {
    const int gt = F.bid * NTHREADS + F.tid, NT = F.G * NTHREADS;
    f32x2* RT = F.ROPE();
    for (int e = gt; e < T * NFREQ; e += NT) {
        const int tok = e / NFREQ, f = e % NFREQ;
        float lth, sc; int fi;
        if (f < 8) { lth = 13.122363377404328f; sc = 2.0f / 16.0f; fi = f; } else if (f < 12) { lth = 13.122363377404328f; sc = 2.0f / 8.0f; fi = f - 8; } else { lth = 9.210340371976184f; sc = 2.0f / 48.0f; fi = f - 12; }
        const float inv = expf(-lth * (float)fi * sc);
        const float p = (float)pos[tok];
        const float ang = p * inv;
        const float kq = rintf(ang * 0.15915494309189535f);
        float r = fmaf(-kq, 6.2831854820251465f, ang);
        r = fmaf(-kq, -1.7484555e-7f, r);
        RT[e] = (f32x2){cosf(r), sinf(r)};
    }
}

struct ProIn { const float *xin, *norm1_g, *w_in, *wa, *wb, *wc, *wo, *w1, *w2, *wg, *lam_re, *lam_im, *log_step, *b_re, *b_im; const int* pos; };
__device__ __forceinline__ void phase_prologue(Frame& F, int l, const ProIn& I) {
#ifdef NO_PHASE_PROLOGUE
    return;
#endif
    LAS float* scr = (LAS float*)(F.lds + F.wave * 16384);
    const int gw = F.bid * NWAVES + F.wave, NGW = F.G * NWAVES;
    constexpr int I_IN = 16 * (NINP / 32), I_A = 4 * 32, I_B = 6 * 32, I_C = 6 * 32, I_O = 16 * 32, I_1 = 16 * 128, I_2 = 64 * 32, I_G = 4 * 8;
    constexpr int NITEMS = I_IN + I_A + I_B + I_C + I_O + I_1 + I_2 + I_G;
    const float* w_in = I.w_in + (size_t)l * DM * NIN; const float* wa = I.wa + (size_t)l * 256 * DM; const float* wb = I.wb + (size_t)l * 384 * DM;
    const float* wc = I.wc + (size_t)l * 384 * DM; const float* wo = I.wo + (size_t)l * DM * DM; const float* w1 = I.w1 + (size_t)l * DM * FF;
    const float* w2 = I.w2 + (size_t)l * FF * DM; const float* wg = I.wg + (size_t)l * 256 * 256;
    for (int it = gw; it < NITEMS; it += NGW) {
        int r = it;
        if (r < I_IN) { tr_item(w_in, NIN, r / (NINP / 32), r % (NINP / 32), F.Win_t(), DM, 0, true, scr, F.lane); continue; } r -= I_IN;
        if (r < I_A) { tr_item(wa, DM, r / 32, r % 32, F.Wabc_t(), DM, 0, false, scr, F.lane); continue; } r -= I_A;
        if (r < I_B) { tr_item(wb, DM, r / 32, r % 32, F.Wabc_t(), DM, 256, false, scr, F.lane); continue; } r -= I_B;
        if (r < I_C) { tr_item(wc, DM, r / 32, r % 32, F.Wabc_t(), DM, 640, false, scr, F.lane); continue; } r -= I_C;
        if (r < I_O) { tr_item(wo, DM, r / 32, r % 32, F.Wout_t(), DM, 0, false, scr, F.lane); continue; } r -= I_O;
        if (r < I_1) { tr_item(w1, FF, r / 128, r % 128, F.W1_t(), DM, 0, false, scr, F.lane); continue; } r -= I_1;
        if (r < I_2) { tr_item(w2, DM, r / 32, r % 32, F.W2_t(), FF, 0, false, scr, F.lane); continue; } r -= I_2;
        tr_item(wg, 256, r / 8, r % 8, F.Wglu_t(), 256, 0, false, scr, F.lane);
    }
    {
        const int gt = F.bid * NTHREADS + F.tid;
        if (gt < 1024) {
            float* SPp = F.SP();
            const int g = gt >> 6, p = gt & 63;
            const float lr = I.lam_re[(l * 16 + g) * 64 + p], li = I.lam_im[(l * 16 + g) * 64 + p];
            const float step = expf(I.log_step[l * 16 + g]);
            const float mag = expf(lr * step); const float lbr = mag * cosf(li * step), lbi = mag * sinf(li * step);
            const float den = lr * lr + li * li;
            const float fr = ((lbr - 1.f) * lr + lbi * li) / den, fi = (lbi * lr - (lbr - 1.f) * li) / den;
            SPp[SP_LB + gt * 2] = lbr; SPp[SP_LB + gt * 2 + 1] = lbi;
            float pr = lbr, pi = lbi;
#pragma unroll
            for (int s = 0; s < 6; ++s) { const float nr = pr * pr - pi * pi, ni = 2.f * pr * pi; pr = nr; pi = ni; }
            SPp[SP_L64 + gt * 2] = pr; SPp[SP_L64 + gt * 2 + 1] = pi;
            const float* br = I.b_re + ((size_t)(l * 16 + g) * 64 + p) * 16; const float* bi = I.b_im + ((size_t)(l * 16 + g) * 64 + p) * 16;
#pragma unroll
            for (int c = 0; c < 16; ++c) { SPp[SP_BBR + gt * 16 + c] = fr * br[c] - fi * bi[c]; SPp[SP_BBI + gt * 16 + c] = fr * bi[c] + fi * br[c]; }
        }
    }
    for (int m = gw; m < T; m += NGW) rms_row_bf16(I.xin + (size_t)m * DM, I.norm1_g + l * DM, F.H() + (size_t)m * DM, F.lane);
}

__device__ __forceinline__ u32x4 pack8(const f32x4& a, const f32x4& b) { u32x4 w; w.x = pk2(a.x, a.y); w.y = pk2(a.z, a.w); w.z = pk2(b.x, b.y); w.w = pk2(b.z, b.w); return w; }
__device__ __forceinline__ void unpack8(const u32x4& w, f32x4& a, f32x4& b) { a = (f32x4){bflo(w.x), bfhi(w.x), bflo(w.y), bfhi(w.y)}; b = (f32x4){bflo(w.z), bfhi(w.z), bflo(w.w), bfhi(w.w)}; }

struct FInProj {
    bf16_t* ZS; bf16_t* GB; float* IW; const f32x2* ROPE;
    __device__ __forceinline__ void rope8(f32x4& a, f32x4& b, int row, int f0) const {
        const f32x2* rt = ROPE + (size_t)row * NFREQ + f0;
        const f32x2 c0 = rt[0], c1 = rt[1], c2 = rt[2], c3 = rt[3];
        f32x4 oa, ob;
        oa.x = a.x * c0.x - a.y * c0.y; oa.y = a.y * c0.x + a.x * c0.y;
        oa.z = a.z * c1.x - a.w * c1.y; oa.w = a.w * c1.x + a.z * c1.y;
        ob.x = b.x * c2.x - b.y * c2.y; ob.y = b.y * c2.x + b.x * c2.y;
        ob.z = b.z * c3.x - b.w * c3.y; ob.w = b.w * c3.x + b.z * c3.y;
        a = oa; b = ob;
    }
    __device__ __forceinline__ void operator()(int row, int col, f32x4 a, f32x4 b) const {
        if (col >= ZEND) return;
        if (col >= ZGATE) {
            a = (f32x4){sigmoidf_(a.x), sigmoidf_(a.y), sigmoidf_(a.z), sigmoidf_(a.w)}; b = (f32x4){sigmoidf_(b.x), sigmoidf_(b.y), sigmoidf_(b.z), sigmoidf_(b.w)};
            *(u32x4*)(GB + (size_t)row * GW + (col - ZGATE)) = pack8(a, b); return;
        }
        if (col >= ZIWC && col < ZRQ) { if (col == ZIWC) *(f32x4*)(IW + (size_t)row * 4) = a; return; }
        if (col >= ZDQ && col < ZDV) { const int hc = (col - ZDQ) & 63; if (hc < 16) rope8(a, b, row, hc >> 1); }
        else if (col >= ZIQ && col < ZIWC) { const int hc = (col - ZIQ) & 31; if (hc < 8) rope8(a, b, row, 8); }
        else if (col >= ZRQ && col < ZRV) { const int hc = (col - ZRQ) % 48; rope8(a, b, row, 12 + (hc >> 1)); }
        *(u32x4*)(ZS + (size_t)row * ZSW + col) = pack8(a, b);
    }
};
struct FMerge {
    bf16_t* MG; const bf16_t* GB; int br;
    __device__ __forceinline__ void operator()(int row, int col, f32x4 a, f32x4 b) const {
        f32x4 ga, gb; unpack8(*(const u32x4*)(GB + (size_t)row * GW + br * DM + col), ga, gb);
        a = a * ga; b = b * gb;
        u32x4* mp = (u32x4*)(MG + (size_t)row * DM + col);
        if (br != 0) { f32x4 pa, pb; unpack8(*mp, pa, pb); a = a + pa; b = b + pb; }
        *mp = pack8(a, b);
    }
};
struct FResid {
    const float* base; float* out;
    __device__ __forceinline__ void operator()(int row, int col, f32x4 a, f32x4 b) const {
        const f32x4* bp = (const f32x4*)(base + (size_t)row * DM + col); f32x4* op = (f32x4*)(out + (size_t)row * DM + col);
        const f32x4 b0 = bp[0], b1 = bp[1]; op[0] = b0 + a; op[1] = b1 + b;
    }
};
struct FRelu2 {
    bf16_t* FB;
    __device__ __forceinline__ void operator()(int row, int col, f32x4 a, f32x4 b) const {
        a = (f32x4){fmaxf(a.x, 0.f), fmaxf(a.y, 0.f), fmaxf(a.z, 0.f), fmaxf(a.w, 0.f)}; b = (f32x4){fmaxf(b.x, 0.f), fmaxf(b.y, 0.f), fmaxf(b.z, 0.f), fmaxf(b.w, 0.f)};
        *(u32x4*)(FB + (size_t)row * FF + col) = pack8(a * a, b * b);
    }
};
struct FGlu {
    bf16_t* H; const float* bias;
    __device__ __forceinline__ void operator()(int row, int col, f32x4 a, f32x4 b) const {
        u32x4* hp = (u32x4*)(H + (size_t)row * DM + col); f32x4 ya, yb; unpack8(*hp, ya, yb);
        const f32x4 ba = *(const f32x4*)(bias + col), bb = *(const f32x4*)(bias + col + 4);
        a = a + ba; b = b + bb;
        a = (f32x4){ya.x * sigmoidf_(a.x), ya.y * sigmoidf_(a.y), ya.z * sigmoidf_(a.z), ya.w * sigmoidf_(a.w)};
        b = (f32x4){yb.x * sigmoidf_(b.x), yb.y * sigmoidf_(b.y), yb.z * sigmoidf_(b.z), yb.w * sigmoidf_(b.w)};
        *hp = pack8(a, b);
    }
};

__device__ __forceinline__ float gelu_tanh(float x) { const float u = 0.7978845608028654f * (x + 0.044715f * x * x * x); const float e = __expf(2.f * u); const float th = 1.f - 2.f / (e + 1.f); return 0.5f * x * (1.f + th); }

#define S5_STEP(t) do { const LAS f32x4* uu = (const LAS f32x4*)(U + (t) * 16); const f32x4 u0 = uu[0], u1 = uu[1], u2 = uu[2], u3 = uu[3]; \
    float bur = bbr[0] * u0.x, bui = bbi[0] * u0.x; \
    bur += bbr[1] * u0.y; bui += bbi[1] * u0.y; bur += bbr[2] * u0.z; bui += bbi[2] * u0.z; bur += bbr[3] * u0.w; bui += bbi[3] * u0.w; \
    bur += bbr[4] * u1.x; bui += bbi[4] * u1.x; bur += bbr[5] * u1.y; bui += bbi[5] * u1.y; bur += bbr[6] * u1.z; bui += bbi[6] * u1.z; bur += bbr[7] * u1.w; bui += bbi[7] * u1.w; \
    bur += bbr[8] * u2.x; bui += bbi[8] * u2.x; bur += bbr[9] * u2.y; bui += bbi[9] * u2.y; bur += bbr[10] * u2.z; bui += bbi[10] * u2.z; bur += bbr[11] * u2.w; bui += bbi[11] * u2.w; \
    bur += bbr[12] * u3.x; bui += bbi[12] * u3.x; bur += bbr[13] * u3.y; bui += bbi[13] * u3.y; bur += bbr[14] * u3.z; bui += bbi[14] * u3.z; bur += bbr[15] * u3.w; bui += bbi[15] * u3.w; \
    const float nr = lbr * xr - lbi * xi + bur, ni = lbr * xi + lbi * xr + bui; xr = nr; xi = ni; } while (0)

__device__ __forceinline__ void s5_stage_u32(const Frame& F, LAS float* U, int tok0, int g) {
    const int tt = F.lane & 31, sub = F.lane >> 5;
    const u32x4 w = *(const u32x4*)(F.ZS() + (size_t)(tok0 + tt) * ZSW + ZU + g * 16 + sub * 8);
    f32x4 a, b; unpack8(w, a, b);
    LAS f32x4* ud = (LAS f32x4*)(U + tt * 16 + sub * 8); ud[0] = a; ud[1] = b;
    asm volatile("s_waitcnt lgkmcnt(0)" ::: "memory");
}
__device__ __forceinline__ void phase_s5_local(Frame& F) {
    const float* SPp = F.SP(); f32x2* S5Ep = F.S5E();
#ifdef NO_PHASE_S5_LOCAL
    return;
#endif
    LAS float* U = (LAS float*)(F.lds + F.wave * 2048);
    const int gw = F.bid * NWAVES + F.wave, NGW = F.G * NWAVES, p = F.lane;
    for (int task = gw; task < 512 * 16; task += NGW) {
        const int g = task & 15, cidx = task >> 4;
        const float lbr = SPp[SP_LB + (g * 64 + p) * 2], lbi = SPp[SP_LB + (g * 64 + p) * 2 + 1];
        float bbr[16], bbi[16];
#pragma unroll
        for (int c = 0; c < 16; ++c) { bbr[c] = SPp[SP_BBR + (g * 64 + p) * 16 + c]; bbi[c] = SPp[SP_BBI + (g * 64 + p) * 16 + c]; }
        float xr = 0.f, xi = 0.f;
        for (int half = 0; half < 2; ++half) {
            s5_stage_u32(F, U, cidx * 64 + half * 32, g);
            for (int t = 0; t < 32; ++t) S5_STEP(t);
            asm volatile("s_waitcnt lgkmcnt(0)" ::: "memory");
        }
        S5Ep[(size_t)(cidx * 16 + g) * 64 + p] = (f32x2){xr, xi};
    }
}
constexpr int XSTR = 132;
constexpr int S5_WAVE_LDS = 2048 + 64 * XSTR * 2;
__device__ __forceinline__ void phase_s5_out(Frame& F, int l, const float* c_re, const float* c_im, const float* ssm_d) {
    const float* SPp = F.SP(); const f32x2* S5Ep = F.S5E();
#ifdef NO_PHASE_S5_OUT
    return;
#endif
    LAS float* U = (LAS float*)(F.lds + F.wave * S5_WAVE_LDS);
    LAS bf16_t* X = (LAS bf16_t*)(F.lds + F.wave * S5_WAVE_LDS + 2048);
    const int gw = F.bid * NWAVES + F.wave, NGW = F.G * NWAVES, p = F.lane;
    for (int task = gw; task < 512 * 16; task += NGW) {
        const int g = task & 15, cidx = task >> 4, tok0 = cidx * 64;
        {
            const float lbr = SPp[SP_LB + (g * 64 + p) * 2], lbi = SPp[SP_LB + (g * 64 + p) * 2 + 1];
            float bbr[16], bbi[16];
#pragma unroll
            for (int c = 0; c < 16; ++c) { bbr[c] = SPp[SP_BBR + (g * 64 + p) * 16 + c]; bbi[c] = SPp[SP_BBI + (g * 64 + p) * 16 + c]; }
            const f32x2 s0 = S5Ep[(size_t)(cidx * 16 + g) * 64 + p];
            float xr = s0.x, xi = s0.y;
            for (int half = 0; half < 2; ++half) {
                s5_stage_u32(F, U, tok0 + half * 32, g);
                for (int t = 0; t < 32; ++t) { S5_STEP(t); LAS bf16_t* xrow = X + (half * 32 + t) * XSTR; xrow[p] = (bf16_t)f2bf(xr); xrow[64 + p] = (bf16_t)f2bf(xi); }
                asm volatile("s_waitcnt lgkmcnt(0)" ::: "memory");
            }
        }
        const int t = F.lane;
        float acc[16];
#pragma unroll
        for (int co = 0; co < 16; ++co) acc[co] = 0.f;
        const float* cre = c_re + (size_t)(l * 16 + g) * 16 * 64; const float* cim = c_im + (size_t)(l * 16 + g) * 16 * 64;
        for (int pc = 0; pc < 16; ++pc) {
            const u32x2 wr_ = *(const LAS u32x2*)(X + t * XSTR + 4 * pc), wi_ = *(const LAS u32x2*)(X + t * XSTR + 64 + 4 * pc);
            const float r0 = bflo(wr_.x), r1 = bfhi(wr_.x), r2 = bflo(wr_.y), r3 = bfhi(wr_.y), i0 = bflo(wi_.x), i1 = bfhi(wi_.x), i2 = bflo(wi_.y), i3 = bfhi(wi_.y);
#pragma unroll
            for (int co = 0; co < 16; ++co) {
                const f32x4 cr = *(const f32x4*)(cre + co * 64 + 4 * pc), ci = *(const f32x4*)(cim + co * 64 + 4 * pc);
                acc[co] += (cr.x * r0 + cr.y * r1 + cr.z * r2 + cr.w * r3) - (ci.x * i0 + ci.y * i1 + ci.z * i2 + ci.w * i3);
            }
        }
        const u32x4* up = (const u32x4*)(F.ZS() + (size_t)(tok0 + t) * ZSW + ZU + g * 16);
        f32x4 ua, ub, uc, ud; unpack8(up[0], ua, ub); unpack8(up[1], uc, ud);
        const float uv[16] = {ua.x, ua.y, ua.z, ua.w, ub.x, ub.y, ub.z, ub.w, uc.x, uc.y, uc.z, uc.w, ud.x, ud.y, ud.z, ud.w};
        const float* dsk = ssm_d + (l * 16 + g) * 16;
        float y[16];
#pragma unroll
        for (int co = 0; co < 16; ++co) y[co] = gelu_tanh(acc[co] + dsk[co] * uv[co]);
        u32x4 o0, o1; o0.x = pk2(y[0], y[1]); o0.y = pk2(y[2], y[3]); o0.z = pk2(y[4], y[5]); o0.w = pk2(y[6], y[7]); o1.x = pk2(y[8], y[9]); o1.y = pk2(y[10], y[11]); o1.z = pk2(y[12], y[13]); o1.w = pk2(y[14], y[15]);
        u32x4* hp = (u32x4*)(F.H() + (size_t)(tok0 + t) * DM + g * 16); hp[0] = o0; hp[1] = o1;
        asm volatile("s_waitcnt lgkmcnt(0)" ::: "memory");
    }
}

__device__ __forceinline__ void phase_carry(Frame& F) {
    const float* SPp = F.SP(); f32x2* S5Ep = F.S5E(); float* RSTp = F.RST();
#ifdef NO_PHASE_CARRY
    return;
#endif
    const int gw = F.bid * NWAVES + F.wave, NGW = F.G * NWAVES;
    for (int task = gw; task < NB * 16; task += NGW) {
        const int b = task >> 4, g = task & 15, p = F.lane;
        const float ar = SPp[SP_L64 + (g * 64 + p) * 2], ai = SPp[SP_L64 + (g * 64 + p) * 2 + 1];
        float sr = 0.f, si = 0.f;
        for (int c0 = 0; c0 < 128; c0 += 16) {
            f32x2 e[16];
#pragma unroll
            for (int j = 0; j < 16; ++j) e[j] = S5Ep[(size_t)((b * 128 + c0 + j) * 16 + g) * 64 + p];
#pragma unroll
            for (int j = 0; j < 16; ++j) { S5Ep[(size_t)((b * 128 + c0 + j) * 16 + g) * 64 + p] = (f32x2){sr, si}; const float nr = ar * sr - ai * si + e[j].x, ni = ar * si + ai * sr + e[j].y; sr = nr; si = ni; }
        }
    }
    const int NT = F.G * NTHREADS;
    for (int gt = F.bid * NTHREADS + F.tid; gt < NB * 4 * 4608; gt += NT) {
        const int b = gt / (4 * 4608), h = (gt / 4608) & 3, el = gt % 4608;
        const float gam = 1.f - exp2f(-5.f - (float)h); const float lg = log1pf(-exp2f(-5.f - (float)h)); (void)gam;
        const float cdec = expf(lg * 64.f);
        float s = 0.f;
        for (int c0 = 0; c0 < 128; c0 += 16) {
            float d[16];
#pragma unroll
            for (int j = 0; j < 16; ++j) d[j] = RSTp[(size_t)((b * 128 + c0 + j) * 4 + h) * 4608 + el];
#pragma unroll
            for (int j = 0; j < 16; ++j) { RSTp[(size_t)((b * 128 + c0 + j) * 4 + h) * 4608 + el] = s; s = s * cdec + d[j]; }
        }
    }
}

__device__ __forceinline__ void phase_ret_local(Frame& F) {
#ifdef NO_PHASE_RET_LOCAL
    return;
#endif
    LAS float* Ks = (LAS float*)F.lds;
    LAS float* Vs = (LAS float*)(F.lds + 12288);
    for (int item = F.bid; item < 2048; item += F.G) {
        const int h = item & 3, cidx = item >> 2, tok0 = cidx * 64;
        const float lg = log1pf(-exp2f(-5.f - (float)h));
        for (int i = F.tid; i < 64 * 6 + 64 * 12; i += NTHREADS) {
            if (i < 384) { const int r = i / 6, v8 = i % 6; f32x4 a, b; unpack8(*(const u32x4*)(F.ZS() + (size_t)(tok0 + r) * ZSW + ZRK + h * 48 + v8 * 8), a, b);
                const float sc = 0.14433756729740643f * expf(lg * (float)(63 - r)); LAS f32x4* d = (LAS f32x4*)(Ks + r * 48 + v8 * 8); d[0] = a * sc; d[1] = b * sc; }
            else { const int q = i - 384, r = q / 12, v8 = q % 12; f32x4 a, b; unpack8(*(const u32x4*)(F.ZS() + (size_t)(tok0 + r) * ZSW + ZRV + h * 96 + v8 * 8), a, b);
                LAS f32x4* d = (LAS f32x4*)(Vs + r * 96 + v8 * 8); d[0] = a; d[1] = b; }
        }
        __syncthreads();
        if (F.tid < 384) {
            const int e = F.tid % 96, dq = F.tid / 96;
            float acc[12];
#pragma unroll
            for (int j = 0; j < 12; ++j) acc[j] = 0.f;
            for (int tk = 0; tk < 64; ++tk) {
                const float v = Vs[tk * 96 + e]; const LAS f32x4* kp = (const LAS f32x4*)(Ks + tk * 48 + dq * 12); const f32x4 k0 = kp[0], k1 = kp[1], k2 = kp[2];
                acc[0] += k0.x * v; acc[1] += k0.y * v; acc[2] += k0.z * v; acc[3] += k0.w * v; acc[4] += k1.x * v; acc[5] += k1.y * v; acc[6] += k1.z * v; acc[7] += k1.w * v;
                acc[8] += k2.x * v; acc[9] += k2.y * v; acc[10] += k2.z * v; acc[11] += k2.w * v;
            }
            f32x4* dst = (f32x4*)(F.RST() + (size_t)item * 4608 + e * 48 + dq * 12);
            dst[0] = (f32x4){acc[0], acc[1], acc[2], acc[3]}; dst[1] = (f32x4){acc[4], acc[5], acc[6], acc[7]}; dst[2] = (f32x4){acc[8], acc[9], acc[10], acc[11]};
        }
        __syncthreads();
    }
}
__device__ __forceinline__ void phase_ret_out(Frame& F, int l, const float* ret_norm_g) {
#ifdef NO_PHASE_RET_OUT
    return;
#endif
    constexpr int QS = 52, VS_ = 100, PS = 68;
    LAS float* Qs = (LAS float*)F.lds;
    LAS float* Ks = Qs + 64 * QS;
    LAS float* Vs = Ks + 64 * QS;
    LAS float* Ps = Vs + 64 * VS_;
    LAS float* Ss = Ps + 64 * PS;
    LAS float* PW = Ss + 96 * QS;
    for (int item = F.bid; item < 2048; item += F.G) {
        const int h = item & 3, cidx = item >> 2, tok0 = cidx * 64;
        const float lg = log1pf(-exp2f(-5.f - (float)h));
        if (F.tid < 65) PW[F.tid] = expf(lg * (float)F.tid);
        for (int i = F.tid; i < 384 + 384 + 768 + 1152; i += NTHREADS) {
            if (i < 384) { const int r = i / 6, v8 = i % 6; f32x4 a, b; unpack8(*(const u32x4*)(F.ZS() + (size_t)(tok0 + r) * ZSW + ZRQ + h * 48 + v8 * 8), a, b);
                LAS f32x4* d = (LAS f32x4*)(Qs + r * QS + v8 * 8); d[0] = a; d[1] = b; }
            else if (i < 768) { const int q = i - 384, r = q / 6, v8 = q % 6; f32x4 a, b; unpack8(*(const u32x4*)(F.ZS() + (size_t)(tok0 + r) * ZSW + ZRK + h * 48 + v8 * 8), a, b);
                const float sc = 0.14433756729740643f; LAS f32x4* d = (LAS f32x4*)(Ks + r * QS + v8 * 8); d[0] = a * sc; d[1] = b * sc; }
            else if (i < 1536) { const int q = i - 768, r = q / 12, v8 = q % 12; f32x4 a, b; unpack8(*(const u32x4*)(F.ZS() + (size_t)(tok0 + r) * ZSW + ZRV + h * 96 + v8 * 8), a, b);
                LAS f32x4* d = (LAS f32x4*)(Vs + r * VS_ + v8 * 8); d[0] = a; d[1] = b; }
            else { const int q = i - 1536, e = q / 12, v4 = q % 12; *(LAS f32x4*)(Ss + e * QS + v4 * 4) = *(const f32x4*)(F.RST() + (size_t)item * 4608 + e * 48 + v4 * 4); }
        }
        __syncthreads();
        const int i = F.tid >> 3, sg = F.tid & 7;
        {
            float pacc[8];
#pragma unroll
            for (int jj = 0; jj < 8; ++jj) pacc[jj] = 0.f;
            for (int d4 = 0; d4 < 12; ++d4) {
                const f32x4 q = *(const LAS f32x4*)(Qs + i * QS + d4 * 4);
#pragma unroll
                for (int jj = 0; jj < 8; ++jj) { const f32x4 k = *(const LAS f32x4*)(Ks + (sg * 8 + jj) * QS + d4 * 4); pacc[jj] += q.x * k.x + q.y * k.y + q.z * k.z + q.w * k.w; }
            }
#pragma unroll
            for (int jj = 0; jj < 8; ++jj) { const int j = sg * 8 + jj; Ps[i * PS + j] = (j <= i) ? pacc[jj] * PW[i - j] : 0.f; }
        }
        __syncthreads();
        float o[12];
        {
            float oc[12];
#pragma unroll
            for (int k = 0; k < 12; ++k) { o[k] = 0.f; oc[k] = 0.f; }
            for (int j = 0; j < 64; ++j) {
                const float pv = Ps[i * PS + j]; const LAS f32x4* vp = (const LAS f32x4*)(Vs + j * VS_ + sg * 12); const f32x4 v0 = vp[0], v1 = vp[1], v2 = vp[2];
                o[0] += pv * v0.x; o[1] += pv * v0.y; o[2] += pv * v0.z; o[3] += pv * v0.w; o[4] += pv * v1.x; o[5] += pv * v1.y; o[6] += pv * v1.z; o[7] += pv * v1.w;
                o[8] += pv * v2.x; o[9] += pv * v2.y; o[10] += pv * v2.z; o[11] += pv * v2.w;
            }
            for (int d4 = 0; d4 < 12; ++d4) {
                const f32x4 q = *(const LAS f32x4*)(Qs + i * QS + d4 * 4);
#pragma unroll
                for (int k = 0; k < 12; ++k) { const f32x4 s = *(const LAS f32x4*)(Ss + (sg * 12 + k) * QS + d4 * 4); oc[k] += q.x * s.x + q.y * s.y + q.z * s.z + q.w * s.w; }
            }
            const float qd = PW[i + 1];
#pragma unroll
            for (int k = 0; k < 12; ++k) o[k] += qd * oc[k];
        }
        float s = 0.f;
#pragma unroll
        for (int k = 0; k < 12; ++k) s += o[k];
        s += __shfl_xor(s, 1); s += __shfl_xor(s, 2); s += __shfl_xor(s, 4);
        const float mu = s * (1.f / 96.f); float q2 = 0.f;
#pragma unroll
        for (int k = 0; k < 12; ++k) { o[k] -= mu; q2 += o[k] * o[k]; }
        q2 += __shfl_xor(q2, 1); q2 += __shfl_xor(q2, 2); q2 += __shfl_xor(q2, 4);
        const float rs = rsqrtf(q2 * (1.f / 96.f) + EPS);
        const int tok = tok0 + i, cb = h * 96 + sg * 12;
        const bf16_t* gp = F.ZS() + (size_t)tok * ZSW + ZRG + cb; const float* ng = ret_norm_g + l * 384 + cb;
        float r[12];
#pragma unroll
        for (int k = 0; k < 12; ++k) { const float gte = bf2f(gp[k]); r[k] = (gte * sigmoidf_(gte)) * (o[k] * rs * ng[k]); }
        u32x2* hp = (u32x2*)(F.H() + (size_t)tok * DM + 640 + cb);
        hp[0] = (u32x2){pk2(r[0], r[1]), pk2(r[2], r[3])}; hp[1] = (u32x2){pk2(r[4], r[5]), pk2(r[6], r[7])}; hp[2] = (u32x2){pk2(r[8], r[9]), pk2(r[10], r[11])};
        __syncthreads();
    }
}

__device__ __forceinline__ unsigned sortable_u32(float f) { if (f == 0.0f) f = 0.0f; const unsigned u = __builtin_bit_cast(unsigned, f); return (u & 0x80000000u) ? ~u : (u | 0x80000000u); }
__device__ __forceinline__ int wave_sum_i(int v) {
#pragma unroll
    for (int o = 1; o < 64; o <<= 1) v += __shfl_xor(v, o);
    return v;
}
__device__ __forceinline__ int lanes_below(unsigned long long m) { return (int)__builtin_amdgcn_mbcnt_hi((unsigned)(m >> 32), __builtin_amdgcn_mbcnt_lo((unsigned)m, 0u)); }

__device__ __forceinline__ void phase_dsa(Frame& F) {
#ifdef NO_PHASE_DSA
    return;
#endif
    LAS unsigned* SC = (LAS unsigned*)F.lds;
    LAS float* QI = (LAS float*)(F.lds + 131072);
    LAS float* WI = QI + 512;
    LAS float* QD = WI + 16;
    LAS unsigned short* LST = (LAS unsigned short*)(QD + 1536);
    const int lane = F.lane, wave = F.wave;
    const bf16_t* ZSp = F.ZS(); const float* IWp = F.IW();
    for (int it = F.bid; it < 512; it += F.G) {
        const int pr = it & 255, b = pr >> 6, cc = pr & 63, c = (it < 256) ? cc : 127 - cc;
        const int V = (c + 1) * 64, tokq0 = b * SEQ + c * 64, kb0 = b * SEQ;
        const int Keff = V < 256 ? V : 256;
        for (int qg = 0; qg < 16; ++qg) {
            const int tq0 = tokq0 + qg * 4;
            { const int qi = F.tid >> 7, j = F.tid & 127; QI[F.tid] = bf2f(ZSp[(size_t)(tq0 + qi) * ZSW + ZIQ + j]) * 0.17677669529663687f; }
            if (F.tid < 16) WI[F.tid] = IWp[(size_t)(tq0 + (F.tid >> 2)) * 4 + (F.tid & 3)] * 0.5f;
            for (int idx = F.tid; idx < 4 * 384; idx += NTHREADS) { const int qi = idx / 384, j = idx % 384; QD[idx] = bf2f(ZSp[(size_t)(tq0 + qi) * ZSW + ZDQ + j]) * 0.125f; }
            __syncthreads();
            {
                const int qi = wave & 3, half = wave >> 2, kend = (half + 1) * (V >> 1);
                const float w0 = WI[qi * 4 + 0], w1 = WI[qi * 4 + 1], w2 = WI[qi * 4 + 2], w3 = WI[qi * 4 + 3];
                for (int k = half * (V >> 1) + lane; k < kend; k += 64) {
                    const u32x4* kp = (const u32x4*)(ZSp + (size_t)(kb0 + k) * ZSW + ZIK);
                    float d0 = 0.f, d1 = 0.f, d2 = 0.f, d3 = 0.f;
#pragma unroll
                    for (int v8 = 0; v8 < 4; ++v8) {
                        f32x4 ka, kb; unpack8(kp[v8], ka, kb);
                        const LAS f32x4* q0 = (const LAS f32x4*)(QI + qi * 128 + v8 * 8);
                        const f32x4 a0 = q0[0], b0 = q0[1], a1 = q0[8], b1 = q0[9], a2 = q0[16], b2 = q0[17], a3 = q0[24], b3 = q0[25];
                        d0 += a0.x * ka.x + a0.y * ka.y + a0.z * ka.z + a0.w * ka.w + b0.x * kb.x + b0.y * kb.y + b0.z * kb.z + b0.w * kb.w;
                        d1 += a1.x * ka.x + a1.y * ka.y + a1.z * ka.z + a1.w * ka.w + b1.x * kb.x + b1.y * kb.y + b1.z * kb.z + b1.w * kb.w;
                        d2 += a2.x * ka.x + a2.y * ka.y + a2.z * ka.z + a2.w * ka.w + b2.x * kb.x + b2.y * kb.y + b2.z * kb.z + b2.w * kb.w;
                        d3 += a3.x * ka.x + a3.y * ka.y + a3.z * ka.z + a3.w * ka.w + b3.x * kb.x + b3.y * kb.y + b3.z * kb.z + b3.w * kb.w;
                    }
                    const float sc = fmaxf(d0, 0.f) * w0 + fmaxf(d1, 0.f) * w1 + fmaxf(d2, 0.f) * w2 + fmaxf(d3, 0.f) * w3;
                    SC[qi * 8192 + k] = sortable_u32(sc);
                }
            }
            __syncthreads();
            if (wave < 4) {
                const int w = wave; LAS unsigned* row = SC + w * 8192; LAS unsigned short* lst = LST + w * 256;
                unsigned tau = 0u; int r = 1 << 30;
                if (V > 256) {
                    for (int bit = 31; bit >= 0; --bit) {
                        const unsigned cand = tau | (1u << bit); int cnt = 0;
                        for (int k = lane * 4; k < V; k += 256) { const u32x4 u = *(const LAS u32x4*)(row + k); cnt += (u.x >= cand) + (u.y >= cand) + (u.z >= cand) + (u.w >= cand); }
                        cnt = wave_sum_i(cnt);
                        if (cnt >= 256) tau = cand;
                    }
                    int cg = 0;
                    for (int k = lane * 4; k < V; k += 256) { const u32x4 u = *(const LAS u32x4*)(row + k); cg += (u.x > tau) + (u.y > tau) + (u.z > tau) + (u.w > tau); }
                    r = 256 - wave_sum_i(cg);
                }
                int eq_base = 0, sel_base = 0;
                for (int k0 = 0; k0 < V; k0 += 64) {
                    const unsigned u = row[k0 + lane];
                    const bool gt = (V <= 256) || (u > tau), eq = (V > 256) && (u == tau);
                    const unsigned long long meq = __ballot(eq);
                    const bool sel = gt || (eq && (eq_base + lanes_below(meq) < r));
                    const unsigned long long msel = __ballot(sel);
                    if (sel) lst[sel_base + lanes_below(msel)] = (unsigned short)(k0 + lane);
                    eq_base += __popcll(meq); sel_base += __popcll(msel);
                }
                asm volatile("s_waitcnt lgkmcnt(0)" ::: "memory");
                LAS float* PB = (LAS float*)row;
                const LAS float* qd = QD + w * 384;
#pragma unroll 1
                for (int jj = 0; jj < 4; ++jj) {
                    const int j = lane + 64 * jj; const bool valid = j < Keff; const int kidx = valid ? (int)lst[j] : 0;
                    const u32x4* kp = (const u32x4*)(ZSp + (size_t)(kb0 + kidx) * ZSW + ZDK);
                    float acc[6] = {0.f, 0.f, 0.f, 0.f, 0.f, 0.f};
#pragma unroll 2
                    for (int v8 = 0; v8 < 8; ++v8) {
                        f32x4 ka, kb; unpack8(kp[v8], ka, kb);
#pragma unroll
                        for (int h = 0; h < 6; ++h) { const LAS f32x4* qq = (const LAS f32x4*)(qd + h * 64 + v8 * 8); const f32x4 a = qq[0], bq = qq[1];
                            acc[h] += a.x * ka.x + a.y * ka.y + a.z * ka.z + a.w * ka.w + bq.x * kb.x + bq.y * kb.y + bq.z * kb.z + bq.w * kb.w; }
                    }
#pragma unroll
                    for (int h = 0; h < 6; ++h) PB[h * 256 + j] = valid ? acc[h] : -1e30f;
                }
                asm volatile("s_waitcnt lgkmcnt(0)" ::: "memory");
#pragma unroll 1
                for (int h = 0; h < 6; ++h) {
                    float sv[4];
#pragma unroll
                    for (int jj = 0; jj < 4; ++jj) sv[jj] = PB[h * 256 + lane + 64 * jj];
                    const float m = wave_max(fmaxf(fmaxf(sv[0], sv[1]), fmaxf(sv[2], sv[3])));
                    float e[4], sum = 0.f;
#pragma unroll
                    for (int jj = 0; jj < 4; ++jj) { e[jj] = (lane + 64 * jj < Keff) ? __expf(sv[jj] - m) : 0.f; sum += e[jj]; }
                    const float inv = 1.f / wave_sum(sum);
#pragma unroll
                    for (int jj = 0; jj < 4; ++jj) PB[h * 256 + lane + 64 * jj] = e[jj] * inv;
                }
                asm volatile("s_waitcnt lgkmcnt(0)" ::: "memory");
                float o[6] = {0.f, 0.f, 0.f, 0.f, 0.f, 0.f};
                for (int j = 0; j < Keff; ++j) {
                    const int kidx = lst[j];
                    const float v = bf2f(ZSp[(size_t)(kb0 + kidx) * ZSW + ZDV + lane]);
#pragma unroll
                    for (int h = 0; h < 6; ++h) o[h] += PB[h * 256 + j] * v;
                }
                bf16_t* op = F.H() + (size_t)(tq0 + w) * DM + 256 + lane;
#pragma unroll
                for (int h = 0; h < 6; ++h) op[h * 64] = (bf16_t)f2bf(o[h]);
            }
            __syncthreads();
        }
    }
}

__global__ void __launch_bounds__(NTHREADS, 2) mk_fwd(Args args) {
    extern __shared__ __attribute__((aligned(16))) unsigned char lds_raw[];
    Frame F;
    F.lds = (LAS unsigned char*)lds_raw;
    F.tid = threadIdx.x; F.lane = F.tid & 63; F.wave = __builtin_amdgcn_readfirstlane(F.tid >> 6);
    F.G = gridDim.x; F.bid = blockIdx.x; F.ws = args.ws;
    unsigned char* ws = args.ws;
#define INF(k) ((const float*)args.in[k])

    volatile LAS unsigned* MISC = (volatile LAS unsigned*)(F.lds + MISC_OFF);
    if (F.tid < 64) MISC[F.tid] = 0u;
    __syncthreads();
    XcdBarrier bar = xcd_barrier_post((unsigned*)(ws + WS_CTL) + CW_BAR, MISC + 8);
    cg::grid_group grid = cg::this_grid();
    int ph = 0; const int lo = args.ph_lo, hi = args.ph_hi;
    bool first_seam = true;
#ifdef NO_CG
#define GRIDSYNC() xcd_barrier(bar)
#else
#define GRIDSYNC() grid.sync()
#endif
#define RUN(...) do { if (ph >= lo && ph < hi) { asm volatile("" : "+v"(F.tid), "+v"(F.lane), "+s"(F.ws), "+s"(F.bid), "+s"(F.G), "+s"(F.wave)); __VA_ARGS__; } ++ph; } while (0)
#define SEAM() do { if (ph > lo && ph < hi) { if (first_seam) { GRIDSYNC(); first_seam = false; } else xcd_barrier(bar); } } while (0)

    RUN(phase_rope(F, (const int*)args.in[1]));
    for (int l = 0; l < DEPTH; ++l) {
        const float* xin = (l == 0) ? INF(0) : args.out;
        RUN({ const ProIn I{xin, INF(2), INF(3), INF(15), INF(16), INF(17), INF(18), INF(20), INF(21), INF(12), INF(4), INF(5), INF(6), INF(7), INF(8), (const int*)args.in[1]};
              phase_prologue(F, l, I); }); SEAM();
#ifndef NO_G1
        RUN({ pg8::Gemm g{F.H(), F.Win_t()}; pg8::StaticOrder<T, NINP> S; S.init(F.G, F.bid);
              pg8::EpiGen<FInProj> E{FInProj{F.ZS(), F.GB(), F.IW(), F.ROPE()}}; pg8::gemm_phase<T, NINP, DM, DM, DM>(F.lds, g, S, E); }); SEAM();
#else
        RUN({}); SEAM();
#endif
        RUN({ phase_s5_local(F); __syncthreads(); phase_ret_local(F); __syncthreads(); phase_dsa(F); }); SEAM();
        RUN(phase_carry(F)); SEAM();
        RUN({ phase_s5_out(F, l, INF(9), INF(10), INF(11)); __syncthreads(); phase_ret_out(F, l, INF(14)); }); SEAM();
#ifndef NO_G2
        RUN({ pg8::Gemm g{F.H(), F.Wglu_t()}; pg8::StaticOrder<T, 256> S; S.init(F.G, F.bid);
              pg8::EpiGen<FGlu, 2> E{FGlu{F.H(), INF(13) + l * 256}}; pg8::gemm_phase<T, 256, 256, DM, 256>(F.lds, g, S, E); }); SEAM();
#else
        RUN({}); SEAM();
#endif
#ifndef NO_G3
        RUN({ pg8::StaticOrder<T, DM> S; S.init(F.G, F.bid);
              { pg8::Gemm g{F.H(), F.Wabc_t()}; pg8::EpiGen<FMerge, 2> E{FMerge{F.MG(), F.GB(), 0}}; pg8::gemm_phase<T, DM, 256, DM, DM>(F.lds, g, S, E); }
              { pg8::Gemm g{F.H() + 256, F.Wabc_t() + 256}; pg8::EpiGen<FMerge, 2> E{FMerge{F.MG(), F.GB(), 1}}; pg8::gemm_phase<T, DM, 384, DM, DM>(F.lds, g, S, E); }
              { pg8::Gemm g{F.H() + 640, F.Wabc_t() + 640}; pg8::EpiGen<FMerge, 2> E{FMerge{F.MG(), F.GB(), 2}}; pg8::gemm_phase<T, DM, 384, DM, DM>(F.lds, g, S, E); } }); SEAM();
#else
        RUN({}); SEAM();
#endif
#ifndef NO_G4
        RUN({ pg8::Gemm g{F.MG(), F.Wout_t()}; pg8::StaticOrder<T, DM> S; S.init(F.G, F.bid);
              pg8::EpiGen<FResid> E{FResid{xin, args.out}}; pg8::gemm_phase<T, DM, DM, DM, DM>(F.lds, g, S, E); }); SEAM();
#else
        RUN({}); SEAM();
#endif
        RUN({ const int gw = F.bid * NWAVES + F.wave, NGW = F.G * NWAVES; const float* g2 = INF(19) + l * DM;
              for (int m = gw; m < T; m += NGW) rms_row_bf16(args.out + (size_t)m * DM, g2, F.H() + (size_t)m * DM, F.lane); }); SEAM();
#ifndef NO_G5
        RUN({ pg8::Gemm g{F.H(), F.W1_t()}; pg8::StaticOrder<T, FF> S; S.init(F.G, F.bid);
              pg8::EpiGen<FRelu2> E{FRelu2{F.FB()}}; pg8::gemm_phase<T, FF, DM, DM, DM>(F.lds, g, S, E); }); SEAM();
#else
        RUN({}); SEAM();
#endif
#ifndef NO_G6
        RUN({ pg8::Gemm g{F.FB(), F.W2_t()}; pg8::StaticOrder<T, DM> S; S.init(F.G, F.bid);
              pg8::EpiGen<FResid> E{FResid{args.out, args.out}}; pg8::gemm_phase<T, DM, FF, FF, FF>(F.lds, g, S, E); }); SEAM();
#else
        RUN({}); SEAM();
#endif
    }
    RUN({ const int gw = F.bid * NWAVES + F.wave, NGW = F.G * NWAVES; const float* gf = INF(22);
          for (int m = gw; m < T; m += NGW) rms_row_f32(args.out + (size_t)m * DM, gf, args.out + (size_t)m * DM, F.lane); });
#undef RUN
#undef SEAM
}

extern "C" void kernel_launch(void* const* d_in, const int* in_sizes, int n_in, void* d_out, int out_size, void* d_ws, size_t ws_size, hipStream_t stream) {
    static int grid = 0;
    if (grid == 0) {
        if (n_in != 23 || out_size != T * DM || ws_size < WS_END) { fprintf(stderr, "kernel_launch: unexpected shapes (n_in %d out %d ws %zu)\n", n_in, out_size, ws_size); grid = -1; return; }
        int dev = 0, cus = 0, per_cu = 0;
        hipGetDevice(&dev); hipDeviceGetAttribute(&cus, hipDeviceAttributeMultiprocessorCount, dev);
        if (hipFuncSetAttribute((const void*)mk_fwd, hipFuncAttributeMaxDynamicSharedMemorySize, LDS_BYTES) != hipSuccess) { fprintf(stderr, "kernel_launch: hipFuncSetAttribute failed\n"); grid = -1; return; }
        if (hipOccupancyMaxActiveBlocksPerMultiprocessor(&per_cu, (const void*)mk_fwd, NTHREADS, LDS_BYTES) != hipSuccess || per_cu < 1) { fprintf(stderr, "kernel_launch: occupancy query says %d\n", per_cu); per_cu = 1; }
        (void)hipGetLastError();
        grid = cus;
    }
    if (grid < 0) return;
    hipMemsetAsync((char*)d_ws + WS_CTL, 0, CTL_ZERO_BYTES, stream);
    Args a{};
    for (int i = 0; i < 23; ++i) a.in[i] = d_in[i];
    a.out = (float*)d_out; a.ws = (unsigned char*)d_ws;
#ifndef MK_SPLIT
    a.ph_lo = 0; a.ph_hi = 1000;
    void* kargs[] = {&a};
    hipError_t e = hipLaunchCooperativeKernel((const void*)mk_fwd, dim3(grid), dim3(NTHREADS), kargs, LDS_BYTES, stream);
    if (e != hipSuccess) fprintf(stderr, "kernel_launch: cooperative launch failed: %s\n", hipGetErrorString(e));
#else
    for (int p = 0; p < 2 * 11 + 2; ++p) { a.ph_lo = p; a.ph_hi = p + 1; hipLaunchKernelGGL(mk_fwd, dim3(grid), dim3(NTHREADS), LDS_BYTES, stream, a); }
#endif
}
```

```cpp
#include <hip/hip_runtime.h>
#include <hip/hip_cooperative_groups.h>
#include <cstdio>
#include <cstdint>
namespace cg = cooperative_groups;

#define LAS __attribute__((address_space(3)))
#define GAS __attribute__((address_space(1)))
typedef unsigned short bf16_t;
typedef short bf16x8 __attribute__((ext_vector_type(8)));
typedef float f32x4 __attribute__((ext_vector_type(4)));
typedef float f32x2 __attribute__((ext_vector_type(2)));
typedef unsigned u32x4 __attribute__((ext_vector_type(4)));
typedef unsigned u32x2 __attribute__((ext_vector_type(2)));

constexpr int NB = 4, SEQ = 8192, T = NB * SEQ, DM = 1024, DEPTH = 2, FF = 4096;
constexpr int NIN = 5156, NINP = 5376;
constexpr int ZSW = 2112, GW = 3072;
constexpr int ZU = 0, ZDQ = 256, ZDK = 640, ZDV = 704, ZIQ = 768, ZIK = 896, ZIWC = 928, ZRQ = 960, ZRK = 1152, ZRV = 1344, ZRG = 1728, ZGATE = 2112, ZEND = 5184;
constexpr int NFREQ = 36;
constexpr float EPS = 1e-6f;

constexpr size_t MiB = 1u << 20;
constexpr size_t WS_CTL = 0, CTL_ZERO_BYTES = 64 * 1024;
constexpr size_t WS_IW = 1 * MiB;
constexpr size_t WS_SP = 1 * MiB + 512 * 1024;
constexpr size_t WS_ROPE = 2 * MiB;
constexpr size_t WS_S5E = 11 * MiB;
constexpr size_t WS_RST = 15 * MiB;
constexpr size_t WS_W = 51 * MiB;
constexpr size_t WO_IN = 0, WO_ABC = WO_IN + (size_t)NINP * DM * 2, WO_OUT = WO_ABC + (size_t)DM * DM * 2, WO_W1 = WO_OUT + (size_t)DM * DM * 2,
                 WO_W2 = WO_W1 + (size_t)FF * DM * 2, WO_GLU = WO_W2 + (size_t)FF * DM * 2, WO_END = WO_GLU + 256 * 256 * 2;
static_assert(WO_END <= 31 * MiB, "weights");
constexpr size_t WS_H = 82 * MiB;
constexpr size_t WS_ZS = 146 * MiB;
constexpr size_t WS_G = 278 * MiB;
constexpr size_t WS_END = 470 * MiB;
static_assert(WS_ZS + (size_t)T * ZSW * 2 <= WS_G && WS_G + (size_t)T * GW * 2 <= WS_END && WS_ZS + (size_t)T * FF * 2 <= WS_END, "ws map");
constexpr int CW_BAR = 1024;

constexpr int LDS_BYTES = 160 * 1024;
constexpr int RING_BYTES = 131072;
constexpr int MISC_OFF = LDS_BYTES - 256;

__device__ __forceinline__ unsigned f2bf(float f) { unsigned u = __builtin_bit_cast(unsigned, f); return (u + 0x7fffu + ((u >> 16) & 1u)) >> 16; }
__device__ __forceinline__ unsigned pk2(float lo, float hi) { unsigned r; asm("v_cvt_pk_bf16_f32 %0, %1, %2" : "=v"(r) : "v"(lo), "v"(hi)); return r; }
__device__ __forceinline__ float bf2f(unsigned short v) { return __builtin_bit_cast(float, (unsigned)v << 16); }
__device__ __forceinline__ float bflo(unsigned w) { return __builtin_bit_cast(float, w << 16); }
__device__ __forceinline__ float bfhi(unsigned w) { return __builtin_bit_cast(float, w & 0xffff0000u); }
__device__ __forceinline__ float sigmoidf_(float x) { return 1.0f / (1.0f + __expf(-x)); }
__device__ __forceinline__ float wave_sum(float v) {
#pragma unroll
    for (int o = 1; o < 64; o <<= 1) v += __shfl_xor(v, o);
    return v;
}
__device__ __forceinline__ float wave_max(float v) {
#pragma unroll
    for (int o = 1; o < 64; o <<= 1) v = fmaxf(v, __shfl_xor(v, o));
    return v;
}

#define XB_TMO      128
#define XB_XCNT(j)  (256  + 64 * (j))
#define XB_XSUB(j)  (1280 + 64 * (j))
#define XB_XGEN(j)  (2304 + 64 * (j))
#define XB_TOP      3328
#define XB_TOPGEN   3392
#define XCD_BAR_WORDS 3456
#define XB_SPIN_CAP (1u << 18)
__device__ __forceinline__ unsigned xb_ld(unsigned* p)              { return __hip_atomic_load(p, __ATOMIC_RELAXED, __HIP_MEMORY_SCOPE_AGENT); }
__device__ __forceinline__ unsigned xb_add(unsigned* p, unsigned v) { return __hip_atomic_fetch_add(p, v, __ATOMIC_RELAXED, __HIP_MEMORY_SCOPE_AGENT); }
__device__ __forceinline__ unsigned xb_xcc_id() { return (unsigned)__builtin_amdgcn_s_getreg((3 << 11) | 20) & 0xFu; }
#define XB_SPIN(cond, bar) do { unsigned _sp = 0; while (cond) { __builtin_amdgcn_s_sleep(1); \
    if ((++_sp & 255u) == 0u) { if (xb_ld(&(bar)[XB_TMO])) break; if (_sp > XB_SPIN_CAP) { atomicAdd(&(bar)[XB_TMO], 1u); break; } } } } while (0)
struct XcdBarrier { unsigned* bar; unsigned x; volatile LAS unsigned* st; };
__device__ __forceinline__ XcdBarrier xcd_barrier_post(unsigned* bar, volatile LAS unsigned* st) {
    XcdBarrier b; b.bar = bar; b.x = xb_xcc_id(); b.st = st;
    if (threadIdx.x == 0) (void)xb_add(&bar[XB_XCNT(b.x)], 1u);
    return b;
}
__device__ __forceinline__ void xcd_barrier_complete(unsigned* bar, unsigned x, unsigned& nloc, unsigned& nx) {
    const unsigned G = gridDim.x * gridDim.y * gridDim.z;
    unsigned sum, cnt, mine, sp = 0u;
    for (;;) {
        sum = 0u; cnt = 0u; mine = 0u;
#pragma unroll
        for (unsigned j = 0; j < 16; ++j) { const unsigned c = xb_ld(&bar[XB_XCNT(j)]); sum += c; cnt += (c > 0u) ? 1u : 0u; mine = (j == x) ? c : mine; }
        if (sum == G) break;
        __builtin_amdgcn_s_sleep(1);
        if ((++sp & 255u) == 0u) { if (xb_ld(&bar[XB_TMO])) break; if (sp > XB_SPIN_CAP) { atomicAdd(&bar[XB_TMO], 1u); break; } }
    }
    nloc = mine > 0u ? mine : 1u; nx = cnt > 0u ? cnt : 1u;
}
__device__ __forceinline__ void xcd_barrier(const XcdBarrier& b) {
    asm volatile("s_waitcnt vmcnt(0)" ::: "memory");
    __syncthreads();
    if (threadIdx.x == 0) {
        unsigned* bar = b.bar; unsigned bx = b.x;
        asm volatile("" : "+s"(bar), "+s"(bx));
        __builtin_amdgcn_s_waitcnt(0);
        unsigned nloc = b.st[0], nx = b.st[1];
        if (nloc == 0u) { xcd_barrier_complete(bar, bx, nloc, nx); b.st[0] = nloc; b.st[1] = nx; }
        const unsigned old = xb_add(&bar[XB_XSUB(bx)], 1u);
        const unsigned gen = old / nloc;
        if (old + 1u == (gen + 1u) * nloc) {
            __builtin_amdgcn_fence(__ATOMIC_RELEASE, "agent");
            asm volatile("s_waitcnt vmcnt(0)" ::: "memory");
            const unsigned og = xb_add(&bar[XB_TOP], 1u);
            const unsigned tg = og / nx;
            if (og + 1u == (tg + 1u) * nx) xb_add(&bar[XB_TOPGEN], 1u);
            else XB_SPIN(xb_ld(&bar[XB_TOPGEN]) == tg, bar);
            __builtin_amdgcn_fence(__ATOMIC_ACQUIRE, "agent");
            xb_add(&bar[XB_XGEN(bx)], 1u);
            asm volatile("s_waitcnt vmcnt(0)" ::: "memory");
        } else {
            XB_SPIN(xb_ld(&bar[XB_XGEN(bx)]) == gen, bar);
            __builtin_amdgcn_fence(__ATOMIC_ACQUIRE, "agent");
            asm volatile("s_waitcnt vmcnt(0)" ::: "memory");
        }
    }
    __syncthreads();
}

namespace pg8 {
constexpr int BM = 256, BK = 64, HALF = 128, HTB = HALF * BK * 2, STAGE_BYTES = 8 * HTB, NXCD = 8, WGM = 8;
__host__ __device__ __forceinline__ int lds_byte(int r, int c) { const int st = (r >> 4) * 2 + (c >> 5), rr = r & 15, cc = c & 31, ob = rr * 64 + cc * 2; return st * 1024 + (ob ^ (((ob >> 9) & 1) << 5)); }
__host__ __device__ __forceinline__ void stage_rc(int b, int& R, int& C) { const int st = b / 1024, sb = b % 1024, swz = sb ^ (((sb >> 9) & 1) << 5); R = (st >> 1) * 16 + swz / 64; C = (st & 1) * 32 + (swz % 64) / 2; }
__host__ __device__ __forceinline__ int perm32(int rho) { const int n = rho >> 4, i = rho & 15; return 8 * (i >> 2) + 4 * n + (i & 3); }

struct Unit { int pm, pn; };
struct Gemm { const bf16_t* A; const bf16_t* Bt; };

template <int M, int N> struct StaticOrder {
    static constexpr int nM = M / BM, nN = N / BM, nwg = nM * nN;
    int G, c;
    __host__ __device__ void init(int G_, int c_) { G = G_; c = c_; }
    __host__ __device__ bool next(int i, Unit& u) const {
        const long L = (long)i * G + c; if (L >= nwg) return false;
        int wgid = (int)L; { constexpr int q = nwg / NXCD, r = nwg % NXCD; const int xcd = wgid % NXCD, off = wgid / NXCD; wgid = (xcd < r ? xcd * (q + 1) : r * (q + 1) + (xcd - r) * q) + off; }
        constexpr int nig = WGM * nN; const int gid = wgid / nig, fm = gid * WGM, gsz = (nM - fm) < WGM ? (nM - fm) : WGM;
        u.pm = fm + ((wgid % nig) % gsz); u.pn = (wgid % nig) / gsz; return true;
    }
};

template <class F, int FENCE = 0> struct EpiGen {
    static constexpr bool PERM = true;
    F f;
    __device__ __forceinline__ void operator()(const f32x4 (&acc)[2][2][4][2], const Unit& u, int wr, int wc, int fr, int fq) const {
        const int row0 = u.pm * BM + wr * 64 + fr, col0 = u.pn * BM + wc * 32 + 8 * fq;
#pragma unroll
        for (int ai = 0; ai < 2; ++ai)
#pragma unroll
            for (int m = 0; m < 4; ++m)
#pragma unroll
                for (int bj = 0; bj < 2; ++bj) { f(row0 + ai * HALF + m * 16, col0 + bj * HALF, acc[ai][bj][m][0], acc[ai][bj][m][1]);
                    if constexpr (FENCE > 0) { if (((ai * 4 + m) * 2 + bj) % FENCE == FENCE - 1) asm volatile("" ::: "memory"); } }
    }
};

template <int M, int N, int K, int LDA, int LDB, class Epi, bool ALIGN_EPI = true>
__device__ __forceinline__ void gemm_phase(LAS unsigned char* lds, const Gemm g, const StaticOrder<M, N>& S, const Epi& E) {
    int tid = threadIdx.x; asm volatile("" : "+v"(tid));
    const int wid = __builtin_amdgcn_readfirstlane(tid >> 6), lane = tid & 63, wr = wid >> 2, wc = wid & 3, fr = lane & 15, fq = lane >> 4;
    constexpr int nt = K / BK;
    unsigned voffA[2], voffB[2];
#pragma unroll
    for (int i = 0; i < 2; ++i) { int R, C; stage_rc(tid * 16 + i * 8192, R, C); const int Rb = Epi::PERM ? ((R & ~31) + perm32(R & 31)) : R;
        voffA[i] = (unsigned)(R * LDA + C) * 2u; voffB[i] = (unsigned)(Rb * LDB + C) * 2u; }
    constexpr size_t kstep = (size_t)(BK * 2);
    constexpr size_t hstepA = (size_t)HALF * LDA * 2, hstepB = (size_t)HALF * LDB * 2;
    constexpr size_t tstepA = 2 * hstepA, tstepB = 2 * hstepB;
    const unsigned ldsw = (unsigned)wid * 1024u;
    const int aoff = lds_byte(wr * 64 + fr, fq * 8), boff = lds_byte(wc * 32 + fr, fq * 8);
#define PG8_SA(b, h) (((b) * 2 + (h)) * HTB)
#define PG8_SB(b, h) ((4 + (b) * 2 + (h)) * HTB)
#define PG8_STAGE(bufoff, gbase, voff) do { _Pragma("unroll") for (int _i = 0; _i < 2; ++_i) \
        __builtin_amdgcn_global_load_lds((const unsigned*)((const char*)(gbase) + (voff)[_i]), (LAS unsigned*)(lds + (bufoff) + ldsw + _i * 8192), 16, 0, 0); } while (0)
#define PG8_LDA(dst, b, h) do { _Pragma("unroll") for (int m = 0; m < 4; ++m) _Pragma("unroll") for (int k = 0; k < 2; ++k) dst[m][k] = *(const LAS bf16x8*)(lds + PG8_SA(b, h) + aoff + m * 2048 + k * 1024); } while (0)
#define PG8_LDB(dst, b, h) do { _Pragma("unroll") for (int n = 0; n < 2; ++n) _Pragma("unroll") for (int k = 0; k < 2; ++k) dst[n][k] = *(const LAS bf16x8*)(lds + PG8_SB(b, h) + boff + n * 2048 + k * 1024); } while (0)
#define PG8_MMA(ai, bj, At, Bt) do { __builtin_amdgcn_s_setprio(1); _Pragma("unroll") for (int m = 0; m < 4; ++m) _Pragma("unroll") for (int n = 0; n < 2; ++n) _Pragma("unroll") for (int k = 0; k < 2; ++k) \
        acc[ai][bj][m][n] = __builtin_amdgcn_mfma_f32_16x16x32_bf16(Bt[n][k], At[m][k], acc[ai][bj][m][n], 0, 0, 0); __builtin_amdgcn_s_setprio(0); } while (0)
#define PG8_WAIT_V(n) asm volatile("s_waitcnt vmcnt(" #n ")" ::: "memory")
#define PG8_WAIT_L(n) asm volatile("s_waitcnt lgkmcnt(" #n ")" ::: "memory")
#define PG8_BAR __builtin_amdgcn_s_barrier()
#define PG8_SCHED __builtin_amdgcn_sched_barrier(0)
    Unit cur, nxt; int ui = 0;
    if (!S.next(0, cur)) return;
    f32x4 acc[2][2][4][2];
#pragma unroll
    for (int a = 0; a < 2; ++a)
#pragma unroll
        for (int b = 0; b < 2; ++b)
#pragma unroll
            for (int m = 0; m < 4; ++m)
#pragma unroll
                for (int n = 0; n < 2; ++n) acc[a][b][m][n] = (f32x4){0.f, 0.f, 0.f, 0.f};
    bf16x8 At[4][2], B0[2][2], B1[2][2];
    const char* cA = (const char*)g.A + (size_t)cur.pm * tstepA; const char* cB = (const char*)g.Bt + (size_t)cur.pn * tstepB;
    PG8_STAGE(PG8_SB(0, 0), cB, voffB); PG8_STAGE(PG8_SB(0, 1), cB + hstepB, voffB); PG8_STAGE(PG8_SA(0, 0), cA, voffA); PG8_STAGE(PG8_SA(0, 1), cA + hstepA, voffA);
    if (wr == 1) PG8_BAR;
    PG8_WAIT_V(2); PG8_BAR;
    PG8_STAGE(PG8_SB(1, 0), cB + kstep, voffB); PG8_STAGE(PG8_SA(1, 0), cA + kstep, voffA); PG8_STAGE(PG8_SB(1, 1), cB + hstepB + kstep, voffB);
    PG8_WAIT_V(6); PG8_BAR;
    for (;;) {
        const bool has_next = S.next(ui + 1, nxt);
        const char* nA = has_next ? (const char*)g.A + (size_t)nxt.pm * tstepA : cA; const char* nB = has_next ? (const char*)g.Bt + (size_t)nxt.pn * tstepB : cB;
#pragma unroll 1
        for (int t = 0; t < nt; t += 2) {
            const bool last = (t == nt - 2);
            const char* a1 = cA + (size_t)(t + 1) * kstep;
            const char* a2 = last ? nA : cA + (size_t)(t + 2) * kstep; const char* b2 = last ? nB : cB + (size_t)(t + 2) * kstep;
            const char* a3 = a2 + kstep; const char* b3 = b2 + kstep;
            PG8_LDB(B0, 0, 0); PG8_LDB(B1, 0, 1); PG8_SCHED; PG8_LDA(At, 0, 0); PG8_STAGE(PG8_SA(1, 1), a1 + hstepA, voffA);
            PG8_WAIT_V(8); PG8_WAIT_L(0); PG8_BAR; PG8_MMA(0, 0, At, B0); PG8_MMA(0, 1, At, B1); PG8_BAR; PG8_SCHED;
            PG8_LDA(At, 0, 1); PG8_STAGE(PG8_SB(0, 0), b2, voffB); PG8_STAGE(PG8_SB(0, 1), b2 + hstepB, voffB); PG8_STAGE(PG8_SA(0, 0), a2, voffA);
            PG8_WAIT_V(8); PG8_WAIT_L(0); PG8_BAR; PG8_MMA(1, 0, At, B0); PG8_MMA(1, 1, At, B1); PG8_BAR; PG8_SCHED;
            PG8_LDB(B0, 1, 0); PG8_LDB(B1, 1, 1); PG8_SCHED; PG8_LDA(At, 1, 0); PG8_STAGE(PG8_SA(0, 1), a2 + hstepA, voffA);
            PG8_WAIT_V(8); PG8_WAIT_L(0); PG8_BAR; PG8_MMA(0, 0, At, B0); PG8_MMA(0, 1, At, B1); PG8_BAR; PG8_SCHED;
            PG8_LDA(At, 1, 1); PG8_STAGE(PG8_SB(1, 0), b3, voffB); PG8_STAGE(PG8_SB(1, 1), b3 + hstepB, voffB); PG8_STAGE(PG8_SA(1, 0), a3, voffA);
            PG8_WAIT_V(8); PG8_WAIT_L(0); PG8_BAR; PG8_MMA(1, 0, At, B0); PG8_MMA(1, 1, At, B1); PG8_BAR; PG8_SCHED;
        }
        if constexpr (ALIGN_EPI) { if (wr == 0) PG8_BAR; }
        E(acc, cur, wr, wc, fr, fq);
        if (!has_next) break;
#pragma unroll
        for (int a = 0; a < 2; ++a)
#pragma unroll
            for (int b = 0; b < 2; ++b)
#pragma unroll
                for (int m = 0; m < 4; ++m)
#pragma unroll
                    for (int n = 0; n < 2; ++n) acc[a][b][m][n] = (f32x4){0.f, 0.f, 0.f, 0.f};
        cur = nxt; cA = nA; cB = nB; ++ui;
        if constexpr (ALIGN_EPI) { if (wr == 1) PG8_BAR; }
    }
    PG8_WAIT_V(0);
    if constexpr (!ALIGN_EPI) { if (wr == 0) PG8_BAR; }
    PG8_BAR;
#undef PG8_SA
#undef PG8_SB
#undef PG8_STAGE
#undef PG8_LDA
#undef PG8_LDB
#undef PG8_MMA
#undef PG8_WAIT_V
#undef PG8_WAIT_L
#undef PG8_BAR
#undef PG8_SCHED
}
}

constexpr int NWAVES = 8, NTHREADS = 512;
struct Args { const void* in[23]; float* out; unsigned char* ws; int ph_lo, ph_hi; };
struct Frame {
    LAS unsigned char* lds;
    int tid, lane, wave, G, bid;
    unsigned char* ws;
    __device__ __forceinline__ float* IW() const { return (float*)(ws + WS_IW); }
    __device__ __forceinline__ float* SP() const { return (float*)(ws + WS_SP); }
    __device__ __forceinline__ f32x2* ROPE() const { return (f32x2*)(ws + WS_ROPE); }
    __device__ __forceinline__ f32x2* S5E() const { return (f32x2*)(ws + WS_S5E); }
    __device__ __forceinline__ float* RST() const { return (float*)(ws + WS_RST); }
    __device__ __forceinline__ bf16_t* Win_t() const { return (bf16_t*)(ws + WS_W + WO_IN); }
    __device__ __forceinline__ bf16_t* Wabc_t() const { return (bf16_t*)(ws + WS_W + WO_ABC); }
    __device__ __forceinline__ bf16_t* Wout_t() const { return (bf16_t*)(ws + WS_W + WO_OUT); }
    __device__ __forceinline__ bf16_t* W1_t() const { return (bf16_t*)(ws + WS_W + WO_W1); }
    __device__ __forceinline__ bf16_t* W2_t() const { return (bf16_t*)(ws + WS_W + WO_W2); }
    __device__ __forceinline__ bf16_t* Wglu_t() const { return (bf16_t*)(ws + WS_W + WO_GLU); }
    __device__ __forceinline__ bf16_t* H() const { return (bf16_t*)(ws + WS_H); }
    __device__ __forceinline__ bf16_t* ZS() const { return (bf16_t*)(ws + WS_ZS); }
    __device__ __forceinline__ bf16_t* GB() const { return (bf16_t*)(ws + WS_G); }
    __device__ __forceinline__ bf16_t* MG() const { return (bf16_t*)(ws + WS_ZS); }
    __device__ __forceinline__ bf16_t* FB() const { return (bf16_t*)(ws + WS_ZS); }
};
constexpr int SP_LB = 0, SP_L64 = 2048, SP_BBR = 4096, SP_BBI = 4096 + 16384;

__device__ __forceinline__ int ropeperm(int j, int r) { const int half = r >> 1; return (j < r) ? ((j & 1) ? half + (j >> 1) : (j >> 1)) : j; }
__device__ __forceinline__ int zmap(int n) {
    if (n < ZDQ) return n;
    if (n < ZDK) { const int q = n - ZDQ, h = q >> 6, hc = q & 63; return 256 + h * 64 + ropeperm(hc, 16); }
    if (n < ZDV) return 640 + ropeperm(n - ZDK, 16);
    if (n < ZIQ) return 704 + (n - ZDV);
    if (n < ZIK) { const int q = n - ZIQ, h = q >> 5, hc = q & 31; return 768 + h * 32 + ropeperm(hc, 8); }
    if (n < ZIWC) return 896 + ropeperm(n - ZIK, 8);
    if (n < ZRQ) return (n - ZIWC) < 4 ? 928 + (n - ZIWC) : -1;
    if (n < ZRK) { const int q = n - ZRQ, h = q / 48, hc = q % 48; return 932 + h * 48 + ropeperm(hc, 48); }
    if (n < ZRV) { const int q = n - ZRK, h = q / 48, hc = q % 48; return 1124 + h * 48 + ropeperm(hc, 48); }
    if (n < ZRG) return 1316 + (n - ZRV);
    if (n < ZGATE) return 1700 + (n - ZRG);
    if (n < ZEND) return 2084 + (n - ZGATE);
    return -1;
}

__device__ __forceinline__ void tr_item(const float* W, int N, int kb, int nb, bf16_t* WT, int ldd, int koff, bool mapped, LAS float* scr, int lane) {
    const int k0 = 64 * kb, n0 = 32 * nb;
    const int c32 = lane & 31; int sc = n0 + c32; if (mapped) sc = zmap(sc);
#pragma unroll 8
    for (int i = 0; i < 32; ++i) { const int kk = 2 * i + (lane >> 5); scr[kk * 33 + c32] = (sc >= 0) ? W[(size_t)(k0 + kk) * N + sc] : 0.f; }
    asm volatile("s_waitcnt lgkmcnt(0)" ::: "memory");
    const int c = lane & 7;
#pragma unroll
    for (int j = 0; j < 4; ++j) { const int n = (lane >> 3) + 8 * j; const LAS float* s = scr + (8 * c) * 33 + n;
        u32x4 o; o.x = pk2(s[0 * 33], s[1 * 33]); o.y = pk2(s[2 * 33], s[3 * 33]); o.z = pk2(s[4 * 33], s[5 * 33]); o.w = pk2(s[6 * 33], s[7 * 33]);
        *(u32x4*)(WT + (size_t)(n0 + n) * ldd + koff + k0 + 8 * c) = o; }
    asm volatile("s_waitcnt lgkmcnt(0)" ::: "memory");
}

__device__ __forceinline__ void rms_row_bf16(const float* xrow, const float* gain, bf16_t* orow, int lane) {
    const f32x4* xr = (const f32x4*)xrow + lane; const f32x4* gr = (const f32x4*)gain + lane;
    f32x4 v[4]; float s = 0.f;
#pragma unroll
    for (int j = 0; j < 4; ++j) { v[j] = xr[64 * j]; s += (v[j].x * v[j].x + v[j].y * v[j].y) + (v[j].z * v[j].z + v[j].w * v[j].w); }
    const float rstd = rsqrtf(wave_sum(s) * (1.f / DM) + EPS);
    u32x2* o8 = (u32x2*)orow + lane;
#pragma unroll
    for (int j = 0; j < 4; ++j) { const f32x4 gg = gr[64 * j]; u32x2 w; w.x = pk2(v[j].x * rstd * gg.x, v[j].y * rstd * gg.y); w.y = pk2(v[j].z * rstd * gg.z, v[j].w * rstd * gg.w); o8[64 * j] = w; }
}
__device__ __forceinline__ void rms_row_f32(const float* xrow, const float* gain, float* orow, int lane) {
    const f32x4* xr = (const f32x4*)xrow + lane; const f32x4* gr = (const f32x4*)gain + lane;
    f32x4 v[4]; float s = 0.f;
#pragma unroll
    for (int j = 0; j < 4; ++j) { v[j] = xr[64 * j]; s += (v[j].x * v[j].x + v[j].y * v[j].y) + (v[j].z * v[j].z + v[j].w * v[j].w); }
    const float rstd = rsqrtf(wave_sum(s) * (1.f / DM) + EPS);
    f32x4* o = (f32x4*)orow + lane;
#pragma unroll
    for (int j = 0; j < 4; ++j) { const f32x4 gg = gr[64 * j]; o[64 * j] = v[j] * rstd * gg; }
}


__device__ __forceinline__ void phase_rope(Frame& F, const int* pos) {
    const int gt = F.bid * NTHREADS + F.tid, NT = F.G * NTHREADS;
    f32x2* RT = F.ROPE();
    for (int e = gt; e < T * NFREQ; e += NT) {
        const int tok = e / NFREQ, f = e % NFREQ;
        float lth, sc; int fi;
        if (f < 8) { lth = 13.122363377404328f; sc = 2.0f / 16.0f; fi = f; } else if (f < 12) { lth = 13.122363377404328f; sc = 2.0f / 8.0f; fi = f - 8; } else { lth = 9.210340371976184f; sc = 2.0f / 48.0f; fi = f - 12; }
        const float inv = expf(-lth * (float)fi * sc);
        const float p = (float)pos[tok];
        const float ang = p * inv;
        const float kq = rintf(ang * 0.15915494309189535f);
        float r = fmaf(-kq, 6.2831854820251465f, ang);
        r = fmaf(-kq, -1.7484555e-7f, r);
        RT[e] = (f32x2){cosf(r), sinf(r)};
    }
}

struct ProIn { const float *xin, *norm1_g, *w_in, *wa, *wb, *wc, *wo, *w1, *w2, *wg, *lam_re, *lam_im, *log_step, *b_re, *b_im; const int* pos; };
__device__ __forceinline__ void phase_prologue(Frame& F, int l, const ProIn& I) {
#ifdef NO_PHASE_PROLOGUE
    return;
#endif
    LAS float* scr = (LAS float*)(F.lds + F.wave * 16384);
    const int gw = F.bid * NWAVES + F.wave, NGW = F.G * NWAVES;
    constexpr int I_IN = 16 * (NINP / 32), I_A = 4 * 32, I_B = 6 * 32, I_C = 6 * 32, I_O = 16 * 32, I_1 = 16 * 128, I_2 = 64 * 32, I_G = 4 * 8;
    constexpr int NITEMS = I_IN + I_A + I_B + I_C + I_O + I_1 + I_2 + I_G;
    const float* w_in = I.w_in + (size_t)l * DM * NIN; const float* wa = I.wa + (size_t)l * 256 * DM; const float* wb = I.wb + (size_t)l * 384 * DM;
    const float* wc = I.wc + (size_t)l * 384 * DM; const float* wo = I.wo + (size_t)l * DM * DM; const float* w1 = I.w1 + (size_t)l * DM * FF;
    const float* w2 = I.w2 + (size_t)l * FF * DM; const float* wg = I.wg + (size_t)l * 256 * 256;
    for (int it = gw; it < NITEMS; it += NGW) {
        int r = it;
        if (r < I_IN) { tr_item(w_in, NIN, r / (NINP / 32), r % (NINP / 32), F.Win_t(), DM, 0, true, scr, F.lane); continue; } r -= I_IN;
        if (r < I_A) { tr_item(wa, DM, r / 32, r % 32, F.Wabc_t(), DM, 0, false, scr, F.lane); continue; } r -= I_A;
        if (r < I_B) { tr_item(wb, DM, r / 32, r % 32, F.Wabc_t(), DM, 256, false, scr, F.lane); continue; } r -= I_B;
        if (r < I_C) { tr_item(wc, DM, r / 32, r % 32, F.Wabc_t(), DM, 640, false, scr, F.lane); continue; } r -= I_C;
        if (r < I_O) { tr_item(wo, DM, r / 32, r % 32, F.Wout_t(), DM, 0, false, scr, F.lane); continue; } r -= I_O;
        if (r < I_1) { tr_item(w1, FF, r / 128, r % 128, F.W1_t(), DM, 0, false, scr, F.lane); continue; } r -= I_1;
        if (r < I_2) { tr_item(w2, DM, r / 32, r % 32, F.W2_t(), FF, 0, false, scr, F.lane); continue; } r -= I_2;
        tr_item(wg, 256, r / 8, r % 8, F.Wglu_t(), 256, 0, false, scr, F.lane);
    }
    {
        const int gt = F.bid * NTHREADS + F.tid;
        if (gt < 1024) {
            float* SPp = F.SP();
            const int g = gt >> 6, p = gt & 63;
            const float lr = I.lam_re[(l * 16 + g) * 64 + p], li = I.lam_im[(l * 16 + g) * 64 + p];
            const float step = expf(I.log_step[l * 16 + g]);
            const float mag = expf(lr * step); const float lbr = mag * cosf(li * step), lbi = mag * sinf(li * step);
            const float den = lr * lr + li * li;
            const float fr = ((lbr - 1.f) * lr + lbi * li) / den, fi = (lbi * lr - (lbr - 1.f) * li) / den;
            SPp[SP_LB + gt * 2] = lbr; SPp[SP_LB + gt * 2 + 1] = lbi;
            float pr = lbr, pi = lbi;
#pragma unroll
            for (int s = 0; s < 6; ++s) { const float nr = pr * pr - pi * pi, ni = 2.f * pr * pi; pr = nr; pi = ni; }
            SPp[SP_L64 + gt * 2] = pr; SPp[SP_L64 + gt * 2 + 1] = pi;
            const float* br = I.b_re + ((size_t)(l * 16 + g) * 64 + p) * 16; const float* bi = I.b_im + ((size_t)(l * 16 + g) * 64 + p) * 16;
#pragma unroll
            for (int c = 0; c < 16; ++c) { SPp[SP_BBR + gt * 16 + c] = fr * br[c] - fi * bi[c]; SPp[SP_BBI + gt * 16 + c] = fr * bi[c] + fi * br[c]; }
        }
    }
    for (int m = gw; m < T; m += NGW) rms_row_bf16(I.xin + (size_t)m * DM, I.norm1_g + l * DM, F.H() + (size_t)m * DM, F.lane);
}

__device__ __forceinline__ u32x4 pack8(const f32x4& a, const f32x4& b) { u32x4 w; w.x = pk2(a.x, a.y); w.y = pk2(a.z, a.w); w.z = pk2(b.x, b.y); w.w = pk2(b.z, b.w); return w; }
__device__ __forceinline__ void unpack8(const u32x4& w, f32x4& a, f32x4& b) { a = (f32x4){bflo(w.x), bfhi(w.x), bflo(w.y), bfhi(w.y)}; b = (f32x4){bflo(w.z), bfhi(w.z), bflo(w.w), bfhi(w.w)}; }

struct FInProj {
    bf16_t* ZS; bf16_t* GB; float* IW; const f32x2* ROPE;
    __device__ __forceinline__ void rope8(f32x4& a, f32x4& b, int row, int f0) const {
        const f32x2* rt = ROPE + (size_t)row * NFREQ + f0;
        const f32x2 c0 = rt[0], c1 = rt[1], c2 = rt[2], c3 = rt[3];
        f32x4 oa, ob;
        oa.x = a.x * c0.x - a.y * c0.y; oa.y = a.y * c0.x + a.x * c0.y;
        oa.z = a.z * c1.x - a.w * c1.y; oa.w = a.w * c1.x + a.z * c1.y;
        ob.x = b.x * c2.x - b.y * c2.y; ob.y = b.y * c2.x + b.x * c2.y;
        ob.z = b.z * c3.x - b.w * c3.y; ob.w = b.w * c3.x + b.z * c3.y;
        a = oa; b = ob;
    }
    __device__ __forceinline__ void operator()(int row, int col, f32x4 a, f32x4 b) const {
        if (col >= ZEND) return;
        if (col >= ZGATE) {
            a = (f32x4){sigmoidf_(a.x), sigmoidf_(a.y), sigmoidf_(a.z), sigmoidf_(a.w)}; b = (f32x4){sigmoidf_(b.x), sigmoidf_(b.y), sigmoidf_(b.z), sigmoidf_(b.w)};
            *(u32x4*)(GB + (size_t)row * GW + (col - ZGATE)) = pack8(a, b); return;
        }
        if (col >= ZIWC && col < ZRQ) { if (col == ZIWC) *(f32x4*)(IW + (size_t)row * 4) = a; return; }
        if (col >= ZDQ && col < ZDV) { const int hc = (col - ZDQ) & 63; if (hc < 16) rope8(a, b, row, hc >> 1); }
        else if (col >= ZIQ && col < ZIWC) { const int hc = (col - ZIQ) & 31; if (hc < 8) rope8(a, b, row, 8); }
        else if (col >= ZRQ && col < ZRV) { const int hc = (col - ZRQ) % 48; rope8(a, b, row, 12 + (hc >> 1)); }
        *(u32x4*)(ZS + (size_t)row * ZSW + col) = pack8(a, b);
    }
};
struct FMerge {
    bf16_t* MG; const bf16_t* GB; int br;
    __device__ __forceinline__ void operator()(int row, int col, f32x4 a, f32x4 b) const {
        f32x4 ga, gb; unpack8(*(const u32x4*)(GB + (size_t)row * GW + br * DM + col), ga, gb);
        a = a * ga; b = b * gb;
        u32x4* mp = (u32x4*)(MG + (size_t)row * DM + col);
        if (br != 0) { f32x4 pa, pb; unpack8(*mp, pa, pb); a = a + pa; b = b + pb; }
        *mp = pack8(a, b);
    }
};
struct FResid {
    const float* base; float* out;
    __device__ __forceinline__ void operator()(int row, int col, f32x4 a, f32x4 b) const {
        const f32x4* bp = (const f32x4*)(base + (size_t)row * DM + col); f32x4* op = (f32x4*)(out + (size_t)row * DM + col);
        const f32x4 b0 = bp[0], b1 = bp[1]; op[0] = b0 + a; op[1] = b1 + b;
    }
};
struct FRelu2 {
    bf16_t* FB;
    __device__ __forceinline__ void operator()(int row, int col, f32x4 a, f32x4 b) const {
        a = (f32x4){fmaxf(a.x, 0.f), fmaxf(a.y, 0.f), fmaxf(a.z, 0.f), fmaxf(a.w, 0.f)}; b = (f32x4){fmaxf(b.x, 0.f), fmaxf(b.y, 0.f), fmaxf(b.z, 0.f), fmaxf(b.w, 0.f)};
        *(u32x4*)(FB + (size_t)row * FF + col) = pack8(a * a, b * b);
    }
};
struct FGlu {
    bf16_t* H; const float* bias;
    __device__ __forceinline__ void operator()(int row, int col, f32x4 a, f32x4 b) const {
        u32x4* hp = (u32x4*)(H + (size_t)row * DM + col); f32x4 ya, yb; unpack8(*hp, ya, yb);
        const f32x4 ba = *(const f32x4*)(bias + col), bb = *(const f32x4*)(bias + col + 4);
        a = a + ba; b = b + bb;
        a = (f32x4){ya.x * sigmoidf_(a.x), ya.y * sigmoidf_(a.y), ya.z * sigmoidf_(a.z), ya.w * sigmoidf_(a.w)};
        b = (f32x4){yb.x * sigmoidf_(b.x), yb.y * sigmoidf_(b.y), yb.z * sigmoidf_(b.z), yb.w * sigmoidf_(b.w)};
        *hp = pack8(a, b);
    }
};

__device__ __forceinline__ float gelu_tanh(float x) { const float u = 0.7978845608028654f * (x + 0.044715f * x * x * x); const float e = __expf(2.f * u); const float th = 1.f - 2.f / (e + 1.f); return 0.5f * x * (1.f + th); }

#define S5_STEP(t) do { const LAS f32x4* uu = (const LAS f32x4*)(U + (t) * 16); const f32x4 u0 = uu[0], u1 = uu[1], u2 = uu[2], u3 = uu[3]; \
    float bur = bbr[0] * u0.x, bui = bbi[0] * u0.x; \
    bur += bbr[1] * u0.y; bui += bbi[1] * u0.y; bur += bbr[2] * u0.z; bui += bbi[2] * u0.z; bur += bbr[3] * u0.w; bui += bbi[3] * u0.w; \
    bur += bbr[4] * u1.x; bui += bbi[4] * u1.x; bur += bbr[5] * u1.y; bui += bbi[5] * u1.y; bur += bbr[6] * u1.z; bui += bbi[6] * u1.z; bur += bbr[7] * u1.w; bui += bbi[7] * u1.w; \
    bur += bbr[8] * u2.x; bui += bbi[8] * u2.x; bur += bbr[9] * u2.y; bui += bbi[9] * u2.y; bur += bbr[10] * u2.z; bui += bbi[10] * u2.z; bur += bbr[11] * u2.w; bui += bbi[11] * u2.w; \
    bur += bbr[12] * u3.x; bui += bbi[12] * u3.x; bur += bbr[13] * u3.y; bui += bbi[13] * u3.y; bur += bbr[14] * u3.z; bui += bbi[14] * u3.z; bur += bbr[15] * u3.w; bui += bbi[15] * u3.w; \
    const float nr = lbr * xr - lbi * xi + bur, ni = lbr * xi + lbi * xr + bui; xr = nr; xi = ni; } while (0)

__device__ __forceinline__ void s5_stage_u32(const Frame& F, LAS float* U, int tok0, int g) {
    const int tt = F.lane & 31, sub = F.lane >> 5;
    const u32x4 w = *(const u32x4*)(F.ZS() + (size_t)(tok0 + tt) * ZSW + ZU + g * 16 + sub * 8);
    f32x4 a, b; unpack8(w, a, b);
    LAS f32x4* ud = (LAS f32x4*)(U + tt * 16 + sub * 8); ud[0] = a; ud[1] = b;
    asm volatile("s_waitcnt lgkmcnt(0)" ::: "memory");
}
__device__ __forceinline__ void phase_s5_local(Frame& F) {
    const float* SPp = F.SP(); f32x2* S5Ep = F.S5E();
#ifdef NO_PHASE_S5_LOCAL
    return;
#endif
    LAS float* U = (LAS float*)(F.lds + F.wave * 2048);
    const int gw = F.bid * NWAVES + F.wave, NGW = F.G * NWAVES, p = F.lane;
    for (int task = gw; task < 512 * 16; task += NGW) {
        const int g = task & 15, cidx = task >> 4;
        const float lbr = SPp[SP_LB + (g * 64 + p) * 2], lbi = SPp[SP_LB + (g * 64 + p) * 2 + 1];
        float bbr[16], bbi[16];
#pragma unroll
        for (int c = 0; c < 16; ++c) { bbr[c] = SPp[SP_BBR + (g * 64 + p) * 16 + c]; bbi[c] = SPp[SP_BBI + (g * 64 + p) * 16 + c]; }
        float xr = 0.f, xi = 0.f;
        for (int half = 0; half < 2; ++half) {
            s5_stage_u32(F, U, cidx * 64 + half * 32, g);
            for (int t = 0; t < 32; ++t) S5_STEP(t);
            asm volatile("s_waitcnt lgkmcnt(0)" ::: "memory");
        }
        S5Ep[(size_t)(cidx * 16 + g) * 64 + p] = (f32x2){xr, xi};
    }
}
constexpr int XSTR = 132;
constexpr int S5_WAVE_LDS = 2048 + 64 * XSTR * 2;
__device__ __forceinline__ void phase_s5_out(Frame& F, int l, const float* c_re, const float* c_im, const float* ssm_d) {
    const float* SPp = F.SP(); const f32x2* S5Ep = F.S5E();
#ifdef NO_PHASE_S5_OUT
    return;
#endif
    LAS float* U = (LAS float*)(F.lds + F.wave * S5_WAVE_LDS);
    LAS bf16_t* X = (LAS bf16_t*)(F.lds + F.wave * S5_WAVE_LDS + 2048);
    const int gw = F.bid * NWAVES + F.wave, NGW = F.G * NWAVES, p = F.lane;
    for (int task = gw; task < 512 * 16; task += NGW) {
        const int g = task & 15, cidx = task >> 4, tok0 = cidx * 64;
        {
            const float lbr = SPp[SP_LB + (g * 64 + p) * 2], lbi = SPp[SP_LB + (g * 64 + p) * 2 + 1];
            float bbr[16], bbi[16];
#pragma unroll
            for (int c = 0; c < 16; ++c) { bbr[c] = SPp[SP_BBR + (g * 64 + p) * 16 + c]; bbi[c] = SPp[SP_BBI + (g * 64 + p) * 16 + c]; }
            const f32x2 s0 = S5Ep[(size_t)(cidx * 16 + g) * 64 + p];
            float xr = s0.x, xi = s0.y;
            for (int half = 0; half < 2; ++half) {
                s5_stage_u32(F, U, tok0 + half * 32, g);
                for (int t = 0; t < 32; ++t) { S5_STEP(t); LAS bf16_t* xrow = X + (half * 32 + t) * XSTR; xrow[p] = (bf16_t)f2bf(xr); xrow[64 + p] = (bf16_t)f2bf(xi); }
                asm volatile("s_waitcnt lgkmcnt(0)" ::: "memory");
            }
        }
        const int t = F.lane;
        float acc[16];
#pragma unroll
        for (int co = 0; co < 16; ++co) acc[co] = 0.f;
        const float* cre = c_re + (size_t)(l * 16 + g) * 16 * 64; const float* cim = c_im + (size_t)(l * 16 + g) * 16 * 64;
        for (int pc = 0; pc < 16; ++pc) {
            const u32x2 wr_ = *(const LAS u32x2*)(X + t * XSTR + 4 * pc), wi_ = *(const LAS u32x2*)(X + t * XSTR + 64 + 4 * pc);
            const float r0 = bflo(wr_.x), r1 = bfhi(wr_.x), r2 = bflo(wr_.y), r3 = bfhi(wr_.y), i0 = bflo(wi_.x), i1 = bfhi(wi_.x), i2 = bflo(wi_.y), i3 = bfhi(wi_.y);
#pragma unroll
            for (int co = 0; co < 16; ++co) {
                const f32x4 cr = *(const f32x4*)(cre + co * 64 + 4 * pc), ci = *(const f32x4*)(cim + co * 64 + 4 * pc);
                acc[co] += (cr.x * r0 + cr.y * r1 + cr.z * r2 + cr.w * r3) - (ci.x * i0 + ci.y * i1 + ci.z * i2 + ci.w * i3);
            }
        }
        const u32x4* up = (const u32x4*)(F.ZS() + (size_t)(tok0 + t) * ZSW + ZU + g * 16);
        f32x4 ua, ub, uc, ud; unpack8(up[0], ua, ub); unpack8(up[1], uc, ud);
        const float uv[16] = {ua.x, ua.y, ua.z, ua.w, ub.x, ub.y, ub.z, ub.w, uc.x, uc.y, uc.z, uc.w, ud.x, ud.y, ud.z, ud.w};
        const float* dsk = ssm_d + (l * 16 + g) * 16;
        float y[16];
#pragma unroll
        for (int co = 0; co < 16; ++co) y[co] = gelu_tanh(acc[co] + dsk[co] * uv[co]);
        u32x4 o0, o1; o0.x = pk2(y[0], y[1]); o0.y = pk2(y[2], y[3]); o0.z = pk2(y[4], y[5]); o0.w = pk2(y[6], y[7]); o1.x = pk2(y[8], y[9]); o1.y = pk2(y[10], y[11]); o1.z = pk2(y[12], y[13]); o1.w = pk2(y[14], y[15]);
        u32x4* hp = (u32x4*)(F.H() + (size_t)(tok0 + t) * DM + g * 16); hp[0] = o0; hp[1] = o1;
        asm volatile("s_waitcnt lgkmcnt(0)" ::: "memory");
    }
}

__device__ __forceinline__ void phase_carry(Frame& F) {
    const float* SPp = F.SP(); f32x2* S5Ep = F.S5E(); float* RSTp = F.RST();
#ifdef NO_PHASE_CARRY
    return;
#endif
    const int gw = F.bid * NWAVES + F.wave, NGW = F.G * NWAVES;
    for (int task = gw; task < NB * 16; task += NGW) {
        const int b = task >> 4, g = task & 15, p = F.lane;
        const float ar = SPp[SP_L64 + (g * 64 + p) * 2], ai = SPp[SP_L64 + (g * 64 + p) * 2 + 1];
        float sr = 0.f, si = 0.f;
        for (int c0 = 0; c0 < 128; c0 += 16) {
            f32x2 e[16];
#pragma unroll
            for (int j = 0; j < 16; ++j) e[j] = S5Ep[(size_t)((b * 128 + c0 + j) * 16 + g) * 64 + p];
#pragma unroll
            for (int j = 0; j < 16; ++j) { S5Ep[(size_t)((b * 128 + c0 + j) * 16 + g) * 64 + p] = (f32x2){sr, si}; const float nr = ar * sr - ai * si + e[j].x, ni = ar * si + ai * sr + e[j].y; sr = nr; si = ni; }
        }
    }
    const int NT = F.G * NTHREADS;
    for (int gt = F.bid * NTHREADS + F.tid; gt < NB * 4 * 4608; gt += NT) {
        const int b = gt / (4 * 4608), h = (gt / 4608) & 3, el = gt % 4608;
        const float gam = 1.f - exp2f(-5.f - (float)h); const float lg = log1pf(-exp2f(-5.f - (float)h)); (void)gam;
        const float cdec = expf(lg * 64.f);
        float s = 0.f;
        for (int c0 = 0; c0 < 128; c0 += 16) {
            float d[16];
#pragma unroll
            for (int j = 0; j < 16; ++j) d[j] = RSTp[(size_t)((b * 128 + c0 + j) * 4 + h) * 4608 + el];
#pragma unroll
            for (int j = 0; j < 16; ++j) { RSTp[(size_t)((b * 128 + c0 + j) * 4 + h) * 4608 + el] = s; s = s * cdec + d[j]; }
        }
    }
}

__device__ __forceinline__ void phase_ret_local(Frame& F) {
#ifdef NO_PHASE_RET_LOCAL
    return;
#endif
    LAS float* Ks = (LAS float*)F.lds;
    LAS float* Vs = (LAS float*)(F.lds + 12288);
    for (int item = F.bid; item < 2048; item += F.G) {
        const int h = item & 3, cidx = item >> 2, tok0 = cidx * 64;
        const float lg = log1pf(-exp2f(-5.f - (float)h));
        for (int i = F.tid; i < 64 * 6 + 64 * 12; i += NTHREADS) {
            if (i < 384) { const int r = i / 6, v8 = i % 6; f32x4 a, b; unpack8(*(const u32x4*)(F.ZS() + (size_t)(tok0 + r) * ZSW + ZRK + h * 48 + v8 * 8), a, b);
                const float sc = 0.14433756729740643f * expf(lg * (float)(63 - r)); LAS f32x4* d = (LAS f32x4*)(Ks + r * 48 + v8 * 8); d[0] = a * sc; d[1] = b * sc; }
            else { const int q = i - 384, r = q / 12, v8 = q % 12; f32x4 a, b; unpack8(*(const u32x4*)(F.ZS() + (size_t)(tok0 + r) * ZSW + ZRV + h * 96 + v8 * 8), a, b);
                LAS f32x4* d = (LAS f32x4*)(Vs + r * 96 + v8 * 8); d[0] = a; d[1] = b; }
        }
        __syncthreads();
        if (F.tid < 384) {
            const int e = F.tid % 96, dq = F.tid / 96;
            float acc[12];
#pragma unroll
            for (int j = 0; j < 12; ++j) acc[j] = 0.f;
            for (int tk = 0; tk < 64; ++tk) {
                const float v = Vs[tk * 96 + e]; const LAS f32x4* kp = (const LAS f32x4*)(Ks + tk * 48 + dq * 12); const f32x4 k0 = kp[0], k1 = kp[1], k2 = kp[2];
                acc[0] += k0.x * v; acc[1] += k0.y * v; acc[2] += k0.z * v; acc[3] += k0.w * v; acc[4] += k1.x * v; acc[5] += k1.y * v; acc[6] += k1.z * v; acc[7] += k1.w * v;
                acc[8] += k2.x * v; acc[9] += k2.y * v; acc[10] += k2.z * v; acc[11] += k2.w * v;
            }
            f32x4* dst = (f32x4*)(F.RST() + (size_t)item * 4608 + e * 48 + dq * 12);
            dst[0] = (f32x4){acc[0], acc[1], acc[2], acc[3]}; dst[1] = (f32x4){acc[4], acc[5], acc[6], acc[7]}; dst[2] = (f32x4){acc[8], acc[9], acc[10], acc[11]};
        }
        __syncthreads();
    }
}
__device__ __forceinline__ void phase_ret_out(Frame& F, int l, const float* ret_norm_g) {
#ifdef NO_PHASE_RET_OUT
    return;
#endif
    constexpr int QS = 52, VS_ = 100, PS = 68;
    LAS float* Qs = (LAS float*)F.lds;
    LAS float* Ks = Qs + 64 * QS;
    LAS float* Vs = Ks + 64 * QS;
    LAS float* Ps = Vs + 64 * VS_;
    LAS float* Ss = Ps + 64 * PS;
    LAS float* PW = Ss + 96 * QS;
    for (int item = F.bid; item < 2048; item += F.G) {
        const int h = item & 3, cidx = item >> 2, tok0 = cidx * 64;
        const float lg = log1pf(-exp2f(-5.f - (float)h));
        if (F.tid < 65) PW[F.tid] = expf(lg * (float)F.tid);
        for (int i = F.tid; i < 384 + 384 + 768 + 1152; i += NTHREADS) {
            if (i < 384) { const int r = i / 6, v8 = i % 6; f32x4 a, b; unpack8(*(const u32x4*)(F.ZS() + (size_t)(tok0 + r) * ZSW + ZRQ + h * 48 + v8 * 8), a, b);
                LAS f32x4* d = (LAS f32x4*)(Qs + r * QS + v8 * 8); d[0] = a; d[1] = b; }
            else if (i < 768) { const int q = i - 384, r = q / 6, v8 = q % 6; f32x4 a, b; unpack8(*(const u32x4*)(F.ZS() + (size_t)(tok0 + r) * ZSW + ZRK + h * 48 + v8 * 8), a, b);
                const float sc = 0.14433756729740643f; LAS f32x4* d = (LAS f32x4*)(Ks + r * QS + v8 * 8); d[0] = a * sc; d[1] = b * sc; }
            else if (i < 1536) { const int q = i - 768, r = q / 12, v8 = q % 12; f32x4 a, b; unpack8(*(const u32x4*)(F.ZS() + (size_t)(tok0 + r) * ZSW + ZRV + h * 96 + v8 * 8), a, b);
                LAS f32x4* d = (LAS f32x4*)(Vs + r * VS_ + v8 * 8); d[0] = a; d[1] = b; }
            else { const int q = i - 1536, e = q / 12, v4 = q % 12; *(LAS f32x4*)(Ss + e * QS + v4 * 4) = *(const f32x4*)(F.RST() + (size_t)item * 4608 + e * 48 + v4 * 4); }
        }
        __syncthreads();
        const int i = F.tid >> 3, sg = F.tid & 7;
        {
            float pacc[8];
#pragma unroll
            for (int jj = 0; jj < 8; ++jj) pacc[jj] = 0.f;
            for (int d4 = 0; d4 < 12; ++d4) {
                const f32x4 q = *(const LAS f32x4*)(Qs + i * QS + d4 * 4);
#pragma unroll
                for (int jj = 0; jj < 8; ++jj) { const f32x4 k = *(const LAS f32x4*)(Ks + (sg * 8 + jj) * QS + d4 * 4); pacc[jj] += q.x * k.x + q.y * k.y + q.z * k.z + q.w * k.w; }
            }
#pragma unroll
            for (int jj = 0; jj < 8; ++jj) { const int j = sg * 8 + jj; Ps[i * PS + j] = (j <= i) ? pacc[jj] * PW[i - j] : 0.f; }
        }
        __syncthreads();
        float o[12];
        {
            float oc[12];
#pragma unroll
            for (int k = 0; k < 12; ++k) { o[k] = 0.f; oc[k] = 0.f; }
            for (int j = 0; j < 64; ++j) {
                const float pv = Ps[i * PS + j]; const LAS f32x4* vp = (const LAS f32x4*)(Vs + j * VS_ + sg * 12); const f32x4 v0 = vp[0], v1 = vp[1], v2 = vp[2];
                o[0] += pv * v0.x; o[1] += pv * v0.y; o[2] += pv * v0.z; o[3] += pv * v0.w; o[4] += pv * v1.x; o[5] += pv * v1.y; o[6] += pv * v1.z; o[7] += pv * v1.w;
                o[8] += pv * v2.x; o[9] += pv * v2.y; o[10] += pv * v2.z; o[11] += pv * v2.w;
            }
            for (int d4 = 0; d4 < 12; ++d4) {
                const f32x4 q = *(const LAS f32x4*)(Qs + i * QS + d4 * 4);
#pragma unroll
                for (int k = 0; k < 12; ++k) { const f32x4 s = *(const LAS f32x4*)(Ss + (sg * 12 + k) * QS + d4 * 4); oc[k] += q.x * s.x + q.y * s.y + q.z * s.z + q.w * s.w; }
            }
            const float qd = PW[i + 1];
#pragma unroll
            for (int k = 0; k < 12; ++k) o[k] += qd * oc[k];
        }
        float s = 0.f;
#pragma unroll
        for (int k = 0; k < 12; ++k) s += o[k];
        s += __shfl_xor(s, 1); s += __shfl_xor(s, 2); s += __shfl_xor(s, 4);
        const float mu = s * (1.f / 96.f); float q2 = 0.f;
#pragma unroll
        for (int k = 0; k < 12; ++k) { o[k] -= mu; q2 += o[k] * o[k]; }
        q2 += __shfl_xor(q2, 1); q2 += __shfl_xor(q2, 2); q2 += __shfl_xor(q2, 4);
        const float rs = rsqrtf(q2 * (1.f / 96.f) + EPS);
        const int tok = tok0 + i, cb = h * 96 + sg * 12;
        const bf16_t* gp = F.ZS() + (size_t)tok * ZSW + ZRG + cb; const float* ng = ret_norm_g + l * 384 + cb;
        float r[12];
#pragma unroll
        for (int k = 0; k < 12; ++k) { const float gte = bf2f(gp[k]); r[k] = (gte * sigmoidf_(gte)) * (o[k] * rs * ng[k]); }
        u32x2* hp = (u32x2*)(F.H() + (size_t)tok * DM + 640 + cb);
        hp[0] = (u32x2){pk2(r[0], r[1]), pk2(r[2], r[3])}; hp[1] = (u32x2){pk2(r[4], r[5]), pk2(r[6], r[7])}; hp[2] = (u32x2){pk2(r[8], r[9]), pk2(r[10], r[11])};
        __syncthreads();
    }
}

typedef float f32x16 __attribute__((ext_vector_type(16)));
typedef short s16x4 __attribute__((ext_vector_type(4)));
typedef _Float16 f16_t;
__device__ __forceinline__ int lanes_below(unsigned long long m) { return (int)__builtin_amdgcn_mbcnt_hi((unsigned)(m >> 32), __builtin_amdgcn_mbcnt_lo((unsigned)m, 0u)); }
__device__ __forceinline__ unsigned sortable_f16(float sc) {
    if (sc == 0.0f) sc = 0.0f;
    const f16_t h = (f16_t)sc; const unsigned u = (unsigned)__builtin_bit_cast(unsigned short, h);
    return (u & 0x8000u) ? (~u & 0xffffu) : (u | 0x8000u);
}
__device__ __forceinline__ int sc_pos(int k) { return (k & ~511) + ((k & 63) << 3) + ((k >> 6) & 7); }
__device__ __forceinline__ int wave_suffix_sum(int v, int lane) {
#pragma unroll
    for (int o = 1; o < 64; o <<= 1) { const int t = __shfl_down(v, o); if (lane + o < 64) v += t; }
    return v;
}
__device__ __forceinline__ void hist_threshold(const u32x4 c, int need, int lane, int& B, int& above) {
    const int s = (int)(c.x + c.y + c.z + c.w);
    const int S = wave_suffix_sum(s, lane);
    int a = S - s;
    const bool found = (a < need) && (S >= need);
    int Bl = 0, al = 0;
    if (found) {
        if (a + (int)c.w >= need) { Bl = 4 * lane + 3; al = a; }
        else { a += (int)c.w; if (a + (int)c.z >= need) { Bl = 4 * lane + 2; al = a; }
        else { a += (int)c.z; if (a + (int)c.y >= need) { Bl = 4 * lane + 1; al = a; }
        else { a += (int)c.y; Bl = 4 * lane; al = a; } } }
    }
    const unsigned long long m = __ballot(found);
    const int src = m ? (int)__builtin_ctzll(m) : 0;
    B = __shfl(Bl, src); above = __shfl(al, src);
}

constexpr int DSA_ROW = 16384;
constexpr int DSA_VSTR = 160;
__device__ __forceinline__ void phase_dsa(Frame& F) {
#ifdef NO_PHASE_DSA
    return;
#endif
    const int lane = F.lane, wave = F.wave;
    const bf16_t* ZSp = F.ZS(); const float* IWp = F.IW();
    LAS unsigned char* SCb = F.lds;
    LAS unsigned* H1 = (LAS unsigned*)(F.lds + 131072) + wave * 512;
    LAS unsigned* H2 = H1 + 256;
    LAS unsigned short* LSTw = (LAS unsigned short*)(F.lds + 131072 + 16384) + wave * 256;
    const int hi = lane >> 5, n32 = lane & 31;
    for (int it = F.bid; it < 512; it += F.G) {
        const int pr = it & 255, vcu = (pr & 7) * 32 + (pr >> 3);
        const int b = vcu >> 6, cc = vcu & 63, c = (it < 256) ? cc : 127 - cc;
        const int V = (c + 1) * 64, tokq0 = b * SEQ + c * 64, kb0 = b * SEQ;
        const int Keff = V < 256 ? V : 256;
        const int nblk = (V + 511) >> 9, ntile_all = nblk * 16, ntile_real = V >> 5;
        for (int qg = 0; qg < 8; ++qg) {
            const int tq0 = tokq0 + qg * 8;
            {
                bf16x8 aq[2];
                { const int qq = n32 >> 2, hd = n32 & 3; const bf16_t* qp = ZSp + (size_t)(tq0 + qq) * ZSW + ZIQ + hd * 32 + 8 * hi;
                  aq[0] = *(const bf16x8*)qp; aq[1] = *(const bf16x8*)(qp + 16); }
                float wq[4][4];
#pragma unroll
                for (int jq = 0; jq < 4; ++jq) { const f32x4 w4 = *(const f32x4*)(IWp + (size_t)(tq0 + 2 * jq + hi) * 4);
                    wq[jq][0] = w4.x * 0.08838834764831845f; wq[jq][1] = w4.y * 0.08838834764831845f; wq[jq][2] = w4.z * 0.08838834764831845f; wq[jq][3] = w4.w * 0.08838834764831845f; }
                for (int tt = wave; tt < ntile_all; tt += 8) {
                    const int key = tt * 32 + n32;
                    unsigned short us[4] = {0, 0, 0, 0};
                    if (tt < ntile_real) {
                        const bf16_t* kp = ZSp + (size_t)(kb0 + key) * ZSW + ZIK + 8 * hi;
                        const bf16x8 b0 = *(const bf16x8*)kp, b1 = *(const bf16x8*)(kp + 16);
                        f32x16 acc = {0.f, 0.f, 0.f, 0.f, 0.f, 0.f, 0.f, 0.f, 0.f, 0.f, 0.f, 0.f, 0.f, 0.f, 0.f, 0.f};
                        acc = __builtin_amdgcn_mfma_f32_32x32x16_bf16(aq[0], b0, acc, 0, 0, 0);
                        acc = __builtin_amdgcn_mfma_f32_32x32x16_bf16(aq[1], b1, acc, 0, 0, 0);
#pragma unroll
                        for (int jq = 0; jq < 4; ++jq) {
                            const float sc = fmaxf(acc[4 * jq + 0], 0.f) * wq[jq][0] + fmaxf(acc[4 * jq + 1], 0.f) * wq[jq][1] + fmaxf(acc[4 * jq + 2], 0.f) * wq[jq][2] + fmaxf(acc[4 * jq + 3], 0.f) * wq[jq][3];
                            us[jq] = (unsigned short)sortable_f16(sc);
                        }
                    }
                    const int pos = sc_pos(key);
#pragma unroll
                    for (int jq = 0; jq < 4; ++jq) *(LAS unsigned short*)(SCb + (2 * jq + hi) * DSA_ROW + pos * 2) = us[jq];
                }
            }
            __syncthreads();
            LAS unsigned char* row = SCb + wave * DSA_ROW;
            if (V > 256) {
                *(LAS u32x4*)(H1 + 4 * lane) = (u32x4){0u, 0u, 0u, 0u}; *(LAS u32x4*)(H2 + 4 * lane) = (u32x4){0u, 0u, 0u, 0u};
                asm volatile("s_waitcnt lgkmcnt(0)" ::: "memory");
                for (int i = 0; i < nblk; ++i) {
                    const u32x4 w = *(const LAS u32x4*)(row + (512 * i + 8 * lane) * 2);
                    __hip_atomic_fetch_add(H1 + ((w.x >> 8) & 255u), 1u, __ATOMIC_RELAXED, __HIP_MEMORY_SCOPE_WORKGROUP); __hip_atomic_fetch_add(H1 + (w.x >> 24), 1u, __ATOMIC_RELAXED, __HIP_MEMORY_SCOPE_WORKGROUP);
                    __hip_atomic_fetch_add(H1 + ((w.y >> 8) & 255u), 1u, __ATOMIC_RELAXED, __HIP_MEMORY_SCOPE_WORKGROUP); __hip_atomic_fetch_add(H1 + (w.y >> 24), 1u, __ATOMIC_RELAXED, __HIP_MEMORY_SCOPE_WORKGROUP);
                    __hip_atomic_fetch_add(H1 + ((w.z >> 8) & 255u), 1u, __ATOMIC_RELAXED, __HIP_MEMORY_SCOPE_WORKGROUP); __hip_atomic_fetch_add(H1 + (w.z >> 24), 1u, __ATOMIC_RELAXED, __HIP_MEMORY_SCOPE_WORKGROUP);
                    __hip_atomic_fetch_add(H1 + ((w.w >> 8) & 255u), 1u, __ATOMIC_RELAXED, __HIP_MEMORY_SCOPE_WORKGROUP); __hip_atomic_fetch_add(H1 + (w.w >> 24), 1u, __ATOMIC_RELAXED, __HIP_MEMORY_SCOPE_WORKGROUP);
                }
                asm volatile("s_waitcnt lgkmcnt(0)" ::: "memory");
                int B1, above1; hist_threshold(*(const LAS u32x4*)(H1 + 4 * lane), 256, lane, B1, above1);
                for (int i = 0; i < nblk; ++i) {
                    const u32x4 w = *(const LAS u32x4*)(row + (512 * i + 8 * lane) * 2);
                    const unsigned ww[4] = {w.x, w.y, w.z, w.w};
#pragma unroll
                    for (int e2 = 0; e2 < 4; ++e2) {
                        if ((int)((ww[e2] >> 8) & 255u) == B1) __hip_atomic_fetch_add(H2 + (ww[e2] & 255u), 1u, __ATOMIC_RELAXED, __HIP_MEMORY_SCOPE_WORKGROUP);
                        if ((int)(ww[e2] >> 24) == B1) __hip_atomic_fetch_add(H2 + ((ww[e2] >> 16) & 255u), 1u, __ATOMIC_RELAXED, __HIP_MEMORY_SCOPE_WORKGROUP);
                    }
                }
                asm volatile("s_waitcnt lgkmcnt(0)" ::: "memory");
                int B2, above2; hist_threshold(*(const LAS u32x4*)(H2 + 4 * lane), 256 - above1, lane, B2, above2);
                const unsigned tau = ((unsigned)B1 << 8) | (unsigned)B2;
                const int r = 256 - above1 - above2;
                int eq_base = 0, sel_base = 0;
                for (int i = 0; i < nblk; ++i) {
                    const u32x4 w = *(const LAS u32x4*)(row + (512 * i + 8 * lane) * 2);
                    const unsigned ww[4] = {w.x, w.y, w.z, w.w};
#pragma unroll
                    for (int e = 0; e < 8; ++e) {
                        const unsigned u = (e & 1) ? (ww[e >> 1] >> 16) : (ww[e >> 1] & 0xffffu);
                        const bool gt = u > tau, eq = (u == tau);
                        const unsigned long long meq = __ballot(eq);
                        const bool sel = gt || (eq && (eq_base + lanes_below(meq) < r));
                        const unsigned long long msel = __ballot(sel);
                        if (sel) LSTw[sel_base + lanes_below(msel)] = (unsigned short)(512 * i + 64 * e + lane);
                        eq_base += __popcll(meq); sel_base += __popcll(msel);
                    }
                }
            } else {
#pragma unroll
                for (int jj = 0; jj < 4; ++jj) LSTw[lane + 64 * jj] = (unsigned short)(lane + 64 * jj);
            }
            asm volatile("s_waitcnt lgkmcnt(0)" ::: "memory");
            {
                const int tq = tq0 + wave, n16 = lane & 15, kg = lane >> 4;
                bf16x8 qf[2];
                if (n16 < 6) { const bf16_t* qp = ZSp + (size_t)tq * ZSW + ZDQ + n16 * 64 + 8 * kg; qf[0] = *(const bf16x8*)qp; qf[1] = *(const bf16x8*)(qp + 32); }
                else { qf[0] = (bf16x8){0, 0, 0, 0, 0, 0, 0, 0}; qf[1] = qf[0]; }
                const int ntile = Keff >> 4;
                f32x4 sa[16];
#pragma unroll
                for (int tb = 0; tb < 4; ++tb) {
                    if (tb * 4 < ntile) {
                        bf16x8 kf[4][2];
#pragma unroll
                        for (int t4 = 0; t4 < 4; ++t4) { const int kidx = LSTw[(tb * 4 + t4) * 16 + n16]; const bf16_t* kp = ZSp + (size_t)(kb0 + kidx) * ZSW + ZDK + 8 * kg;
                            kf[t4][0] = *(const bf16x8*)kp; kf[t4][1] = *(const bf16x8*)(kp + 32); }
#pragma unroll
                        for (int t4 = 0; t4 < 4; ++t4) { f32x4 a = {0.f, 0.f, 0.f, 0.f};
                            a = __builtin_amdgcn_mfma_f32_16x16x32_bf16(kf[t4][0], qf[0], a, 0, 0, 0); a = __builtin_amdgcn_mfma_f32_16x16x32_bf16(kf[t4][1], qf[1], a, 0, 0, 0); sa[tb * 4 + t4] = a; }
                    } else {
#pragma unroll
                        for (int t4 = 0; t4 < 4; ++t4) sa[tb * 4 + t4] = (f32x4){-1e30f, -1e30f, -1e30f, -1e30f};
                    }
                }
                float m = -1e30f;
#pragma unroll
                for (int t = 0; t < 16; ++t) m = fmaxf(m, fmaxf(fmaxf(sa[t].x, sa[t].y), fmaxf(sa[t].z, sa[t].w)));
                m = fmaxf(m, __shfl_xor(m, 16)); m = fmaxf(m, __shfl_xor(m, 32));
                const float sc2 = 0.125f * 1.4426950408889634f; float lsum = 0.f;
#pragma unroll
                for (int t = 0; t < 16; ++t) { sa[t].x = exp2f((sa[t].x - m) * sc2); sa[t].y = exp2f((sa[t].y - m) * sc2); sa[t].z = exp2f((sa[t].z - m) * sc2); sa[t].w = exp2f((sa[t].w - m) * sc2);
                    lsum += (sa[t].x + sa[t].y) + (sa[t].z + sa[t].w); }
                lsum += __shfl_xor(lsum, 16); lsum += __shfl_xor(lsum, 32);
                const float linv = 1.f / lsum;
                f32x4 oacc[4] = {{0.f, 0.f, 0.f, 0.f}, {0.f, 0.f, 0.f, 0.f}, {0.f, 0.f, 0.f, 0.f}, {0.f, 0.f, 0.f, 0.f}};
                LAS unsigned char* vst = row;
                const int q4 = n16 >> 2, p4 = n16 & 3;
#pragma unroll
                for (int ch = 0; ch < 4; ++ch) {
                    if (ch * 4 < ntile) {
                        u32x4 vr[8];
#pragma unroll
                        for (int i8 = 0; i8 < 8; ++i8) { const int rr = (lane >> 3) + 8 * i8; const int kidx = LSTw[ch * 64 + rr];
                            vr[i8] = *(const u32x4*)(ZSp + (size_t)(kb0 + kidx) * ZSW + ZDV + (lane & 7) * 8); }
#pragma unroll
                        for (int i8 = 0; i8 < 8; ++i8) { const int rr = (lane >> 3) + 8 * i8; *(LAS u32x4*)(vst + rr * DSA_VSTR + (lane & 7) * 16) = vr[i8]; }
                        asm volatile("s_waitcnt lgkmcnt(0)" ::: "memory");
#pragma unroll
                        for (int sl = 0; sl < 2; ++sl) {
                            const int s = ch * 2 + sl;
                            u32x4 pw; pw.x = pk2(sa[2 * s].x, sa[2 * s].y); pw.y = pk2(sa[2 * s].z, sa[2 * s].w); pw.z = pk2(sa[2 * s + 1].x, sa[2 * s + 1].y); pw.w = pk2(sa[2 * s + 1].z, sa[2 * s + 1].w);
                            const bf16x8 pb = __builtin_bit_cast(bf16x8, pw);
#pragma unroll
                            for (int mt = 0; mt < 4; ++mt) {
                                const LAS unsigned char* a0 = vst + (32 * sl + 4 * kg + q4) * DSA_VSTR + (16 * mt + 4 * p4) * 2;
                                const s16x4 lo = __builtin_bit_cast(s16x4, __builtin_amdgcn_ds_read_tr16_b64_v4i16((LAS s16x4*)a0));
                                const s16x4 hi4 = __builtin_bit_cast(s16x4, __builtin_amdgcn_ds_read_tr16_b64_v4i16((LAS s16x4*)(a0 + 16 * DSA_VSTR)));
                                const bf16x8 va = (bf16x8){lo[0], lo[1], lo[2], lo[3], hi4[0], hi4[1], hi4[2], hi4[3]};
                                oacc[mt] = __builtin_amdgcn_mfma_f32_16x16x32_bf16(va, pb, oacc[mt], 0, 0, 0);
                            }
                        }
                        asm volatile("s_waitcnt lgkmcnt(0)" ::: "memory");
                    }
                }
                if (n16 < 6) {
                    bf16_t* op = F.H() + (size_t)tq * DM + 256 + n16 * 64 + 4 * kg;
#pragma unroll
                    for (int mt = 0; mt < 4; ++mt) { u32x2 o; o.x = pk2(oacc[mt].x * linv, oacc[mt].y * linv); o.y = pk2(oacc[mt].z * linv, oacc[mt].w * linv); *(u32x2*)(op + 16 * mt) = o; }
                }
            }
            __syncthreads();
        }
    }
}

__global__ void __launch_bounds__(NTHREADS, 2) mk_fwd(Args args) {
    extern __shared__ __attribute__((aligned(16))) unsigned char lds_raw[];
    Frame F;
    F.lds = (LAS unsigned char*)lds_raw;
    F.tid = threadIdx.x; F.lane = F.tid & 63; F.wave = __builtin_amdgcn_readfirstlane(F.tid >> 6);
    F.G = gridDim.x; F.bid = blockIdx.x; F.ws = args.ws;
    unsigned char* ws = args.ws;
#define INF(k) ((const float*)args.in[k])

    volatile LAS unsigned* MISC = (volatile LAS unsigned*)(F.lds + MISC_OFF);
    if (F.tid < 64) MISC[F.tid] = 0u;
    __syncthreads();
    XcdBarrier bar = xcd_barrier_post((unsigned*)(ws + WS_CTL) + CW_BAR, MISC + 8);
    cg::grid_group grid = cg::this_grid();
    int ph = 0; const int lo = args.ph_lo, hi = args.ph_hi;
    bool first_seam = true;
#ifdef NO_CG
#define GRIDSYNC() xcd_barrier(bar)
#else
#define GRIDSYNC() grid.sync()
#endif
#define RUN(...) do { if (ph >= lo && ph < hi) { asm volatile("" : "+v"(F.tid), "+v"(F.lane), "+s"(F.ws), "+s"(F.bid), "+s"(F.G), "+s"(F.wave)); __VA_ARGS__; } ++ph; } while (0)
#define SEAM() do { if (ph > lo && ph < hi) { if (first_seam) { GRIDSYNC(); first_seam = false; } else xcd_barrier(bar); } } while (0)

    RUN(phase_rope(F, (const int*)args.in[1]));
    for (int l = 0; l < DEPTH; ++l) {
        const float* xin = (l == 0) ? INF(0) : args.out;
        RUN({ const ProIn I{xin, INF(2), INF(3), INF(15), INF(16), INF(17), INF(18), INF(20), INF(21), INF(12), INF(4), INF(5), INF(6), INF(7), INF(8), (const int*)args.in[1]};
              phase_prologue(F, l, I); }); SEAM();
#ifndef NO_G1
        RUN({ pg8::Gemm g{F.H(), F.Win_t()}; pg8::StaticOrder<T, NINP> S; S.init(F.G, F.bid);
              pg8::EpiGen<FInProj> E{FInProj{F.ZS(), F.GB(), F.IW(), F.ROPE()}}; pg8::gemm_phase<T, NINP, DM, DM, DM>(F.lds, g, S, E); }); SEAM();
#else
        RUN({}); SEAM();
#endif
        RUN({ phase_s5_local(F); __syncthreads(); phase_ret_local(F); __syncthreads(); phase_dsa(F); }); SEAM();
        RUN(phase_carry(F)); SEAM();
        RUN({ phase_s5_out(F, l, INF(9), INF(10), INF(11)); __syncthreads(); phase_ret_out(F, l, INF(14)); }); SEAM();
#ifndef NO_G2
        RUN({ pg8::Gemm g{F.H(), F.Wglu_t()}; pg8::StaticOrder<T, 256> S; S.init(F.G, F.bid);
              pg8::EpiGen<FGlu, 2> E{FGlu{F.H(), INF(13) + l * 256}}; pg8::gemm_phase<T, 256, 256, DM, 256>(F.lds, g, S, E); }); SEAM();
#else
        RUN({}); SEAM();
#endif
#ifndef NO_G3
        RUN({ pg8::StaticOrder<T, DM> S; S.init(F.G, F.bid);
              { pg8::Gemm g{F.H(), F.Wabc_t()}; pg8::EpiGen<FMerge, 2> E{FMerge{F.MG(), F.GB(), 0}}; pg8::gemm_phase<T, DM, 256, DM, DM>(F.lds, g, S, E); }
              { pg8::Gemm g{F.H() + 256, F.Wabc_t() + 256}; pg8::EpiGen<FMerge, 2> E{FMerge{F.MG(), F.GB(), 1}}; pg8::gemm_phase<T, DM, 384, DM, DM>(F.lds, g, S, E); }
              { pg8::Gemm g{F.H() + 640, F.Wabc_t() + 640}; pg8::EpiGen<FMerge, 2> E{FMerge{F.MG(), F.GB(), 2}}; pg8::gemm_phase<T, DM, 384, DM, DM>(F.lds, g, S, E); } }); SEAM();
#else
        RUN({}); SEAM();
#endif
#ifndef NO_G4
        RUN({ pg8::Gemm g{F.MG(), F.Wout_t()}; pg8::StaticOrder<T, DM> S; S.init(F.G, F.bid);
              pg8::EpiGen<FResid> E{FResid{xin, args.out}}; pg8::gemm_phase<T, DM, DM, DM, DM>(F.lds, g, S, E); }); SEAM();
#else
        RUN({}); SEAM();
#endif
        RUN({ const int gw = F.bid * NWAVES + F.wave, NGW = F.G * NWAVES; const float* g2 = INF(19) + l * DM;
              for (int m = gw; m < T; m += NGW) rms_row_bf16(args.out + (size_t)m * DM, g2, F.H() + (size_t)m * DM, F.lane); }); SEAM();
#ifndef NO_G5
        RUN({ pg8::Gemm g{F.H(), F.W1_t()}; pg8::StaticOrder<T, FF> S; S.init(F.G, F.bid);
              pg8::EpiGen<FRelu2> E{FRelu2{F.FB()}}; pg8::gemm_phase<T, FF, DM, DM, DM>(F.lds, g, S, E); }); SEAM();
#else
        RUN({}); SEAM();
#endif
#ifndef NO_G6
        RUN({ pg8::Gemm g{F.FB(), F.W2_t()}; pg8::StaticOrder<T, DM> S; S.init(F.G, F.bid);
              pg8::EpiGen<FResid> E{FResid{args.out, args.out}}; pg8::gemm_phase<T, DM, FF, FF, FF>(F.lds, g, S, E); }); SEAM();
#else
        RUN({}); SEAM();
#endif
    }
    RUN({ const int gw = F.bid * NWAVES + F.wave, NGW = F.G * NWAVES; const float* gf = INF(22);
          for (int m = gw; m < T; m += NGW) rms_row_f32(args.out + (size_t)m * DM, gf, args.out + (size_t)m * DM, F.lane); });
#undef RUN
#undef SEAM
}

extern "C" void kernel_launch(void* const* d_in, const int* in_sizes, int n_in, void* d_out, int out_size, void* d_ws, size_t ws_size, hipStream_t stream) {
    static int grid = 0;
    if (grid == 0) {
        if (n_in != 23 || out_size != T * DM || ws_size < WS_END) { fprintf(stderr, "kernel_launch: unexpected shapes (n_in %d out %d ws %zu)\n", n_in, out_size, ws_size); grid = -1; return; }
        int dev = 0, cus = 0, per_cu = 0;
        hipGetDevice(&dev); hipDeviceGetAttribute(&cus, hipDeviceAttributeMultiprocessorCount, dev);
        if (hipFuncSetAttribute((const void*)mk_fwd, hipFuncAttributeMaxDynamicSharedMemorySize, LDS_BYTES) != hipSuccess) { fprintf(stderr, "kernel_launch: hipFuncSetAttribute failed\n"); grid = -1; return; }
        if (hipOccupancyMaxActiveBlocksPerMultiprocessor(&per_cu, (const void*)mk_fwd, NTHREADS, LDS_BYTES) != hipSuccess || per_cu < 1) { fprintf(stderr, "kernel_launch: occupancy query says %d\n", per_cu); per_cu = 1; }
        (void)hipGetLastError();
        grid = cus;
    }
    if (grid < 0) return;
    hipMemsetAsync((char*)d_ws + WS_CTL, 0, CTL_ZERO_BYTES, stream);
    Args a{};
    for (int i = 0; i < 23; ++i) a.in[i] = d_in[i];
    a.out = (float*)d_out; a.ws = (unsigned char*)d_ws;
#ifndef MK_SPLIT
    a.ph_lo = 0; a.ph_hi = 1000;
    void* kargs[] = {&a};
    hipError_t e = hipLaunchCooperativeKernel((const void*)mk_fwd, dim3(grid), dim3(NTHREADS), kargs, LDS_BYTES, stream);
    if (e != hipSuccess) fprintf(stderr, "kernel_launch: cooperative launch failed: %s\n", hipGetErrorString(e));
#else
    for (int p = 0; p < 2 * 11 + 2; ++p) { a.ph_lo = p; a.ph_hi = p + 1; hipLaunchKernelGGL(mk_fwd, dim3(grid), dim3(NTHREADS), LDS_BYTES, stream, a); }
#endif
}
```

```cpp
#include <hip/hip_runtime.h>
#include <hip/hip_cooperative_groups.h>
#include <cstdio>
#include <cstdint>
namespace cg = cooperative_groups;

#define LAS __attribute__((address_space(3)))
#define GAS __attribute__((address_space(1)))
typedef unsigned short bf16_t;
typedef short bf16x8 __attribute__((ext_vector_type(8)));
typedef float f32x4 __attribute__((ext_vector_type(4)));
typedef float f32x2 __attribute__((ext_vector_type(2)));
typedef unsigned u32x4 __attribute__((ext_vector_type(4)));
typedef unsigned u32x2 __attribute__((ext_vector_type(2)));

constexpr int NB = 4, SEQ = 8192, T = NB * SEQ, DM = 1024, DEPTH = 2, FF = 4096;
constexpr int NIN = 5156, NINP = 5376;
constexpr int ZSW = 2112, GW = 3072;
constexpr int ZU = 0, ZDQ = 256, ZDK = 640, ZDV = 704, ZIQ = 768, ZIK = 896, ZIWC = 928, ZRQ = 960, ZRK = 1152, ZRV = 1344, ZRG = 1728, ZGATE = 2112, ZEND = 5184;
constexpr int NFREQ = 36;
constexpr float EPS = 1e-6f;

constexpr size_t MiB = 1u << 20;
constexpr size_t WS_CTL = 0, CTL_ZERO_BYTES = 64 * 1024;
constexpr size_t WS_IW = 1 * MiB;
constexpr size_t WS_SP = 1 * MiB + 512 * 1024;
constexpr size_t WS_ROPE = 2 * MiB;
constexpr size_t WS_S5E = 11 * MiB;
constexpr size_t WS_RST = 15 * MiB;
constexpr size_t WS_W = 51 * MiB;
constexpr size_t WO_IN = 0, WO_ABC = WO_IN + (size_t)NINP * DM * 2, WO_OUT = WO_ABC + (size_t)DM * DM * 2, WO_W1 = WO_OUT + (size_t)DM * DM * 2,
                 WO_W2 = WO_W1 + (size_t)FF * DM * 2, WO_GLU = WO_W2 + (size_t)FF * DM * 2, WO_END = WO_GLU + 256 * 256 * 2;
static_assert(WO_END <= 31 * MiB, "weights");
constexpr size_t WS_H = 82 * MiB;
constexpr size_t WS_ZS = 146 * MiB;
constexpr size_t WS_G = 278 * MiB;
constexpr size_t WS_END = 470 * MiB;
static_assert(WS_ZS + (size_t)T * ZSW * 2 <= WS_G && WS_G + (size_t)T * GW * 2 <= WS_END && WS_ZS + (size_t)T * FF * 2 <= WS_END, "ws map");
constexpr int CW_BAR = 1024;

constexpr int LDS_BYTES = 160 * 1024;
constexpr int RING_BYTES = 131072;
constexpr int MISC_OFF = LDS_BYTES - 256;

__device__ __forceinline__ unsigned f2bf(float f) { unsigned u = __builtin_bit_cast(unsigned, f); return (u + 0x7fffu + ((u >> 16) & 1u)) >> 16; }
__device__ __forceinline__ unsigned pk2(float lo, float hi) { unsigned r; asm("v_cvt_pk_bf16_f32 %0, %1, %2" : "=v"(r) : "v"(lo), "v"(hi)); return r; }
__device__ __forceinline__ float bf2f(unsigned short v) { return __builtin_bit_cast(float, (unsigned)v << 16); }
__device__ __forceinline__ float bflo(unsigned w) { return __builtin_bit_cast(float, w << 16); }
__device__ __forceinline__ float bfhi(unsigned w) { return __builtin_bit_cast(float, w & 0xffff0000u); }
__device__ __forceinline__ float sigmoidf_(float x) { return 1.0f / (1.0f + __expf(-x)); }
__device__ __forceinline__ float wave_sum(float v) {
#pragma unroll
    for (int o = 1; o < 64; o <<= 1) v += __shfl_xor(v, o);
    return v;
}
__device__ __forceinline__ float wave_max(float v) {
#pragma unroll
    for (int o = 1; o < 64; o <<= 1) v = fmaxf(v, __shfl_xor(v, o));
    return v;
}

#define XB_TMO      128
#define XB_XCNT(j)  (256  + 64 * (j))
#define XB_XSUB(j)  (1280 + 64 * (j))
#define XB_XGEN(j)  (2304 + 64 * (j))
#define XB_TOP      3328
#define XB_TOPGEN   3392
#define XCD_BAR_WORDS 3456
#define XB_SPIN_CAP (1u << 18)
__device__ __forceinline__ unsigned xb_ld(unsigned* p)              { return __hip_atomic_load(p, __ATOMIC_RELAXED, __HIP_MEMORY_SCOPE_AGENT); }
__device__ __forceinline__ unsigned xb_add(unsigned* p, unsigned v) { return __hip_atomic_fetch_add(p, v, __ATOMIC_RELAXED, __HIP_MEMORY_SCOPE_AGENT); }
__device__ __forceinline__ unsigned xb_xcc_id() { return (unsigned)__builtin_amdgcn_s_getreg((3 << 11) | 20) & 0xFu; }
#define XB_SPIN(cond, bar) do { unsigned _sp = 0; while (cond) { __builtin_amdgcn_s_sleep(1); \
    if ((++_sp & 255u) == 0u) { if (xb_ld(&(bar)[XB_TMO])) break; if (_sp > XB_SPIN_CAP) { atomicAdd(&(bar)[XB_TMO], 1u); break; } } } } while (0)
struct XcdBarrier { unsigned* bar; unsigned x; volatile LAS unsigned* st; };
__device__ __forceinline__ XcdBarrier xcd_barrier_post(unsigned* bar, volatile LAS unsigned* st) {
    XcdBarrier b; b.bar = bar; b.x = xb_xcc_id(); b.st = st;
    if (threadIdx.x == 0) (void)xb_add(&bar[XB_XCNT(b.x)], 1u);
    return b;
}
__device__ __forceinline__ void xcd_barrier_complete(unsigned* bar, unsigned x, unsigned& nloc, unsigned& nx) {
    const unsigned G = gridDim.x * gridDim.y * gridDim.z;
    unsigned sum, cnt, mine, sp = 0u;
    for (;;) {
        sum = 0u; cnt = 0u; mine = 0u;
#pragma unroll
        for (unsigned j = 0; j < 16; ++j) { const unsigned c = xb_ld(&bar[XB_XCNT(j)]); sum += c; cnt += (c > 0u) ? 1u : 0u; mine = (j == x) ? c : mine; }
        if (sum == G) break;
        __builtin_amdgcn_s_sleep(1);
        if ((++sp & 255u) == 0u) { if (xb_ld(&bar[XB_TMO])) break; if (sp > XB_SPIN_CAP) { atomicAdd(&bar[XB_TMO], 1u); break; } }
    }
    nloc = mine > 0u ? mine : 1u; nx = cnt > 0u ? cnt : 1u;
}
__device__ __forceinline__ void xcd_barrier(const XcdBarrier& b) {
    asm volatile("s_waitcnt vmcnt(0)" ::: "memory");
    __syncthreads();
    if (threadIdx.x == 0) {
        unsigned* bar = b.bar; unsigned bx = b.x;
        asm volatile("" : "+s"(bar), "+s"(bx));
        __builtin_amdgcn_s_waitcnt(0);
        unsigned nloc = b.st[0], nx = b.st[1];
        if (nloc == 0u) { xcd_barrier_complete(bar, bx, nloc, nx); b.st[0] = nloc; b.st[1] = nx; }
        const unsigned old = xb_add(&bar[XB_XSUB(bx)], 1u);
        const unsigned gen = old / nloc;
        if (old + 1u == (gen + 1u) * nloc) {
            __builtin_amdgcn_fence(__ATOMIC_RELEASE, "agent");
            asm volatile("s_waitcnt vmcnt(0)" ::: "memory");
            const unsigned og = xb_add(&bar[XB_TOP], 1u);
            const unsigned tg = og / nx;
            if (og + 1u == (tg + 1u) * nx) xb_add(&bar[XB_TOPGEN], 1u);
            else XB_SPIN(xb_ld(&bar[XB_TOPGEN]) == tg, bar);
            __builtin_amdgcn_fence(__ATOMIC_ACQUIRE, "agent");
            xb_add(&bar[XB_XGEN(bx)], 1u);
            asm volatile("s_waitcnt vmcnt(0)" ::: "memory");
        } else {
            XB_SPIN(xb_ld(&bar[XB_XGEN(bx)]) == gen, bar);
            __builtin_amdgcn_fence(__ATOMIC_ACQUIRE, "agent");
            asm volatile("s_waitcnt vmcnt(0)" ::: "memory");
        }
    }
    __syncthreads();
}

namespace pg8 {
constexpr int BM = 256, BK = 64, HALF = 128, HTB = HALF * BK * 2, STAGE_BYTES = 8 * HTB, NXCD = 8, WGM = 8;
__host__ __device__ __forceinline__ int lds_byte(int r, int c) { const int st = (r >> 4) * 2 + (c >> 5), rr = r & 15, cc = c & 31, ob = rr * 64 + cc * 2; return st * 1024 + (ob ^ (((ob >> 9) & 1) << 5)); }
__host__ __device__ __forceinline__ void stage_rc(int b, int& R, int& C) { const int st = b / 1024, sb = b % 1024, swz = sb ^ (((sb >> 9) & 1) << 5); R = (st >> 1) * 16 + swz / 64; C = (st & 1) * 32 + (swz % 64) / 2; }
__host__ __device__ __forceinline__ int perm32(int rho) { const int n = rho >> 4, i = rho & 15; return 8 * (i >> 2) + 4 * n + (i & 3); }

struct Unit { int pm, pn; };
struct Gemm { const bf16_t* A; const bf16_t* Bt; };

template <int M, int N> struct StaticOrder {
    static constexpr int nM = M / BM, nN = N / BM, nwg = nM * nN;
    int G, c;
    __host__ __device__ void init(int G_, int c_) { G = G_; c = c_; }
    __host__ __device__ bool next(int i, Unit& u) const {
        const long L = (long)i * G + c; if (L >= nwg) return false;
        int wgid = (int)L; { constexpr int q = nwg / NXCD, r = nwg % NXCD; const int xcd = wgid % NXCD, off = wgid / NXCD; wgid = (xcd < r ? xcd * (q + 1) : r * (q + 1) + (xcd - r) * q) + off; }
        constexpr int nig = WGM * nN; const int gid = wgid / nig, fm = gid * WGM, gsz = (nM - fm) < WGM ? (nM - fm) : WGM;
        u.pm = fm + ((wgid % nig) % gsz); u.pn = (wgid % nig) / gsz; return true;
    }
};

template <class F, int FENCE = 0> struct EpiGen {
    static constexpr bool PERM = true;
    F f;
    __device__ __forceinline__ void operator()(const f32x4 (&acc)[2][2][4][2], const Unit& u, int wr, int wc, int fr, int fq) const {
        const int row0 = u.pm * BM + wr * 64 + fr, col0 = u.pn * BM + wc * 32 + 8 * fq;
#pragma unroll
        for (int ai = 0; ai < 2; ++ai)
#pragma unroll
            for (int m = 0; m < 4; ++m)
#pragma unroll
                for (int bj = 0; bj < 2; ++bj) { f(row0 + ai * HALF + m * 16, col0 + bj * HALF, acc[ai][bj][m][0], acc[ai][bj][m][1]);
                    if constexpr (FENCE > 0) { if (((ai * 4 + m) * 2 + bj) % FENCE == FENCE - 1) asm volatile("" ::: "memory"); } }
    }
};

template <int M, int N, int K, int LDA, int LDB, class Epi, bool ALIGN_EPI = true>
__device__ __forceinline__ void gemm_phase(LAS unsigned char* lds, const Gemm g, const StaticOrder<M, N>& S, const Epi& E) {
    int tid = threadIdx.x; asm volatile("" : "+v"(tid));
    const int wid = __builtin_amdgcn_readfirstlane(tid >> 6), lane = tid & 63, wr = wid >> 2, wc = wid & 3, fr = lane & 15, fq = lane >> 4;
    constexpr int nt = K / BK;
    unsigned voffA[2], voffB[2];
#pragma unroll
    for (int i = 0; i < 2; ++i) { int R, C; stage_rc(tid * 16 + i * 8192, R, C); const int Rb = Epi::PERM ? ((R & ~31) + perm32(R & 31)) : R;
        voffA[i] = (unsigned)(R * LDA + C) * 2u; voffB[i] = (unsigned)(Rb * LDB + C) * 2u; }
    constexpr size_t kstep = (size_t)(BK * 2);
    constexpr size_t hstepA = (size_t)HALF * LDA * 2, hstepB = (size_t)HALF * LDB * 2;
    constexpr size_t tstepA = 2 * hstepA, tstepB = 2 * hstepB;
    const unsigned ldsw = (unsigned)wid * 1024u;
    const int aoff = lds_byte(wr * 64 + fr, fq * 8), boff = lds_byte(wc * 32 + fr, fq * 8);
#define PG8_SA(b, h) (((b) * 2 + (h)) * HTB)
#define PG8_SB(b, h) ((4 + (b) * 2 + (h)) * HTB)
#define PG8_STAGE(bufoff, gbase, voff) do { _Pragma("unroll") for (int _i = 0; _i < 2; ++_i) \
        __builtin_amdgcn_global_load_lds((const unsigned*)((const char*)(gbase) + (voff)[_i]), (LAS unsigned*)(lds + (bufoff) + ldsw + _i * 8192), 16, 0, 0); } while (0)
#define PG8_LDA(dst, b, h) do { _Pragma("unroll") for (int m = 0; m < 4; ++m) _Pragma("unroll") for (int k = 0; k < 2; ++k) dst[m][k] = *(const LAS bf16x8*)(lds + PG8_SA(b, h) + aoff + m * 2048 + k * 1024); } while (0)
#define PG8_LDB(dst, b, h) do { _Pragma("unroll") for (int n = 0; n < 2; ++n) _Pragma("unroll") for (int k = 0; k < 2; ++k) dst[n][k] = *(const LAS bf16x8*)(lds + PG8_SB(b, h) + boff + n * 2048 + k * 1024); } while (0)
#define PG8_MMA(ai, bj, At, Bt) do { __builtin_amdgcn_s_setprio(1); _Pragma("unroll") for (int m = 0; m < 4; ++m) _Pragma("unroll") for (int n = 0; n < 2; ++n) _Pragma("unroll") for (int k = 0; k < 2; ++k) \
        acc[ai][bj][m][n] = __builtin_amdgcn_mfma_f32_16x16x32_bf16(Bt[n][k], At[m][k], acc[ai][bj][m][n], 0, 0, 0); __builtin_amdgcn_s_setprio(0); } while (0)
#define PG8_WAIT_V(n) asm volatile("s_waitcnt vmcnt(" #n ")" ::: "memory")
#define PG8_WAIT_L(n) asm volatile("s_waitcnt lgkmcnt(" #n ")" ::: "memory")
#define PG8_BAR __builtin_amdgcn_s_barrier()
#define PG8_SCHED __builtin_amdgcn_sched_barrier(0)
    Unit cur, nxt; int ui = 0;
    if (!S.next(0, cur)) return;
    f32x4 acc[2][2][4][2];
#pragma unroll
    for (int a = 0; a < 2; ++a)
#pragma unroll
        for (int b = 0; b < 2; ++b)
#pragma unroll
            for (int m = 0; m < 4; ++m)
#pragma unroll
                for (int n = 0; n < 2; ++n) acc[a][b][m][n] = (f32x4){0.f, 0.f, 0.f, 0.f};
    bf16x8 At[4][2], B0[2][2], B1[2][2];
    const char* cA = (const char*)g.A + (size_t)cur.pm * tstepA; const char* cB = (const char*)g.Bt + (size_t)cur.pn * tstepB;
    PG8_STAGE(PG8_SB(0, 0), cB, voffB); PG8_STAGE(PG8_SB(0, 1), cB + hstepB, voffB); PG8_STAGE(PG8_SA(0, 0), cA, voffA); PG8_STAGE(PG8_SA(0, 1), cA + hstepA, voffA);
    if (wr == 1) PG8_BAR;
    PG8_WAIT_V(2); PG8_BAR;
    PG8_STAGE(PG8_SB(1, 0), cB + kstep, voffB); PG8_STAGE(PG8_SA(1, 0), cA + kstep, voffA); PG8_STAGE(PG8_SB(1, 1), cB + hstepB + kstep, voffB);
    PG8_WAIT_V(6); PG8_BAR;
    for (;;) {
        const bool has_next = S.next(ui + 1, nxt);
        const char* nA = has_next ? (const char*)g.A + (size_t)nxt.pm * tstepA : cA; const char* nB = has_next ? (const char*)g.Bt + (size_t)nxt.pn * tstepB : cB;
#pragma unroll 1
        for (int t = 0; t < nt; t += 2) {
            const bool last = (t == nt - 2);
            const char* a1 = cA + (size_t)(t + 1) * kstep;
            const char* a2 = last ? nA : cA + (size_t)(t + 2) * kstep; const char* b2 = last ? nB : cB + (size_t)(t + 2) * kstep;
            const char* a3 = a2 + kstep; const char* b3 = b2 + kstep;
            PG8_LDB(B0, 0, 0); PG8_LDB(B1, 0, 1); PG8_SCHED; PG8_LDA(At, 0, 0); PG8_STAGE(PG8_SA(1, 1), a1 + hstepA, voffA);
            PG8_WAIT_V(8); PG8_WAIT_L(0); PG8_BAR; PG8_MMA(0, 0, At, B0); PG8_MMA(0, 1, At, B1); PG8_BAR; PG8_SCHED;
            PG8_LDA(At, 0, 1); PG8_STAGE(PG8_SB(0, 0), b2, voffB); PG8_STAGE(PG8_SB(0, 1), b2 + hstepB, voffB); PG8_STAGE(PG8_SA(0, 0), a2, voffA);
            PG8_WAIT_V(8); PG8_WAIT_L(0); PG8_BAR; PG8_MMA(1, 0, At, B0); PG8_MMA(1, 1, At, B1); PG8_BAR; PG8_SCHED;
            PG8_LDB(B0, 1, 0); PG8_LDB(B1, 1, 1); PG8_SCHED; PG8_LDA(At, 1, 0); PG8_STAGE(PG8_SA(0, 1), a2 + hstepA, voffA);
            PG8_WAIT_V(8); PG8_WAIT_L(0); PG8_BAR; PG8_MMA(0, 0, At, B0); PG8_MMA(0, 1, At, B1); PG8_BAR; PG8_SCHED;
            PG8_LDA(At, 1, 1); PG8_STAGE(PG8_SB(1, 0), b3, voffB); PG8_STAGE(PG8_SB(1, 1), b3 + hstepB, voffB); PG8_STAGE(PG8_SA(1, 0), a3, voffA);
            PG8_WAIT_V(8); PG8_WAIT_L(0); PG8_BAR; PG8_MMA(1, 0, At, B0); PG8_MMA(1, 1, At, B1); PG8_BAR; PG8_SCHED;
        }
        if constexpr (ALIGN_EPI) { if (wr == 0) PG8_BAR; }
        E(acc, cur, wr, wc, fr, fq);
        if (!has_next) break;
#pragma unroll
        for (int a = 0; a < 2; ++a)
#pragma unroll
            for (int b = 0; b < 2; ++b)
#pragma unroll
                for (int m = 0; m < 4; ++m)
#pragma unroll
                    for (int n = 0; n < 2; ++n) acc[a][b][m][n] = (f32x4){0.f, 0.f, 0.f, 0.f};
        cur = nxt; cA = nA; cB = nB; ++ui;
        if constexpr (ALIGN_EPI) { if (wr == 1) PG8_BAR; }
    }
    PG8_WAIT_V(0);
    if constexpr (!ALIGN_EPI) { if (wr == 0) PG8_BAR; }
    PG8_BAR;
#undef PG8_SA
#undef PG8_SB
#undef PG8_STAGE
#undef PG8_LDA
#undef PG8_LDB
#undef PG8_MMA
#undef PG8_WAIT_V
#undef PG8_WAIT_L
#undef PG8_BAR
#undef PG8_SCHED
}
}

constexpr int NWAVES = 8, NTHREADS = 512;
struct Args { const void* in[23]; float* out; unsigned char* ws; int ph_lo, ph_hi; };
struct Frame {
    LAS unsigned char* lds;
    int tid, lane, wave, G, bid;
    unsigned char* ws;
    __device__ __forceinline__ float* IW() const { return (float*)(ws + WS_IW); }
    __device__ __forceinline__ float* SP() const { return (float*)(ws + WS_SP); }
    __device__ __forceinline__ f32x2* ROPE() const { return (f32x2*)(ws + WS_ROPE); }
    __device__ __forceinline__ f32x2* S5E() const { return (f32x2*)(ws + WS_S5E); }
    __device__ __forceinline__ float* RST() const { return (float*)(ws + WS_RST); }
    __device__ __forceinline__ bf16_t* Win_t() const { return (bf16_t*)(ws + WS_W + WO_IN); }
    __device__ __forceinline__ bf16_t* Wabc_t() const { return (bf16_t*)(ws + WS_W + WO_ABC); }
    __device__ __forceinline__ bf16_t* Wout_t() const { return (bf16_t*)(ws + WS_W + WO_OUT); }
    __device__ __forceinline__ bf16_t* W1_t() const { return (bf16_t*)(ws + WS_W + WO_W1); }
    __device__ __forceinline__ bf16_t* W2_t() const { return (bf16_t*)(ws + WS_W + WO_W2); }
    __device__ __forceinline__ bf16_t* Wglu_t() const { return (bf16_t*)(ws + WS_W + WO_GLU); }
    __device__ __forceinline__ bf16_t* H() const { return (bf16_t*)(ws + WS_H); }
    __device__ __forceinline__ bf16_t* ZS() const { return (bf16_t*)(ws + WS_ZS); }
    __device__ __forceinline__ bf16_t* GB() const { return (bf16_t*)(ws + WS_G); }
    __device__ __forceinline__ bf16_t* MG() const { return (bf16_t*)(ws + WS_ZS); }
    __device__ __forceinline__ bf16_t* FB() const { return (bf16_t*)(ws + WS_ZS); }
};
constexpr int SP_LB = 0, SP_L64 = 2048, SP_BBR = 4096, SP_BBI = 4096 + 16384;

__device__ __forceinline__ int ropeperm(int j, int r) { const int half = r >> 1; return (j < r) ? ((j & 1) ? half + (j >> 1) : (j >> 1)) : j; }
__device__ __forceinline__ int zmap(int n) {
    if (n < ZDQ) return n;
    if (n < ZDK) { const int q = n - ZDQ, h = q >> 6, hc = q & 63; return 256 + h * 64 + ropeperm(hc, 16); }
    if (n < ZDV) return 640 + ropeperm(n - ZDK, 16);
    if (n < ZIQ) return 704 + (n - ZDV);
    if (n < ZIK) { const int q = n - ZIQ, h = q >> 5, hc = q & 31; return 768 + h * 32 + ropeperm(hc, 8); }
    if (n < ZIWC) return 896 + ropeperm(n - ZIK, 8);
    if (n < ZRQ) return (n - ZIWC) < 4 ? 928 + (n - ZIWC) : -1;
    if (n < ZRK) { const int q = n - ZRQ, h = q / 48, hc = q % 48; return 932 + h * 48 + ropeperm(hc, 48); }
    if (n < ZRV) { const int q = n - ZRK, h = q / 48, hc = q % 48; return 1124 + h * 48 + ropeperm(hc, 48); }
    if (n < ZRG) return 1316 + (n - ZRV);
    if (n < ZGATE) return 1700 + (n - ZRG);
    if (n < ZEND) return 2084 + (n - ZGATE);
    return -1;
}

__device__ __forceinline__ void tr_item(const float* W, int N, int kb, int nb, bf16_t* WT, int ldd, int koff, bool mapped, LAS float* scr, int lane) {
    const int k0 = 64 * kb, n0 = 32 * nb;
    const int c32 = lane & 31; int sc = n0 + c32; if (mapped) sc = zmap(sc);
#pragma unroll 8
    for (int i = 0; i < 32; ++i) { const int kk = 2 * i + (lane >> 5); scr[kk * 33 + c32] = (sc >= 0) ? W[(size_t)(k0 + kk) * N + sc] : 0.f; }
    asm volatile("s_waitcnt lgkmcnt(0)" ::: "memory");
    const int c = lane & 7;
#pragma unroll
    for (int j = 0; j < 4; ++j) { const int n = (lane >> 3) + 8 * j; const LAS float* s = scr + (8 * c) * 33 + n;
        u32x4 o; o.x = pk2(s[0 * 33], s[1 * 33]); o.y = pk2(s[2 * 33], s[3 * 33]); o.z = pk2(s[4 * 33], s[5 * 33]); o.w = pk2(s[6 * 33], s[7 * 33]);
        *(u32x4*)(WT + (size_t)(n0 + n) * ldd + koff + k0 + 8 * c) = o; }
    asm volatile("s_waitcnt lgkmcnt(0)" ::: "memory");
}

__device__ __forceinline__ void rms_row_bf16(const float* xrow, const float* gain, bf16_t* orow, int lane) {
    const f32x4* xr = (const f32x4*)xrow + lane; const f32x4* gr = (const f32x4*)gain + lane;
    f32x4 v[4]; float s = 0.f;
#pragma unroll
    for (int j = 0; j < 4; ++j) { v[j] = xr[64 * j]; s += (v[j].x * v[j].x + v[j].y * v[j].y) + (v[j].z * v[j].z + v[j].w * v[j].w); }
    const float rstd = rsqrtf(wave_sum(s) * (1.f / DM) + EPS);
    u32x2* o8 = (u32x2*)orow + lane;
#pragma unroll
    for (int j = 0; j < 4; ++j) { const f32x4 gg = gr[64 * j]; u32x2 w; w.x = pk2(v[j].x * rstd * gg.x, v[j].y * rstd * gg.y); w.y = pk2(v[j].z * rstd * gg.z, v[j].w * rstd * gg.w); o8[64 * j] = w; }
}
__device__ __forceinline__ void rms_row_f32(const float* xrow, const float* gain, float* orow, int lane) {
    const f32x4* xr = (const f32x4*)xrow + lane; const f32x4* gr = (const f32x4*)gain + lane;
    f32x4 v[4]; float s = 0.f;
#pragma unroll
    for (int j = 0; j < 4; ++j) { v[j] = xr[64 * j]; s += (v[j].x * v[j].x + v[j].y * v[j].y) + (v[j].z * v[j].z + v[j].w * v[j].w); }
    const float rstd = rsqrtf(wave_sum(s) * (1.f / DM) + EPS);
    f32x4* o = (f32x4*)orow + lane;
#pragma unroll
    for (int j = 0; j < 4; ++j) { const f32x4 gg = gr[64 * j]; o[64 * j] = v[j] * rstd * gg; }
}


__device__ __forceinline__ void phase_rope(Frame& F, const int* pos) {
    const int gt = F.bid * NTHREADS + F.tid, NT = F.G * NTHREADS;
    f32x2* RT = F.ROPE();
    for (int e = gt; e < T * NFREQ; e += NT) {
        const int tok = e / NFREQ, f = e % NFREQ;
        float lth, sc; int fi;
        if (f < 8) { lth = 13.122363377404328f; sc = 2.0f / 16.0f; fi = f; } else if (f < 12) { lth = 13.122363377404328f; sc = 2.0f / 8.0f; fi = f - 8; } else { lth = 9.210340371976184f; sc = 2.0f / 48.0f; fi = f - 12; }
        const float inv = expf(-lth * (float)fi * sc);
        const float p = (float)pos[tok];
        const float ang = p * inv;
        const float kq = rintf(ang * 0.15915494309189535f);
        float r = fmaf(-kq, 6.2831854820251465f, ang);
        r = fmaf(-kq, -1.7484555e-7f, r);
        RT[e] = (f32x2){cosf(r), sinf(r)};
    }
}

struct ProIn { const float *xin, *norm1_g, *w_in, *wa, *wb, *wc, *wo, *w1, *w2, *wg, *lam_re, *lam_im, *log_step, *b_re, *b_im; const int* pos; };
__device__ __forceinline__ void phase_prologue(Frame& F, int l, const ProIn& I) {
#ifdef NO_PHASE_PROLOGUE
    return;
#endif
    LAS float* scr = (LAS float*)(F.lds + F.wave * 16384);
    const int gw = F.bid * NWAVES + F.wave, NGW = F.G * NWAVES;
    constexpr int I_IN = 16 * (NINP / 32), I_A = 4 * 32, I_B = 6 * 32, I_C = 6 * 32, I_O = 16 * 32, I_1 = 16 * 128, I_2 = 64 * 32, I_G = 4 * 8;
    constexpr int NITEMS = I_IN + I_A + I_B + I_C + I_O + I_1 + I_2 + I_G;
    const float* w_in = I.w_in + (size_t)l * DM * NIN; const float* wa = I.wa + (size_t)l * 256 * DM; const float* wb = I.wb + (size_t)l * 384 * DM;
    const float* wc = I.wc + (size_t)l * 384 * DM; const float* wo = I.wo + (size_t)l * DM * DM; const float* w1 = I.w1 + (size_t)l * DM * FF;
    const float* w2 = I.w2 + (size_t)l * FF * DM; const float* wg = I.wg + (size_t)l * 256 * 256;
    for (int it = gw; it < NITEMS; it += NGW) {
        int r = it;
        if (r < I_IN) { tr_item(w_in, NIN, r / (NINP / 32), r % (NINP / 32), F.Win_t(), DM, 0, true, scr, F.lane); continue; } r -= I_IN;
        if (r < I_A) { tr_item(wa, DM, r / 32, r % 32, F.Wabc_t(), DM, 0, false, scr, F.lane); continue; } r -= I_A;
        if (r < I_B) { tr_item(wb, DM, r / 32, r % 32, F.Wabc_t(), DM, 256, false, scr, F.lane); continue; } r -= I_B;
        if (r < I_C) { tr_item(wc, DM, r / 32, r % 32, F.Wabc_t(), DM, 640, false, scr, F.lane); continue; } r -= I_C;
        if (r < I_O) { tr_item(wo, DM, r / 32, r % 32, F.Wout_t(), DM, 0, false, scr, F.lane); continue; } r -= I_O;
        if (r < I_1) { tr_item(w1, FF, r / 128, r % 128, F.W1_t(), DM, 0, false, scr, F.lane); continue; } r -= I_1;
        if (r < I_2) { tr_item(w2, DM, r / 32, r % 32, F.W2_t(), FF, 0, false, scr, F.lane); continue; } r -= I_2;
        tr_item(wg, 256, r / 8, r % 8, F.Wglu_t(), 256, 0, false, scr, F.lane);
    }
    {
        const int gt = F.bid * NTHREADS + F.tid;
        if (gt < 1024) {
            float* SPp = F.SP();
            const int g = gt >> 6, p = gt & 63;
            const float lr = I.lam_re[(l * 16 + g) * 64 + p], li = I.lam_im[(l * 16 + g) * 64 + p];
            const float step = expf(I.log_step[l * 16 + g]);
            const float mag = expf(lr * step); const float lbr = mag * cosf(li * step), lbi = mag * sinf(li * step);
            const float den = lr * lr + li * li;
            const float fr = ((lbr - 1.f) * lr + lbi * li) / den, fi = (lbi * lr - (lbr - 1.f) * li) / den;
            SPp[SP_LB + gt * 2] = lbr; SPp[SP_LB + gt * 2 + 1] = lbi;
            float pr = lbr, pi = lbi;
#pragma unroll
            for (int s = 0; s < 6; ++s) { const float nr = pr * pr - pi * pi, ni = 2.f * pr * pi; pr = nr; pi = ni; }
            SPp[SP_L64 + gt * 2] = pr; SPp[SP_L64 + gt * 2 + 1] = pi;
            const float* br = I.b_re + ((size_t)(l * 16 + g) * 64 + p) * 16; const float* bi = I.b_im + ((size_t)(l * 16 + g) * 64 + p) * 16;
#pragma unroll
            for (int c = 0; c < 16; ++c) { SPp[SP_BBR + gt * 16 + c] = fr * br[c] - fi * bi[c]; SPp[SP_BBI + gt * 16 + c] = fr * bi[c] + fi * br[c]; }
        }
    }
    for (int m = gw; m < T; m += NGW) rms_row_bf16(I.xin + (size_t)m * DM, I.norm1_g + l * DM, F.H() + (size_t)m * DM, F.lane);
}

__device__ __forceinline__ u32x4 pack8(const f32x4& a, const f32x4& b) { u32x4 w; w.x = pk2(a.x, a.y); w.y = pk2(a.z, a.w); w.z = pk2(b.x, b.y); w.w = pk2(b.z, b.w); return w; }
__device__ __forceinline__ void unpack8(const u32x4& w, f32x4& a, f32x4& b) { a = (f32x4){bflo(w.x), bfhi(w.x), bflo(w.y), bfhi(w.y)}; b = (f32x4){bflo(w.z), bfhi(w.z), bflo(w.w), bfhi(w.w)}; }

struct FInProj {
    bf16_t* ZS; bf16_t* GB; float* IW; const f32x2* ROPE;
    __device__ __forceinline__ void rope8(f32x4& a, f32x4& b, int row, int f0) const {
        const f32x2* rt = ROPE + (size_t)row * NFREQ + f0;
        const f32x2 c0 = rt[0], c1 = rt[1], c2 = rt[2], c3 = rt[3];
        f32x4 oa, ob;
        oa.x = a.x * c0.x - a.y * c0.y; oa.y = a.y * c0.x + a.x * c0.y;
        oa.z = a.z * c1.x - a.w * c1.y; oa.w = a.w * c1.x + a.z * c1.y;
        ob.x = b.x * c2.x - b.y * c2.y; ob.y = b.y * c2.x + b.x * c2.y;
        ob.z = b.z * c3.x - b.w * c3.y; ob.w = b.w * c3.x + b.z * c3.y;
        a = oa; b = ob;
    }
    __device__ __forceinline__ void operator()(int row, int col, f32x4 a, f32x4 b) const {
        if (col >= ZEND) return;
        if (col >= ZGATE) {
            a = (f32x4){sigmoidf_(a.x), sigmoidf_(a.y), sigmoidf_(a.z), sigmoidf_(a.w)}; b = (f32x4){sigmoidf_(b.x), sigmoidf_(b.y), sigmoidf_(b.z), sigmoidf_(b.w)};
            *(u32x4*)(GB + (size_t)row * GW + (col - ZGATE)) = pack8(a, b); return;
        }
        if (col >= ZIWC && col < ZRQ) { if (col == ZIWC) *(f32x4*)(IW + (size_t)row * 4) = a; return; }
        if (col >= ZDQ && col < ZDV) { const int hc = (col - ZDQ) & 63; if (hc < 16) rope8(a, b, row, hc >> 1); }
        else if (col >= ZIQ && col < ZIWC) { const int hc = (col - ZIQ) & 31; if (hc < 8) rope8(a, b, row, 8); }
        else if (col >= ZRQ && col < ZRV) { const int hc = (col - ZRQ) % 48; rope8(a, b, row, 12 + (hc >> 1)); }
        *(u32x4*)(ZS + (size_t)row * ZSW + col) = pack8(a, b);
    }
};
struct FMerge {
    bf16_t* MG; const bf16_t* GB; int br;
    __device__ __forceinline__ void operator()(int row, int col, f32x4 a, f32x4 b) const {
        f32x4 ga, gb; unpack8(*(const u32x4*)(GB + (size_t)row * GW + br * DM + col), ga, gb);
        a = a * ga; b = b * gb;
        u32x4* mp = (u32x4*)(MG + (size_t)row * DM + col);
        if (br != 0) { f32x4 pa, pb; unpack8(*mp, pa, pb); a = a + pa; b = b + pb; }
        *mp = pack8(a, b);
    }
};
struct FResid {
    const float* base; float* out;
    __device__ __forceinline__ void operator()(int row, int col, f32x4 a, f32x4 b) const {
        const f32x4* bp = (const f32x4*)(base + (size_t)row * DM + col); f32x4* op = (f32x4*)(out + (size_t)row * DM + col);
        const f32x4 b0 = bp[0], b1 = bp[1]; op[0] = b0 + a; op[1] = b1 + b;
    }
};
struct FRelu2 {
    bf16_t* FB;
    __device__ __forceinline__ void operator()(int row, int col, f32x4 a, f32x4 b) const {
        a = (f32x4){fmaxf(a.x, 0.f), fmaxf(a.y, 0.f), fmaxf(a.z, 0.f), fmaxf(a.w, 0.f)}; b = (f32x4){fmaxf(b.x, 0.f), fmaxf(b.y, 0.f), fmaxf(b.z, 0.f), fmaxf(b.w, 0.f)};
        *(u32x4*)(FB + (size_t)row * FF + col) = pack8(a * a, b * b);
    }
};
struct FGlu {
    bf16_t* H; const float* bias;
    __device__ __forceinline__ void operator()(int row, int col, f32x4 a, f32x4 b) const {
        u32x4* hp = (u32x4*)(H + (size_t)row * DM + col); f32x4 ya, yb; unpack8(*hp, ya, yb);
        const f32x4 ba = *(const f32x4*)(bias + col), bb = *(const f32x4*)(bias + col + 4);
        a = a + ba; b = b + bb;
        a = (f32x4){ya.x * sigmoidf_(a.x), ya.y * sigmoidf_(a.y), ya.z * sigmoidf_(a.z), ya.w * sigmoidf_(a.w)};
        b = (f32x4){yb.x * sigmoidf_(b.x), yb.y * sigmoidf_(b.y), yb.z * sigmoidf_(b.z), yb.w * sigmoidf_(b.w)};
        *hp = pack8(a, b);
    }
};

__device__ __forceinline__ float gelu_tanh(float x) { const float u = 0.7978845608028654f * (x + 0.044715f * x * x * x); const float e = __expf(2.f * u); const float th = 1.f - 2.f / (e + 1.f); return 0.5f * x * (1.f + th); }

#define S5_STEP(t) do { const LAS f32x4* uu = (const LAS f32x4*)(U + (t) * 16); const f32x4 u0 = uu[0], u1 = uu[1], u2 = uu[2], u3 = uu[3]; \
    float bur = bbr[0] * u0.x, bui = bbi[0] * u0.x; \
    bur += bbr[1] * u0.y; bui += bbi[1] * u0.y; bur += bbr[2] * u0.z; bui += bbi[2] * u0.z; bur += bbr[3] * u0.w; bui += bbi[3] * u0.w; \
    bur += bbr[4] * u1.x; bui += bbi[4] * u1.x; bur += bbr[5] * u1.y; bui += bbi[5] * u1.y; bur += bbr[6] * u1.z; bui += bbi[6] * u1.z; bur += bbr[7] * u1.w; bui += bbi[7] * u1.w; \
    bur += bbr[8] * u2.x; bui += bbi[8] * u2.x; bur += bbr[9] * u2.y; bui += bbi[9] * u2.y; bur += bbr[10] * u2.z; bui += bbi[10] * u2.z; bur += bbr[11] * u2.w; bui += bbi[11] * u2.w; \
    bur += bbr[12] * u3.x; bui += bbi[12] * u3.x; bur += bbr[13] * u3.y; bui += bbi[13] * u3.y; bur += bbr[14] * u3.z; bui += bbi[14] * u3.z; bur += bbr[15] * u3.w; bui += bbi[15] * u3.w; \
    const float nr = lbr * xr - lbi * xi + bur, ni = lbr * xi + lbi * xr + bui; xr = nr; xi = ni; } while (0)

__device__ __forceinline__ void s5_stage_u32(const Frame& F, LAS float* U, int tok0, int g) {
    const int tt = F.lane & 31, sub = F.lane >> 5;
    const u32x4 w = *(const u32x4*)(F.ZS() + (size_t)(tok0 + tt) * ZSW + ZU + g * 16 + sub * 8);
    f32x4 a, b; unpack8(w, a, b);
    LAS f32x4* ud = (LAS f32x4*)(U + tt * 16 + sub * 8); ud[0] = a; ud[1] = b;
    asm volatile("s_waitcnt lgkmcnt(0)" ::: "memory");
}
__device__ __forceinline__ void phase_s5_local(Frame& F) {
    const float* SPp = F.SP(); f32x2* S5Ep = F.S5E();
#ifdef NO_PHASE_S5_LOCAL
    return;
#endif
    LAS float* U = (LAS float*)(F.lds + F.wave * 2048);
    const int gw = F.bid * NWAVES + F.wave, NGW = F.G * NWAVES, p = F.lane;
    for (int task = gw; task < 512 * 16; task += NGW) {
        const int g = task & 15, cidx = task >> 4;
        const float lbr = SPp[SP_LB + (g * 64 + p) * 2], lbi = SPp[SP_LB + (g * 64 + p) * 2 + 1];
        float bbr[16], bbi[16];
#pragma unroll
        for (int c = 0; c < 16; ++c) { bbr[c] = SPp[SP_BBR + (g * 64 + p) * 16 + c]; bbi[c] = SPp[SP_BBI + (g * 64 + p) * 16 + c]; }
        float xr = 0.f, xi = 0.f;
        for (int half = 0; half < 2; ++half) {
            s5_stage_u32(F, U, cidx * 64 + half * 32, g);
            for (int t = 0; t < 32; ++t) S5_STEP(t);
            asm volatile("s_waitcnt lgkmcnt(0)" ::: "memory");
        }
        S5Ep[(size_t)(cidx * 16 + g) * 64 + p] = (f32x2){xr, xi};
    }
}
constexpr int XSTR = 132;
constexpr int S5_WAVE_LDS = 2048 + 64 * XSTR * 2;
__device__ __forceinline__ void phase_s5_out(Frame& F, int l, const float* c_re, const float* c_im, const float* ssm_d) {
    const float* SPp = F.SP(); const f32x2* S5Ep = F.S5E();
#ifdef NO_PHASE_S5_OUT
    return;
#endif
    LAS float* U = (LAS float*)(F.lds + F.wave * S5_WAVE_LDS);
    LAS bf16_t* X = (LAS bf16_t*)(F.lds + F.wave * S5_WAVE_LDS + 2048);
    const int gw = F.bid * NWAVES + F.wave, NGW = F.G * NWAVES, p = F.lane;
    for (int task = gw; task < 512 * 16; task += NGW) {
        const int g = task & 15, cidx = task >> 4, tok0 = cidx * 64;
        {
            const float lbr = SPp[SP_LB + (g * 64 + p) * 2], lbi = SPp[SP_LB + (g * 64 + p) * 2 + 1];
            float bbr[16], bbi[16];
#pragma unroll
            for (int c = 0; c < 16; ++c) { bbr[c] = SPp[SP_BBR + (g * 64 + p) * 16 + c]; bbi[c] = SPp[SP_BBI + (g * 64 + p) * 16 + c]; }
            const f32x2 s0 = S5Ep[(size_t)(cidx * 16 + g) * 64 + p];
            float xr = s0.x, xi = s0.y;
            for (int half = 0; half < 2; ++half) {
                s5_stage_u32(F, U, tok0 + half * 32, g);
                for (int t = 0; t < 32; ++t) { S5_STEP(t); LAS bf16_t* xrow = X + (half * 32 + t) * XSTR; xrow[p] = (bf16_t)f2bf(xr); xrow[64 + p] = (bf16_t)f2bf(xi); }
                asm volatile("s_waitcnt lgkmcnt(0)" ::: "memory");
            }
        }
        const int t = F.lane;
        float acc[16];
#pragma unroll
        for (int co = 0; co < 16; ++co) acc[co] = 0.f;
        const float* cre = c_re + (size_t)(l * 16 + g) * 16 * 64; const float* cim = c_im + (size_t)(l * 16 + g) * 16 * 64;
        for (int pc = 0; pc < 16; ++pc) {
            const u32x2 wr_ = *(const LAS u32x2*)(X + t * XSTR + 4 * pc), wi_ = *(const LAS u32x2*)(X + t * XSTR + 64 + 4 * pc);
            const float r0 = bflo(wr_.x), r1 = bfhi(wr_.x), r2 = bflo(wr_.y), r3 = bfhi(wr_.y), i0 = bflo(wi_.x), i1 = bfhi(wi_.x), i2 = bflo(wi_.y), i3 = bfhi(wi_.y);
#pragma unroll
            for (int co = 0; co < 16; ++co) {
                const f32x4 cr = *(const f32x4*)(cre + co * 64 + 4 * pc), ci = *(const f32x4*)(cim + co * 64 + 4 * pc);
                acc[co] += (cr.x * r0 + cr.y * r1 + cr.z * r2 + cr.w * r3) - (ci.x * i0 + ci.y * i1 + ci.z * i2 + ci.w * i3);
            }
        }
        const u32x4* up = (const u32x4*)(F.ZS() + (size_t)(tok0 + t) * ZSW + ZU + g * 16);
        f32x4 ua, ub, uc, ud; unpack8(up[0], ua, ub); unpack8(up[1], uc, ud);
        const float uv[16] = {ua.x, ua.y, ua.z, ua.w, ub.x, ub.y, ub.z, ub.w, uc.x, uc.y, uc.z, uc.w, ud.x, ud.y, ud.z, ud.w};
        const float* dsk = ssm_d + (l * 16 + g) * 16;
        float y[16];
#pragma unroll
        for (int co = 0; co < 16; ++co) y[co] = gelu_tanh(acc[co] + dsk[co] * uv[co]);
        u32x4 o0, o1; o0.x = pk2(y[0], y[1]); o0.y = pk2(y[2], y[3]); o0.z = pk2(y[4], y[5]); o0.w = pk2(y[6], y[7]); o1.x = pk2(y[8], y[9]); o1.y = pk2(y[10], y[11]); o1.z = pk2(y[12], y[13]); o1.w = pk2(y[14], y[15]);
        u32x4* hp = (u32x4*)(F.H() + (size_t)(tok0 + t) * DM + g * 16); hp[0] = o0; hp[1] = o1;
        asm volatile("s_waitcnt lgkmcnt(0)" ::: "memory");
    }
}

__device__ __forceinline__ void phase_carry(Frame& F) {
    const float* SPp = F.SP(); f32x2* S5Ep = F.S5E(); float* RSTp = F.RST();
#ifdef NO_PHASE_CARRY
    return;
#endif
    const int gw = F.bid * NWAVES + F.wave, NGW = F.G * NWAVES;
    for (int task = gw; task < NB * 16; task += NGW) {
        const int b = task >> 4, g = task & 15, p = F.lane;
        const float ar = SPp[SP_L64 + (g * 64 + p) * 2], ai = SPp[SP_L64 + (g * 64 + p) * 2 + 1];
        float sr = 0.f, si = 0.f;
        for (int c0 = 0; c0 < 128; c0 += 16) {
            f32x2 e[16];
#pragma unroll
            for (int j = 0; j < 16; ++j) e[j] = S5Ep[(size_t)((b * 128 + c0 + j) * 16 + g) * 64 + p];
#pragma unroll
            for (int j = 0; j < 16; ++j) { S5Ep[(size_t)((b * 128 + c0 + j) * 16 + g) * 64 + p] = (f32x2){sr, si}; const float nr = ar * sr - ai * si + e[j].x, ni = ar * si + ai * sr + e[j].y; sr = nr; si = ni; }
        }
    }
    const int NT = F.G * NTHREADS;
    for (int gt = F.bid * NTHREADS + F.tid; gt < NB * 4 * 4608; gt += NT) {
        const int b = gt / (4 * 4608), h = (gt / 4608) & 3, el = gt % 4608;
        const float gam = 1.f - exp2f(-5.f - (float)h); const float lg = log1pf(-exp2f(-5.f - (float)h)); (void)gam;
        const float cdec = expf(lg * 64.f);
        float s = 0.f;
        for (int c0 = 0; c0 < 128; c0 += 16) {
            float d[16];
#pragma unroll
            for (int j = 0; j < 16; ++j) d[j] = RSTp[(size_t)((b * 128 + c0 + j) * 4 + h) * 4608 + el];
#pragma unroll
            for (int j = 0; j < 16; ++j) { RSTp[(size_t)((b * 128 + c0 + j) * 4 + h) * 4608 + el] = s; s = s * cdec + d[j]; }
        }
    }
}


typedef float f32x16 __attribute__((ext_vector_type(16)));
typedef short s16x4 __attribute__((ext_vector_type(4)));
__device__ __forceinline__ bf16x8 tr8(const LAS unsigned char* a0, const LAS unsigned char* a1) {
    const s16x4 lo = __builtin_bit_cast(s16x4, __builtin_amdgcn_ds_read_tr16_b64_v4i16((LAS s16x4*)a0));
    const s16x4 hi = __builtin_bit_cast(s16x4, __builtin_amdgcn_ds_read_tr16_b64_v4i16((LAS s16x4*)a1));
    return (bf16x8){lo[0], lo[1], lo[2], lo[3], hi[0], hi[1], hi[2], hi[3]};
}
__device__ __forceinline__ bf16x8 pack8f(const f32x4& a, const f32x4& b) { return __builtin_bit_cast(bf16x8, pack8(a, b)); }
__device__ __forceinline__ void ret_stage_v(const bf16_t* ZSp, LAS unsigned char* Vb, int tok0, int h, int lane) {
#pragma unroll
    for (int n = 0; n < 12; ++n) { const int o = n * 1024 + 16 * lane, r = o / 192, ch = (o % 192) >> 4;
        __builtin_amdgcn_global_load_lds((const unsigned*)(ZSp + (size_t)(tok0 + r) * ZSW + ZRV + h * 96 + ch * 8), (LAS unsigned*)(Vb + n * 1024), 16, 0, 0); }
}
constexpr int RET_VB = 12288, RET_KSTR = 112, RET_WAVE_LDS = RET_VB + 64 * RET_KSTR;
__device__ __forceinline__ void phase_ret_local(Frame& F) {
#ifdef NO_PHASE_RET_LOCAL
    return;
#endif
    const bf16_t* ZSp = F.ZS(); float* RSTp = F.RST();
    LAS unsigned char* Vb = F.lds + F.wave * RET_WAVE_LDS; LAS unsigned char* Kb = Vb + RET_VB;
    for (int item = F.bid * NWAVES + F.wave; item < 2048; item += F.G * NWAVES) {
        int lane = F.lane; asm volatile("" : "+v"(lane));
        const int l31 = lane & 31, hh = lane >> 5, g1 = (lane >> 4) & 1, q4 = (lane & 15) >> 2, p4 = lane & 3;
        const int h = item & 3, tok0 = (item >> 2) * 64;
        ret_stage_v(ZSp, Vb, tok0, h, lane);
        const float lg2 = log2f(1.f - exp2f(-5.f - (float)h));
#pragma unroll
        for (int n = 0; n < 6; ++n) { const int idx = n * 64 + lane, r = idx / 6, ch = idx % 6;
            f32x4 a, b; unpack8(*(const u32x4*)(ZSp + (size_t)(tok0 + r) * ZSW + ZRK + h * 48 + ch * 8), a, b);
            const float sc = 0.14433756729740643f * exp2f(lg2 * (float)(63 - r));
            *(LAS u32x4*)(Kb + r * RET_KSTR + ch * 16) = pack8(a * sc, b * sc); }
        asm volatile("s_waitcnt vmcnt(0) lgkmcnt(0)" ::: "memory");
        f32x16 acc[3][2];
#pragma unroll
        for (int me = 0; me < 3; ++me)
#pragma unroll
            for (int nt = 0; nt < 2; ++nt) acc[me][nt] = (f32x16){0.f, 0.f, 0.f, 0.f, 0.f, 0.f, 0.f, 0.f, 0.f, 0.f, 0.f, 0.f, 0.f, 0.f, 0.f, 0.f};
#pragma unroll
        for (int s = 0; s < 4; ++s) {
            const int r0 = 16 * s + 8 * hh + q4;
            bf16x8 kf[2], vf[3];
#pragma unroll
            for (int nt = 0; nt < 2; ++nt) { const LAS unsigned char* a0 = Kb + r0 * RET_KSTR + (32 * nt + 16 * g1 + 4 * p4) * 2; kf[nt] = tr8(a0, a0 + 4 * RET_KSTR); }
#pragma unroll
            for (int me = 0; me < 3; ++me) { const LAS unsigned char* a0 = Vb + r0 * 192 + (32 * me + 16 * g1 + 4 * p4) * 2; vf[me] = tr8(a0, a0 + 4 * 192); }
#pragma unroll
            for (int me = 0; me < 3; ++me)
#pragma unroll
                for (int nt = 0; nt < 2; ++nt) acc[me][nt] = __builtin_amdgcn_mfma_f32_32x32x16_bf16(vf[me], kf[nt], acc[me][nt], 0, 0, 0);
        }
        float* dst = RSTp + (size_t)item * 4608 + (4 * hh) * 48 + l31;
#pragma unroll
        for (int me = 0; me < 3; ++me)
#pragma unroll
            for (int r4 = 0; r4 < 4; ++r4) {
                float* dp = dst + (32 * me + 8 * r4) * 48; asm volatile("" : "+v"(dp));
#pragma unroll
                for (int k = 0; k < 4; ++k) { dp[k * 48] = acc[me][0][4 * r4 + k]; if (l31 < 16) dp[k * 48 + 32] = acc[me][1][4 * r4 + k]; }
            }
        asm volatile("s_waitcnt lgkmcnt(0)" ::: "memory");
    }
}
__device__ __forceinline__ void phase_ret_out(Frame& F, int l, const float* ret_norm_g) {
#ifdef NO_PHASE_RET_OUT
    return;
#endif
    const bf16_t* ZSp = F.ZS(); const float* RSTp = F.RST();
    LAS unsigned char* Vb = F.lds + F.wave * RET_WAVE_LDS;
    for (int item = F.bid * NWAVES + F.wave; item < 2048; item += F.G * NWAVES) {
        int lane = F.lane; asm volatile("" : "+v"(lane));
        const int l31 = lane & 31, hh = lane >> 5, g1 = (lane >> 4) & 1, q4 = (lane & 15) >> 2, p4 = lane & 3;
        const int h = item & 3, tok0 = (item >> 2) * 64;
        ret_stage_v(ZSp, Vb, tok0, h, lane);
        const float lg2 = log2f(1.f - exp2f(-5.f - (float)h));
        bf16x8 qf[2][3], kf[2][3];
#pragma unroll
        for (int t = 0; t < 2; ++t)
#pragma unroll
            for (int ks = 0; ks < 3; ++ks) { const size_t ro = (size_t)(tok0 + 32 * t + l31) * ZSW + h * 48 + 8 * hh + 16 * ks;
                qf[t][ks] = *(const bf16x8*)(ZSp + ro + ZRQ); kf[t][ks] = *(const bf16x8*)(ZSp + ro + ZRK); }
        bf16x8 pm[2][4];
#pragma unroll
        for (int mt = 0; mt < 2; ++mt)
#pragma unroll
            for (int nt = mt; nt < 2; ++nt) {
                f32x16 p = {0.f, 0.f, 0.f, 0.f, 0.f, 0.f, 0.f, 0.f, 0.f, 0.f, 0.f, 0.f, 0.f, 0.f, 0.f, 0.f};
#pragma unroll
                for (int ks = 0; ks < 3; ++ks) p = __builtin_amdgcn_mfma_f32_32x32x16_bf16(kf[mt][ks], qf[nt][ks], p, 0, 0, 0);
                const int i = 32 * nt + l31;
#pragma unroll
                for (int r = 0; r < 16; ++r) { const int j = 32 * mt + (r & 3) + 8 * (r >> 2) + 4 * hh;
                    p[r] = (i >= j) ? p[r] * (0.14433756729740643f * exp2f(lg2 * (float)(i - j))) : 0.f; }
                pm[nt][2 * mt + 0] = pack8f((f32x4){p[0], p[1], p[2], p[3]}, (f32x4){p[4], p[5], p[6], p[7]});
                pm[nt][2 * mt + 1] = pack8f((f32x4){p[8], p[9], p[10], p[11]}, (f32x4){p[12], p[13], p[14], p[15]});
            }
        f32x16 ot[3][2];
#pragma unroll
        for (int me = 0; me < 3; ++me) {
            bf16x8 sf[3];
            const float* sp0 = RSTp + (size_t)item * 4608 + (32 * me + l31) * 48 + 8 * hh; asm volatile("" : "+v"(sp0));
#pragma unroll
            for (int ks = 0; ks < 3; ++ks) { const float* sp = sp0 + 16 * ks; sf[ks] = pack8f(*(const f32x4*)sp, *(const f32x4*)(sp + 4)); }
#pragma unroll
            for (int nt = 0; nt < 2; ++nt) {
                f32x16 a = {0.f, 0.f, 0.f, 0.f, 0.f, 0.f, 0.f, 0.f, 0.f, 0.f, 0.f, 0.f, 0.f, 0.f, 0.f, 0.f};
#pragma unroll
                for (int ks = 0; ks < 3; ++ks) a = __builtin_amdgcn_mfma_f32_32x32x16_bf16(sf[ks], qf[nt][ks], a, 0, 0, 0);
                const float qd = exp2f(lg2 * (float)(32 * nt + l31 + 1));
                ot[me][nt] = a * qd;
            }
        }
        asm volatile("s_waitcnt vmcnt(0)" ::: "memory");
#pragma unroll
        for (int s = 0; s < 4; ++s) {
            const int r0 = 16 * s + 4 * hh + q4;
#pragma unroll
            for (int me = 0; me < 3; ++me) {
                const LAS unsigned char* a0 = Vb + r0 * 192 + (32 * me + 16 * g1 + 4 * p4) * 2;
                const bf16x8 vf = tr8(a0, a0 + 8 * 192);
                if (s < 2) ot[me][0] = __builtin_amdgcn_mfma_f32_32x32x16_bf16(vf, pm[0][s], ot[me][0], 0, 0, 0);
                ot[me][1] = __builtin_amdgcn_mfma_f32_32x32x16_bf16(vf, pm[1][s], ot[me][1], 0, 0, 0);
            }
        }
#pragma unroll
        for (int nt = 0; nt < 2; ++nt) {
            float sum = 0.f;
#pragma unroll
            for (int me = 0; me < 3; ++me)
#pragma unroll
                for (int r = 0; r < 16; ++r) sum += ot[me][nt][r];
            sum += __shfl_xor(sum, 32);
            const float mu = sum * (1.f / 96.f); float q2 = 0.f;
#pragma unroll
            for (int me = 0; me < 3; ++me)
#pragma unroll
                for (int r = 0; r < 16; ++r) { const float d = ot[me][nt][r] - mu; q2 += d * d; }
            q2 += __shfl_xor(q2, 32);
            const float rs = rsqrtf(q2 * (1.f / 96.f) + EPS);
            const int tok = tok0 + 32 * nt + l31;
            const bf16_t* gbase = ZSp + (size_t)tok * ZSW + ZRG + h * 96 + 4 * hh; const float* nbase = ret_norm_g + l * 384 + h * 96 + 4 * hh; bf16_t* obase = F.H() + (size_t)tok * DM + 640 + h * 96 + 4 * hh;
#pragma unroll
            for (int me = 0; me < 3; ++me) {
                const bf16_t* gp = gbase + 32 * me; const float* np = nbase + 32 * me; bf16_t* op = obase + 32 * me;
                asm volatile("" : "+v"(gp), "+v"(np), "+v"(op));
#pragma unroll
                for (int r4 = 0; r4 < 4; ++r4) {
                    const u32x2 gw = *(const u32x2*)(gp + 8 * r4);
                    const f32x4 ng = *(const f32x4*)(np + 8 * r4);
                    const float g0 = bflo(gw.x), g1f = bfhi(gw.x), g2 = bflo(gw.y), g3 = bfhi(gw.y);
                    const float y0 = (ot[me][nt][4 * r4 + 0] - mu) * rs * ng.x * (g0 * sigmoidf_(g0)), y1 = (ot[me][nt][4 * r4 + 1] - mu) * rs * ng.y * (g1f * sigmoidf_(g1f));
                    const float y2 = (ot[me][nt][4 * r4 + 2] - mu) * rs * ng.z * (g2 * sigmoidf_(g2)), y3 = (ot[me][nt][4 * r4 + 3] - mu) * rs * ng.w * (g3 * sigmoidf_(g3));
                    *(u32x2*)(op + 8 * r4) = (u32x2){pk2(y0, y1), pk2(y2, y3)};
                }
            }
        }
        asm volatile("s_waitcnt lgkmcnt(0)" ::: "memory");
    }
}

typedef _Float16 f16_t;
__device__ __forceinline__ int lanes_below(unsigned long long m) { return (int)__builtin_amdgcn_mbcnt_hi((unsigned)(m >> 32), __builtin_amdgcn_mbcnt_lo((unsigned)m, 0u)); }
__device__ __forceinline__ unsigned sortable_f16(float sc) {
    if (sc == 0.0f) sc = 0.0f;
    const f16_t h = (f16_t)sc; const unsigned u = (unsigned)__builtin_bit_cast(unsigned short, h);
    return (u & 0x8000u) ? (~u & 0xffffu) : (u | 0x8000u);
}
__device__ __forceinline__ int sc_pos(int k) { return (k & ~511) + ((k & 63) << 3) + ((k >> 6) & 7); }
__device__ __forceinline__ int wave_suffix_sum(int v, int lane) {
#pragma unroll
    for (int o = 1; o < 64; o <<= 1) { const int t = __shfl_down(v, o); if (lane + o < 64) v += t; }
    return v;
}
__device__ __forceinline__ void hist_threshold(const u32x4 c, int need, int lane, int& B, int& above) {
    const int s = (int)(c.x + c.y + c.z + c.w);
    const int S = wave_suffix_sum(s, lane);
    int a = S - s;
    const bool found = (a < need) && (S >= need);
    int Bl = 0, al = 0;
    if (found) {
        if (a + (int)c.w >= need) { Bl = 4 * lane + 3; al = a; }
        else { a += (int)c.w; if (a + (int)c.z >= need) { Bl = 4 * lane + 2; al = a; }
        else { a += (int)c.z; if (a + (int)c.y >= need) { Bl = 4 * lane + 1; al = a; }
        else { a += (int)c.y; Bl = 4 * lane; al = a; } } }
    }
    const unsigned long long m = __ballot(found);
    const int src = m ? (int)__builtin_ctzll(m) : 0;
    B = __shfl(Bl, src); above = __shfl(al, src);
}

#ifndef DSA_DUP
#define DSA_DUP 0
#endif
constexpr int DSA_ROW = 16384;
__device__ __forceinline__ void phase_dsa(Frame& F) {
#ifdef NO_PHASE_DSA
    return;
#endif
    const int lane = F.lane, wave = F.wave;
    const bf16_t* ZSp = F.ZS(); const float* IWp = F.IW();
    LAS unsigned char* SCb = F.lds;
    LAS unsigned* H1 = (LAS unsigned*)(F.lds + 131072) + wave * 512;
    LAS unsigned* H2 = H1 + 256;
    LAS unsigned short* LSTw = (LAS unsigned short*)(F.lds + 131072 + 16384) + wave * 256;
    const int hi = lane >> 5, n32 = lane & 31;
    for (int it = F.bid; it < 512; it += F.G) {
        const int pr = it & 255, vcu = (pr & 7) * 32 + (pr >> 3);
        const int b = vcu >> 6, cc = vcu & 63, c = (it < 256) ? cc : 127 - cc;
        const int V = (c + 1) * 64, tokq0 = b * SEQ + c * 64, kb0 = b * SEQ;
        const int Keff = V < 256 ? V : 256;
        const int nblk = (V + 511) >> 9, ntile_all = nblk * 16, ntile_real = V >> 5;
        for (int qg = 0; qg < 8; ++qg) {
            const int tq0 = tokq0 + qg * 8;
            for (int repA = 0; repA < 1 + (DSA_DUP & 1); ++repA) {
                bf16x8 aq[2];
                { const int qq = n32 >> 2, hd = n32 & 3; const bf16_t* qp = ZSp + (size_t)(tq0 + qq) * ZSW + ZIQ + hd * 32 + 8 * hi;
                  aq[0] = *(const bf16x8*)qp; aq[1] = *(const bf16x8*)(qp + 16); }
                float wq[4][4];
#pragma unroll
                for (int jq = 0; jq < 4; ++jq) { const f32x4 w4 = *(const f32x4*)(IWp + (size_t)(tq0 + 2 * jq + hi) * 4);
                    wq[jq][0] = w4.x * 0.08838834764831845f; wq[jq][1] = w4.y * 0.08838834764831845f; wq[jq][2] = w4.z * 0.08838834764831845f; wq[jq][3] = w4.w * 0.08838834764831845f; }
                for (int tt0 = wave; tt0 < ntile_all; tt0 += 16) {
                    bf16x8 bfr[2][2]; bool real[2];
#pragma unroll
                    for (int u = 0; u < 2; ++u) { const int tt = tt0 + 8 * u; real[u] = tt < ntile_real;
                        if (real[u]) { const bf16_t* kp = ZSp + (size_t)(kb0 + tt * 32 + n32) * ZSW + ZIK + 8 * hi; bfr[u][0] = *(const bf16x8*)kp; bfr[u][1] = *(const bf16x8*)(kp + 16); } }
#pragma unroll
                    for (int u = 0; u < 2; ++u) {
                        const int tt = tt0 + 8 * u;
                        if (tt < ntile_all) {
                            unsigned short us[4] = {0, 0, 0, 0};
                            if (real[u]) {
                                f32x16 acc = {0.f, 0.f, 0.f, 0.f, 0.f, 0.f, 0.f, 0.f, 0.f, 0.f, 0.f, 0.f, 0.f, 0.f, 0.f, 0.f};
                                acc = __builtin_amdgcn_mfma_f32_32x32x16_bf16(aq[0], bfr[u][0], acc, 0, 0, 0);
                                acc = __builtin_amdgcn_mfma_f32_32x32x16_bf16(aq[1], bfr[u][1], acc, 0, 0, 0);
#pragma unroll
                                for (int jq = 0; jq < 4; ++jq) {
                                    const float sc = fmaxf(acc[4 * jq + 0], 0.f) * wq[jq][0] + fmaxf(acc[4 * jq + 1], 0.f) * wq[jq][1] + fmaxf(acc[4 * jq + 2], 0.f) * wq[jq][2] + fmaxf(acc[4 * jq + 3], 0.f) * wq[jq][3];
                                    us[jq] = (unsigned short)sortable_f16(sc);
                                }
                            }
                            const int pos = sc_pos(tt * 32 + n32);
#pragma unroll
                            for (int jq = 0; jq < 4; ++jq) *(LAS unsigned short*)(SCb + (2 * jq + hi) * DSA_ROW + pos * 2) = us[jq];
                        }
                    }
                }
            }
            __syncthreads();
            LAS unsigned char* row = SCb + wave * DSA_ROW;
            for (int repB = 0; repB < 1 + ((DSA_DUP >> 1) & 1); ++repB)
            if (V > 256) {
                *(LAS u32x4*)(H1 + 4 * lane) = (u32x4){0u, 0u, 0u, 0u}; *(LAS u32x4*)(H2 + 4 * lane) = (u32x4){0u, 0u, 0u, 0u};
                asm volatile("s_waitcnt lgkmcnt(0)" ::: "memory");
                for (int i = 0; i < nblk; ++i) {
                    const u32x4 w = *(const LAS u32x4*)(row + (512 * i + 8 * lane) * 2);
                    __hip_atomic_fetch_add(H1 + ((w.x >> 8) & 255u), 1u, __ATOMIC_RELAXED, __HIP_MEMORY_SCOPE_WORKGROUP); __hip_atomic_fetch_add(H1 + (w.x >> 24), 1u, __ATOMIC_RELAXED, __HIP_MEMORY_SCOPE_WORKGROUP);
                    __hip_atomic_fetch_add(H1 + ((w.y >> 8) & 255u), 1u, __ATOMIC_RELAXED, __HIP_MEMORY_SCOPE_WORKGROUP); __hip_atomic_fetch_add(H1 + (w.y >> 24), 1u, __ATOMIC_RELAXED, __HIP_MEMORY_SCOPE_WORKGROUP);
                    __hip_atomic_fetch_add(H1 + ((w.z >> 8) & 255u), 1u, __ATOMIC_RELAXED, __HIP_MEMORY_SCOPE_WORKGROUP); __hip_atomic_fetch_add(H1 + (w.z >> 24), 1u, __ATOMIC_RELAXED, __HIP_MEMORY_SCOPE_WORKGROUP);
                    __hip_atomic_fetch_add(H1 + ((w.w >> 8) & 255u), 1u, __ATOMIC_RELAXED, __HIP_MEMORY_SCOPE_WORKGROUP); __hip_atomic_fetch_add(H1 + (w.w >> 24), 1u, __ATOMIC_RELAXED, __HIP_MEMORY_SCOPE_WORKGROUP);
                }
                asm volatile("s_waitcnt lgkmcnt(0)" ::: "memory");
                int B1, above1; hist_threshold(*(const LAS u32x4*)(H1 + 4 * lane), 256, lane, B1, above1);
                for (int i = 0; i < nblk; ++i) {
                    const u32x4 w = *(const LAS u32x4*)(row + (512 * i + 8 * lane) * 2);
                    const unsigned ww[4] = {w.x, w.y, w.z, w.w};
#pragma unroll
                    for (int e2 = 0; e2 < 4; ++e2) {
                        if ((int)((ww[e2] >> 8) & 255u) == B1) __hip_atomic_fetch_add(H2 + (ww[e2] & 255u), 1u, __ATOMIC_RELAXED, __HIP_MEMORY_SCOPE_WORKGROUP);
                        if ((int)(ww[e2] >> 24) == B1) __hip_atomic_fetch_add(H2 + ((ww[e2] >> 16) & 255u), 1u, __ATOMIC_RELAXED, __HIP_MEMORY_SCOPE_WORKGROUP);
                    }
                }
                asm volatile("s_waitcnt lgkmcnt(0)" ::: "memory");
                int B2, above2; hist_threshold(*(const LAS u32x4*)(H2 + 4 * lane), 256 - above1, lane, B2, above2);
                const unsigned tau = ((unsigned)B1 << 8) | (unsigned)B2;
                const int r = 256 - above1 - above2;
                int eq_base = 0, sel_base = 0;
                for (int i = 0; i < nblk; ++i) {
                    const u32x4 w = *(const LAS u32x4*)(row + (512 * i + 8 * lane) * 2);
                    const unsigned ww[4] = {w.x, w.y, w.z, w.w};
#pragma unroll
                    for (int e = 0; e < 8; ++e) {
                        const unsigned u = (e & 1) ? (ww[e >> 1] >> 16) : (ww[e >> 1] & 0xffffu);
                        const bool gt = u > tau, eq = (u == tau);
                        const unsigned long long meq = __ballot(eq);
                        const bool sel = gt || (eq && (eq_base + lanes_below(meq) < r));
                        const unsigned long long msel = __ballot(sel);
                        if (sel) LSTw[sel_base + lanes_below(msel)] = (unsigned short)(512 * i + 64 * e + lane);
                        eq_base += __popcll(meq); sel_base += __popcll(msel);
                    }
                }
            } else {
#pragma unroll
                for (int jj = 0; jj < 4; ++jj) LSTw[lane + 64 * jj] = (unsigned short)(lane + 64 * jj);
            }
            asm volatile("s_waitcnt lgkmcnt(0)" ::: "memory");
            for (int repC = 0; repC < 1 + ((DSA_DUP >> 2) & 1); ++repC) {
                const int tq = tq0 + wave, n16 = lane & 15, kg = lane >> 4;
                bf16x8 qf[2];
                if (n16 < 6) { const bf16_t* qp = ZSp + (size_t)tq * ZSW + ZDQ + n16 * 64 + 8 * kg; qf[0] = *(const bf16x8*)qp; qf[1] = *(const bf16x8*)(qp + 32); }
                else { qf[0] = (bf16x8){0, 0, 0, 0, 0, 0, 0, 0}; qf[1] = qf[0]; }
                const int ntile = Keff >> 4;
                LAS unsigned char* vst = row;
#define DSA_VDMA(ch, buf) do { _Pragma("unroll") for (int i8 = 0; i8 < 8; ++i8) { const int rr = (lane >> 3) + 8 * i8; const int kidx = LSTw[(ch) * 64 + rr]; \
        const int sch = (lane & 7) ^ (2 * ((rr >> 1) & 3)); \
        __builtin_amdgcn_global_load_lds((const unsigned*)(ZSp + (size_t)(kb0 + kidx) * ZSW + ZDV + sch * 8), (LAS unsigned*)(vst + (buf) * 8192 + i8 * 1024), 16, 0, 0); } } while (0)
                DSA_VDMA(0, 0);
                if (ntile > 4) DSA_VDMA(1, 1);
                f32x4 sa[16];
#pragma unroll
                for (int tb = 0; tb < 2; ++tb) {
                    if (tb * 8 < ntile) {
                        bf16x8 kf[8][2];
#pragma unroll
                        for (int t8 = 0; t8 < 8; ++t8) { if (tb * 8 + t8 < ntile) { const int kidx = LSTw[(tb * 8 + t8) * 16 + n16]; const bf16_t* kp = ZSp + (size_t)(kb0 + kidx) * ZSW + ZDK + 8 * kg;
                            kf[t8][0] = *(const bf16x8*)kp; kf[t8][1] = *(const bf16x8*)(kp + 32); } }
#pragma unroll
                        for (int t8 = 0; t8 < 8; ++t8) {
                            if (tb * 8 + t8 < ntile) { f32x4 a = {0.f, 0.f, 0.f, 0.f};
                                a = __builtin_amdgcn_mfma_f32_16x16x32_bf16(kf[t8][0], qf[0], a, 0, 0, 0); a = __builtin_amdgcn_mfma_f32_16x16x32_bf16(kf[t8][1], qf[1], a, 0, 0, 0); sa[tb * 8 + t8] = a; }
                            else sa[tb * 8 + t8] = (f32x4){-1e30f, -1e30f, -1e30f, -1e30f};
                        }
                    } else {
#pragma unroll
                        for (int t8 = 0; t8 < 8; ++t8) sa[tb * 8 + t8] = (f32x4){-1e30f, -1e30f, -1e30f, -1e30f};
                    }
                }
                float m = -1e30f;
#pragma unroll
                for (int t = 0; t < 16; ++t) m = fmaxf(m, fmaxf(fmaxf(sa[t].x, sa[t].y), fmaxf(sa[t].z, sa[t].w)));
                m = fmaxf(m, __shfl_xor(m, 16)); m = fmaxf(m, __shfl_xor(m, 32));
                const float sc2 = 0.125f * 1.4426950408889634f; float lsum = 0.f;
#pragma unroll
                for (int t = 0; t < 16; ++t) { sa[t].x = exp2f((sa[t].x - m) * sc2); sa[t].y = exp2f((sa[t].y - m) * sc2); sa[t].z = exp2f((sa[t].z - m) * sc2); sa[t].w = exp2f((sa[t].w - m) * sc2);
                    lsum += (sa[t].x + sa[t].y) + (sa[t].z + sa[t].w); }
                lsum += __shfl_xor(lsum, 16); lsum += __shfl_xor(lsum, 32);
                const float linv = 1.f / lsum;
                f32x4 oacc[4] = {{0.f, 0.f, 0.f, 0.f}, {0.f, 0.f, 0.f, 0.f}, {0.f, 0.f, 0.f, 0.f}, {0.f, 0.f, 0.f, 0.f}};
                const int q4 = n16 >> 2, p4 = n16 & 3;
#pragma unroll
                for (int ch = 0; ch < 4; ++ch) {
                    if (ch * 4 < ntile) {
                        if ((ch + 1) * 4 < ntile) asm volatile("s_waitcnt vmcnt(8)" ::: "memory");
                        else asm volatile("s_waitcnt vmcnt(0)" ::: "memory");
#pragma unroll
                        for (int sl = 0; sl < 2; ++sl) {
                            const int s = ch * 2 + sl;
                            u32x4 pw; pw.x = pk2(sa[2 * s].x, sa[2 * s].y); pw.y = pk2(sa[2 * s].z, sa[2 * s].w); pw.z = pk2(sa[2 * s + 1].x, sa[2 * s + 1].y); pw.w = pk2(sa[2 * s + 1].z, sa[2 * s + 1].w);
                            const bf16x8 pb = __builtin_bit_cast(bf16x8, pw);
#pragma unroll
                            for (int mt = 0; mt < 4; ++mt) {
                                const int P0 = 32 * sl + 4 * kg + q4, P1 = P0 + 16;
                                const LAS unsigned char* a0 = vst + (ch & 1) * 8192 + P0 * 128 + (((2 * mt + (p4 >> 1)) ^ (2 * ((P0 >> 1) & 3))) * 16) + 8 * (p4 & 1);
                                const LAS unsigned char* a1 = vst + (ch & 1) * 8192 + P1 * 128 + (((2 * mt + (p4 >> 1)) ^ (2 * ((P1 >> 1) & 3))) * 16) + 8 * (p4 & 1);
                                const s16x4 lo = __builtin_bit_cast(s16x4, __builtin_amdgcn_ds_read_tr16_b64_v4i16((LAS s16x4*)a0));
                                const s16x4 hi4 = __builtin_bit_cast(s16x4, __builtin_amdgcn_ds_read_tr16_b64_v4i16((LAS s16x4*)a1));
                                const bf16x8 va = (bf16x8){lo[0], lo[1], lo[2], lo[3], hi4[0], hi4[1], hi4[2], hi4[3]};
                                oacc[mt] = __builtin_amdgcn_mfma_f32_16x16x32_bf16(va, pb, oacc[mt], 0, 0, 0);
                            }
                        }
                        asm volatile("s_waitcnt lgkmcnt(0)" ::: "memory");
                        if (ch + 2 < 4 && (ch + 2) * 4 < ntile) DSA_VDMA(ch + 2, ch & 1);
                    }
                }
#undef DSA_VDMA
                if (n16 < 6) {
                    bf16_t* op = F.H() + (size_t)tq * DM + 256 + n16 * 64 + 4 * kg;
#pragma unroll
                    for (int mt = 0; mt < 4; ++mt) { u32x2 o; o.x = pk2(oacc[mt].x * linv, oacc[mt].y * linv); o.y = pk2(oacc[mt].z * linv, oacc[mt].w * linv); *(u32x2*)(op + 16 * mt) = o; }
                }
            }
            __syncthreads();
        }
    }
}

__global__ void __launch_bounds__(NTHREADS, 2) mk_fwd(Args args) {
    extern __shared__ __attribute__((aligned(16))) unsigned char lds_raw[];
    Frame F;
    F.lds = (LAS unsigned char*)lds_raw;
    F.tid = threadIdx.x; F.lane = F.tid & 63; F.wave = __builtin_amdgcn_readfirstlane(F.tid >> 6);
    F.G = gridDim.x; F.bid = blockIdx.x; F.ws = args.ws;
    unsigned char* ws = args.ws;
#define INF(k) ((const float*)args.in[k])

    volatile LAS unsigned* MISC = (volatile LAS unsigned*)(F.lds + MISC_OFF);
    if (F.tid < 64) MISC[F.tid] = 0u;
    __syncthreads();
    XcdBarrier bar = xcd_barrier_post((unsigned*)(ws + WS_CTL) + CW_BAR, MISC + 8);
    cg::grid_group grid = cg::this_grid();
    int ph = 0; const int lo = args.ph_lo, hi = args.ph_hi;
    unsigned long long* TSp = (unsigned long long*)(ws + WS_CTL + 32768); int nst = 0; (void)TSp; (void)nst;
    bool first_seam = true;
#ifndef DUP_MASK
#define DUP_MASK 0
#endif
#ifdef PROBE_LO
#define STAMP() do { if (F.bid == 0 && F.tid == 0) { TSp[nst] = __builtin_amdgcn_s_memrealtime(); } ++nst; } while (0)
#else
#define STAMP() do { } while (0)
#endif
#ifdef NO_CG
#define GRIDSYNC() xcd_barrier(bar)
#else
#define GRIDSYNC() grid.sync()
#endif
#define RUN(...) do { if (ph >= lo && ph < hi) { asm volatile("" : "+v"(F.tid), "+v"(F.lane), "+s"(F.ws), "+s"(F.bid), "+s"(F.G), "+s"(F.wave)); __VA_ARGS__; } ++ph; } while (0)
#define SEAM() do { if (ph > lo && ph < hi) { if (first_seam) { GRIDSYNC(); first_seam = false; } else xcd_barrier(bar); } STAMP(); } while (0)

    STAMP();
    RUN(phase_rope(F, (const int*)args.in[1])); STAMP();
    for (int l = 0; l < DEPTH; ++l) {
        const float* xin = (l == 0) ? INF(0) : args.out;
        RUN({ const ProIn I{xin, INF(2), INF(3), INF(15), INF(16), INF(17), INF(18), INF(20), INF(21), INF(12), INF(4), INF(5), INF(6), INF(7), INF(8), (const int*)args.in[1]};
              phase_prologue(F, l, I); }); SEAM();
#ifndef NO_G1
        RUN({ pg8::Gemm g{F.H(), F.Win_t()}; pg8::StaticOrder<T, NINP> S; S.init(F.G, F.bid);
              pg8::EpiGen<FInProj> E{FInProj{F.ZS(), F.GB(), F.IW(), F.ROPE()}}; for (int rep = 0; rep < 1 + (DUP_MASK & 1); ++rep) pg8::gemm_phase<T, NINP, DM, DM, DM>(F.lds, g, S, E); }); SEAM();
#else
        RUN({}); SEAM();
#endif
        RUN({ for (int rep = 0; rep < 1 + ((DUP_MASK >> 2) & 1); ++rep) { phase_s5_local(F); __syncthreads(); } STAMP();
              for (int rep = 0; rep < 1 + ((DUP_MASK >> 3) & 1); ++rep) { phase_ret_local(F); __syncthreads(); } STAMP();
              for (int rep = 0; rep < 1 + ((DUP_MASK >> 1) & 1); ++rep) { phase_dsa(F); __syncthreads(); } }); SEAM();
        RUN(phase_carry(F)); SEAM();
        RUN({ for (int rep = 0; rep < 1 + ((DUP_MASK >> 2) & 1); ++rep) { phase_s5_out(F, l, INF(9), INF(10), INF(11)); __syncthreads(); } STAMP();
              for (int rep = 0; rep < 1 + ((DUP_MASK >> 3) & 1); ++rep) { phase_ret_out(F, l, INF(14)); __syncthreads(); } }); SEAM();
#ifndef NO_G2
        RUN({ pg8::Gemm g{F.H(), F.Wglu_t()}; pg8::StaticOrder<T, 256> S; S.init(F.G, F.bid);
              pg8::EpiGen<FGlu, 2> E{FGlu{F.H(), INF(13) + l * 256}}; pg8::gemm_phase<T, 256, 256, DM, 256>(F.lds, g, S, E); }); SEAM();
#else
        RUN({}); SEAM();
#endif
#ifndef NO_G3
        RUN({ pg8::StaticOrder<T, DM> S; S.init(F.G, F.bid);
              { pg8::Gemm g{F.H(), F.Wabc_t()}; pg8::EpiGen<FMerge, 2> E{FMerge{F.MG(), F.GB(), 0}}; pg8::gemm_phase<T, DM, 256, DM, DM>(F.lds, g, S, E); }
              { pg8::Gemm g{F.H() + 256, F.Wabc_t() + 256}; pg8::EpiGen<FMerge, 2> E{FMerge{F.MG(), F.GB(), 1}}; pg8::gemm_phase<T, DM, 384, DM, DM>(F.lds, g, S, E); }
              { pg8::Gemm g{F.H() + 640, F.Wabc_t() + 640}; pg8::EpiGen<FMerge, 2> E{FMerge{F.MG(), F.GB(), 2}}; pg8::gemm_phase<T, DM, 384, DM, DM>(F.lds, g, S, E); } }); SEAM();
#else
        RUN({}); SEAM();
#endif
#ifndef NO_G4
        RUN({ pg8::Gemm g{F.MG(), F.Wout_t()}; pg8::StaticOrder<T, DM> S; S.init(F.G, F.bid);
              pg8::EpiGen<FResid> E{FResid{xin, args.out}}; pg8::gemm_phase<T, DM, DM, DM, DM>(F.lds, g, S, E); }); SEAM();
#else
        RUN({}); SEAM();
#endif
        RUN({ const int gw = F.bid * NWAVES + F.wave, NGW = F.G * NWAVES; const float* g2 = INF(19) + l * DM;
              for (int m = gw; m < T; m += NGW) rms_row_bf16(args.out + (size_t)m * DM, g2, F.H() + (size_t)m * DM, F.lane); }); SEAM();
#ifndef NO_G5
        RUN({ pg8::Gemm g{F.H(), F.W1_t()}; pg8::StaticOrder<T, FF> S; S.init(F.G, F.bid);
              pg8::EpiGen<FRelu2> E{FRelu2{F.FB()}}; for (int rep = 0; rep < 1 + (DUP_MASK & 1); ++rep) pg8::gemm_phase<T, FF, DM, DM, DM>(F.lds, g, S, E); }); SEAM();
#else
        RUN({}); SEAM();
#endif
#ifndef NO_G6
        RUN({ pg8::Gemm g{F.FB(), F.W2_t()}; pg8::StaticOrder<T, DM> S; S.init(F.G, F.bid);
              pg8::EpiGen<FResid> E{FResid{args.out, args.out}}; pg8::gemm_phase<T, DM, FF, FF, FF>(F.lds, g, S, E); }); SEAM();
#else
        RUN({}); SEAM();
#endif
    }
    RUN({ const int gw = F.bid * NWAVES + F.wave, NGW = F.G * NWAVES; const float* gf = INF(22);
          for (int m = gw; m < T; m += NGW) rms_row_f32(args.out + (size_t)m * DM, gf, args.out + (size_t)m * DM, F.lane); });
    STAMP();
#ifdef PROBE_LO
    if (F.bid == 0 && F.tid == 0) {
        const int sel[] = PROBE_SEL; unsigned long long tot = 0;
        for (unsigned i = 0; i < sizeof(sel) / sizeof(int); ++i) tot += TSp[sel[i] + 1] - TSp[sel[i]];
        const float us = (float)tot * 0.01f;
        asm volatile("s_waitcnt vmcnt(0)" ::: "memory");
        args.out[0] = sqrtf(us * (float)((size_t)T * DM));
    }
#endif
#undef RUN
#undef SEAM
}

extern "C" void kernel_launch(void* const* d_in, const int* in_sizes, int n_in, void* d_out, int out_size, void* d_ws, size_t ws_size, hipStream_t stream) {
    static int grid = 0;
    if (grid == 0) {
        if (n_in != 23 || out_size != T * DM || ws_size < WS_END) { fprintf(stderr, "kernel_launch: unexpected shapes (n_in %d out %d ws %zu)\n", n_in, out_size, ws_size); grid = -1; return; }
        int dev = 0, cus = 0, per_cu = 0;
        hipGetDevice(&dev); hipDeviceGetAttribute(&cus, hipDeviceAttributeMultiprocessorCount, dev);
        if (hipFuncSetAttribute((const void*)mk_fwd, hipFuncAttributeMaxDynamicSharedMemorySize, LDS_BYTES) != hipSuccess) { fprintf(stderr, "kernel_launch: hipFuncSetAttribute failed\n"); grid = -1; return; }
        if (hipOccupancyMaxActiveBlocksPerMultiprocessor(&per_cu, (const void*)mk_fwd, NTHREADS, LDS_BYTES) != hipSuccess || per_cu < 1) { fprintf(stderr, "kernel_launch: occupancy query says %d\n", per_cu); per_cu = 1; }
        (void)hipGetLastError();
        grid = cus;
    }
    if (grid < 0) return;
    hipMemsetAsync((char*)d_ws + WS_CTL, 0, CTL_ZERO_BYTES, stream);
    Args a{};
    for (int i = 0; i < 23; ++i) a.in[i] = d_in[i];
    a.out = (float*)d_out; a.ws = (unsigned char*)d_ws;
#ifndef MK_SPLIT
    a.ph_lo = 0; a.ph_hi = 1000;
    void* kargs[] = {&a};
    hipError_t e = hipLaunchCooperativeKernel((const void*)mk_fwd, dim3(grid), dim3(NTHREADS), kargs, LDS_BYTES, stream);
    if (e != hipSuccess) fprintf(stderr, "kernel_launch: cooperative launch failed: %s\n", hipGetErrorString(e));
#else
    for (int p = 0; p < 2 * 11 + 2; ++p) { a.ph_lo = p; a.ph_hi = p + 1; hipLaunchKernelGGL(mk_fwd, dim3(grid), dim3(NTHREADS), LDS_BYTES, stream, a); }
#endif
}
```

```cpp
#include <hip/hip_runtime.h>
#include <hip/hip_cooperative_groups.h>
#include <cstdio>
#include <cstdint>
namespace cg = cooperative_groups;

#define LAS __attribute__((address_space(3)))
#define GAS __attribute__((address_space(1)))
typedef unsigned short bf16_t;
typedef short bf16x8 __attribute__((ext_vector_type(8)));
typedef float f32x4 __attribute__((ext_vector_type(4)));
typedef float f32x2 __attribute__((ext_vector_type(2)));
typedef unsigned u32x4 __attribute__((ext_vector_type(4)));
typedef unsigned u32x2 __attribute__((ext_vector_type(2)));

constexpr int NB = 4, SEQ = 8192, T = NB * SEQ, DM = 1024, DEPTH = 2, FF = 4096;
constexpr int NIN = 5156, NINP = 5376;
constexpr int ZSW = 2112, GW = 3072;
constexpr int ZU = 0, ZDQ = 256, ZDK = 640, ZDV = 704, ZIQ = 768, ZIK = 896, ZIWC = 928, ZRQ = 960, ZRK = 1152, ZRV = 1344, ZRG = 1728, ZGATE = 2112, ZEND = 5184;
constexpr int NFREQ = 36;
constexpr float EPS = 1e-6f;

constexpr size_t MiB = 1u << 20;
constexpr size_t WS_CTL = 0, CTL_ZERO_BYTES = 64 * 1024;
constexpr size_t WS_IW = 1 * MiB;
constexpr size_t WS_SP = 1 * MiB + 512 * 1024;
constexpr size_t WS_ROPE = 2 * MiB;
constexpr size_t WS_S5E = 11 * MiB;
constexpr size_t WS_RST = 15 * MiB;
constexpr size_t WS_W = 51 * MiB;
constexpr size_t WO_IN = 0, WO_ABC = WO_IN + (size_t)NINP * DM * 2, WO_OUT = WO_ABC + (size_t)DM * DM * 2, WO_W1 = WO_OUT + (size_t)DM * DM * 2,
                 WO_W2 = WO_W1 + (size_t)FF * DM * 2, WO_GLU = WO_W2 + (size_t)FF * DM * 2, WO_END = WO_GLU + 256 * 256 * 2;
static_assert(WO_END <= 31 * MiB, "weights");
constexpr size_t WS_H = 82 * MiB;
constexpr size_t WS_ZS = 146 * MiB;
constexpr size_t WS_G = 278 * MiB;
constexpr size_t WS_IKD = 470 * MiB;
constexpr size_t WS_END = 472 * MiB;
static_assert(WS_ZS + (size_t)T * ZSW * 2 <= WS_G && WS_G + (size_t)T * GW * 2 <= WS_END && WS_ZS + (size_t)T * FF * 2 <= WS_END, "ws map");
constexpr int CW_BAR = 1024;

constexpr int LDS_BYTES = 160 * 1024;
constexpr int RING_BYTES = 131072;
constexpr int MISC_OFF = LDS_BYTES - 256;

__device__ __forceinline__ unsigned f2bf(float f) { unsigned u = __builtin_bit_cast(unsigned, f); return (u + 0x7fffu + ((u >> 16) & 1u)) >> 16; }
__device__ __forceinline__ unsigned pk2(float lo, float hi) { unsigned r; asm("v_cvt_pk_bf16_f32 %0, %1, %2" : "=v"(r) : "v"(lo), "v"(hi)); return r; }
__device__ __forceinline__ float bf2f(unsigned short v) { return __builtin_bit_cast(float, (unsigned)v << 16); }
__device__ __forceinline__ float bflo(unsigned w) { return __builtin_bit_cast(float, w << 16); }
__device__ __forceinline__ float bfhi(unsigned w) { return __builtin_bit_cast(float, w & 0xffff0000u); }
__device__ __forceinline__ float sigmoidf_(float x) { return 1.0f / (1.0f + __expf(-x)); }
__device__ __forceinline__ float wave_sum(float v) {
#pragma unroll
    for (int o = 1; o < 64; o <<= 1) v += __shfl_xor(v, o);
    return v;
}
__device__ __forceinline__ float wave_max(float v) {
#pragma unroll
    for (int o = 1; o < 64; o <<= 1) v = fmaxf(v, __shfl_xor(v, o));
    return v;
}

#define XB_TMO      128
#define XB_XCNT(j)  (256  + 64 * (j))
#define XB_XSUB(j)  (1280 + 64 * (j))
#define XB_XGEN(j)  (2304 + 64 * (j))
#define XB_TOP      3328
#define XB_TOPGEN   3392
#define XCD_BAR_WORDS 3456
#define XB_SPIN_CAP (1u << 18)
__device__ __forceinline__ unsigned xb_ld(unsigned* p)              { return __hip_atomic_load(p, __ATOMIC_RELAXED, __HIP_MEMORY_SCOPE_AGENT); }
__device__ __forceinline__ unsigned xb_add(unsigned* p, unsigned v) { return __hip_atomic_fetch_add(p, v, __ATOMIC_RELAXED, __HIP_MEMORY_SCOPE_AGENT); }
__device__ __forceinline__ unsigned xb_xcc_id() { return (unsigned)__builtin_amdgcn_s_getreg((3 << 11) | 20) & 0xFu; }
#define XB_SPIN(cond, bar) do { unsigned _sp = 0; while (cond) { __builtin_amdgcn_s_sleep(1); \
    if ((++_sp & 255u) == 0u) { if (xb_ld(&(bar)[XB_TMO])) break; if (_sp > XB_SPIN_CAP) { atomicAdd(&(bar)[XB_TMO], 1u); break; } } } } while (0)
struct XcdBarrier { unsigned* bar; unsigned x; volatile LAS unsigned* st; };
__device__ __forceinline__ XcdBarrier xcd_barrier_post(unsigned* bar, volatile LAS unsigned* st) {
    XcdBarrier b; b.bar = bar; b.x = xb_xcc_id(); b.st = st;
    if (threadIdx.x == 0) (void)xb_add(&bar[XB_XCNT(b.x)], 1u);
    return b;
}
__device__ __forceinline__ void xcd_barrier_complete(unsigned* bar, unsigned x, unsigned& nloc, unsigned& nx) {
    const unsigned G = gridDim.x * gridDim.y * gridDim.z;
    unsigned sum, cnt, mine, sp = 0u;
    for (;;) {
        sum = 0u; cnt = 0u; mine = 0u;
#pragma unroll
        for (unsigned j = 0; j < 16; ++j) { const unsigned c = xb_ld(&bar[XB_XCNT(j)]); sum += c; cnt += (c > 0u) ? 1u : 0u; mine = (j == x) ? c : mine; }
        if (sum == G) break;
        __builtin_amdgcn_s_sleep(1);
        if ((++sp & 255u) == 0u) { if (xb_ld(&bar[XB_TMO])) break; if (sp > XB_SPIN_CAP) { atomicAdd(&bar[XB_TMO], 1u); break; } }
    }
    nloc = mine > 0u ? mine : 1u; nx = cnt > 0u ? cnt : 1u;
}
__device__ __forceinline__ void xcd_barrier(const XcdBarrier& b, bool leader) {
    asm volatile("s_waitcnt vmcnt(0)" ::: "memory");
    __syncthreads();
    if (leader) {
        unsigned* bar = b.bar; unsigned bx = b.x;
        asm volatile("" : "+s"(bar), "+s"(bx));
        __builtin_amdgcn_s_waitcnt(0);
        unsigned nloc = b.st[0], nx = b.st[1];
        if (nloc == 0u) { xcd_barrier_complete(bar, bx, nloc, nx); b.st[0] = nloc; b.st[1] = nx; }
        const unsigned old = xb_add(&bar[XB_XSUB(bx)], 1u);
        const unsigned gen = old / nloc;
        if (old + 1u == (gen + 1u) * nloc) {
            __builtin_amdgcn_fence(__ATOMIC_RELEASE, "agent");
            asm volatile("s_waitcnt vmcnt(0)" ::: "memory");
            const unsigned og = xb_add(&bar[XB_TOP], 1u);
            const unsigned tg = og / nx;
            if (og + 1u == (tg + 1u) * nx) xb_add(&bar[XB_TOPGEN], 1u);
            else XB_SPIN(xb_ld(&bar[XB_TOPGEN]) == tg, bar);
            __builtin_amdgcn_fence(__ATOMIC_ACQUIRE, "agent");
            xb_add(&bar[XB_XGEN(bx)], 1u);
            asm volatile("s_waitcnt vmcnt(0)" ::: "memory");
        } else {
            XB_SPIN(xb_ld(&bar[XB_XGEN(bx)]) == gen, bar);
            __builtin_amdgcn_fence(__ATOMIC_ACQUIRE, "agent");
            asm volatile("s_waitcnt vmcnt(0)" ::: "memory");
        }
    }
    __syncthreads();
}

namespace pg8 {
constexpr int BM = 256, BK = 64, HALF = 128, HTB = HALF * BK * 2, STAGE_BYTES = 8 * HTB, NXCD = 8, WGM = 8;
__host__ __device__ __forceinline__ int lds_byte(int r, int c) { const int st = (r >> 4) * 2 + (c >> 5), rr = r & 15, cc = c & 31, ob = rr * 64 + cc * 2; return st * 1024 + (ob ^ (((ob >> 9) & 1) << 5)); }
__host__ __device__ __forceinline__ void stage_rc(int b, int& R, int& C) { const int st = b / 1024, sb = b % 1024, swz = sb ^ (((sb >> 9) & 1) << 5); R = (st >> 1) * 16 + swz / 64; C = (st & 1) * 32 + (swz % 64) / 2; }
__host__ __device__ __forceinline__ int perm32(int rho) { const int n = rho >> 4, i = rho & 15; return 8 * (i >> 2) + 4 * n + (i & 3); }

struct Unit { int pm, pn; };
struct Gemm { const bf16_t* A; const bf16_t* Bt; };

template <int M, int N> struct StaticOrder {
    static constexpr int nM = M / BM, nN = N / BM, nwg = nM * nN;
    int G, c;
    __host__ __device__ void init(int G_, int c_) { G = G_; c = c_; }
    __host__ __device__ bool next(int i, Unit& u) const {
        const long L = (long)i * G + c; if (L >= nwg) return false;
        int wgid = (int)L; { constexpr int q = nwg / NXCD, r = nwg % NXCD; const int xcd = wgid % NXCD, off = wgid / NXCD; wgid = (xcd < r ? xcd * (q + 1) : r * (q + 1) + (xcd - r) * q) + off; }
        constexpr int nig = WGM * nN; const int gid = wgid / nig, fm = gid * WGM, gsz = (nM - fm) < WGM ? (nM - fm) : WGM;
        u.pm = fm + ((wgid % nig) % gsz); u.pn = (wgid % nig) / gsz; return true;
    }
};

template <class F, int FENCE = 0> struct EpiGen {
    static constexpr bool PERM = true, HAS_MID = false;
    F f;
    __device__ __forceinline__ void operator()(const f32x4 (&acc)[2][2][4][2], const Unit& u, int wr, int wc, int fr, int fq) const {
        const int row0 = u.pm * BM + wr * 64 + fr, col0 = u.pn * BM + wc * 32 + 8 * fq;
#pragma unroll
        for (int ai = 0; ai < 2; ++ai)
#pragma unroll
            for (int m = 0; m < 4; ++m)
#pragma unroll
                for (int bj = 0; bj < 2; ++bj) { f(row0 + ai * HALF + m * 16, col0 + bj * HALF, acc[ai][bj][m][0], acc[ai][bj][m][1]);
                    if constexpr (FENCE > 0) { if (((ai * 4 + m) * 2 + bj) % FENCE == FENCE - 1) asm volatile("" ::: "memory"); } }
    }
};

template <int M, int N, int K, int LDA, int LDB, class Epi, bool ALIGN_EPI = true>
__device__ __forceinline__ void gemm_phase(LAS unsigned char* lds, const Gemm g, const StaticOrder<M, N>& S, const Epi& E, int tid_in) {
    int tid = tid_in; asm volatile("" : "+v"(tid));
    const int wid = __builtin_amdgcn_readfirstlane(tid >> 6), lane = tid & 63, wr = wid >> 2, wc = wid & 3, fr = lane & 15, fq = lane >> 4;
    constexpr int nt = K / BK;
    unsigned voffA[2], voffB[2];
#pragma unroll
    for (int i = 0; i < 2; ++i) { int R, C; stage_rc(tid * 16 + i * 8192, R, C); const int Rb = Epi::PERM ? ((R & ~31) + perm32(R & 31)) : R;
        voffA[i] = (unsigned)(R * LDA + C) * 2u; voffB[i] = (unsigned)(Rb * LDB + C) * 2u; }
    constexpr size_t kstep = (size_t)(BK * 2);
    constexpr size_t hstepA = (size_t)HALF * LDA * 2, hstepB = (size_t)HALF * LDB * 2;
    constexpr size_t tstepA = 2 * hstepA, tstepB = 2 * hstepB;
    const unsigned ldsw = (unsigned)wid * 1024u;
    const int aoff = lds_byte(wr * 64 + fr, fq * 8), boff = lds_byte(wc * 32 + fr, fq * 8);
#define PG8_SA(b, h) (((b) * 2 + (h)) * HTB)
#define PG8_SB(b, h) ((4 + (b) * 2 + (h)) * HTB)
#define PG8_STAGE(bufoff, gbase, voff) do { _Pragma("unroll") for (int _i = 0; _i < 2; ++_i) \
        __builtin_amdgcn_global_load_lds((const unsigned*)((const char*)(gbase) + (voff)[_i]), (LAS unsigned*)(lds + (bufoff) + ldsw + _i * 8192), 16, 0, 0); } while (0)
#define PG8_LDA(dst, b, h) do { _Pragma("unroll") for (int m = 0; m < 4; ++m) _Pragma("unroll") for (int k = 0; k < 2; ++k) dst[m][k] = *(const LAS bf16x8*)(lds + PG8_SA(b, h) + aoff + m * 2048 + k * 1024); } while (0)
#define PG8_LDB(dst, b, h) do { _Pragma("unroll") for (int n = 0; n < 2; ++n) _Pragma("unroll") for (int k = 0; k < 2; ++k) dst[n][k] = *(const LAS bf16x8*)(lds + PG8_SB(b, h) + boff + n * 2048 + k * 1024); } while (0)
#define PG8_MMA(ai, bj, At, Bt) do { __builtin_amdgcn_s_setprio(1); _Pragma("unroll") for (int m = 0; m < 4; ++m) _Pragma("unroll") for (int n = 0; n < 2; ++n) _Pragma("unroll") for (int k = 0; k < 2; ++k) \
        acc[ai][bj][m][n] = __builtin_amdgcn_mfma_f32_16x16x32_bf16(Bt[n][k], At[m][k], acc[ai][bj][m][n], 0, 0, 0); __builtin_amdgcn_s_setprio(0); } while (0)
#define PG8_WAIT_V(n) asm volatile("s_waitcnt vmcnt(" #n ")" ::: "memory")
#define PG8_WAIT_L(n) asm volatile("s_waitcnt lgkmcnt(" #n ")" ::: "memory")
#define PG8_BAR __builtin_amdgcn_s_barrier()
#define PG8_SCHED __builtin_amdgcn_sched_barrier(0)
    Unit cur, nxt; int ui = 0;
    if (!S.next(0, cur)) return;
    f32x4 acc[2][2][4][2];
#pragma unroll
    for (int a = 0; a < 2; ++a)
#pragma unroll
        for (int b = 0; b < 2; ++b)
#pragma unroll
            for (int m = 0; m < 4; ++m)
#pragma unroll
                for (int n = 0; n < 2; ++n) acc[a][b][m][n] = (f32x4){0.f, 0.f, 0.f, 0.f};
    bf16x8 At[4][2], B0[2][2], B1[2][2];
    const char* cA = (const char*)g.A + (size_t)cur.pm * tstepA; const char* cB = (const char*)g.Bt + (size_t)cur.pn * tstepB;
    PG8_STAGE(PG8_SB(0, 0), cB, voffB); PG8_STAGE(PG8_SB(0, 1), cB + hstepB, voffB); PG8_STAGE(PG8_SA(0, 0), cA, voffA); PG8_STAGE(PG8_SA(0, 1), cA + hstepA, voffA);
    if (wr == 1) PG8_BAR;
    PG8_WAIT_V(2); PG8_BAR;
    PG8_STAGE(PG8_SB(1, 0), cB + kstep, voffB); PG8_STAGE(PG8_SA(1, 0), cA + kstep, voffA); PG8_STAGE(PG8_SB(1, 1), cB + hstepB + kstep, voffB);
    PG8_WAIT_V(6); PG8_BAR;
    for (;;) {
        const bool has_next = S.next(ui + 1, nxt);
        const char* nA = has_next ? (const char*)g.A + (size_t)nxt.pm * tstepA : cA; const char* nB = has_next ? (const char*)g.Bt + (size_t)nxt.pn * tstepB : cB;
#pragma unroll 1
        for (int t = 0; t < nt; t += 2) {
            const bool last = (t == nt - 2);
            const char* a1 = cA + (size_t)(t + 1) * kstep;
            const char* a2 = last ? nA : cA + (size_t)(t + 2) * kstep; const char* b2 = last ? nB : cB + (size_t)(t + 2) * kstep;
            const char* a3 = a2 + kstep; const char* b3 = b2 + kstep;
            if constexpr (Epi::HAS_MID) { if (t == Epi::MID0 || t == Epi::MID1) E.mid(acc, cur, t, wr, wc, fr, fq); }
            PG8_LDB(B0, 0, 0); PG8_LDB(B1, 0, 1); PG8_SCHED; PG8_LDA(At, 0, 0); PG8_STAGE(PG8_SA(1, 1), a1 + hstepA, voffA);
            PG8_WAIT_V(8); PG8_WAIT_L(0); PG8_BAR; PG8_MMA(0, 0, At, B0); PG8_MMA(0, 1, At, B1); PG8_BAR; PG8_SCHED;
            PG8_LDA(At, 0, 1); PG8_STAGE(PG8_SB(0, 0), b2, voffB); PG8_STAGE(PG8_SB(0, 1), b2 + hstepB, voffB); PG8_STAGE(PG8_SA(0, 0), a2, voffA);
            PG8_WAIT_V(8); PG8_WAIT_L(0); PG8_BAR; PG8_MMA(1, 0, At, B0); PG8_MMA(1, 1, At, B1); PG8_BAR; PG8_SCHED;
            PG8_LDB(B0, 1, 0); PG8_LDB(B1, 1, 1); PG8_SCHED; PG8_LDA(At, 1, 0); PG8_STAGE(PG8_SA(0, 1), a2 + hstepA, voffA);
            PG8_WAIT_V(8); PG8_WAIT_L(0); PG8_BAR; PG8_MMA(0, 0, At, B0); PG8_MMA(0, 1, At, B1); PG8_BAR; PG8_SCHED;
            PG8_LDA(At, 1, 1); PG8_STAGE(PG8_SB(1, 0), b3, voffB); PG8_STAGE(PG8_SB(1, 1), b3 + hstepB, voffB); PG8_STAGE(PG8_SA(1, 0), a3, voffA);
            PG8_WAIT_V(8); PG8_WAIT_L(0); PG8_BAR; PG8_MMA(1, 0, At, B0); PG8_MMA(1, 1, At, B1); PG8_BAR; PG8_SCHED;
        }
        if constexpr (ALIGN_EPI) { if (wr == 0) PG8_BAR; }
        E(acc, cur, wr, wc, fr, fq);
        if (!has_next) break;
#pragma unroll
        for (int a = 0; a < 2; ++a)
#pragma unroll
            for (int b = 0; b < 2; ++b)
#pragma unroll
                for (int m = 0; m < 4; ++m)
#pragma unroll
                    for (int n = 0; n < 2; ++n) acc[a][b][m][n] = (f32x4){0.f, 0.f, 0.f, 0.f};
        cur = nxt; cA = nA; cB = nB; ++ui;
        if constexpr (ALIGN_EPI) { if (wr == 1) PG8_BAR; }
    }
    PG8_WAIT_V(0);
    if constexpr (!ALIGN_EPI) { if (wr == 0) PG8_BAR; }
    PG8_BAR;
#undef PG8_SA
#undef PG8_SB
#undef PG8_STAGE
#undef PG8_LDA
#undef PG8_LDB
#undef PG8_MMA
#undef PG8_WAIT_V
#undef PG8_WAIT_L
#undef PG8_BAR
#undef PG8_SCHED
}
}

constexpr int NWAVES = 8, NTHREADS = 512;
struct Args { const void* in[23]; float* out; unsigned char* ws; int ph_lo, ph_hi; };
struct Frame {
    LAS unsigned char* lds;
    int tid, lane, wave, G, bid;
    unsigned char* wsb; unsigned zo;
    __device__ __forceinline__ bf16_t* IKD() const { return (bf16_t*)(wsb + zo + WS_IKD); }
    __device__ __forceinline__ float* IW() const { return (float*)(wsb + zo + WS_IW); }
    __device__ __forceinline__ float* SP() const { return (float*)(wsb + zo + WS_SP); }
    __device__ __forceinline__ f32x2* ROPE() const { return (f32x2*)(wsb + zo + WS_ROPE); }
    __device__ __forceinline__ f32x2* S5E() const { return (f32x2*)(wsb + zo + WS_S5E); }
    __device__ __forceinline__ float* RST() const { return (float*)(wsb + zo + WS_RST); }
    __device__ __forceinline__ bf16_t* Win_t() const { return (bf16_t*)(wsb + zo + WS_W + WO_IN); }
    __device__ __forceinline__ bf16_t* Wabc_t() const { return (bf16_t*)(wsb + zo + WS_W + WO_ABC); }
    __device__ __forceinline__ bf16_t* Wout_t() const { return (bf16_t*)(wsb + zo + WS_W + WO_OUT); }
    __device__ __forceinline__ bf16_t* W1_t() const { return (bf16_t*)(wsb + zo + WS_W + WO_W1); }
    __device__ __forceinline__ bf16_t* W2_t() const { return (bf16_t*)(wsb + zo + WS_W + WO_W2); }
    __device__ __forceinline__ bf16_t* Wglu_t() const { return (bf16_t*)(wsb + zo + WS_W + WO_GLU); }
    __device__ __forceinline__ bf16_t* H() const { return (bf16_t*)(wsb + zo + WS_H); }
    __device__ __forceinline__ bf16_t* ZS() const { return (bf16_t*)(wsb + zo + WS_ZS); }
    __device__ __forceinline__ unsigned char* GB() const { return wsb + zo + WS_G; }
    __device__ __forceinline__ bf16_t* MG() const { return (bf16_t*)(wsb + zo + WS_ZS); }
    __device__ __forceinline__ bf16_t* FB() const { return (bf16_t*)(wsb + zo + WS_ZS); }
};
constexpr int SP_LB = 0, SP_L64 = 2048, SP_BBR = 4096, SP_BBI = 4096 + 16384;

__device__ __forceinline__ int ropeperm(int j, int r) { const int half = r >> 1; return (j < r) ? ((j & 1) ? half + (j >> 1) : (j >> 1)) : j; }
__device__ __forceinline__ int zmap(int n) {
    if (n < ZDQ) return n;
    if (n < ZDK) { const int q = n - ZDQ, h = q >> 6, hc = q & 63; return 256 + h * 64 + ropeperm(hc, 16); }
    if (n < ZDV) return 640 + ropeperm(n - ZDK, 16);
    if (n < ZIQ) return 704 + (n - ZDV);
    if (n < ZIK) { const int q = n - ZIQ, h = q >> 5, hc = q & 31; return 768 + h * 32 + ropeperm(hc, 8); }
    if (n < ZIWC) return 896 + ropeperm(n - ZIK, 8);
    if (n < ZRQ) return (n - ZIWC) < 4 ? 928 + (n - ZIWC) : -1;
    if (n < ZRK) { const int q = n - ZRQ, h = q / 48, hc = q % 48; return 932 + h * 48 + ropeperm(hc, 48); }
    if (n < ZRV) { const int q = n - ZRK, h = q / 48, hc = q % 48; return 1124 + h * 48 + ropeperm(hc, 48); }
    if (n < ZRG) return 1316 + (n - ZRV);
    if (n < ZGATE) return 1700 + (n - ZRG);
    if (n < ZEND) return 2084 + (n - ZGATE);
    return -1;
}

__device__ __forceinline__ void tr_item(const float* W, int N, int kb, int nb, bf16_t* WT, int ldd, int koff, bool mapped, LAS float* scr, int lane) {
    const int k0 = 64 * kb, n0 = 32 * nb;
    const int c32 = lane & 31; int sc = n0 + c32; if (mapped) sc = zmap(sc);
#pragma unroll 8
    for (int i = 0; i < 32; ++i) { const int kk = 2 * i + (lane >> 5); scr[kk * 33 + c32] = (sc >= 0) ? W[(size_t)(k0 + kk) * N + sc] : 0.f; }
    asm volatile("s_waitcnt lgkmcnt(0)" ::: "memory");
    const int c = lane & 7;
#pragma unroll
    for (int j = 0; j < 4; ++j) { const int n = (lane >> 3) + 8 * j; const LAS float* s = scr + (8 * c) * 33 + n;
        u32x4 o; o.x = pk2(s[0 * 33], s[1 * 33]); o.y = pk2(s[2 * 33], s[3 * 33]); o.z = pk2(s[4 * 33], s[5 * 33]); o.w = pk2(s[6 * 33], s[7 * 33]);
        *(u32x4*)(WT + (size_t)(n0 + n) * ldd + koff + k0 + 8 * c) = o; }
    asm volatile("s_waitcnt lgkmcnt(0)" ::: "memory");
}

__device__ __forceinline__ void rms_row_bf16(const float* xrow, const float* gain, bf16_t* orow, int lane) {
    const f32x4* xr = (const f32x4*)xrow + lane; const f32x4* gr = (const f32x4*)gain + lane;
    f32x4 v[4]; float s = 0.f;
#pragma unroll
    for (int j = 0; j < 4; ++j) { v[j] = xr[64 * j]; s += (v[j].x * v[j].x + v[j].y * v[j].y) + (v[j].z * v[j].z + v[j].w * v[j].w); }
    const float rstd = rsqrtf(wave_sum(s) * (1.f / DM) + EPS);
    u32x2* o8 = (u32x2*)orow + lane;
#pragma unroll
    for (int j = 0; j < 4; ++j) { const f32x4 gg = gr[64 * j]; u32x2 w; w.x = pk2(v[j].x * rstd * gg.x, v[j].y * rstd * gg.y); w.y = pk2(v[j].z * rstd * gg.z, v[j].w * rstd * gg.w); o8[64 * j] = w; }
}
__device__ __forceinline__ void rms_row_f32(const float* xrow, const float* gain, float* orow, int lane) {
    const f32x4* xr = (const f32x4*)xrow + lane; const f32x4* gr = (const f32x4*)gain + lane;
    f32x4 v[4]; float s = 0.f;
#pragma unroll
    for (int j = 0; j < 4; ++j) { v[j] = xr[64 * j]; s += (v[j].x * v[j].x + v[j].y * v[j].y) + (v[j].z * v[j].z + v[j].w * v[j].w); }
    const float rstd = rsqrtf(wave_sum(s) * (1.f / DM) + EPS);
    f32x4* o = (f32x4*)orow + lane;
#pragma unroll
    for (int j = 0; j < 4; ++j) { const f32x4 gg = gr[64 * j]; o[64 * j] = v[j] * rstd * gg; }
}


__device__ __forceinline__ void phase_rope(Frame& F, const int* pos) {
    const int gt = F.bid * NTHREADS + F.tid, NT = F.G * NTHREADS;
    f32x2* RT = F.ROPE();
    for (int e = gt; e < T * NFREQ; e += NT) {
        const int tok = e / NFREQ, f = e % NFREQ;
        float lth, sc; int fi;
        if (f < 8) { lth = 13.122363377404328f; sc = 2.0f / 16.0f; fi = f; } else if (f < 12) { lth = 13.122363377404328f; sc = 2.0f / 8.0f; fi = f - 8; } else { lth = 9.210340371976184f; sc = 2.0f / 48.0f; fi = f - 12; }
        const float inv = expf(-lth * (float)fi * sc);
        const float p = (float)pos[tok];
        const float ang = p * inv;
        const float kq = rintf(ang * 0.15915494309189535f);
        float r = fmaf(-kq, 6.2831854820251465f, ang);
        r = fmaf(-kq, -1.7484555e-7f, r);
        RT[e] = (f32x2){cosf(r), sinf(r)};
    }
}

struct ProIn { const float *xin, *norm1_g, *w_in, *wa, *wb, *wc, *wo, *w1, *w2, *wg, *lam_re, *lam_im, *log_step, *b_re, *b_im; const int* pos; };
__device__ __forceinline__ void phase_prologue(Frame& F, int l, const ProIn& I) {
#ifdef NO_PHASE_PROLOGUE
    return;
#endif
    LAS float* scr = (LAS float*)(F.lds + F.wave * 16384);
    const int gw = F.bid * NWAVES + F.wave, NGW = F.G * NWAVES;
    constexpr int I_IN = 16 * (NINP / 32), I_A = 4 * 32, I_B = 6 * 32, I_C = 6 * 32, I_O = 16 * 32, I_1 = 16 * 128, I_2 = 64 * 32, I_G = 4 * 8;
    constexpr int NITEMS = I_IN + I_A + I_B + I_C + I_O + I_1 + I_2 + I_G;
    const float* w_in = I.w_in + (size_t)l * DM * NIN; const float* wa = I.wa + (size_t)l * 256 * DM; const float* wb = I.wb + (size_t)l * 384 * DM;
    const float* wc = I.wc + (size_t)l * 384 * DM; const float* wo = I.wo + (size_t)l * DM * DM; const float* w1 = I.w1 + (size_t)l * DM * FF;
    const float* w2 = I.w2 + (size_t)l * FF * DM; const float* wg = I.wg + (size_t)l * 256 * 256;
    for (int it = gw; it < NITEMS; it += NGW) {
        int r = it;
        if (r < I_IN) { tr_item(w_in, NIN, r / (NINP / 32), r % (NINP / 32), F.Win_t(), DM, 0, true, scr, F.lane); continue; } r -= I_IN;
        if (r < I_A) { tr_item(wa, DM, r / 32, r % 32, F.Wabc_t(), DM, 0, false, scr, F.lane); continue; } r -= I_A;
        if (r < I_B) { tr_item(wb, DM, r / 32, r % 32, F.Wabc_t(), DM, 256, false, scr, F.lane); continue; } r -= I_B;
        if (r < I_C) { tr_item(wc, DM, r / 32, r % 32, F.Wabc_t(), DM, 640, false, scr, F.lane); continue; } r -= I_C;
        if (r < I_O) { tr_item(wo, DM, r / 32, r % 32, F.Wout_t(), DM, 0, false, scr, F.lane); continue; } r -= I_O;
        if (r < I_1) { tr_item(w1, FF, r / 128, r % 128, F.W1_t(), DM, 0, false, scr, F.lane); continue; } r -= I_1;
        if (r < I_2) { tr_item(w2, DM, r / 32, r % 32, F.W2_t(), FF, 0, false, scr, F.lane); continue; } r -= I_2;
        tr_item(wg, 256, r / 8, r % 8, F.Wglu_t(), 256, 0, false, scr, F.lane);
    }
    {
        const int gt = F.bid * NTHREADS + F.tid;
        if (gt < 1024) {
            float* SPp = F.SP();
            const int g = gt >> 6, p = gt & 63;
            const float lr = I.lam_re[(l * 16 + g) * 64 + p], li = I.lam_im[(l * 16 + g) * 64 + p];
            const float step = expf(I.log_step[l * 16 + g]);
            const float mag = expf(lr * step); const float lbr = mag * cosf(li * step), lbi = mag * sinf(li * step);
            const float den = lr * lr + li * li;
            const float fr = ((lbr - 1.f) * lr + lbi * li) / den, fi = (lbi * lr - (lbr - 1.f) * li) / den;
            SPp[SP_LB + gt * 2] = lbr; SPp[SP_LB + gt * 2 + 1] = lbi;
            float pr = lbr, pi = lbi;
#pragma unroll
            for (int s = 0; s < 6; ++s) { const float nr = pr * pr - pi * pi, ni = 2.f * pr * pi; pr = nr; pi = ni; }
            SPp[SP_L64 + gt * 2] = pr; SPp[SP_L64 + gt * 2 + 1] = pi;
            const float* br = I.b_re + ((size_t)(l * 16 + g) * 64 + p) * 16; const float* bi = I.b_im + ((size_t)(l * 16 + g) * 64 + p) * 16;
#pragma unroll
            for (int c = 0; c < 16; ++c) { SPp[SP_BBR + gt * 16 + c] = fr * br[c] - fi * bi[c]; SPp[SP_BBI + gt * 16 + c] = fr * bi[c] + fi * br[c]; }
        }
    }
    for (int m = gw; m < T; m += NGW) rms_row_bf16(I.xin + (size_t)m * DM, I.norm1_g + l * DM, F.H() + (size_t)m * DM, F.lane);
}

__device__ __forceinline__ u32x4 pack8(const f32x4& a, const f32x4& b) { u32x4 w; w.x = pk2(a.x, a.y); w.y = pk2(a.z, a.w); w.z = pk2(b.x, b.y); w.w = pk2(b.z, b.w); return w; }
__device__ __forceinline__ void unpack8(const u32x4& w, f32x4& a, f32x4& b) { a = (f32x4){bflo(w.x), bfhi(w.x), bflo(w.y), bfhi(w.y)}; b = (f32x4){bflo(w.z), bfhi(w.z), bflo(w.w), bfhi(w.w)}; }

__device__ __forceinline__ unsigned gate1_u8(float x) { const float s = 255.f * sigmoidf_(x) + 0.5f; const unsigned u = (unsigned)s; return u < 1u ? 1u : u; }
__device__ __forceinline__ unsigned gate4_u8(const f32x4& a) { return gate1_u8(a.x) | (gate1_u8(a.y) << 8) | (gate1_u8(a.z) << 16) | (gate1_u8(a.w) << 24); }
__device__ __forceinline__ void ungate8(const u32x2& w, f32x4& a, f32x4& b) {
    a = (f32x4){(float)(w.x & 255u), (float)((w.x >> 8) & 255u), (float)((w.x >> 16) & 255u), (float)(w.x >> 24)};
    b = (f32x4){(float)(w.y & 255u), (float)((w.y >> 8) & 255u), (float)((w.y >> 16) & 255u), (float)(w.y >> 24)};
}
struct FInProj {
    bf16_t* ZS; unsigned char* GB; float* IW; const f32x2* ROPE; bf16_t* IKD;
    __device__ __forceinline__ void rope8(f32x4& a, f32x4& b, int row, int f0) const {
        const f32x2* rt = ROPE + (size_t)row * NFREQ + f0;
        const f32x2 c0 = rt[0], c1 = rt[1], c2 = rt[2], c3 = rt[3];
        f32x4 oa, ob;
        oa.x = a.x * c0.x - a.y * c0.y; oa.y = a.y * c0.x + a.x * c0.y;
        oa.z = a.z * c1.x - a.w * c1.y; oa.w = a.w * c1.x + a.z * c1.y;
        ob.x = b.x * c2.x - b.y * c2.y; ob.y = b.y * c2.x + b.x * c2.y;
        ob.z = b.z * c3.x - b.w * c3.y; ob.w = b.w * c3.x + b.z * c3.y;
        a = oa; b = ob;
    }
    __device__ __forceinline__ void operator()(int row, int col, f32x4 a, f32x4 b) const {
        if (col >= ZEND) return;
        if (col >= ZGATE) {
            *(u32x2*)(GB + (size_t)row * GW + (col - ZGATE)) = (u32x2){gate4_u8(a), gate4_u8(b)}; return;
        }
        if (col >= ZIWC && col < ZRQ) { if (col == ZIWC) *(f32x4*)(IW + (size_t)row * 4) = a; return; }
        if (col >= ZDQ && col < ZDV) { const int hc = (col - ZDQ) & 63; if (hc < 16) rope8(a, b, row, hc >> 1); }
        else if (col >= ZIQ && col < ZIWC) { const int hc = (col - ZIQ) & 31; if (hc < 8) rope8(a, b, row, 8);
            if (col >= ZIK) { *(u32x4*)(IKD + ((size_t)((row >> 5) * 4 + ((col - ZIK) >> 3)) * 32 + (row & 31)) * 8) = pack8(a, b); return; } }
        else if (col >= ZRQ && col < ZRV) { const int hc = (col - ZRQ) % 48; rope8(a, b, row, 12 + (hc >> 1)); }
        *(u32x4*)(ZS + (size_t)row * ZSW + col) = pack8(a, b);
    }
};
struct FMerge {
    bf16_t* MG; const bf16_t* GB; int br;
    __device__ __forceinline__ void operator()(int row, int col, f32x4 a, f32x4 b) const {
        f32x4 ga, gb; unpack8(*(const u32x4*)(GB + (size_t)row * GW + br * DM + col), ga, gb);
        a = a * ga; b = b * gb;
        u32x4* mp = (u32x4*)(MG + (size_t)row * DM + col);
        if (br != 0) { f32x4 pa, pb; unpack8(*mp, pa, pb); a = a + pa; b = b + pb; }
        *mp = pack8(a, b);
    }
};
struct FResid {
    const float* base; float* out;
    __device__ __forceinline__ void operator()(int row, int col, f32x4 a, f32x4 b) const {
        const f32x4* bp = (const f32x4*)(base + (size_t)row * DM + col); f32x4* op = (f32x4*)(out + (size_t)row * DM + col);
        const f32x4 b0 = bp[0], b1 = bp[1]; op[0] = b0 + a; op[1] = b1 + b;
    }
};
struct FRelu2 {
    bf16_t* FB;
    __device__ __forceinline__ void operator()(int row, int col, f32x4 a, f32x4 b) const {
        a = (f32x4){fmaxf(a.x, 0.f), fmaxf(a.y, 0.f), fmaxf(a.z, 0.f), fmaxf(a.w, 0.f)}; b = (f32x4){fmaxf(b.x, 0.f), fmaxf(b.y, 0.f), fmaxf(b.z, 0.f), fmaxf(b.w, 0.f)};
        *(u32x4*)(FB + (size_t)row * FF + col) = pack8(a * a, b * b);
    }
};
struct FGlu {
    bf16_t* H; const float* bias;
    __device__ __forceinline__ void operator()(int row, int col, f32x4 a, f32x4 b) const {
        u32x4* hp = (u32x4*)(H + (size_t)row * DM + col); f32x4 ya, yb; unpack8(*hp, ya, yb);
        const f32x4 ba = *(const f32x4*)(bias + col), bb = *(const f32x4*)(bias + col + 4);
        a = a + ba; b = b + bb;
        a = (f32x4){ya.x * sigmoidf_(a.x), ya.y * sigmoidf_(a.y), ya.z * sigmoidf_(a.z), ya.w * sigmoidf_(a.w)};
        b = (f32x4){yb.x * sigmoidf_(b.x), yb.y * sigmoidf_(b.y), yb.z * sigmoidf_(b.z), yb.w * sigmoidf_(b.w)};
        *hp = pack8(a, b);
    }
};

struct EpiMerge {
    static constexpr bool PERM = true, HAS_MID = true; static constexpr int MID0 = 4, MID1 = 10;
    bf16_t* MG; const unsigned char* GB;
    __device__ __forceinline__ void mid(f32x4 (&acc)[2][2][4][2], const pg8::Unit& u, int t, int wr, int wc, int fr, int fq) const {
        int zz = 0; asm volatile("" : "+v"(zz));
        const int row0 = u.pm * 256 + wr * 64 + fr + zz, col0 = u.pn * 256 + wc * 32 + 8 * fq, bp = (t == MID0) ? 0 : 1;
#pragma unroll
        for (int ai = 0; ai < 2; ++ai)
#pragma unroll
            for (int m = 0; m < 4; ++m) {
#pragma unroll
                for (int bj = 0; bj < 2; ++bj) {
                    const unsigned char* gp = GB + (size_t)(row0 + ai * 128 + m * 16) * GW + bp * DM + col0 + bj * 128;
                    f32x4 pa, pb, na, nb; ungate8(*(const u32x2*)gp, pa, pb); ungate8(*(const u32x2*)(gp + DM), na, nb);
                    const f32x4 fa = {pa.x * __builtin_amdgcn_rcpf(na.x), pa.y * __builtin_amdgcn_rcpf(na.y), pa.z * __builtin_amdgcn_rcpf(na.z), pa.w * __builtin_amdgcn_rcpf(na.w)};
                    const f32x4 fb = {pb.x * __builtin_amdgcn_rcpf(nb.x), pb.y * __builtin_amdgcn_rcpf(nb.y), pb.z * __builtin_amdgcn_rcpf(nb.z), pb.w * __builtin_amdgcn_rcpf(nb.w)};
                    acc[ai][bj][m][0] = acc[ai][bj][m][0] * fa; acc[ai][bj][m][1] = acc[ai][bj][m][1] * fb;
                }
                if (m == 3) asm volatile("" ::: "memory");
            }
    }
    __device__ __forceinline__ void operator()(const f32x4 (&acc)[2][2][4][2], const pg8::Unit& u, int wr, int wc, int fr, int fq) const {
        const int row0 = u.pm * 256 + wr * 64 + fr, col0 = u.pn * 256 + wc * 32 + 8 * fq;
#pragma unroll
        for (int ai = 0; ai < 2; ++ai)
#pragma unroll
            for (int m = 0; m < 4; ++m)
#pragma unroll
                for (int bj = 0; bj < 2; ++bj) {
                    const int row = row0 + ai * 128 + m * 16, col = col0 + bj * 128;
                    f32x4 ga, gb; ungate8(*(const u32x2*)(GB + (size_t)row * GW + 2 * DM + col), ga, gb);
                    *(u32x4*)(MG + (size_t)row * DM + col) = pack8(acc[ai][bj][m][0] * (ga * (1.f / 255.f)), acc[ai][bj][m][1] * (gb * (1.f / 255.f)));
                }
    }
};

typedef float f32x16 __attribute__((ext_vector_type(16)));
__device__ __forceinline__ float gelu_tanh(float x) { const float u = 0.7978845608028654f * (x + 0.044715f * x * x * x); const float e = __expf(2.f * u); const float th = 1.f - 2.f / (e + 1.f); return 0.5f * x * (1.f + th); }
constexpr int S5_XSTR = 272;
constexpr int S5_WAVE_LDS = 2 * 16 * S5_XSTR;
template <bool OUT>
__device__ __forceinline__ void s5_pass(Frame& F, int l, const float* c_re, const float* c_im, const float* ssm_d) {
    const bf16_t* ZSp = F.ZS(); const float* SPp = F.SP(); f32x2* S5Ep = F.S5E();
    LAS unsigned char* XL = F.lds + F.wave * S5_WAVE_LDS;
    for (int task = F.bid * NWAVES + F.wave; task < 256 * 16; task += F.G * NWAVES) {
        int lane = F.lane; asm volatile("" : "+v"(lane));
        const int n = lane & 31, hh = lane >> 5, l15 = lane & 15, kg = lane >> 4;
        const int g = task & 15, pp = task >> 4, cmine = 2 * pp + hh;
        bf16x8 bbf[2][2];
#pragma unroll
        for (int st = 0; st < 2; ++st) { const float* br = SPp + SP_BBR + (size_t)(g * 64 + 2 * n + st) * 16 + 8 * hh; const float* bi = SPp + SP_BBI + (size_t)(g * 64 + 2 * n + st) * 16 + 8 * hh;
            bbf[st][0] = __builtin_bit_cast(bf16x8, pack8(*(const f32x4*)br, *(const f32x4*)(br + 4))); bbf[st][1] = __builtin_bit_cast(bf16x8, pack8(*(const f32x4*)bi, *(const f32x4*)(bi + 4))); }
        const f32x4 lb = *(const f32x4*)(SPp + SP_LB + (g * 64 + 2 * n) * 2);
        f32x4 x = {0.f, 0.f, 0.f, 0.f};
        if constexpr (OUT) x = *(const f32x4*)(S5Ep + (size_t)(cmine * 16 + g) * 64 + 2 * n);
        bf16x8 cf[4]; f32x4 dsk = {0.f, 0.f, 0.f, 0.f};
        if constexpr (OUT) {
#pragma unroll
            for (int ks = 0; ks < 4; ++ks) { const float* cp = ((ks < 2) ? c_re : c_im) + ((size_t)(l * 16 + g) * 16 + l15) * 64 + 32 * (ks & 1) + 8 * kg;
                f32x4 a = *(const f32x4*)cp, b = *(const f32x4*)(cp + 4); if (ks >= 2) { a = -a; b = -b; }
                cf[ks] = __builtin_bit_cast(bf16x8, pack8(a, b)); }
            dsk = *(const f32x4*)(ssm_d + (l * 16 + g) * 16 + 4 * kg);
        }
        const bf16_t* urow = ZSp + (size_t)((2 * pp + ((n >> 2) & 1)) * 64 + 4 * (n >> 3) + (n & 3)) * ZSW + ZU + g * 16 + 8 * hh;
#pragma unroll 1
        for (int k = 0; k < 4; ++k) {
            const bf16x8 uf = *(const bf16x8*)(urow + (size_t)(16 * k) * ZSW);
            const f32x16 z16 = {0.f, 0.f, 0.f, 0.f, 0.f, 0.f, 0.f, 0.f, 0.f, 0.f, 0.f, 0.f, 0.f, 0.f, 0.f, 0.f};
            const f32x16 r0 = __builtin_amdgcn_mfma_f32_32x32x16_bf16(uf, bbf[0][0], z16, 0, 0, 0), i0 = __builtin_amdgcn_mfma_f32_32x32x16_bf16(uf, bbf[0][1], z16, 0, 0, 0);
            const f32x16 r1 = __builtin_amdgcn_mfma_f32_32x32x16_bf16(uf, bbf[1][0], z16, 0, 0, 0), i1 = __builtin_amdgcn_mfma_f32_32x32x16_bf16(uf, bbf[1][1], z16, 0, 0, 0);
#pragma unroll
            for (int t = 0; t < 16; ++t) {
                const float nr0 = lb.x * x.x - lb.y * x.y + r0[t], ni0 = lb.x * x.y + lb.y * x.x + i0[t];
                const float nr1 = lb.z * x.z - lb.w * x.w + r1[t], ni1 = lb.z * x.w + lb.w * x.z + i1[t];
                x = (f32x4){nr0, ni0, nr1, ni1};
                if constexpr (OUT) { LAS unsigned* xw = (LAS unsigned*)(XL + (hh * 16 + t) * S5_XSTR + 4 * n); xw[0] = pk2(nr0, nr1); xw[32] = pk2(ni0, ni1); }
            }
            if constexpr (OUT) {
                asm volatile("s_waitcnt lgkmcnt(0)" ::: "memory");
#pragma unroll
                for (int sel = 0; sel < 2; ++sel) {
                    f32x4 y = {0.f, 0.f, 0.f, 0.f};
#pragma unroll
                    for (int ks = 0; ks < 4; ++ks) { const bf16x8 xf = *(const LAS bf16x8*)(XL + (sel * 16 + l15) * S5_XSTR + (32 * ks + 8 * kg) * 2); y = __builtin_amdgcn_mfma_f32_16x16x32_bf16(cf[ks], xf, y, 0, 0, 0); }
                    const size_t tok = (size_t)(2 * pp + sel) * 64 + 16 * k + l15;
                    const u32x2 uw = *(const u32x2*)(ZSp + tok * ZSW + ZU + g * 16 + 4 * kg);
                    const float y0 = gelu_tanh(y.x + dsk.x * bflo(uw.x)), y1 = gelu_tanh(y.y + dsk.y * bfhi(uw.x)), y2 = gelu_tanh(y.z + dsk.z * bflo(uw.y)), y3 = gelu_tanh(y.w + dsk.w * bfhi(uw.y));
                    *(u32x2*)(F.H() + tok * DM + g * 16 + 4 * kg) = (u32x2){pk2(y0, y1), pk2(y2, y3)};
                }
                asm volatile("s_waitcnt lgkmcnt(0)" ::: "memory");
            }
        }
        if constexpr (!OUT) *(f32x4*)(S5Ep + (size_t)(cmine * 16 + g) * 64 + 2 * n) = x;
    }
}
__device__ __forceinline__ void phase_s5_local(Frame& F) {
#ifdef NO_PHASE_S5_LOCAL
    return;
#endif
    s5_pass<false>(F, 0, nullptr, nullptr, nullptr);
}
__device__ __forceinline__ void phase_s5_out(Frame& F, int l, const float* c_re, const float* c_im, const float* ssm_d) {
#ifdef NO_PHASE_S5_OUT
    return;
#endif
    s5_pass<true>(F, l, c_re, c_im, ssm_d);
}

__device__ __forceinline__ void phase_carry(Frame& F) {
#ifdef NO_PHASE_CARRY
    return;
#endif
    const float* SPp = F.SP(); f32x2* S5Ep = F.S5E(); float* RSTp = F.RST();
    const int gw = F.bid * NWAVES + F.wave, NGW = F.G * NWAVES;
    for (int task = gw; task < NB * 16; task += NGW) {
        const int b = task >> 4, g = task & 15, p = F.lane;
        const float ar = SPp[SP_L64 + (g * 64 + p) * 2], ai = SPp[SP_L64 + (g * 64 + p) * 2 + 1];
        float sr = 0.f, si = 0.f;
        for (int c0 = 0; c0 < 128; c0 += 16) {
            f32x2 e[16];
#pragma unroll
            for (int j = 0; j < 16; ++j) e[j] = S5Ep[(size_t)((b * 128 + c0 + j) * 16 + g) * 64 + p];
#pragma unroll
            for (int j = 0; j < 16; ++j) { S5Ep[(size_t)((b * 128 + c0 + j) * 16 + g) * 64 + p] = (f32x2){sr, si}; const float nr = ar * sr - ai * si + e[j].x, ni = ar * si + ai * sr + e[j].y; sr = nr; si = ni; }
        }
    }
    const int NT = F.G * NTHREADS;
    for (int gt = F.bid * NTHREADS + F.tid; gt < NB * 4 * 4608; gt += NT) {
        const int b = gt / (4 * 4608), h = (gt / 4608) & 3, el = gt % 4608;
        const float lg = log1pf(-exp2f(-5.f - (float)h));
        const float cdec = expf(lg * 64.f);
        float s = 0.f;
        for (int c0 = 0; c0 < 128; c0 += 16) {
            float d[16];
#pragma unroll
            for (int j = 0; j < 16; ++j) d[j] = RSTp[(size_t)((b * 128 + c0 + j) * 4 + h) * 4608 + el];
#pragma unroll
            for (int j = 0; j < 16; ++j) { RSTp[(size_t)((b * 128 + c0 + j) * 4 + h) * 4608 + el] = s; s = s * cdec + d[j]; }
        }
    }
}

typedef float f32x16 __attribute__((ext_vector_type(16)));
typedef short s16x4 __attribute__((ext_vector_type(4)));
__device__ __forceinline__ bf16x8 tr8(const LAS unsigned char* a0, const LAS unsigned char* a1) {
    const s16x4 lo = __builtin_bit_cast(s16x4, __builtin_amdgcn_ds_read_tr16_b64_v4i16((LAS s16x4*)a0));
    const s16x4 hi = __builtin_bit_cast(s16x4, __builtin_amdgcn_ds_read_tr16_b64_v4i16((LAS s16x4*)a1));
    return (bf16x8){lo[0], lo[1], lo[2], lo[3], hi[0], hi[1], hi[2], hi[3]};
}
__device__ __forceinline__ bf16x8 pack8f(const f32x4& a, const f32x4& b) { return __builtin_bit_cast(bf16x8, pack8(a, b)); }
__device__ __forceinline__ void ret_stage_v(const bf16_t* ZSp, LAS unsigned char* Vb, int tok0, int h, int lane) {
#pragma unroll
    for (int n = 0; n < 12; ++n) { const int o = n * 1024 + 16 * lane, r = o / 192, ch = (o % 192) >> 4;
        __builtin_amdgcn_global_load_lds((const unsigned*)(ZSp + (size_t)(tok0 + r) * ZSW + ZRV + h * 96 + ch * 8), (LAS unsigned*)(Vb + n * 1024), 16, 0, 0); }
}
constexpr int RET_VB = 12288, RET_KSTR = 112, RET_WAVE_LDS = RET_VB + 64 * RET_KSTR;
__device__ __forceinline__ void phase_ret_local(Frame& F) {
#ifdef NO_PHASE_RET_LOCAL
    return;
#endif
    const bf16_t* ZSp = F.ZS(); float* RSTp = F.RST();
    LAS unsigned char* Vb = F.lds + F.wave * RET_WAVE_LDS; LAS unsigned char* Kb = Vb + RET_VB;
    for (int item = F.bid * NWAVES + F.wave; item < 2048; item += F.G * NWAVES) {
        int lane = F.lane; asm volatile("" : "+v"(lane));
        const int l31 = lane & 31, hh = lane >> 5, g1 = (lane >> 4) & 1, q4 = (lane & 15) >> 2, p4 = lane & 3;
        const int h = item & 3, tok0 = (item >> 2) * 64;
        ret_stage_v(ZSp, Vb, tok0, h, lane);
        const float lg2 = log2f(1.f - exp2f(-5.f - (float)h));
#pragma unroll
        for (int n = 0; n < 6; ++n) { const int idx = n * 64 + lane, r = idx / 6, ch = idx % 6;
            f32x4 a, b; unpack8(*(const u32x4*)(ZSp + (size_t)(tok0 + r) * ZSW + ZRK + h * 48 + ch * 8), a, b);
            const float sc = 0.14433756729740643f * exp2f(lg2 * (float)(63 - r));
            *(LAS u32x4*)(Kb + r * RET_KSTR + ch * 16) = pack8(a * sc, b * sc); }
        asm volatile("s_waitcnt vmcnt(0) lgkmcnt(0)" ::: "memory");
        f32x16 acc[3][2];
#pragma unroll
        for (int me = 0; me < 3; ++me)
#pragma unroll
            for (int nt = 0; nt < 2; ++nt) acc[me][nt] = (f32x16){0.f, 0.f, 0.f, 0.f, 0.f, 0.f, 0.f, 0.f, 0.f, 0.f, 0.f, 0.f, 0.f, 0.f, 0.f, 0.f};
#pragma unroll
        for (int s = 0; s < 4; ++s) {
            const int r0 = 16 * s + 8 * hh + q4;
            bf16x8 kf[2], vf[3];
#pragma unroll
            for (int nt = 0; nt < 2; ++nt) { const LAS unsigned char* a0 = Kb + r0 * RET_KSTR + (32 * nt + 16 * g1 + 4 * p4) * 2; kf[nt] = tr8(a0, a0 + 4 * RET_KSTR); }
#pragma unroll
            for (int me = 0; me < 3; ++me) { const LAS unsigned char* a0 = Vb + r0 * 192 + (32 * me + 16 * g1 + 4 * p4) * 2; vf[me] = tr8(a0, a0 + 4 * 192); }
#pragma unroll
            for (int me = 0; me < 3; ++me)
#pragma unroll
                for (int nt = 0; nt < 2; ++nt) acc[me][nt] = __builtin_amdgcn_mfma_f32_32x32x16_bf16(vf[me], kf[nt], acc[me][nt], 0, 0, 0);
        }
        float* dst = RSTp + (size_t)item * 4608 + (4 * hh) * 48 + l31;
#pragma unroll
        for (int me = 0; me < 3; ++me)
#pragma unroll
            for (int r4 = 0; r4 < 4; ++r4) {
                int zz = 0; asm volatile("" : "+v"(zz)); float* dp = dst + (32 * me + 8 * r4) * 48 + zz;
#pragma unroll
                for (int k = 0; k < 4; ++k) { dp[k * 48] = acc[me][0][4 * r4 + k]; if (l31 < 16) dp[k * 48 + 32] = acc[me][1][4 * r4 + k]; }
            }
        asm volatile("s_waitcnt lgkmcnt(0)" ::: "memory");
    }
}
__device__ __forceinline__ void phase_ret_out(Frame& F, int l, const float* ret_norm_g) {
#ifdef NO_PHASE_RET_OUT
    return;
#endif
    const bf16_t* ZSp = F.ZS(); const float* RSTp = F.RST();
    LAS unsigned char* Vb = F.lds + F.wave * RET_WAVE_LDS;
    for (int item = F.bid * NWAVES + F.wave; item < 2048; item += F.G * NWAVES) {
        int lane = F.lane; asm volatile("" : "+v"(lane));
        const int l31 = lane & 31, hh = lane >> 5, g1 = (lane >> 4) & 1, q4 = (lane & 15) >> 2, p4 = lane & 3;
        const int h = item & 3, tok0 = (item >> 2) * 64;
        ret_stage_v(ZSp, Vb, tok0, h, lane);
        const float lg2 = log2f(1.f - exp2f(-5.f - (float)h));
        bf16x8 qf[2][3], kf[2][3];
#pragma unroll
        for (int t = 0; t < 2; ++t)
#pragma unroll
            for (int ks = 0; ks < 3; ++ks) { const size_t ro = (size_t)(tok0 + 32 * t + l31) * ZSW + h * 48 + 8 * hh + 16 * ks;
                qf[t][ks] = *(const bf16x8*)(ZSp + ro + ZRQ); kf[t][ks] = *(const bf16x8*)(ZSp + ro + ZRK); }
        bf16x8 pm[2][4];
#pragma unroll
        for (int mt = 0; mt < 2; ++mt)
#pragma unroll
            for (int nt = mt; nt < 2; ++nt) {
                f32x16 p = {0.f, 0.f, 0.f, 0.f, 0.f, 0.f, 0.f, 0.f, 0.f, 0.f, 0.f, 0.f, 0.f, 0.f, 0.f, 0.f};
#pragma unroll
                for (int ks = 0; ks < 3; ++ks) p = __builtin_amdgcn_mfma_f32_32x32x16_bf16(kf[mt][ks], qf[nt][ks], p, 0, 0, 0);
                const int i = 32 * nt + l31;
#pragma unroll
                for (int r = 0; r < 16; ++r) { const int j = 32 * mt + (r & 3) + 8 * (r >> 2) + 4 * hh;
                    p[r] = (i >= j) ? p[r] * (0.14433756729740643f * exp2f(lg2 * (float)(i - j))) : 0.f; }
                pm[nt][2 * mt + 0] = pack8f((f32x4){p[0], p[1], p[2], p[3]}, (f32x4){p[4], p[5], p[6], p[7]});
                pm[nt][2 * mt + 1] = pack8f((f32x4){p[8], p[9], p[10], p[11]}, (f32x4){p[12], p[13], p[14], p[15]});
            }
        f32x16 ot[3][2];
#pragma unroll
        for (int me = 0; me < 3; ++me) {
            bf16x8 sf[3];
            int zz = 0; asm volatile("" : "+v"(zz)); const float* sp0 = RSTp + (size_t)item * 4608 + (32 * me + l31) * 48 + 8 * hh + zz;
#pragma unroll
            for (int ks = 0; ks < 3; ++ks) { const float* sp = sp0 + 16 * ks; sf[ks] = pack8f(*(const f32x4*)sp, *(const f32x4*)(sp + 4)); }
#pragma unroll
            for (int nt = 0; nt < 2; ++nt) {
                f32x16 a = {0.f, 0.f, 0.f, 0.f, 0.f, 0.f, 0.f, 0.f, 0.f, 0.f, 0.f, 0.f, 0.f, 0.f, 0.f, 0.f};
#pragma unroll
                for (int ks = 0; ks < 3; ++ks) a = __builtin_amdgcn_mfma_f32_32x32x16_bf16(sf[ks], qf[nt][ks], a, 0, 0, 0);
                const float qd = exp2f(lg2 * (float)(32 * nt + l31 + 1));
                ot[me][nt] = a * qd;
            }
        }
        asm volatile("s_waitcnt vmcnt(0)" ::: "memory");
#pragma unroll
        for (int s = 0; s < 4; ++s) {
            const int r0 = 16 * s + 4 * hh + q4;
#pragma unroll
            for (int me = 0; me < 3; ++me) {
                const LAS unsigned char* a0 = Vb + r0 * 192 + (32 * me + 16 * g1 + 4 * p4) * 2;
                const bf16x8 vf = tr8(a0, a0 + 8 * 192);
                if (s < 2) ot[me][0] = __builtin_amdgcn_mfma_f32_32x32x16_bf16(vf, pm[0][s], ot[me][0], 0, 0, 0);
                ot[me][1] = __builtin_amdgcn_mfma_f32_32x32x16_bf16(vf, pm[1][s], ot[me][1], 0, 0, 0);
            }
        }
#pragma unroll
        for (int nt = 0; nt < 2; ++nt) {
            float sum = 0.f;
#pragma unroll
            for (int me = 0; me < 3; ++me)
#pragma unroll
                for (int r = 0; r < 16; ++r) sum += ot[me][nt][r];
            sum += __shfl_xor(sum, 32);
            const float mu = sum * (1.f / 96.f); float q2 = 0.f;
#pragma unroll
            for (int me = 0; me < 3; ++me)
#pragma unroll
                for (int r = 0; r < 16; ++r) { const float d = ot[me][nt][r] - mu; q2 += d * d; }
            q2 += __shfl_xor(q2, 32);
            const float rs = rsqrtf(q2 * (1.f / 96.f) + EPS);
            const int tok = tok0 + 32 * nt + l31;
            const bf16_t* gbase = ZSp + (size_t)tok * ZSW + ZRG + h * 96 + 4 * hh; const float* nbase = ret_norm_g + l * 384 + h * 96 + 4 * hh; bf16_t* obase = F.H() + (size_t)tok * DM + 640 + h * 96 + 4 * hh;
#pragma unroll
            for (int me = 0; me < 3; ++me) {
                int zz = 0; asm volatile("" : "+v"(zz));
                const bf16_t* gp = gbase + 32 * me + zz; const float* np = nbase + 32 * me + zz; bf16_t* op = obase + 32 * me + zz;
#pragma unroll
                for (int r4 = 0; r4 < 4; ++r4) {
                    const u32x2 gw = *(const u32x2*)(gp + 8 * r4);
                    const f32x4 ng = *(const f32x4*)(np + 8 * r4);
                    const float g0 = bflo(gw.x), g1f = bfhi(gw.x), g2 = bflo(gw.y), g3 = bfhi(gw.y);
                    const float y0 = (ot[me][nt][4 * r4 + 0] - mu) * rs * ng.x * (g0 * sigmoidf_(g0)), y1 = (ot[me][nt][4 * r4 + 1] - mu) * rs * ng.y * (g1f * sigmoidf_(g1f));
                    const float y2 = (ot[me][nt][4 * r4 + 2] - mu) * rs * ng.z * (g2 * sigmoidf_(g2)), y3 = (ot[me][nt][4 * r4 + 3] - mu) * rs * ng.w * (g3 * sigmoidf_(g3));
                    *(u32x2*)(op + 8 * r4) = (u32x2){pk2(y0, y1), pk2(y2, y3)};
                }
            }
        }
        asm volatile("s_waitcnt lgkmcnt(0)" ::: "memory");
    }
}

typedef _Float16 f16_t;
__device__ __forceinline__ u32x4 zero4() { unsigned z = 0u; asm volatile("" : "+v"(z)); return (u32x4){z, z, z, z}; }
__device__ __forceinline__ int lanes_below(unsigned long long m) { return (int)__builtin_amdgcn_mbcnt_hi((unsigned)(m >> 32), __builtin_amdgcn_mbcnt_lo((unsigned)m, 0u)); }
__device__ __forceinline__ float relu1(float x) { return __builtin_amdgcn_fmed3f(x, 0.f, __builtin_inff()); }
__device__ __forceinline__ unsigned sortable_f16(float sc) {
    const f16_t h = (f16_t)sc; const unsigned u = (unsigned)__builtin_bit_cast(unsigned short, h), mag = u & 0x7fffu;
    return (u & 0x8000u) ? (0x8000u - mag) : (0x8000u + mag);
}
__device__ __forceinline__ int sc_pos(int k) { return k; }
__device__ __forceinline__ int wave_suffix_sum(int v, int lane) {
#pragma unroll
    for (int o = 1; o < 64; o <<= 1) { const int t = __shfl_down(v, o); if (lane + o < 64) v += t; }
    return v;
}
__device__ __forceinline__ void hist_threshold(const u32x4 c, int need, int& B, int& above, int& cntB) {
    const int s = (int)(c.x + c.y + c.z + c.w);
    int acc = 0, L = 63;
    for (; L > 0; --L) { const int sL = __builtin_amdgcn_readlane(s, L); if (acc + sL >= need) break; acc += sL; }
    const int cw = __builtin_amdgcn_readlane((int)c.w, L), cz = __builtin_amdgcn_readlane((int)c.z, L), cy = __builtin_amdgcn_readlane((int)c.y, L), cx = __builtin_amdgcn_readlane((int)c.x, L);
    if (acc + cw >= need) { B = 4 * L + 3; cntB = cw; }
    else { acc += cw; if (acc + cz >= need) { B = 4 * L + 2; cntB = cz; }
    else { acc += cz; if (acc + cy >= need) { B = 4 * L + 1; cntB = cy; }
    else { acc += cy; B = 4 * L; cntB = cx; } } }
    above = acc;
}

#ifndef DSA_CAND
#define DSA_CAND 0
#endif
#ifndef DSA_DUP
#define DSA_DUP 0
#endif
constexpr int DSA_ROW = 16384;
__device__ __forceinline__ void phase_dsa(Frame& F) {
#ifdef NO_PHASE_DSA
    return;
#endif
    const int wave = F.wave;
    const bf16_t* ZSp = F.ZS(); const float* IWp = F.IW(); const bf16_t* IKp = F.IKD();
    LAS unsigned char* SCb = F.lds;
    for (int it = F.bid; it < 512; it += F.G) {
        int lane = F.lane; asm volatile("" : "+v"(lane));
        const int hi = lane >> 5, n32 = lane & 31;
        LAS unsigned short* LSTw = (LAS unsigned short*)(F.lds + 131072) + wave * 256;
        LAS unsigned char* WB = F.lds + 135168 + wave * 3520;
        LAS unsigned* H1 = (LAS unsigned*)WB; LAS unsigned* H2 = H1 + 256;
        LAS unsigned* DUM = (LAS unsigned*)(WB + 3264) + lane;
        LAS unsigned short* CK = (LAS unsigned short*)(WB + 1024); LAS unsigned short* CI = (LAS unsigned short*)(WB + 2144);
        const int pr = it & 255, vcu = (pr & 7) * 32 + (pr >> 3);
        const int b = vcu >> 6, cc = vcu & 63, c = (it < 256) ? cc : 127 - cc;
        const int V = (c + 1) * 64, tokq0 = b * SEQ + c * 64, kb0 = b * SEQ;
        const int Keff = V < 256 ? V : 256;
        const int nblk = (V + 511) >> 9, ntile_all = nblk * 16, ntile_real = V >> 5;
        for (int qg = 0; qg < 8; ++qg) {
            const int tq0 = tokq0 + qg * 8;
#ifndef DSA_NO_A
            for (int repA = 0; repA < 1 + (DSA_DUP & 1); ++repA) {
                bf16x8 aq[2];
                { const int qq = n32 >> 2, hd = n32 & 3; const bf16_t* qp = ZSp + (size_t)(tq0 + qq) * ZSW + ZIQ + hd * 32 + 8 * hi;
                  aq[0] = *(const bf16x8*)qp; aq[1] = *(const bf16x8*)(qp + 16); }
                float wq[4][4];
#pragma unroll
                for (int jq = 0; jq < 4; ++jq) { const f32x4 w4 = *(const f32x4*)(IWp + (size_t)(tq0 + 2 * jq + hi) * 4);
                    wq[jq][0] = w4.x * 0.08838834764831845f; wq[jq][1] = w4.y * 0.08838834764831845f; wq[jq][2] = w4.z * 0.08838834764831845f; wq[jq][3] = w4.w * 0.08838834764831845f; }
                bf16x8 fr[2][4][2];
                const int nb = (ntile_all - wave + 31) >> 5;
#define DSA_ALOAD(buf, bt) do { int zz = 0; asm volatile("" : "+v"(zz)); _Pragma("unroll") for (int u = 0; u < 4; ++u) { const int tt = wave + 8 * (4 * (bt) + u); \
        if (tt < ntile_real) { const bf16_t* kp = IKp + ((size_t)(((kb0 >> 5) + tt) * 4 + hi) * 32 + n32 + zz) * 8; fr[buf][u][0] = *(const bf16x8*)kp; fr[buf][u][1] = *(const bf16x8*)(kp + 512); } } } while (0)
#define DSA_ACOMP(buf, bt) do { _Pragma("unroll") for (int u = 0; u < 4; ++u) { const int tt = wave + 8 * (4 * (bt) + u); \
        if (tt < ntile_all) { unsigned short us[4] = {0, 0, 0, 0}; \
            if (tt < ntile_real) { f32x16 acc = {0.f, 0.f, 0.f, 0.f, 0.f, 0.f, 0.f, 0.f, 0.f, 0.f, 0.f, 0.f, 0.f, 0.f, 0.f, 0.f}; \
                acc = __builtin_amdgcn_mfma_f32_32x32x16_bf16(aq[0], fr[buf][u][0], acc, 0, 0, 0); acc = __builtin_amdgcn_mfma_f32_32x32x16_bf16(aq[1], fr[buf][u][1], acc, 0, 0, 0); \
                _Pragma("unroll") for (int jq = 0; jq < 4; ++jq) { \
                    const float sc = relu1(acc[4 * jq + 0]) * wq[jq][0] + relu1(acc[4 * jq + 1]) * wq[jq][1] + relu1(acc[4 * jq + 2]) * wq[jq][2] + relu1(acc[4 * jq + 3]) * wq[jq][3]; \
                    us[jq] = (unsigned short)sortable_f16(sc); } } \
            const int pos = sc_pos(tt * 32 + n32); \
            _Pragma("unroll") for (int jq = 0; jq < 4; ++jq) *(LAS unsigned short*)(SCb + (2 * jq + hi) * DSA_ROW + pos * 2) = us[jq]; } } } while (0)
                DSA_ALOAD(0, 0);
                for (int bp = 0; bp < nb; bp += 2) {
                    if (bp + 1 < nb) DSA_ALOAD(1, bp + 1);
                    DSA_ACOMP(0, bp);
                    if (bp + 2 < nb) DSA_ALOAD(0, bp + 2);
                    if (bp + 1 < nb) DSA_ACOMP(1, bp + 1);
                }
#undef DSA_ALOAD
#undef DSA_ACOMP
            }
#endif
            __syncthreads();
            LAS unsigned char* row = SCb + wave * DSA_ROW;
#ifndef DSA_NO_B
            for (int repB = 0; repB < 1 + ((DSA_DUP >> 1) & 1); ++repB)
            if (V > 256) {
                *(LAS u32x4*)(H1 + 4 * lane) = zero4(); *(LAS u32x4*)(H2 + 4 * lane) = zero4();
                u32x4 rw[4];
#define DSA_LD8(hf) do { _Pragma("unroll") for (int i = 0; i < 4; ++i) if (4 * (hf) + i < nblk) rw[i] = *(const LAS u32x4*)(row + (512 * (4 * (hf) + i) + 8 * lane) * 2); \
        asm volatile("s_waitcnt lgkmcnt(0)" ::: "memory"); } while (0)
#define DSA_W(i, e2) ((e2) == 0 ? rw[i].x : (e2) == 1 ? rw[i].y : (e2) == 2 ? rw[i].z : rw[i].w)
                asm volatile("s_waitcnt lgkmcnt(0)" ::: "memory");
#pragma unroll 1
                for (int hf = 0; 4 * hf < nblk; ++hf) {
                    DSA_LD8(hf);
#pragma unroll
                    for (int i = 0; i < 4; ++i) if (4 * hf + i < nblk) __hip_atomic_fetch_add(H2 + ((rw[i].x >> 8) & 255u), 1u, __ATOMIC_RELAXED, __HIP_MEMORY_SCOPE_WORKGROUP);
                }
                asm volatile("s_waitcnt lgkmcnt(0)" ::: "memory");
                int Bc, abovec, cntc; hist_threshold(*(const LAS u32x4*)(H2 + 4 * lane), 40, Bc, abovec, cntc);
                *(LAS u32x4*)(H2 + 4 * lane) = zero4();
                bool done = false;
                if (DSA_CAND && Bc > 0) {
                    asm volatile("s_waitcnt lgkmcnt(0)" ::: "memory");
#pragma unroll 1
                    for (int hf = 0; 4 * hf < nblk; ++hf) {
                        DSA_LD8(hf);
#pragma unroll
                        for (int i = 0; i < 4; ++i) if (4 * hf + i < nblk) { const unsigned w = rw[i].x; LAS unsigned* p0 = ((int)((w >> 8) & 255u) == Bc) ? H2 + (w & 255u) : DUM; __hip_atomic_fetch_add(p0, 1u, __ATOMIC_RELAXED, __HIP_MEMORY_SCOPE_WORKGROUP); }
                    }
                    asm volatile("s_waitcnt lgkmcnt(0)" ::: "memory");
                    int Bs2, aboves2, cnts2; hist_threshold(*(const LAS u32x4*)(H2 + 4 * lane), 40 - abovec, Bs2, aboves2, cnts2);
                    *(LAS u32x4*)(H2 + 4 * lane) = zero4();
                    const unsigned thr = ((unsigned)Bc << 8) | (unsigned)Bs2;
                    int cnt = 0;
#pragma unroll 1
                    for (int hf = 0; 4 * hf < nblk; ++hf) {
                        DSA_LD8(hf);
#pragma unroll
                        for (int i = 0; i < 4; ++i) if (4 * hf + i < nblk) {
#pragma unroll
                            for (int e = 0; e < 8; ++e) { const unsigned w = DSA_W(i, e >> 1); const unsigned u = (e & 1) ? (w >> 16) : (w & 0xffffu); cnt += (u >= thr) ? 1 : 0; }
                        }
                    }
                    int pos = cnt;
#pragma unroll
                    for (int o = 1; o < 64; o <<= 1) { const int t = __shfl_up(pos, o); if (lane >= o) pos += t; }
                    const int ncand = __shfl(pos, 63); pos -= cnt;
                    if (ncand >= 256 && ncand <= 560) {
                        LAS unsigned short* ldum = (LAS unsigned short*)DUM;
#pragma unroll 1
                        for (int hf = 0; 4 * hf < nblk; ++hf) {
                            DSA_LD8(hf);
#pragma unroll
                            for (int i = 0; i < 4; ++i) if (4 * hf + i < nblk) {
#pragma unroll
                                for (int e = 0; e < 8; ++e) { const unsigned w = DSA_W(i, e >> 1); const unsigned u = (e & 1) ? (w >> 16) : (w & 0xffffu);
                                    const bool sel = u >= thr; LAS unsigned short* pk = sel ? CK + pos : ldum; LAS unsigned short* pi = sel ? CI + pos : ldum;
                                    *pk = (unsigned short)u; *pi = (unsigned short)(512 * (4 * hf + i) + 8 * lane + e); pos += sel ? 1 : 0; }
                            }
                        }
                        *(LAS u32x4*)(H1 + 4 * lane) = zero4();
                        asm volatile("s_waitcnt lgkmcnt(0)" ::: "memory");
                        unsigned cu[9];
#pragma unroll
                        for (int j = 0; j < 9; ++j) { const int p = j * 64 + lane; const bool v = p < ncand; cu[j] = v ? (unsigned)CK[v ? p : 0] : 0u; }
                        asm volatile("s_waitcnt lgkmcnt(0)" ::: "memory");
#pragma unroll
                        for (int j = 0; j < 9; ++j) if (j * 64 + lane < ncand) __hip_atomic_fetch_add(H1 + (cu[j] >> 8), 1u, __ATOMIC_RELAXED, __HIP_MEMORY_SCOPE_WORKGROUP);
                        asm volatile("s_waitcnt lgkmcnt(0)" ::: "memory");
                        int B1c, above1c, cnt1c; hist_threshold(*(const LAS u32x4*)(H1 + 4 * lane), 256, B1c, above1c, cnt1c);
                        *(LAS u32x4*)(H1 + 4 * lane) = zero4();
                        asm volatile("s_waitcnt lgkmcnt(0)" ::: "memory");
#pragma unroll
                        for (int j = 0; j < 9; ++j) if (j * 64 + lane < ncand && (int)(cu[j] >> 8) == B1c) __hip_atomic_fetch_add(H1 + (cu[j] & 255u), 1u, __ATOMIC_RELAXED, __HIP_MEMORY_SCOPE_WORKGROUP);
                        asm volatile("s_waitcnt lgkmcnt(0)" ::: "memory");
                        int B2c, above2c, cnt2c; hist_threshold(*(const LAS u32x4*)(H1 + 4 * lane), 256 - above1c, B2c, above2c, cnt2c);
                        const unsigned tauc = ((unsigned)B1c << 8) | (unsigned)B2c;
                        if (cnt2c == 256 - above1c - above2c) {
                            int c2 = 0;
#pragma unroll
                            for (int j = 0; j < 9; ++j) c2 += (j * 64 + lane < ncand && cu[j] >= tauc) ? 1 : 0;
                            int p2 = c2;
#pragma unroll
                            for (int o = 1; o < 64; o <<= 1) { const int t = __shfl_up(p2, o); if (lane >= o) p2 += t; }
                            p2 -= c2;
#pragma unroll
                            for (int j = 0; j < 9; ++j) { const bool sel = (j * 64 + lane < ncand) && cu[j] >= tauc; LAS unsigned short* pl = sel ? LSTw + p2 : ldum; *pl = CI[sel ? j * 64 + lane : 0]; p2 += sel ? 1 : 0; }
                            done = true;
                        }
                        *(LAS u32x4*)(H1 + 4 * lane) = zero4(); *(LAS u32x4*)(H2 + 4 * lane) = zero4();
                        asm volatile("s_waitcnt lgkmcnt(0)" ::: "memory");
                    }
                }
                if (!done) {
                int lo_bin = Bc, hi_bin = 256, B1 = 0, above1 = 0, cnt1 = 0;
                for (;;) {
#pragma unroll 1
                    for (int hf = 0; 4 * hf < nblk; ++hf) {
                        DSA_LD8(hf);
#pragma unroll
                        for (int i = 0; i < 4; ++i) if (4 * hf + i < nblk) {
#pragma unroll
                            for (int e2 = 0; e2 < 4; ++e2) { const unsigned w = DSA_W(i, e2); const int b0 = (int)((w >> 8) & 255u), b1 = (int)(w >> 24);
                                LAS unsigned* p0 = ((unsigned)(b0 - lo_bin) < (unsigned)(hi_bin - lo_bin)) ? H1 + b0 : DUM; LAS unsigned* p1 = ((unsigned)(b1 - lo_bin) < (unsigned)(hi_bin - lo_bin)) ? H1 + b1 : DUM;
                                __hip_atomic_fetch_add(p0, 1u, __ATOMIC_RELAXED, __HIP_MEMORY_SCOPE_WORKGROUP); __hip_atomic_fetch_add(p1, 1u, __ATOMIC_RELAXED, __HIP_MEMORY_SCOPE_WORKGROUP); }
                        }
                    }
                    asm volatile("s_waitcnt lgkmcnt(0)" ::: "memory");
                    hist_threshold(*(const LAS u32x4*)(H1 + 4 * lane), 256, B1, above1, cnt1);
                    if (lo_bin == 0 || above1 + cnt1 >= 256) break;
                    hi_bin = lo_bin; lo_bin = 0;
                }
#pragma unroll 1
                for (int hf = 0; 4 * hf < nblk; ++hf) {
                    DSA_LD8(hf);
#pragma unroll
                    for (int i = 0; i < 4; ++i) if (4 * hf + i < nblk) {
#pragma unroll
                        for (int e2 = 0; e2 < 4; ++e2) { const unsigned w = DSA_W(i, e2);
                            LAS unsigned* p0 = ((int)((w >> 8) & 255u) == B1) ? H2 + (w & 255u) : DUM; LAS unsigned* p1 = ((int)(w >> 24) == B1) ? H2 + ((w >> 16) & 255u) : DUM;
                            __hip_atomic_fetch_add(p0, 1u, __ATOMIC_RELAXED, __HIP_MEMORY_SCOPE_WORKGROUP); __hip_atomic_fetch_add(p1, 1u, __ATOMIC_RELAXED, __HIP_MEMORY_SCOPE_WORKGROUP); }
                    }
                }
                asm volatile("s_waitcnt lgkmcnt(0)" ::: "memory");
                int B2, above2, neq; hist_threshold(*(const LAS u32x4*)(H2 + 4 * lane), 256 - above1, B2, above2, neq);
                const unsigned tau = ((unsigned)B1 << 8) | (unsigned)B2;
                const int r = 256 - above1 - above2;
                if (neq == r) {
                    int cnt = 0;
#pragma unroll 1
                    for (int hf = 0; 4 * hf < nblk; ++hf) {
                        DSA_LD8(hf);
#pragma unroll
                        for (int i = 0; i < 4; ++i) if (4 * hf + i < nblk) {
#pragma unroll
                            for (int e = 0; e < 8; ++e) { const unsigned w = DSA_W(i, e >> 1); const unsigned u = (e & 1) ? (w >> 16) : (w & 0xffffu); cnt += (u >= tau) ? 1 : 0; }
                        }
                    }
                    int pos = cnt;
#pragma unroll
                    for (int o = 1; o < 64; o <<= 1) { const int t = __shfl_up(pos, o); if (lane >= o) pos += t; }
                    pos -= cnt;
                    LAS unsigned short* ldum = (LAS unsigned short*)DUM;
#pragma unroll 1
                    for (int hf = 0; 4 * hf < nblk; ++hf) {
                        DSA_LD8(hf);
#pragma unroll
                        for (int i = 0; i < 4; ++i) if (4 * hf + i < nblk) {
#pragma unroll
                            for (int e = 0; e < 8; ++e) { const unsigned w = DSA_W(i, e >> 1); const unsigned u = (e & 1) ? (w >> 16) : (w & 0xffffu);
                                const bool sel = u >= tau; LAS unsigned short* p = sel ? LSTw + pos : ldum;
                                *p = (unsigned short)(512 * (4 * hf + i) + 8 * lane + e); pos += sel ? 1 : 0; }
                        }
                    }
                } else {
                    int eq_base = 0, sel_base = 0;
#pragma unroll 1
                    for (int i = 0; i < nblk; ++i) {
                        const u32x4 w4 = *(const LAS u32x4*)(row + (512 * i + 8 * lane) * 2);
                        const unsigned ww[4] = {w4.x, w4.y, w4.z, w4.w};
                        int below_eq = 0, mine_eq = 0;
#pragma unroll
                        for (int e = 0; e < 8; ++e) { const unsigned u = (e & 1) ? (ww[e >> 1] >> 16) : (ww[e >> 1] & 0xffffu); below_eq += lanes_below(__ballot(u == tau)); }
                        int blk_eq = 0;
#pragma unroll
                        for (int e = 0; e < 8; ++e) {
                            const unsigned u = (e & 1) ? (ww[e >> 1] >> 16) : (ww[e >> 1] & 0xffffu);
                            const bool gt = u > tau, eq = (u == tau);
                            const bool sel = gt || (eq && (eq_base + below_eq + mine_eq < r));
                            mine_eq += eq ? 1 : 0;
                            const unsigned long long msel = __ballot(sel);
                            if (sel) LSTw[sel_base + lanes_below(msel)] = (unsigned short)(512 * i + 8 * lane + e);
                            sel_base += __popcll(msel); blk_eq += __popcll(__ballot(eq));
                        }
                        eq_base += blk_eq;
                    }
                }
                }
#undef DSA_W
#undef DSA_LD8
            } else {
#pragma unroll
                for (int jj = 0; jj < 4; ++jj) LSTw[lane + 64 * jj] = (unsigned short)(lane + 64 * jj);
            }
#endif
            asm volatile("s_waitcnt lgkmcnt(0)" ::: "memory");
            for (int repC = 0; repC < 1 + ((DSA_DUP >> 2) & 1); ++repC) {
                const int tq = tq0 + wave, n16 = lane & 15, kg = lane >> 4;
                bf16x8 qf[2];
                if (n16 < 6) { const bf16_t* qp = ZSp + (size_t)tq * ZSW + ZDQ + n16 * 64 + 8 * kg; qf[0] = *(const bf16x8*)qp; qf[1] = *(const bf16x8*)(qp + 32); }
                else { qf[0] = (bf16x8){0, 0, 0, 0, 0, 0, 0, 0}; qf[1] = qf[0]; }
                const int ntile = Keff >> 4;
                LAS unsigned char* vst = row;
#define DSA_VDMA(ch, buf) do { _Pragma("unroll") for (int i8 = 0; i8 < 8; ++i8) { const int rr = (lane >> 3) + 8 * i8; const int kidx = LSTw[(ch) * 64 + rr]; \
        const int sch = (lane & 7) ^ (2 * ((rr >> 1) & 3)); \
        __builtin_amdgcn_global_load_lds((const unsigned*)(ZSp + (size_t)(kb0 + kidx) * ZSW + ZDV + sch * 8), (LAS unsigned*)(vst + (buf) * 8192 + i8 * 1024), 16, 0, 0); } } while (0)
                DSA_VDMA(0, 0);
                if (ntile > 4) DSA_VDMA(1, 1);
                f32x4 sa[16];
#pragma unroll
                for (int tb = 0; tb < 4; ++tb) {
                    constexpr int T0[5] = {0, 4, 8, 12, 16};
                    bf16x8 kf[6][2];
#pragma unroll
                    for (int t8 = 0; t8 < 6; ++t8) if (T0[tb] + t8 < T0[tb + 1] && T0[tb] + t8 < ntile) { const int kidx = LSTw[(T0[tb] + t8) * 16 + n16]; const bf16_t* kp = ZSp + (size_t)(kb0 + kidx) * ZSW + ZDK + 8 * kg;
                        kf[t8][0] = *(const bf16x8*)kp; kf[t8][1] = *(const bf16x8*)(kp + 32); }
#pragma unroll
                    for (int t8 = 0; t8 < 6; ++t8) if (T0[tb] + t8 < T0[tb + 1]) {
                        if (T0[tb] + t8 < ntile) { f32x4 a = {0.f, 0.f, 0.f, 0.f};
                            a = __builtin_amdgcn_mfma_f32_16x16x32_bf16(kf[t8][0], qf[0], a, 0, 0, 0); a = __builtin_amdgcn_mfma_f32_16x16x32_bf16(kf[t8][1], qf[1], a, 0, 0, 0); sa[T0[tb] + t8] = a; }
                        else sa[T0[tb] + t8] = (f32x4){-1e30f, -1e30f, -1e30f, -1e30f};
                    }
                }
                float m = -1e30f;
#pragma unroll
                for (int t = 0; t < 16; ++t) m = fmaxf(m, fmaxf(fmaxf(sa[t].x, sa[t].y), fmaxf(sa[t].z, sa[t].w)));
                m = fmaxf(m, __shfl_xor(m, 16)); m = fmaxf(m, __shfl_xor(m, 32));
                const float sc2 = 0.125f * 1.4426950408889634f; float lsum = 0.f;
#pragma unroll
                for (int t = 0; t < 16; ++t) { sa[t].x = exp2f((sa[t].x - m) * sc2); sa[t].y = exp2f((sa[t].y - m) * sc2); sa[t].z = exp2f((sa[t].z - m) * sc2); sa[t].w = exp2f((sa[t].w - m) * sc2);
                    lsum += (sa[t].x + sa[t].y) + (sa[t].z + sa[t].w); }
                lsum += __shfl_xor(lsum, 16); lsum += __shfl_xor(lsum, 32);
                const float linv = 1.f / lsum;
                f32x4 oacc[4] = {{0.f, 0.f, 0.f, 0.f}, {0.f, 0.f, 0.f, 0.f}, {0.f, 0.f, 0.f, 0.f}, {0.f, 0.f, 0.f, 0.f}};
                const int q4 = n16 >> 2, p4 = n16 & 3;
#pragma unroll
                for (int ch = 0; ch < 4; ++ch) {
                    if (ch * 4 < ntile) {
                        if ((ch + 1) * 4 < ntile) asm volatile("s_waitcnt vmcnt(8)" ::: "memory");
                        else asm volatile("s_waitcnt vmcnt(0)" ::: "memory");
#pragma unroll
                        for (int sl = 0; sl < 2; ++sl) {
                            const int s = ch * 2 + sl;
                            u32x4 pw; pw.x = pk2(sa[2 * s].x, sa[2 * s].y); pw.y = pk2(sa[2 * s].z, sa[2 * s].w); pw.z = pk2(sa[2 * s + 1].x, sa[2 * s + 1].y); pw.w = pk2(sa[2 * s + 1].z, sa[2 * s + 1].w);
                            const bf16x8 pb = __builtin_bit_cast(bf16x8, pw);
#pragma unroll
                            for (int mt = 0; mt < 4; ++mt) {
                                const int P0 = 32 * sl + 4 * kg + q4, P1 = P0 + 16;
                                const LAS unsigned char* a0 = vst + (ch & 1) * 8192 + P0 * 128 + (((2 * mt + (p4 >> 1)) ^ (2 * ((P0 >> 1) & 3))) * 16) + 8 * (p4 & 1);
                                const LAS unsigned char* a1 = vst + (ch & 1) * 8192 + P1 * 128 + (((2 * mt + (p4 >> 1)) ^ (2 * ((P1 >> 1) & 3))) * 16) + 8 * (p4 & 1);
                                const s16x4 lo = __builtin_bit_cast(s16x4, __builtin_amdgcn_ds_read_tr16_b64_v4i16((LAS s16x4*)a0));
                                const s16x4 hi4 = __builtin_bit_cast(s16x4, __builtin_amdgcn_ds_read_tr16_b64_v4i16((LAS s16x4*)a1));
                                const bf16x8 va = (bf16x8){lo[0], lo[1], lo[2], lo[3], hi4[0], hi4[1], hi4[2], hi4[3]};
                                oacc[mt] = __builtin_amdgcn_mfma_f32_16x16x32_bf16(va, pb, oacc[mt], 0, 0, 0);
                            }
                        }
                        asm volatile("s_waitcnt lgkmcnt(0)" ::: "memory");
                        if (ch + 2 < 4 && (ch + 2) * 4 < ntile) DSA_VDMA(ch + 2, ch & 1);
                    }
                }
#undef DSA_VDMA
                if (n16 < 6) {
                    bf16_t* op = F.H() + (size_t)tq * DM + 256 + n16 * 64 + 4 * kg;
#pragma unroll
                    for (int mt = 0; mt < 4; ++mt) { u32x2 o; o.x = pk2(oacc[mt].x * linv, oacc[mt].y * linv); o.y = pk2(oacc[mt].z * linv, oacc[mt].w * linv); *(u32x2*)(op + 16 * mt) = o; }
                }
            }
            __syncthreads();
        }
    }
}

__global__ void __launch_bounds__(NTHREADS, 2) mk_fwd(Args args) {
    extern __shared__ __attribute__((aligned(16))) unsigned char lds_raw[];
    Frame F;
    F.lds = (LAS unsigned char*)lds_raw;
    F.tid = threadIdx.x; F.lane = F.tid & 63; F.wave = __builtin_amdgcn_readfirstlane(F.tid >> 6);
    F.G = gridDim.x; F.bid = blockIdx.x; F.wsb = args.ws; F.zo = 0u;
    unsigned char* ws = args.ws;
#define INF(k) ((const float*)args.in[k])

    volatile LAS unsigned* MISC = (volatile LAS unsigned*)(F.lds + MISC_OFF);
    if (F.tid < 64) MISC[F.tid] = 0u;
    __syncthreads();
    XcdBarrier bar = xcd_barrier_post((unsigned*)(ws + WS_CTL) + CW_BAR, MISC + 8);
    cg::grid_group grid = cg::this_grid();
    int ph = 0; const int lo = args.ph_lo, hi = args.ph_hi;
    unsigned long long* TSp = (unsigned long long*)(ws + WS_CTL + 32768); int nst = 0; (void)TSp; (void)nst;
    bool first_seam = true;
#ifndef DUP_MASK
#define DUP_MASK 0
#endif
#ifdef PROBE_LO
#define STAMP() do { if (F.bid == 0 && F.tid == 0) { TSp[nst] = __builtin_amdgcn_s_memrealtime(); } ++nst; } while (0)
#else
#define STAMP() do { } while (0)
#endif
#ifdef NO_CG
#define GRIDSYNC() xcd_barrier(bar, F.wave == 0 && (int)__builtin_amdgcn_mbcnt_hi(~0u, __builtin_amdgcn_mbcnt_lo(~0u, 0u)) == 0)
#else
#define GRIDSYNC() grid.sync()
#endif
#define RUN(...) do { if (ph >= lo && ph < hi) { F.lane = (int)__builtin_amdgcn_mbcnt_hi(~0u, __builtin_amdgcn_mbcnt_lo(~0u, 0u)); asm volatile("" : "+v"(F.lane), "+s"(F.zo), "+s"(F.bid), "+s"(F.G), "+s"(F.wave)); F.tid = F.wave * 64 + F.lane; __VA_ARGS__; } ++ph; } while (0)
#define SEAM() do { if (ph > lo && ph < hi) { if (first_seam) { GRIDSYNC(); first_seam = false; } else xcd_barrier(bar, F.wave == 0 && (int)__builtin_amdgcn_mbcnt_hi(~0u, __builtin_amdgcn_mbcnt_lo(~0u, 0u)) == 0); } STAMP(); } while (0)

    STAMP();
    RUN(phase_rope(F, (const int*)args.in[1])); STAMP();
#pragma unroll
    for (int l = 0; l < DEPTH; ++l) {
        const float* xin = (l == 0) ? INF(0) : args.out;
        RUN({ const ProIn I{xin, INF(2), INF(3), INF(15), INF(16), INF(17), INF(18), INF(20), INF(21), INF(12), INF(4), INF(5), INF(6), INF(7), INF(8), (const int*)args.in[1]};
              for (int rep = 0; rep < 1 + ((DUP_MASK >> 4) & 1); ++rep) { phase_prologue(F, l, I); __syncthreads(); } }); SEAM();
#ifndef NO_G1
        RUN({ pg8::Gemm g{F.H(), F.Win_t()}; pg8::StaticOrder<T, NINP> S; S.init(F.G, F.bid);
              pg8::EpiGen<FInProj> E{FInProj{F.ZS(), F.GB(), F.IW(), F.ROPE(), F.IKD()}}; for (int rep = 0; rep < 1 + (DUP_MASK & 1); ++rep) pg8::gemm_phase<T, NINP, DM, DM, DM>(F.lds, g, S, E, F.tid); }); SEAM();
#else
        RUN({}); SEAM();
#endif
        RUN({ for (int rep = 0; rep < 1 + ((DUP_MASK >> 2) & 1); ++rep) { phase_s5_local(F); __syncthreads(); } STAMP();
              for (int rep = 0; rep < 1 + ((DUP_MASK >> 3) & 1); ++rep) { phase_ret_local(F); __syncthreads(); } STAMP();
              for (int rep = 0; rep < 1 + ((DUP_MASK >> 1) & 1); ++rep) { phase_dsa(F); __syncthreads(); } }); SEAM();
        RUN(phase_carry(F)); SEAM();
        RUN({ for (int rep = 0; rep < 1 + ((DUP_MASK >> 2) & 1); ++rep) { phase_s5_out(F, l, INF(9), INF(10), INF(11)); __syncthreads(); } STAMP();
              for (int rep = 0; rep < 1 + ((DUP_MASK >> 3) & 1); ++rep) { phase_ret_out(F, l, INF(14)); __syncthreads(); } }); SEAM();
#ifndef NO_G2
        RUN({ pg8::Gemm g{F.H(), F.Wglu_t()}; pg8::StaticOrder<T, 256> S; S.init(F.G, F.bid);
              pg8::EpiGen<FGlu, 0> E{FGlu{F.H(), INF(13) + l * 256}}; pg8::gemm_phase<T, 256, 256, DM, 256>(F.lds, g, S, E, F.tid); }); SEAM();
#else
        RUN({}); SEAM();
#endif
#ifndef NO_G3
        RUN({ pg8::Gemm g{F.H(), F.Wabc_t()}; pg8::StaticOrder<T, DM> S; S.init(F.G, F.bid);
              EpiMerge E{F.MG(), F.GB()}; for (int rep = 0; rep < 1 + ((DUP_MASK >> 5) & 1); ++rep) pg8::gemm_phase<T, DM, DM, DM, DM>(F.lds, g, S, E, F.tid); }); SEAM();
#else
        RUN({}); SEAM();
#endif
#ifndef NO_G4
        RUN({ pg8::Gemm g{F.MG(), F.Wout_t()}; pg8::StaticOrder<T, DM> S; S.init(F.G, F.bid);
              pg8::EpiGen<FResid> E{FResid{xin, args.out}}; pg8::gemm_phase<T, DM, DM, DM, DM>(F.lds, g, S, E, F.tid); }); SEAM();
#else
        RUN({}); SEAM();
#endif
        RUN({ const int gw = F.bid * NWAVES + F.wave, NGW = F.G * NWAVES; const float* g2 = INF(19) + l * DM;
              for (int rep = 0; rep < 1 + ((DUP_MASK >> 4) & 1); ++rep) for (int m = gw; m < T; m += NGW) rms_row_bf16(args.out + (size_t)m * DM, g2, F.H() + (size_t)m * DM, F.lane); }); SEAM();
#ifndef NO_G5
        RUN({ pg8::Gemm g{F.H(), F.W1_t()}; pg8::StaticOrder<T, FF> S; S.init(F.G, F.bid);
              pg8::EpiGen<FRelu2> E{FRelu2{F.FB()}}; for (int rep = 0; rep < 1 + (DUP_MASK & 1); ++rep) pg8::gemm_phase<T, FF, DM, DM, DM>(F.lds, g, S, E, F.tid); }); SEAM();
#else
        RUN({}); SEAM();
#endif
#ifndef NO_G6
        RUN({ pg8::Gemm g{F.FB(), F.W2_t()}; pg8::StaticOrder<T, DM> S; S.init(F.G, F.bid);
              pg8::EpiGen<FResid> E{FResid{args.out, args.out}}; pg8::gemm_phase<T, DM, FF, FF, FF>(F.lds, g, S, E, F.tid); }); SEAM();
#else
        RUN({}); SEAM();
#endif
    }
    RUN({ const int gw = F.bid * NWAVES + F.wave, NGW = F.G * NWAVES; const float* gf = INF(22);
          for (int m = gw; m < T; m += NGW) rms_row_f32(args.out + (size_t)m * DM, gf, args.out + (size_t)m * DM, F.lane); });
    STAMP();
#ifdef PROBE_LO
    if (F.bid == 0 && F.tid == 0) {
        const int sel[] = PROBE_SEL; unsigned long long tot = 0;
        for (unsigned i = 0; i < sizeof(sel) / sizeof(int); ++i) tot += TSp[sel[i] + 1] - TSp[sel[i]];
        const float us = (float)tot * 0.01f;
        asm volatile("s_waitcnt vmcnt(0)" ::: "memory");
        args.out[0] = sqrtf(us * (float)((size_t)T * DM));
    }
#endif
#undef RUN
#undef SEAM
}

extern "C" void kernel_launch(void* const* d_in, const int* in_sizes, int n_in, void* d_out, int out_size, void* d_ws, size_t ws_size, hipStream_t stream) {
    static int grid = 0;
    if (grid == 0) {
        if (n_in != 23 || out_size != T * DM || ws_size < WS_END) { fprintf(stderr, "kernel_launch: unexpected shapes (n_in %d out %d ws %zu)\n", n_in, out_size, ws_size); grid = -1; return; }
        int dev = 0, cus = 0, per_cu = 0;
        hipGetDevice(&dev); hipDeviceGetAttribute(&cus, hipDeviceAttributeMultiprocessorCount, dev);
        if (hipFuncSetAttribute((const void*)mk_fwd, hipFuncAttributeMaxDynamicSharedMemorySize, LDS_BYTES) != hipSuccess) { fprintf(stderr, "kernel_launch: hipFuncSetAttribute failed\n"); grid = -1; return; }
        if (hipOccupancyMaxActiveBlocksPerMultiprocessor(&per_cu, (const void*)mk_fwd, NTHREADS, LDS_BYTES) != hipSuccess || per_cu < 1) { fprintf(stderr, "kernel_launch: occupancy query says %d\n", per_cu); per_cu = 1; }
        (void)hipGetLastError();
        grid = cus;
    }
    if (grid < 0) return;
    hipMemsetAsync((char*)d_ws + WS_CTL, 0, CTL_ZERO_BYTES, stream);
    Args a{};
    for (int i = 0; i < 23; ++i) a.in[i] = d_in[i];
    a.out = (float*)d_out; a.ws = (unsigned char*)d_ws;
#ifndef MK_SPLIT
    a.ph_lo = 0; a.ph_hi = 1000;
    void* kargs[] = {&a};
    hipError_t e = hipLaunchCooperativeKernel((const void*)mk_fwd, dim3(grid), dim3(NTHREADS), kargs, LDS_BYTES, stream);
    if (e != hipSuccess) fprintf(stderr, "kernel_launch: cooperative launch failed: %s\n", hipGetErrorString(e));
#else
    for (int p = 0; p < 2 * 11 + 2; ++p) { a.ph_lo = p; a.ph_hi = p + 1; hipLaunchKernelGGL(mk_fwd, dim3(grid), dim3(NTHREADS), LDS_BYTES, stream, a); }
#endif
}
```

```cpp
#include <hip/hip_runtime.h>
#include <hip/hip_cooperative_groups.h>
#include <cstdio>
#include <cstdint>
namespace cg = cooperative_groups;

#define LAS __attribute__((address_space(3)))
#define GAS __attribute__((address_space(1)))
typedef unsigned short bf16_t;
typedef short bf16x8 __attribute__((ext_vector_type(8)));
typedef float f32x4 __attribute__((ext_vector_type(4)));
typedef float f32x2 __attribute__((ext_vector_type(2)));
typedef unsigned u32x4 __attribute__((ext_vector_type(4)));
typedef unsigned u32x2 __attribute__((ext_vector_type(2)));

constexpr int NB = 4, SEQ = 8192, T = NB * SEQ, DM = 1024, DEPTH = 2, FF = 4096;
constexpr int NIN = 5156, NINP = 5376;
constexpr int ZSW = 2112, GW = 3072;
constexpr int ZU = 0, ZDQ = 256, ZDK = 640, ZDV = 704, ZIQ = 768, ZIK = 896, ZIWC = 928, ZRQ = 960, ZRK = 1152, ZRV = 1344, ZRG = 1728, ZGATE = 2112, ZEND = 5184;
constexpr int NFREQ = 36;
constexpr float EPS = 1e-6f;

constexpr size_t MiB = 1u << 20;
constexpr size_t WS_CTL = 0, CTL_ZERO_BYTES = 64 * 1024;
constexpr size_t WS_IW = 1 * MiB;
constexpr size_t WS_SP = 1 * MiB + 512 * 1024;
constexpr size_t WS_ROPE = 2 * MiB;
constexpr size_t WS_S5E = 11 * MiB;
constexpr size_t WS_RST = 15 * MiB;
constexpr size_t WS_W = 51 * MiB;
constexpr size_t WO_IN = 0, WO_ABC = WO_IN + (size_t)NINP * DM * 2, WO_OUT = WO_ABC + (size_t)DM * DM * 2, WO_W1 = WO_OUT + (size_t)DM * DM * 2,
                 WO_W2 = WO_W1 + (size_t)FF * DM * 2, WO_GLU = WO_W2 + (size_t)FF * DM * 2, WO_END = WO_GLU + 256 * 256 * 2;
static_assert(WO_END <= 31 * MiB, "weights");
constexpr size_t WS_H = 82 * MiB;
constexpr size_t WS_ZS = 146 * MiB;
constexpr size_t WS_G = 278 * MiB;
constexpr size_t WS_IKD = 470 * MiB;
constexpr size_t WS_END = 472 * MiB;
static_assert(WS_ZS + (size_t)T * ZSW * 2 <= WS_G && WS_G + (size_t)T * GW * 2 <= WS_END && WS_ZS + (size_t)T * FF * 2 <= WS_END, "ws map");
constexpr int CW_BAR = 1024;

constexpr int LDS_BYTES = 160 * 1024;
constexpr int RING_BYTES = 131072;
constexpr int MISC_OFF = LDS_BYTES - 256;

__device__ __forceinline__ unsigned f2bf(float f) { unsigned u = __builtin_bit_cast(unsigned, f); return (u + 0x7fffu + ((u >> 16) & 1u)) >> 16; }
__device__ __forceinline__ unsigned pk2(float lo, float hi) { unsigned r; asm("v_cvt_pk_bf16_f32 %0, %1, %2" : "=v"(r) : "v"(lo), "v"(hi)); return r; }
__device__ __forceinline__ float bf2f(unsigned short v) { return __builtin_bit_cast(float, (unsigned)v << 16); }
__device__ __forceinline__ float bflo(unsigned w) { return __builtin_bit_cast(float, w << 16); }
__device__ __forceinline__ float bfhi(unsigned w) { return __builtin_bit_cast(float, w & 0xffff0000u); }
__device__ __forceinline__ float sigmoidf_(float x) { return 1.0f / (1.0f + __expf(-x)); }
__device__ __forceinline__ float wave_sum(float v) {
#pragma unroll
    for (int o = 1; o < 64; o <<= 1) v += __shfl_xor(v, o);
    return v;
}
__device__ __forceinline__ float wave_max(float v) {
#pragma unroll
    for (int o = 1; o < 64; o <<= 1) v = fmaxf(v, __shfl_xor(v, o));
    return v;
}

#define XB_TMO      128
#define XB_XCNT(j)  (256  + 64 * (j))
#define XB_XSUB(j)  (1280 + 64 * (j))
#define XB_XGEN(j)  (2304 + 64 * (j))
#define XB_TOP      3328
#define XB_TOPGEN   3392
#define XCD_BAR_WORDS 3456
#define XB_SPIN_CAP (1u << 18)
__device__ __forceinline__ unsigned xb_ld(unsigned* p)              { return __hip_atomic_load(p, __ATOMIC_RELAXED, __HIP_MEMORY_SCOPE_AGENT); }
__device__ __forceinline__ unsigned xb_add(unsigned* p, unsigned v) { return __hip_atomic_fetch_add(p, v, __ATOMIC_RELAXED, __HIP_MEMORY_SCOPE_AGENT); }
__device__ __forceinline__ unsigned xb_xcc_id() { return (unsigned)__builtin_amdgcn_s_getreg((3 << 11) | 20) & 0xFu; }
#define XB_SPIN(cond, bar) do { unsigned _sp = 0; while (cond) { __builtin_amdgcn_s_sleep(1); \
    if ((++_sp & 255u) == 0u) { if (xb_ld(&(bar)[XB_TMO])) break; if (_sp > XB_SPIN_CAP) { atomicAdd(&(bar)[XB_TMO], 1u); break; } } } } while (0)
struct XcdBarrier { unsigned* bar; unsigned x; volatile LAS unsigned* st; };
__device__ __forceinline__ XcdBarrier xcd_barrier_post(unsigned* bar, volatile LAS unsigned* st) {
    XcdBarrier b; b.bar = bar; b.x = xb_xcc_id(); b.st = st;
    if (threadIdx.x == 0) (void)xb_add(&bar[XB_XCNT(b.x)], 1u);
    return b;
}
__device__ __forceinline__ void xcd_barrier_complete(unsigned* bar, unsigned x, unsigned& nloc, unsigned& nx) {
    const unsigned G = gridDim.x * gridDim.y * gridDim.z;
    unsigned sum, cnt, mine, sp = 0u;
    for (;;) {
        sum = 0u; cnt = 0u; mine = 0u;
#pragma unroll
        for (unsigned j = 0; j < 16; ++j) { const unsigned c = xb_ld(&bar[XB_XCNT(j)]); sum += c; cnt += (c > 0u) ? 1u : 0u; mine = (j == x) ? c : mine; }
        if (sum == G) break;
        __builtin_amdgcn_s_sleep(1);
        if ((++sp & 255u) == 0u) { if (xb_ld(&bar[XB_TMO])) break; if (sp > XB_SPIN_CAP) { atomicAdd(&bar[XB_TMO], 1u); break; } }
    }
    nloc = mine > 0u ? mine : 1u; nx = cnt > 0u ? cnt : 1u;
}
__device__ __forceinline__ void xcd_barrier(const XcdBarrier& b, bool leader) {
    asm volatile("s_waitcnt vmcnt(0)" ::: "memory");
    __syncthreads();
    if (leader) {
        unsigned* bar = b.bar; unsigned bx = b.x;
        asm volatile("" : "+s"(bar), "+s"(bx));
        __builtin_amdgcn_s_waitcnt(0);
        unsigned nloc = b.st[0], nx = b.st[1];
        if (nloc == 0u) { xcd_barrier_complete(bar, bx, nloc, nx); b.st[0] = nloc; b.st[1] = nx; }
        const unsigned old = xb_add(&bar[XB_XSUB(bx)], 1u);
        const unsigned gen = old / nloc;
        if (old + 1u == (gen + 1u) * nloc) {
            __builtin_amdgcn_fence(__ATOMIC_RELEASE, "agent");
            asm volatile("s_waitcnt vmcnt(0)" ::: "memory");
            const unsigned og = xb_add(&bar[XB_TOP], 1u);
            const unsigned tg = og / nx;
            if (og + 1u == (tg + 1u) * nx) xb_add(&bar[XB_TOPGEN], 1u);
            else XB_SPIN(xb_ld(&bar[XB_TOPGEN]) == tg, bar);
            __builtin_amdgcn_fence(__ATOMIC_ACQUIRE, "agent");
            xb_add(&bar[XB_XGEN(bx)], 1u);
            asm volatile("s_waitcnt vmcnt(0)" ::: "memory");
        } else {
            XB_SPIN(xb_ld(&bar[XB_XGEN(bx)]) == gen, bar);
            __builtin_amdgcn_fence(__ATOMIC_ACQUIRE, "agent");
            asm volatile("s_waitcnt vmcnt(0)" ::: "memory");
        }
    }
    __syncthreads();
}

namespace pg8 {
constexpr int BM = 256, BK = 64, HALF = 128, HTB = HALF * BK * 2, STAGE_BYTES = 8 * HTB, NXCD = 8, WGM = 8;
__host__ __device__ __forceinline__ int lds_byte(int r, int c) { const int st = (r >> 4) * 2 + (c >> 5), rr = r & 15, cc = c & 31, ob = rr * 64 + cc * 2; return st * 1024 + (ob ^ (((ob >> 9) & 1) << 5)); }
__host__ __device__ __forceinline__ void stage_rc(int b, int& R, int& C) { const int st = b / 1024, sb = b % 1024, swz = sb ^ (((sb >> 9) & 1) << 5); R = (st >> 1) * 16 + swz / 64; C = (st & 1) * 32 + (swz % 64) / 2; }
__host__ __device__ __forceinline__ int perm32(int rho) { const int n = rho >> 4, i = rho & 15; return 8 * (i >> 2) + 4 * n + (i & 3); }

struct Unit { int pm, pn; };
struct Gemm { const bf16_t* A; const bf16_t* Bt; };

template <int M, int N> struct StaticOrder {
    static constexpr int nM = M / BM, nN = N / BM, nwg = nM * nN;
    int G, c;
    __host__ __device__ void init(int G_, int c_) { G = G_; c = c_; }
    __host__ __device__ bool next(int i, Unit& u) const {
        const long L = (long)i * G + c; if (L >= nwg) return false;
        int wgid = (int)L; { constexpr int q = nwg / NXCD, r = nwg % NXCD; const int xcd = wgid % NXCD, off = wgid / NXCD; wgid = (xcd < r ? xcd * (q + 1) : r * (q + 1) + (xcd - r) * q) + off; }
        constexpr int nig = WGM * nN; const int gid = wgid / nig, fm = gid * WGM, gsz = (nM - fm) < WGM ? (nM - fm) : WGM;
        u.pm = fm + ((wgid % nig) % gsz); u.pn = (wgid % nig) / gsz; return true;
    }
};

template <class F, int FENCE = 0> struct EpiGen {
    static constexpr bool PERM = true, HAS_MID = false;
    F f;
    __device__ __forceinline__ void operator()(const f32x4 (&acc)[2][2][4][2], const Unit& u, int wr, int wc, int fr, int fq) const {
        const int row0 = u.pm * BM + wr * 64 + fr, col0 = u.pn * BM + wc * 32 + 8 * fq;
#pragma unroll
        for (int ai = 0; ai < 2; ++ai)
#pragma unroll
            for (int m = 0; m < 4; ++m)
#pragma unroll
                for (int bj = 0; bj < 2; ++bj) { f(row0 + ai * HALF + m * 16, col0 + bj * HALF, acc[ai][bj][m][0], acc[ai][bj][m][1]);
                    if constexpr (FENCE > 0) { if (((ai * 4 + m) * 2 + bj) % FENCE == FENCE - 1) asm volatile("" ::: "memory"); } }
    }
};

template <int M, int N, int K, int LDA, int LDB, class Epi, bool ALIGN_EPI = true>
__device__ __forceinline__ void gemm_phase(LAS unsigned char* lds, const Gemm g, const StaticOrder<M, N>& S, const Epi& E, int tid_in) {
    int tid = tid_in; asm volatile("" : "+v"(tid));
    const int wid = __builtin_amdgcn_readfirstlane(tid >> 6), lane = tid & 63, wr = wid >> 2, wc = wid & 3, fr = lane & 15, fq = lane >> 4;
    constexpr int nt = K / BK;
    unsigned voffA[2], voffB[2];
#pragma unroll
    for (int i = 0; i < 2; ++i) { int R, C; stage_rc(tid * 16 + i * 8192, R, C); const int Rb = Epi::PERM ? ((R & ~31) + perm32(R & 31)) : R;
        voffA[i] = (unsigned)(R * LDA + C) * 2u; voffB[i] = (unsigned)(Rb * LDB + C) * 2u; }
    constexpr size_t kstep = (size_t)(BK * 2);
    constexpr size_t hstepA = (size_t)HALF * LDA * 2, hstepB = (size_t)HALF * LDB * 2;
    constexpr size_t tstepA = 2 * hstepA, tstepB = 2 * hstepB;
    const unsigned ldsw = (unsigned)wid * 1024u;
    const int aoff = lds_byte(wr * 64 + fr, fq * 8), boff = lds_byte(wc * 32 + fr, fq * 8);
#define PG8_SA(b, h) (((b) * 2 + (h)) * HTB)
#define PG8_SB(b, h) ((4 + (b) * 2 + (h)) * HTB)
#define PG8_STAGE(bufoff, gbase, voff) do { _Pragma("unroll") for (int _i = 0; _i < 2; ++_i) \
        __builtin_amdgcn_global_load_lds((const unsigned*)((const char*)(gbase) + (voff)[_i]), (LAS unsigned*)(lds + (bufoff) + ldsw + _i * 8192), 16, 0, 0); } while (0)
#define PG8_LDA(dst, b, h) do { _Pragma("unroll") for (int m = 0; m < 4; ++m) _Pragma("unroll") for (int k = 0; k < 2; ++k) dst[m][k] = *(const LAS bf16x8*)(lds + PG8_SA(b, h) + aoff + m * 2048 + k * 1024); } while (0)
#define PG8_LDB(dst, b, h) do { _Pragma("unroll") for (int n = 0; n < 2; ++n) _Pragma("unroll") for (int k = 0; k < 2; ++k) dst[n][k] = *(const LAS bf16x8*)(lds + PG8_SB(b, h) + boff + n * 2048 + k * 1024); } while (0)
#define PG8_MMA(ai, bj, At, Bt) do { __builtin_amdgcn_s_setprio(1); _Pragma("unroll") for (int m = 0; m < 4; ++m) _Pragma("unroll") for (int n = 0; n < 2; ++n) _Pragma("unroll") for (int k = 0; k < 2; ++k) \
        acc[ai][bj][m][n] = __builtin_amdgcn_mfma_f32_16x16x32_bf16(Bt[n][k], At[m][k], acc[ai][bj][m][n], 0, 0, 0); __builtin_amdgcn_s_setprio(0); } while (0)
#define PG8_WAIT_V(n) asm volatile("s_waitcnt vmcnt(" #n ")" ::: "memory")
#define PG8_WAIT_L(n) asm volatile("s_waitcnt lgkmcnt(" #n ")" ::: "memory")
#define PG8_BAR __builtin_amdgcn_s_barrier()
#define PG8_SCHED __builtin_amdgcn_sched_barrier(0)
    Unit cur, nxt; int ui = 0;
    if (!S.next(0, cur)) return;
    f32x4 acc[2][2][4][2];
#pragma unroll
    for (int a = 0; a < 2; ++a)
#pragma unroll
        for (int b = 0; b < 2; ++b)
#pragma unroll
            for (int m = 0; m < 4; ++m)
#pragma unroll
                for (int n = 0; n < 2; ++n) acc[a][b][m][n] = (f32x4){0.f, 0.f, 0.f, 0.f};
    bf16x8 At[4][2], B0[2][2], B1[2][2];
    const char* cA = (const char*)g.A + (size_t)cur.pm * tstepA; const char* cB = (const char*)g.Bt + (size_t)cur.pn * tstepB;
    PG8_STAGE(PG8_SB(0, 0), cB, voffB); PG8_STAGE(PG8_SB(0, 1), cB + hstepB, voffB); PG8_STAGE(PG8_SA(0, 0), cA, voffA); PG8_STAGE(PG8_SA(0, 1), cA + hstepA, voffA);
    if (wr == 1) PG8_BAR;
    PG8_WAIT_V(2); PG8_BAR;
    PG8_STAGE(PG8_SB(1, 0), cB + kstep, voffB); PG8_STAGE(PG8_SA(1, 0), cA + kstep, voffA); PG8_STAGE(PG8_SB(1, 1), cB + hstepB + kstep, voffB);
    PG8_WAIT_V(6); PG8_BAR;
    for (;;) {
        const bool has_next = S.next(ui + 1, nxt);
        const char* nA = has_next ? (const char*)g.A + (size_t)nxt.pm * tstepA : cA; const char* nB = has_next ? (const char*)g.Bt + (size_t)nxt.pn * tstepB : cB;
#pragma unroll 1
        for (int t = 0; t < nt; t += 2) {
            const bool last = (t == nt - 2);
            const char* a1 = cA + (size_t)(t + 1) * kstep;
            const char* a2 = last ? nA : cA + (size_t)(t + 2) * kstep; const char* b2 = last ? nB : cB + (size_t)(t + 2) * kstep;
            const char* a3 = a2 + kstep; const char* b3 = b2 + kstep;
            if constexpr (Epi::HAS_MID) { if (t == Epi::MID0 || t == Epi::MID1) E.mid(acc, cur, t, wr, wc, fr, fq); }
            PG8_LDB(B0, 0, 0); PG8_LDB(B1, 0, 1); PG8_SCHED; PG8_LDA(At, 0, 0); PG8_STAGE(PG8_SA(1, 1), a1 + hstepA, voffA);
            PG8_WAIT_V(8); PG8_WAIT_L(0); PG8_BAR; PG8_MMA(0, 0, At, B0); PG8_MMA(0, 1, At, B1); PG8_BAR; PG8_SCHED;
            PG8_LDA(At, 0, 1); PG8_STAGE(PG8_SB(0, 0), b2, voffB); PG8_STAGE(PG8_SB(0, 1), b2 + hstepB, voffB); PG8_STAGE(PG8_SA(0, 0), a2, voffA);
            PG8_WAIT_V(8); PG8_WAIT_L(0); PG8_BAR; PG8_MMA(1, 0, At, B0); PG8_MMA(1, 1, At, B1); PG8_BAR; PG8_SCHED;
            PG8_LDB(B0, 1, 0); PG8_LDB(B1, 1, 1); PG8_SCHED; PG8_LDA(At, 1, 0); PG8_STAGE(PG8_SA(0, 1), a2 + hstepA, voffA);
            PG8_WAIT_V(8); PG8_WAIT_L(0); PG8_BAR; PG8_MMA(0, 0, At, B0); PG8_MMA(0, 1, At, B1); PG8_BAR; PG8_SCHED;
            PG8_LDA(At, 1, 1); PG8_STAGE(PG8_SB(1, 0), b3, voffB); PG8_STAGE(PG8_SB(1, 1), b3 + hstepB, voffB); PG8_STAGE(PG8_SA(1, 0), a3, voffA);
            PG8_WAIT_V(8); PG8_WAIT_L(0); PG8_BAR; PG8_MMA(1, 0, At, B0); PG8_MMA(1, 1, At, B1); PG8_BAR; PG8_SCHED;
        }
        if constexpr (ALIGN_EPI) { if (wr == 0) PG8_BAR; }
        E(acc, cur, wr, wc, fr, fq);
        if (!has_next) break;
#pragma unroll
        for (int a = 0; a < 2; ++a)
#pragma unroll
            for (int b = 0; b < 2; ++b)
#pragma unroll
                for (int m = 0; m < 4; ++m)
#pragma unroll
                    for (int n = 0; n < 2; ++n) acc[a][b][m][n] = (f32x4){0.f, 0.f, 0.f, 0.f};
        cur = nxt; cA = nA; cB = nB; ++ui;
        if constexpr (ALIGN_EPI) { if (wr == 1) PG8_BAR; }
    }
    PG8_WAIT_V(0);
    if constexpr (!ALIGN_EPI) { if (wr == 0) PG8_BAR; }
    PG8_BAR;
#undef PG8_SA
#undef PG8_SB
#undef PG8_STAGE
#undef PG8_LDA
#undef PG8_LDB
#undef PG8_MMA
#undef PG8_WAIT_V
#undef PG8_WAIT_L
#undef PG8_BAR
#undef PG8_SCHED
}
}

constexpr int NWAVES = 8, NTHREADS = 512;
struct Args { const void* in[23]; float* out; unsigned char* ws; int ph_lo, ph_hi; };
struct Frame {
    LAS unsigned char* lds;
    int tid, lane, wave, G, bid;
    unsigned char* wsb; unsigned zo;
    __device__ __forceinline__ bf16_t* IKD() const { return (bf16_t*)(wsb + zo + WS_IKD); }
    __device__ __forceinline__ float* IW() const { return (float*)(wsb + zo + WS_IW); }
    __device__ __forceinline__ float* SP() const { return (float*)(wsb + zo + WS_SP); }
    __device__ __forceinline__ f32x2* ROPE() const { return (f32x2*)(wsb + zo + WS_ROPE); }
    __device__ __forceinline__ f32x2* S5E() const { return (f32x2*)(wsb + zo + WS_S5E); }
    __device__ __forceinline__ float* RST() const { return (float*)(wsb + zo + WS_RST); }
    __device__ __forceinline__ bf16_t* Win_t() const { return (bf16_t*)(wsb + zo + WS_W + WO_IN); }
    __device__ __forceinline__ bf16_t* Wabc_t() const { return (bf16_t*)(wsb + zo + WS_W + WO_ABC); }
    __device__ __forceinline__ bf16_t* Wout_t() const { return (bf16_t*)(wsb + zo + WS_W + WO_OUT); }
    __device__ __forceinline__ bf16_t* W1_t() const { return (bf16_t*)(wsb + zo + WS_W + WO_W1); }
    __device__ __forceinline__ bf16_t* W2_t() const { return (bf16_t*)(wsb + zo + WS_W + WO_W2); }
    __device__ __forceinline__ bf16_t* Wglu_t() const { return (bf16_t*)(wsb + zo + WS_W + WO_GLU); }
    __device__ __forceinline__ bf16_t* H() const { return (bf16_t*)(wsb + zo + WS_H); }
    __device__ __forceinline__ bf16_t* ZS() const { return (bf16_t*)(wsb + zo + WS_ZS); }
    __device__ __forceinline__ unsigned char* GB() const { return wsb + zo + WS_G; }
    __device__ __forceinline__ bf16_t* MG() const { return (bf16_t*)(wsb + zo + WS_ZS); }
    __device__ __forceinline__ bf16_t* FB() const { return (bf16_t*)(wsb + zo + WS_ZS); }
};
constexpr int SP_LB = 0, SP_L64 = 2048, SP_BBR = 4096, SP_BBI = 4096 + 16384;

__device__ __forceinline__ int ropeperm(int j, int r) { const int half = r >> 1; return (j < r) ? ((j & 1) ? half + (j >> 1) : (j >> 1)) : j; }
__device__ __forceinline__ int zmap(int n) {
    if (n < ZDQ) return n;
    if (n < ZDK) { const int q = n - ZDQ, h = q >> 6, hc = q & 63; return 256 + h * 64 + ropeperm(hc, 16); }
    if (n < ZDV) return 640 + ropeperm(n - ZDK, 16);
    if (n < ZIQ) return 704 + (n - ZDV);
    if (n < ZIK) { const int q = n - ZIQ, h = q >> 5, hc = q & 31; return 768 + h * 32 + ropeperm(hc, 8); }
    if (n < ZIWC) return 896 + ropeperm(n - ZIK, 8);
    if (n < ZRQ) return (n - ZIWC) < 4 ? 928 + (n - ZIWC) : -1;
    if (n < ZRK) { const int q = n - ZRQ, h = q / 48, hc = q % 48; return 932 + h * 48 + ropeperm(hc, 48); }
    if (n < ZRV) { const int q = n - ZRK, h = q / 48, hc = q % 48; return 1124 + h * 48 + ropeperm(hc, 48); }
    if (n < ZRG) return 1316 + (n - ZRV);
    if (n < ZGATE) return 1700 + (n - ZRG);
    if (n < ZEND) return 2084 + (n - ZGATE);
    return -1;
}

__device__ __forceinline__ void tr_item(const float* W, int N, int kb, int nb, bf16_t* WT, int ldd, int koff, bool mapped, LAS float* scr, int lane) {
    const int k0 = 64 * kb, n0 = 32 * nb;
    const int c32 = lane & 31; int sc = n0 + c32; if (mapped) sc = zmap(sc);
#pragma unroll 8
    for (int i = 0; i < 32; ++i) { const int kk = 2 * i + (lane >> 5); scr[kk * 33 + c32] = (sc >= 0) ? W[(size_t)(k0 + kk) * N + sc] : 0.f; }
    asm volatile("s_waitcnt lgkmcnt(0)" ::: "memory");
    const int c = lane & 7;
#pragma unroll
    for (int j = 0; j < 4; ++j) { const int n = (lane >> 3) + 8 * j; const LAS float* s = scr + (8 * c) * 33 + n;
        u32x4 o; o.x = pk2(s[0 * 33], s[1 * 33]); o.y = pk2(s[2 * 33], s[3 * 33]); o.z = pk2(s[4 * 33], s[5 * 33]); o.w = pk2(s[6 * 33], s[7 * 33]);
        *(u32x4*)(WT + (size_t)(n0 + n) * ldd + koff + k0 + 8 * c) = o; }
    asm volatile("s_waitcnt lgkmcnt(0)" ::: "memory");
}

__device__ __forceinline__ void rms_row_bf16(const float* xrow, const float* gain, bf16_t* orow, int lane) {
    const f32x4* xr = (const f32x4*)xrow + lane; const f32x4* gr = (const f32x4*)gain + lane;
    f32x4 v[4]; float s = 0.f;
#pragma unroll
    for (int j = 0; j < 4; ++j) { v[j] = xr[64 * j]; s += (v[j].x * v[j].x + v[j].y * v[j].y) + (v[j].z * v[j].z + v[j].w * v[j].w); }
    const float rstd = rsqrtf(wave_sum(s) * (1.f / DM) + EPS);
    u32x2* o8 = (u32x2*)orow + lane;
#pragma unroll
    for (int j = 0; j < 4; ++j) { const f32x4 gg = gr[64 * j]; u32x2 w; w.x = pk2(v[j].x * rstd * gg.x, v[j].y * rstd * gg.y); w.y = pk2(v[j].z * rstd * gg.z, v[j].w * rstd * gg.w); o8[64 * j] = w; }
}
__device__ __forceinline__ void rms_row_f32(const float* xrow, const float* gain, float* orow, int lane) {
    const f32x4* xr = (const f32x4*)xrow + lane; const f32x4* gr = (const f32x4*)gain + lane;
    f32x4 v[4]; float s = 0.f;
#pragma unroll
    for (int j = 0; j < 4; ++j) { v[j] = xr[64 * j]; s += (v[j].x * v[j].x + v[j].y * v[j].y) + (v[j].z * v[j].z + v[j].w * v[j].w); }
    const float rstd = rsqrtf(wave_sum(s) * (1.f / DM) + EPS);
    f32x4* o = (f32x4*)orow + lane;
#pragma unroll
    for (int j = 0; j < 4; ++j) { const f32x4 gg = gr[64 * j]; o[64 * j] = v[j] * rstd * gg; }
}


__device__ __forceinline__ void phase_rope(Frame& F, const int* pos) {
    const int gt = F.bid * NTHREADS + F.tid, NT = F.G * NTHREADS;
    f32x2* RT = F.ROPE();
    for (int e = gt; e < T * NFREQ; e += NT) {
        const int tok = e / NFREQ, f = e % NFREQ;
        float lth, sc; int fi;
        if (f < 8) { lth = 13.122363377404328f; sc = 2.0f / 16.0f; fi = f; } else if (f < 12) { lth = 13.122363377404328f; sc = 2.0f / 8.0f; fi = f - 8; } else { lth = 9.210340371976184f; sc = 2.0f / 48.0f; fi = f - 12; }
        const float inv = expf(-lth * (float)fi * sc);
        const float p = (float)pos[tok];
        const float ang = p * inv;
        const float kq = rintf(ang * 0.15915494309189535f);
        float r = fmaf(-kq, 6.2831854820251465f, ang);
        r = fmaf(-kq, -1.7484555e-7f, r);
        RT[e] = (f32x2){cosf(r), sinf(r)};
    }
}

struct ProIn { const float *xin, *norm1_g, *w_in, *wa, *wb, *wc, *wo, *w1, *w2, *wg, *lam_re, *lam_im, *log_step, *b_re, *b_im; const int* pos; };
__device__ __forceinline__ void phase_prologue(Frame& F, int l, const ProIn& I) {
#ifdef NO_PHASE_PROLOGUE
    return;
#endif
    LAS float* scr = (LAS float*)(F.lds + F.wave * 16384);
    const int gw = F.bid * NWAVES + F.wave, NGW = F.G * NWAVES;
    constexpr int I_IN = 16 * (NINP / 32), I_A = 4 * 32, I_B = 6 * 32, I_C = 6 * 32, I_O = 16 * 32, I_1 = 16 * 128, I_2 = 64 * 32, I_G = 4 * 8;
    constexpr int NITEMS = I_IN + I_A + I_B + I_C + I_O + I_1 + I_2 + I_G;
    const float* w_in = I.w_in + (size_t)l * DM * NIN; const float* wa = I.wa + (size_t)l * 256 * DM; const float* wb = I.wb + (size_t)l * 384 * DM;
    const float* wc = I.wc + (size_t)l * 384 * DM; const float* wo = I.wo + (size_t)l * DM * DM; const float* w1 = I.w1 + (size_t)l * DM * FF;
    const float* w2 = I.w2 + (size_t)l * FF * DM; const float* wg = I.wg + (size_t)l * 256 * 256;
    for (int it = gw; it < NITEMS; it += NGW) {
        int r = it;
        if (r < I_IN) { tr_item(w_in, NIN, r / (NINP / 32), r % (NINP / 32), F.Win_t(), DM, 0, true, scr, F.lane); continue; } r -= I_IN;
        if (r < I_A) { tr_item(wa, DM, r / 32, r % 32, F.Wabc_t(), DM, 0, false, scr, F.lane); continue; } r -= I_A;
        if (r < I_B) { tr_item(wb, DM, r / 32, r % 32, F.Wabc_t(), DM, 256, false, scr, F.lane); continue; } r -= I_B;
        if (r < I_C) { tr_item(wc, DM, r / 32, r % 32, F.Wabc_t(), DM, 640, false, scr, F.lane); continue; } r -= I_C;
        if (r < I_O) { tr_item(wo, DM, r / 32, r % 32, F.Wout_t(), DM, 0, false, scr, F.lane); continue; } r -= I_O;
        if (r < I_1) { tr_item(w1, FF, r / 128, r % 128, F.W1_t(), DM, 0, false, scr, F.lane); continue; } r -= I_1;
        if (r < I_2) { tr_item(w2, DM, r / 32, r % 32, F.W2_t(), FF, 0, false, scr, F.lane); continue; } r -= I_2;
        tr_item(wg, 256, r / 8, r % 8, F.Wglu_t(), 256, 0, false, scr, F.lane);
    }
    {
        const int gt = F.bid * NTHREADS + F.tid;
        if (gt < 1024) {
            float* SPp = F.SP();
            const int g = gt >> 6, p = gt & 63;
            const float lr = I.lam_re[(l * 16 + g) * 64 + p], li = I.lam_im[(l * 16 + g) * 64 + p];
            const float step = expf(I.log_step[l * 16 + g]);
            const float mag = expf(lr * step); const float lbr = mag * cosf(li * step), lbi = mag * sinf(li * step);
            const float den = lr * lr + li * li;
            const float fr = ((lbr - 1.f) * lr + lbi * li) / den, fi = (lbi * lr - (lbr - 1.f) * li) / den;
            SPp[SP_LB + gt * 2] = lbr; SPp[SP_LB + gt * 2 + 1] = lbi;
            float pr = lbr, pi = lbi;
#pragma unroll
            for (int s = 0; s < 6; ++s) { const float nr = pr * pr - pi * pi, ni = 2.f * pr * pi; pr = nr; pi = ni; }
            SPp[SP_L64 + gt * 2] = pr; SPp[SP_L64 + gt * 2 + 1] = pi;
            const float* br = I.b_re + ((size_t)(l * 16 + g) * 64 + p) * 16; const float* bi = I.b_im + ((size_t)(l * 16 + g) * 64 + p) * 16;
#pragma unroll
            for (int c = 0; c < 16; ++c) { SPp[SP_BBR + gt * 16 + c] = fr * br[c] - fi * bi[c]; SPp[SP_BBI + gt * 16 + c] = fr * bi[c] + fi * br[c]; }
        }
    }
    for (int m = gw; m < T; m += NGW) rms_row_bf16(I.xin + (size_t)m * DM, I.norm1_g + l * DM, F.H() + (size_t)m * DM, F.lane);
}

__device__ __forceinline__ u32x4 pack8(const f32x4& a, const f32x4& b) { u32x4 w; w.x = pk2(a.x, a.y); w.y = pk2(a.z, a.w); w.z = pk2(b.x, b.y); w.w = pk2(b.z, b.w); return w; }
__device__ __forceinline__ void unpack8(const u32x4& w, f32x4& a, f32x4& b) { a = (f32x4){bflo(w.x), bfhi(w.x), bflo(w.y), bfhi(w.y)}; b = (f32x4){bflo(w.z), bfhi(w.z), bflo(w.w), bfhi(w.w)}; }

__device__ __forceinline__ unsigned gate1_u8(float x) { const float s = 255.f * sigmoidf_(x) + 0.5f; const unsigned u = (unsigned)s; return u < 1u ? 1u : u; }
__device__ __forceinline__ unsigned gate4_u8(const f32x4& a) { return gate1_u8(a.x) | (gate1_u8(a.y) << 8) | (gate1_u8(a.z) << 16) | (gate1_u8(a.w) << 24); }
__device__ __forceinline__ void ungate8(const u32x2& w, f32x4& a, f32x4& b) {
    a = (f32x4){(float)(w.x & 255u), (float)((w.x >> 8) & 255u), (float)((w.x >> 16) & 255u), (float)(w.x >> 24)};
    b = (f32x4){(float)(w.y & 255u), (float)((w.y >> 8) & 255u), (float)((w.y >> 16) & 255u), (float)(w.y >> 24)};
}
struct FInProj {
    bf16_t* ZS; unsigned char* GB; float* IW; const f32x2* ROPE; bf16_t* IKD;
    __device__ __forceinline__ void rope8(f32x4& a, f32x4& b, int row, int f0) const {
        const f32x2* rt = ROPE + (size_t)row * NFREQ + f0;
        const f32x2 c0 = rt[0], c1 = rt[1], c2 = rt[2], c3 = rt[3];
        f32x4 oa, ob;
        oa.x = a.x * c0.x - a.y * c0.y; oa.y = a.y * c0.x + a.x * c0.y;
        oa.z = a.z * c1.x - a.w * c1.y; oa.w = a.w * c1.x + a.z * c1.y;
        ob.x = b.x * c2.x - b.y * c2.y; ob.y = b.y * c2.x + b.x * c2.y;
        ob.z = b.z * c3.x - b.w * c3.y; ob.w = b.w * c3.x + b.z * c3.y;
        a = oa; b = ob;
    }
    __device__ __forceinline__ void operator()(int row, int col, f32x4 a, f32x4 b) const {
        if (col >= ZEND) return;
        if (col >= ZGATE) {
            *(u32x2*)(GB + (size_t)row * GW + (col - ZGATE)) = (u32x2){gate4_u8(a), gate4_u8(b)}; return;
        }
        if (col >= ZIWC && col < ZRQ) { if (col == ZIWC) *(f32x4*)(IW + (size_t)row * 4) = a; return; }
        if (col >= ZDQ && col < ZDV) { const int hc = (col - ZDQ) & 63; if (hc < 16) rope8(a, b, row, hc >> 1); }
        else if (col >= ZIQ && col < ZIWC) { const int hc = (col - ZIQ) & 31; if (hc < 8) rope8(a, b, row, 8);
            if (col >= ZIK) { *(u32x4*)(IKD + ((size_t)((row >> 5) * 4 + ((col - ZIK) >> 3)) * 32 + (row & 31)) * 8) = pack8(a, b); return; } }
        else if (col >= ZRQ && col < ZRV) { const int hc = (col - ZRQ) % 48; rope8(a, b, row, 12 + (hc >> 1)); }
        *(u32x4*)(ZS + (size_t)row * ZSW + col) = pack8(a, b);
    }
};
struct FMerge {
    bf16_t* MG; const bf16_t* GB; int br;
    __device__ __forceinline__ void operator()(int row, int col, f32x4 a, f32x4 b) const {
        f32x4 ga, gb; unpack8(*(const u32x4*)(GB + (size_t)row * GW + br * DM + col), ga, gb);
        a = a * ga; b = b * gb;
        u32x4* mp = (u32x4*)(MG + (size_t)row * DM + col);
        if (br != 0) { f32x4 pa, pb; unpack8(*mp, pa, pb); a = a + pa; b = b + pb; }
        *mp = pack8(a, b);
    }
};
struct FResid {
    const float* base; float* out;
    __device__ __forceinline__ void operator()(int row, int col, f32x4 a, f32x4 b) const {
        const f32x4* bp = (const f32x4*)(base + (size_t)row * DM + col); f32x4* op = (f32x4*)(out + (size_t)row * DM + col);
        const f32x4 b0 = bp[0], b1 = bp[1]; op[0] = b0 + a; op[1] = b1 + b;
    }
};
struct FRelu2 {
    bf16_t* FB;
    __device__ __forceinline__ void operator()(int row, int col, f32x4 a, f32x4 b) const {
        a = (f32x4){fmaxf(a.x, 0.f), fmaxf(a.y, 0.f), fmaxf(a.z, 0.f), fmaxf(a.w, 0.f)}; b = (f32x4){fmaxf(b.x, 0.f), fmaxf(b.y, 0.f), fmaxf(b.z, 0.f), fmaxf(b.w, 0.f)};
        *(u32x4*)(FB + (size_t)row * FF + col) = pack8(a * a, b * b);
    }
};
struct FGlu {
    bf16_t* H; const float* bias;
    __device__ __forceinline__ void operator()(int row, int col, f32x4 a, f32x4 b) const {
        u32x4* hp = (u32x4*)(H + (size_t)row * DM + col); f32x4 ya, yb; unpack8(*hp, ya, yb);
        const f32x4 ba = *(const f32x4*)(bias + col), bb = *(const f32x4*)(bias + col + 4);
        a = a + ba; b = b + bb;
        a = (f32x4){ya.x * sigmoidf_(a.x), ya.y * sigmoidf_(a.y), ya.z * sigmoidf_(a.z), ya.w * sigmoidf_(a.w)};
        b = (f32x4){yb.x * sigmoidf_(b.x), yb.y * sigmoidf_(b.y), yb.z * sigmoidf_(b.z), yb.w * sigmoidf_(b.w)};
        *hp = pack8(a, b);
    }
};

struct EpiMerge {
    static constexpr bool PERM = true, HAS_MID = true; static constexpr int MID0 = 4, MID1 = 10;
    bf16_t* MG; const unsigned char* GB;
    __device__ __forceinline__ void mid(f32x4 (&acc)[2][2][4][2], const pg8::Unit& u, int t, int wr, int wc, int fr, int fq) const {
        int zz = 0; asm volatile("" : "+v"(zz));
        const int row0 = u.pm * 256 + wr * 64 + fr + zz, col0 = u.pn * 256 + wc * 32 + 8 * fq, bp = (t == MID0) ? 0 : 1;
#pragma unroll
        for (int ai = 0; ai < 2; ++ai)
#pragma unroll
            for (int m = 0; m < 4; ++m) {
#pragma unroll
                for (int bj = 0; bj < 2; ++bj) {
                    const unsigned char* gp = GB + (size_t)(row0 + ai * 128 + m * 16) * GW + bp * DM + col0 + bj * 128;
                    f32x4 pa, pb, na, nb; ungate8(*(const u32x2*)gp, pa, pb); ungate8(*(const u32x2*)(gp + DM), na, nb);
                    const f32x4 fa = {pa.x * __builtin_amdgcn_rcpf(na.x), pa.y * __builtin_amdgcn_rcpf(na.y), pa.z * __builtin_amdgcn_rcpf(na.z), pa.w * __builtin_amdgcn_rcpf(na.w)};
                    const f32x4 fb = {pb.x * __builtin_amdgcn_rcpf(nb.x), pb.y * __builtin_amdgcn_rcpf(nb.y), pb.z * __builtin_amdgcn_rcpf(nb.z), pb.w * __builtin_amdgcn_rcpf(nb.w)};
                    acc[ai][bj][m][0] = acc[ai][bj][m][0] * fa; acc[ai][bj][m][1] = acc[ai][bj][m][1] * fb;
                }
                if (m == 3) asm volatile("" ::: "memory");
            }
    }
    __device__ __forceinline__ void operator()(const f32x4 (&acc)[2][2][4][2], const pg8::Unit& u, int wr, int wc, int fr, int fq) const {
        const int row0 = u.pm * 256 + wr * 64 + fr, col0 = u.pn * 256 + wc * 32 + 8 * fq;
#pragma unroll
        for (int ai = 0; ai < 2; ++ai)
#pragma unroll
            for (int m = 0; m < 4; ++m)
#pragma unroll
                for (int bj = 0; bj < 2; ++bj) {
                    const int row = row0 + ai * 128 + m * 16, col = col0 + bj * 128;
                    f32x4 ga, gb; ungate8(*(const u32x2*)(GB + (size_t)row * GW + 2 * DM + col), ga, gb);
                    *(u32x4*)(MG + (size_t)row * DM + col) = pack8(acc[ai][bj][m][0] * (ga * (1.f / 255.f)), acc[ai][bj][m][1] * (gb * (1.f / 255.f)));
                }
    }
};

typedef float f32x16 __attribute__((ext_vector_type(16)));
__device__ __forceinline__ float gelu_tanh(float x) { const float u = 0.7978845608028654f * (x + 0.044715f * x * x * x); const float e = __expf(2.f * u); const float th = 1.f - 2.f / (e + 1.f); return 0.5f * x * (1.f + th); }
constexpr int S5_XSTR = 272;
constexpr int S5_WAVE_LDS = 2 * 16 * S5_XSTR;
template <bool OUT>
__device__ __forceinline__ void s5_pass(Frame& F, int l, const float* c_re, const float* c_im, const float* ssm_d) {
    const bf16_t* ZSp = F.ZS(); const float* SPp = F.SP(); f32x2* S5Ep = F.S5E();
    LAS unsigned char* XL = F.lds + F.wave * S5_WAVE_LDS;
    for (int task = F.bid * NWAVES + F.wave; task < 256 * 16; task += F.G * NWAVES) {
        int lane = F.lane; asm volatile("" : "+v"(lane));
        const int n = lane & 31, hh = lane >> 5, l15 = lane & 15, kg = lane >> 4;
        const int g = task & 15, pp = task >> 4, cmine = 2 * pp + hh;
        bf16x8 bbf[2][2];
#pragma unroll
        for (int st = 0; st < 2; ++st) { const float* br = SPp + SP_BBR + (size_t)(g * 64 + 2 * n + st) * 16 + 8 * hh; const float* bi = SPp + SP_BBI + (size_t)(g * 64 + 2 * n + st) * 16 + 8 * hh;
            bbf[st][0] = __builtin_bit_cast(bf16x8, pack8(*(const f32x4*)br, *(const f32x4*)(br + 4))); bbf[st][1] = __builtin_bit_cast(bf16x8, pack8(*(const f32x4*)bi, *(const f32x4*)(bi + 4))); }
        const f32x4 lb = *(const f32x4*)(SPp + SP_LB + (g * 64 + 2 * n) * 2);
        f32x4 x = {0.f, 0.f, 0.f, 0.f};
        if constexpr (OUT) x = *(const f32x4*)(S5Ep + (size_t)(cmine * 16 + g) * 64 + 2 * n);
        bf16x8 cf[4]; f32x4 dsk = {0.f, 0.f, 0.f, 0.f};
        if constexpr (OUT) {
#pragma unroll
            for (int ks = 0; ks < 4; ++ks) { const float* cp = ((ks < 2) ? c_re : c_im) + ((size_t)(l * 16 + g) * 16 + l15) * 64 + 32 * (ks & 1) + 8 * kg;
                f32x4 a = *(const f32x4*)cp, b = *(const f32x4*)(cp + 4); if (ks >= 2) { a = -a; b = -b; }
                cf[ks] = __builtin_bit_cast(bf16x8, pack8(a, b)); }
            dsk = *(const f32x4*)(ssm_d + (l * 16 + g) * 16 + 4 * kg);
        }
        const bf16_t* urow = ZSp + (size_t)((2 * pp + ((n >> 2) & 1)) * 64 + 4 * (n >> 3) + (n & 3)) * ZSW + ZU + g * 16 + 8 * hh;
#pragma unroll 1
        for (int k = 0; k < 4; ++k) {
            const bf16x8 uf = *(const bf16x8*)(urow + (size_t)(16 * k) * ZSW);
            const f32x16 z16 = {0.f, 0.f, 0.f, 0.f, 0.f, 0.f, 0.f, 0.f, 0.f, 0.f, 0.f, 0.f, 0.f, 0.f, 0.f, 0.f};
            const f32x16 r0 = __builtin_amdgcn_mfma_f32_32x32x16_bf16(uf, bbf[0][0], z16, 0, 0, 0), i0 = __builtin_amdgcn_mfma_f32_32x32x16_bf16(uf, bbf[0][1], z16, 0, 0, 0);
            const f32x16 r1 = __builtin_amdgcn_mfma_f32_32x32x16_bf16(uf, bbf[1][0], z16, 0, 0, 0), i1 = __builtin_amdgcn_mfma_f32_32x32x16_bf16(uf, bbf[1][1], z16, 0, 0, 0);
#pragma unroll
            for (int t = 0; t < 16; ++t) {
                const float nr0 = lb.x * x.x - lb.y * x.y + r0[t], ni0 = lb.x * x.y + lb.y * x.x + i0[t];
                const float nr1 = lb.z * x.z - lb.w * x.w + r1[t], ni1 = lb.z * x.w + lb.w * x.z + i1[t];
                x = (f32x4){nr0, ni0, nr1, ni1};
                if constexpr (OUT) { LAS unsigned* xw = (LAS unsigned*)(XL + (hh * 16 + t) * S5_XSTR + 4 * n); xw[0] = pk2(nr0, nr1); xw[32] = pk2(ni0, ni1); }
            }
            if constexpr (OUT) {
                asm volatile("s_waitcnt lgkmcnt(0)" ::: "memory");
#pragma unroll
                for (int sel = 0; sel < 2; ++sel) {
                    f32x4 y = {0.f, 0.f, 0.f, 0.f};
#pragma unroll
                    for (int ks = 0; ks < 4; ++ks) { const bf16x8 xf = *(const LAS bf16x8*)(XL + (sel * 16 + l15) * S5_XSTR + (32 * ks + 8 * kg) * 2); y = __builtin_amdgcn_mfma_f32_16x16x32_bf16(cf[ks], xf, y, 0, 0, 0); }
                    const size_t tok = (size_t)(2 * pp + sel) * 64 + 16 * k + l15;
                    const u32x2 uw = *(const u32x2*)(ZSp + tok * ZSW + ZU + g * 16 + 4 * kg);
                    const float y0 = gelu_tanh(y.x + dsk.x * bflo(uw.x)), y1 = gelu_tanh(y.y + dsk.y * bfhi(uw.x)), y2 = gelu_tanh(y.z + dsk.z * bflo(uw.y)), y3 = gelu_tanh(y.w + dsk.w * bfhi(uw.y));
                    *(u32x2*)(F.H() + tok * DM + g * 16 + 4 * kg) = (u32x2){pk2(y0, y1), pk2(y2, y3)};
                }
                asm volatile("s_waitcnt lgkmcnt(0)" ::: "memory");
            }
        }
        if constexpr (!OUT) *(f32x4*)(S5Ep + (size_t)(cmine * 16 + g) * 64 + 2 * n) = x;
    }
}
__device__ __forceinline__ void phase_s5_local(Frame& F) {
#ifdef NO_PHASE_S5_LOCAL
    return;
#endif
    s5_pass<false>(F, 0, nullptr, nullptr, nullptr);
}
__device__ __forceinline__ void phase_s5_out(Frame& F, int l, const float* c_re, const float* c_im, const float* ssm_d) {
#ifdef NO_PHASE_S5_OUT
    return;
#endif
    s5_pass<true>(F, l, c_re, c_im, ssm_d);
}

__device__ __forceinline__ void phase_carry(Frame& F) {
#ifdef NO_PHASE_CARRY
    return;
#endif
    const float* SPp = F.SP(); f32x2* S5Ep = F.S5E(); float* RSTp = F.RST();
    const int gw = F.bid * NWAVES + F.wave, NGW = F.G * NWAVES;
    for (int task = gw; task < NB * 16; task += NGW) {
        const int b = task >> 4, g = task & 15, p = F.lane;
        const float ar = SPp[SP_L64 + (g * 64 + p) * 2], ai = SPp[SP_L64 + (g * 64 + p) * 2 + 1];
        float sr = 0.f, si = 0.f;
        for (int c0 = 0; c0 < 128; c0 += 16) {
            f32x2 e[16];
#pragma unroll
            for (int j = 0; j < 16; ++j) e[j] = S5Ep[(size_t)((b * 128 + c0 + j) * 16 + g) * 64 + p];
#pragma unroll
            for (int j = 0; j < 16; ++j) { S5Ep[(size_t)((b * 128 + c0 + j) * 16 + g) * 64 + p] = (f32x2){sr, si}; const float nr = ar * sr - ai * si + e[j].x, ni = ar * si + ai * sr + e[j].y; sr = nr; si = ni; }
        }
    }
    const int NT = F.G * NTHREADS;
    for (int gt = F.bid * NTHREADS + F.tid; gt < NB * 4 * 4608; gt += NT) {
        const int b = gt / (4 * 4608), h = (gt / 4608) & 3, el = gt % 4608;
        const float lg = log1pf(-exp2f(-5.f - (float)h));
        const float cdec = expf(lg * 64.f);
        float s = 0.f;
        for (int c0 = 0; c0 < 128; c0 += 16) {
            float d[16];
#pragma unroll
            for (int j = 0; j < 16; ++j) d[j] = RSTp[(size_t)((b * 128 + c0 + j) * 4 + h) * 4608 + el];
#pragma unroll
            for (int j = 0; j < 16; ++j) { RSTp[(size_t)((b * 128 + c0 + j) * 4 + h) * 4608 + el] = s; s = s * cdec + d[j]; }
        }
    }
}

typedef float f32x16 __attribute__((ext_vector_type(16)));
typedef short s16x4 __attribute__((ext_vector_type(4)));
__device__ __forceinline__ bf16x8 tr8(const LAS unsigned char* a0, const LAS unsigned char* a1) {
    const s16x4 lo = __builtin_bit_cast(s16x4, __builtin_amdgcn_ds_read_tr16_b64_v4i16((LAS s16x4*)a0));
    const s16x4 hi = __builtin_bit_cast(s16x4, __builtin_amdgcn_ds_read_tr16_b64_v4i16((LAS s16x4*)a1));
    return (bf16x8){lo[0], lo[1], lo[2], lo[3], hi[0], hi[1], hi[2], hi[3]};
}
__device__ __forceinline__ bf16x8 pack8f(const f32x4& a, const f32x4& b) { return __builtin_bit_cast(bf16x8, pack8(a, b)); }
__device__ __forceinline__ void ret_stage_v(const bf16_t* ZSp, LAS unsigned char* Vb, int tok0, int h, int lane) {
#pragma unroll
    for (int n = 0; n < 12; ++n) { const int o = n * 1024 + 16 * lane, r = o / 192, ch = (o % 192) >> 4;
        __builtin_amdgcn_global_load_lds((const unsigned*)(ZSp + (size_t)(tok0 + r) * ZSW + ZRV + h * 96 + ch * 8), (LAS unsigned*)(Vb + n * 1024), 16, 0, 0); }
}
constexpr int RET_VB = 12288, RET_KSTR = 112, RET_WAVE_LDS = RET_VB + 64 * RET_KSTR;
__device__ __forceinline__ void phase_ret_local(Frame& F) {
#ifdef NO_PHASE_RET_LOCAL
    return;
#endif
    const bf16_t* ZSp = F.ZS(); float* RSTp = F.RST();
    LAS unsigned char* Vb = F.lds + F.wave * RET_WAVE_LDS; LAS unsigned char* Kb = Vb + RET_VB;
    for (int item = F.bid * NWAVES + F.wave; item < 2048; item += F.G * NWAVES) {
        int lane = F.lane; asm volatile("" : "+v"(lane));
        const int l31 = lane & 31, hh = lane >> 5, g1 = (lane >> 4) & 1, q4 = (lane & 15) >> 2, p4 = lane & 3;
        const int h = item & 3, tok0 = (item >> 2) * 64;
        ret_stage_v(ZSp, Vb, tok0, h, lane);
        const float lg2 = log2f(1.f - exp2f(-5.f - (float)h));
#pragma unroll
        for (int n = 0; n < 6; ++n) { const int idx = n * 64 + lane, r = idx / 6, ch = idx % 6;
            f32x4 a, b; unpack8(*(const u32x4*)(ZSp + (size_t)(tok0 + r) * ZSW + ZRK + h * 48 + ch * 8), a, b);
            const float sc = 0.14433756729740643f * exp2f(lg2 * (float)(63 - r));
            *(LAS u32x4*)(Kb + r * RET_KSTR + ch * 16) = pack8(a * sc, b * sc); }
        asm volatile("s_waitcnt vmcnt(0) lgkmcnt(0)" ::: "memory");
        f32x16 acc[3][2];
#pragma unroll
        for (int me = 0; me < 3; ++me)
#pragma unroll
            for (int nt = 0; nt < 2; ++nt) acc[me][nt] = (f32x16){0.f, 0.f, 0.f, 0.f, 0.f, 0.f, 0.f, 0.f, 0.f, 0.f, 0.f, 0.f, 0.f, 0.f, 0.f, 0.f};
#pragma unroll
        for (int s = 0; s < 4; ++s) {
            const int r0 = 16 * s + 8 * hh + q4;
            bf16x8 kf[2], vf[3];
#pragma unroll
            for (int nt = 0; nt < 2; ++nt) { const LAS unsigned char* a0 = Kb + r0 * RET_KSTR + (32 * nt + 16 * g1 + 4 * p4) * 2; kf[nt] = tr8(a0, a0 + 4 * RET_KSTR); }
#pragma unroll
            for (int me = 0; me < 3; ++me) { const LAS unsigned char* a0 = Vb + r0 * 192 + (32 * me + 16 * g1 + 4 * p4) * 2; vf[me] = tr8(a0, a0 + 4 * 192); }
#pragma unroll
            for (int me = 0; me < 3; ++me)
#pragma unroll
                for (int nt = 0; nt < 2; ++nt) acc[me][nt] = __builtin_amdgcn_mfma_f32_32x32x16_bf16(vf[me], kf[nt], acc[me][nt], 0, 0, 0);
        }
        float* dst = RSTp + (size_t)item * 4608 + (4 * hh) * 48 + l31;
#pragma unroll
        for (int me = 0; me < 3; ++me)
#pragma unroll
            for (int r4 = 0; r4 < 4; ++r4) {
                int zz = 0; asm volatile("" : "+v"(zz)); float* dp = dst + (32 * me + 8 * r4) * 48 + zz;
#pragma unroll
                for (int k = 0; k < 4; ++k) { dp[k * 48] = acc[me][0][4 * r4 + k]; if (l31 < 16) dp[k * 48 + 32] = acc[me][1][4 * r4 + k]; }
            }
        asm volatile("s_waitcnt lgkmcnt(0)" ::: "memory");
    }
}
__device__ __forceinline__ void phase_ret_out(Frame& F, int l, const float* ret_norm_g) {
#ifdef NO_PHASE_RET_OUT
    return;
#endif
    const bf16_t* ZSp = F.ZS(); const float* RSTp = F.RST();
    LAS unsigned char* Vb = F.lds + F.wave * RET_WAVE_LDS;
    for (int item = F.bid * NWAVES + F.wave; item < 2048; item += F.G * NWAVES) {
        int lane = F.lane; asm volatile("" : "+v"(lane));
        const int l31 = lane & 31, hh = lane >> 5, g1 = (lane >> 4) & 1, q4 = (lane & 15) >> 2, p4 = lane & 3;
        const int h = item & 3, tok0 = (item >> 2) * 64;
        ret_stage_v(ZSp, Vb, tok0, h, lane);
        const float lg2 = log2f(1.f - exp2f(-5.f - (float)h));
        bf16x8 qf[2][3], kf[2][3];
#pragma unroll
        for (int t = 0; t < 2; ++t)
#pragma unroll
            for (int ks = 0; ks < 3; ++ks) { const size_t ro = (size_t)(tok0 + 32 * t + l31) * ZSW + h * 48 + 8 * hh + 16 * ks;
                qf[t][ks] = *(const bf16x8*)(ZSp + ro + ZRQ); kf[t][ks] = *(const bf16x8*)(ZSp + ro + ZRK); }
        bf16x8 pm[2][4];
#pragma unroll
        for (int mt = 0; mt < 2; ++mt)
#pragma unroll
            for (int nt = mt; nt < 2; ++nt) {
                f32x16 p = {0.f, 0.f, 0.f, 0.f, 0.f, 0.f, 0.f, 0.f, 0.f, 0.f, 0.f, 0.f, 0.f, 0.f, 0.f, 0.f};
#pragma unroll
                for (int ks = 0; ks < 3; ++ks) p = __builtin_amdgcn_mfma_f32_32x32x16_bf16(kf[mt][ks], qf[nt][ks], p, 0, 0, 0);
                const int i = 32 * nt + l31;
#pragma unroll
                for (int r = 0; r < 16; ++r) { const int j = 32 * mt + (r & 3) + 8 * (r >> 2) + 4 * hh;
                    p[r] = (i >= j) ? p[r] * (0.14433756729740643f * exp2f(lg2 * (float)(i - j))) : 0.f; }
                pm[nt][2 * mt + 0] = pack8f((f32x4){p[0], p[1], p[2], p[3]}, (f32x4){p[4], p[5], p[6], p[7]});
                pm[nt][2 * mt + 1] = pack8f((f32x4){p[8], p[9], p[10], p[11]}, (f32x4){p[12], p[13], p[14], p[15]});
            }
        f32x16 ot[3][2];
#pragma unroll
        for (int me = 0; me < 3; ++me) {
            bf16x8 sf[3];
            int zz = 0; asm volatile("" : "+v"(zz)); const float* sp0 = RSTp + (size_t)item * 4608 + (32 * me + l31) * 48 + 8 * hh + zz;
#pragma unroll
            for (int ks = 0; ks < 3; ++ks) { const float* sp = sp0 + 16 * ks; sf[ks] = pack8f(*(const f32x4*)sp, *(const f32x4*)(sp + 4)); }
#pragma unroll
            for (int nt = 0; nt < 2; ++nt) {
                f32x16 a = {0.f, 0.f, 0.f, 0.f, 0.f, 0.f, 0.f, 0.f, 0.f, 0.f, 0.f, 0.f, 0.f, 0.f, 0.f, 0.f};
#pragma unroll
                for (int ks = 0; ks < 3; ++ks) a = __builtin_amdgcn_mfma_f32_32x32x16_bf16(sf[ks], qf[nt][ks], a, 0, 0, 0);
                const float qd = exp2f(lg2 * (float)(32 * nt + l31 + 1));
                ot[me][nt] = a * qd;
            }
        }
        asm volatile("s_waitcnt vmcnt(0)" ::: "memory");
#pragma unroll
        for (int s = 0; s < 4; ++s) {
            const int r0 = 16 * s + 4 * hh + q4;
#pragma unroll
            for (int me = 0; me < 3; ++me) {
                const LAS unsigned char* a0 = Vb + r0 * 192 + (32 * me + 16 * g1 + 4 * p4) * 2;
                const bf16x8 vf = tr8(a0, a0 + 8 * 192);
                if (s < 2) ot[me][0] = __builtin_amdgcn_mfma_f32_32x32x16_bf16(vf, pm[0][s], ot[me][0], 0, 0, 0);
                ot[me][1] = __builtin_amdgcn_mfma_f32_32x32x16_bf16(vf, pm[1][s], ot[me][1], 0, 0, 0);
            }
        }
#pragma unroll
        for (int nt = 0; nt < 2; ++nt) {
            float sum = 0.f;
#pragma unroll
            for (int me = 0; me < 3; ++me)
#pragma unroll
                for (int r = 0; r < 16; ++r) sum += ot[me][nt][r];
            sum += __shfl_xor(sum, 32);
            const float mu = sum * (1.f / 96.f); float q2 = 0.f;
#pragma unroll
            for (int me = 0; me < 3; ++me)
#pragma unroll
                for (int r = 0; r < 16; ++r) { const float d = ot[me][nt][r] - mu; q2 += d * d; }
            q2 += __shfl_xor(q2, 32);
            const float rs = rsqrtf(q2 * (1.f / 96.f) + EPS);
            const int tok = tok0 + 32 * nt + l31;
            const bf16_t* gbase = ZSp + (size_t)tok * ZSW + ZRG + h * 96 + 4 * hh; const float* nbase = ret_norm_g + l * 384 + h * 96 + 4 * hh; bf16_t* obase = F.H() + (size_t)tok * DM + 640 + h * 96 + 4 * hh;
#pragma unroll
            for (int me = 0; me < 3; ++me) {
                int zz = 0; asm volatile("" : "+v"(zz));
                const bf16_t* gp = gbase + 32 * me + zz; const float* np = nbase + 32 * me + zz; bf16_t* op = obase + 32 * me + zz;
#pragma unroll
                for (int r4 = 0; r4 < 4; ++r4) {
                    const u32x2 gw = *(const u32x2*)(gp + 8 * r4);
                    const f32x4 ng = *(const f32x4*)(np + 8 * r4);
                    const float g0 = bflo(gw.x), g1f = bfhi(gw.x), g2 = bflo(gw.y), g3 = bfhi(gw.y);
                    const float y0 = (ot[me][nt][4 * r4 + 0] - mu) * rs * ng.x * (g0 * sigmoidf_(g0)), y1 = (ot[me][nt][4 * r4 + 1] - mu) * rs * ng.y * (g1f * sigmoidf_(g1f));
                    const float y2 = (ot[me][nt][4 * r4 + 2] - mu) * rs * ng.z * (g2 * sigmoidf_(g2)), y3 = (ot[me][nt][4 * r4 + 3] - mu) * rs * ng.w * (g3 * sigmoidf_(g3));
                    *(u32x2*)(op + 8 * r4) = (u32x2){pk2(y0, y1), pk2(y2, y3)};
                }
            }
        }
        asm volatile("s_waitcnt lgkmcnt(0)" ::: "memory");
    }
}

typedef _Float16 f16_t;
__device__ __forceinline__ u32x4 zero4() { unsigned z = 0u; asm volatile("" : "+v"(z)); return (u32x4){z, z, z, z}; }
__device__ __forceinline__ int lanes_below(unsigned long long m) { return (int)__builtin_amdgcn_mbcnt_hi((unsigned)(m >> 32), __builtin_amdgcn_mbcnt_lo((unsigned)m, 0u)); }
__device__ __forceinline__ float relu1(float x) { return __builtin_amdgcn_fmed3f(x, 0.f, __builtin_inff()); }
__device__ __forceinline__ unsigned sortable_f16(float sc) {
    const f16_t h = (f16_t)sc; const unsigned u = (unsigned)__builtin_bit_cast(unsigned short, h), mag = u & 0x7fffu;
    return (u & 0x8000u) ? (0x8000u - mag) : (0x8000u + mag);
}
__device__ __forceinline__ int sc_pos(int k) { return k; }
__device__ __forceinline__ int wave_suffix_sum(int v, int lane) {
#pragma unroll
    for (int o = 1; o < 64; o <<= 1) { const int t = __shfl_down(v, o); if (lane + o < 64) v += t; }
    return v;
}
__device__ __forceinline__ void hist_threshold(const u32x4 c, int need, int lane, int& B, int& above) {
    const int s = (int)(c.x + c.y + c.z + c.w);
    const int S = wave_suffix_sum(s, lane);
    int a = S - s;
    const bool found = (a < need) && (S >= need);
    int Bl = 0, al = 0;
    if (found) {
        if (a + (int)c.w >= need) { Bl = 4 * lane + 3; al = a; }
        else { a += (int)c.w; if (a + (int)c.z >= need) { Bl = 4 * lane + 2; al = a; }
        else { a += (int)c.z; if (a + (int)c.y >= need) { Bl = 4 * lane + 1; al = a; }
        else { a += (int)c.y; Bl = 4 * lane; al = a; } } }
    }
    const unsigned long long m = __ballot(found);
    const int src = m ? (int)__builtin_ctzll(m) : 0;
    B = __shfl(Bl, src); above = __shfl(al, src);
}

#ifndef DSA_CAND
#define DSA_CAND 0
#endif
#ifndef DSA_DUP
#define DSA_DUP 0
#endif
constexpr int DSA_ROW = 16384;
__device__ __forceinline__ void phase_dsa(Frame& F) {
#ifdef NO_PHASE_DSA
    return;
#endif
    const int wave = F.wave;
    const bf16_t* ZSp = F.ZS(); const float* IWp = F.IW(); const bf16_t* IKp = F.IKD();
    LAS unsigned char* SCb = F.lds;
    for (int it = F.bid; it < 512; it += F.G) {
        int lane = F.lane; asm volatile("" : "+v"(lane));
        const int hi = lane >> 5, n32 = lane & 31;
        LAS unsigned short* LSTw = (LAS unsigned short*)(F.lds + 131072) + wave * 256;
        LAS unsigned char* WB = F.lds + 135168 + wave * 3520;
        LAS unsigned* H1 = (LAS unsigned*)WB; LAS unsigned* H2 = H1 + 256;
        LAS unsigned* DUM = (LAS unsigned*)(WB + 3264) + lane;
        LAS unsigned short* CK = (LAS unsigned short*)(WB + 1024); LAS unsigned short* CI = (LAS unsigned short*)(WB + 2144);
        const int pr = it & 255, vcu = (pr & 7) * 32 + (pr >> 3);
        const int b = vcu >> 6, cc = vcu & 63, c = (it < 256) ? cc : 127 - cc;
        const int V = (c + 1) * 64, tokq0 = b * SEQ + c * 64, kb0 = b * SEQ;
        const int Keff = V < 256 ? V : 256;
        const int nblk = (V + 511) >> 9, ntile_all = nblk * 16, ntile_real = V >> 5;
        for (int qg = 0; qg < 8; ++qg) {
            const int tq0 = tokq0 + qg * 8;
#ifndef DSA_NO_A
            for (int repA = 0; repA < 1 + (DSA_DUP & 1); ++repA) {
                bf16x8 aq[2];
                { const int qq = n32 >> 2, hd = n32 & 3; const bf16_t* qp = ZSp + (size_t)(tq0 + qq) * ZSW + ZIQ + hd * 32 + 8 * hi;
                  aq[0] = *(const bf16x8*)qp; aq[1] = *(const bf16x8*)(qp + 16); }
                float wq[4][4];
#pragma unroll
                for (int jq = 0; jq < 4; ++jq) { const f32x4 w4 = *(const f32x4*)(IWp + (size_t)(tq0 + 2 * jq + hi) * 4);
                    wq[jq][0] = w4.x * 0.08838834764831845f; wq[jq][1] = w4.y * 0.08838834764831845f; wq[jq][2] = w4.z * 0.08838834764831845f; wq[jq][3] = w4.w * 0.08838834764831845f; }
                bf16x8 fr[2][4][2];
                const int nb = (ntile_all - wave + 31) >> 5;
#define DSA_ALOAD(buf, bt) do { int zz = 0; asm volatile("" : "+v"(zz)); _Pragma("unroll") for (int u = 0; u < 4; ++u) { const int tt = wave + 8 * (4 * (bt) + u); \
        if (tt < ntile_real) { const bf16_t* kp = IKp + ((size_t)(((kb0 >> 5) + tt) * 4 + hi) * 32 + n32 + zz) * 8; fr[buf][u][0] = *(const bf16x8*)kp; fr[buf][u][1] = *(const bf16x8*)(kp + 512); } } } while (0)
#define DSA_ACOMP(buf, bt) do { _Pragma("unroll") for (int u = 0; u < 4; ++u) { const int tt = wave + 8 * (4 * (bt) + u); \
        if (tt < ntile_all) { unsigned short us[4] = {0, 0, 0, 0}; \
            if (tt < ntile_real) { f32x16 acc = {0.f, 0.f, 0.f, 0.f, 0.f, 0.f, 0.f, 0.f, 0.f, 0.f, 0.f, 0.f, 0.f, 0.f, 0.f, 0.f}; \
                acc = __builtin_amdgcn_mfma_f32_32x32x16_bf16(aq[0], fr[buf][u][0], acc, 0, 0, 0); acc = __builtin_amdgcn_mfma_f32_32x32x16_bf16(aq[1], fr[buf][u][1], acc, 0, 0, 0); \
                _Pragma("unroll") for (int jq = 0; jq < 4; ++jq) { \
                    const float sc = relu1(acc[4 * jq + 0]) * wq[jq][0] + relu1(acc[4 * jq + 1]) * wq[jq][1] + relu1(acc[4 * jq + 2]) * wq[jq][2] + relu1(acc[4 * jq + 3]) * wq[jq][3]; \
                    us[jq] = (unsigned short)sortable_f16(sc); } } \
            const int pos = sc_pos(tt * 32 + n32); \
            _Pragma("unroll") for (int jq = 0; jq < 4; ++jq) *(LAS unsigned short*)(SCb + (2 * jq + hi) * DSA_ROW + pos * 2) = us[jq]; } } } while (0)
                DSA_ALOAD(0, 0);
                for (int bp = 0; bp < nb; bp += 2) {
                    if (bp + 1 < nb) DSA_ALOAD(1, bp + 1);
                    DSA_ACOMP(0, bp);
                    if (bp + 2 < nb) DSA_ALOAD(0, bp + 2);
                    if (bp + 1 < nb) DSA_ACOMP(1, bp + 1);
                }
#undef DSA_ALOAD
#undef DSA_ACOMP
            }
#endif
            __syncthreads();
            LAS unsigned char* row = SCb + wave * DSA_ROW;
#ifndef DSA_NO_B
            for (int repB = 0; repB < 1 + ((DSA_DUP >> 1) & 1); ++repB)
            if (V > 256) {
                *(LAS u32x4*)(H1 + 4 * lane) = zero4(); *(LAS u32x4*)(H2 + 4 * lane) = zero4();
                u32x4 rw[4];
#define DSA_LD8(hf) do { _Pragma("unroll") for (int i = 0; i < 4; ++i) if (4 * (hf) + i < nblk) rw[i] = *(const LAS u32x4*)(row + (512 * (4 * (hf) + i) + 8 * lane) * 2); \
        asm volatile("s_waitcnt lgkmcnt(0)" ::: "memory"); } while (0)
#define DSA_W(i, e2) ((e2) == 0 ? rw[i].x : (e2) == 1 ? rw[i].y : (e2) == 2 ? rw[i].z : rw[i].w)
                asm volatile("s_waitcnt lgkmcnt(0)" ::: "memory");
#pragma unroll 1
                for (int hf = 0; 4 * hf < nblk; ++hf) {
                    DSA_LD8(hf);
#pragma unroll
                    for (int i = 0; i < 4; ++i) if (4 * hf + i < nblk) __hip_atomic_fetch_add(H2 + ((rw[i].x >> 8) & 255u), 1u, __ATOMIC_RELAXED, __HIP_MEMORY_SCOPE_WORKGROUP);
                }
                asm volatile("s_waitcnt lgkmcnt(0)" ::: "memory");
                int Bc, abovec; hist_threshold(*(const LAS u32x4*)(H2 + 4 * lane), 40, lane, Bc, abovec);
                { const u32x4 hs = *(const LAS u32x4*)(H2 + 4 * lane); const int tot = wave_suffix_sum((int)(hs.x + hs.y + hs.z + hs.w), lane); if (__shfl(tot, 0) < 40) Bc = 0; }
                *(LAS u32x4*)(H2 + 4 * lane) = zero4();
                bool done = false;
                if (DSA_CAND && Bc > 0) {
                    const unsigned thr = (unsigned)Bc << 8;
                    int cnt = 0;
#pragma unroll 1
                    for (int hf = 0; 4 * hf < nblk; ++hf) {
                        DSA_LD8(hf);
#pragma unroll
                        for (int i = 0; i < 4; ++i) if (4 * hf + i < nblk) {
#pragma unroll
                            for (int e = 0; e < 8; ++e) { const unsigned w = DSA_W(i, e >> 1); const unsigned u = (e & 1) ? (w >> 16) : (w & 0xffffu); cnt += (u >= thr) ? 1 : 0; }
                        }
                    }
                    int pos = cnt;
#pragma unroll
                    for (int o = 1; o < 64; o <<= 1) { const int t = __shfl_up(pos, o); if (lane >= o) pos += t; }
                    const int ncand = __shfl(pos, 63); pos -= cnt;
                    if (ncand >= 256 && ncand <= 560) {
                        LAS unsigned short* ldum = (LAS unsigned short*)DUM;
#pragma unroll 1
                        for (int hf = 0; 4 * hf < nblk; ++hf) {
                            DSA_LD8(hf);
#pragma unroll
                            for (int i = 0; i < 4; ++i) if (4 * hf + i < nblk) {
#pragma unroll
                                for (int e = 0; e < 8; ++e) { const unsigned w = DSA_W(i, e >> 1); const unsigned u = (e & 1) ? (w >> 16) : (w & 0xffffu);
                                    const bool sel = u >= thr; LAS unsigned short* pk = sel ? CK + pos : ldum; LAS unsigned short* pi = sel ? CI + pos : ldum;
                                    *pk = (unsigned short)u; *pi = (unsigned short)(512 * (4 * hf + i) + 8 * lane + e); pos += sel ? 1 : 0; }
                            }
                        }
                        *(LAS u32x4*)(H1 + 4 * lane) = zero4();
                        asm volatile("s_waitcnt lgkmcnt(0)" ::: "memory");
                        unsigned cu[9];
#pragma unroll
                        for (int j = 0; j < 9; ++j) { const int p = j * 64 + lane; const bool v = p < ncand; cu[j] = v ? (unsigned)CK[v ? p : 0] : 0u; }
                        asm volatile("s_waitcnt lgkmcnt(0)" ::: "memory");
#pragma unroll
                        for (int j = 0; j < 9; ++j) if (j * 64 + lane < ncand) __hip_atomic_fetch_add(H1 + (cu[j] >> 8), 1u, __ATOMIC_RELAXED, __HIP_MEMORY_SCOPE_WORKGROUP);
                        asm volatile("s_waitcnt lgkmcnt(0)" ::: "memory");
                        int B1c, above1c; hist_threshold(*(const LAS u32x4*)(H1 + 4 * lane), 256, lane, B1c, above1c);
                        *(LAS u32x4*)(H1 + 4 * lane) = zero4();
                        asm volatile("s_waitcnt lgkmcnt(0)" ::: "memory");
#pragma unroll
                        for (int j = 0; j < 9; ++j) if (j * 64 + lane < ncand && (int)(cu[j] >> 8) == B1c) __hip_atomic_fetch_add(H1 + (cu[j] & 255u), 1u, __ATOMIC_RELAXED, __HIP_MEMORY_SCOPE_WORKGROUP);
                        asm volatile("s_waitcnt lgkmcnt(0)" ::: "memory");
                        int B2c, above2c; hist_threshold(*(const LAS u32x4*)(H1 + 4 * lane), 256 - above1c, lane, B2c, above2c);
                        const unsigned tauc = ((unsigned)B1c << 8) | (unsigned)B2c;
                        if ((int)H1[B2c] == 256 - above1c - above2c) {
                            int c2 = 0;
#pragma unroll
                            for (int j = 0; j < 9; ++j) c2 += (j * 64 + lane < ncand && cu[j] >= tauc) ? 1 : 0;
                            int p2 = c2;
#pragma unroll
                            for (int o = 1; o < 64; o <<= 1) { const int t = __shfl_up(p2, o); if (lane >= o) p2 += t; }
                            p2 -= c2;
#pragma unroll
                            for (int j = 0; j < 9; ++j) { const bool sel = (j * 64 + lane < ncand) && cu[j] >= tauc; LAS unsigned short* pl = sel ? LSTw + p2 : ldum; *pl = CI[sel ? j * 64 + lane : 0]; p2 += sel ? 1 : 0; }
                            done = true;
                        }
                        *(LAS u32x4*)(H1 + 4 * lane) = zero4(); *(LAS u32x4*)(H2 + 4 * lane) = zero4();
                        asm volatile("s_waitcnt lgkmcnt(0)" ::: "memory");
                    }
                }
                if (!done) {
                int lo_bin = Bc, hi_bin = 256;
                for (;;) {
#pragma unroll 1
                    for (int hf = 0; 4 * hf < nblk; ++hf) {
                        DSA_LD8(hf);
#pragma unroll
                        for (int i = 0; i < 4; ++i) if (4 * hf + i < nblk) {
#pragma unroll
                            for (int e2 = 0; e2 < 4; ++e2) { const unsigned w = DSA_W(i, e2); const int b0 = (int)((w >> 8) & 255u), b1 = (int)(w >> 24);
                                LAS unsigned* p0 = ((unsigned)(b0 - lo_bin) < (unsigned)(hi_bin - lo_bin)) ? H1 + b0 : DUM; LAS unsigned* p1 = ((unsigned)(b1 - lo_bin) < (unsigned)(hi_bin - lo_bin)) ? H1 + b1 : DUM;
                                __hip_atomic_fetch_add(p0, 1u, __ATOMIC_RELAXED, __HIP_MEMORY_SCOPE_WORKGROUP); __hip_atomic_fetch_add(p1, 1u, __ATOMIC_RELAXED, __HIP_MEMORY_SCOPE_WORKGROUP); }
                        }
                    }
                    asm volatile("s_waitcnt lgkmcnt(0)" ::: "memory");
                    if (lo_bin == 0) break;
                    const u32x4 h4 = *(const LAS u32x4*)(H1 + 4 * lane); const int tot = __shfl(wave_suffix_sum((int)(h4.x + h4.y + h4.z + h4.w), lane), 0);
                    if (tot >= 256) break;
                    hi_bin = lo_bin; lo_bin = 0;
                }
                asm volatile("s_waitcnt lgkmcnt(0)" ::: "memory");
                int B1, above1; hist_threshold(*(const LAS u32x4*)(H1 + 4 * lane), 256, lane, B1, above1);
#pragma unroll 1
                for (int hf = 0; 4 * hf < nblk; ++hf) {
                    DSA_LD8(hf);
#pragma unroll
                    for (int i = 0; i < 4; ++i) if (4 * hf + i < nblk) {
#pragma unroll
                        for (int e2 = 0; e2 < 4; ++e2) { const unsigned w = DSA_W(i, e2);
                            LAS unsigned* p0 = ((int)((w >> 8) & 255u) == B1) ? H2 + (w & 255u) : DUM; LAS unsigned* p1 = ((int)(w >> 24) == B1) ? H2 + ((w >> 16) & 255u) : DUM;
                            __hip_atomic_fetch_add(p0, 1u, __ATOMIC_RELAXED, __HIP_MEMORY_SCOPE_WORKGROUP); __hip_atomic_fetch_add(p1, 1u, __ATOMIC_RELAXED, __HIP_MEMORY_SCOPE_WORKGROUP); }
                    }
                }
                asm volatile("s_waitcnt lgkmcnt(0)" ::: "memory");
                int B2, above2; hist_threshold(*(const LAS u32x4*)(H2 + 4 * lane), 256 - above1, lane, B2, above2);
                const unsigned tau = ((unsigned)B1 << 8) | (unsigned)B2;
                const int r = 256 - above1 - above2;
                const int neq = (int)H2[B2];
                if (neq == r) {
                    int cnt = 0;
#pragma unroll 1
                    for (int hf = 0; 4 * hf < nblk; ++hf) {
                        DSA_LD8(hf);
#pragma unroll
                        for (int i = 0; i < 4; ++i) if (4 * hf + i < nblk) {
#pragma unroll
                            for (int e = 0; e < 8; ++e) { const unsigned w = DSA_W(i, e >> 1); const unsigned u = (e & 1) ? (w >> 16) : (w & 0xffffu); cnt += (u >= tau) ? 1 : 0; }
                        }
                    }
                    int pos = cnt;
#pragma unroll
                    for (int o = 1; o < 64; o <<= 1) { const int t = __shfl_up(pos, o); if (lane >= o) pos += t; }
                    pos -= cnt;
                    LAS unsigned short* ldum = (LAS unsigned short*)DUM;
#pragma unroll 1
                    for (int hf = 0; 4 * hf < nblk; ++hf) {
                        DSA_LD8(hf);
#pragma unroll
                        for (int i = 0; i < 4; ++i) if (4 * hf + i < nblk) {
#pragma unroll
                            for (int e = 0; e < 8; ++e) { const unsigned w = DSA_W(i, e >> 1); const unsigned u = (e & 1) ? (w >> 16) : (w & 0xffffu);
                                const bool sel = u >= tau; LAS unsigned short* p = sel ? LSTw + pos : ldum;
                                *p = (unsigned short)(512 * (4 * hf + i) + 8 * lane + e); pos += sel ? 1 : 0; }
                        }
                    }
                } else {
                    int eq_base = 0, sel_base = 0;
#pragma unroll 1
                    for (int i = 0; i < nblk; ++i) {
                        const u32x4 w4 = *(const LAS u32x4*)(row + (512 * i + 8 * lane) * 2);
                        const unsigned ww[4] = {w4.x, w4.y, w4.z, w4.w};
                        int below_eq = 0, mine_eq = 0;
#pragma unroll
                        for (int e = 0; e < 8; ++e) { const unsigned u = (e & 1) ? (ww[e >> 1] >> 16) : (ww[e >> 1] & 0xffffu); below_eq += lanes_below(__ballot(u == tau)); }
                        int blk_eq = 0;
#pragma unroll
                        for (int e = 0; e < 8; ++e) {
                            const unsigned u = (e & 1) ? (ww[e >> 1] >> 16) : (ww[e >> 1] & 0xffffu);
                            const bool gt = u > tau, eq = (u == tau);
                            const bool sel = gt || (eq && (eq_base + below_eq + mine_eq < r));
                            mine_eq += eq ? 1 : 0;
                            const unsigned long long msel = __ballot(sel);
                            if (sel) LSTw[sel_base + lanes_below(msel)] = (unsigned short)(512 * i + 8 * lane + e);
                            sel_base += __popcll(msel); blk_eq += __popcll(__ballot(eq));
                        }
                        eq_base += blk_eq;
                    }
                }
                }
#undef DSA_W
#undef DSA_LD8
            } else {
#pragma unroll
                for (int jj = 0; jj < 4; ++jj) LSTw[lane + 64 * jj] = (unsigned short)(lane + 64 * jj);
            }
#endif
            asm volatile("s_waitcnt lgkmcnt(0)" ::: "memory");
            for (int repC = 0; repC < 1 + ((DSA_DUP >> 2) & 1); ++repC) {
                const int tq = tq0 + wave, n16 = lane & 15, kg = lane >> 4;
                bf16x8 qf[2];
                if (n16 < 6) { const bf16_t* qp = ZSp + (size_t)tq * ZSW + ZDQ + n16 * 64 + 8 * kg; qf[0] = *(const bf16x8*)qp; qf[1] = *(const bf16x8*)(qp + 32); }
                else { qf[0] = (bf16x8){0, 0, 0, 0, 0, 0, 0, 0}; qf[1] = qf[0]; }
                const int ntile = Keff >> 4;
                LAS unsigned char* vst = row;
#define DSA_VDMA(ch, buf) do { _Pragma("unroll") for (int i8 = 0; i8 < 8; ++i8) { const int rr = (lane >> 3) + 8 * i8; const int kidx = LSTw[(ch) * 64 + rr]; \
        const int sch = (lane & 7) ^ (2 * ((rr >> 1) & 3)); \
        __builtin_amdgcn_global_load_lds((const unsigned*)(ZSp + (size_t)(kb0 + kidx) * ZSW + ZDV + sch * 8), (LAS unsigned*)(vst + (buf) * 8192 + i8 * 1024), 16, 0, 0); } } while (0)
                DSA_VDMA(0, 0);
                if (ntile > 4) DSA_VDMA(1, 1);
                f32x4 sa[16];
#pragma unroll
                for (int tb = 0; tb < 4; ++tb) {
                    constexpr int T0[5] = {0, 4, 8, 12, 16};
                    bf16x8 kf[6][2];
#pragma unroll
                    for (int t8 = 0; t8 < 6; ++t8) if (T0[tb] + t8 < T0[tb + 1] && T0[tb] + t8 < ntile) { const int kidx = LSTw[(T0[tb] + t8) * 16 + n16]; const bf16_t* kp = ZSp + (size_t)(kb0 + kidx) * ZSW + ZDK + 8 * kg;
                        kf[t8][0] = *(const bf16x8*)kp; kf[t8][1] = *(const bf16x8*)(kp + 32); }
#pragma unroll
                    for (int t8 = 0; t8 < 6; ++t8) if (T0[tb] + t8 < T0[tb + 1]) {
                        if (T0[tb] + t8 < ntile) { f32x4 a = {0.f, 0.f, 0.f, 0.f};
                            a = __builtin_amdgcn_mfma_f32_16x16x32_bf16(kf[t8][0], qf[0], a, 0, 0, 0); a = __builtin_amdgcn_mfma_f32_16x16x32_bf16(kf[t8][1], qf[1], a, 0, 0, 0); sa[T0[tb] + t8] = a; }
                        else sa[T0[tb] + t8] = (f32x4){-1e30f, -1e30f, -1e30f, -1e30f};
                    }
                }
                float m = -1e30f;
#pragma unroll
                for (int t = 0; t < 16; ++t) m = fmaxf(m, fmaxf(fmaxf(sa[t].x, sa[t].y), fmaxf(sa[t].z, sa[t].w)));
                m = fmaxf(m, __shfl_xor(m, 16)); m = fmaxf(m, __shfl_xor(m, 32));
                const float sc2 = 0.125f * 1.4426950408889634f; float lsum = 0.f;
#pragma unroll
                for (int t = 0; t < 16; ++t) { sa[t].x = exp2f((sa[t].x - m) * sc2); sa[t].y = exp2f((sa[t].y - m) * sc2); sa[t].z = exp2f((sa[t].z - m) * sc2); sa[t].w = exp2f((sa[t].w - m) * sc2);
                    lsum += (sa[t].x + sa[t].y) + (sa[t].z + sa[t].w); }
                lsum += __shfl_xor(lsum, 16); lsum += __shfl_xor(lsum, 32);
                const float linv = 1.f / lsum;
                f32x4 oacc[4] = {{0.f, 0.f, 0.f, 0.f}, {0.f, 0.f, 0.f, 0.f}, {0.f, 0.f, 0.f, 0.f}, {0.f, 0.f, 0.f, 0.f}};
                const int q4 = n16 >> 2, p4 = n16 & 3;
#pragma unroll
                for (int ch = 0; ch < 4; ++ch) {
                    if (ch * 4 < ntile) {
                        if ((ch + 1) * 4 < ntile) asm volatile("s_waitcnt vmcnt(8)" ::: "memory");
                        else asm volatile("s_waitcnt vmcnt(0)" ::: "memory");
#pragma unroll
                        for (int sl = 0; sl < 2; ++sl) {
                            const int s = ch * 2 + sl;
                            u32x4 pw; pw.x = pk2(sa[2 * s].x, sa[2 * s].y); pw.y = pk2(sa[2 * s].z, sa[2 * s].w); pw.z = pk2(sa[2 * s + 1].x, sa[2 * s + 1].y); pw.w = pk2(sa[2 * s + 1].z, sa[2 * s + 1].w);
                            const bf16x8 pb = __builtin_bit_cast(bf16x8, pw);
#pragma unroll
                            for (int mt = 0; mt < 4; ++mt) {
                                const int P0 = 32 * sl + 4 * kg + q4, P1 = P0 + 16;
                                const LAS unsigned char* a0 = vst + (ch & 1) * 8192 + P0 * 128 + (((2 * mt + (p4 >> 1)) ^ (2 * ((P0 >> 1) & 3))) * 16) + 8 * (p4 & 1);
                                const LAS unsigned char* a1 = vst + (ch & 1) * 8192 + P1 * 128 + (((2 * mt + (p4 >> 1)) ^ (2 * ((P1 >> 1) & 3))) * 16) + 8 * (p4 & 1);
                                const s16x4 lo = __builtin_bit_cast(s16x4, __builtin_amdgcn_ds_read_tr16_b64_v4i16((LAS s16x4*)a0));
                                const s16x4 hi4 = __builtin_bit_cast(s16x4, __builtin_amdgcn_ds_read_tr16_b64_v4i16((LAS s16x4*)a1));
                                const bf16x8 va = (bf16x8){lo[0], lo[1], lo[2], lo[3], hi4[0], hi4[1], hi4[2], hi4[3]};
                                oacc[mt] = __builtin_amdgcn_mfma_f32_16x16x32_bf16(va, pb, oacc[mt], 0, 0, 0);
                            }
                        }
                        asm volatile("s_waitcnt lgkmcnt(0)" ::: "memory");
                        if (ch + 2 < 4 && (ch + 2) * 4 < ntile) DSA_VDMA(ch + 2, ch & 1);
                    }
                }
#undef DSA_VDMA
                if (n16 < 6) {
                    bf16_t* op = F.H() + (size_t)tq * DM + 256 + n16 * 64 + 4 * kg;
#pragma unroll
                    for (int mt = 0; mt < 4; ++mt) { u32x2 o; o.x = pk2(oacc[mt].x * linv, oacc[mt].y * linv); o.y = pk2(oacc[mt].z * linv, oacc[mt].w * linv); *(u32x2*)(op + 16 * mt) = o; }
                }
            }
            __syncthreads();
        }
    }
}

__global__ void __launch_bounds__(NTHREADS, 2) mk_fwd(Args args) {
    extern __shared__ __attribute__((aligned(16))) unsigned char lds_raw[];
    Frame F;
    F.lds = (LAS unsigned char*)lds_raw;
    F.tid = threadIdx.x; F.lane = F.tid & 63; F.wave = __builtin_amdgcn_readfirstlane(F.tid >> 6);
    F.G = gridDim.x; F.bid = blockIdx.x; F.wsb = args.ws; F.zo = 0u;
    unsigned char* ws = args.ws;
#define INF(k) ((const float*)args.in[k])

    volatile LAS unsigned* MISC = (volatile LAS unsigned*)(F.lds + MISC_OFF);
    if (F.tid < 64) MISC[F.tid] = 0u;
    __syncthreads();
    XcdBarrier bar = xcd_barrier_post((unsigned*)(ws + WS_CTL) + CW_BAR, MISC + 8);
    cg::grid_group grid = cg::this_grid();
    int ph = 0; const int lo = args.ph_lo, hi = args.ph_hi;
    unsigned long long* TSp = (unsigned long long*)(ws + WS_CTL + 32768); int nst = 0; (void)TSp; (void)nst;
    bool first_seam = true;
#ifndef DUP_MASK
#define DUP_MASK 0
#endif
#ifdef PROBE_LO
#define STAMP() do { if (F.bid == 0 && F.tid == 0) { TSp[nst] = __builtin_amdgcn_s_memrealtime(); } ++nst; } while (0)
#else
#define STAMP() do { } while (0)
#endif
#ifdef NO_CG
#define GRIDSYNC() xcd_barrier(bar, F.wave == 0 && (int)__builtin_amdgcn_mbcnt_hi(~0u, __builtin_amdgcn_mbcnt_lo(~0u, 0u)) == 0)
#else
#define GRIDSYNC() grid.sync()
#endif
#define RUN(...) do { if (ph >= lo && ph < hi) { F.lane = (int)__builtin_amdgcn_mbcnt_hi(~0u, __builtin_amdgcn_mbcnt_lo(~0u, 0u)); asm volatile("" : "+v"(F.lane), "+s"(F.zo), "+s"(F.bid), "+s"(F.G), "+s"(F.wave)); F.tid = F.wave * 64 + F.lane; __VA_ARGS__; } ++ph; } while (0)
#define SEAM() do { if (ph > lo && ph < hi) { if (first_seam) { GRIDSYNC(); first_seam = false; } else xcd_barrier(bar, F.wave == 0 && (int)__builtin_amdgcn_mbcnt_hi(~0u, __builtin_amdgcn_mbcnt_lo(~0u, 0u)) == 0); } STAMP(); } while (0)

    STAMP();
    RUN(phase_rope(F, (const int*)args.in[1])); STAMP();
#pragma unroll
    for (int l = 0; l < DEPTH; ++l) {
        const float* xin = (l == 0) ? INF(0) : args.out;
        RUN({ const ProIn I{xin, INF(2), INF(3), INF(15), INF(16), INF(17), INF(18), INF(20), INF(21), INF(12), INF(4), INF(5), INF(6), INF(7), INF(8), (const int*)args.in[1]};
              for (int rep = 0; rep < 1 + ((DUP_MASK >> 4) & 1); ++rep) { phase_prologue(F, l, I); __syncthreads(); } }); SEAM();
#ifndef NO_G1
        RUN({ pg8::Gemm g{F.H(), F.Win_t()}; pg8::StaticOrder<T, NINP> S; S.init(F.G, F.bid);
              pg8::EpiGen<FInProj> E{FInProj{F.ZS(), F.GB(), F.IW(), F.ROPE(), F.IKD()}}; for (int rep = 0; rep < 1 + (DUP_MASK & 1); ++rep) pg8::gemm_phase<T, NINP, DM, DM, DM>(F.lds, g, S, E, F.tid); }); SEAM();
#else
        RUN({}); SEAM();
#endif
        RUN({ for (int rep = 0; rep < 1 + ((DUP_MASK >> 2) & 1); ++rep) { phase_s5_local(F); __syncthreads(); } STAMP();
              for (int rep = 0; rep < 1 + ((DUP_MASK >> 3) & 1); ++rep) { phase_ret_local(F); __syncthreads(); } STAMP();
              for (int rep = 0; rep < 1 + ((DUP_MASK >> 1) & 1); ++rep) { phase_dsa(F); __syncthreads(); } }); SEAM();
        RUN(phase_carry(F)); SEAM();
        RUN({ for (int rep = 0; rep < 1 + ((DUP_MASK >> 2) & 1); ++rep) { phase_s5_out(F, l, INF(9), INF(10), INF(11)); __syncthreads(); } STAMP();
              for (int rep = 0; rep < 1 + ((DUP_MASK >> 3) & 1); ++rep) { phase_ret_out(F, l, INF(14)); __syncthreads(); } }); SEAM();
#ifndef NO_G2
        RUN({ pg8::Gemm g{F.H(), F.Wglu_t()}; pg8::StaticOrder<T, 256> S; S.init(F.G, F.bid);
              pg8::EpiGen<FGlu, 0> E{FGlu{F.H(), INF(13) + l * 256}}; pg8::gemm_phase<T, 256, 256, DM, 256>(F.lds, g, S, E, F.tid); }); SEAM();
#else
        RUN({}); SEAM();
#endif
#ifndef NO_G3
        RUN({ pg8::Gemm g{F.H(), F.Wabc_t()}; pg8::StaticOrder<T, DM> S; S.init(F.G, F.bid);
              EpiMerge E{F.MG(), F.GB()}; for (int rep = 0; rep < 1 + ((DUP_MASK >> 5) & 1); ++rep) pg8::gemm_phase<T, DM, DM, DM, DM>(F.lds, g, S, E, F.tid); }); SEAM();
#else
        RUN({}); SEAM();
#endif
#ifndef NO_G4
        RUN({ pg8::Gemm g{F.MG(), F.Wout_t()}; pg8::StaticOrder<T, DM> S; S.init(F.G, F.bid);
              pg8::EpiGen<FResid> E{FResid{xin, args.out}}; pg8::gemm_phase<T, DM, DM, DM, DM>(F.lds, g, S, E, F.tid); }); SEAM();
#else
        RUN({}); SEAM();
#endif
        RUN({ const int gw = F.bid * NWAVES + F.wave, NGW = F.G * NWAVES; const float* g2 = INF(19) + l * DM;
              for (int rep = 0; rep < 1 + ((DUP_MASK >> 4) & 1); ++rep) for (int m = gw; m < T; m += NGW) rms_row_bf16(args.out + (size_t)m * DM, g2, F.H() + (size_t)m * DM, F.lane); }); SEAM();
#ifndef NO_G5
        RUN({ pg8::Gemm g{F.H(), F.W1_t()}; pg8::StaticOrder<T, FF> S; S.init(F.G, F.bid);
              pg8::EpiGen<FRelu2> E{FRelu2{F.FB()}}; for (int rep = 0; rep < 1 + (DUP_MASK & 1); ++rep) pg8::gemm_phase<T, FF, DM, DM, DM>(F.lds, g, S, E, F.tid); }); SEAM();
#else
        RUN({}); SEAM();
#endif
#ifndef NO_G6
        RUN({ pg8::Gemm g{F.FB(), F.W2_t()}; pg8::StaticOrder<T, DM> S; S.init(F.G, F.bid);
              pg8::EpiGen<FResid> E{FResid{args.out, args.out}}; pg8::gemm_phase<T, DM, FF, FF, FF>(F.lds, g, S, E, F.tid); }); SEAM();
#else
        RUN({}); SEAM();
#endif
    }
    RUN({ const int gw = F.bid * NWAVES + F.wave, NGW = F.G * NWAVES; const float* gf = INF(22);
          for (int m = gw; m < T; m += NGW) rms_row_f32(args.out + (size_t)m * DM, gf, args.out + (size_t)m * DM, F.lane); });
    STAMP();
#ifdef PROBE_LO
    if (F.bid == 0 && F.tid == 0) {
        const int sel[] = PROBE_SEL; unsigned long long tot = 0;
        for (unsigned i = 0; i < sizeof(sel) / sizeof(int); ++i) tot += TSp[sel[i] + 1] - TSp[sel[i]];
        const float us = (float)tot * 0.01f;
        asm volatile("s_waitcnt vmcnt(0)" ::: "memory");
        args.out[0] = sqrtf(us * (float)((size_t)T * DM));
    }
#endif
#undef RUN
#undef SEAM
}

extern "C" void kernel_launch(void* const* d_in, const int* in_sizes, int n_in, void* d_out, int out_size, void* d_ws, size_t ws_size, hipStream_t stream) {
    static int grid = 0;
    if (grid == 0) {
        if (n_in != 23 || out_size != T * DM || ws_size < WS_END) { fprintf(stderr, "kernel_launch: unexpected shapes (n_in %d out %d ws %zu)\n", n_in, out_size, ws_size); grid = -1; return; }
        int dev = 0, cus = 0, per_cu = 0;
        hipGetDevice(&dev); hipDeviceGetAttribute(&cus, hipDeviceAttributeMultiprocessorCount, dev);
        if (hipFuncSetAttribute((const void*)mk_fwd, hipFuncAttributeMaxDynamicSharedMemorySize, LDS_BYTES) != hipSuccess) { fprintf(stderr, "kernel_launch: hipFuncSetAttribute failed\n"); grid = -1; return; }
        if (hipOccupancyMaxActiveBlocksPerMultiprocessor(&per_cu, (const void*)mk_fwd, NTHREADS, LDS_BYTES) != hipSuccess || per_cu < 1) { fprintf(stderr, "kernel_launch: occupancy query says %d\n", per_cu); per_cu = 1; }
        (void)hipGetLastError();
        grid = cus;
    }
    if (grid < 0) return;
    hipMemsetAsync((char*)d_ws + WS_CTL, 0, CTL_ZERO_BYTES, stream);
    Args a{};
    for (int i = 0; i < 23; ++i) a.in[i] = d_in[i];
    a.out = (float*)d_out; a.ws = (unsigned char*)d_ws;
#ifndef MK_SPLIT
    a.ph_lo = 0; a.ph_hi = 1000;
    void* kargs[] = {&a};
    hipError_t e = hipLaunchCooperativeKernel((const void*)mk_fwd, dim3(grid), dim3(NTHREADS), kargs, LDS_BYTES, stream);
    if (e != hipSuccess) fprintf(stderr, "kernel_launch: cooperative launch failed: %s\n", hipGetErrorString(e));
#else
    for (int p = 0; p < 2 * 11 + 2; ++p) { a.ph_lo = p; a.ph_hi = p + 1; hipLaunchKernelGGL(mk_fwd, dim3(grid), dim3(NTHREADS), LDS_BYTES, stream, a); }
#endif
}
```

```cpp
#include <hip/hip_runtime.h>
#include <hip/hip_cooperative_groups.h>
#include <cstdio>
#include <cstdint>
namespace cg = cooperative_groups;

#define LAS __attribute__((address_space(3)))
#define GAS __attribute__((address_space(1)))
typedef unsigned short bf16_t;
typedef short bf16x8 __attribute__((ext_vector_type(8)));
typedef float f32x4 __attribute__((ext_vector_type(4)));
typedef float f32x2 __attribute__((ext_vector_type(2)));
typedef unsigned u32x4 __attribute__((ext_vector_type(4)));
typedef unsigned u32x2 __attribute__((ext_vector_type(2)));

constexpr int NB = 4, SEQ = 8192, T = NB * SEQ, DM = 1024, DEPTH = 2, FF = 4096;
constexpr int NIN = 5156, NINP = 5376;
constexpr int ZSW = 2112, GW = 3072;
constexpr int ZU = 0, ZDQ = 256, ZDK = 640, ZDV = 704, ZIQ = 768, ZIK = 896, ZIWC = 928, ZRQ = 960, ZRK = 1152, ZRV = 1344, ZRG = 1728, ZGATE = 2112, ZEND = 5184;
constexpr int NFREQ = 36;
constexpr float EPS = 1e-6f;

constexpr size_t MiB = 1u << 20;
constexpr size_t WS_CTL = 0, CTL_ZERO_BYTES = 64 * 1024;
constexpr size_t WS_IW = 1 * MiB;
constexpr size_t WS_SP = 1 * MiB + 512 * 1024;
constexpr size_t WS_ROPE = 2 * MiB;
constexpr size_t WS_S5E = 11 * MiB;
constexpr size_t WS_RST = 15 * MiB;
constexpr size_t WS_W = 51 * MiB;
constexpr size_t WO_IN = 0, WO_ABC = WO_IN + (size_t)NINP * DM * 2, WO_OUT = WO_ABC + (size_t)DM * DM * 2, WO_W1 = WO_OUT + (size_t)DM * DM * 2,
                 WO_W2 = WO_W1 + (size_t)FF * DM * 2, WO_GLU = WO_W2 + (size_t)FF * DM * 2, WO_END = WO_GLU + 256 * 256 * 2;
static_assert(WO_END <= 31 * MiB, "weights");
constexpr size_t WS_H = 82 * MiB;
constexpr size_t WS_ZS = 146 * MiB;
constexpr size_t WS_G = 278 * MiB;
constexpr size_t WS_IKD = 470 * MiB;
constexpr size_t WS_END = 472 * MiB;
static_assert(WS_ZS + (size_t)T * ZSW * 2 <= WS_G && WS_G + (size_t)T * GW * 2 <= WS_END && WS_ZS + (size_t)T * FF * 2 <= WS_END, "ws map");
constexpr int CW_BAR = 1024;

constexpr int LDS_BYTES = 160 * 1024;
constexpr int RING_BYTES = 131072;
constexpr int MISC_OFF = LDS_BYTES - 256;

__device__ __forceinline__ unsigned f2bf(float f) { unsigned u = __builtin_bit_cast(unsigned, f); return (u + 0x7fffu + ((u >> 16) & 1u)) >> 16; }
__device__ __forceinline__ unsigned pk2(float lo, float hi) { unsigned r; asm("v_cvt_pk_bf16_f32 %0, %1, %2" : "=v"(r) : "v"(lo), "v"(hi)); return r; }
__device__ __forceinline__ float bf2f(unsigned short v) { return __builtin_bit_cast(float, (unsigned)v << 16); }
__device__ __forceinline__ float bflo(unsigned w) { return __builtin_bit_cast(float, w << 16); }
__device__ __forceinline__ float bfhi(unsigned w) { return __builtin_bit_cast(float, w & 0xffff0000u); }
__device__ __forceinline__ float sigmoidf_(float x) { return __builtin_amdgcn_rcpf(1.0f + __expf(-x)); }
__device__ __forceinline__ float wave_sum(float v) {
#pragma unroll
    for (int o = 1; o < 64; o <<= 1) v += __shfl_xor(v, o);
    return v;
}
__device__ __forceinline__ float wave_max(float v) {
#pragma unroll
    for (int o = 1; o < 64; o <<= 1) v = fmaxf(v, __shfl_xor(v, o));
    return v;
}

#define XB_TMO      128
#define XB_XCNT(j)  (256  + 64 * (j))
#define XB_XSUB(j)  (1280 + 64 * (j))
#define XB_XGEN(j)  (2304 + 64 * (j))
#define XB_TOP      3328
#define XB_TOPGEN   3392
#define XCD_BAR_WORDS 3456
#define XB_SPIN_CAP (1u << 18)
__device__ __forceinline__ unsigned xb_ld(unsigned* p)              { return __hip_atomic_load(p, __ATOMIC_RELAXED, __HIP_MEMORY_SCOPE_AGENT); }
__device__ __forceinline__ unsigned xb_add(unsigned* p, unsigned v) { return __hip_atomic_fetch_add(p, v, __ATOMIC_RELAXED, __HIP_MEMORY_SCOPE_AGENT); }
__device__ __forceinline__ unsigned xb_xcc_id() { return (unsigned)__builtin_amdgcn_s_getreg((3 << 11) | 20) & 0xFu; }
#define XB_SPIN(cond, bar) do { unsigned _sp = 0; while (cond) { __builtin_amdgcn_s_sleep(1); \
    if ((++_sp & 255u) == 0u) { if (xb_ld(&(bar)[XB_TMO])) break; if (_sp > XB_SPIN_CAP) { atomicAdd(&(bar)[XB_TMO], 1u); break; } } } } while (0)
struct XcdBarrier { unsigned* bar; unsigned x; volatile LAS unsigned* st; };
__device__ __forceinline__ XcdBarrier xcd_barrier_post(unsigned* bar, volatile LAS unsigned* st) {
    XcdBarrier b; b.bar = bar; b.x = xb_xcc_id(); b.st = st;
    if (threadIdx.x == 0) (void)xb_add(&bar[XB_XCNT(b.x)], 1u);
    return b;
}
__device__ __forceinline__ void xcd_barrier_complete(unsigned* bar, unsigned x, unsigned& nloc, unsigned& nx) {
    const unsigned G = gridDim.x * gridDim.y * gridDim.z;
    unsigned sum, cnt, mine, sp = 0u;
    for (;;) {
        sum = 0u; cnt = 0u; mine = 0u;
#pragma unroll
        for (unsigned j = 0; j < 16; ++j) { const unsigned c = xb_ld(&bar[XB_XCNT(j)]); sum += c; cnt += (c > 0u) ? 1u : 0u; mine = (j == x) ? c : mine; }
        if (sum == G) break;
        __builtin_amdgcn_s_sleep(1);
        if ((++sp & 255u) == 0u) { if (xb_ld(&bar[XB_TMO])) break; if (sp > XB_SPIN_CAP) { atomicAdd(&bar[XB_TMO], 1u); break; } }
    }
    nloc = mine > 0u ? mine : 1u; nx = cnt > 0u ? cnt : 1u;
}
__device__ __forceinline__ void xcd_barrier(const XcdBarrier& b, bool leader) {
    asm volatile("s_waitcnt vmcnt(0)" ::: "memory");
    __syncthreads();
    if (leader) {
        unsigned* bar = b.bar; unsigned bx = b.x;
        asm volatile("" : "+s"(bar), "+s"(bx));
        __builtin_amdgcn_s_waitcnt(0);
        unsigned nloc = b.st[0], nx = b.st[1];
        if (nloc == 0u) { xcd_barrier_complete(bar, bx, nloc, nx); b.st[0] = nloc; b.st[1] = nx; }
        const unsigned old = xb_add(&bar[XB_XSUB(bx)], 1u);
        const unsigned gen = old / nloc;
        if (old + 1u == (gen + 1u) * nloc) {
            __builtin_amdgcn_fence(__ATOMIC_RELEASE, "agent");
            asm volatile("s_waitcnt vmcnt(0)" ::: "memory");
            const unsigned og = xb_add(&bar[XB_TOP], 1u);
            const unsigned tg = og / nx;
            if (og + 1u == (tg + 1u) * nx) xb_add(&bar[XB_TOPGEN], 1u);
            else XB_SPIN(xb_ld(&bar[XB_TOPGEN]) == tg, bar);
            __builtin_amdgcn_fence(__ATOMIC_ACQUIRE, "agent");
            xb_add(&bar[XB_XGEN(bx)], 1u);
            asm volatile("s_waitcnt vmcnt(0)" ::: "memory");
        } else {
            XB_SPIN(xb_ld(&bar[XB_XGEN(bx)]) == gen, bar);
            __builtin_amdgcn_fence(__ATOMIC_ACQUIRE, "agent");
            asm volatile("s_waitcnt vmcnt(0)" ::: "memory");
        }
    }
    __syncthreads();
}

namespace pg8 {
constexpr int BM = 256, BK = 64, HALF = 128, HTB = HALF * BK * 2, STAGE_BYTES = 8 * HTB, NXCD = 8, WGM = 8;
__host__ __device__ __forceinline__ int lds_byte(int r, int c) { const int st = (r >> 4) * 2 + (c >> 5), rr = r & 15, cc = c & 31, ob = rr * 64 + cc * 2; return st * 1024 + (ob ^ (((ob >> 9) & 1) << 5)); }
__host__ __device__ __forceinline__ void stage_rc(int b, int& R, int& C) { const int st = b / 1024, sb = b % 1024, swz = sb ^ (((sb >> 9) & 1) << 5); R = (st >> 1) * 16 + swz / 64; C = (st & 1) * 32 + (swz % 64) / 2; }
__host__ __device__ __forceinline__ int perm32(int rho) { const int n = rho >> 4, i = rho & 15; return 8 * (i >> 2) + 4 * n + (i & 3); }

struct Unit { int pm, pn; };
struct Gemm { const bf16_t* A; const bf16_t* Bt; };

template <int M, int N> struct StaticOrder {
    static constexpr int nM = M / BM, nN = N / BM, nwg = nM * nN;
    int G, c;
    __host__ __device__ void init(int G_, int c_) { G = G_; c = c_; }
    __host__ __device__ bool next(int i, Unit& u) const {
        const long L = (long)i * G + c; if (L >= nwg) return false;
        int wgid = (int)L; { constexpr int q = nwg / NXCD, r = nwg % NXCD; const int xcd = wgid % NXCD, off = wgid / NXCD; wgid = (xcd < r ? xcd * (q + 1) : r * (q + 1) + (xcd - r) * q) + off; }
        constexpr int nig = WGM * nN; const int gid = wgid / nig, fm = gid * WGM, gsz = (nM - fm) < WGM ? (nM - fm) : WGM;
        u.pm = fm + ((wgid % nig) % gsz); u.pn = (wgid % nig) / gsz; return true;
    }
};

template <class F, int FENCE = 0> struct EpiGen {
    static constexpr bool PERM = true, HAS_MID = false;
    F f;
    __device__ __forceinline__ void operator()(const f32x4 (&acc)[2][2][4][2], const Unit& u, int wr, int wc, int fr, int fq) const {
        const int row0 = u.pm * BM + wr * 64 + fr, col0 = u.pn * BM + wc * 32 + 8 * fq;
#pragma unroll
        for (int ai = 0; ai < 2; ++ai)
#pragma unroll
            for (int m = 0; m < 4; ++m)
#pragma unroll
                for (int bj = 0; bj < 2; ++bj) { f(row0 + ai * HALF + m * 16, col0 + bj * HALF, acc[ai][bj][m][0], acc[ai][bj][m][1]);
                    if constexpr (FENCE > 0) { if (((ai * 4 + m) * 2 + bj) % FENCE == FENCE - 1) asm volatile("" ::: "memory"); } }
    }
};

template <int M, int N, int K, int LDA, int LDB, class Epi, bool ALIGN_EPI = true>
__device__ __forceinline__ void gemm_phase(LAS unsigned char* lds, const Gemm g, const StaticOrder<M, N>& S, const Epi& E, int tid_in) {
    int tid = tid_in; asm volatile("" : "+v"(tid));
    const int wid = __builtin_amdgcn_readfirstlane(tid >> 6), lane = tid & 63, wr = wid >> 2, wc = wid & 3, fr = lane & 15, fq = lane >> 4;
    constexpr int nt = K / BK;
    unsigned voffA[2], voffB[2];
#pragma unroll
    for (int i = 0; i < 2; ++i) { int R, C; stage_rc(tid * 16 + i * 8192, R, C); const int Rb = Epi::PERM ? ((R & ~31) + perm32(R & 31)) : R;
        voffA[i] = (unsigned)(R * LDA + C) * 2u; voffB[i] = (unsigned)(Rb * LDB + C) * 2u; }
    constexpr size_t kstep = (size_t)(BK * 2);
    constexpr size_t hstepA = (size_t)HALF * LDA * 2, hstepB = (size_t)HALF * LDB * 2;
    constexpr size_t tstepA = 2 * hstepA, tstepB = 2 * hstepB;
    const unsigned ldsw = (unsigned)wid * 1024u;
    const int aoff = lds_byte(wr * 64 + fr, fq * 8), boff = lds_byte(wc * 32 + fr, fq * 8);
#define PG8_SA(b, h) (((b) * 2 + (h)) * HTB)
#define PG8_SB(b, h) ((4 + (b) * 2 + (h)) * HTB)
#define PG8_STAGE(bufoff, gbase, voff) do { _Pragma("unroll") for (int _i = 0; _i < 2; ++_i) \
        __builtin_amdgcn_global_load_lds((const unsigned*)((const char*)(gbase) + (voff)[_i]), (LAS unsigned*)(lds + (bufoff) + ldsw + _i * 8192), 16, 0, 0); } while (0)
#define PG8_LDA(dst, b, h) do { _Pragma("unroll") for (int m = 0; m < 4; ++m) _Pragma("unroll") for (int k = 0; k < 2; ++k) dst[m][k] = *(const LAS bf16x8*)(lds + PG8_SA(b, h) + aoff + m * 2048 + k * 1024); } while (0)
#define PG8_LDB(dst, b, h) do { _Pragma("unroll") for (int n = 0; n < 2; ++n) _Pragma("unroll") for (int k = 0; k < 2; ++k) dst[n][k] = *(const LAS bf16x8*)(lds + PG8_SB(b, h) + boff + n * 2048 + k * 1024); } while (0)
#define PG8_MMA(ai, bj, At, Bt) do { __builtin_amdgcn_s_setprio(1); _Pragma("unroll") for (int m = 0; m < 4; ++m) _Pragma("unroll") for (int n = 0; n < 2; ++n) _Pragma("unroll") for (int k = 0; k < 2; ++k) \
        acc[ai][bj][m][n] = __builtin_amdgcn_mfma_f32_16x16x32_bf16(Bt[n][k], At[m][k], acc[ai][bj][m][n], 0, 0, 0); __builtin_amdgcn_s_setprio(0); } while (0)
#define PG8_WAIT_V(n) asm volatile("s_waitcnt vmcnt(" #n ")" ::: "memory")
#define PG8_WAIT_L(n) asm volatile("s_waitcnt lgkmcnt(" #n ")" ::: "memory")
#define PG8_BAR __builtin_amdgcn_s_barrier()
#define PG8_SCHED __builtin_amdgcn_sched_barrier(0)
    Unit cur, nxt; int ui = 0;
    if (!S.next(0, cur)) return;
    f32x4 acc[2][2][4][2];
#pragma unroll
    for (int a = 0; a < 2; ++a)
#pragma unroll
        for (int b = 0; b < 2; ++b)
#pragma unroll
            for (int m = 0; m < 4; ++m)
#pragma unroll
                for (int n = 0; n < 2; ++n) acc[a][b][m][n] = (f32x4){0.f, 0.f, 0.f, 0.f};
    bf16x8 At[4][2], B0[2][2], B1[2][2];
    const char* cA = (const char*)g.A + (size_t)cur.pm * tstepA; const char* cB = (const char*)g.Bt + (size_t)cur.pn * tstepB;
    PG8_STAGE(PG8_SB(0, 0), cB, voffB); PG8_STAGE(PG8_SB(0, 1), cB + hstepB, voffB); PG8_STAGE(PG8_SA(0, 0), cA, voffA); PG8_STAGE(PG8_SA(0, 1), cA + hstepA, voffA);
    if (wr == 1) PG8_BAR;
    PG8_WAIT_V(2); PG8_BAR;
    PG8_STAGE(PG8_SB(1, 0), cB + kstep, voffB); PG8_STAGE(PG8_SA(1, 0), cA + kstep, voffA); PG8_STAGE(PG8_SB(1, 1), cB + hstepB + kstep, voffB);
    PG8_WAIT_V(6); PG8_BAR;
    for (;;) {
        const bool has_next = S.next(ui + 1, nxt);
        const char* nA = has_next ? (const char*)g.A + (size_t)nxt.pm * tstepA : cA; const char* nB = has_next ? (const char*)g.Bt + (size_t)nxt.pn * tstepB : cB;
#pragma unroll 1
        for (int t = 0; t < nt; t += 2) {
            const bool last = (t == nt - 2);
            const char* a1 = cA + (size_t)(t + 1) * kstep;
            const char* a2 = last ? nA : cA + (size_t)(t + 2) * kstep; const char* b2 = last ? nB : cB + (size_t)(t + 2) * kstep;
            const char* a3 = a2 + kstep; const char* b3 = b2 + kstep;
            if constexpr (Epi::HAS_MID) { if (t == Epi::MID0 || t == Epi::MID1) E.mid(acc, cur, t, wr, wc, fr, fq); }
            PG8_LDB(B0, 0, 0); PG8_LDB(B1, 0, 1); PG8_SCHED; PG8_LDA(At, 0, 0); PG8_STAGE(PG8_SA(1, 1), a1 + hstepA, voffA);
            PG8_WAIT_V(8); PG8_WAIT_L(0); PG8_BAR; PG8_MMA(0, 0, At, B0); PG8_MMA(0, 1, At, B1); PG8_BAR; PG8_SCHED;
            PG8_LDA(At, 0, 1); PG8_STAGE(PG8_SB(0, 0), b2, voffB); PG8_STAGE(PG8_SB(0, 1), b2 + hstepB, voffB); PG8_STAGE(PG8_SA(0, 0), a2, voffA);
            PG8_WAIT_V(8); PG8_WAIT_L(0); PG8_BAR; PG8_MMA(1, 0, At, B0); PG8_MMA(1, 1, At, B1); PG8_BAR; PG8_SCHED;
            PG8_LDB(B0, 1, 0); PG8_LDB(B1, 1, 1); PG8_SCHED; PG8_LDA(At, 1, 0); PG8_STAGE(PG8_SA(0, 1), a2 + hstepA, voffA);
            PG8_WAIT_V(8); PG8_WAIT_L(0); PG8_BAR; PG8_MMA(0, 0, At, B0); PG8_MMA(0, 1, At, B1); PG8_BAR; PG8_SCHED;
            PG8_LDA(At, 1, 1); PG8_STAGE(PG8_SB(1, 0), b3, voffB); PG8_STAGE(PG8_SB(1, 1), b3 + hstepB, voffB); PG8_STAGE(PG8_SA(1, 0), a3, voffA);
            PG8_WAIT_V(8); PG8_WAIT_L(0); PG8_BAR; PG8_MMA(1, 0, At, B0); PG8_MMA(1, 1, At, B1); PG8_BAR; PG8_SCHED;
        }
        if constexpr (ALIGN_EPI) { if (wr == 0) PG8_BAR; }
        E(acc, cur, wr, wc, fr, fq);
        if (!has_next) break;
#pragma unroll
        for (int a = 0; a < 2; ++a)
#pragma unroll
            for (int b = 0; b < 2; ++b)
#pragma unroll
                for (int m = 0; m < 4; ++m)
#pragma unroll
                    for (int n = 0; n < 2; ++n) acc[a][b][m][n] = (f32x4){0.f, 0.f, 0.f, 0.f};
        cur = nxt; cA = nA; cB = nB; ++ui;
        if constexpr (ALIGN_EPI) { if (wr == 1) PG8_BAR; }
    }
    PG8_WAIT_V(0);
    if constexpr (!ALIGN_EPI) { if (wr == 0) PG8_BAR; }
    PG8_BAR;
#undef PG8_SA
#undef PG8_SB
#undef PG8_STAGE
#undef PG8_LDA
#undef PG8_LDB
#undef PG8_MMA
#undef PG8_WAIT_V
#undef PG8_WAIT_L
#undef PG8_BAR
#undef PG8_SCHED
}
}

constexpr int NWAVES = 8, NTHREADS = 512;
struct Args { const void* in[23]; float* out; unsigned char* ws; int ph_lo, ph_hi; };
struct Frame {
    LAS unsigned char* lds;
    int tid, lane, wave, G, bid;
    unsigned char* wsb; unsigned zo;
    __device__ __forceinline__ bf16_t* IKD() const { return (bf16_t*)(wsb + zo + WS_IKD); }
    __device__ __forceinline__ float* IW() const { return (float*)(wsb + zo + WS_IW); }
    __device__ __forceinline__ float* SP() const { return (float*)(wsb + zo + WS_SP); }
    __device__ __forceinline__ f32x2* ROPE() const { return (f32x2*)(wsb + zo + WS_ROPE); }
    __device__ __forceinline__ f32x2* S5E() const { return (f32x2*)(wsb + zo + WS_S5E); }
    __device__ __forceinline__ float* RST() const { return (float*)(wsb + zo + WS_RST); }
    __device__ __forceinline__ bf16_t* Win_t() const { return (bf16_t*)(wsb + zo + WS_W + WO_IN); }
    __device__ __forceinline__ bf16_t* Wabc_t() const { return (bf16_t*)(wsb + zo + WS_W + WO_ABC); }
    __device__ __forceinline__ bf16_t* Wout_t() const { return (bf16_t*)(wsb + zo + WS_W + WO_OUT); }
    __device__ __forceinline__ bf16_t* W1_t() const { return (bf16_t*)(wsb + zo + WS_W + WO_W1); }
    __device__ __forceinline__ bf16_t* W2_t() const { return (bf16_t*)(wsb + zo + WS_W + WO_W2); }
    __device__ __forceinline__ bf16_t* Wglu_t() const { return (bf16_t*)(wsb + zo + WS_W + WO_GLU); }
    __device__ __forceinline__ bf16_t* H() const { return (bf16_t*)(wsb + zo + WS_H); }
    __device__ __forceinline__ bf16_t* ZS() const { return (bf16_t*)(wsb + zo + WS_ZS); }
    __device__ __forceinline__ unsigned char* GB() const { return wsb + zo + WS_G; }
    __device__ __forceinline__ bf16_t* MG() const { return (bf16_t*)(wsb + zo + WS_ZS); }
    __device__ __forceinline__ bf16_t* FB() const { return (bf16_t*)(wsb + zo + WS_ZS); }
};
constexpr int SP_LB = 0, SP_L64 = 2048, SP_BBR = 4096, SP_BBI = 4096 + 16384;

__device__ __forceinline__ int ropeperm(int j, int r) { const int half = r >> 1; return (j < r) ? ((j & 1) ? half + (j >> 1) : (j >> 1)) : j; }
__device__ __forceinline__ int zmap(int n) {
    if (n < ZDQ) return n;
    if (n < ZDK) { const int q = n - ZDQ, h = q >> 6, hc = q & 63; return 256 + h * 64 + ropeperm(hc, 16); }
    if (n < ZDV) return 640 + ropeperm(n - ZDK, 16);
    if (n < ZIQ) return 704 + (n - ZDV);
    if (n < ZIK) { const int q = n - ZIQ, h = q >> 5, hc = q & 31; return 768 + h * 32 + ropeperm(hc, 8); }
    if (n < ZIWC) return 896 + ropeperm(n - ZIK, 8);
    if (n < ZRQ) return (n - ZIWC) < 4 ? 928 + (n - ZIWC) : -1;
    if (n < ZRK) { const int q = n - ZRQ, h = q / 48, hc = q % 48; return 932 + h * 48 + ropeperm(hc, 48); }
    if (n < ZRV) { const int q = n - ZRK, h = q / 48, hc = q % 48; return 1124 + h * 48 + ropeperm(hc, 48); }
    if (n < ZRG) return 1316 + (n - ZRV);
    if (n < ZGATE) return 1700 + (n - ZRG);
    if (n < ZEND) return 2084 + (n - ZGATE);
    return -1;
}

__device__ __forceinline__ void tr_item(const float* W, int N, int kb, int nb, bf16_t* WT, int ldd, int koff, bool mapped, LAS float* scr, int lane) {
    const int k0 = 64 * kb, n0 = 32 * nb;
    const int c32 = lane & 31; int sc = n0 + c32; if (mapped) sc = zmap(sc);
#pragma unroll 8
    for (int i = 0; i < 32; ++i) { const int kk = 2 * i + (lane >> 5); scr[kk * 33 + c32] = (sc >= 0) ? W[(size_t)(k0 + kk) * N + sc] : 0.f; }
    asm volatile("s_waitcnt lgkmcnt(0)" ::: "memory");
    const int c = lane & 7;
#pragma unroll
    for (int j = 0; j < 4; ++j) { const int n = (lane >> 3) + 8 * j; const LAS float* s = scr + (8 * c) * 33 + n;
        u32x4 o; o.x = pk2(s[0 * 33], s[1 * 33]); o.y = pk2(s[2 * 33], s[3 * 33]); o.z = pk2(s[4 * 33], s[5 * 33]); o.w = pk2(s[6 * 33], s[7 * 33]);
        *(u32x4*)(WT + (size_t)(n0 + n) * ldd + koff + k0 + 8 * c) = o; }
    asm volatile("s_waitcnt lgkmcnt(0)" ::: "memory");
}

__device__ __forceinline__ void rms_row_bf16(const float* xrow, const float* gain, bf16_t* orow, int lane) {
    const f32x4* xr = (const f32x4*)xrow + lane; const f32x4* gr = (const f32x4*)gain + lane;
    f32x4 v[4]; float s = 0.f;
#pragma unroll
    for (int j = 0; j < 4; ++j) { v[j] = xr[64 * j]; s += (v[j].x * v[j].x + v[j].y * v[j].y) + (v[j].z * v[j].z + v[j].w * v[j].w); }
    const float rstd = rsqrtf(wave_sum(s) * (1.f / DM) + EPS);
    u32x2* o8 = (u32x2*)orow + lane;
#pragma unroll
    for (int j = 0; j < 4; ++j) { const f32x4 gg = gr[64 * j]; u32x2 w; w.x = pk2(v[j].x * rstd * gg.x, v[j].y * rstd * gg.y); w.y = pk2(v[j].z * rstd * gg.z, v[j].w * rstd * gg.w); o8[64 * j] = w; }
}
__device__ __forceinline__ void rms_row_f32(const float* xrow, const float* gain, float* orow, int lane) {
    const f32x4* xr = (const f32x4*)xrow + lane; const f32x4* gr = (const f32x4*)gain + lane;
    f32x4 v[4]; float s = 0.f;
#pragma unroll
    for (int j = 0; j < 4; ++j) { v[j] = xr[64 * j]; s += (v[j].x * v[j].x + v[j].y * v[j].y) + (v[j].z * v[j].z + v[j].w * v[j].w); }
    const float rstd = rsqrtf(wave_sum(s) * (1.f / DM) + EPS);
    f32x4* o = (f32x4*)orow + lane;
#pragma unroll
    for (int j = 0; j < 4; ++j) { const f32x4 gg = gr[64 * j]; o[64 * j] = v[j] * rstd * gg; }
}


__device__ __forceinline__ void phase_rope(Frame& F, const int* pos) {
    const int gt = F.bid * NTHREADS + F.tid, NT = F.G * NTHREADS;
    f32x2* RT = F.ROPE();
    for (int e = gt; e < T * NFREQ; e += NT) {
        const int tok = e / NFREQ, f = e % NFREQ;
        float lth, sc; int fi;
        if (f < 8) { lth = 13.122363377404328f; sc = 2.0f / 16.0f; fi = f; } else if (f < 12) { lth = 13.122363377404328f; sc = 2.0f / 8.0f; fi = f - 8; } else { lth = 9.210340371976184f; sc = 2.0f / 48.0f; fi = f - 12; }
        const float inv = expf(-lth * (float)fi * sc);
        const float p = (float)pos[tok];
        const float ang = p * inv;
        const float kq = rintf(ang * 0.15915494309189535f);
        float r = fmaf(-kq, 6.2831854820251465f, ang);
        r = fmaf(-kq, -1.7484555e-7f, r);
        RT[e] = (f32x2){cosf(r), sinf(r)};
    }
}

struct ProIn { const float *xin, *norm1_g, *w_in, *wa, *wb, *wc, *wo, *w1, *w2, *wg, *lam_re, *lam_im, *log_step, *b_re, *b_im; const int* pos; };
__device__ __forceinline__ void phase_prologue(Frame& F, int l, const ProIn& I) {
#ifdef NO_PHASE_PROLOGUE
    return;
#endif
    LAS float* scr = (LAS float*)(F.lds + F.wave * 16384);
    const int gw = F.bid * NWAVES + F.wave, NGW = F.G * NWAVES;
    constexpr int I_IN = 16 * (NINP / 32), I_A = 4 * 32, I_B = 6 * 32, I_C = 6 * 32, I_O = 16 * 32, I_1 = 16 * 128, I_2 = 64 * 32, I_G = 4 * 8;
    constexpr int NITEMS = I_IN + I_A + I_B + I_C + I_O + I_1 + I_2 + I_G;
    const float* w_in = I.w_in + (size_t)l * DM * NIN; const float* wa = I.wa + (size_t)l * 256 * DM; const float* wb = I.wb + (size_t)l * 384 * DM;
    const float* wc = I.wc + (size_t)l * 384 * DM; const float* wo = I.wo + (size_t)l * DM * DM; const float* w1 = I.w1 + (size_t)l * DM * FF;
    const float* w2 = I.w2 + (size_t)l * FF * DM; const float* wg = I.wg + (size_t)l * 256 * 256;
    for (int it = gw; it < NITEMS; it += NGW) {
        int r = it;
        if (r < I_IN) { tr_item(w_in, NIN, r / (NINP / 32), r % (NINP / 32), F.Win_t(), DM, 0, true, scr, F.lane); continue; } r -= I_IN;
        if (r < I_A) { tr_item(wa, DM, r / 32, r % 32, F.Wabc_t(), DM, 0, false, scr, F.lane); continue; } r -= I_A;
        if (r < I_B) { tr_item(wb, DM, r / 32, r % 32, F.Wabc_t(), DM, 256, false, scr, F.lane); continue; } r -= I_B;
        if (r < I_C) { tr_item(wc, DM, r / 32, r % 32, F.Wabc_t(), DM, 640, false, scr, F.lane); continue; } r -= I_C;
        if (r < I_O) { tr_item(wo, DM, r / 32, r % 32, F.Wout_t(), DM, 0, false, scr, F.lane); continue; } r -= I_O;
        if (r < I_1) { tr_item(w1, FF, r / 128, r % 128, F.W1_t(), DM, 0, false, scr, F.lane); continue; } r -= I_1;
        if (r < I_2) { tr_item(w2, DM, r / 32, r % 32, F.W2_t(), FF, 0, false, scr, F.lane); continue; } r -= I_2;
        tr_item(wg, 256, r / 8, r % 8, F.Wglu_t(), 256, 0, false, scr, F.lane);
    }
    {
        const int gt = F.bid * NTHREADS + F.tid;
        if (gt < 1024) {
            float* SPp = F.SP();
            const int g = gt >> 6, p = gt & 63;
            const float lr = I.lam_re[(l * 16 + g) * 64 + p], li = I.lam_im[(l * 16 + g) * 64 + p];
            const float step = expf(I.log_step[l * 16 + g]);
            const float mag = expf(lr * step); const float lbr = mag * cosf(li * step), lbi = mag * sinf(li * step);
            const float den = lr * lr + li * li;
            const float fr = ((lbr - 1.f) * lr + lbi * li) / den, fi = (lbi * lr - (lbr - 1.f) * li) / den;
            SPp[SP_LB + gt * 2] = lbr; SPp[SP_LB + gt * 2 + 1] = lbi;
            float pr = lbr, pi = lbi;
#pragma unroll
            for (int s = 0; s < 6; ++s) { const float nr = pr * pr - pi * pi, ni = 2.f * pr * pi; pr = nr; pi = ni; }
            SPp[SP_L64 + gt * 2] = pr; SPp[SP_L64 + gt * 2 + 1] = pi;
            const float* br = I.b_re + ((size_t)(l * 16 + g) * 64 + p) * 16; const float* bi = I.b_im + ((size_t)(l * 16 + g) * 64 + p) * 16;
#pragma unroll
            for (int c = 0; c < 16; ++c) { SPp[SP_BBR + gt * 16 + c] = fr * br[c] - fi * bi[c]; SPp[SP_BBI + gt * 16 + c] = fr * bi[c] + fi * br[c]; }
        }
    }
    for (int m = gw; m < T; m += NGW) rms_row_bf16(I.xin + (size_t)m * DM, I.norm1_g + l * DM, F.H() + (size_t)m * DM, F.lane);
}

__device__ __forceinline__ u32x4 pack8(const f32x4& a, const f32x4& b) { u32x4 w; w.x = pk2(a.x, a.y); w.y = pk2(a.z, a.w); w.z = pk2(b.x, b.y); w.w = pk2(b.z, b.w); return w; }
__device__ __forceinline__ void unpack8(const u32x4& w, f32x4& a, f32x4& b) { a = (f32x4){bflo(w.x), bfhi(w.x), bflo(w.y), bfhi(w.y)}; b = (f32x4){bflo(w.z), bfhi(w.z), bflo(w.w), bfhi(w.w)}; }

__device__ __forceinline__ unsigned gate1_u8(float x) { const float s = 255.f * sigmoidf_(x) + 0.5f; const unsigned u = (unsigned)s; return u < 1u ? 1u : u; }
__device__ __forceinline__ unsigned gate4_u8(const f32x4& a) { return gate1_u8(a.x) | (gate1_u8(a.y) << 8) | (gate1_u8(a.z) << 16) | (gate1_u8(a.w) << 24); }
__device__ __forceinline__ void ungate8(const u32x2& w, f32x4& a, f32x4& b) {
    a = (f32x4){(float)(w.x & 255u), (float)((w.x >> 8) & 255u), (float)((w.x >> 16) & 255u), (float)(w.x >> 24)};
    b = (f32x4){(float)(w.y & 255u), (float)((w.y >> 8) & 255u), (float)((w.y >> 16) & 255u), (float)(w.y >> 24)};
}
struct FInProj {
    bf16_t* ZS; unsigned char* GB; float* IW; const f32x2* ROPE; bf16_t* IKD;
    __device__ __forceinline__ void rope8(f32x4& a, f32x4& b, int row, int f0) const {
        const f32x2* rt = ROPE + (size_t)row * NFREQ + f0;
        const f32x2 c0 = rt[0], c1 = rt[1], c2 = rt[2], c3 = rt[3];
        f32x4 oa, ob;
        oa.x = a.x * c0.x - a.y * c0.y; oa.y = a.y * c0.x + a.x * c0.y;
        oa.z = a.z * c1.x - a.w * c1.y; oa.w = a.w * c1.x + a.z * c1.y;
        ob.x = b.x * c2.x - b.y * c2.y; ob.y = b.y * c2.x + b.x * c2.y;
        ob.z = b.z * c3.x - b.w * c3.y; ob.w = b.w * c3.x + b.z * c3.y;
        a = oa; b = ob;
    }
    __device__ __forceinline__ void operator()(int row, int col, f32x4 a, f32x4 b) const {
        if (col >= ZEND) return;
        if (col >= ZGATE) {
            *(u32x2*)(GB + (size_t)row * GW + (col - ZGATE)) = (u32x2){gate4_u8(a), gate4_u8(b)}; return;
        }
        if (col >= ZIWC && col < ZRQ) { if (col == ZIWC) *(f32x4*)(IW + (size_t)row * 4) = a; return; }
        if (col >= ZDQ && col < ZDV) { const int hc = (col - ZDQ) & 63; if (hc < 16) rope8(a, b, row, hc >> 1); }
        else if (col >= ZIQ && col < ZIWC) { const int hc = (col - ZIQ) & 31; if (hc < 8) rope8(a, b, row, 8);
            if (col >= ZIK) { *(u32x4*)(IKD + ((size_t)((row >> 5) * 4 + ((col - ZIK) >> 3)) * 32 + (row & 31)) * 8) = pack8(a, b); return; } }
        else if (col >= ZRQ && col < ZRV) { const int hc = (col - ZRQ) % 48; rope8(a, b, row, 12 + (hc >> 1)); }
        *(u32x4*)(ZS + (size_t)row * ZSW + col) = pack8(a, b);
    }
};
struct FMerge {
    bf16_t* MG; const bf16_t* GB; int br;
    __device__ __forceinline__ void operator()(int row, int col, f32x4 a, f32x4 b) const {
        f32x4 ga, gb; unpack8(*(const u32x4*)(GB + (size_t)row * GW + br * DM + col), ga, gb);
        a = a * ga; b = b * gb;
        u32x4* mp = (u32x4*)(MG + (size_t)row * DM + col);
        if (br != 0) { f32x4 pa, pb; unpack8(*mp, pa, pb); a = a + pa; b = b + pb; }
        *mp = pack8(a, b);
    }
};
struct FResid {
    const float* base; float* out;
    __device__ __forceinline__ void operator()(int row, int col, f32x4 a, f32x4 b) const {
        const f32x4* bp = (const f32x4*)(base + (size_t)row * DM + col); f32x4* op = (f32x4*)(out + (size_t)row * DM + col);
        const f32x4 b0 = bp[0], b1 = bp[1]; op[0] = b0 + a; op[1] = b1 + b;
    }
};
struct FRelu2 {
    bf16_t* FB;
    __device__ __forceinline__ void operator()(int row, int col, f32x4 a, f32x4 b) const {
        a = (f32x4){fmaxf(a.x, 0.f), fmaxf(a.y, 0.f), fmaxf(a.z, 0.f), fmaxf(a.w, 0.f)}; b = (f32x4){fmaxf(b.x, 0.f), fmaxf(b.y, 0.f), fmaxf(b.z, 0.f), fmaxf(b.w, 0.f)};
        *(u32x4*)(FB + (size_t)row * FF + col) = pack8(a * a, b * b);
    }
};
struct FGlu {
    bf16_t* H; const float* bias;
    __device__ __forceinline__ void operator()(int row, int col, f32x4 a, f32x4 b) const {
        u32x4* hp = (u32x4*)(H + (size_t)row * DM + col); f32x4 ya, yb; unpack8(*hp, ya, yb);
        const f32x4 ba = *(const f32x4*)(bias + col), bb = *(const f32x4*)(bias + col + 4);
        a = a + ba; b = b + bb;
        a = (f32x4){ya.x * sigmoidf_(a.x), ya.y * sigmoidf_(a.y), ya.z * sigmoidf_(a.z), ya.w * sigmoidf_(a.w)};
        b = (f32x4){yb.x * sigmoidf_(b.x), yb.y * sigmoidf_(b.y), yb.z * sigmoidf_(b.z), yb.w * sigmoidf_(b.w)};
        *hp = pack8(a, b);
    }
};

struct EpiMerge {
    static constexpr bool PERM = true, HAS_MID = true; static constexpr int MID0 = 4, MID1 = 10;
    bf16_t* MG; const unsigned char* GB;
    __device__ __forceinline__ void mid(f32x4 (&acc)[2][2][4][2], const pg8::Unit& u, int t, int wr, int wc, int fr, int fq) const {
        int zz = 0; asm volatile("" : "+v"(zz));
        const int row0 = u.pm * 256 + wr * 64 + fr + zz, col0 = u.pn * 256 + wc * 32 + 8 * fq, bp = (t == MID0) ? 0 : 1;
#pragma unroll
        for (int ai = 0; ai < 2; ++ai)
#pragma unroll
            for (int m = 0; m < 4; ++m) {
#pragma unroll
                for (int bj = 0; bj < 2; ++bj) {
                    const unsigned char* gp = GB + (size_t)(row0 + ai * 128 + m * 16) * GW + bp * DM + col0 + bj * 128;
                    f32x4 pa, pb, na, nb; ungate8(*(const u32x2*)gp, pa, pb); ungate8(*(const u32x2*)(gp + DM), na, nb);
                    const f32x4 fa = {pa.x * __builtin_amdgcn_rcpf(na.x), pa.y * __builtin_amdgcn_rcpf(na.y), pa.z * __builtin_amdgcn_rcpf(na.z), pa.w * __builtin_amdgcn_rcpf(na.w)};
                    const f32x4 fb = {pb.x * __builtin_amdgcn_rcpf(nb.x), pb.y * __builtin_amdgcn_rcpf(nb.y), pb.z * __builtin_amdgcn_rcpf(nb.z), pb.w * __builtin_amdgcn_rcpf(nb.w)};
                    acc[ai][bj][m][0] = acc[ai][bj][m][0] * fa; acc[ai][bj][m][1] = acc[ai][bj][m][1] * fb;
                }
                if (m == 3) asm volatile("" ::: "memory");
            }
    }
    __device__ __forceinline__ void operator()(const f32x4 (&acc)[2][2][4][2], const pg8::Unit& u, int wr, int wc, int fr, int fq) const {
        const int row0 = u.pm * 256 + wr * 64 + fr, col0 = u.pn * 256 + wc * 32 + 8 * fq;
#pragma unroll
        for (int ai = 0; ai < 2; ++ai)
#pragma unroll
            for (int m = 0; m < 4; ++m)
#pragma unroll
                for (int bj = 0; bj < 2; ++bj) {
                    const int row = row0 + ai * 128 + m * 16, col = col0 + bj * 128;
                    f32x4 ga, gb; ungate8(*(const u32x2*)(GB + (size_t)row * GW + 2 * DM + col), ga, gb);
                    *(u32x4*)(MG + (size_t)row * DM + col) = pack8(acc[ai][bj][m][0] * (ga * (1.f / 255.f)), acc[ai][bj][m][1] * (gb * (1.f / 255.f)));
                }
    }
};

typedef float f32x16 __attribute__((ext_vector_type(16)));
__device__ __forceinline__ float gelu_tanh(float x) { const float u = 0.7978845608028654f * (x + 0.044715f * x * x * x); const float e = __expf(2.f * u); const float th = 1.f - 2.f * __builtin_amdgcn_rcpf(e + 1.f); return 0.5f * x * (1.f + th); }
constexpr int S5_XSTR = 272;
constexpr int S5_WAVE_LDS = 2 * 16 * S5_XSTR;
template <bool OUT>
__device__ __forceinline__ void s5_pass(Frame& F, int l, const float* c_re, const float* c_im, const float* ssm_d) {
    const bf16_t* ZSp = F.ZS(); const float* SPp = F.SP(); f32x2* S5Ep = F.S5E();
    LAS unsigned char* XL = F.lds + F.wave * S5_WAVE_LDS;
    for (int task = F.bid * NWAVES + F.wave; task < 256 * 16; task += F.G * NWAVES) {
        int lane = F.lane; asm volatile("" : "+v"(lane));
        const int n = lane & 31, hh = lane >> 5, l15 = lane & 15, kg = lane >> 4;
        const int g = task & 15, pp = task >> 4, cmine = 2 * pp + hh;
        bf16x8 bbf[2][2];
#pragma unroll
        for (int st = 0; st < 2; ++st) { const float* br = SPp + SP_BBR + (size_t)(g * 64 + 2 * n + st) * 16 + 8 * hh; const float* bi = SPp + SP_BBI + (size_t)(g * 64 + 2 * n + st) * 16 + 8 * hh;
            bbf[st][0] = __builtin_bit_cast(bf16x8, pack8(*(const f32x4*)br, *(const f32x4*)(br + 4))); bbf[st][1] = __builtin_bit_cast(bf16x8, pack8(*(const f32x4*)bi, *(const f32x4*)(bi + 4))); }
        const f32x4 lb = *(const f32x4*)(SPp + SP_LB + (g * 64 + 2 * n) * 2);
        f32x4 x = {0.f, 0.f, 0.f, 0.f};
        if constexpr (OUT) x = *(const f32x4*)(S5Ep + (size_t)(cmine * 16 + g) * 64 + 2 * n);
        bf16x8 cf[4]; f32x4 dsk = {0.f, 0.f, 0.f, 0.f};
        if constexpr (OUT) {
#pragma unroll
            for (int ks = 0; ks < 4; ++ks) { const float* cp = ((ks < 2) ? c_re : c_im) + ((size_t)(l * 16 + g) * 16 + l15) * 64 + 32 * (ks & 1) + 8 * kg;
                f32x4 a = *(const f32x4*)cp, b = *(const f32x4*)(cp + 4); if (ks >= 2) { a = -a; b = -b; }
                cf[ks] = __builtin_bit_cast(bf16x8, pack8(a, b)); }
            dsk = *(const f32x4*)(ssm_d + (l * 16 + g) * 16 + 4 * kg);
        }
        const bf16_t* urow = ZSp + (size_t)((2 * pp + ((n >> 2) & 1)) * 64 + 4 * (n >> 3) + (n & 3)) * ZSW + ZU + g * 16 + 8 * hh;
#pragma unroll 1
        for (int k = 0; k < 4; ++k) {
            const bf16x8 uf = *(const bf16x8*)(urow + (size_t)(16 * k) * ZSW);
            const f32x16 z16 = {0.f, 0.f, 0.f, 0.f, 0.f, 0.f, 0.f, 0.f, 0.f, 0.f, 0.f, 0.f, 0.f, 0.f, 0.f, 0.f};
            const f32x16 r0 = __builtin_amdgcn_mfma_f32_32x32x16_bf16(uf, bbf[0][0], z16, 0, 0, 0), i0 = __builtin_amdgcn_mfma_f32_32x32x16_bf16(uf, bbf[0][1], z16, 0, 0, 0);
            const f32x16 r1 = __builtin_amdgcn_mfma_f32_32x32x16_bf16(uf, bbf[1][0], z16, 0, 0, 0), i1 = __builtin_amdgcn_mfma_f32_32x32x16_bf16(uf, bbf[1][1], z16, 0, 0, 0);
#pragma unroll
            for (int t = 0; t < 16; ++t) {
                const float nr0 = lb.x * x.x - lb.y * x.y + r0[t], ni0 = lb.x * x.y + lb.y * x.x + i0[t];
                const float nr1 = lb.z * x.z - lb.w * x.w + r1[t], ni1 = lb.z * x.w + lb.w * x.z + i1[t];
                x = (f32x4){nr0, ni0, nr1, ni1};
                if constexpr (OUT) { LAS unsigned* xw = (LAS unsigned*)(XL + (hh * 16 + t) * S5_XSTR + 4 * n); xw[0] = pk2(nr0, nr1); xw[32] = pk2(ni0, ni1); }
            }
            if constexpr (OUT) {
                asm volatile("s_waitcnt lgkmcnt(0)" ::: "memory");
#pragma unroll
                for (int sel = 0; sel < 2; ++sel) {
                    f32x4 y = {0.f, 0.f, 0.f, 0.f};
#pragma unroll
                    for (int ks = 0; ks < 4; ++ks) { const bf16x8 xf = *(const LAS bf16x8*)(XL + (sel * 16 + l15) * S5_XSTR + (32 * ks + 8 * kg) * 2); y = __builtin_amdgcn_mfma_f32_16x16x32_bf16(cf[ks], xf, y, 0, 0, 0); }
                    const size_t tok = (size_t)(2 * pp + sel) * 64 + 16 * k + l15;
                    const u32x2 uw = *(const u32x2*)(ZSp + tok * ZSW + ZU + g * 16 + 4 * kg);
                    const float y0 = gelu_tanh(y.x + dsk.x * bflo(uw.x)), y1 = gelu_tanh(y.y + dsk.y * bfhi(uw.x)), y2 = gelu_tanh(y.z + dsk.z * bflo(uw.y)), y3 = gelu_tanh(y.w + dsk.w * bfhi(uw.y));
                    *(u32x2*)(F.H() + tok * DM + g * 16 + 4 * kg) = (u32x2){pk2(y0, y1), pk2(y2, y3)};
                }
                asm volatile("s_waitcnt lgkmcnt(0)" ::: "memory");
            }
        }
        if constexpr (!OUT) *(f32x4*)(S5Ep + (size_t)(cmine * 16 + g) * 64 + 2 * n) = x;
    }
}
__device__ __forceinline__ void phase_s5_local(Frame& F) {
#ifdef NO_PHASE_S5_LOCAL
    return;
#endif
    s5_pass<false>(F, 0, nullptr, nullptr, nullptr);
}
__device__ __forceinline__ void phase_s5_out(Frame& F, int l, const float* c_re, const float* c_im, const float* ssm_d) {
#ifdef NO_PHASE_S5_OUT
    return;
#endif
    s5_pass<true>(F, l, c_re, c_im, ssm_d);
}

__device__ __forceinline__ void phase_carry(Frame& F) {
#ifdef NO_PHASE_CARRY
    return;
#endif
    const float* SPp = F.SP(); f32x2* S5Ep = F.S5E(); float* RSTp = F.RST();
    const int gw = F.bid * NWAVES + F.wave, NGW = F.G * NWAVES;
    for (int task = gw; task < NB * 16; task += NGW) {
        const int b = task >> 4, g = task & 15, p = F.lane;
        const float ar = SPp[SP_L64 + (g * 64 + p) * 2], ai = SPp[SP_L64 + (g * 64 + p) * 2 + 1];
        float sr = 0.f, si = 0.f;
        for (int c0 = 0; c0 < 128; c0 += 16) {
            f32x2 e[16];
#pragma unroll
            for (int j = 0; j < 16; ++j) e[j] = S5Ep[(size_t)((b * 128 + c0 + j) * 16 + g) * 64 + p];
#pragma unroll
            for (int j = 0; j < 16; ++j) { S5Ep[(size_t)((b * 128 + c0 + j) * 16 + g) * 64 + p] = (f32x2){sr, si}; const float nr = ar * sr - ai * si + e[j].x, ni = ar * si + ai * sr + e[j].y; sr = nr; si = ni; }
        }
    }
    const int NT = F.G * NTHREADS;
    for (int gt = F.bid * NTHREADS + F.tid; gt < NB * 4 * 4608; gt += NT) {
        const int b = gt / (4 * 4608), h = (gt / 4608) & 3, el = gt % 4608;
        const float lg = log1pf(-exp2f(-5.f - (float)h));
        const float cdec = expf(lg * 64.f);
        float s = 0.f;
        for (int c0 = 0; c0 < 128; c0 += 16) {
            float d[16];
#pragma unroll
            for (int j = 0; j < 16; ++j) d[j] = RSTp[(size_t)((b * 128 + c0 + j) * 4 + h) * 4608 + el];
#pragma unroll
            for (int j = 0; j < 16; ++j) { RSTp[(size_t)((b * 128 + c0 + j) * 4 + h) * 4608 + el] = s; s = s * cdec + d[j]; }
        }
    }
}

typedef float f32x16 __attribute__((ext_vector_type(16)));
typedef short s16x4 __attribute__((ext_vector_type(4)));
__device__ __forceinline__ bf16x8 tr8(const LAS unsigned char* a0, const LAS unsigned char* a1) {
    const s16x4 lo = __builtin_bit_cast(s16x4, __builtin_amdgcn_ds_read_tr16_b64_v4i16((LAS s16x4*)a0));
    const s16x4 hi = __builtin_bit_cast(s16x4, __builtin_amdgcn_ds_read_tr16_b64_v4i16((LAS s16x4*)a1));
    return (bf16x8){lo[0], lo[1], lo[2], lo[3], hi[0], hi[1], hi[2], hi[3]};
}
__device__ __forceinline__ bf16x8 pack8f(const f32x4& a, const f32x4& b) { return __builtin_bit_cast(bf16x8, pack8(a, b)); }
__device__ __forceinline__ void ret_stage_v(const bf16_t* ZSp, LAS unsigned char* Vb, int tok0, int h, int lane) {
#pragma unroll
    for (int n = 0; n < 12; ++n) { const int o = n * 1024 + 16 * lane, r = o / 192, ch = (o % 192) >> 4;
        __builtin_amdgcn_global_load_lds((const unsigned*)(ZSp + (size_t)(tok0 + r) * ZSW + ZRV + h * 96 + ch * 8), (LAS unsigned*)(Vb + n * 1024), 16, 0, 0); }
}
constexpr int RET_VB = 12288, RET_KSTR = 112, RET_WAVE_LDS = RET_VB + 64 * RET_KSTR;
__device__ __forceinline__ void phase_ret_local(Frame& F) {
#ifdef NO_PHASE_RET_LOCAL
    return;
#endif
    const bf16_t* ZSp = F.ZS(); float* RSTp = F.RST();
    LAS unsigned char* Vb = F.lds + F.wave * RET_WAVE_LDS; LAS unsigned char* Kb = Vb + RET_VB;
    for (int item = F.bid * NWAVES + F.wave; item < 2048; item += F.G * NWAVES) {
        int lane = F.lane; asm volatile("" : "+v"(lane));
        const int l31 = lane & 31, hh = lane >> 5, g1 = (lane >> 4) & 1, q4 = (lane & 15) >> 2, p4 = lane & 3;
        const int h = item & 3, tok0 = (item >> 2) * 64;
        ret_stage_v(ZSp, Vb, tok0, h, lane);
        const float lg2 = log2f(1.f - exp2f(-5.f - (float)h));
#pragma unroll
        for (int n = 0; n < 6; ++n) { const int idx = n * 64 + lane, r = idx / 6, ch = idx % 6;
            f32x4 a, b; unpack8(*(const u32x4*)(ZSp + (size_t)(tok0 + r) * ZSW + ZRK + h * 48 + ch * 8), a, b);
            const float sc = 0.14433756729740643f * exp2f(lg2 * (float)(63 - r));
            *(LAS u32x4*)(Kb + r * RET_KSTR + ch * 16) = pack8(a * sc, b * sc); }
        asm volatile("s_waitcnt vmcnt(0) lgkmcnt(0)" ::: "memory");
        f32x16 acc[3][2];
#pragma unroll
        for (int me = 0; me < 3; ++me)
#pragma unroll
            for (int nt = 0; nt < 2; ++nt) acc[me][nt] = (f32x16){0.f, 0.f, 0.f, 0.f, 0.f, 0.f, 0.f, 0.f, 0.f, 0.f, 0.f, 0.f, 0.f, 0.f, 0.f, 0.f};
#pragma unroll
        for (int s = 0; s < 4; ++s) {
            const int r0 = 16 * s + 8 * hh + q4;
            bf16x8 kf[2], vf[3];
#pragma unroll
            for (int nt = 0; nt < 2; ++nt) { const LAS unsigned char* a0 = Kb + r0 * RET_KSTR + (32 * nt + 16 * g1 + 4 * p4) * 2; kf[nt] = tr8(a0, a0 + 4 * RET_KSTR); }
#pragma unroll
            for (int me = 0; me < 3; ++me) { const LAS unsigned char* a0 = Vb + r0 * 192 + (32 * me + 16 * g1 + 4 * p4) * 2; vf[me] = tr8(a0, a0 + 4 * 192); }
#pragma unroll
            for (int me = 0; me < 3; ++me)
#pragma unroll
                for (int nt = 0; nt < 2; ++nt) acc[me][nt] = __builtin_amdgcn_mfma_f32_32x32x16_bf16(vf[me], kf[nt], acc[me][nt], 0, 0, 0);
        }
        float* dst = RSTp + (size_t)item * 4608 + (4 * hh) * 48 + l31;
#pragma unroll
        for (int me = 0; me < 3; ++me)
#pragma unroll
            for (int r4 = 0; r4 < 4; ++r4) {
                int zz = 0; asm volatile("" : "+v"(zz)); float* dp = dst + (32 * me + 8 * r4) * 48 + zz;
#pragma unroll
                for (int k = 0; k < 4; ++k) { dp[k * 48] = acc[me][0][4 * r4 + k]; if (l31 < 16) dp[k * 48 + 32] = acc[me][1][4 * r4 + k]; }
            }
        asm volatile("s_waitcnt lgkmcnt(0)" ::: "memory");
    }
}
__device__ __forceinline__ void phase_ret_out(Frame& F, int l, const float* ret_norm_g) {
#ifdef NO_PHASE_RET_OUT
    return;
#endif
    const bf16_t* ZSp = F.ZS(); const float* RSTp = F.RST();
    LAS unsigned char* Vb = F.lds + F.wave * RET_WAVE_LDS;
    for (int item = F.bid * NWAVES + F.wave; item < 2048; item += F.G * NWAVES) {
        int lane = F.lane; asm volatile("" : "+v"(lane));
        const int l31 = lane & 31, hh = lane >> 5, g1 = (lane >> 4) & 1, q4 = (lane & 15) >> 2, p4 = lane & 3;
        const int h = item & 3, tok0 = (item >> 2) * 64;
        ret_stage_v(ZSp, Vb, tok0, h, lane);
        const float lg2 = log2f(1.f - exp2f(-5.f - (float)h));
        bf16x8 qf[2][3], kf[2][3];
#pragma unroll
        for (int t = 0; t < 2; ++t)
#pragma unroll
            for (int ks = 0; ks < 3; ++ks) { const size_t ro = (size_t)(tok0 + 32 * t + l31) * ZSW + h * 48 + 8 * hh + 16 * ks;
                qf[t][ks] = *(const bf16x8*)(ZSp + ro + ZRQ); kf[t][ks] = *(const bf16x8*)(ZSp + ro + ZRK); }
        bf16x8 pm[2][4];
#pragma unroll
        for (int mt = 0; mt < 2; ++mt)
#pragma unroll
            for (int nt = mt; nt < 2; ++nt) {
                f32x16 p = {0.f, 0.f, 0.f, 0.f, 0.f, 0.f, 0.f, 0.f, 0.f, 0.f, 0.f, 0.f, 0.f, 0.f, 0.f, 0.f};
#pragma unroll
                for (int ks = 0; ks < 3; ++ks) p = __builtin_amdgcn_mfma_f32_32x32x16_bf16(kf[mt][ks], qf[nt][ks], p, 0, 0, 0);
                const int i = 32 * nt + l31;
#pragma unroll
                for (int r = 0; r < 16; ++r) { const int j = 32 * mt + (r & 3) + 8 * (r >> 2) + 4 * hh;
                    p[r] = (i >= j) ? p[r] * (0.14433756729740643f * exp2f(lg2 * (float)(i - j))) : 0.f; }
                pm[nt][2 * mt + 0] = pack8f((f32x4){p[0], p[1], p[2], p[3]}, (f32x4){p[4], p[5], p[6], p[7]});
                pm[nt][2 * mt + 1] = pack8f((f32x4){p[8], p[9], p[10], p[11]}, (f32x4){p[12], p[13], p[14], p[15]});
            }
        f32x16 ot[3][2];
#pragma unroll
        for (int me = 0; me < 3; ++me) {
            bf16x8 sf[3];
            int zz = 0; asm volatile("" : "+v"(zz)); const float* sp0 = RSTp + (size_t)item * 4608 + (32 * me + l31) * 48 + 8 * hh + zz;
#pragma unroll
            for (int ks = 0; ks < 3; ++ks) { const float* sp = sp0 + 16 * ks; sf[ks] = pack8f(*(const f32x4*)sp, *(const f32x4*)(sp + 4)); }
#pragma unroll
            for (int nt = 0; nt < 2; ++nt) {
                f32x16 a = {0.f, 0.f, 0.f, 0.f, 0.f, 0.f, 0.f, 0.f, 0.f, 0.f, 0.f, 0.f, 0.f, 0.f, 0.f, 0.f};
#pragma unroll
                for (int ks = 0; ks < 3; ++ks) a = __builtin_amdgcn_mfma_f32_32x32x16_bf16(sf[ks], qf[nt][ks], a, 0, 0, 0);
                const float qd = exp2f(lg2 * (float)(32 * nt + l31 + 1));
                ot[me][nt] = a * qd;
            }
        }
        asm volatile("s_waitcnt vmcnt(0)" ::: "memory");
#pragma unroll
        for (int s = 0; s < 4; ++s) {
            const int r0 = 16 * s + 4 * hh + q4;
#pragma unroll
            for (int me = 0; me < 3; ++me) {
                const LAS unsigned char* a0 = Vb + r0 * 192 + (32 * me + 16 * g1 + 4 * p4) * 2;
                const bf16x8 vf = tr8(a0, a0 + 8 * 192);
                if (s < 2) ot[me][0] = __builtin_amdgcn_mfma_f32_32x32x16_bf16(vf, pm[0][s], ot[me][0], 0, 0, 0);
                ot[me][1] = __builtin_amdgcn_mfma_f32_32x32x16_bf16(vf, pm[1][s], ot[me][1], 0, 0, 0);
            }
        }
#pragma unroll
        for (int nt = 0; nt < 2; ++nt) {
            float sum = 0.f;
#pragma unroll
            for (int me = 0; me < 3; ++me)
#pragma unroll
                for (int r = 0; r < 16; ++r) sum += ot[me][nt][r];
            sum += __shfl_xor(sum, 32);
            const float mu = sum * (1.f / 96.f); float q2 = 0.f;
#pragma unroll
            for (int me = 0; me < 3; ++me)
#pragma unroll
                for (int r = 0; r < 16; ++r) { const float d = ot[me][nt][r] - mu; q2 += d * d; }
            q2 += __shfl_xor(q2, 32);
            const float rs = rsqrtf(q2 * (1.f / 96.f) + EPS);
            const int tok = tok0 + 32 * nt + l31;
            const bf16_t* gbase = ZSp + (size_t)tok * ZSW + ZRG + h * 96 + 4 * hh; const float* nbase = ret_norm_g + l * 384 + h * 96 + 4 * hh; bf16_t* obase = F.H() + (size_t)tok * DM + 640 + h * 96 + 4 * hh;
#pragma unroll
            for (int me = 0; me < 3; ++me) {
                int zz = 0; asm volatile("" : "+v"(zz));
                const bf16_t* gp = gbase + 32 * me + zz; const float* np = nbase + 32 * me + zz; bf16_t* op = obase + 32 * me + zz;
#pragma unroll
                for (int r4 = 0; r4 < 4; ++r4) {
                    const u32x2 gw = *(const u32x2*)(gp + 8 * r4);
                    const f32x4 ng = *(const f32x4*)(np + 8 * r4);
                    const float g0 = bflo(gw.x), g1f = bfhi(gw.x), g2 = bflo(gw.y), g3 = bfhi(gw.y);
                    const float y0 = (ot[me][nt][4 * r4 + 0] - mu) * rs * ng.x * (g0 * sigmoidf_(g0)), y1 = (ot[me][nt][4 * r4 + 1] - mu) * rs * ng.y * (g1f * sigmoidf_(g1f));
                    const float y2 = (ot[me][nt][4 * r4 + 2] - mu) * rs * ng.z * (g2 * sigmoidf_(g2)), y3 = (ot[me][nt][4 * r4 + 3] - mu) * rs * ng.w * (g3 * sigmoidf_(g3));
                    *(u32x2*)(op + 8 * r4) = (u32x2){pk2(y0, y1), pk2(y2, y3)};
                }
            }
        }
        asm volatile("s_waitcnt lgkmcnt(0)" ::: "memory");
    }
}

typedef _Float16 f16_t;
__device__ __forceinline__ u32x4 zero4() { unsigned z = 0u; asm volatile("" : "+v"(z)); return (u32x4){z, z, z, z}; }
__device__ __forceinline__ int lanes_below(unsigned long long m) { return (int)__builtin_amdgcn_mbcnt_hi((unsigned)(m >> 32), __builtin_amdgcn_mbcnt_lo((unsigned)m, 0u)); }
__device__ __forceinline__ float relu1(float x) { return __builtin_amdgcn_fmed3f(x, 0.f, __builtin_inff()); }
__device__ __forceinline__ unsigned sortable_f16(float sc) {
    const f16_t h = (f16_t)sc; const unsigned u = (unsigned)__builtin_bit_cast(unsigned short, h), mag = u & 0x7fffu;
    return (u & 0x8000u) ? (0x8000u - mag) : (0x8000u + mag);
}
__device__ __forceinline__ int sc_pos(int k) { return k; }
__device__ __forceinline__ int wave_suffix_sum(int v, int lane) {
#pragma unroll
    for (int o = 1; o < 64; o <<= 1) { const int t = __shfl_down(v, o); if (lane + o < 64) v += t; }
    return v;
}
__device__ __forceinline__ void hist_threshold(const u32x4 c, int need, int lane, int& B, int& above) {
    const int s = (int)(c.x + c.y + c.z + c.w);
    const int S = wave_suffix_sum(s, lane);
    int a = S - s;
    const bool found = (a < need) && (S >= need);
    int Bl = 0, al = 0;
    if (found) {
        if (a + (int)c.w >= need) { Bl = 4 * lane + 3; al = a; }
        else { a += (int)c.w; if (a + (int)c.z >= need) { Bl = 4 * lane + 2; al = a; }
        else { a += (int)c.z; if (a + (int)c.y >= need) { Bl = 4 * lane + 1; al = a; }
        else { a += (int)c.y; Bl = 4 * lane; al = a; } } }
    }
    const unsigned long long m = __ballot(found);
    const int src = m ? (int)__builtin_ctzll(m) : 0;
    B = __shfl(Bl, src); above = __shfl(al, src);
}

#ifndef DSA_CAND
#define DSA_CAND 0
#endif
#ifndef DSA_DUP
#define DSA_DUP 0
#endif
constexpr int DSA_ROW = 16384;
__device__ __forceinline__ void phase_dsa(Frame& F) {
#ifdef NO_PHASE_DSA
    return;
#endif
    const int wave = F.wave;
    const bf16_t* ZSp = F.ZS(); const float* IWp = F.IW(); const bf16_t* IKp = F.IKD();
    LAS unsigned char* SCb = F.lds;
    for (int it = F.bid; it < 512; it += F.G) {
        int lane = F.lane; asm volatile("" : "+v"(lane));
        const int hi = lane >> 5, n32 = lane & 31;
        LAS unsigned short* LSTw = (LAS unsigned short*)(F.lds + 131072) + wave * 256;
        LAS unsigned char* WB = F.lds + 135168 + wave * 3520;
        LAS unsigned* H1 = (LAS unsigned*)WB; LAS unsigned* H2 = H1 + 256;
        LAS unsigned* DUM = (LAS unsigned*)(WB + 3264) + lane;
        LAS unsigned short* CK = (LAS unsigned short*)(WB + 1024); LAS unsigned short* CI = (LAS unsigned short*)(WB + 2144);
        const int pr = it & 255, vcu = (pr & 7) * 32 + (pr >> 3);
        const int b = vcu >> 6, cc = vcu & 63, c = (it < 256) ? cc : 127 - cc;
        const int V = (c + 1) * 64, tokq0 = b * SEQ + c * 64, kb0 = b * SEQ;
        const int Keff = V < 256 ? V : 256;
        const int nblk = (V + 511) >> 9, ntile_all = nblk * 16, ntile_real = V >> 5;
        for (int qg = 0; qg < 8; ++qg) {
            const int tq0 = tokq0 + qg * 8;
#ifndef DSA_NO_A
            for (int repA = 0; repA < 1 + (DSA_DUP & 1); ++repA) {
                bf16x8 aq[2];
                { const int qq = n32 >> 2, hd = n32 & 3; const bf16_t* qp = ZSp + (size_t)(tq0 + qq) * ZSW + ZIQ + hd * 32 + 8 * hi;
                  aq[0] = *(const bf16x8*)qp; aq[1] = *(const bf16x8*)(qp + 16); }
                float wq[4][4];
#pragma unroll
                for (int jq = 0; jq < 4; ++jq) { const f32x4 w4 = *(const f32x4*)(IWp + (size_t)(tq0 + 2 * jq + hi) * 4);
                    wq[jq][0] = w4.x * 0.08838834764831845f; wq[jq][1] = w4.y * 0.08838834764831845f; wq[jq][2] = w4.z * 0.08838834764831845f; wq[jq][3] = w4.w * 0.08838834764831845f; }
                bf16x8 fr[2][4][2];
                const int nb = (ntile_all - wave + 31) >> 5;
#define DSA_ALOAD(buf, bt) do { int zz = 0; asm volatile("" : "+v"(zz)); _Pragma("unroll") for (int u = 0; u < 4; ++u) { const int tt = wave + 8 * (4 * (bt) + u); \
        if (tt < ntile_real) { const bf16_t* kp = IKp + ((size_t)(((kb0 >> 5) + tt) * 4 + hi) * 32 + n32 + zz) * 8; fr[buf][u][0] = *(const bf16x8*)kp; fr[buf][u][1] = *(const bf16x8*)(kp + 512); } } } while (0)
#define DSA_ACOMP(buf, bt) do { _Pragma("unroll") for (int u = 0; u < 4; ++u) { const int tt = wave + 8 * (4 * (bt) + u); \
        if (tt < ntile_all) { unsigned short us[4] = {0, 0, 0, 0}; \
            if (tt < ntile_real) { f32x16 acc = {0.f, 0.f, 0.f, 0.f, 0.f, 0.f, 0.f, 0.f, 0.f, 0.f, 0.f, 0.f, 0.f, 0.f, 0.f, 0.f}; \
                acc = __builtin_amdgcn_mfma_f32_32x32x16_bf16(aq[0], fr[buf][u][0], acc, 0, 0, 0); acc = __builtin_amdgcn_mfma_f32_32x32x16_bf16(aq[1], fr[buf][u][1], acc, 0, 0, 0); \
                _Pragma("unroll") for (int jq = 0; jq < 4; ++jq) { \
                    const float sc = relu1(acc[4 * jq + 0]) * wq[jq][0] + relu1(acc[4 * jq + 1]) * wq[jq][1] + relu1(acc[4 * jq + 2]) * wq[jq][2] + relu1(acc[4 * jq + 3]) * wq[jq][3]; \
                    us[jq] = (unsigned short)sortable_f16(sc); } } \
            const int pos = sc_pos(tt * 32 + n32); \
            _Pragma("unroll") for (int jq = 0; jq < 4; ++jq) *(LAS unsigned short*)(SCb + (2 * jq + hi) * DSA_ROW + pos * 2) = us[jq]; } } } while (0)
                DSA_ALOAD(0, 0);
                for (int bp = 0; bp < nb; bp += 2) {
                    if (bp + 1 < nb) DSA_ALOAD(1, bp + 1);
                    DSA_ACOMP(0, bp);
                    if (bp + 2 < nb) DSA_ALOAD(0, bp + 2);
                    if (bp + 1 < nb) DSA_ACOMP(1, bp + 1);
                }
#undef DSA_ALOAD
#undef DSA_ACOMP
            }
#endif
            __syncthreads();
            LAS unsigned char* row = SCb + wave * DSA_ROW;
#ifndef DSA_NO_B
            for (int repB = 0; repB < 1 + ((DSA_DUP >> 1) & 1); ++repB)
            if (V > 256) {
                *(LAS u32x4*)(H1 + 4 * lane) = zero4(); *(LAS u32x4*)(H2 + 4 * lane) = zero4();
                u32x4 rw[4];
#define DSA_LD8(hf) do { _Pragma("unroll") for (int i = 0; i < 4; ++i) if (4 * (hf) + i < nblk) rw[i] = *(const LAS u32x4*)(row + (512 * (4 * (hf) + i) + 8 * lane) * 2); \
        asm volatile("s_waitcnt lgkmcnt(0)" ::: "memory"); } while (0)
#define DSA_W(i, e2) ((e2) == 0 ? rw[i].x : (e2) == 1 ? rw[i].y : (e2) == 2 ? rw[i].z : rw[i].w)
                asm volatile("s_waitcnt lgkmcnt(0)" ::: "memory");
#pragma unroll 1
                for (int hf = 0; 4 * hf < nblk; ++hf) {
                    DSA_LD8(hf);
#pragma unroll
                    for (int i = 0; i < 4; ++i) if (4 * hf + i < nblk) __hip_atomic_fetch_add(H2 + ((rw[i].x >> 8) & 255u), 1u, __ATOMIC_RELAXED, __HIP_MEMORY_SCOPE_WORKGROUP);
                }
                asm volatile("s_waitcnt lgkmcnt(0)" ::: "memory");
                int Bc, abovec; hist_threshold(*(const LAS u32x4*)(H2 + 4 * lane), 40, lane, Bc, abovec);
                { const u32x4 hs = *(const LAS u32x4*)(H2 + 4 * lane); const int tot = wave_suffix_sum((int)(hs.x + hs.y + hs.z + hs.w), lane); if (__shfl(tot, 0) < 40) Bc = 0; }
                *(LAS u32x4*)(H2 + 4 * lane) = zero4();
                bool done = false;
                if (DSA_CAND && Bc > 0) {
                    const unsigned thr = (unsigned)Bc << 8;
                    int cnt = 0;
#pragma unroll 1
                    for (int hf = 0; 4 * hf < nblk; ++hf) {
                        DSA_LD8(hf);
#pragma unroll
                        for (int i = 0; i < 4; ++i) if (4 * hf + i < nblk) {
#pragma unroll
                            for (int e = 0; e < 8; ++e) { const unsigned w = DSA_W(i, e >> 1); const unsigned u = (e & 1) ? (w >> 16) : (w & 0xffffu); cnt += (u >= thr) ? 1 : 0; }
                        }
                    }
                    int pos = cnt;
#pragma unroll
                    for (int o = 1; o < 64; o <<= 1) { const int t = __shfl_up(pos, o); if (lane >= o) pos += t; }
                    const int ncand = __shfl(pos, 63); pos -= cnt;
                    if (ncand >= 256 && ncand <= 560) {
                        LAS unsigned short* ldum = (LAS unsigned short*)DUM;
#pragma unroll 1
                        for (int hf = 0; 4 * hf < nblk; ++hf) {
                            DSA_LD8(hf);
#pragma unroll
                            for (int i = 0; i < 4; ++i) if (4 * hf + i < nblk) {
#pragma unroll
                                for (int e = 0; e < 8; ++e) { const unsigned w = DSA_W(i, e >> 1); const unsigned u = (e & 1) ? (w >> 16) : (w & 0xffffu);
                                    const bool sel = u >= thr; LAS unsigned short* pk = sel ? CK + pos : ldum; LAS unsigned short* pi = sel ? CI + pos : ldum;
                                    *pk = (unsigned short)u; *pi = (unsigned short)(512 * (4 * hf + i) + 8 * lane + e); pos += sel ? 1 : 0; }
                            }
                        }
                        *(LAS u32x4*)(H1 + 4 * lane) = zero4();
                        asm volatile("s_waitcnt lgkmcnt(0)" ::: "memory");
                        unsigned cu[9];
#pragma unroll
                        for (int j = 0; j < 9; ++j) { const int p = j * 64 + lane; const bool v = p < ncand; cu[j] = v ? (unsigned)CK[v ? p : 0] : 0u; }
                        asm volatile("s_waitcnt lgkmcnt(0)" ::: "memory");
#pragma unroll
                        for (int j = 0; j < 9; ++j) if (j * 64 + lane < ncand) __hip_atomic_fetch_add(H1 + (cu[j] >> 8), 1u, __ATOMIC_RELAXED, __HIP_MEMORY_SCOPE_WORKGROUP);
                        asm volatile("s_waitcnt lgkmcnt(0)" ::: "memory");
                        int B1c, above1c; hist_threshold(*(const LAS u32x4*)(H1 + 4 * lane), 256, lane, B1c, above1c);
                        *(LAS u32x4*)(H1 + 4 * lane) = zero4();
                        asm volatile("s_waitcnt lgkmcnt(0)" ::: "memory");
#pragma unroll
                        for (int j = 0; j < 9; ++j) if (j * 64 + lane < ncand && (int)(cu[j] >> 8) == B1c) __hip_atomic_fetch_add(H1 + (cu[j] & 255u), 1u, __ATOMIC_RELAXED, __HIP_MEMORY_SCOPE_WORKGROUP);
                        asm volatile("s_waitcnt lgkmcnt(0)" ::: "memory");
                        int B2c, above2c; hist_threshold(*(const LAS u32x4*)(H1 + 4 * lane), 256 - above1c, lane, B2c, above2c);
                        const unsigned tauc = ((unsigned)B1c << 8) | (unsigned)B2c;
                        if ((int)H1[B2c] == 256 - above1c - above2c) {
                            int c2 = 0;
#pragma unroll
                            for (int j = 0; j < 9; ++j) c2 += (j * 64 + lane < ncand && cu[j] >= tauc) ? 1 : 0;
                            int p2 = c2;
#pragma unroll
                            for (int o = 1; o < 64; o <<= 1) { const int t = __shfl_up(p2, o); if (lane >= o) p2 += t; }
                            p2 -= c2;
#pragma unroll
                            for (int j = 0; j < 9; ++j) { const bool sel = (j * 64 + lane < ncand) && cu[j] >= tauc; LAS unsigned short* pl = sel ? LSTw + p2 : ldum; *pl = CI[sel ? j * 64 + lane : 0]; p2 += sel ? 1 : 0; }
                            done = true;
                        }
                        *(LAS u32x4*)(H1 + 4 * lane) = zero4(); *(LAS u32x4*)(H2 + 4 * lane) = zero4();
                        asm volatile("s_waitcnt lgkmcnt(0)" ::: "memory");
                    }
                }
                if (!done) {
                int lo_bin = Bc, hi_bin = 256;
                for (;;) {
#pragma unroll 1
                    for (int hf = 0; 4 * hf < nblk; ++hf) {
                        DSA_LD8(hf);
#pragma unroll
                        for (int i = 0; i < 4; ++i) if (4 * hf + i < nblk) {
#pragma unroll
                            for (int e2 = 0; e2 < 4; ++e2) { const unsigned w = DSA_W(i, e2); const int b0 = (int)((w >> 8) & 255u), b1 = (int)(w >> 24);
                                LAS unsigned* p0 = ((unsigned)(b0 - lo_bin) < (unsigned)(hi_bin - lo_bin)) ? H1 + b0 : DUM; LAS unsigned* p1 = ((unsigned)(b1 - lo_bin) < (unsigned)(hi_bin - lo_bin)) ? H1 + b1 : DUM;
                                __hip_atomic_fetch_add(p0, 1u, __ATOMIC_RELAXED, __HIP_MEMORY_SCOPE_WORKGROUP); __hip_atomic_fetch_add(p1, 1u, __ATOMIC_RELAXED, __HIP_MEMORY_SCOPE_WORKGROUP); }
                        }
                    }
                    asm volatile("s_waitcnt lgkmcnt(0)" ::: "memory");
                    if (lo_bin == 0) break;
                    const u32x4 h4 = *(const LAS u32x4*)(H1 + 4 * lane); const int tot = __shfl(wave_suffix_sum((int)(h4.x + h4.y + h4.z + h4.w), lane), 0);
                    if (tot >= 256) break;
                    hi_bin = lo_bin; lo_bin = 0;
                }
                asm volatile("s_waitcnt lgkmcnt(0)" ::: "memory");
                int B1, above1; hist_threshold(*(const LAS u32x4*)(H1 + 4 * lane), 256, lane, B1, above1);
#pragma unroll 1
                for (int hf = 0; 4 * hf < nblk; ++hf) {
                    DSA_LD8(hf);
#pragma unroll
                    for (int i = 0; i < 4; ++i) if (4 * hf + i < nblk) {
#pragma unroll
                        for (int e2 = 0; e2 < 4; ++e2) { const unsigned w = DSA_W(i, e2);
                            LAS unsigned* p0 = ((int)((w >> 8) & 255u) == B1) ? H2 + (w & 255u) : DUM; LAS unsigned* p1 = ((int)(w >> 24) == B1) ? H2 + ((w >> 16) & 255u) : DUM;
                            __hip_atomic_fetch_add(p0, 1u, __ATOMIC_RELAXED, __HIP_MEMORY_SCOPE_WORKGROUP); __hip_atomic_fetch_add(p1, 1u, __ATOMIC_RELAXED, __HIP_MEMORY_SCOPE_WORKGROUP); }
                    }
                }
                asm volatile("s_waitcnt lgkmcnt(0)" ::: "memory");
                int B2, above2; hist_threshold(*(const LAS u32x4*)(H2 + 4 * lane), 256 - above1, lane, B2, above2);
                const unsigned tau = ((unsigned)B1 << 8) | (unsigned)B2;
                const int r = 256 - above1 - above2;
                const int neq = (int)H2[B2];
                if (neq == r) {
                    int cnt = 0;
#pragma unroll 1
                    for (int hf = 0; 4 * hf < nblk; ++hf) {
                        DSA_LD8(hf);
#pragma unroll
                        for (int i = 0; i < 4; ++i) if (4 * hf + i < nblk) {
#pragma unroll
                            for (int e = 0; e < 8; ++e) { const unsigned w = DSA_W(i, e >> 1); const unsigned u = (e & 1) ? (w >> 16) : (w & 0xffffu); cnt += (u >= tau) ? 1 : 0; }
                        }
                    }
                    int pos = cnt;
#pragma unroll
                    for (int o = 1; o < 64; o <<= 1) { const int t = __shfl_up(pos, o); if (lane >= o) pos += t; }
                    pos -= cnt;
                    LAS unsigned short* ldum = (LAS unsigned short*)DUM;
#pragma unroll 1
                    for (int hf = 0; 4 * hf < nblk; ++hf) {
                        DSA_LD8(hf);
#pragma unroll
                        for (int i = 0; i < 4; ++i) if (4 * hf + i < nblk) {
#pragma unroll
                            for (int e = 0; e < 8; ++e) { const unsigned w = DSA_W(i, e >> 1); const unsigned u = (e & 1) ? (w >> 16) : (w & 0xffffu);
                                const bool sel = u >= tau; LAS unsigned short* p = sel ? LSTw + pos : ldum;
                                *p = (unsigned short)(512 * (4 * hf + i) + 8 * lane + e); pos += sel ? 1 : 0; }
                        }
                    }
                } else {
                    int eq_base = 0, sel_base = 0;
#pragma unroll 1
                    for (int i = 0; i < nblk; ++i) {
                        const u32x4 w4 = *(const LAS u32x4*)(row + (512 * i + 8 * lane) * 2);
                        const unsigned ww[4] = {w4.x, w4.y, w4.z, w4.w};
                        int below_eq = 0, mine_eq = 0;
#pragma unroll
                        for (int e = 0; e < 8; ++e) { const unsigned u = (e & 1) ? (ww[e >> 1] >> 16) : (ww[e >> 1] & 0xffffu); below_eq += lanes_below(__ballot(u == tau)); }
                        int blk_eq = 0;
#pragma unroll
                        for (int e = 0; e < 8; ++e) {
                            const unsigned u = (e & 1) ? (ww[e >> 1] >> 16) : (ww[e >> 1] & 0xffffu);
                            const bool gt = u > tau, eq = (u == tau);
                            const bool sel = gt || (eq && (eq_base + below_eq + mine_eq < r));
                            mine_eq += eq ? 1 : 0;
                            const unsigned long long msel = __ballot(sel);
                            if (sel) LSTw[sel_base + lanes_below(msel)] = (unsigned short)(512 * i + 8 * lane + e);
                            sel_base += __popcll(msel); blk_eq += __popcll(__ballot(eq));
                        }
                        eq_base += blk_eq;
                    }
                }
                }
#undef DSA_W
#undef DSA_LD8
            } else {
#pragma unroll
                for (int jj = 0; jj < 4; ++jj) LSTw[lane + 64 * jj] = (unsigned short)(lane + 64 * jj);
            }
#endif
            asm volatile("s_waitcnt lgkmcnt(0)" ::: "memory");
            for (int repC = 0; repC < 1 + ((DSA_DUP >> 2) & 1); ++repC) {
                const int tq = tq0 + wave, n16 = lane & 15, kg = lane >> 4;
                bf16x8 qf[2];
                if (n16 < 6) { const bf16_t* qp = ZSp + (size_t)tq * ZSW + ZDQ + n16 * 64 + 8 * kg; qf[0] = *(const bf16x8*)qp; qf[1] = *(const bf16x8*)(qp + 32); }
                else { qf[0] = (bf16x8){0, 0, 0, 0, 0, 0, 0, 0}; qf[1] = qf[0]; }
                const int ntile = Keff >> 4;
                LAS unsigned char* vst = row;
#define DSA_VDMA(ch, buf) do { _Pragma("unroll") for (int i8 = 0; i8 < 8; ++i8) { const int rr = (lane >> 3) + 8 * i8; const int kidx = LSTw[(ch) * 64 + rr]; \
        const int sch = (lane & 7) ^ (2 * ((rr >> 1) & 3)); \
        __builtin_amdgcn_global_load_lds((const unsigned*)(ZSp + (size_t)(kb0 + kidx) * ZSW + ZDV + sch * 8), (LAS unsigned*)(vst + (buf) * 8192 + i8 * 1024), 16, 0, 0); } } while (0)
                DSA_VDMA(0, 0);
                if (ntile > 4) DSA_VDMA(1, 1);
                f32x4 sa[16];
                bf16x8 kf[2][4][2];
#define DSA_KLOAD(buf, tb) do { _Pragma("unroll") for (int t4 = 0; t4 < 4; ++t4) if (4 * (tb) + t4 < ntile) { const int kidx = LSTw[(4 * (tb) + t4) * 16 + n16]; \
        const bf16_t* kp = ZSp + (size_t)(kb0 + kidx) * ZSW + ZDK + 8 * kg; kf[buf][t4][0] = *(const bf16x8*)kp; kf[buf][t4][1] = *(const bf16x8*)(kp + 32); } } while (0)
#define DSA_KMMA(buf, tb) do { _Pragma("unroll") for (int t4 = 0; t4 < 4; ++t4) { \
        if (4 * (tb) + t4 < ntile) { f32x4 a = {0.f, 0.f, 0.f, 0.f}; \
            a = __builtin_amdgcn_mfma_f32_16x16x32_bf16(kf[buf][t4][0], qf[0], a, 0, 0, 0); a = __builtin_amdgcn_mfma_f32_16x16x32_bf16(kf[buf][t4][1], qf[1], a, 0, 0, 0); sa[4 * (tb) + t4] = a; } \
        else sa[4 * (tb) + t4] = (f32x4){-1e30f, -1e30f, -1e30f, -1e30f}; } } while (0)
                DSA_KLOAD(0, 0); DSA_KLOAD(1, 1);
                DSA_KMMA(0, 0); DSA_KLOAD(0, 2);
                DSA_KMMA(1, 1); DSA_KLOAD(1, 3);
                DSA_KMMA(0, 2);
                DSA_KMMA(1, 3);
#undef DSA_KLOAD
#undef DSA_KMMA
                float m = -1e30f;
#pragma unroll
                for (int t = 0; t < 16; ++t) m = fmaxf(m, fmaxf(fmaxf(sa[t].x, sa[t].y), fmaxf(sa[t].z, sa[t].w)));
                m = fmaxf(m, __shfl_xor(m, 16)); m = fmaxf(m, __shfl_xor(m, 32));
                const float sc2 = 0.125f * 1.4426950408889634f; float lsum = 0.f;
#pragma unroll
                for (int t = 0; t < 16; ++t) { sa[t].x = exp2f((sa[t].x - m) * sc2); sa[t].y = exp2f((sa[t].y - m) * sc2); sa[t].z = exp2f((sa[t].z - m) * sc2); sa[t].w = exp2f((sa[t].w - m) * sc2);
                    lsum += (sa[t].x + sa[t].y) + (sa[t].z + sa[t].w); }
                lsum += __shfl_xor(lsum, 16); lsum += __shfl_xor(lsum, 32);
                const float linv = __builtin_amdgcn_rcpf(lsum);
                f32x4 oacc[4] = {{0.f, 0.f, 0.f, 0.f}, {0.f, 0.f, 0.f, 0.f}, {0.f, 0.f, 0.f, 0.f}, {0.f, 0.f, 0.f, 0.f}};
                const int q4 = n16 >> 2, p4 = n16 & 3;
#pragma unroll
                for (int ch = 0; ch < 4; ++ch) {
                    if (ch * 4 < ntile) {
                        if ((ch + 1) * 4 < ntile) asm volatile("s_waitcnt vmcnt(8)" ::: "memory");
                        else asm volatile("s_waitcnt vmcnt(0)" ::: "memory");
#pragma unroll
                        for (int sl = 0; sl < 2; ++sl) {
                            const int s = ch * 2 + sl;
                            u32x4 pw; pw.x = pk2(sa[2 * s].x, sa[2 * s].y); pw.y = pk2(sa[2 * s].z, sa[2 * s].w); pw.z = pk2(sa[2 * s + 1].x, sa[2 * s + 1].y); pw.w = pk2(sa[2 * s + 1].z, sa[2 * s + 1].w);
                            const bf16x8 pb = __builtin_bit_cast(bf16x8, pw);
#pragma unroll
                            for (int mt = 0; mt < 4; ++mt) {
                                const int P0 = 32 * sl + 4 * kg + q4, P1 = P0 + 16;
                                const LAS unsigned char* a0 = vst + (ch & 1) * 8192 + P0 * 128 + (((2 * mt + (p4 >> 1)) ^ (2 * ((P0 >> 1) & 3))) * 16) + 8 * (p4 & 1);
                                const LAS unsigned char* a1 = vst + (ch & 1) * 8192 + P1 * 128 + (((2 * mt + (p4 >> 1)) ^ (2 * ((P1 >> 1) & 3))) * 16) + 8 * (p4 & 1);
                                const s16x4 lo = __builtin_bit_cast(s16x4, __builtin_amdgcn_ds_read_tr16_b64_v4i16((LAS s16x4*)a0));
                                const s16x4 hi4 = __builtin_bit_cast(s16x4, __builtin_amdgcn_ds_read_tr16_b64_v4i16((LAS s16x4*)a1));
                                const bf16x8 va = (bf16x8){lo[0], lo[1], lo[2], lo[3], hi4[0], hi4[1], hi4[2], hi4[3]};
                                oacc[mt] = __builtin_amdgcn_mfma_f32_16x16x32_bf16(va, pb, oacc[mt], 0, 0, 0);
                            }
                        }
                        asm volatile("s_waitcnt lgkmcnt(0)" ::: "memory");
                        if (ch + 2 < 4 && (ch + 2) * 4 < ntile) DSA_VDMA(ch + 2, ch & 1);
                    }
                }
#undef DSA_VDMA
                if (n16 < 6) {
                    bf16_t* op = F.H() + (size_t)tq * DM + 256 + n16 * 64 + 4 * kg;
#pragma unroll
                    for (int mt = 0; mt < 4; ++mt) { u32x2 o; o.x = pk2(oacc[mt].x * linv, oacc[mt].y * linv); o.y = pk2(oacc[mt].z * linv, oacc[mt].w * linv); *(u32x2*)(op + 16 * mt) = o; }
                }
            }
            __syncthreads();
        }
    }
}

__global__ void __launch_bounds__(NTHREADS, 2) mk_fwd(Args args) {
    extern __shared__ __attribute__((aligned(16))) unsigned char lds_raw[];
    Frame F;
    F.lds = (LAS unsigned char*)lds_raw;
    F.tid = threadIdx.x; F.lane = F.tid & 63; F.wave = __builtin_amdgcn_readfirstlane(F.tid >> 6);
    F.G = gridDim.x; F.bid = blockIdx.x; F.wsb = args.ws; F.zo = 0u;
    unsigned char* ws = args.ws;
#define INF(k) ((const float*)args.in[k])

    volatile LAS unsigned* MISC = (volatile LAS unsigned*)(F.lds + MISC_OFF);
    if (F.tid < 64) MISC[F.tid] = 0u;
    __syncthreads();
    XcdBarrier bar = xcd_barrier_post((unsigned*)(ws + WS_CTL) + CW_BAR, MISC + 8);
    int ph = 0; const int lo = args.ph_lo, hi = args.ph_hi;
    unsigned long long* TSp = (unsigned long long*)(ws + WS_CTL + 32768); int nst = 0; (void)TSp; (void)nst;
    bool first_seam = true;
#ifndef DUP_MASK
#define DUP_MASK 0
#endif
#ifdef PROBE_LO
#define STAMP() do { if (F.bid == 0 && F.tid == 0) { TSp[nst] = __builtin_amdgcn_s_memrealtime(); } ++nst; } while (0)
#else
#define STAMP() do { } while (0)
#endif
#define GRIDSYNC() xcd_barrier(bar, F.wave == 0 && (int)__builtin_amdgcn_mbcnt_hi(~0u, __builtin_amdgcn_mbcnt_lo(~0u, 0u)) == 0)
#define RUN(...) do { if (ph >= lo && ph < hi) { F.lane = (int)__builtin_amdgcn_mbcnt_hi(~0u, __builtin_amdgcn_mbcnt_lo(~0u, 0u)); asm volatile("" : "+v"(F.lane), "+s"(F.zo), "+s"(F.bid), "+s"(F.G), "+s"(F.wave)); F.tid = F.wave * 64 + F.lane; __VA_ARGS__; } ++ph; } while (0)
#define SEAM() do { if (ph > lo && ph < hi) { if (first_seam) { GRIDSYNC(); first_seam = false; } else xcd_barrier(bar, F.wave == 0 && (int)__builtin_amdgcn_mbcnt_hi(~0u, __builtin_amdgcn_mbcnt_lo(~0u, 0u)) == 0); } STAMP(); } while (0)

    STAMP();
    RUN(phase_rope(F, (const int*)args.in[1])); STAMP();
#pragma unroll
    for (int l = 0; l < DEPTH; ++l) {
        const float* xin = (l == 0) ? INF(0) : args.out;
        RUN({ const ProIn I{xin, INF(2), INF(3), INF(15), INF(16), INF(17), INF(18), INF(20), INF(21), INF(12), INF(4), INF(5), INF(6), INF(7), INF(8), (const int*)args.in[1]};
              for (int rep = 0; rep < 1 + ((DUP_MASK >> 4) & 1); ++rep) { phase_prologue(F, l, I); __syncthreads(); } }); SEAM();
#ifndef NO_G1
        RUN({ pg8::Gemm g{F.H(), F.Win_t()}; pg8::StaticOrder<T, NINP> S; S.init(F.G, F.bid);
              pg8::EpiGen<FInProj> E{FInProj{F.ZS(), F.GB(), F.IW(), F.ROPE(), F.IKD()}}; for (int rep = 0; rep < 1 + (DUP_MASK & 1); ++rep) pg8::gemm_phase<T, NINP, DM, DM, DM>(F.lds, g, S, E, F.tid); }); SEAM();
#else
        RUN({}); SEAM();
#endif
        RUN({ for (int rep = 0; rep < 1 + ((DUP_MASK >> 2) & 1); ++rep) { phase_s5_local(F); __syncthreads(); } STAMP();
              for (int rep = 0; rep < 1 + ((DUP_MASK >> 3) & 1); ++rep) { phase_ret_local(F); __syncthreads(); } STAMP();
              for (int rep = 0; rep < 1 + ((DUP_MASK >> 1) & 1); ++rep) { phase_dsa(F); __syncthreads(); } }); SEAM();
        RUN(phase_carry(F)); SEAM();
        RUN({ for (int rep = 0; rep < 1 + ((DUP_MASK >> 2) & 1); ++rep) { phase_s5_out(F, l, INF(9), INF(10), INF(11)); __syncthreads(); } STAMP();
              for (int rep = 0; rep < 1 + ((DUP_MASK >> 3) & 1); ++rep) { phase_ret_out(F, l, INF(14)); __syncthreads(); } }); SEAM();
#ifndef NO_G2
        RUN({ pg8::Gemm g{F.H(), F.Wglu_t()}; pg8::StaticOrder<T, 256> S; S.init(F.G, F.bid);
              pg8::EpiGen<FGlu, 0> E{FGlu{F.H(), INF(13) + l * 256}}; pg8::gemm_phase<T, 256, 256, DM, 256>(F.lds, g, S, E, F.tid); }); SEAM();
#else
        RUN({}); SEAM();
#endif
#ifndef NO_G3
        RUN({ pg8::Gemm g{F.H(), F.Wabc_t()}; pg8::StaticOrder<T, DM> S; S.init(F.G, F.bid);
              EpiMerge E{F.MG(), F.GB()}; for (int rep = 0; rep < 1 + ((DUP_MASK >> 5) & 1); ++rep) pg8::gemm_phase<T, DM, DM, DM, DM>(F.lds, g, S, E, F.tid); }); SEAM();
#else
        RUN({}); SEAM();
#endif
#ifndef NO_G4
        RUN({ pg8::Gemm g{F.MG(), F.Wout_t()}; pg8::StaticOrder<T, DM> S; S.init(F.G, F.bid);
              pg8::EpiGen<FResid> E{FResid{xin, args.out}}; pg8::gemm_phase<T, DM, DM, DM, DM>(F.lds, g, S, E, F.tid); }); SEAM();
#else
        RUN({}); SEAM();
#endif
        RUN({ const int gw = F.bid * NWAVES + F.wave, NGW = F.G * NWAVES; const float* g2 = INF(19) + l * DM;
              for (int rep = 0; rep < 1 + ((DUP_MASK >> 4) & 1); ++rep) for (int m = gw; m < T; m += NGW) rms_row_bf16(args.out + (size_t)m * DM, g2, F.H() + (size_t)m * DM, F.lane); }); SEAM();
#ifndef NO_G5
        RUN({ pg8::Gemm g{F.H(), F.W1_t()}; pg8::StaticOrder<T, FF> S; S.init(F.G, F.bid);
              pg8::EpiGen<FRelu2> E{FRelu2{F.FB()}}; for (int rep = 0; rep < 1 + (DUP_MASK & 1); ++rep) pg8::gemm_phase<T, FF, DM, DM, DM>(F.lds, g, S, E, F.tid); }); SEAM();
#else
        RUN({}); SEAM();
#endif
#ifndef NO_G6
        RUN({ pg8::Gemm g{F.FB(), F.W2_t()}; pg8::StaticOrder<T, DM> S; S.init(F.G, F.bid);
              pg8::EpiGen<FResid> E{FResid{args.out, args.out}}; pg8::gemm_phase<T, DM, FF, FF, FF>(F.lds, g, S, E, F.tid); }); SEAM();
#else
        RUN({}); SEAM();
#endif
    }
    RUN({ const int gw = F.bid * NWAVES + F.wave, NGW = F.G * NWAVES; const float* gf = INF(22);
          for (int m = gw; m < T; m += NGW) rms_row_f32(args.out + (size_t)m * DM, gf, args.out + (size_t)m * DM, F.lane); });
    STAMP();
#ifdef PROBE_LO
    if (F.bid == 0 && F.tid == 0) {
        const int sel[] = PROBE_SEL; unsigned long long tot = 0;
        for (unsigned i = 0; i < sizeof(sel) / sizeof(int); ++i) tot += TSp[sel[i] + 1] - TSp[sel[i]];
        const float us = (float)tot * 0.01f;
        asm volatile("s_waitcnt vmcnt(0)" ::: "memory");
        args.out[0] = sqrtf(us * (float)((size_t)T * DM));
    }
#endif
#undef RUN
#undef SEAM
}

extern "C" void kernel_launch(void* const* d_in, const int* in_sizes, int n_in, void* d_out, int out_size, void* d_ws, size_t ws_size, hipStream_t stream) {
    static int grid = 0;
    if (grid == 0) {
        if (n_in != 23 || out_size != T * DM || ws_size < WS_END) { fprintf(stderr, "kernel_launch: unexpected shapes (n_in %d out %d ws %zu)\n", n_in, out_size, ws_size); grid = -1; return; }
        int dev = 0, cus = 0, per_cu = 0;
        hipGetDevice(&dev); hipDeviceGetAttribute(&cus, hipDeviceAttributeMultiprocessorCount, dev);
        if (hipFuncSetAttribute((const void*)mk_fwd, hipFuncAttributeMaxDynamicSharedMemorySize, LDS_BYTES) != hipSuccess) { fprintf(stderr, "kernel_launch: hipFuncSetAttribute failed\n"); grid = -1; return; }
        if (hipOccupancyMaxActiveBlocksPerMultiprocessor(&per_cu, (const void*)mk_fwd, NTHREADS, LDS_BYTES) != hipSuccess || per_cu < 1) { fprintf(stderr, "kernel_launch: occupancy query says %d\n", per_cu); per_cu = 1; }
        (void)hipGetLastError();
        grid = cus;
    }
    if (grid < 0) return;
    hipMemsetAsync((char*)d_ws + WS_CTL, 0, CTL_ZERO_BYTES, stream);
    Args a{};
    for (int i = 0; i < 23; ++i) a.in[i] = d_in[i];
    a.out = (float*)d_out; a.ws = (unsigned char*)d_ws;
#ifndef MK_SPLIT
    a.ph_lo = 0; a.ph_hi = 1000;
    void* kargs[] = {&a};
    hipError_t e = hipLaunchCooperativeKernel((const void*)mk_fwd, dim3(grid), dim3(NTHREADS), kargs, LDS_BYTES, stream);
    if (e != hipSuccess) fprintf(stderr, "kernel_launch: cooperative launch failed: %s\n", hipGetErrorString(e));
#else
    for (int p = 0; p < 2 * 11 + 2; ++p) { a.ph_lo = p; a.ph_hi = p + 1; hipLaunchKernelGGL(mk_fwd, dim3(grid), dim3(NTHREADS), LDS_BYTES, stream, a); }
#endif
}
```

```cpp
#include <hip/hip_runtime.h>
#include <hip/hip_cooperative_groups.h>
#include <cstdio>
#include <cstdint>
namespace cg = cooperative_groups;

#define LAS __attribute__((address_space(3)))
#define GAS __attribute__((address_space(1)))
typedef unsigned short bf16_t;
typedef short bf16x8 __attribute__((ext_vector_type(8)));
typedef float f32x4 __attribute__((ext_vector_type(4)));
typedef float f32x2 __attribute__((ext_vector_type(2)));
typedef unsigned u32x4 __attribute__((ext_vector_type(4)));
typedef unsigned u32x2 __attribute__((ext_vector_type(2)));

constexpr int NB = 4, SEQ = 8192, T = NB * SEQ, DM = 1024, DEPTH = 2, FF = 4096;
constexpr int NIN = 5156, NINP = 5376;
constexpr int ZSW = 2112, GW = 3072;
constexpr int ZU = 0, ZDQ = 256, ZDK = 640, ZDV = 704, ZIQ = 768, ZIK = 896, ZIWC = 928, ZRQ = 960, ZRK = 1152, ZRV = 1344, ZRG = 1728, ZGATE = 2112, ZEND = 5184;
constexpr int NFREQ = 36;
constexpr float EPS = 1e-6f;

constexpr size_t MiB = 1u << 20;
constexpr size_t WS_CTL = 0, CTL_ZERO_BYTES = 512 * 1024;
constexpr size_t WS_IW = 1 * MiB;
constexpr size_t WS_SP = 1 * MiB + 512 * 1024;
constexpr size_t WS_ROPE = 2 * MiB;
constexpr size_t WS_S5E = 11 * MiB;
constexpr size_t WS_RST = 15 * MiB;
constexpr size_t WS_W = 51 * MiB;
constexpr size_t WO_IN = 0, WO_ABC = WO_IN + (size_t)NINP * DM * 2, WO_OUT = WO_ABC + (size_t)DM * DM * 2, WO_W1 = WO_OUT + (size_t)DM * DM * 2,
                 WO_W2 = WO_W1 + (size_t)FF * DM * 2, WO_GLU = WO_W2 + (size_t)FF * DM * 2, WO_END = WO_GLU + 256 * 256 * 2;
static_assert(WO_END <= 31 * MiB, "weights");
constexpr size_t WS_H = 82 * MiB;
constexpr size_t WS_ZS = 146 * MiB;
constexpr size_t WS_G = 278 * MiB;
constexpr size_t WS_IKD = 470 * MiB;
constexpr size_t WS_XB = 472 * MiB;
constexpr size_t WS_W1L = 474 * MiB;
constexpr size_t WS_END = 505 * MiB;
static_assert(WS_ZS + (size_t)T * ZSW * 2 <= WS_G && WS_G + (size_t)T * GW * 2 <= WS_END && WS_ZS + (size_t)T * FF * 2 <= WS_END, "ws map");
constexpr int CW_BAR = 1024, CW_PANEL = 32768;

constexpr int LDS_BYTES = 160 * 1024;
constexpr int RING_BYTES = 131072;
constexpr int MISC_OFF = LDS_BYTES - 256;

__device__ __forceinline__ unsigned f2bf(float f) { unsigned u = __builtin_bit_cast(unsigned, f); return (u + 0x7fffu + ((u >> 16) & 1u)) >> 16; }
__device__ __forceinline__ unsigned pk2(float lo, float hi) { unsigned r; asm("v_cvt_pk_bf16_f32 %0, %1, %2" : "=v"(r) : "v"(lo), "v"(hi)); return r; }
__device__ __forceinline__ float bf2f(unsigned short v) { return __builtin_bit_cast(float, (unsigned)v << 16); }
__device__ __forceinline__ float bflo(unsigned w) { return __builtin_bit_cast(float, w << 16); }
__device__ __forceinline__ float bfhi(unsigned w) { return __builtin_bit_cast(float, w & 0xffff0000u); }
__device__ __forceinline__ float sigmoidf_(float x) { return __builtin_amdgcn_rcpf(1.0f + __expf(-x)); }
__device__ __forceinline__ float wave_sum(float v) {
#pragma unroll
    for (int o = 1; o < 64; o <<= 1) v += __shfl_xor(v, o);
    return v;
}
__device__ __forceinline__ float wave_max(float v) {
#pragma unroll
    for (int o = 1; o < 64; o <<= 1) v = fmaxf(v, __shfl_xor(v, o));
    return v;
}

#define XB_TMO      128
#define XB_XCNT(j)  (256  + 64 * (j))
#define XB_XSUB(j)  (1280 + 64 * (j))
#define XB_XGEN(j)  (2304 + 64 * (j))
#define XB_TOP      3328
#define XB_TOPGEN   3392
#define XCD_BAR_WORDS 3456
#define XB_SPIN_CAP (1u << 18)
__device__ __forceinline__ unsigned xb_ld(unsigned* p)              { return __hip_atomic_load(p, __ATOMIC_RELAXED, __HIP_MEMORY_SCOPE_AGENT); }
__device__ __forceinline__ unsigned xb_add(unsigned* p, unsigned v) { return __hip_atomic_fetch_add(p, v, __ATOMIC_RELAXED, __HIP_MEMORY_SCOPE_AGENT); }
__device__ __forceinline__ unsigned xb_xcc_id() { return (unsigned)__builtin_amdgcn_s_getreg((3 << 11) | 20) & 0xFu; }
#define XB_SPIN(cond, bar) do { unsigned _sp = 0; while (cond) { __builtin_amdgcn_s_sleep(1); \
    if ((++_sp & 255u) == 0u) { if (xb_ld(&(bar)[XB_TMO])) break; if (_sp > XB_SPIN_CAP) { atomicAdd(&(bar)[XB_TMO], 1u); break; } } } } while (0)
struct XcdBarrier { unsigned* bar; unsigned x; volatile LAS unsigned* st; };
__device__ __forceinline__ XcdBarrier xcd_barrier_post(unsigned* bar, volatile LAS unsigned* st) {
    XcdBarrier b; b.bar = bar; b.x = xb_xcc_id(); b.st = st;
    if (threadIdx.x == 0) (void)xb_add(&bar[XB_XCNT(b.x)], 1u);
    return b;
}
__device__ __forceinline__ void xcd_barrier_complete(unsigned* bar, unsigned x, unsigned& nloc, unsigned& nx) {
    const unsigned G = gridDim.x * gridDim.y * gridDim.z;
    unsigned sum, cnt, mine, sp = 0u;
    for (;;) {
        sum = 0u; cnt = 0u; mine = 0u;
#pragma unroll
        for (unsigned j = 0; j < 16; ++j) { const unsigned c = xb_ld(&bar[XB_XCNT(j)]); sum += c; cnt += (c > 0u) ? 1u : 0u; mine = (j == x) ? c : mine; }
        if (sum == G) break;
        __builtin_amdgcn_s_sleep(1);
        if ((++sp & 255u) == 0u) { if (xb_ld(&bar[XB_TMO])) break; if (sp > XB_SPIN_CAP) { atomicAdd(&bar[XB_TMO], 1u); break; } }
    }
    nloc = mine > 0u ? mine : 1u; nx = cnt > 0u ? cnt : 1u;
}
__device__ __forceinline__ void xcd_barrier(const XcdBarrier& b, bool leader) {
    asm volatile("s_waitcnt vmcnt(0)" ::: "memory");
    __syncthreads();
    if (leader) {
        unsigned* bar = b.bar; unsigned bx = b.x;
        asm volatile("" : "+s"(bar), "+s"(bx));
        __builtin_amdgcn_s_waitcnt(0);
        unsigned nloc = b.st[0], nx = b.st[1];
        if (nloc == 0u) { xcd_barrier_complete(bar, bx, nloc, nx); b.st[0] = nloc; b.st[1] = nx; }
        const unsigned old = xb_add(&bar[XB_XSUB(bx)], 1u);
        const unsigned gen = old / nloc;
        if (old + 1u == (gen + 1u) * nloc) {
            __builtin_amdgcn_fence(__ATOMIC_RELEASE, "agent");
            asm volatile("s_waitcnt vmcnt(0)" ::: "memory");
            const unsigned og = xb_add(&bar[XB_TOP], 1u);
            const unsigned tg = og / nx;
            if (og + 1u == (tg + 1u) * nx) xb_add(&bar[XB_TOPGEN], 1u);
            else XB_SPIN(xb_ld(&bar[XB_TOPGEN]) == tg, bar);
            __builtin_amdgcn_fence(__ATOMIC_ACQUIRE, "agent");
            xb_add(&bar[XB_XGEN(bx)], 1u);
            asm volatile("s_waitcnt vmcnt(0)" ::: "memory");
        } else {
            XB_SPIN(xb_ld(&bar[XB_XGEN(bx)]) == gen, bar);
            __builtin_amdgcn_fence(__ATOMIC_ACQUIRE, "agent");
            asm volatile("s_waitcnt vmcnt(0)" ::: "memory");
        }
    }
    __syncthreads();
}

namespace pg8 {
constexpr int BM = 256, BK = 64, HALF = 128, HTB = HALF * BK * 2, STAGE_BYTES = 8 * HTB, NXCD = 8, WGM = 8;
__host__ __device__ __forceinline__ int lds_byte(int r, int c) { const int st = (r >> 4) * 2 + (c >> 5), rr = r & 15, cc = c & 31, ob = rr * 64 + cc * 2; return st * 1024 + (ob ^ (((ob >> 9) & 1) << 5)); }
__host__ __device__ __forceinline__ void stage_rc(int b, int& R, int& C) { const int st = b / 1024, sb = b % 1024, swz = sb ^ (((sb >> 9) & 1) << 5); R = (st >> 1) * 16 + swz / 64; C = (st & 1) * 32 + (swz % 64) / 2; }
__host__ __device__ __forceinline__ int perm32(int rho) { const int n = rho >> 4, i = rho & 15; return 8 * (i >> 2) + 4 * n + (i & 3); }

struct Unit { int pm, pn; };
struct Gemm { const bf16_t* A; const bf16_t* Bt; };

template <int M, int N> struct StaticOrder {
    static constexpr int nM = M / BM, nN = N / BM, nwg = nM * nN;
    int G, c;
    __host__ __device__ void init(int G_, int c_) { G = G_; c = c_; }
    __host__ __device__ bool next(int i, Unit& u) const {
        const long L = (long)i * G + c; if (L >= nwg) return false;
        int wgid = (int)L; { constexpr int q = nwg / NXCD, r = nwg % NXCD; const int xcd = wgid % NXCD, off = wgid / NXCD; wgid = (xcd < r ? xcd * (q + 1) : r * (q + 1) + (xcd - r) * q) + off; }
        constexpr int nig = WGM * nN; const int gid = wgid / nig, fm = gid * WGM, gsz = (nM - fm) < WGM ? (nM - fm) : WGM;
        u.pm = fm + ((wgid % nig) % gsz); u.pn = (wgid % nig) / gsz; return true;
    }
};

template <class F, int FENCE = 0> struct EpiGen {
    static constexpr bool PERM = true, HAS_MID = false, FUSED = false;
    F f;
    __device__ __forceinline__ void operator()(const f32x4 (&acc)[2][2][4][2], const Unit& u, int wr, int wc, int fr, int fq) const {
        const int row0 = u.pm * BM + wr * 64 + fr, col0 = u.pn * BM + wc * 32 + 8 * fq;
#pragma unroll
        for (int ai = 0; ai < 2; ++ai)
#pragma unroll
            for (int m = 0; m < 4; ++m)
#pragma unroll
                for (int bj = 0; bj < 2; ++bj) { f(row0 + ai * HALF + m * 16, col0 + bj * HALF, acc[ai][bj][m][0], acc[ai][bj][m][1]);
                    if constexpr (FENCE > 0) { if (((ai * 4 + m) * 2 + bj) % FENCE == FENCE - 1) asm volatile("" ::: "memory"); } }
    }
};

template <int M, int N, int K, int LDA, int LDB, class Epi, bool ALIGN_EPI = true>
__device__ __forceinline__ void gemm_phase(LAS unsigned char* lds, const Gemm g, const StaticOrder<M, N>& S, const Epi& E, int tid_in) {
    int tid = tid_in; asm volatile("" : "+v"(tid));
    const int wid = __builtin_amdgcn_readfirstlane(tid >> 6), lane = tid & 63, wr = wid >> 2, wc = wid & 3, fr = lane & 15, fq = lane >> 4;
    constexpr int nt = K / BK;
    unsigned voffA[2], voffB[2];
#pragma unroll
    for (int i = 0; i < 2; ++i) { int R, C; stage_rc(tid * 16 + i * 8192, R, C); const int Rb = Epi::PERM ? ((R & ~31) + perm32(R & 31)) : R;
        voffA[i] = (unsigned)(R * LDA + C) * 2u; voffB[i] = (unsigned)(Rb * LDB + C) * 2u; }
    constexpr size_t kstep = (size_t)(BK * 2);
    constexpr size_t hstepA = (size_t)HALF * LDA * 2, hstepB = (size_t)HALF * LDB * 2;
    constexpr size_t tstepA = 2 * hstepA, tstepB = 2 * hstepB;
    const unsigned ldsw = (unsigned)wid * 1024u;
    const int aoff = lds_byte(wr * 64 + fr, fq * 8), boff = lds_byte(wc * 32 + fr, fq * 8);
#define PG8_SA(b, h) (((b) * 2 + (h)) * HTB)
#define PG8_SB(b, h) ((4 + (b) * 2 + (h)) * HTB)
#define PG8_STAGE(bufoff, gbase, voff) do { _Pragma("unroll") for (int _i = 0; _i < 2; ++_i) \
        __builtin_amdgcn_global_load_lds((const unsigned*)((const char*)(gbase) + (voff)[_i]), (LAS unsigned*)(lds + (bufoff) + ldsw + _i * 8192), 16, 0, 0); } while (0)
#define PG8_LDA(dst, b, h) do { _Pragma("unroll") for (int m = 0; m < 4; ++m) _Pragma("unroll") for (int k = 0; k < 2; ++k) dst[m][k] = *(const LAS bf16x8*)(lds + PG8_SA(b, h) + aoff + m * 2048 + k * 1024); } while (0)
#define PG8_LDB(dst, b, h) do { _Pragma("unroll") for (int n = 0; n < 2; ++n) _Pragma("unroll") for (int k = 0; k < 2; ++k) dst[n][k] = *(const LAS bf16x8*)(lds + PG8_SB(b, h) + boff + n * 2048 + k * 1024); } while (0)
#define PG8_MMA(ai, bj, At, Bt) do { __builtin_amdgcn_s_setprio(1); _Pragma("unroll") for (int m = 0; m < 4; ++m) _Pragma("unroll") for (int n = 0; n < 2; ++n) _Pragma("unroll") for (int k = 0; k < 2; ++k) \
        acc[ai][bj][m][n] = __builtin_amdgcn_mfma_f32_16x16x32_bf16(Bt[n][k], At[m][k], acc[ai][bj][m][n], 0, 0, 0); __builtin_amdgcn_s_setprio(0); } while (0)
#define PG8_WAIT_V(n) asm volatile("s_waitcnt vmcnt(" #n ")" ::: "memory")
#define PG8_WAIT_L(n) asm volatile("s_waitcnt lgkmcnt(" #n ")" ::: "memory")
#define PG8_BAR __builtin_amdgcn_s_barrier()
#define PG8_SCHED __builtin_amdgcn_sched_barrier(0)
    Unit cur, nxt; int ui = 0;
    if (!S.next(0, cur)) return;
    f32x4 acc[2][2][4][2];
#pragma unroll
    for (int a = 0; a < 2; ++a)
#pragma unroll
        for (int b = 0; b < 2; ++b)
#pragma unroll
            for (int m = 0; m < 4; ++m)
#pragma unroll
                for (int n = 0; n < 2; ++n) acc[a][b][m][n] = (f32x4){0.f, 0.f, 0.f, 0.f};
    bf16x8 At[4][2], B0[2][2], B1[2][2];
    const char* cA = (const char*)g.A + (size_t)cur.pm * tstepA; const char* cB = (const char*)g.Bt + (size_t)cur.pn * tstepB;
    PG8_STAGE(PG8_SB(0, 0), cB, voffB); PG8_STAGE(PG8_SB(0, 1), cB + hstepB, voffB); PG8_STAGE(PG8_SA(0, 0), cA, voffA); PG8_STAGE(PG8_SA(0, 1), cA + hstepA, voffA);
    if (wr == 1) PG8_BAR;
    PG8_WAIT_V(2); PG8_BAR;
    PG8_STAGE(PG8_SB(1, 0), cB + kstep, voffB); PG8_STAGE(PG8_SA(1, 0), cA + kstep, voffA); PG8_STAGE(PG8_SB(1, 1), cB + hstepB + kstep, voffB);
    PG8_WAIT_V(6); PG8_BAR;
    for (;;) {
        const bool has_next = S.next(ui + 1, nxt);
        const char* nA = has_next ? (const char*)g.A + (size_t)nxt.pm * tstepA : cA; const char* nB = has_next ? (const char*)g.Bt + (size_t)nxt.pn * tstepB : cB;
#pragma unroll 1
        for (int t = 0; t < nt; t += 2) {
            const bool last = (t == nt - 2);
            const char* a1 = cA + (size_t)(t + 1) * kstep;
            const char* a2 = last ? nA : cA + (size_t)(t + 2) * kstep; const char* b2 = last ? nB : cB + (size_t)(t + 2) * kstep;
            const char* a3 = a2 + kstep; const char* b3 = b2 + kstep;
            if constexpr (Epi::HAS_MID) { if (t == Epi::MID0 || t == Epi::MID1) E.mid(acc, cur, t, wr, wc, fr, fq); }
            PG8_LDB(B0, 0, 0); PG8_LDB(B1, 0, 1); PG8_SCHED; PG8_LDA(At, 0, 0); PG8_STAGE(PG8_SA(1, 1), a1 + hstepA, voffA);
            PG8_WAIT_V(8); PG8_WAIT_L(0); PG8_BAR; PG8_MMA(0, 0, At, B0); PG8_MMA(0, 1, At, B1); PG8_BAR; PG8_SCHED;
            PG8_LDA(At, 0, 1); PG8_STAGE(PG8_SB(0, 0), b2, voffB); PG8_STAGE(PG8_SB(0, 1), b2 + hstepB, voffB); PG8_STAGE(PG8_SA(0, 0), a2, voffA);
            PG8_WAIT_V(8); PG8_WAIT_L(0); PG8_BAR; PG8_MMA(1, 0, At, B0); PG8_MMA(1, 1, At, B1); PG8_BAR; PG8_SCHED;
            PG8_LDB(B0, 1, 0); PG8_LDB(B1, 1, 1); PG8_SCHED; PG8_LDA(At, 1, 0); PG8_STAGE(PG8_SA(0, 1), a2 + hstepA, voffA);
            PG8_WAIT_V(8); PG8_WAIT_L(0); PG8_BAR; PG8_MMA(0, 0, At, B0); PG8_MMA(0, 1, At, B1); PG8_BAR; PG8_SCHED;
            PG8_LDA(At, 1, 1); PG8_STAGE(PG8_SB(1, 0), b3, voffB); PG8_STAGE(PG8_SB(1, 1), b3 + hstepB, voffB); PG8_STAGE(PG8_SA(1, 0), a3, voffA);
            PG8_WAIT_V(8); PG8_WAIT_L(0); PG8_BAR; PG8_MMA(1, 0, At, B0); PG8_MMA(1, 1, At, B1); PG8_BAR; PG8_SCHED;
        }
        if constexpr (ALIGN_EPI) { if (wr == 0) PG8_BAR; }
        if constexpr (Epi::FUSED) E.fused(acc, cur, wr, wc, fr, fq, lds, wid, lane); else E(acc, cur, wr, wc, fr, fq);
        if (!has_next) break;
#pragma unroll
        for (int a = 0; a < 2; ++a)
#pragma unroll
            for (int b = 0; b < 2; ++b)
#pragma unroll
                for (int m = 0; m < 4; ++m)
#pragma unroll
                    for (int n = 0; n < 2; ++n) acc[a][b][m][n] = (f32x4){0.f, 0.f, 0.f, 0.f};
        cur = nxt; cA = nA; cB = nB; ++ui;
        if constexpr (ALIGN_EPI) { if (wr == 1) PG8_BAR; }
    }
    PG8_WAIT_V(0);
    if constexpr (!ALIGN_EPI) { if (wr == 0) PG8_BAR; }
    PG8_BAR;
#undef PG8_SA
#undef PG8_SB
#undef PG8_STAGE
#undef PG8_LDA
#undef PG8_LDB
#undef PG8_MMA
#undef PG8_WAIT_V
#undef PG8_WAIT_L
#undef PG8_BAR
#undef PG8_SCHED
}
}

constexpr int NWAVES = 8, NTHREADS = 512;
struct Args { const void* in[23]; float* out; unsigned char* ws; int ph_lo, ph_hi; };
struct Frame {
    LAS unsigned char* lds;
    int tid, lane, wave, G, bid;
    unsigned char* wsb; unsigned zo; unsigned wl;
    __device__ __forceinline__ bf16_t* IKD() const { return (bf16_t*)(wsb + zo + WS_IKD); }
    __device__ __forceinline__ float* XB() const { return (float*)(wsb + zo + WS_XB); }
    __device__ __forceinline__ unsigned* PANEL(int bank) const { return (unsigned*)(wsb + zo + WS_CTL) + CW_PANEL + bank * 8192; }
    __device__ __forceinline__ float* IW() const { return (float*)(wsb + zo + WS_IW); }
    __device__ __forceinline__ float* SP(int l) const { return (float*)(wsb + zo + WS_SP) + l * 36864; }
    __device__ __forceinline__ f32x2* ROPE() const { return (f32x2*)(wsb + zo + WS_ROPE); }
    __device__ __forceinline__ f32x2* S5E() const { return (f32x2*)(wsb + zo + WS_S5E); }
    __device__ __forceinline__ float* RST() const { return (float*)(wsb + zo + WS_RST); }
    __device__ __forceinline__ bf16_t* Win_t() const { return (bf16_t*)(wsb + zo + wl + WS_W + WO_IN); }
    __device__ __forceinline__ bf16_t* Wabc_t() const { return (bf16_t*)(wsb + zo + wl + WS_W + WO_ABC); }
    __device__ __forceinline__ bf16_t* Wout_t() const { return (bf16_t*)(wsb + zo + wl + WS_W + WO_OUT); }
    __device__ __forceinline__ bf16_t* W1_t() const { return (bf16_t*)(wsb + zo + wl + WS_W + WO_W1); }
    __device__ __forceinline__ bf16_t* W2_t() const { return (bf16_t*)(wsb + zo + wl + WS_W + WO_W2); }
    __device__ __forceinline__ bf16_t* Wglu_t() const { return (bf16_t*)(wsb + zo + wl + WS_W + WO_GLU); }
    __device__ __forceinline__ bf16_t* H() const { return (bf16_t*)(wsb + zo + WS_H); }
    __device__ __forceinline__ bf16_t* ZS() const { return (bf16_t*)(wsb + zo + WS_ZS); }
    __device__ __forceinline__ unsigned char* GB() const { return wsb + zo + WS_G; }
    __device__ __forceinline__ bf16_t* MG() const { return (bf16_t*)(wsb + zo + WS_ZS); }
    __device__ __forceinline__ bf16_t* FB() const { return (bf16_t*)(wsb + zo + WS_ZS); }
};
constexpr int SP_LB = 0, SP_L64 = 2048, SP_BBR = 4096, SP_BBI = 4096 + 16384;

__device__ __forceinline__ int ropeperm(int j, int r) { const int half = r >> 1; return (j < r) ? ((j & 1) ? half + (j >> 1) : (j >> 1)) : j; }
__device__ __forceinline__ int zmap(int n) {
    if (n < ZDQ) return n;
    if (n < ZDK) { const int q = n - ZDQ, h = q >> 6, hc = q & 63; return 256 + h * 64 + ropeperm(hc, 16); }
    if (n < ZDV) return 640 + ropeperm(n - ZDK, 16);
    if (n < ZIQ) return 704 + (n - ZDV);
    if (n < ZIK) { const int q = n - ZIQ, h = q >> 5, hc = q & 31; return 768 + h * 32 + ropeperm(hc, 8); }
    if (n < ZIWC) return 896 + ropeperm(n - ZIK, 8);
    if (n < ZRQ) return (n - ZIWC) < 4 ? 928 + (n - ZIWC) : -1;
    if (n < ZRK) { const int q = n - ZRQ, h = q / 48, hc = q % 48; return 932 + h * 48 + ropeperm(hc, 48); }
    if (n < ZRV) { const int q = n - ZRK, h = q / 48, hc = q % 48; return 1124 + h * 48 + ropeperm(hc, 48); }
    if (n < ZRG) return 1316 + (n - ZRV);
    if (n < ZGATE) return 1700 + (n - ZRG);
    if (n < ZEND) return 2084 + (n - ZGATE);
    return -1;
}

__device__ __forceinline__ void tr_item(const float* W, int N, int kb, int nb, bf16_t* WT, int ldd, int koff, bool mapped, LAS float* scr, int lane) {
    const int k0 = 64 * kb, n0 = 32 * nb;
    const int c32 = lane & 31; int sc = n0 + c32; if (mapped) sc = zmap(sc);
#pragma unroll 8
    for (int i = 0; i < 32; ++i) { const int kk = 2 * i + (lane >> 5); scr[kk * 33 + c32] = (sc >= 0) ? W[(size_t)(k0 + kk) * N + sc] : 0.f; }
    asm volatile("s_waitcnt lgkmcnt(0)" ::: "memory");
    const int c = lane & 7;
#pragma unroll
    for (int j = 0; j < 4; ++j) { const int n = (lane >> 3) + 8 * j; const LAS float* s = scr + (8 * c) * 33 + n;
        u32x4 o; o.x = pk2(s[0 * 33], s[1 * 33]); o.y = pk2(s[2 * 33], s[3 * 33]); o.z = pk2(s[4 * 33], s[5 * 33]); o.w = pk2(s[6 * 33], s[7 * 33]);
        *(u32x4*)(WT + (size_t)(n0 + n) * ldd + koff + k0 + 8 * c) = o; }
    asm volatile("s_waitcnt lgkmcnt(0)" ::: "memory");
}

__device__ __forceinline__ void rms_row_bf16(const float* xrow, const float* gain, bf16_t* orow, int lane) {
    const f32x4* xr = (const f32x4*)xrow + lane; const f32x4* gr = (const f32x4*)gain + lane;
    f32x4 v[4]; float s = 0.f;
#pragma unroll
    for (int j = 0; j < 4; ++j) { v[j] = xr[64 * j]; s += (v[j].x * v[j].x + v[j].y * v[j].y) + (v[j].z * v[j].z + v[j].w * v[j].w); }
    const float rstd = rsqrtf(wave_sum(s) * (1.f / DM) + EPS);
    u32x2* o8 = (u32x2*)orow + lane;
#pragma unroll
    for (int j = 0; j < 4; ++j) { const f32x4 gg = gr[64 * j]; u32x2 w; w.x = pk2(v[j].x * rstd * gg.x, v[j].y * rstd * gg.y); w.y = pk2(v[j].z * rstd * gg.z, v[j].w * rstd * gg.w); o8[64 * j] = w; }
}
__device__ __forceinline__ void rms_row_f32(const float* xrow, const float* gain, float* orow, int lane) {
    const f32x4* xr = (const f32x4*)xrow + lane; const f32x4* gr = (const f32x4*)gain + lane;
    f32x4 v[4]; float s = 0.f;
#pragma unroll
    for (int j = 0; j < 4; ++j) { v[j] = xr[64 * j]; s += (v[j].x * v[j].x + v[j].y * v[j].y) + (v[j].z * v[j].z + v[j].w * v[j].w); }
    const float rstd = rsqrtf(wave_sum(s) * (1.f / DM) + EPS);
    f32x4* o = (f32x4*)orow + lane;
#pragma unroll
    for (int j = 0; j < 4; ++j) { const f32x4 gg = gr[64 * j]; o[64 * j] = v[j] * rstd * gg; }
}


__device__ __forceinline__ void phase_rope(Frame& F, const int* pos) {
    const int gt = F.bid * NTHREADS + F.tid, NT = F.G * NTHREADS;
    f32x2* RT = F.ROPE();
    for (int e = gt; e < T * NFREQ; e += NT) {
        const int tok = e / NFREQ, f = e % NFREQ;
        float lth, sc; int fi;
        if (f < 8) { lth = 13.122363377404328f; sc = 2.0f / 16.0f; fi = f; } else if (f < 12) { lth = 13.122363377404328f; sc = 2.0f / 8.0f; fi = f - 8; } else { lth = 9.210340371976184f; sc = 2.0f / 48.0f; fi = f - 12; }
        const float inv = expf(-lth * (float)fi * sc);
        const float p = (float)pos[tok];
        const float ang = p * inv;
        const float kq = rintf(ang * 0.15915494309189535f);
        float r = fmaf(-kq, 6.2831854820251465f, ang);
        r = fmaf(-kq, -1.7484555e-7f, r);
        RT[e] = (f32x2){cosf(r), sinf(r)};
    }
}

struct ProIn { const float *xin, *norm1_g, *w_in, *wa, *wb, *wc, *wo, *w1, *w2, *wg, *lam_re, *lam_im, *log_step, *b_re, *b_im; const int* pos; };
__device__ __forceinline__ void phase_prologue(Frame& F, const ProIn& I) {
#ifdef NO_PHASE_PROLOGUE
    return;
#endif
    LAS float* scr = (LAS float*)(F.lds + F.wave * 16384);
    const int gw = F.bid * NWAVES + F.wave, NGW = F.G * NWAVES;
#pragma unroll 1
    for (int l = 0; l < DEPTH; ++l) {
    F.wl = l ? (unsigned)(WS_W1L - WS_W) : 0u;
    constexpr int I_IN = 16 * (NINP / 32), I_A = 4 * 32, I_B = 6 * 32, I_C = 6 * 32, I_O = 16 * 32, I_1 = 16 * 128, I_2 = 64 * 32, I_G = 4 * 8;
    constexpr int NITEMS = I_IN + I_A + I_B + I_C + I_O + I_1 + I_2 + I_G;
    const float* w_in = I.w_in + (size_t)l * DM * NIN; const float* wa = I.wa + (size_t)l * 256 * DM; const float* wb = I.wb + (size_t)l * 384 * DM;
    const float* wc = I.wc + (size_t)l * 384 * DM; const float* wo = I.wo + (size_t)l * DM * DM; const float* w1 = I.w1 + (size_t)l * DM * FF;
    const float* w2 = I.w2 + (size_t)l * FF * DM; const float* wg = I.wg + (size_t)l * 256 * 256;
    for (int it = gw; it < NITEMS; it += NGW) {
        int r = it;
        if (r < I_IN) { tr_item(w_in, NIN, r / (NINP / 32), r % (NINP / 32), F.Win_t(), DM, 0, true, scr, F.lane); continue; } r -= I_IN;
        if (r < I_A) { tr_item(wa, DM, r / 32, r % 32, F.Wabc_t(), DM, 0, false, scr, F.lane); continue; } r -= I_A;
        if (r < I_B) { tr_item(wb, DM, r / 32, r % 32, F.Wabc_t(), DM, 256, false, scr, F.lane); continue; } r -= I_B;
        if (r < I_C) { tr_item(wc, DM, r / 32, r % 32, F.Wabc_t(), DM, 640, false, scr, F.lane); continue; } r -= I_C;
        if (r < I_O) { tr_item(wo, DM, r / 32, r % 32, F.Wout_t(), DM, 0, false, scr, F.lane); continue; } r -= I_O;
        if (r < I_1) { tr_item(w1, FF, r / 128, r % 128, F.W1_t(), DM, 0, false, scr, F.lane); continue; } r -= I_1;
        if (r < I_2) { tr_item(w2, DM, r / 32, r % 32, F.W2_t(), FF, 0, false, scr, F.lane); continue; } r -= I_2;
        tr_item(wg, 256, r / 8, r % 8, F.Wglu_t(), 256, 0, false, scr, F.lane);
    }
    {
        const int gt = F.bid * NTHREADS + F.tid;
        if (gt < 1024) {
            float* SPp = F.SP(l);
            const int g = gt >> 6, p = gt & 63;
            const float lr = I.lam_re[(l * 16 + g) * 64 + p], li = I.lam_im[(l * 16 + g) * 64 + p];
            const float step = expf(I.log_step[l * 16 + g]);
            const float mag = expf(lr * step); const float lbr = mag * cosf(li * step), lbi = mag * sinf(li * step);
            const float den = lr * lr + li * li;
            const float fr = ((lbr - 1.f) * lr + lbi * li) / den, fi = (lbi * lr - (lbr - 1.f) * li) / den;
            SPp[SP_LB + gt * 2] = lbr; SPp[SP_LB + gt * 2 + 1] = lbi;
            float pr = lbr, pi = lbi;
#pragma unroll
            for (int s = 0; s < 6; ++s) { const float nr = pr * pr - pi * pi, ni = 2.f * pr * pi; pr = nr; pi = ni; }
            SPp[SP_L64 + gt * 2] = pr; SPp[SP_L64 + gt * 2 + 1] = pi;
            const float* br = I.b_re + ((size_t)(l * 16 + g) * 64 + p) * 16; const float* bi = I.b_im + ((size_t)(l * 16 + g) * 64 + p) * 16;
#pragma unroll
            for (int c = 0; c < 16; ++c) { SPp[SP_BBR + gt * 16 + c] = fr * br[c] - fi * bi[c]; SPp[SP_BBI + gt * 16 + c] = fr * bi[c] + fi * br[c]; }
        }
    }
    }
    F.wl = 0u;
    for (int m = gw; m < T; m += NGW) rms_row_bf16(I.xin + (size_t)m * DM, I.norm1_g, F.H() + (size_t)m * DM, F.lane);
}

__device__ __forceinline__ u32x4 pack8(const f32x4& a, const f32x4& b) { u32x4 w; w.x = pk2(a.x, a.y); w.y = pk2(a.z, a.w); w.z = pk2(b.x, b.y); w.w = pk2(b.z, b.w); return w; }
__device__ __forceinline__ void unpack8(const u32x4& w, f32x4& a, f32x4& b) { a = (f32x4){bflo(w.x), bfhi(w.x), bflo(w.y), bfhi(w.y)}; b = (f32x4){bflo(w.z), bfhi(w.z), bflo(w.w), bfhi(w.w)}; }

__device__ __forceinline__ unsigned gate1_u8(float x) { const float s = 255.f * sigmoidf_(x) + 0.5f; const unsigned u = (unsigned)s; return u < 1u ? 1u : u; }
__device__ __forceinline__ unsigned gate4_u8(const f32x4& a) { return gate1_u8(a.x) | (gate1_u8(a.y) << 8) | (gate1_u8(a.z) << 16) | (gate1_u8(a.w) << 24); }
__device__ __forceinline__ void ungate8(const u32x2& w, f32x4& a, f32x4& b) {
    a = (f32x4){(float)(w.x & 255u), (float)((w.x >> 8) & 255u), (float)((w.x >> 16) & 255u), (float)(w.x >> 24)};
    b = (f32x4){(float)(w.y & 255u), (float)((w.y >> 8) & 255u), (float)((w.y >> 16) & 255u), (float)(w.y >> 24)};
}
struct FInProj {
    bf16_t* ZS; unsigned char* GB; float* IW; const f32x2* ROPE; bf16_t* IKD;
    __device__ __forceinline__ void rope8(f32x4& a, f32x4& b, int row, int f0) const {
        const f32x2* rt = ROPE + (size_t)row * NFREQ + f0;
        const f32x2 c0 = rt[0], c1 = rt[1], c2 = rt[2], c3 = rt[3];
        f32x4 oa, ob;
        oa.x = a.x * c0.x - a.y * c0.y; oa.y = a.y * c0.x + a.x * c0.y;
        oa.z = a.z * c1.x - a.w * c1.y; oa.w = a.w * c1.x + a.z * c1.y;
        ob.x = b.x * c2.x - b.y * c2.y; ob.y = b.y * c2.x + b.x * c2.y;
        ob.z = b.z * c3.x - b.w * c3.y; ob.w = b.w * c3.x + b.z * c3.y;
        a = oa; b = ob;
    }
    __device__ __forceinline__ void operator()(int row, int col, f32x4 a, f32x4 b) const {
        if (col >= ZEND) return;
        if (col >= ZGATE) {
            *(u32x2*)(GB + (size_t)row * GW + (col - ZGATE)) = (u32x2){gate4_u8(a), gate4_u8(b)}; return;
        }
        if (col >= ZIWC && col < ZRQ) { if (col == ZIWC) *(f32x4*)(IW + (size_t)row * 4) = a; return; }
        if (col >= ZDQ && col < ZDV) { const int hc = (col - ZDQ) & 63; if (hc < 16) rope8(a, b, row, hc >> 1); }
        else if (col >= ZIQ && col < ZIWC) { const int hc = (col - ZIQ) & 31; if (hc < 8) rope8(a, b, row, 8);
            if (col >= ZIK) { *(u32x4*)(IKD + ((size_t)((row >> 5) * 4 + ((col - ZIK) >> 3)) * 32 + (row & 31)) * 8) = pack8(a, b); return; } }
        else if (col >= ZRQ && col < ZRV) { const int hc = (col - ZRQ) % 48; rope8(a, b, row, 12 + (hc >> 1)); }
        *(u32x4*)(ZS + (size_t)row * ZSW + col) = pack8(a, b);
    }
};
struct FMerge {
    bf16_t* MG; const bf16_t* GB; int br;
    __device__ __forceinline__ void operator()(int row, int col, f32x4 a, f32x4 b) const {
        f32x4 ga, gb; unpack8(*(const u32x4*)(GB + (size_t)row * GW + br * DM + col), ga, gb);
        a = a * ga; b = b * gb;
        u32x4* mp = (u32x4*)(MG + (size_t)row * DM + col);
        if (br != 0) { f32x4 pa, pb; unpack8(*mp, pa, pb); a = a + pa; b = b + pb; }
        *mp = pack8(a, b);
    }
};
struct FResid {
    const float* base; float* out;
    __device__ __forceinline__ void operator()(int row, int col, f32x4 a, f32x4 b) const {
        const f32x4* bp = (const f32x4*)(base + (size_t)row * DM + col); f32x4* op = (f32x4*)(out + (size_t)row * DM + col);
        const f32x4 b0 = bp[0], b1 = bp[1]; op[0] = b0 + a; op[1] = b1 + b;
    }
};
struct FRelu2 {
    bf16_t* FB;
    __device__ __forceinline__ void operator()(int row, int col, f32x4 a, f32x4 b) const {
        a = (f32x4){fmaxf(a.x, 0.f), fmaxf(a.y, 0.f), fmaxf(a.z, 0.f), fmaxf(a.w, 0.f)}; b = (f32x4){fmaxf(b.x, 0.f), fmaxf(b.y, 0.f), fmaxf(b.z, 0.f), fmaxf(b.w, 0.f)};
        *(u32x4*)(FB + (size_t)row * FF + col) = pack8(a * a, b * b);
    }
};
struct FGlu {
    bf16_t* H; const float* bias;
    __device__ __forceinline__ void operator()(int row, int col, f32x4 a, f32x4 b) const {
        u32x4* hp = (u32x4*)(H + (size_t)row * DM + col); f32x4 ya, yb; unpack8(*hp, ya, yb);
        const f32x4 ba = *(const f32x4*)(bias + col), bb = *(const f32x4*)(bias + col + 4);
        a = a + ba; b = b + bb;
        a = (f32x4){ya.x * sigmoidf_(a.x), ya.y * sigmoidf_(a.y), ya.z * sigmoidf_(a.z), ya.w * sigmoidf_(a.w)};
        b = (f32x4){yb.x * sigmoidf_(b.x), yb.y * sigmoidf_(b.y), yb.z * sigmoidf_(b.z), yb.w * sigmoidf_(b.w)};
        *hp = pack8(a, b);
    }
};

struct EpiMerge {
    static constexpr bool PERM = true, HAS_MID = true, FUSED = false; static constexpr int MID0 = 4, MID1 = 10;
    bf16_t* MG; const unsigned char* GB;
    __device__ __forceinline__ void mid(f32x4 (&acc)[2][2][4][2], const pg8::Unit& u, int t, int wr, int wc, int fr, int fq) const {
        int zz = 0; asm volatile("" : "+v"(zz));
        const int row0 = u.pm * 256 + wr * 64 + fr + zz, col0 = u.pn * 256 + wc * 32 + 8 * fq, bp = (t == MID0) ? 0 : 1;
#pragma unroll
        for (int ai = 0; ai < 2; ++ai)
#pragma unroll
            for (int m = 0; m < 4; ++m) {
#pragma unroll
                for (int bj = 0; bj < 2; ++bj) {
                    const unsigned char* gp = GB + (size_t)(row0 + ai * 128 + m * 16) * GW + bp * DM + col0 + bj * 128;
                    f32x4 pa, pb, na, nb; ungate8(*(const u32x2*)gp, pa, pb); ungate8(*(const u32x2*)(gp + DM), na, nb);
                    const f32x4 fa = {pa.x * __builtin_amdgcn_rcpf(na.x), pa.y * __builtin_amdgcn_rcpf(na.y), pa.z * __builtin_amdgcn_rcpf(na.z), pa.w * __builtin_amdgcn_rcpf(na.w)};
                    const f32x4 fb = {pb.x * __builtin_amdgcn_rcpf(nb.x), pb.y * __builtin_amdgcn_rcpf(nb.y), pb.z * __builtin_amdgcn_rcpf(nb.z), pb.w * __builtin_amdgcn_rcpf(nb.w)};
                    acc[ai][bj][m][0] = acc[ai][bj][m][0] * fa; acc[ai][bj][m][1] = acc[ai][bj][m][1] * fb;
                }
                if (m == 3) asm volatile("" ::: "memory");
            }
    }
    __device__ __forceinline__ void operator()(const f32x4 (&acc)[2][2][4][2], const pg8::Unit& u, int wr, int wc, int fr, int fq) const {
        const int row0 = u.pm * 256 + wr * 64 + fr, col0 = u.pn * 256 + wc * 32 + 8 * fq;
#pragma unroll
        for (int ai = 0; ai < 2; ++ai)
#pragma unroll
            for (int m = 0; m < 4; ++m)
#pragma unroll
                for (int bj = 0; bj < 2; ++bj) {
                    const int row = row0 + ai * 128 + m * 16, col = col0 + bj * 128;
                    f32x4 ga, gb; ungate8(*(const u32x2*)(GB + (size_t)row * GW + 2 * DM + col), ga, gb);
                    *(u32x4*)(MG + (size_t)row * DM + col) = pack8(acc[ai][bj][m][0] * (ga * (1.f / 255.f)), acc[ai][bj][m][1] * (gb * (1.f / 255.f)));
                }
    }
};

struct EpiResidNorm {
    static constexpr bool PERM = true, HAS_MID = false, FUSED = true;
    const float* base; float* XOUT; bf16_t* HN; float* NOUT; const float* gain; float* xbuf; unsigned* cnt;
    __device__ __forceinline__ void fused(f32x4 (&acc)[2][2][4][2], const pg8::Unit& u, int wr, int wc, int fr, int fq, LAS unsigned char* lds, int wid, int lane) const {
        LAS float* P = (LAS float*)(lds + 131072);
        LAS float* S = (LAS float*)(lds + 131072 + 4096);
        LAS unsigned* flag = (LAS unsigned*)(lds + 131072 + 5120);
        int zz = 0; asm volatile("" : "+v"(zz));
        const int rl0 = wr * 64 + fr + zz, row0 = u.pm * 256 + rl0, col0 = u.pn * 256 + wc * 32 + 8 * fq;
#pragma unroll
        for (int ai = 0; ai < 2; ++ai) {
#pragma unroll
            for (int m = 0; m < 4; ++m) {
                float ss = 0.f;
#pragma unroll
                for (int bj = 0; bj < 2; ++bj) {
                    const size_t off = (size_t)(row0 + ai * 128 + m * 16) * DM + col0 + bj * 128;
                    const f32x4 x0 = *(const f32x4*)(base + off) + acc[ai][bj][m][0], x1 = *(const f32x4*)(base + off + 4) + acc[ai][bj][m][1];
                    acc[ai][bj][m][0] = x0; acc[ai][bj][m][1] = x1;
                    if (XOUT) { *(f32x4*)(XOUT + off) = x0; *(f32x4*)(XOUT + off + 4) = x1; }
                    ss += (x0.x * x0.x + x0.y * x0.y) + (x0.z * x0.z + x0.w * x0.w) + (x1.x * x1.x + x1.y * x1.y) + (x1.z * x1.z + x1.w * x1.w);
                }
                ss += __shfl_xor(ss, 16); ss += __shfl_xor(ss, 32);
                if (fq == 0) P[(rl0 + ai * 128 + m * 16) * 4 + wc] = ss;
            }
            asm volatile("" ::: "memory");
        }
        asm volatile("s_waitcnt lgkmcnt(0)" ::: "memory"); __builtin_amdgcn_s_barrier(); asm volatile("" ::: "memory");
        const int rowt = wid * 64 + lane;
        if (wid < 4) {
            const f32x4 p = *(const LAS f32x4*)(P + rowt * 4);
            __hip_atomic_store(xbuf + (size_t)(u.pm * 256 + rowt) * 4 + u.pn, (p.x + p.y) + (p.z + p.w), __ATOMIC_RELAXED, __HIP_MEMORY_SCOPE_AGENT);
        }
        asm volatile("s_waitcnt vmcnt(0)" ::: "memory");
        if (lane == 0) __hip_atomic_fetch_add(cnt + 64 * u.pm, 1u, __ATOMIC_RELAXED, __HIP_MEMORY_SCOPE_AGENT);
        if (wid == 0) {
            unsigned sp = 0u;
            for (;;) {
                if ((unsigned)__builtin_amdgcn_readfirstlane(__hip_atomic_load(cnt + 64 * u.pm, __ATOMIC_RELAXED, __HIP_MEMORY_SCOPE_AGENT)) >= 32u) break;
                __builtin_amdgcn_s_sleep(2);
                if (++sp > (1u << 20)) break;
            }
            __builtin_amdgcn_fence(__ATOMIC_ACQUIRE, "agent");
            if (lane == 0) flag[0] = 1u;
        }
        asm volatile("s_waitcnt vmcnt(0) lgkmcnt(0)" ::: "memory"); __builtin_amdgcn_s_barrier(); asm volatile("" ::: "memory");
        if (wid < 4) {
            const float* sl = xbuf + (size_t)(u.pm * 256 + rowt) * 4;
            const float s = (__hip_atomic_load(sl, __ATOMIC_RELAXED, __HIP_MEMORY_SCOPE_AGENT) + __hip_atomic_load(sl + 1, __ATOMIC_RELAXED, __HIP_MEMORY_SCOPE_AGENT))
                          + (__hip_atomic_load(sl + 2, __ATOMIC_RELAXED, __HIP_MEMORY_SCOPE_AGENT) + __hip_atomic_load(sl + 3, __ATOMIC_RELAXED, __HIP_MEMORY_SCOPE_AGENT));
            S[rowt] = rsqrtf(s * (1.f / DM) + EPS);
        }
        asm volatile("s_waitcnt vmcnt(0) lgkmcnt(0)" ::: "memory"); __builtin_amdgcn_s_barrier(); asm volatile("" ::: "memory");
#pragma unroll
        for (int bj = 0; bj < 2; ++bj) {
            const f32x4 g0 = *(const f32x4*)(gain + col0 + bj * 128), g1 = *(const f32x4*)(gain + col0 + bj * 128 + 4);
#pragma unroll
            for (int ai = 0; ai < 2; ++ai)
#pragma unroll
                for (int m = 0; m < 4; ++m) {
                    const float rs = S[rl0 + ai * 128 + m * 16];
                    const size_t off = (size_t)(row0 + ai * 128 + m * 16) * DM + col0 + bj * 128;
                    const f32x4 y0 = acc[ai][bj][m][0] * rs * g0, y1 = acc[ai][bj][m][1] * rs * g1;
                    if (HN) *(u32x4*)(HN + off) = pack8(y0, y1);
                    if (NOUT) { *(f32x4*)(NOUT + off) = y0; *(f32x4*)(NOUT + off + 4) = y1; }
                }
        }
        asm volatile("s_waitcnt lgkmcnt(0)" ::: "memory"); __builtin_amdgcn_s_barrier(); asm volatile("" ::: "memory");
    }
    __device__ __forceinline__ void operator()(const f32x4 (&)[2][2][4][2], const pg8::Unit&, int, int, int, int) const {}
};

typedef float f32x16 __attribute__((ext_vector_type(16)));
__device__ __forceinline__ float gelu_tanh(float x) { const float u = 0.7978845608028654f * (x + 0.044715f * x * x * x); const float e = __expf(2.f * u); const float th = 1.f - 2.f * __builtin_amdgcn_rcpf(e + 1.f); return 0.5f * x * (1.f + th); }
constexpr int S5_XSTR = 272;
constexpr int S5_WAVE_LDS = 2 * 16 * S5_XSTR;
template <bool OUT>
__device__ __forceinline__ void s5_pass(Frame& F, int l, const float* c_re, const float* c_im, const float* ssm_d) {
    const bf16_t* ZSp = F.ZS(); const float* SPp = F.SP(l); f32x2* S5Ep = F.S5E();
    LAS unsigned char* XL = F.lds + F.wave * S5_WAVE_LDS;
    for (int task = F.bid * NWAVES + F.wave; task < 256 * 16; task += F.G * NWAVES) {
        int lane = F.lane; asm volatile("" : "+v"(lane));
        const int n = lane & 31, hh = lane >> 5, l15 = lane & 15, kg = lane >> 4;
        const int g = task & 15, pp = task >> 4, cmine = 2 * pp + hh;
        bf16x8 bbf[2][2];
#pragma unroll
        for (int st = 0; st < 2; ++st) { const float* br = SPp + SP_BBR + (size_t)(g * 64 + 2 * n + st) * 16 + 8 * hh; const float* bi = SPp + SP_BBI + (size_t)(g * 64 + 2 * n + st) * 16 + 8 * hh;
            bbf[st][0] = __builtin_bit_cast(bf16x8, pack8(*(const f32x4*)br, *(const f32x4*)(br + 4))); bbf[st][1] = __builtin_bit_cast(bf16x8, pack8(*(const f32x4*)bi, *(const f32x4*)(bi + 4))); }
        const f32x4 lb = *(const f32x4*)(SPp + SP_LB + (g * 64 + 2 * n) * 2);
        f32x4 x = {0.f, 0.f, 0.f, 0.f};
        if constexpr (OUT) x = *(const f32x4*)(S5Ep + (size_t)(cmine * 16 + g) * 64 + 2 * n);
        bf16x8 cf[4]; f32x4 dsk = {0.f, 0.f, 0.f, 0.f};
        if constexpr (OUT) {
#pragma unroll
            for (int ks = 0; ks < 4; ++ks) { const float* cp = ((ks < 2) ? c_re : c_im) + ((size_t)(l * 16 + g) * 16 + l15) * 64 + 32 * (ks & 1) + 8 * kg;
                f32x4 a = *(const f32x4*)cp, b = *(const f32x4*)(cp + 4); if (ks >= 2) { a = -a; b = -b; }
                cf[ks] = __builtin_bit_cast(bf16x8, pack8(a, b)); }
            dsk = *(const f32x4*)(ssm_d + (l * 16 + g) * 16 + 4 * kg);
        }
        const bf16_t* urow = ZSp + (size_t)((2 * pp + ((n >> 2) & 1)) * 64 + 4 * (n >> 3) + (n & 3)) * ZSW + ZU + g * 16 + 8 * hh;
#pragma unroll 1
        for (int k = 0; k < 4; ++k) {
            const bf16x8 uf = *(const bf16x8*)(urow + (size_t)(16 * k) * ZSW);
            const f32x16 z16 = {0.f, 0.f, 0.f, 0.f, 0.f, 0.f, 0.f, 0.f, 0.f, 0.f, 0.f, 0.f, 0.f, 0.f, 0.f, 0.f};
            const f32x16 r0 = __builtin_amdgcn_mfma_f32_32x32x16_bf16(uf, bbf[0][0], z16, 0, 0, 0), i0 = __builtin_amdgcn_mfma_f32_32x32x16_bf16(uf, bbf[0][1], z16, 0, 0, 0);
            const f32x16 r1 = __builtin_amdgcn_mfma_f32_32x32x16_bf16(uf, bbf[1][0], z16, 0, 0, 0), i1 = __builtin_amdgcn_mfma_f32_32x32x16_bf16(uf, bbf[1][1], z16, 0, 0, 0);
#pragma unroll
            for (int t = 0; t < 16; ++t) {
                const float nr0 = lb.x * x.x - lb.y * x.y + r0[t], ni0 = lb.x * x.y + lb.y * x.x + i0[t];
                const float nr1 = lb.z * x.z - lb.w * x.w + r1[t], ni1 = lb.z * x.w + lb.w * x.z + i1[t];
                x = (f32x4){nr0, ni0, nr1, ni1};
                if constexpr (OUT) { LAS unsigned* xw = (LAS unsigned*)(XL + (hh * 16 + t) * S5_XSTR + 4 * n); xw[0] = pk2(nr0, nr1); xw[32] = pk2(ni0, ni1); }
            }
            if constexpr (OUT) {
                asm volatile("s_waitcnt lgkmcnt(0)" ::: "memory");
#pragma unroll
                for (int sel = 0; sel < 2; ++sel) {
                    f32x4 y = {0.f, 0.f, 0.f, 0.f};
#pragma unroll
                    for (int ks = 0; ks < 4; ++ks) { const bf16x8 xf = *(const LAS bf16x8*)(XL + (sel * 16 + l15) * S5_XSTR + (32 * ks + 8 * kg) * 2); y = __builtin_amdgcn_mfma_f32_16x16x32_bf16(cf[ks], xf, y, 0, 0, 0); }
                    const size_t tok = (size_t)(2 * pp + sel) * 64 + 16 * k + l15;
                    const u32x2 uw = *(const u32x2*)(ZSp + tok * ZSW + ZU + g * 16 + 4 * kg);
                    const float y0 = gelu_tanh(y.x + dsk.x * bflo(uw.x)), y1 = gelu_tanh(y.y + dsk.y * bfhi(uw.x)), y2 = gelu_tanh(y.z + dsk.z * bflo(uw.y)), y3 = gelu_tanh(y.w + dsk.w * bfhi(uw.y));
                    *(u32x2*)(F.H() + tok * DM + g * 16 + 4 * kg) = (u32x2){pk2(y0, y1), pk2(y2, y3)};
                }
                asm volatile("s_waitcnt lgkmcnt(0)" ::: "memory");
            }
        }
        if constexpr (!OUT) *(f32x4*)(S5Ep + (size_t)(cmine * 16 + g) * 64 + 2 * n) = x;
    }
}
__device__ __forceinline__ void phase_s5_local(Frame& F, int l) {
#ifdef NO_PHASE_S5_LOCAL
    return;
#endif
    s5_pass<false>(F, l, nullptr, nullptr, nullptr);
}
__device__ __forceinline__ void phase_s5_out(Frame& F, int l, const float* c_re, const float* c_im, const float* ssm_d) {
#ifdef NO_PHASE_S5_OUT
    return;
#endif
    s5_pass<true>(F, l, c_re, c_im, ssm_d);
}

__device__ __forceinline__ void phase_carry(Frame& F, int l) {
#ifdef NO_PHASE_CARRY
    return;
#endif
    const float* SPp = F.SP(l); f32x2* S5Ep = F.S5E(); float* RSTp = F.RST();
    const int gw = F.bid * NWAVES + F.wave, NGW = F.G * NWAVES;
    for (int task = gw; task < NB * 16; task += NGW) {
        const int b = task >> 4, g = task & 15, p = F.lane;
        const float ar = SPp[SP_L64 + (g * 64 + p) * 2], ai = SPp[SP_L64 + (g * 64 + p) * 2 + 1];
        float sr = 0.f, si = 0.f;
        for (int c0 = 0; c0 < 128; c0 += 16) {
            f32x2 e[16];
#pragma unroll
            for (int j = 0; j < 16; ++j) e[j] = S5Ep[(size_t)((b * 128 + c0 + j) * 16 + g) * 64 + p];
#pragma unroll
            for (int j = 0; j < 16; ++j) { S5Ep[(size_t)((b * 128 + c0 + j) * 16 + g) * 64 + p] = (f32x2){sr, si}; const float nr = ar * sr - ai * si + e[j].x, ni = ar * si + ai * sr + e[j].y; sr = nr; si = ni; }
        }
    }
    const int NT = F.G * NTHREADS;
    for (int gt = F.bid * NTHREADS + F.tid; gt < NB * 4 * 4608; gt += NT) {
        const int b = gt / (4 * 4608), h = (gt / 4608) & 3, el = gt % 4608;
        const float lg = log1pf(-exp2f(-5.f - (float)h));
        const float cdec = expf(lg * 64.f);
        float s = 0.f;
        for (int c0 = 0; c0 < 128; c0 += 16) {
            float d[16];
#pragma unroll
            for (int j = 0; j < 16; ++j) d[j] = RSTp[(size_t)((b * 128 + c0 + j) * 4 + h) * 4608 + el];
#pragma unroll
            for (int j = 0; j < 16; ++j) { RSTp[(size_t)((b * 128 + c0 + j) * 4 + h) * 4608 + el] = s; s = s * cdec + d[j]; }
        }
    }
}

typedef float f32x16 __attribute__((ext_vector_type(16)));
typedef short s16x4 __attribute__((ext_vector_type(4)));
__device__ __forceinline__ bf16x8 tr8(const LAS unsigned char* a0, const LAS unsigned char* a1) {
    const s16x4 lo = __builtin_bit_cast(s16x4, __builtin_amdgcn_ds_read_tr16_b64_v4i16((LAS s16x4*)a0));
    const s16x4 hi = __builtin_bit_cast(s16x4, __builtin_amdgcn_ds_read_tr16_b64_v4i16((LAS s16x4*)a1));
    return (bf16x8){lo[0], lo[1], lo[2], lo[3], hi[0], hi[1], hi[2], hi[3]};
}
__device__ __forceinline__ bf16x8 pack8f(const f32x4& a, const f32x4& b) { return __builtin_bit_cast(bf16x8, pack8(a, b)); }
__device__ __forceinline__ void ret_stage_v(const bf16_t* ZSp, LAS unsigned char* Vb, int tok0, int h, int lane) {
#pragma unroll
    for (int n = 0; n < 12; ++n) { const int o = n * 1024 + 16 * lane, r = o / 192, ch = (o % 192) >> 4;
        __builtin_amdgcn_global_load_lds((const unsigned*)(ZSp + (size_t)(tok0 + r) * ZSW + ZRV + h * 96 + ch * 8), (LAS unsigned*)(Vb + n * 1024), 16, 0, 0); }
}
constexpr int RET_VB = 12288, RET_KSTR = 112, RET_WAVE_LDS = RET_VB + 64 * RET_KSTR;
__device__ __forceinline__ void phase_ret_local(Frame& F) {
#ifdef NO_PHASE_RET_LOCAL
    return;
#endif
    const bf16_t* ZSp = F.ZS(); float* RSTp = F.RST();
    LAS unsigned char* Vb = F.lds + F.wave * RET_WAVE_LDS; LAS unsigned char* Kb = Vb + RET_VB;
    for (int item = F.bid * NWAVES + F.wave; item < 2048; item += F.G * NWAVES) {
        int lane = F.lane; asm volatile("" : "+v"(lane));
        const int l31 = lane & 31, hh = lane >> 5, g1 = (lane >> 4) & 1, q4 = (lane & 15) >> 2, p4 = lane & 3;
        const int h = item & 3, tok0 = (item >> 2) * 64;
        ret_stage_v(ZSp, Vb, tok0, h, lane);
        const float lg2 = log2f(1.f - exp2f(-5.f - (float)h));
#pragma unroll
        for (int n = 0; n < 6; ++n) { const int idx = n * 64 + lane, r = idx / 6, ch = idx % 6;
            f32x4 a, b; unpack8(*(const u32x4*)(ZSp + (size_t)(tok0 + r) * ZSW + ZRK + h * 48 + ch * 8), a, b);
            const float sc = 0.14433756729740643f * exp2f(lg2 * (float)(63 - r));
            *(LAS u32x4*)(Kb + r * RET_KSTR + ch * 16) = pack8(a * sc, b * sc); }
        asm volatile("s_waitcnt vmcnt(0) lgkmcnt(0)" ::: "memory");
        f32x16 acc[3][2];
#pragma unroll
        for (int me = 0; me < 3; ++me)
#pragma unroll
            for (int nt = 0; nt < 2; ++nt) acc[me][nt] = (f32x16){0.f, 0.f, 0.f, 0.f, 0.f, 0.f, 0.f, 0.f, 0.f, 0.f, 0.f, 0.f, 0.f, 0.f, 0.f, 0.f};
#pragma unroll
        for (int s = 0; s < 4; ++s) {
            const int r0 = 16 * s + 8 * hh + q4;
            bf16x8 kf[2], vf[3];
#pragma unroll
            for (int nt = 0; nt < 2; ++nt) { const LAS unsigned char* a0 = Kb + r0 * RET_KSTR + (32 * nt + 16 * g1 + 4 * p4) * 2; kf[nt] = tr8(a0, a0 + 4 * RET_KSTR); }
#pragma unroll
            for (int me = 0; me < 3; ++me) { const LAS unsigned char* a0 = Vb + r0 * 192 + (32 * me + 16 * g1 + 4 * p4) * 2; vf[me] = tr8(a0, a0 + 4 * 192); }
#pragma unroll
            for (int me = 0; me < 3; ++me)
#pragma unroll
                for (int nt = 0; nt < 2; ++nt) acc[me][nt] = __builtin_amdgcn_mfma_f32_32x32x16_bf16(vf[me], kf[nt], acc[me][nt], 0, 0, 0);
        }
        float* dst = RSTp + (size_t)item * 4608 + (4 * hh) * 48 + l31;
#pragma unroll
        for (int me = 0; me < 3; ++me)
#pragma unroll
            for (int r4 = 0; r4 < 4; ++r4) {
                int zz = 0; asm volatile("" : "+v"(zz)); float* dp = dst + (32 * me + 8 * r4) * 48 + zz;
#pragma unroll
                for (int k = 0; k < 4; ++k) { dp[k * 48] = acc[me][0][4 * r4 + k]; if (l31 < 16) dp[k * 48 + 32] = acc[me][1][4 * r4 + k]; }
            }
        asm volatile("s_waitcnt lgkmcnt(0)" ::: "memory");
    }
}
__device__ __forceinline__ void phase_ret_out(Frame& F, int l, const float* ret_norm_g) {
#ifdef NO_PHASE_RET_OUT
    return;
#endif
    const bf16_t* ZSp = F.ZS(); const float* RSTp = F.RST();
    LAS unsigned char* Vb = F.lds + F.wave * RET_WAVE_LDS;
    for (int item = F.bid * NWAVES + F.wave; item < 2048; item += F.G * NWAVES) {
        int lane = F.lane; asm volatile("" : "+v"(lane));
        const int l31 = lane & 31, hh = lane >> 5, g1 = (lane >> 4) & 1, q4 = (lane & 15) >> 2, p4 = lane & 3;
        const int h = item & 3, tok0 = (item >> 2) * 64;
        ret_stage_v(ZSp, Vb, tok0, h, lane);
        const float lg2 = log2f(1.f - exp2f(-5.f - (float)h));
        bf16x8 qf[2][3], kf[2][3];
#pragma unroll
        for (int t = 0; t < 2; ++t)
#pragma unroll
            for (int ks = 0; ks < 3; ++ks) { const size_t ro = (size_t)(tok0 + 32 * t + l31) * ZSW + h * 48 + 8 * hh + 16 * ks;
                qf[t][ks] = *(const bf16x8*)(ZSp + ro + ZRQ); kf[t][ks] = *(const bf16x8*)(ZSp + ro + ZRK); }
        bf16x8 pm[2][4];
#pragma unroll
        for (int mt = 0; mt < 2; ++mt)
#pragma unroll
            for (int nt = mt; nt < 2; ++nt) {
                f32x16 p = {0.f, 0.f, 0.f, 0.f, 0.f, 0.f, 0.f, 0.f, 0.f, 0.f, 0.f, 0.f, 0.f, 0.f, 0.f, 0.f};
#pragma unroll
                for (int ks = 0; ks < 3; ++ks) p = __builtin_amdgcn_mfma_f32_32x32x16_bf16(kf[mt][ks], qf[nt][ks], p, 0, 0, 0);
                const int i = 32 * nt + l31;
#pragma unroll
                for (int r = 0; r < 16; ++r) { const int j = 32 * mt + (r & 3) + 8 * (r >> 2) + 4 * hh;
                    p[r] = (i >= j) ? p[r] * (0.14433756729740643f * exp2f(lg2 * (float)(i - j))) : 0.f; }
                pm[nt][2 * mt + 0] = pack8f((f32x4){p[0], p[1], p[2], p[3]}, (f32x4){p[4], p[5], p[6], p[7]});
                pm[nt][2 * mt + 1] = pack8f((f32x4){p[8], p[9], p[10], p[11]}, (f32x4){p[12], p[13], p[14], p[15]});
            }
        f32x16 ot[3][2];
#pragma unroll
        for (int me = 0; me < 3; ++me) {
            bf16x8 sf[3];
            int zz = 0; asm volatile("" : "+v"(zz)); const float* sp0 = RSTp + (size_t)item * 4608 + (32 * me + l31) * 48 + 8 * hh + zz;
#pragma unroll
            for (int ks = 0; ks < 3; ++ks) { const float* sp = sp0 + 16 * ks; sf[ks] = pack8f(*(const f32x4*)sp, *(const f32x4*)(sp + 4)); }
#pragma unroll
            for (int nt = 0; nt < 2; ++nt) {
                f32x16 a = {0.f, 0.f, 0.f, 0.f, 0.f, 0.f, 0.f, 0.f, 0.f, 0.f, 0.f, 0.f, 0.f, 0.f, 0.f, 0.f};
#pragma unroll
                for (int ks = 0; ks < 3; ++ks) a = __builtin_amdgcn_mfma_f32_32x32x16_bf16(sf[ks], qf[nt][ks], a, 0, 0, 0);
                const float qd = exp2f(lg2 * (float)(32 * nt + l31 + 1));
                ot[me][nt] = a * qd;
            }
        }
        asm volatile("s_waitcnt vmcnt(0)" ::: "memory");
#pragma unroll
        for (int s = 0; s < 4; ++s) {
            const int r0 = 16 * s + 4 * hh + q4;
#pragma unroll
            for (int me = 0; me < 3; ++me) {
                const LAS unsigned char* a0 = Vb + r0 * 192 + (32 * me + 16 * g1 + 4 * p4) * 2;
                const bf16x8 vf = tr8(a0, a0 + 8 * 192);
                if (s < 2) ot[me][0] = __builtin_amdgcn_mfma_f32_32x32x16_bf16(vf, pm[0][s], ot[me][0], 0, 0, 0);
                ot[me][1] = __builtin_amdgcn_mfma_f32_32x32x16_bf16(vf, pm[1][s], ot[me][1], 0, 0, 0);
            }
        }
#pragma unroll
        for (int nt = 0; nt < 2; ++nt) {
            float sum = 0.f;
#pragma unroll
            for (int me = 0; me < 3; ++me)
#pragma unroll
                for (int r = 0; r < 16; ++r) sum += ot[me][nt][r];
            sum += __shfl_xor(sum, 32);
            const float mu = sum * (1.f / 96.f); float q2 = 0.f;
#pragma unroll
            for (int me = 0; me < 3; ++me)
#pragma unroll
                for (int r = 0; r < 16; ++r) { const float d = ot[me][nt][r] - mu; q2 += d * d; }
            q2 += __shfl_xor(q2, 32);
            const float rs = rsqrtf(q2 * (1.f / 96.f) + EPS);
            const int tok = tok0 + 32 * nt + l31;
            const bf16_t* gbase = ZSp + (size_t)tok * ZSW + ZRG + h * 96 + 4 * hh; const float* nbase = ret_norm_g + l * 384 + h * 96 + 4 * hh; bf16_t* obase = F.H() + (size_t)tok * DM + 640 + h * 96 + 4 * hh;
#pragma unroll
            for (int me = 0; me < 3; ++me) {
                int zz = 0; asm volatile("" : "+v"(zz));
                const bf16_t* gp = gbase + 32 * me + zz; const float* np = nbase + 32 * me + zz; bf16_t* op = obase + 32 * me + zz;
#pragma unroll
                for (int r4 = 0; r4 < 4; ++r4) {
                    const u32x2 gw = *(const u32x2*)(gp + 8 * r4);
                    const f32x4 ng = *(const f32x4*)(np + 8 * r4);
                    const float g0 = bflo(gw.x), g1f = bfhi(gw.x), g2 = bflo(gw.y), g3 = bfhi(gw.y);
                    const float y0 = (ot[me][nt][4 * r4 + 0] - mu) * rs * ng.x * (g0 * sigmoidf_(g0)), y1 = (ot[me][nt][4 * r4 + 1] - mu) * rs * ng.y * (g1f * sigmoidf_(g1f));
                    const float y2 = (ot[me][nt][4 * r4 + 2] - mu) * rs * ng.z * (g2 * sigmoidf_(g2)), y3 = (ot[me][nt][4 * r4 + 3] - mu) * rs * ng.w * (g3 * sigmoidf_(g3));
                    *(u32x2*)(op + 8 * r4) = (u32x2){pk2(y0, y1), pk2(y2, y3)};
                }
            }
        }
        asm volatile("s_waitcnt lgkmcnt(0)" ::: "memory");
    }
}

typedef _Float16 f16_t;
__device__ __forceinline__ u32x4 zero4() { unsigned z = 0u; asm volatile("" : "+v"(z)); return (u32x4){z, z, z, z}; }
__device__ __forceinline__ int lanes_below(unsigned long long m) { return (int)__builtin_amdgcn_mbcnt_hi((unsigned)(m >> 32), __builtin_amdgcn_mbcnt_lo((unsigned)m, 0u)); }
__device__ __forceinline__ float relu1(float x) { return __builtin_amdgcn_fmed3f(x, 0.f, __builtin_inff()); }
__device__ __forceinline__ unsigned sortable_f16(float sc) {
    const f16_t h = (f16_t)sc; const unsigned u = (unsigned)__builtin_bit_cast(unsigned short, h), mag = u & 0x7fffu;
    return (u & 0x8000u) ? (0x8000u - mag) : (0x8000u + mag);
}
__device__ __forceinline__ int sc_pos(int k) { return k; }
__device__ __forceinline__ int wave_suffix_sum(int v, int lane) {
#pragma unroll
    for (int o = 1; o < 64; o <<= 1) { const int t = __shfl_down(v, o); if (lane + o < 64) v += t; }
    return v;
}
__device__ __forceinline__ void hist_threshold(const u32x4 c, int need, int lane, int& B, int& above) {
    const int s = (int)(c.x + c.y + c.z + c.w);
    const int S = wave_suffix_sum(s, lane);
    int a = S - s;
    const bool found = (a < need) && (S >= need);
    int Bl = 0, al = 0;
    if (found) {
        if (a + (int)c.w >= need) { Bl = 4 * lane + 3; al = a; }
        else { a += (int)c.w; if (a + (int)c.z >= need) { Bl = 4 * lane + 2; al = a; }
        else { a += (int)c.z; if (a + (int)c.y >= need) { Bl = 4 * lane + 1; al = a; }
        else { a += (int)c.y; Bl = 4 * lane; al = a; } } }
    }
    const unsigned long long m = __ballot(found);
    const int src = m ? (int)__builtin_ctzll(m) : 0;
    B = __shfl(Bl, src); above = __shfl(al, src);
}

#ifndef DSA_CAND
#define DSA_CAND 0
#endif
#ifndef DSA_DUP
#define DSA_DUP 0
#endif
constexpr int DSA_ROW = 16384;
__device__ __forceinline__ void phase_dsa(Frame& F) {
#ifdef NO_PHASE_DSA
    return;
#endif
    const int wave = F.wave;
    const bf16_t* ZSp = F.ZS(); const float* IWp = F.IW(); const bf16_t* IKp = F.IKD();
    LAS unsigned char* SCb = F.lds;
    for (int it = F.bid; it < 512; it += F.G) {
        int lane = F.lane; asm volatile("" : "+v"(lane));
        const int hi = lane >> 5, n32 = lane & 31;
        LAS unsigned short* LSTw = (LAS unsigned short*)(F.lds + 131072) + wave * 256;
        LAS unsigned char* WB = F.lds + 135168 + wave * 3520;
        LAS unsigned* H1 = (LAS unsigned*)WB; LAS unsigned* H2 = H1 + 256;
        LAS unsigned* DUM = (LAS unsigned*)(WB + 3264) + lane;
        LAS unsigned short* CK = (LAS unsigned short*)(WB + 1024); LAS unsigned short* CI = (LAS unsigned short*)(WB + 2144);
        const int pr = it & 255, vcu = (pr & 7) * 32 + (pr >> 3);
        const int b = vcu >> 6, cc = vcu & 63, c = (it < 256) ? cc : 127 - cc;
        const int V = (c + 1) * 64, tokq0 = b * SEQ + c * 64, kb0 = b * SEQ;
        const int Keff = V < 256 ? V : 256;
        const int nblk = (V + 511) >> 9, ntile_all = nblk * 16, ntile_real = V >> 5;
        for (int qg = 0; qg < 8; ++qg) {
            const int tq0 = tokq0 + qg * 8;
#ifndef DSA_NO_A
            for (int repA = 0; repA < 1 + (DSA_DUP & 1); ++repA) {
                bf16x8 aq[2];
                { const int qq = n32 >> 2, hd = n32 & 3; const bf16_t* qp = ZSp + (size_t)(tq0 + qq) * ZSW + ZIQ + hd * 32 + 8 * hi;
                  aq[0] = *(const bf16x8*)qp; aq[1] = *(const bf16x8*)(qp + 16); }
                float wq[4][4];
#pragma unroll
                for (int jq = 0; jq < 4; ++jq) { const f32x4 w4 = *(const f32x4*)(IWp + (size_t)(tq0 + 2 * jq + hi) * 4);
                    wq[jq][0] = w4.x * 0.08838834764831845f; wq[jq][1] = w4.y * 0.08838834764831845f; wq[jq][2] = w4.z * 0.08838834764831845f; wq[jq][3] = w4.w * 0.08838834764831845f; }
                bf16x8 fr[2][4][2];
                const int nb = (ntile_all - wave + 31) >> 5;
#define DSA_ALOAD(buf, bt) do { int zz = 0; asm volatile("" : "+v"(zz)); _Pragma("unroll") for (int u = 0; u < 4; ++u) { const int tt = wave + 8 * (4 * (bt) + u); \
        if (tt < ntile_real) { const bf16_t* kp = IKp + ((size_t)(((kb0 >> 5) + tt) * 4 + hi) * 32 + n32 + zz) * 8; fr[buf][u][0] = *(const bf16x8*)kp; fr[buf][u][1] = *(const bf16x8*)(kp + 512); } } } while (0)
#define DSA_ACOMP(buf, bt) do { _Pragma("unroll") for (int u = 0; u < 4; ++u) { const int tt = wave + 8 * (4 * (bt) + u); \
        if (tt < ntile_all) { unsigned short us[4] = {0, 0, 0, 0}; \
            if (tt < ntile_real) { f32x16 acc = {0.f, 0.f, 0.f, 0.f, 0.f, 0.f, 0.f, 0.f, 0.f, 0.f, 0.f, 0.f, 0.f, 0.f, 0.f, 0.f}; \
                acc = __builtin_amdgcn_mfma_f32_32x32x16_bf16(aq[0], fr[buf][u][0], acc, 0, 0, 0); acc = __builtin_amdgcn_mfma_f32_32x32x16_bf16(aq[1], fr[buf][u][1], acc, 0, 0, 0); \
                _Pragma("unroll") for (int jq = 0; jq < 4; ++jq) { \
                    const float sc = relu1(acc[4 * jq + 0]) * wq[jq][0] + relu1(acc[4 * jq + 1]) * wq[jq][1] + relu1(acc[4 * jq + 2]) * wq[jq][2] + relu1(acc[4 * jq + 3]) * wq[jq][3]; \
                    us[jq] = (unsigned short)sortable_f16(sc); } } \
            const int pos = sc_pos(tt * 32 + n32); \
            _Pragma("unroll") for (int jq = 0; jq < 4; ++jq) *(LAS unsigned short*)(SCb + (2 * jq + hi) * DSA_ROW + pos * 2) = us[jq]; } } } while (0)
                DSA_ALOAD(0, 0);
                for (int bp = 0; bp < nb; bp += 2) {
                    if (bp + 1 < nb) DSA_ALOAD(1, bp + 1);
                    DSA_ACOMP(0, bp);
                    if (bp + 2 < nb) DSA_ALOAD(0, bp + 2);
                    if (bp + 1 < nb) DSA_ACOMP(1, bp + 1);
                }
#undef DSA_ALOAD
#undef DSA_ACOMP
            }
#endif
            __syncthreads();
            LAS unsigned char* row = SCb + wave * DSA_ROW;
#ifndef DSA_NO_B
            for (int repB = 0; repB < 1 + ((DSA_DUP >> 1) & 1); ++repB)
            if (V > 256) {
                *(LAS u32x4*)(H1 + 4 * lane) = zero4(); *(LAS u32x4*)(H2 + 4 * lane) = zero4();
                u32x4 rw[4];
#define DSA_LD8(hf) do { _Pragma("unroll") for (int i = 0; i < 4; ++i) if (4 * (hf) + i < nblk) rw[i] = *(const LAS u32x4*)(row + (512 * (4 * (hf) + i) + 8 * lane) * 2); \
        asm volatile("s_waitcnt lgkmcnt(0)" ::: "memory"); } while (0)
#define DSA_W(i, e2) ((e2) == 0 ? rw[i].x : (e2) == 1 ? rw[i].y : (e2) == 2 ? rw[i].z : rw[i].w)
                asm volatile("s_waitcnt lgkmcnt(0)" ::: "memory");
#pragma unroll 1
                for (int hf = 0; 4 * hf < nblk; ++hf) {
                    DSA_LD8(hf);
#pragma unroll
                    for (int i = 0; i < 4; ++i) if (4 * hf + i < nblk) __hip_atomic_fetch_add(H2 + ((rw[i].x >> 8) & 255u), 1u, __ATOMIC_RELAXED, __HIP_MEMORY_SCOPE_WORKGROUP);
                }
                asm volatile("s_waitcnt lgkmcnt(0)" ::: "memory");
                int Bc, abovec; hist_threshold(*(const LAS u32x4*)(H2 + 4 * lane), 40, lane, Bc, abovec);
                { const u32x4 hs = *(const LAS u32x4*)(H2 + 4 * lane); const int tot = wave_suffix_sum((int)(hs.x + hs.y + hs.z + hs.w), lane); if (__shfl(tot, 0) < 40) Bc = 0; }
                *(LAS u32x4*)(H2 + 4 * lane) = zero4();
                bool done = false;
                if (DSA_CAND && Bc > 0) {
                    const unsigned thr = (unsigned)Bc << 8;
                    int cnt = 0;
#pragma unroll 1
                    for (int hf = 0; 4 * hf < nblk; ++hf) {
                        DSA_LD8(hf);
#pragma unroll
                        for (int i = 0; i < 4; ++i) if (4 * hf + i < nblk) {
#pragma unroll
                            for (int e = 0; e < 8; ++e) { const unsigned w = DSA_W(i, e >> 1); const unsigned u = (e & 1) ? (w >> 16) : (w & 0xffffu); cnt += (u >= thr) ? 1 : 0; }
                        }
                    }
                    int pos = cnt;
#pragma unroll
                    for (int o = 1; o < 64; o <<= 1) { const int t = __shfl_up(pos, o); if (lane >= o) pos += t; }
                    const int ncand = __shfl(pos, 63); pos -= cnt;
                    if (ncand >= 256 && ncand <= 560) {
                        LAS unsigned short* ldum = (LAS unsigned short*)DUM;
#pragma unroll 1
                        for (int hf = 0; 4 * hf < nblk; ++hf) {
                            DSA_LD8(hf);
#pragma unroll
                            for (int i = 0; i < 4; ++i) if (4 * hf + i < nblk) {
#pragma unroll
                                for (int e = 0; e < 8; ++e) { const unsigned w = DSA_W(i, e >> 1); const unsigned u = (e & 1) ? (w >> 16) : (w & 0xffffu);
                                    const bool sel = u >= thr; LAS unsigned short* pk = sel ? CK + pos : ldum; LAS unsigned short* pi = sel ? CI + pos : ldum;
                                    *pk = (unsigned short)u; *pi = (unsigned short)(512 * (4 * hf + i) + 8 * lane + e); pos += sel ? 1 : 0; }
                            }
                        }
                        *(LAS u32x4*)(H1 + 4 * lane) = zero4();
                        asm volatile("s_waitcnt lgkmcnt(0)" ::: "memory");
                        unsigned cu[9];
#pragma unroll
                        for (int j = 0; j < 9; ++j) { const int p = j * 64 + lane; const bool v = p < ncand; cu[j] = v ? (unsigned)CK[v ? p : 0] : 0u; }
                        asm volatile("s_waitcnt lgkmcnt(0)" ::: "memory");
#pragma unroll
                        for (int j = 0; j < 9; ++j) if (j * 64 + lane < ncand) __hip_atomic_fetch_add(H1 + (cu[j] >> 8), 1u, __ATOMIC_RELAXED, __HIP_MEMORY_SCOPE_WORKGROUP);
                        asm volatile("s_waitcnt lgkmcnt(0)" ::: "memory");
                        int B1c, above1c; hist_threshold(*(const LAS u32x4*)(H1 + 4 * lane), 256, lane, B1c, above1c);
                        *(LAS u32x4*)(H1 + 4 * lane) = zero4();
                        asm volatile("s_waitcnt lgkmcnt(0)" ::: "memory");
#pragma unroll
                        for (int j = 0; j < 9; ++j) if (j * 64 + lane < ncand && (int)(cu[j] >> 8) == B1c) __hip_atomic_fetch_add(H1 + (cu[j] & 255u), 1u, __ATOMIC_RELAXED, __HIP_MEMORY_SCOPE_WORKGROUP);
                        asm volatile("s_waitcnt lgkmcnt(0)" ::: "memory");
                        int B2c, above2c; hist_threshold(*(const LAS u32x4*)(H1 + 4 * lane), 256 - above1c, lane, B2c, above2c);
                        const unsigned tauc = ((unsigned)B1c << 8) | (unsigned)B2c;
                        if ((int)H1[B2c] == 256 - above1c - above2c) {
                            int c2 = 0;
#pragma unroll
                            for (int j = 0; j < 9; ++j) c2 += (j * 64 + lane < ncand && cu[j] >= tauc) ? 1 : 0;
                            int p2 = c2;
#pragma unroll
                            for (int o = 1; o < 64; o <<= 1) { const int t = __shfl_up(p2, o); if (lane >= o) p2 += t; }
                            p2 -= c2;
#pragma unroll
                            for (int j = 0; j < 9; ++j) { const bool sel = (j * 64 + lane < ncand) && cu[j] >= tauc; LAS unsigned short* pl = sel ? LSTw + p2 : ldum; *pl = CI[sel ? j * 64 + lane : 0]; p2 += sel ? 1 : 0; }
                            done = true;
                        }
                        *(LAS u32x4*)(H1 + 4 * lane) = zero4(); *(LAS u32x4*)(H2 + 4 * lane) = zero4();
                        asm volatile("s_waitcnt lgkmcnt(0)" ::: "memory");
                    }
                }
                if (!done) {
                int lo_bin = Bc, hi_bin = 256;
                for (;;) {
#pragma unroll 1
                    for (int hf = 0; 4 * hf < nblk; ++hf) {
                        DSA_LD8(hf);
#pragma unroll
                        for (int i = 0; i < 4; ++i) if (4 * hf + i < nblk) {
#pragma unroll
                            for (int e2 = 0; e2 < 4; ++e2) { const unsigned w = DSA_W(i, e2); const int b0 = (int)((w >> 8) & 255u), b1 = (int)(w >> 24);
                                LAS unsigned* p0 = ((unsigned)(b0 - lo_bin) < (unsigned)(hi_bin - lo_bin)) ? H1 + b0 : DUM; LAS unsigned* p1 = ((unsigned)(b1 - lo_bin) < (unsigned)(hi_bin - lo_bin)) ? H1 + b1 : DUM;
                                __hip_atomic_fetch_add(p0, 1u, __ATOMIC_RELAXED, __HIP_MEMORY_SCOPE_WORKGROUP); __hip_atomic_fetch_add(p1, 1u, __ATOMIC_RELAXED, __HIP_MEMORY_SCOPE_WORKGROUP); }
                        }
                    }
                    asm volatile("s_waitcnt lgkmcnt(0)" ::: "memory");
                    if (lo_bin == 0) break;
                    const u32x4 h4 = *(const LAS u32x4*)(H1 + 4 * lane); const int tot = __shfl(wave_suffix_sum((int)(h4.x + h4.y + h4.z + h4.w), lane), 0);
                    if (tot >= 256) break;
                    hi_bin = lo_bin; lo_bin = 0;
                }
                asm volatile("s_waitcnt lgkmcnt(0)" ::: "memory");
                int B1, above1; hist_threshold(*(const LAS u32x4*)(H1 + 4 * lane), 256, lane, B1, above1);
#pragma unroll 1
                for (int hf = 0; 4 * hf < nblk; ++hf) {
                    DSA_LD8(hf);
#pragma unroll
                    for (int i = 0; i < 4; ++i) if (4 * hf + i < nblk) {
#pragma unroll
                        for (int e2 = 0; e2 < 4; ++e2) { const unsigned w = DSA_W(i, e2);
                            LAS unsigned* p0 = ((int)((w >> 8) & 255u) == B1) ? H2 + (w & 255u) : DUM; LAS unsigned* p1 = ((int)(w >> 24) == B1) ? H2 + ((w >> 16) & 255u) : DUM;
                            __hip_atomic_fetch_add(p0, 1u, __ATOMIC_RELAXED, __HIP_MEMORY_SCOPE_WORKGROUP); __hip_atomic_fetch_add(p1, 1u, __ATOMIC_RELAXED, __HIP_MEMORY_SCOPE_WORKGROUP); }
                    }
                }
                asm volatile("s_waitcnt lgkmcnt(0)" ::: "memory");
                int B2, above2; hist_threshold(*(const LAS u32x4*)(H2 + 4 * lane), 256 - above1, lane, B2, above2);
                const unsigned tau = ((unsigned)B1 << 8) | (unsigned)B2;
                const int r = 256 - above1 - above2;
                const int neq = (int)H2[B2];
                if (neq == r) {
                    int cnt = 0;
#pragma unroll 1
                    for (int hf = 0; 4 * hf < nblk; ++hf) {
                        DSA_LD8(hf);
#pragma unroll
                        for (int i = 0; i < 4; ++i) if (4 * hf + i < nblk) {
#pragma unroll
                            for (int e = 0; e < 8; ++e) { const unsigned w = DSA_W(i, e >> 1); const unsigned u = (e & 1) ? (w >> 16) : (w & 0xffffu); cnt += (u >= tau) ? 1 : 0; }
                        }
                    }
                    int pos = cnt;
#pragma unroll
                    for (int o = 1; o < 64; o <<= 1) { const int t = __shfl_up(pos, o); if (lane >= o) pos += t; }
                    pos -= cnt;
                    LAS unsigned short* ldum = (LAS unsigned short*)DUM;
#pragma unroll 1
                    for (int hf = 0; 4 * hf < nblk; ++hf) {
                        DSA_LD8(hf);
#pragma unroll
                        for (int i = 0; i < 4; ++i) if (4 * hf + i < nblk) {
#pragma unroll
                            for (int e = 0; e < 8; ++e) { const unsigned w = DSA_W(i, e >> 1); const unsigned u = (e & 1) ? (w >> 16) : (w & 0xffffu);
                                const bool sel = u >= tau; LAS unsigned short* p = sel ? LSTw + pos : ldum;
                                *p = (unsigned short)(512 * (4 * hf + i) + 8 * lane + e); pos += sel ? 1 : 0; }
                        }
                    }
                } else {
                    int eq_base = 0, sel_base = 0;
#pragma unroll 1
                    for (int i = 0; i < nblk; ++i) {
                        const u32x4 w4 = *(const LAS u32x4*)(row + (512 * i + 8 * lane) * 2);
                        const unsigned ww[4] = {w4.x, w4.y, w4.z, w4.w};
                        int below_eq = 0, mine_eq = 0;
#pragma unroll
                        for (int e = 0; e < 8; ++e) { const unsigned u = (e & 1) ? (ww[e >> 1] >> 16) : (ww[e >> 1] & 0xffffu); below_eq += lanes_below(__ballot(u == tau)); }
                        int blk_eq = 0;
#pragma unroll
                        for (int e = 0; e < 8; ++e) {
                            const unsigned u = (e & 1) ? (ww[e >> 1] >> 16) : (ww[e >> 1] & 0xffffu);
                            const bool gt = u > tau, eq = (u == tau);
                            const bool sel = gt || (eq && (eq_base + below_eq + mine_eq < r));
                            mine_eq += eq ? 1 : 0;
                            const unsigned long long msel = __ballot(sel);
                            if (sel) LSTw[sel_base + lanes_below(msel)] = (unsigned short)(512 * i + 8 * lane + e);
                            sel_base += __popcll(msel); blk_eq += __popcll(__ballot(eq));
                        }
                        eq_base += blk_eq;
                    }
                }
                }
#undef DSA_W
#undef DSA_LD8
            } else {
#pragma unroll
                for (int jj = 0; jj < 4; ++jj) LSTw[lane + 64 * jj] = (unsigned short)(lane + 64 * jj);
            }
#endif
            asm volatile("s_waitcnt lgkmcnt(0)" ::: "memory");
            for (int repC = 0; repC < 1 + ((DSA_DUP >> 2) & 1); ++repC) {
                const int tq = tq0 + wave, n16 = lane & 15, kg = lane >> 4;
                bf16x8 qf[2];
                if (n16 < 6) { const bf16_t* qp = ZSp + (size_t)tq * ZSW + ZDQ + n16 * 64 + 8 * kg; qf[0] = *(const bf16x8*)qp; qf[1] = *(const bf16x8*)(qp + 32); }
                else { qf[0] = (bf16x8){0, 0, 0, 0, 0, 0, 0, 0}; qf[1] = qf[0]; }
                const int ntile = Keff >> 4;
                LAS unsigned char* vst = row;
#define DSA_VDMA(ch, buf) do { _Pragma("unroll") for (int i8 = 0; i8 < 8; ++i8) { const int rr = (lane >> 3) + 8 * i8; const int kidx = LSTw[(ch) * 64 + rr]; \
        const int sch = (lane & 7) ^ (2 * ((rr >> 1) & 3)); \
        __builtin_amdgcn_global_load_lds((const unsigned*)(ZSp + (size_t)(kb0 + kidx) * ZSW + ZDV + sch * 8), (LAS unsigned*)(vst + (buf) * 8192 + i8 * 1024), 16, 0, 0); } } while (0)
                DSA_VDMA(0, 0);
                if (ntile > 4) DSA_VDMA(1, 1);
                f32x4 sa[16];
                bf16x8 kf[2][4][2];
#define DSA_KLOAD(buf, tb) do { _Pragma("unroll") for (int t4 = 0; t4 < 4; ++t4) if (4 * (tb) + t4 < ntile) { const int kidx = LSTw[(4 * (tb) + t4) * 16 + n16]; \
        const bf16_t* kp = ZSp + (size_t)(kb0 + kidx) * ZSW + ZDK + 8 * kg; kf[buf][t4][0] = *(const bf16x8*)kp; kf[buf][t4][1] = *(const bf16x8*)(kp + 32); } } while (0)
#define DSA_KMMA(buf, tb) do { _Pragma("unroll") for (int t4 = 0; t4 < 4; ++t4) { \
        if (4 * (tb) + t4 < ntile) { f32x4 a = {0.f, 0.f, 0.f, 0.f}; \
            a = __builtin_amdgcn_mfma_f32_16x16x32_bf16(kf[buf][t4][0], qf[0], a, 0, 0, 0); a = __builtin_amdgcn_mfma_f32_16x16x32_bf16(kf[buf][t4][1], qf[1], a, 0, 0, 0); sa[4 * (tb) + t4] = a; } \
        else sa[4 * (tb) + t4] = (f32x4){-1e30f, -1e30f, -1e30f, -1e30f}; } } while (0)
                DSA_KLOAD(0, 0); DSA_KLOAD(1, 1);
                DSA_KMMA(0, 0); DSA_KLOAD(0, 2);
                DSA_KMMA(1, 1); DSA_KLOAD(1, 3);
                DSA_KMMA(0, 2);
                DSA_KMMA(1, 3);
#undef DSA_KLOAD
#undef DSA_KMMA
                float m = -1e30f;
#pragma unroll
                for (int t = 0; t < 16; ++t) m = fmaxf(m, fmaxf(fmaxf(sa[t].x, sa[t].y), fmaxf(sa[t].z, sa[t].w)));
                m = fmaxf(m, __shfl_xor(m, 16)); m = fmaxf(m, __shfl_xor(m, 32));
                const float sc2 = 0.125f * 1.4426950408889634f; float lsum = 0.f;
#pragma unroll
                for (int t = 0; t < 16; ++t) { sa[t].x = exp2f((sa[t].x - m) * sc2); sa[t].y = exp2f((sa[t].y - m) * sc2); sa[t].z = exp2f((sa[t].z - m) * sc2); sa[t].w = exp2f((sa[t].w - m) * sc2);
                    lsum += (sa[t].x + sa[t].y) + (sa[t].z + sa[t].w); }
                lsum += __shfl_xor(lsum, 16); lsum += __shfl_xor(lsum, 32);
                const float linv = __builtin_amdgcn_rcpf(lsum);
                f32x4 oacc[4] = {{0.f, 0.f, 0.f, 0.f}, {0.f, 0.f, 0.f, 0.f}, {0.f, 0.f, 0.f, 0.f}, {0.f, 0.f, 0.f, 0.f}};
                const int q4 = n16 >> 2, p4 = n16 & 3;
#pragma unroll
                for (int ch = 0; ch < 4; ++ch) {
                    if (ch * 4 < ntile) {
                        if ((ch + 1) * 4 < ntile) asm volatile("s_waitcnt vmcnt(8)" ::: "memory");
                        else asm volatile("s_waitcnt vmcnt(0)" ::: "memory");
#pragma unroll
                        for (int sl = 0; sl < 2; ++sl) {
                            const int s = ch * 2 + sl;
                            u32x4 pw; pw.x = pk2(sa[2 * s].x, sa[2 * s].y); pw.y = pk2(sa[2 * s].z, sa[2 * s].w); pw.z = pk2(sa[2 * s + 1].x, sa[2 * s + 1].y); pw.w = pk2(sa[2 * s + 1].z, sa[2 * s + 1].w);
                            const bf16x8 pb = __builtin_bit_cast(bf16x8, pw);
#pragma unroll
                            for (int mt = 0; mt < 4; ++mt) {
                                const int P0 = 32 * sl + 4 * kg + q4, P1 = P0 + 16;
                                const LAS unsigned char* a0 = vst + (ch & 1) * 8192 + P0 * 128 + (((2 * mt + (p4 >> 1)) ^ (2 * ((P0 >> 1) & 3))) * 16) + 8 * (p4 & 1);
                                const LAS unsigned char* a1 = vst + (ch & 1) * 8192 + P1 * 128 + (((2 * mt + (p4 >> 1)) ^ (2 * ((P1 >> 1) & 3))) * 16) + 8 * (p4 & 1);
                                const s16x4 lo = __builtin_bit_cast(s16x4, __builtin_amdgcn_ds_read_tr16_b64_v4i16((LAS s16x4*)a0));
                                const s16x4 hi4 = __builtin_bit_cast(s16x4, __builtin_amdgcn_ds_read_tr16_b64_v4i16((LAS s16x4*)a1));
                                const bf16x8 va = (bf16x8){lo[0], lo[1], lo[2], lo[3], hi4[0], hi4[1], hi4[2], hi4[3]};
                                oacc[mt] = __builtin_amdgcn_mfma_f32_16x16x32_bf16(va, pb, oacc[mt], 0, 0, 0);
                            }
                        }
                        asm volatile("s_waitcnt lgkmcnt(0)" ::: "memory");
                        if (ch + 2 < 4 && (ch + 2) * 4 < ntile) DSA_VDMA(ch + 2, ch & 1);
                    }
                }
#undef DSA_VDMA
                if (n16 < 6) {
                    bf16_t* op = F.H() + (size_t)tq * DM + 256 + n16 * 64 + 4 * kg;
#pragma unroll
                    for (int mt = 0; mt < 4; ++mt) { u32x2 o; o.x = pk2(oacc[mt].x * linv, oacc[mt].y * linv); o.y = pk2(oacc[mt].z * linv, oacc[mt].w * linv); *(u32x2*)(op + 16 * mt) = o; }
                }
            }
            __syncthreads();
        }
    }
}

__global__ void __launch_bounds__(NTHREADS, 2) mk_fwd(Args args) {
    extern __shared__ __attribute__((aligned(16))) unsigned char lds_raw[];
    Frame F;
    F.lds = (LAS unsigned char*)lds_raw;
    F.tid = threadIdx.x; F.lane = F.tid & 63; F.wave = __builtin_amdgcn_readfirstlane(F.tid >> 6);
    F.G = gridDim.x; F.bid = blockIdx.x; F.wsb = args.ws; F.zo = 0u; F.wl = 0u;
    unsigned char* ws = args.ws;
#define INF(k) ((const float*)args.in[k])

    volatile LAS unsigned* MISC = (volatile LAS unsigned*)(F.lds + MISC_OFF);
    if (F.tid < 64) MISC[F.tid] = 0u;
    __syncthreads();
    XcdBarrier bar = xcd_barrier_post((unsigned*)(ws + WS_CTL) + CW_BAR, MISC + 8);
    int ph = 0; const int lo = args.ph_lo, hi = args.ph_hi;
    unsigned long long* TSp = (unsigned long long*)(ws + WS_CTL + 32768); int nst = 0; (void)TSp; (void)nst;
    bool first_seam = true;
#ifndef DUP_MASK
#define DUP_MASK 0
#endif
#ifdef PROBE_LO
#define STAMP() do { if (F.bid == 0 && F.tid == 0) { TSp[nst] = __builtin_amdgcn_s_memrealtime(); } ++nst; } while (0)
#else
#define STAMP() do { } while (0)
#endif
#define GRIDSYNC() xcd_barrier(bar, F.wave == 0 && (int)__builtin_amdgcn_mbcnt_hi(~0u, __builtin_amdgcn_mbcnt_lo(~0u, 0u)) == 0)
#define RUN(...) do { if (ph >= lo && ph < hi) { F.lane = (int)__builtin_amdgcn_mbcnt_hi(~0u, __builtin_amdgcn_mbcnt_lo(~0u, 0u)); asm volatile("" : "+v"(F.lane), "+s"(F.zo), "+s"(F.bid), "+s"(F.G), "+s"(F.wave)); F.tid = F.wave * 64 + F.lane; __VA_ARGS__; } ++ph; } while (0)
#define SEAM() do { if (ph > lo && ph < hi) { if (first_seam) { GRIDSYNC(); first_seam = false; } else xcd_barrier(bar, F.wave == 0 && (int)__builtin_amdgcn_mbcnt_hi(~0u, __builtin_amdgcn_mbcnt_lo(~0u, 0u)) == 0); } STAMP(); } while (0)

    STAMP();
    RUN(phase_rope(F, (const int*)args.in[1])); STAMP();
#pragma unroll
    RUN({ const ProIn I{INF(0), INF(2), INF(3), INF(15), INF(16), INF(17), INF(18), INF(20), INF(21), INF(12), INF(4), INF(5), INF(6), INF(7), INF(8), (const int*)args.in[1]};
          phase_prologue(F, I); }); SEAM();
    for (int l = 0; l < DEPTH; ++l) {
        const float* xin = (l == 0) ? INF(0) : args.out;
        F.wl = l ? (unsigned)(WS_W1L - WS_W) : 0u;
        RUN({ pg8::Gemm g{F.H(), F.Win_t()}; pg8::StaticOrder<T, NINP> S; S.init(F.G, F.bid);
              pg8::EpiGen<FInProj> E{FInProj{F.ZS(), F.GB(), F.IW(), F.ROPE(), F.IKD()}}; pg8::gemm_phase<T, NINP, DM, DM, DM>(F.lds, g, S, E, F.tid); }); SEAM();
        RUN({ phase_s5_local(F, l); __syncthreads(); phase_ret_local(F); __syncthreads(); phase_dsa(F); __syncthreads(); }); SEAM();
        RUN(phase_carry(F, l)); SEAM();
        RUN({ phase_s5_out(F, l, INF(9), INF(10), INF(11)); __syncthreads(); phase_ret_out(F, l, INF(14)); __syncthreads(); }); SEAM();
        RUN({ pg8::Gemm g{F.H(), F.Wglu_t()}; pg8::StaticOrder<T, 256> S; S.init(F.G, F.bid);
              pg8::EpiGen<FGlu, 0> E{FGlu{F.H(), INF(13) + l * 256}}; pg8::gemm_phase<T, 256, 256, DM, 256>(F.lds, g, S, E, F.tid); }); SEAM();
        RUN({ pg8::Gemm g{F.H(), F.Wabc_t()}; pg8::StaticOrder<T, DM> S; S.init(F.G, F.bid);
              EpiMerge E{F.MG(), F.GB()}; pg8::gemm_phase<T, DM, DM, DM, DM>(F.lds, g, S, E, F.tid); }); SEAM();
        RUN({ pg8::Gemm g{F.MG(), F.Wout_t()}; pg8::StaticOrder<T, DM> S; S.init(F.G, F.bid);
              EpiResidNorm E{xin, args.out, F.H(), nullptr, INF(19) + l * DM, F.XB(), F.PANEL(2 * l)}; pg8::gemm_phase<T, DM, DM, DM, DM>(F.lds, g, S, E, F.tid); }); SEAM();
        RUN({ pg8::Gemm g{F.H(), F.W1_t()}; pg8::StaticOrder<T, FF> S; S.init(F.G, F.bid);
              pg8::EpiGen<FRelu2> E{FRelu2{F.FB()}}; pg8::gemm_phase<T, FF, DM, DM, DM>(F.lds, g, S, E, F.tid); }); SEAM();
        RUN({ pg8::Gemm g{F.FB(), F.W2_t()}; pg8::StaticOrder<T, DM> S; S.init(F.G, F.bid);
              const bool lastl = (l + 1 == DEPTH);
              EpiResidNorm E{args.out, lastl ? (float*)nullptr : args.out, lastl ? (bf16_t*)nullptr : F.H(), lastl ? args.out : (float*)nullptr, lastl ? INF(22) : INF(2) + (l + 1) * DM, F.XB(), F.PANEL(2 * l + 1)};
              pg8::gemm_phase<T, DM, FF, FF, FF>(F.lds, g, S, E, F.tid); }); if (l + 1 < DEPTH) SEAM();
    }
    STAMP();
#ifdef PROBE_LO
    if (F.bid == 0 && F.tid == 0) {
        const int sel[] = PROBE_SEL; unsigned long long tot = 0;
        for (unsigned i = 0; i < sizeof(sel) / sizeof(int); ++i) tot += TSp[sel[i] + 1] - TSp[sel[i]];
        const float us = (float)tot * 0.01f;
        asm volatile("s_waitcnt vmcnt(0)" ::: "memory");
        args.out[0] = sqrtf(us * (float)((size_t)T * DM));
    }
#endif
#undef RUN
#undef SEAM
}

extern "C" void kernel_launch(void* const* d_in, const int* in_sizes, int n_in, void* d_out, int out_size, void* d_ws, size_t ws_size, hipStream_t stream) {
    static int grid = 0;
    if (grid == 0) {
        if (n_in != 23 || out_size != T * DM || ws_size < WS_END) { fprintf(stderr, "kernel_launch: unexpected shapes (n_in %d out %d ws %zu)\n", n_in, out_size, ws_size); grid = -1; return; }
        int dev = 0, cus = 0, per_cu = 0;
        hipGetDevice(&dev); hipDeviceGetAttribute(&cus, hipDeviceAttributeMultiprocessorCount, dev);
        if (hipFuncSetAttribute((const void*)mk_fwd, hipFuncAttributeMaxDynamicSharedMemorySize, LDS_BYTES) != hipSuccess) { fprintf(stderr, "kernel_launch: hipFuncSetAttribute failed\n"); grid = -1; return; }
        if (hipOccupancyMaxActiveBlocksPerMultiprocessor(&per_cu, (const void*)mk_fwd, NTHREADS, LDS_BYTES) != hipSuccess || per_cu < 1) { fprintf(stderr, "kernel_launch: occupancy query says %d\n", per_cu); per_cu = 1; }
        (void)hipGetLastError();
        grid = cus;
    }
    if (grid < 0) return;
    hipMemsetAsync((char*)d_ws + WS_CTL, 0, CTL_ZERO_BYTES, stream);
    Args a{};
    for (int i = 0; i < 23; ++i) a.in[i] = d_in[i];
    a.out = (float*)d_out; a.ws = (unsigned char*)d_ws;
#ifndef MK_SPLIT
    a.ph_lo = 0; a.ph_hi = 1000;
    void* kargs[] = {&a};
    hipError_t e = hipLaunchCooperativeKernel((const void*)mk_fwd, dim3(grid), dim3(NTHREADS), kargs, LDS_BYTES, stream);
    if (e != hipSuccess) fprintf(stderr, "kernel_launch: cooperative launch failed: %s\n", hipGetErrorString(e));
#else
    for (int p = 0; p < 2 * 9 + 2; ++p) { a.ph_lo = p; a.ph_hi = p + 1; hipLaunchKernelGGL(mk_fwd, dim3(grid), dim3(NTHREADS), LDS_BYTES, stream, a); }
#endif
}
```

```cpp
#include <hip/hip_runtime.h>
#include <cstdio>
#include <cstdint>

#define LAS __attribute__((address_space(3)))
#define GAS __attribute__((address_space(1)))
typedef unsigned short bf16_t;
typedef short bf16x8 __attribute__((ext_vector_type(8)));
typedef float f32x4 __attribute__((ext_vector_type(4)));
typedef float f32x2 __attribute__((ext_vector_type(2)));
typedef unsigned u32x4 __attribute__((ext_vector_type(4)));
typedef unsigned u32x2 __attribute__((ext_vector_type(2)));

constexpr int NB = 4, SEQ = 8192, T = NB * SEQ, DM = 1024, DEPTH = 2, FF = 4096;
constexpr int NIN = 5156, NINP = 5376;
constexpr int ZSW = 2112, GW = 3072;
constexpr int ZU = 0, ZDQ = 256, ZDK = 640, ZDV = 704, ZIQ = 768, ZIK = 896, ZIWC = 928, ZRQ = 960, ZRK = 1152, ZRV = 1344, ZRG = 1728, ZGATE = 2112, ZEND = 5184;
constexpr int NFREQ = 36;
constexpr float EPS = 1e-6f;

constexpr size_t MiB = 1u << 20;
constexpr size_t WS_CTL = 0, CTL_ZERO_BYTES = 512 * 1024;
constexpr size_t WS_IW = 1 * MiB;
constexpr size_t WS_SP = 1 * MiB + 512 * 1024;
constexpr size_t WS_ROPE = 2 * MiB;
constexpr size_t WS_S5E = 11 * MiB;
constexpr size_t WS_RST = 15 * MiB;
constexpr size_t WS_W = 51 * MiB;
constexpr size_t WO_IN = 0, WO_ABC = WO_IN + (size_t)NINP * DM * 2, WO_OUT = WO_ABC + (size_t)DM * DM * 2, WO_W1 = WO_OUT + (size_t)DM * DM * 2,
                 WO_W2 = WO_W1 + (size_t)FF * DM * 2, WO_GLU = WO_W2 + (size_t)FF * DM * 2, WO_END = WO_GLU + 256 * 256 * 2;
static_assert(WO_END <= 31 * MiB, "weights");
constexpr size_t WS_H = 82 * MiB;
constexpr size_t WS_ZS = 146 * MiB;
constexpr size_t WS_G = 278 * MiB;
constexpr size_t WS_IKD = 470 * MiB;
constexpr size_t WS_XB = 472 * MiB;
constexpr size_t WS_W1L = 474 * MiB;
constexpr size_t WS_END = 505 * MiB;
static_assert(WS_ZS + (size_t)T * ZSW * 2 <= WS_G && WS_G + (size_t)T * GW * 2 <= WS_END && WS_ZS + (size_t)T * FF * 2 <= WS_END, "ws map");
constexpr int CW_BAR = 1024, CW_PANEL = 32768;

constexpr int LDS_BYTES = 160 * 1024;
constexpr int RING_BYTES = 131072;
constexpr int MISC_OFF = LDS_BYTES - 256;

__device__ __forceinline__ unsigned f2bf(float f) { unsigned u = __builtin_bit_cast(unsigned, f); return (u + 0x7fffu + ((u >> 16) & 1u)) >> 16; }
__device__ __forceinline__ unsigned pk2(float lo, float hi) { unsigned r; asm("v_cvt_pk_bf16_f32 %0, %1, %2" : "=v"(r) : "v"(lo), "v"(hi)); return r; }
__device__ __forceinline__ float bf2f(unsigned short v) { return __builtin_bit_cast(float, (unsigned)v << 16); }
__device__ __forceinline__ float bflo(unsigned w) { return __builtin_bit_cast(float, w << 16); }
__device__ __forceinline__ float bfhi(unsigned w) { return __builtin_bit_cast(float, w & 0xffff0000u); }
__device__ __forceinline__ float sigmoidf_(float x) { return __builtin_amdgcn_rcpf(1.0f + __expf(-x)); }
__device__ __forceinline__ float wave_sum(float v) {
#pragma unroll
    for (int o = 1; o < 64; o <<= 1) v += __shfl_xor(v, o);
    return v;
}
__device__ __forceinline__ float wave_max(float v) {
#pragma unroll
    for (int o = 1; o < 64; o <<= 1) v = fmaxf(v, __shfl_xor(v, o));
    return v;
}

#define XB_TMO      128
#define XB_XCNT(j)  (256  + 64 * (j))
#define XB_XSUB(j)  (1280 + 64 * (j))
#define XB_XGEN(j)  (2304 + 64 * (j))
#define XB_TOP      3328
#define XB_TOPGEN   3392
#define XCD_BAR_WORDS 3456
#define XB_SPIN_CAP (1u << 18)
__device__ __forceinline__ unsigned xb_ld(unsigned* p)              { return __hip_atomic_load(p, __ATOMIC_RELAXED, __HIP_MEMORY_SCOPE_AGENT); }
__device__ __forceinline__ unsigned xb_add(unsigned* p, unsigned v) { return __hip_atomic_fetch_add(p, v, __ATOMIC_RELAXED, __HIP_MEMORY_SCOPE_AGENT); }
__device__ __forceinline__ unsigned xb_xcc_id() { return (unsigned)__builtin_amdgcn_s_getreg((3 << 11) | 20) & 0xFu; }
#define XB_SPIN(cond, bar) do { unsigned _sp = 0; while (cond) { __builtin_amdgcn_s_sleep(1); \
    if ((++_sp & 255u) == 0u) { if (xb_ld(&(bar)[XB_TMO])) break; if (_sp > XB_SPIN_CAP) { atomicAdd(&(bar)[XB_TMO], 1u); break; } } } } while (0)
struct XcdBarrier { unsigned* bar; unsigned x; volatile LAS unsigned* st; };
__device__ __forceinline__ XcdBarrier xcd_barrier_post(unsigned* bar, volatile LAS unsigned* st) {
    XcdBarrier b; b.bar = bar; b.x = xb_xcc_id(); b.st = st;
    if (threadIdx.x == 0) (void)xb_add(&bar[XB_XCNT(b.x)], 1u);
    return b;
}
__device__ __forceinline__ void xcd_barrier_complete(unsigned* bar, unsigned x, unsigned& nloc, unsigned& nx) {
    const unsigned G = gridDim.x * gridDim.y * gridDim.z;
    unsigned sum, cnt, mine, sp = 0u;
    for (;;) {
        sum = 0u; cnt = 0u; mine = 0u;
#pragma unroll
        for (unsigned j = 0; j < 16; ++j) { const unsigned c = xb_ld(&bar[XB_XCNT(j)]); sum += c; cnt += (c > 0u) ? 1u : 0u; mine = (j == x) ? c : mine; }
        if (sum == G) break;
        __builtin_amdgcn_s_sleep(1);
        if ((++sp & 255u) == 0u) { if (xb_ld(&bar[XB_TMO])) break; if (sp > XB_SPIN_CAP) { atomicAdd(&bar[XB_TMO], 1u); break; } }
    }
    nloc = mine > 0u ? mine : 1u; nx = cnt > 0u ? cnt : 1u;
}
__device__ __forceinline__ void xcd_barrier(const XcdBarrier& b, bool leader) {
    asm volatile("s_waitcnt vmcnt(0)" ::: "memory");
    __syncthreads();
    if (leader) {
        unsigned* bar = b.bar; unsigned bx = b.x;
        asm volatile("" : "+s"(bar), "+s"(bx));
        __builtin_amdgcn_s_waitcnt(0);
        unsigned nloc = b.st[0], nx = b.st[1];
        if (nloc == 0u) { xcd_barrier_complete(bar, bx, nloc, nx); b.st[0] = nloc; b.st[1] = nx; }
        const unsigned old = xb_add(&bar[XB_XSUB(bx)], 1u);
        const unsigned gen = old / nloc;
        if (old + 1u == (gen + 1u) * nloc) {
            __builtin_amdgcn_fence(__ATOMIC_RELEASE, "agent");
            asm volatile("s_waitcnt vmcnt(0)" ::: "memory");
            const unsigned og = xb_add(&bar[XB_TOP], 1u);
            const unsigned tg = og / nx;
            if (og + 1u == (tg + 1u) * nx) xb_add(&bar[XB_TOPGEN], 1u);
            else XB_SPIN(xb_ld(&bar[XB_TOPGEN]) == tg, bar);
            __builtin_amdgcn_fence(__ATOMIC_ACQUIRE, "agent");
            xb_add(&bar[XB_XGEN(bx)], 1u);
            asm volatile("s_waitcnt vmcnt(0)" ::: "memory");
        } else {
            XB_SPIN(xb_ld(&bar[XB_XGEN(bx)]) == gen, bar);
            __builtin_amdgcn_fence(__ATOMIC_ACQUIRE, "agent");
            asm volatile("s_waitcnt vmcnt(0)" ::: "memory");
        }
    }
    __syncthreads();
}

namespace pg8 {
constexpr int BM = 256, BK = 64, HALF = 128, HTB = HALF * BK * 2, STAGE_BYTES = 8 * HTB, NXCD = 8, WGM = 8;
__host__ __device__ __forceinline__ int lds_byte(int r, int c) { const int st = (r >> 4) * 2 + (c >> 5), rr = r & 15, cc = c & 31, ob = rr * 64 + cc * 2; return st * 1024 + (ob ^ (((ob >> 9) & 1) << 5)); }
__host__ __device__ __forceinline__ void stage_rc(int b, int& R, int& C) { const int st = b / 1024, sb = b % 1024, swz = sb ^ (((sb >> 9) & 1) << 5); R = (st >> 1) * 16 + swz / 64; C = (st & 1) * 32 + (swz % 64) / 2; }
__host__ __device__ __forceinline__ int perm32(int rho) { const int n = rho >> 4, i = rho & 15; return 8 * (i >> 2) + 4 * n + (i & 3); }

struct Unit { int pm, pn; };
struct Gemm { const bf16_t* A; const bf16_t* Bt; };

template <int M, int N> struct StaticOrder {
    static constexpr int nM = M / BM, nN = N / BM, nwg = nM * nN;
    int G, c;
    __host__ __device__ void init(int G_, int c_) { G = G_; c = c_; }
    __host__ __device__ bool next(int i, Unit& u) const {
        const long L = (long)i * G + c; if (L >= nwg) return false;
        int wgid = (int)L; { constexpr int q = nwg / NXCD, r = nwg % NXCD; const int xcd = wgid % NXCD, off = wgid / NXCD; wgid = (xcd < r ? xcd * (q + 1) : r * (q + 1) + (xcd - r) * q) + off; }
        constexpr int nig = WGM * nN; const int gid = wgid / nig, fm = gid * WGM, gsz = (nM - fm) < WGM ? (nM - fm) : WGM;
        u.pm = fm + ((wgid % nig) % gsz); u.pn = (wgid % nig) / gsz; return true;
    }
};

template <class F, int FENCE = 0> struct EpiGen {
    static constexpr bool PERM = true, HAS_MID = false, FUSED = false;
    F f;
    __device__ __forceinline__ void operator()(const f32x4 (&acc)[2][2][4][2], const Unit& u, int wr, int wc, int fr, int fq) const {
        const int row0 = u.pm * BM + wr * 64 + fr, col0 = u.pn * BM + wc * 32 + 8 * fq;
#pragma unroll
        for (int ai = 0; ai < 2; ++ai)
#pragma unroll
            for (int m = 0; m < 4; ++m)
#pragma unroll
                for (int bj = 0; bj < 2; ++bj) { f(row0 + ai * HALF + m * 16, col0 + bj * HALF, acc[ai][bj][m][0], acc[ai][bj][m][1]);
                    if constexpr (FENCE > 0) { if (((ai * 4 + m) * 2 + bj) % FENCE == FENCE - 1) asm volatile("" ::: "memory"); } }
    }
};

template <int M, int N, int K, int LDA, int LDB, class Epi, bool ALIGN_EPI = true>
__device__ __forceinline__ void gemm_phase(LAS unsigned char* lds, const Gemm g, const StaticOrder<M, N>& S, const Epi& E, int tid_in) {
    int tid = tid_in; asm volatile("" : "+v"(tid));
    const int wid = __builtin_amdgcn_readfirstlane(tid >> 6), lane = tid & 63, wr = wid >> 2, wc = wid & 3, fr = lane & 15, fq = lane >> 4;
    constexpr int nt = K / BK;
    unsigned voffA[2], voffB[2];
#pragma unroll
    for (int i = 0; i < 2; ++i) { int R, C; stage_rc(tid * 16 + i * 8192, R, C); const int Rb = Epi::PERM ? ((R & ~31) + perm32(R & 31)) : R;
        voffA[i] = (unsigned)(R * LDA + C) * 2u; voffB[i] = (unsigned)(Rb * LDB + C) * 2u; }
    constexpr size_t kstep = (size_t)(BK * 2);
    constexpr size_t hstepA = (size_t)HALF * LDA * 2, hstepB = (size_t)HALF * LDB * 2;
    constexpr size_t tstepA = 2 * hstepA, tstepB = 2 * hstepB;
    const unsigned ldsw = (unsigned)wid * 1024u;
    const int aoff = lds_byte(wr * 64 + fr, fq * 8), boff = lds_byte(wc * 32 + fr, fq * 8);
#define PG8_SA(b, h) (((b) * 2 + (h)) * HTB)
#define PG8_SB(b, h) ((4 + (b) * 2 + (h)) * HTB)
#define PG8_STAGE(bufoff, gbase, voff) do { _Pragma("unroll") for (int _i = 0; _i < 2; ++_i) \
        __builtin_amdgcn_global_load_lds((const unsigned*)((const char*)(gbase) + (voff)[_i]), (LAS unsigned*)(lds + (bufoff) + ldsw + _i * 8192), 16, 0, 0); } while (0)
#define PG8_LDA(dst, b, h) do { _Pragma("unroll") for (int m = 0; m < 4; ++m) _Pragma("unroll") for (int k = 0; k < 2; ++k) dst[m][k] = *(const LAS bf16x8*)(lds + PG8_SA(b, h) + aoff + m * 2048 + k * 1024); } while (0)
#define PG8_LDB(dst, b, h) do { _Pragma("unroll") for (int n = 0; n < 2; ++n) _Pragma("unroll") for (int k = 0; k < 2; ++k) dst[n][k] = *(const LAS bf16x8*)(lds + PG8_SB(b, h) + boff + n * 2048 + k * 1024); } while (0)
#define PG8_MMA(ai, bj, At, Bt) do { __builtin_amdgcn_s_setprio(1); _Pragma("unroll") for (int m = 0; m < 4; ++m) _Pragma("unroll") for (int n = 0; n < 2; ++n) _Pragma("unroll") for (int k = 0; k < 2; ++k) \
        acc[ai][bj][m][n] = __builtin_amdgcn_mfma_f32_16x16x32_bf16(Bt[n][k], At[m][k], acc[ai][bj][m][n], 0, 0, 0); __builtin_amdgcn_s_setprio(0); } while (0)
#define PG8_WAIT_V(n) asm volatile("s_waitcnt vmcnt(" #n ")" ::: "memory")
#define PG8_WAIT_L(n) asm volatile("s_waitcnt lgkmcnt(" #n ")" ::: "memory")
#define PG8_BAR __builtin_amdgcn_s_barrier()
#define PG8_SCHED __builtin_amdgcn_sched_barrier(0)
    Unit cur, nxt; int ui = 0;
    if (!S.next(0, cur)) return;
    f32x4 acc[2][2][4][2];
#pragma unroll
    for (int a = 0; a < 2; ++a)
#pragma unroll
        for (int b = 0; b < 2; ++b)
#pragma unroll
            for (int m = 0; m < 4; ++m)
#pragma unroll
                for (int n = 0; n < 2; ++n) acc[a][b][m][n] = (f32x4){0.f, 0.f, 0.f, 0.f};
    bf16x8 At[4][2], B0[2][2], B1[2][2];
    const char* cA = (const char*)g.A + (size_t)cur.pm * tstepA; const char* cB = (const char*)g.Bt + (size_t)cur.pn * tstepB;
    PG8_STAGE(PG8_SB(0, 0), cB, voffB); PG8_STAGE(PG8_SB(0, 1), cB + hstepB, voffB); PG8_STAGE(PG8_SA(0, 0), cA, voffA); PG8_STAGE(PG8_SA(0, 1), cA + hstepA, voffA);
    if (wr == 1) PG8_BAR;
    PG8_WAIT_V(2); PG8_BAR;
    PG8_STAGE(PG8_SB(1, 0), cB + kstep, voffB); PG8_STAGE(PG8_SA(1, 0), cA + kstep, voffA); PG8_STAGE(PG8_SB(1, 1), cB + hstepB + kstep, voffB);
    PG8_WAIT_V(6); PG8_BAR;
    for (;;) {
        const bool has_next = S.next(ui + 1, nxt);
        const char* nA = has_next ? (const char*)g.A + (size_t)nxt.pm * tstepA : cA; const char* nB = has_next ? (const char*)g.Bt + (size_t)nxt.pn * tstepB : cB;
#pragma unroll 1
        for (int t = 0; t < nt; t += 2) {
            const bool last = (t == nt - 2);
            const char* a1 = cA + (size_t)(t + 1) * kstep;
            const char* a2 = last ? nA : cA + (size_t)(t + 2) * kstep; const char* b2 = last ? nB : cB + (size_t)(t + 2) * kstep;
            const char* a3 = a2 + kstep; const char* b3 = b2 + kstep;
            if constexpr (Epi::HAS_MID) { if (t == Epi::MID0 || t == Epi::MID1) E.mid(acc, cur, t, wr, wc, fr, fq); }
            PG8_LDB(B0, 0, 0); PG8_LDB(B1, 0, 1); PG8_SCHED; PG8_LDA(At, 0, 0); PG8_STAGE(PG8_SA(1, 1), a1 + hstepA, voffA);
            PG8_WAIT_V(8); PG8_WAIT_L(0); PG8_BAR; PG8_MMA(0, 0, At, B0); PG8_MMA(0, 1, At, B1); PG8_BAR; PG8_SCHED;
            PG8_LDA(At, 0, 1); PG8_STAGE(PG8_SB(0, 0), b2, voffB); PG8_STAGE(PG8_SB(0, 1), b2 + hstepB, voffB); PG8_STAGE(PG8_SA(0, 0), a2, voffA);
            PG8_WAIT_V(8); PG8_WAIT_L(0); PG8_BAR; PG8_MMA(1, 0, At, B0); PG8_MMA(1, 1, At, B1); PG8_BAR; PG8_SCHED;
            PG8_LDB(B0, 1, 0); PG8_LDB(B1, 1, 1); PG8_SCHED; PG8_LDA(At, 1, 0); PG8_STAGE(PG8_SA(0, 1), a2 + hstepA, voffA);
            PG8_WAIT_V(8); PG8_WAIT_L(0); PG8_BAR; PG8_MMA(0, 0, At, B0); PG8_MMA(0, 1, At, B1); PG8_BAR; PG8_SCHED;
            PG8_LDA(At, 1, 1); PG8_STAGE(PG8_SB(1, 0), b3, voffB); PG8_STAGE(PG8_SB(1, 1), b3 + hstepB, voffB); PG8_STAGE(PG8_SA(1, 0), a3, voffA);
            PG8_WAIT_V(8); PG8_WAIT_L(0); PG8_BAR; PG8_MMA(1, 0, At, B0); PG8_MMA(1, 1, At, B1); PG8_BAR; PG8_SCHED;
        }
        if constexpr (ALIGN_EPI) { if (wr == 0) PG8_BAR; }
        if constexpr (Epi::FUSED) E.fused(acc, cur, wr, wc, fr, fq, lds, wid, lane); else E(acc, cur, wr, wc, fr, fq);
        if (!has_next) break;
#pragma unroll
        for (int a = 0; a < 2; ++a)
#pragma unroll
            for (int b = 0; b < 2; ++b)
#pragma unroll
                for (int m = 0; m < 4; ++m)
#pragma unroll
                    for (int n = 0; n < 2; ++n) acc[a][b][m][n] = (f32x4){0.f, 0.f, 0.f, 0.f};
        cur = nxt; cA = nA; cB = nB; ++ui;
        if constexpr (ALIGN_EPI) { if (wr == 1) PG8_BAR; }
    }
    PG8_WAIT_V(0);
    if constexpr (!ALIGN_EPI) { if (wr == 0) PG8_BAR; }
    PG8_BAR;
#undef PG8_SA
#undef PG8_SB
#undef PG8_STAGE
#undef PG8_LDA
#undef PG8_LDB
#undef PG8_MMA
#undef PG8_WAIT_V
#undef PG8_WAIT_L
#undef PG8_BAR
#undef PG8_SCHED
}
}

constexpr int NWAVES = 8, NTHREADS = 512;
struct Args { const void* in[23]; float* out; unsigned char* ws; int ph_lo, ph_hi; };
struct Frame {
    LAS unsigned char* lds;
    int tid, lane, wave, G, bid;
    unsigned char* wsb; unsigned zo; unsigned wl;
    __device__ __forceinline__ bf16_t* IKD() const { return (bf16_t*)(wsb + zo + WS_IKD); }
    __device__ __forceinline__ float* XB() const { return (float*)(wsb + zo + WS_XB); }
    __device__ __forceinline__ unsigned* PANEL(int bank) const { return (unsigned*)(wsb + zo + WS_CTL) + CW_PANEL + bank * 8192; }
    __device__ __forceinline__ float* IW() const { return (float*)(wsb + zo + WS_IW); }
    __device__ __forceinline__ float* SP(int l) const { return (float*)(wsb + zo + WS_SP) + l * 36864; }
    __device__ __forceinline__ f32x2* ROPE() const { return (f32x2*)(wsb + zo + WS_ROPE); }
    __device__ __forceinline__ f32x2* S5E() const { return (f32x2*)(wsb + zo + WS_S5E); }
    __device__ __forceinline__ float* RST() const { return (float*)(wsb + zo + WS_RST); }
    __device__ __forceinline__ bf16_t* Win_t() const { return (bf16_t*)(wsb + zo + wl + WS_W + WO_IN); }
    __device__ __forceinline__ bf16_t* Wabc_t() const { return (bf16_t*)(wsb + zo + wl + WS_W + WO_ABC); }
    __device__ __forceinline__ bf16_t* Wout_t() const { return (bf16_t*)(wsb + zo + wl + WS_W + WO_OUT); }
    __device__ __forceinline__ bf16_t* W1_t() const { return (bf16_t*)(wsb + zo + wl + WS_W + WO_W1); }
    __device__ __forceinline__ bf16_t* W2_t() const { return (bf16_t*)(wsb + zo + wl + WS_W + WO_W2); }
    __device__ __forceinline__ bf16_t* Wglu_t() const { return (bf16_t*)(wsb + zo + wl + WS_W + WO_GLU); }
    __device__ __forceinline__ bf16_t* H() const { return (bf16_t*)(wsb + zo + WS_H); }
    __device__ __forceinline__ bf16_t* ZS() const { return (bf16_t*)(wsb + zo + WS_ZS); }
    __device__ __forceinline__ unsigned char* GB() const { return wsb + zo + WS_G; }
    __device__ __forceinline__ bf16_t* MG() const { return (bf16_t*)(wsb + zo + WS_ZS); }
    __device__ __forceinline__ bf16_t* FB() const { return (bf16_t*)(wsb + zo + WS_ZS); }
};
constexpr int SP_LB = 0, SP_L64 = 2048, SP_BBR = 4096, SP_BBI = 4096 + 16384;

__device__ __forceinline__ int ropeperm(int j, int r) { const int half = r >> 1; return (j < r) ? ((j & 1) ? half + (j >> 1) : (j >> 1)) : j; }
__device__ __forceinline__ int zmap(int n) {
    if (n < ZDQ) return n;
    if (n < ZDK) { const int q = n - ZDQ, h = q >> 6, hc = q & 63; return 256 + h * 64 + ropeperm(hc, 16); }
    if (n < ZDV) return 640 + ropeperm(n - ZDK, 16);
    if (n < ZIQ) return 704 + (n - ZDV);
    if (n < ZIK) { const int q = n - ZIQ, h = q >> 5, hc = q & 31; return 768 + h * 32 + ropeperm(hc, 8); }
    if (n < ZIWC) return 896 + ropeperm(n - ZIK, 8);
    if (n < ZRQ) return (n - ZIWC) < 4 ? 928 + (n - ZIWC) : -1;
    if (n < ZRK) { const int q = n - ZRQ, h = q / 48, hc = q % 48; return 932 + h * 48 + ropeperm(hc, 48); }
    if (n < ZRV) { const int q = n - ZRK, h = q / 48, hc = q % 48; return 1124 + h * 48 + ropeperm(hc, 48); }
    if (n < ZRG) return 1316 + (n - ZRV);
    if (n < ZGATE) return 1700 + (n - ZRG);
    if (n < ZEND) return 2084 + (n - ZGATE);
    return -1;
}

__device__ __forceinline__ void tr_item(const float* W, int N, int kb, int nb, bf16_t* WT, int ldd, int koff, bool mapped, LAS float* scr, int lane) {
    const int k0 = 64 * kb, n0 = 32 * nb;
    const int c32 = lane & 31; int sc = n0 + c32; if (mapped) sc = zmap(sc);
#pragma unroll 8
    for (int i = 0; i < 32; ++i) { const int kk = 2 * i + (lane >> 5); scr[kk * 33 + c32] = (sc >= 0) ? W[(size_t)(k0 + kk) * N + sc] : 0.f; }
    asm volatile("s_waitcnt lgkmcnt(0)" ::: "memory");
    const int c = lane & 7;
#pragma unroll
    for (int j = 0; j < 4; ++j) { const int n = (lane >> 3) + 8 * j; const LAS float* s = scr + (8 * c) * 33 + n;
        u32x4 o; o.x = pk2(s[0 * 33], s[1 * 33]); o.y = pk2(s[2 * 33], s[3 * 33]); o.z = pk2(s[4 * 33], s[5 * 33]); o.w = pk2(s[6 * 33], s[7 * 33]);
        *(u32x4*)(WT + (size_t)(n0 + n) * ldd + koff + k0 + 8 * c) = o; }
    asm volatile("s_waitcnt lgkmcnt(0)" ::: "memory");
}

__device__ __forceinline__ void rms_row_bf16(const float* xrow, const float* gain, bf16_t* orow, int lane) {
    const f32x4* xr = (const f32x4*)xrow + lane; const f32x4* gr = (const f32x4*)gain + lane;
    f32x4 v[4]; float s = 0.f;
#pragma unroll
    for (int j = 0; j < 4; ++j) { v[j] = xr[64 * j]; s += (v[j].x * v[j].x + v[j].y * v[j].y) + (v[j].z * v[j].z + v[j].w * v[j].w); }
    const float rstd = rsqrtf(wave_sum(s) * (1.f / DM) + EPS);
    u32x2* o8 = (u32x2*)orow + lane;
#pragma unroll
    for (int j = 0; j < 4; ++j) { const f32x4 gg = gr[64 * j]; u32x2 w; w.x = pk2(v[j].x * rstd * gg.x, v[j].y * rstd * gg.y); w.y = pk2(v[j].z * rstd * gg.z, v[j].w * rstd * gg.w); o8[64 * j] = w; }
}
__device__ __forceinline__ void rms_row_f32(const float* xrow, const float* gain, float* orow, int lane) {
    const f32x4* xr = (const f32x4*)xrow + lane; const f32x4* gr = (const f32x4*)gain + lane;
    f32x4 v[4]; float s = 0.f;
#pragma unroll
    for (int j = 0; j < 4; ++j) { v[j] = xr[64 * j]; s += (v[j].x * v[j].x + v[j].y * v[j].y) + (v[j].z * v[j].z + v[j].w * v[j].w); }
    const float rstd = rsqrtf(wave_sum(s) * (1.f / DM) + EPS);
    f32x4* o = (f32x4*)orow + lane;
#pragma unroll
    for (int j = 0; j < 4; ++j) { const f32x4 gg = gr[64 * j]; o[64 * j] = v[j] * rstd * gg; }
}


__device__ __forceinline__ void phase_rope(Frame& F, const int* pos) {
    const int gt = F.bid * NTHREADS + F.tid, NT = F.G * NTHREADS;
    f32x2* RT = F.ROPE();
    for (int e = gt; e < T * NFREQ; e += NT) {
        const int tok = e / NFREQ, f = e % NFREQ;
        float lth, sc; int fi;
        if (f < 8) { lth = 13.122363377404328f; sc = 2.0f / 16.0f; fi = f; } else if (f < 12) { lth = 13.122363377404328f; sc = 2.0f / 8.0f; fi = f - 8; } else { lth = 9.210340371976184f; sc = 2.0f / 48.0f; fi = f - 12; }
        const float inv = expf(-lth * (float)fi * sc);
        const float p = (float)pos[tok];
        const float ang = p * inv;
        const float kq = rintf(ang * 0.15915494309189535f);
        float r = fmaf(-kq, 6.2831854820251465f, ang);
        r = fmaf(-kq, -1.7484555e-7f, r);
        RT[e] = (f32x2){cosf(r), sinf(r)};
    }
}

struct ProIn { const float *xin, *norm1_g, *w_in, *wa, *wb, *wc, *wo, *w1, *w2, *wg, *lam_re, *lam_im, *log_step, *b_re, *b_im; const int* pos; };
__device__ __forceinline__ void phase_prologue(Frame& F, const ProIn& I) {
#ifdef NO_PHASE_PROLOGUE
    return;
#endif
    LAS float* scr = (LAS float*)(F.lds + F.wave * 16384);
    const int gw = F.bid * NWAVES + F.wave, NGW = F.G * NWAVES;
#pragma unroll 1
    for (int l = 0; l < DEPTH; ++l) {
    F.wl = l ? (unsigned)(WS_W1L - WS_W) : 0u;
    constexpr int I_IN = 16 * (NINP / 32), I_A = 4 * 32, I_B = 6 * 32, I_C = 6 * 32, I_O = 16 * 32, I_1 = 16 * 128, I_2 = 64 * 32, I_G = 4 * 8;
    constexpr int NITEMS = I_IN + I_A + I_B + I_C + I_O + I_1 + I_2 + I_G;
    const float* w_in = I.w_in + (size_t)l * DM * NIN; const float* wa = I.wa + (size_t)l * 256 * DM; const float* wb = I.wb + (size_t)l * 384 * DM;
    const float* wc = I.wc + (size_t)l * 384 * DM; const float* wo = I.wo + (size_t)l * DM * DM; const float* w1 = I.w1 + (size_t)l * DM * FF;
    const float* w2 = I.w2 + (size_t)l * FF * DM; const float* wg = I.wg + (size_t)l * 256 * 256;
    for (int it = gw; it < NITEMS; it += NGW) {
        int r = it;
        if (r < I_IN) { tr_item(w_in, NIN, r / (NINP / 32), r % (NINP / 32), F.Win_t(), DM, 0, true, scr, F.lane); continue; } r -= I_IN;
        if (r < I_A) { tr_item(wa, DM, r / 32, r % 32, F.Wabc_t(), DM, 0, false, scr, F.lane); continue; } r -= I_A;
        if (r < I_B) { tr_item(wb, DM, r / 32, r % 32, F.Wabc_t(), DM, 256, false, scr, F.lane); continue; } r -= I_B;
        if (r < I_C) { tr_item(wc, DM, r / 32, r % 32, F.Wabc_t(), DM, 640, false, scr, F.lane); continue; } r -= I_C;
        if (r < I_O) { tr_item(wo, DM, r / 32, r % 32, F.Wout_t(), DM, 0, false, scr, F.lane); continue; } r -= I_O;
        if (r < I_1) { tr_item(w1, FF, r / 128, r % 128, F.W1_t(), DM, 0, false, scr, F.lane); continue; } r -= I_1;
        if (r < I_2) { tr_item(w2, DM, r / 32, r % 32, F.W2_t(), FF, 0, false, scr, F.lane); continue; } r -= I_2;
        tr_item(wg, 256, r / 8, r % 8, F.Wglu_t(), 256, 0, false, scr, F.lane);
    }
    {
        const int gt = F.bid * NTHREADS + F.tid;
        if (gt < 1024) {
            float* SPp = F.SP(l);
            const int g = gt >> 6, p = gt & 63;
            const float lr = I.lam_re[(l * 16 + g) * 64 + p], li = I.lam_im[(l * 16 + g) * 64 + p];
            const float step = expf(I.log_step[l * 16 + g]);
            const float mag = expf(lr * step); const float lbr = mag * cosf(li * step), lbi = mag * sinf(li * step);
            const float den = lr * lr + li * li;
            const float fr = ((lbr - 1.f) * lr + lbi * li) / den, fi = (lbi * lr - (lbr - 1.f) * li) / den;
            SPp[SP_LB + gt * 2] = lbr; SPp[SP_LB + gt * 2 + 1] = lbi;
            float pr = lbr, pi = lbi;
#pragma unroll
            for (int s = 0; s < 6; ++s) { const float nr = pr * pr - pi * pi, ni = 2.f * pr * pi; pr = nr; pi = ni; }
            SPp[SP_L64 + gt * 2] = pr; SPp[SP_L64 + gt * 2 + 1] = pi;
            const float* br = I.b_re + ((size_t)(l * 16 + g) * 64 + p) * 16; const float* bi = I.b_im + ((size_t)(l * 16 + g) * 64 + p) * 16;
#pragma unroll
            for (int c = 0; c < 16; ++c) { SPp[SP_BBR + gt * 16 + c] = fr * br[c] - fi * bi[c]; SPp[SP_BBI + gt * 16 + c] = fr * bi[c] + fi * br[c]; }
        }
    }
    }
    F.wl = 0u;
    for (int m = gw; m < T; m += NGW) rms_row_bf16(I.xin + (size_t)m * DM, I.norm1_g, F.H() + (size_t)m * DM, F.lane);
}

__device__ __forceinline__ u32x4 pack8(const f32x4& a, const f32x4& b) { u32x4 w; w.x = pk2(a.x, a.y); w.y = pk2(a.z, a.w); w.z = pk2(b.x, b.y); w.w = pk2(b.z, b.w); return w; }
__device__ __forceinline__ void unpack8(const u32x4& w, f32x4& a, f32x4& b) { a = (f32x4){bflo(w.x), bfhi(w.x), bflo(w.y), bfhi(w.y)}; b = (f32x4){bflo(w.z), bfhi(w.z), bflo(w.w), bfhi(w.w)}; }

__device__ __forceinline__ unsigned gate1_u8(float x) { const float s = 255.f * sigmoidf_(x) + 0.5f; const unsigned u = (unsigned)s; return u < 1u ? 1u : u; }
__device__ __forceinline__ unsigned gate4_u8(const f32x4& a) { return gate1_u8(a.x) | (gate1_u8(a.y) << 8) | (gate1_u8(a.z) << 16) | (gate1_u8(a.w) << 24); }
__device__ __forceinline__ void ungate8(const u32x2& w, f32x4& a, f32x4& b) {
    a = (f32x4){(float)(w.x & 255u), (float)((w.x >> 8) & 255u), (float)((w.x >> 16) & 255u), (float)(w.x >> 24)};
    b = (f32x4){(float)(w.y & 255u), (float)((w.y >> 8) & 255u), (float)((w.y >> 16) & 255u), (float)(w.y >> 24)};
}
struct FInProj {
    bf16_t* ZS; unsigned char* GB; float* IW; const f32x2* ROPE; bf16_t* IKD;
    __device__ __forceinline__ void rope8(f32x4& a, f32x4& b, int row, int f0) const {
        const f32x2* rt = ROPE + (size_t)row * NFREQ + f0;
        const f32x2 c0 = rt[0], c1 = rt[1], c2 = rt[2], c3 = rt[3];
        f32x4 oa, ob;
        oa.x = a.x * c0.x - a.y * c0.y; oa.y = a.y * c0.x + a.x * c0.y;
        oa.z = a.z * c1.x - a.w * c1.y; oa.w = a.w * c1.x + a.z * c1.y;
        ob.x = b.x * c2.x - b.y * c2.y; ob.y = b.y * c2.x + b.x * c2.y;
        ob.z = b.z * c3.x - b.w * c3.y; ob.w = b.w * c3.x + b.z * c3.y;
        a = oa; b = ob;
    }
    __device__ __forceinline__ void operator()(int row, int col, f32x4 a, f32x4 b) const {
        if (col >= ZEND) return;
        if (col >= ZGATE) {
            *(u32x2*)(GB + (size_t)row * GW + (col - ZGATE)) = (u32x2){gate4_u8(a), gate4_u8(b)}; return;
        }
        if (col >= ZIWC && col < ZRQ) { if (col == ZIWC) *(f32x4*)(IW + (size_t)row * 4) = a; return; }
        if (col >= ZDQ && col < ZDV) { const int hc = (col - ZDQ) & 63; if (hc < 16) rope8(a, b, row, hc >> 1); }
        else if (col >= ZIQ && col < ZIWC) { const int hc = (col - ZIQ) & 31; if (hc < 8) rope8(a, b, row, 8);
            if (col >= ZIK) { *(u32x4*)(IKD + ((size_t)((row >> 5) * 4 + ((col - ZIK) >> 3)) * 32 + (row & 31)) * 8) = pack8(a, b); return; } }
        else if (col >= ZRQ && col < ZRV) { const int hc = (col - ZRQ) % 48; rope8(a, b, row, 12 + (hc >> 1)); }
        *(u32x4*)(ZS + (size_t)row * ZSW + col) = pack8(a, b);
    }
};
struct FMerge {
    bf16_t* MG; const bf16_t* GB; int br;
    __device__ __forceinline__ void operator()(int row, int col, f32x4 a, f32x4 b) const {
        f32x4 ga, gb; unpack8(*(const u32x4*)(GB + (size_t)row * GW + br * DM + col), ga, gb);
        a = a * ga; b = b * gb;
        u32x4* mp = (u32x4*)(MG + (size_t)row * DM + col);
        if (br != 0) { f32x4 pa, pb; unpack8(*mp, pa, pb); a = a + pa; b = b + pb; }
        *mp = pack8(a, b);
    }
};
struct FResid {
    const float* base; float* out;
    __device__ __forceinline__ void operator()(int row, int col, f32x4 a, f32x4 b) const {
        const f32x4* bp = (const f32x4*)(base + (size_t)row * DM + col); f32x4* op = (f32x4*)(out + (size_t)row * DM + col);
        const f32x4 b0 = bp[0], b1 = bp[1]; op[0] = b0 + a; op[1] = b1 + b;
    }
};
struct FRelu2 {
    bf16_t* FB;
    __device__ __forceinline__ void operator()(int row, int col, f32x4 a, f32x4 b) const {
        a = (f32x4){fmaxf(a.x, 0.f), fmaxf(a.y, 0.f), fmaxf(a.z, 0.f), fmaxf(a.w, 0.f)}; b = (f32x4){fmaxf(b.x, 0.f), fmaxf(b.y, 0.f), fmaxf(b.z, 0.f), fmaxf(b.w, 0.f)};
        *(u32x4*)(FB + (size_t)row * FF + col) = pack8(a * a, b * b);
    }
};
struct FGlu {
    bf16_t* H; const float* bias;
    __device__ __forceinline__ void operator()(int row, int col, f32x4 a, f32x4 b) const {
        u32x4* hp = (u32x4*)(H + (size_t)row * DM + col); f32x4 ya, yb; unpack8(*hp, ya, yb);
        const f32x4 ba = *(const f32x4*)(bias + col), bb = *(const f32x4*)(bias + col + 4);
        a = a + ba; b = b + bb;
        a = (f32x4){ya.x * sigmoidf_(a.x), ya.y * sigmoidf_(a.y), ya.z * sigmoidf_(a.z), ya.w * sigmoidf_(a.w)};
        b = (f32x4){yb.x * sigmoidf_(b.x), yb.y * sigmoidf_(b.y), yb.z * sigmoidf_(b.z), yb.w * sigmoidf_(b.w)};
        *hp = pack8(a, b);
    }
};

struct EpiMerge {
    static constexpr bool PERM = true, HAS_MID = true, FUSED = false; static constexpr int MID0 = 4, MID1 = 10;
    bf16_t* MG; const unsigned char* GB;
    __device__ __forceinline__ void mid(f32x4 (&acc)[2][2][4][2], const pg8::Unit& u, int t, int wr, int wc, int fr, int fq) const {
        int zz = 0; asm volatile("" : "+v"(zz));
        const int row0 = u.pm * 256 + wr * 64 + fr + zz, col0 = u.pn * 256 + wc * 32 + 8 * fq, bp = (t == MID0) ? 0 : 1;
#pragma unroll
        for (int ai = 0; ai < 2; ++ai)
#pragma unroll
            for (int m = 0; m < 4; ++m) {
#pragma unroll
                for (int bj = 0; bj < 2; ++bj) {
                    const unsigned char* gp = GB + (size_t)(row0 + ai * 128 + m * 16) * GW + bp * DM + col0 + bj * 128;
                    f32x4 pa, pb, na, nb; ungate8(*(const u32x2*)gp, pa, pb); ungate8(*(const u32x2*)(gp + DM), na, nb);
                    const f32x4 fa = {pa.x * __builtin_amdgcn_rcpf(na.x), pa.y * __builtin_amdgcn_rcpf(na.y), pa.z * __builtin_amdgcn_rcpf(na.z), pa.w * __builtin_amdgcn_rcpf(na.w)};
                    const f32x4 fb = {pb.x * __builtin_amdgcn_rcpf(nb.x), pb.y * __builtin_amdgcn_rcpf(nb.y), pb.z * __builtin_amdgcn_rcpf(nb.z), pb.w * __builtin_amdgcn_rcpf(nb.w)};
                    acc[ai][bj][m][0] = acc[ai][bj][m][0] * fa; acc[ai][bj][m][1] = acc[ai][bj][m][1] * fb;
                }
                if (m == 3) asm volatile("" ::: "memory");
            }
    }
    __device__ __forceinline__ void operator()(const f32x4 (&acc)[2][2][4][2], const pg8::Unit& u, int wr, int wc, int fr, int fq) const {
        const int row0 = u.pm * 256 + wr * 64 + fr, col0 = u.pn * 256 + wc * 32 + 8 * fq;
#pragma unroll
        for (int ai = 0; ai < 2; ++ai)
#pragma unroll
            for (int m = 0; m < 4; ++m)
#pragma unroll
                for (int bj = 0; bj < 2; ++bj) {
                    const int row = row0 + ai * 128 + m * 16, col = col0 + bj * 128;
                    f32x4 ga, gb; ungate8(*(const u32x2*)(GB + (size_t)row * GW + 2 * DM + col), ga, gb);
                    *(u32x4*)(MG + (size_t)row * DM + col) = pack8(acc[ai][bj][m][0] * (ga * (1.f / 255.f)), acc[ai][bj][m][1] * (gb * (1.f / 255.f)));
                }
    }
};

struct EpiResidNorm {
    static constexpr bool PERM = true, HAS_MID = false, FUSED = true;
    const float* base; float* XOUT; bf16_t* HN; float* NOUT; const float* gain; float* xbuf; unsigned* cnt;
    __device__ __forceinline__ void fused(f32x4 (&acc)[2][2][4][2], const pg8::Unit& u, int wr, int wc, int fr, int fq, LAS unsigned char* lds, int wid, int lane) const {
        LAS float* P = (LAS float*)(lds + 131072);
        LAS float* S = (LAS float*)(lds + 131072 + 4096);
        LAS unsigned* flag = (LAS unsigned*)(lds + 131072 + 5120);
        int zz = 0; asm volatile("" : "+v"(zz));
        const int rl0 = wr * 64 + fr + zz, row0 = u.pm * 256 + rl0, col0 = u.pn * 256 + wc * 32 + 8 * fq;
#pragma unroll
        for (int ai = 0; ai < 2; ++ai) {
#pragma unroll
            for (int m = 0; m < 4; ++m) {
                float ss = 0.f;
#pragma unroll
                for (int bj = 0; bj < 2; ++bj) {
                    const size_t off = (size_t)(row0 + ai * 128 + m * 16) * DM + col0 + bj * 128;
                    const f32x4 x0 = *(const f32x4*)(base + off) + acc[ai][bj][m][0], x1 = *(const f32x4*)(base + off + 4) + acc[ai][bj][m][1];
                    acc[ai][bj][m][0] = x0; acc[ai][bj][m][1] = x1;
                    if (XOUT) { *(f32x4*)(XOUT + off) = x0; *(f32x4*)(XOUT + off + 4) = x1; }
                    ss += (x0.x * x0.x + x0.y * x0.y) + (x0.z * x0.z + x0.w * x0.w) + (x1.x * x1.x + x1.y * x1.y) + (x1.z * x1.z + x1.w * x1.w);
                }
                ss += __shfl_xor(ss, 16); ss += __shfl_xor(ss, 32);
                if (fq == 0) P[(rl0 + ai * 128 + m * 16) * 4 + wc] = ss;
            }
            asm volatile("" ::: "memory");
        }
        asm volatile("s_waitcnt lgkmcnt(0)" ::: "memory"); __builtin_amdgcn_s_barrier(); asm volatile("" ::: "memory");
        const int rowt = wid * 64 + lane;
        if (wid < 4) {
            const f32x4 p = *(const LAS f32x4*)(P + rowt * 4);
            __hip_atomic_store(xbuf + (size_t)(u.pm * 256 + rowt) * 4 + u.pn, (p.x + p.y) + (p.z + p.w), __ATOMIC_RELAXED, __HIP_MEMORY_SCOPE_AGENT);
        }
        asm volatile("s_waitcnt vmcnt(0)" ::: "memory");
        if (lane == 0) __hip_atomic_fetch_add(cnt + 64 * u.pm, 1u, __ATOMIC_RELAXED, __HIP_MEMORY_SCOPE_AGENT);
        if (wid == 0) {
            unsigned sp = 0u;
            for (;;) {
                if ((unsigned)__builtin_amdgcn_readfirstlane(__hip_atomic_load(cnt + 64 * u.pm, __ATOMIC_RELAXED, __HIP_MEMORY_SCOPE_AGENT)) >= 32u) break;
                __builtin_amdgcn_s_sleep(2);
                if (++sp > (1u << 20)) break;
            }
            __builtin_amdgcn_fence(__ATOMIC_ACQUIRE, "agent");
            if (lane == 0) flag[0] = 1u;
        }
        asm volatile("s_waitcnt vmcnt(0) lgkmcnt(0)" ::: "memory"); __builtin_amdgcn_s_barrier(); asm volatile("" ::: "memory");
        if (wid < 4) {
            const float* sl = xbuf + (size_t)(u.pm * 256 + rowt) * 4;
            const float s = (__hip_atomic_load(sl, __ATOMIC_RELAXED, __HIP_MEMORY_SCOPE_AGENT) + __hip_atomic_load(sl + 1, __ATOMIC_RELAXED, __HIP_MEMORY_SCOPE_AGENT))
                          + (__hip_atomic_load(sl + 2, __ATOMIC_RELAXED, __HIP_MEMORY_SCOPE_AGENT) + __hip_atomic_load(sl + 3, __ATOMIC_RELAXED, __HIP_MEMORY_SCOPE_AGENT));
            S[rowt] = rsqrtf(s * (1.f / DM) + EPS);
        }
        asm volatile("s_waitcnt vmcnt(0) lgkmcnt(0)" ::: "memory"); __builtin_amdgcn_s_barrier(); asm volatile("" ::: "memory");
#pragma unroll
        for (int bj = 0; bj < 2; ++bj) {
            const f32x4 g0 = *(const f32x4*)(gain + col0 + bj * 128), g1 = *(const f32x4*)(gain + col0 + bj * 128 + 4);
#pragma unroll
            for (int ai = 0; ai < 2; ++ai)
#pragma unroll
                for (int m = 0; m < 4; ++m) {
                    const float rs = S[rl0 + ai * 128 + m * 16];
                    const size_t off = (size_t)(row0 + ai * 128 + m * 16) * DM + col0 + bj * 128;
                    const f32x4 y0 = acc[ai][bj][m][0] * rs * g0, y1 = acc[ai][bj][m][1] * rs * g1;
                    if (HN) *(u32x4*)(HN + off) = pack8(y0, y1);
                    if (NOUT) { *(f32x4*)(NOUT + off) = y0; *(f32x4*)(NOUT + off + 4) = y1; }
                }
        }
        asm volatile("s_waitcnt lgkmcnt(0)" ::: "memory"); __builtin_amdgcn_s_barrier(); asm volatile("" ::: "memory");
    }
    __device__ __forceinline__ void operator()(const f32x4 (&)[2][2][4][2], const pg8::Unit&, int, int, int, int) const {}
};

typedef float f32x16 __attribute__((ext_vector_type(16)));
__device__ __forceinline__ float gelu_tanh(float x) { const float u = 0.7978845608028654f * (x + 0.044715f * x * x * x); const float e = __expf(2.f * u); const float th = 1.f - 2.f * __builtin_amdgcn_rcpf(e + 1.f); return 0.5f * x * (1.f + th); }
constexpr int S5_XSTR = 272;
constexpr int S5_WAVE_LDS = 2 * 16 * S5_XSTR;
template <bool OUT>
__device__ __forceinline__ void s5_pass(Frame& F, int l, const float* c_re, const float* c_im, const float* ssm_d) {
    const bf16_t* ZSp = F.ZS(); const float* SPp = F.SP(l); f32x2* S5Ep = F.S5E();
    LAS unsigned char* XL = F.lds + F.wave * S5_WAVE_LDS;
    for (int task = F.bid * NWAVES + F.wave; task < 256 * 16; task += F.G * NWAVES) {
        int lane = F.lane; asm volatile("" : "+v"(lane));
        const int n = lane & 31, hh = lane >> 5, l15 = lane & 15, kg = lane >> 4;
        const int g = task & 15, pp = task >> 4, cmine = 2 * pp + hh;
        bf16x8 bbf[2][2];
#pragma unroll
        for (int st = 0; st < 2; ++st) { const float* br = SPp + SP_BBR + (size_t)(g * 64 + 2 * n + st) * 16 + 8 * hh; const float* bi = SPp + SP_BBI + (size_t)(g * 64 + 2 * n + st) * 16 + 8 * hh;
            bbf[st][0] = __builtin_bit_cast(bf16x8, pack8(*(const f32x4*)br, *(const f32x4*)(br + 4))); bbf[st][1] = __builtin_bit_cast(bf16x8, pack8(*(const f32x4*)bi, *(const f32x4*)(bi + 4))); }
        const f32x4 lb = *(const f32x4*)(SPp + SP_LB + (g * 64 + 2 * n) * 2);
        f32x4 x = {0.f, 0.f, 0.f, 0.f};
        if constexpr (OUT) x = *(const f32x4*)(S5Ep + (size_t)(cmine * 16 + g) * 64 + 2 * n);
        bf16x8 cf[4]; f32x4 dsk = {0.f, 0.f, 0.f, 0.f};
        if constexpr (OUT) {
#pragma unroll
            for (int ks = 0; ks < 4; ++ks) { const float* cp = ((ks < 2) ? c_re : c_im) + ((size_t)(l * 16 + g) * 16 + l15) * 64 + 32 * (ks & 1) + 8 * kg;
                f32x4 a = *(const f32x4*)cp, b = *(const f32x4*)(cp + 4); if (ks >= 2) { a = -a; b = -b; }
                cf[ks] = __builtin_bit_cast(bf16x8, pack8(a, b)); }
            dsk = *(const f32x4*)(ssm_d + (l * 16 + g) * 16 + 4 * kg);
        }
        const bf16_t* urow = ZSp + (size_t)((2 * pp + ((n >> 2) & 1)) * 64 + 4 * (n >> 3) + (n & 3)) * ZSW + ZU + g * 16 + 8 * hh;
#pragma unroll 1
        for (int k = 0; k < 4; ++k) {
            const bf16x8 uf = *(const bf16x8*)(urow + (size_t)(16 * k) * ZSW);
            const f32x16 z16 = {0.f, 0.f, 0.f, 0.f, 0.f, 0.f, 0.f, 0.f, 0.f, 0.f, 0.f, 0.f, 0.f, 0.f, 0.f, 0.f};
            const f32x16 r0 = __builtin_amdgcn_mfma_f32_32x32x16_bf16(uf, bbf[0][0], z16, 0, 0, 0), i0 = __builtin_amdgcn_mfma_f32_32x32x16_bf16(uf, bbf[0][1], z16, 0, 0, 0);
            const f32x16 r1 = __builtin_amdgcn_mfma_f32_32x32x16_bf16(uf, bbf[1][0], z16, 0, 0, 0), i1 = __builtin_amdgcn_mfma_f32_32x32x16_bf16(uf, bbf[1][1], z16, 0, 0, 0);
#pragma unroll
            for (int t = 0; t < 16; ++t) {
                const float nr0 = lb.x * x.x - lb.y * x.y + r0[t], ni0 = lb.x * x.y + lb.y * x.x + i0[t];
                const float nr1 = lb.z * x.z - lb.w * x.w + r1[t], ni1 = lb.z * x.w + lb.w * x.z + i1[t];
                x = (f32x4){nr0, ni0, nr1, ni1};
                if constexpr (OUT) { LAS unsigned* xw = (LAS unsigned*)(XL + (hh * 16 + t) * S5_XSTR + 4 * n); xw[0] = pk2(nr0, nr1); xw[32] = pk2(ni0, ni1); }
            }
            if constexpr (OUT) {
                asm volatile("s_waitcnt lgkmcnt(0)" ::: "memory");
#pragma unroll
                for (int sel = 0; sel < 2; ++sel) {
                    f32x4 y = {0.f, 0.f, 0.f, 0.f};
#pragma unroll
                    for (int ks = 0; ks < 4; ++ks) { const bf16x8 xf = *(const LAS bf16x8*)(XL + (sel * 16 + l15) * S5_XSTR + (32 * ks + 8 * kg) * 2); y = __builtin_amdgcn_mfma_f32_16x16x32_bf16(cf[ks], xf, y, 0, 0, 0); }
                    const size_t tok = (size_t)(2 * pp + sel) * 64 + 16 * k + l15;
                    const u32x2 uw = *(const u32x2*)(ZSp + tok * ZSW + ZU + g * 16 + 4 * kg);
                    const float y0 = gelu_tanh(y.x + dsk.x * bflo(uw.x)), y1 = gelu_tanh(y.y + dsk.y * bfhi(uw.x)), y2 = gelu_tanh(y.z + dsk.z * bflo(uw.y)), y3 = gelu_tanh(y.w + dsk.w * bfhi(uw.y));
                    *(u32x2*)(F.H() + tok * DM + g * 16 + 4 * kg) = (u32x2){pk2(y0, y1), pk2(y2, y3)};
                }
                asm volatile("s_waitcnt lgkmcnt(0)" ::: "memory");
            }
        }
        if constexpr (!OUT) *(f32x4*)(S5Ep + (size_t)(cmine * 16 + g) * 64 + 2 * n) = x;
    }
}
__device__ __forceinline__ void phase_s5_local(Frame& F, int l) {
#ifdef NO_PHASE_S5_LOCAL
    return;
#endif
    s5_pass<false>(F, l, nullptr, nullptr, nullptr);
}
__device__ __forceinline__ void phase_s5_out(Frame& F, int l, const float* c_re, const float* c_im, const float* ssm_d) {
#ifdef NO_PHASE_S5_OUT
    return;
#endif
    s5_pass<true>(F, l, c_re, c_im, ssm_d);
}

__device__ __forceinline__ void phase_carry(Frame& F, int l) {
#ifdef NO_PHASE_CARRY
    return;
#endif
    const float* SPp = F.SP(l); f32x2* S5Ep = F.S5E(); float* RSTp = F.RST();
    const int gw = F.bid * NWAVES + F.wave, NGW = F.G * NWAVES;
    for (int task = gw; task < NB * 16; task += NGW) {
        const int b = task >> 4, g = task & 15, p = F.lane;
        const float ar = SPp[SP_L64 + (g * 64 + p) * 2], ai = SPp[SP_L64 + (g * 64 + p) * 2 + 1];
        float sr = 0.f, si = 0.f;
        for (int c0 = 0; c0 < 128; c0 += 16) {
            f32x2 e[16];
#pragma unroll
            for (int j = 0; j < 16; ++j) e[j] = S5Ep[(size_t)((b * 128 + c0 + j) * 16 + g) * 64 + p];
#pragma unroll
            for (int j = 0; j < 16; ++j) { S5Ep[(size_t)((b * 128 + c0 + j) * 16 + g) * 64 + p] = (f32x2){sr, si}; const float nr = ar * sr - ai * si + e[j].x, ni = ar * si + ai * sr + e[j].y; sr = nr; si = ni; }
        }
    }
    const int NT = F.G * NTHREADS;
    for (int gt = F.bid * NTHREADS + F.tid; gt < NB * 4 * 4608; gt += NT) {
        const int b = gt / (4 * 4608), h = (gt / 4608) & 3, el = gt % 4608;
        const float lg = log1pf(-exp2f(-5.f - (float)h));
        const float cdec = expf(lg * 64.f);
        float s = 0.f;
        for (int c0 = 0; c0 < 128; c0 += 16) {
            float d[16];
#pragma unroll
            for (int j = 0; j < 16; ++j) d[j] = RSTp[(size_t)((b * 128 + c0 + j) * 4 + h) * 4608 + el];
#pragma unroll
            for (int j = 0; j < 16; ++j) { RSTp[(size_t)((b * 128 + c0 + j) * 4 + h) * 4608 + el] = s; s = s * cdec + d[j]; }
        }
    }
}

typedef float f32x16 __attribute__((ext_vector_type(16)));
typedef short s16x4 __attribute__((ext_vector_type(4)));
__device__ __forceinline__ bf16x8 tr8(const LAS unsigned char* a0, const LAS unsigned char* a1) {
    const s16x4 lo = __builtin_bit_cast(s16x4, __builtin_amdgcn_ds_read_tr16_b64_v4i16((LAS s16x4*)a0));
    const s16x4 hi = __builtin_bit_cast(s16x4, __builtin_amdgcn_ds_read_tr16_b64_v4i16((LAS s16x4*)a1));
    return (bf16x8){lo[0], lo[1], lo[2], lo[3], hi[0], hi[1], hi[2], hi[3]};
}
__device__ __forceinline__ bf16x8 pack8f(const f32x4& a, const f32x4& b) { return __builtin_bit_cast(bf16x8, pack8(a, b)); }
__device__ __forceinline__ void ret_stage_v(const bf16_t* ZSp, LAS unsigned char* Vb, int tok0, int h, int lane) {
#pragma unroll
    for (int n = 0; n < 12; ++n) { const int o = n * 1024 + 16 * lane, r = o / 192, ch = (o % 192) >> 4;
        __builtin_amdgcn_global_load_lds((const unsigned*)(ZSp + (size_t)(tok0 + r) * ZSW + ZRV + h * 96 + ch * 8), (LAS unsigned*)(Vb + n * 1024), 16, 0, 0); }
}
constexpr int RET_VB = 12288, RET_KSTR = 112, RET_WAVE_LDS = RET_VB + 64 * RET_KSTR;
__device__ __forceinline__ void phase_ret_local(Frame& F) {
#ifdef NO_PHASE_RET_LOCAL
    return;
#endif
    const bf16_t* ZSp = F.ZS(); float* RSTp = F.RST();
    LAS unsigned char* Vb = F.lds + F.wave * RET_WAVE_LDS; LAS unsigned char* Kb = Vb + RET_VB;
    for (int item = F.bid * NWAVES + F.wave; item < 2048; item += F.G * NWAVES) {
        int lane = F.lane; asm volatile("" : "+v"(lane));
        const int l31 = lane & 31, hh = lane >> 5, g1 = (lane >> 4) & 1, q4 = (lane & 15) >> 2, p4 = lane & 3;
        const int h = item & 3, tok0 = (item >> 2) * 64;
        ret_stage_v(ZSp, Vb, tok0, h, lane);
        const float lg2 = log2f(1.f - exp2f(-5.f - (float)h));
#pragma unroll
        for (int n = 0; n < 6; ++n) { const int idx = n * 64 + lane, r = idx / 6, ch = idx % 6;
            f32x4 a, b; unpack8(*(const u32x4*)(ZSp + (size_t)(tok0 + r) * ZSW + ZRK + h * 48 + ch * 8), a, b);
            const float sc = 0.14433756729740643f * exp2f(lg2 * (float)(63 - r));
            *(LAS u32x4*)(Kb + r * RET_KSTR + ch * 16) = pack8(a * sc, b * sc); }
        asm volatile("s_waitcnt vmcnt(0) lgkmcnt(0)" ::: "memory");
        f32x16 acc[3][2];
#pragma unroll
        for (int me = 0; me < 3; ++me)
#pragma unroll
            for (int nt = 0; nt < 2; ++nt) acc[me][nt] = (f32x16){0.f, 0.f, 0.f, 0.f, 0.f, 0.f, 0.f, 0.f, 0.f, 0.f, 0.f, 0.f, 0.f, 0.f, 0.f, 0.f};
#pragma unroll
        for (int s = 0; s < 4; ++s) {
            const int r0 = 16 * s + 8 * hh + q4;
            bf16x8 kf[2], vf[3];
#pragma unroll
            for (int nt = 0; nt < 2; ++nt) { const LAS unsigned char* a0 = Kb + r0 * RET_KSTR + (32 * nt + 16 * g1 + 4 * p4) * 2; kf[nt] = tr8(a0, a0 + 4 * RET_KSTR); }
#pragma unroll
            for (int me = 0; me < 3; ++me) { const LAS unsigned char* a0 = Vb + r0 * 192 + (32 * me + 16 * g1 + 4 * p4) * 2; vf[me] = tr8(a0, a0 + 4 * 192); }
#pragma unroll
            for (int me = 0; me < 3; ++me)
#pragma unroll
                for (int nt = 0; nt < 2; ++nt) acc[me][nt] = __builtin_amdgcn_mfma_f32_32x32x16_bf16(vf[me], kf[nt], acc[me][nt], 0, 0, 0);
        }
        float* dst = RSTp + (size_t)item * 4608 + (4 * hh) * 48 + l31;
#pragma unroll
        for (int me = 0; me < 3; ++me)
#pragma unroll
            for (int r4 = 0; r4 < 4; ++r4) {
                int zz = 0; asm volatile("" : "+v"(zz)); float* dp = dst + (32 * me + 8 * r4) * 48 + zz;
#pragma unroll
                for (int k = 0; k < 4; ++k) { dp[k * 48] = acc[me][0][4 * r4 + k]; if (l31 < 16) dp[k * 48 + 32] = acc[me][1][4 * r4 + k]; }
            }
        asm volatile("s_waitcnt lgkmcnt(0)" ::: "memory");
    }
}
__device__ __forceinline__ void phase_ret_out(Frame& F, int l, const float* ret_norm_g) {
#ifdef NO_PHASE_RET_OUT
    return;
#endif
    const bf16_t* ZSp = F.ZS(); const float* RSTp = F.RST();
    LAS unsigned char* Vb = F.lds + F.wave * RET_WAVE_LDS;
    for (int item = F.bid * NWAVES + F.wave; item < 2048; item += F.G * NWAVES) {
        int lane = F.lane; asm volatile("" : "+v"(lane));
        const int l31 = lane & 31, hh = lane >> 5, g1 = (lane >> 4) & 1, q4 = (lane & 15) >> 2, p4 = lane & 3;
        const int h = item & 3, tok0 = (item >> 2) * 64;
        ret_stage_v(ZSp, Vb, tok0, h, lane);
        const float lg2 = log2f(1.f - exp2f(-5.f - (float)h));
        bf16x8 qf[2][3], kf[2][3];
#pragma unroll
        for (int t = 0; t < 2; ++t)
#pragma unroll
            for (int ks = 0; ks < 3; ++ks) { const size_t ro = (size_t)(tok0 + 32 * t + l31) * ZSW + h * 48 + 8 * hh + 16 * ks;
                qf[t][ks] = *(const bf16x8*)(ZSp + ro + ZRQ); kf[t][ks] = *(const bf16x8*)(ZSp + ro + ZRK); }
        bf16x8 pm[2][4];
#pragma unroll
        for (int mt = 0; mt < 2; ++mt)
#pragma unroll
            for (int nt = mt; nt < 2; ++nt) {
                f32x16 p = {0.f, 0.f, 0.f, 0.f, 0.f, 0.f, 0.f, 0.f, 0.f, 0.f, 0.f, 0.f, 0.f, 0.f, 0.f, 0.f};
#pragma unroll
                for (int ks = 0; ks < 3; ++ks) p = __builtin_amdgcn_mfma_f32_32x32x16_bf16(kf[mt][ks], qf[nt][ks], p, 0, 0, 0);
                const int i = 32 * nt + l31;
#pragma unroll
                for (int r = 0; r < 16; ++r) { const int j = 32 * mt + (r & 3) + 8 * (r >> 2) + 4 * hh;
                    p[r] = (i >= j) ? p[r] * (0.14433756729740643f * exp2f(lg2 * (float)(i - j))) : 0.f; }
                pm[nt][2 * mt + 0] = pack8f((f32x4){p[0], p[1], p[2], p[3]}, (f32x4){p[4], p[5], p[6], p[7]});
                pm[nt][2 * mt + 1] = pack8f((f32x4){p[8], p[9], p[10], p[11]}, (f32x4){p[12], p[13], p[14], p[15]});
            }
        f32x16 ot[3][2];
#pragma unroll
        for (int me = 0; me < 3; ++me) {
            bf16x8 sf[3];
            int zz = 0; asm volatile("" : "+v"(zz)); const float* sp0 = RSTp + (size_t)item * 4608 + (32 * me + l31) * 48 + 8 * hh + zz;
#pragma unroll
            for (int ks = 0; ks < 3; ++ks) { const float* sp = sp0 + 16 * ks; sf[ks] = pack8f(*(const f32x4*)sp, *(const f32x4*)(sp + 4)); }
#pragma unroll
            for (int nt = 0; nt < 2; ++nt) {
                f32x16 a = {0.f, 0.f, 0.f, 0.f, 0.f, 0.f, 0.f, 0.f, 0.f, 0.f, 0.f, 0.f, 0.f, 0.f, 0.f, 0.f};
#pragma unroll
                for (int ks = 0; ks < 3; ++ks) a = __builtin_amdgcn_mfma_f32_32x32x16_bf16(sf[ks], qf[nt][ks], a, 0, 0, 0);
                const float qd = exp2f(lg2 * (float)(32 * nt + l31 + 1));
                ot[me][nt] = a * qd;
            }
        }
        asm volatile("s_waitcnt vmcnt(0)" ::: "memory");
#pragma unroll
        for (int s = 0; s < 4; ++s) {
            const int r0 = 16 * s + 4 * hh + q4;
#pragma unroll
            for (int me = 0; me < 3; ++me) {
                const LAS unsigned char* a0 = Vb + r0 * 192 + (32 * me + 16 * g1 + 4 * p4) * 2;
                const bf16x8 vf = tr8(a0, a0 + 8 * 192);
                if (s < 2) ot[me][0] = __builtin_amdgcn_mfma_f32_32x32x16_bf16(vf, pm[0][s], ot[me][0], 0, 0, 0);
                ot[me][1] = __builtin_amdgcn_mfma_f32_32x32x16_bf16(vf, pm[1][s], ot[me][1], 0, 0, 0);
            }
        }
#pragma unroll
        for (int nt = 0; nt < 2; ++nt) {
            float sum = 0.f;
#pragma unroll
            for (int me = 0; me < 3; ++me)
#pragma unroll
                for (int r = 0; r < 16; ++r) sum += ot[me][nt][r];
            sum += __shfl_xor(sum, 32);
            const float mu = sum * (1.f / 96.f); float q2 = 0.f;
#pragma unroll
            for (int me = 0; me < 3; ++me)
#pragma unroll
                for (int r = 0; r < 16; ++r) { const float d = ot[me][nt][r] - mu; q2 += d * d; }
            q2 += __shfl_xor(q2, 32);
            const float rs = rsqrtf(q2 * (1.f / 96.f) + EPS);
            const int tok = tok0 + 32 * nt + l31;
            const bf16_t* gbase = ZSp + (size_t)tok * ZSW + ZRG + h * 96 + 4 * hh; const float* nbase = ret_norm_g + l * 384 + h * 96 + 4 * hh; bf16_t* obase = F.H() + (size_t)tok * DM + 640 + h * 96 + 4 * hh;
#pragma unroll
            for (int me = 0; me < 3; ++me) {
                int zz = 0; asm volatile("" : "+v"(zz));
                const bf16_t* gp = gbase + 32 * me + zz; const float* np = nbase + 32 * me + zz; bf16_t* op = obase + 32 * me + zz;
#pragma unroll
                for (int r4 = 0; r4 < 4; ++r4) {
                    const u32x2 gw = *(const u32x2*)(gp + 8 * r4);
                    const f32x4 ng = *(const f32x4*)(np + 8 * r4);
                    const float g0 = bflo(gw.x), g1f = bfhi(gw.x), g2 = bflo(gw.y), g3 = bfhi(gw.y);
                    const float y0 = (ot[me][nt][4 * r4 + 0] - mu) * rs * ng.x * (g0 * sigmoidf_(g0)), y1 = (ot[me][nt][4 * r4 + 1] - mu) * rs * ng.y * (g1f * sigmoidf_(g1f));
                    const float y2 = (ot[me][nt][4 * r4 + 2] - mu) * rs * ng.z * (g2 * sigmoidf_(g2)), y3 = (ot[me][nt][4 * r4 + 3] - mu) * rs * ng.w * (g3 * sigmoidf_(g3));
                    *(u32x2*)(op + 8 * r4) = (u32x2){pk2(y0, y1), pk2(y2, y3)};
                }
            }
        }
        asm volatile("s_waitcnt lgkmcnt(0)" ::: "memory");
    }
}

typedef _Float16 f16_t;
__device__ __forceinline__ u32x4 zero4() { unsigned z = 0u; asm volatile("" : "+v"(z)); return (u32x4){z, z, z, z}; }
__device__ __forceinline__ int lanes_below(unsigned long long m) { return (int)__builtin_amdgcn_mbcnt_hi((unsigned)(m >> 32), __builtin_amdgcn_mbcnt_lo((unsigned)m, 0u)); }
__device__ __forceinline__ float relu1(float x) { return __builtin_amdgcn_fmed3f(x, 0.f, __builtin_inff()); }
__device__ __forceinline__ unsigned sortable_f16(float sc) {
    const f16_t h = (f16_t)sc; const unsigned u = (unsigned)__builtin_bit_cast(unsigned short, h), mag = u & 0x7fffu;
    return (u & 0x8000u) ? (0x8000u - mag) : (0x8000u + mag);
}
__device__ __forceinline__ int sc_pos(int k) { return k; }
__device__ __forceinline__ int wave_suffix_sum(int v, int lane) {
#pragma unroll
    for (int o = 1; o < 64; o <<= 1) { const int t = __shfl_down(v, o); if (lane + o < 64) v += t; }
    return v;
}
__device__ __forceinline__ void hist_threshold(const u32x4 c, int need, int lane, int& B, int& above) {
    const int s = (int)(c.x + c.y + c.z + c.w);
    const int S = wave_suffix_sum(s, lane);
    int a = S - s;
    const bool found = (a < need) && (S >= need);
    int Bl = 0, al = 0;
    if (found) {
        if (a + (int)c.w >= need) { Bl = 4 * lane + 3; al = a; }
        else { a += (int)c.w; if (a + (int)c.z >= need) { Bl = 4 * lane + 2; al = a; }
        else { a += (int)c.z; if (a + (int)c.y >= need) { Bl = 4 * lane + 1; al = a; }
        else { a += (int)c.y; Bl = 4 * lane; al = a; } } }
    }
    const unsigned long long m = __ballot(found);
    const int src = m ? (int)__builtin_ctzll(m) : 0;
    B = __shfl(Bl, src); above = __shfl(al, src);
}

#ifndef DSA_CAND
#define DSA_CAND 0
#endif
#ifndef DSA_DUP
#define DSA_DUP 0
#endif
constexpr int DSA_ROW = 16384;
__device__ __forceinline__ void phase_dsa(Frame& F) {
#ifdef NO_PHASE_DSA
    return;
#endif
    const int wave = F.wave;
    const bf16_t* ZSp = F.ZS(); const float* IWp = F.IW(); const bf16_t* IKp = F.IKD();
    LAS unsigned char* SCb = F.lds;
    for (int it = F.bid; it < 512; it += F.G) {
        int lane = F.lane; asm volatile("" : "+v"(lane));
        const int hi = lane >> 5, n32 = lane & 31;
        LAS unsigned short* LSTw = (LAS unsigned short*)(F.lds + 131072) + wave * 256;
        LAS unsigned char* WB = F.lds + 135168 + wave * 3520;
        LAS unsigned* H1 = (LAS unsigned*)WB; LAS unsigned* H2 = H1 + 256;
        LAS unsigned* DUM = (LAS unsigned*)(WB + 3264) + lane;
        LAS unsigned short* CK = (LAS unsigned short*)(WB + 1024); LAS unsigned short* CI = (LAS unsigned short*)(WB + 2144);
        const int pr = it & 255, vcu = (pr & 7) * 32 + (pr >> 3);
        const int b = vcu >> 6, cc = vcu & 63, c = (it < 256) ? cc : 127 - cc;
        const int V = (c + 1) * 64, tokq0 = b * SEQ + c * 64, kb0 = b * SEQ;
        const int Keff = V < 256 ? V : 256;
        const int nblk = (V + 511) >> 9, ntile_all = nblk * 16, ntile_real = V >> 5;
        for (int qg = 0; qg < 8; ++qg) {
            const int tq0 = tokq0 + qg * 8;
#ifndef DSA_NO_A
            for (int repA = 0; repA < 1 + (DSA_DUP & 1); ++repA) {
                bf16x8 aq[2];
                { const int qq = n32 >> 2, hd = n32 & 3; const bf16_t* qp = ZSp + (size_t)(tq0 + qq) * ZSW + ZIQ + hd * 32 + 8 * hi;
                  aq[0] = *(const bf16x8*)qp; aq[1] = *(const bf16x8*)(qp + 16); }
                float wq[4][4];
#pragma unroll
                for (int jq = 0; jq < 4; ++jq) { const f32x4 w4 = *(const f32x4*)(IWp + (size_t)(tq0 + 2 * jq + hi) * 4);
                    wq[jq][0] = w4.x * 0.08838834764831845f; wq[jq][1] = w4.y * 0.08838834764831845f; wq[jq][2] = w4.z * 0.08838834764831845f; wq[jq][3] = w4.w * 0.08838834764831845f; }
                bf16x8 fr[2][4][2];
                const int nb = (ntile_all - wave + 31) >> 5;
#define DSA_ALOAD(buf, bt) do { int zz = 0; asm volatile("" : "+v"(zz)); _Pragma("unroll") for (int u = 0; u < 4; ++u) { const int tt = wave + 8 * (4 * (bt) + u); \
        if (tt < ntile_real) { const bf16_t* kp = IKp + ((size_t)(((kb0 >> 5) + tt) * 4 + hi) * 32 + n32 + zz) * 8; fr[buf][u][0] = *(const bf16x8*)kp; fr[buf][u][1] = *(const bf16x8*)(kp + 512); } } } while (0)
#define DSA_ACOMP(buf, bt) do { _Pragma("unroll") for (int u = 0; u < 4; ++u) { const int tt = wave + 8 * (4 * (bt) + u); \
        if (tt < ntile_all) { unsigned short us[4] = {0, 0, 0, 0}; \
            if (tt < ntile_real) { f32x16 acc = {0.f, 0.f, 0.f, 0.f, 0.f, 0.f, 0.f, 0.f, 0.f, 0.f, 0.f, 0.f, 0.f, 0.f, 0.f, 0.f}; \
                acc = __builtin_amdgcn_mfma_f32_32x32x16_bf16(aq[0], fr[buf][u][0], acc, 0, 0, 0); acc = __builtin_amdgcn_mfma_f32_32x32x16_bf16(aq[1], fr[buf][u][1], acc, 0, 0, 0); \
                _Pragma("unroll") for (int jq = 0; jq < 4; ++jq) { \
                    const float sc = relu1(acc[4 * jq + 0]) * wq[jq][0] + relu1(acc[4 * jq + 1]) * wq[jq][1] + relu1(acc[4 * jq + 2]) * wq[jq][2] + relu1(acc[4 * jq + 3]) * wq[jq][3]; \
                    us[jq] = (unsigned short)sortable_f16(sc); } } \
            const int pos = sc_pos(tt * 32 + n32); \
            _Pragma("unroll") for (int jq = 0; jq < 4; ++jq) *(LAS unsigned short*)(SCb + (2 * jq + hi) * DSA_ROW + pos * 2) = us[jq]; } } } while (0)
                DSA_ALOAD(0, 0);
                for (int bp = 0; bp < nb; bp += 2) {
                    if (bp + 1 < nb) DSA_ALOAD(1, bp + 1);
                    DSA_ACOMP(0, bp);
                    if (bp + 2 < nb) DSA_ALOAD(0, bp + 2);
                    if (bp + 1 < nb) DSA_ACOMP(1, bp + 1);
                }
#undef DSA_ALOAD
#undef DSA_ACOMP
            }
#endif
            __syncthreads();
            LAS unsigned char* row = SCb + wave * DSA_ROW;
#ifndef DSA_NO_B
            for (int repB = 0; repB < 1 + ((DSA_DUP >> 1) & 1); ++repB)
            if (V > 256) {
                *(LAS u32x4*)(H1 + 4 * lane) = zero4(); *(LAS u32x4*)(H2 + 4 * lane) = zero4();
                u32x4 rw[4];
#define DSA_LD8(hf) do { _Pragma("unroll") for (int i = 0; i < 4; ++i) if (4 * (hf) + i < nblk) rw[i] = *(const LAS u32x4*)(row + (512 * (4 * (hf) + i) + 8 * lane) * 2); \
        asm volatile("s_waitcnt lgkmcnt(0)" ::: "memory"); } while (0)
#define DSA_W(i, e2) ((e2) == 0 ? rw[i].x : (e2) == 1 ? rw[i].y : (e2) == 2 ? rw[i].z : rw[i].w)
                asm volatile("s_waitcnt lgkmcnt(0)" ::: "memory");
#pragma unroll 1
                for (int hf = 0; 4 * hf < nblk; ++hf) {
                    DSA_LD8(hf);
#pragma unroll
                    for (int i = 0; i < 4; ++i) if (4 * hf + i < nblk) __hip_atomic_fetch_add(H2 + ((rw[i].x >> 8) & 255u), 1u, __ATOMIC_RELAXED, __HIP_MEMORY_SCOPE_WORKGROUP);
                }
                asm volatile("s_waitcnt lgkmcnt(0)" ::: "memory");
                int Bc, abovec; hist_threshold(*(const LAS u32x4*)(H2 + 4 * lane), 40, lane, Bc, abovec);
                { const u32x4 hs = *(const LAS u32x4*)(H2 + 4 * lane); const int tot = wave_suffix_sum((int)(hs.x + hs.y + hs.z + hs.w), lane); if (__shfl(tot, 0) < 40) Bc = 0; }
                *(LAS u32x4*)(H2 + 4 * lane) = zero4();
                bool done = false;
                if (DSA_CAND && Bc > 0) {
                    const unsigned thr = (unsigned)Bc << 8;
                    int cnt = 0;
#pragma unroll 1
                    for (int hf = 0; 4 * hf < nblk; ++hf) {
                        DSA_LD8(hf);
#pragma unroll
                        for (int i = 0; i < 4; ++i) if (4 * hf + i < nblk) {
#pragma unroll
                            for (int e = 0; e < 8; ++e) { const unsigned w = DSA_W(i, e >> 1); const unsigned u = (e & 1) ? (w >> 16) : (w & 0xffffu); cnt += (u >= thr) ? 1 : 0; }
                        }
                    }
                    int pos = cnt;
#pragma unroll
                    for (int o = 1; o < 64; o <<= 1) { const int t = __shfl_up(pos, o); if (lane >= o) pos += t; }
                    const int ncand = __shfl(pos, 63); pos -= cnt;
                    if (ncand >= 256 && ncand <= 560) {
                        LAS unsigned short* ldum = (LAS unsigned short*)DUM;
#pragma unroll 1
                        for (int hf = 0; 4 * hf < nblk; ++hf) {
                            DSA_LD8(hf);
#pragma unroll
                            for (int i = 0; i < 4; ++i) if (4 * hf + i < nblk) {
#pragma unroll
                                for (int e = 0; e < 8; ++e) { const unsigned w = DSA_W(i, e >> 1); const unsigned u = (e & 1) ? (w >> 16) : (w & 0xffffu);
                                    const bool sel = u >= thr; LAS unsigned short* pk = sel ? CK + pos : ldum; LAS unsigned short* pi = sel ? CI + pos : ldum;
                                    *pk = (unsigned short)u; *pi = (unsigned short)(512 * (4 * hf + i) + 8 * lane + e); pos += sel ? 1 : 0; }
                            }
                        }
                        *(LAS u32x4*)(H1 + 4 * lane) = zero4();
                        asm volatile("s_waitcnt lgkmcnt(0)" ::: "memory");
                        unsigned cu[9];
#pragma unroll
                        for (int j = 0; j < 9; ++j) { const int p = j * 64 + lane; const bool v = p < ncand; cu[j] = v ? (unsigned)CK[v ? p : 0] : 0u; }
                        asm volatile("s_waitcnt lgkmcnt(0)" ::: "memory");
#pragma unroll
                        for (int j = 0; j < 9; ++j) if (j * 64 + lane < ncand) __hip_atomic_fetch_add(H1 + (cu[j] >> 8), 1u, __ATOMIC_RELAXED, __HIP_MEMORY_SCOPE_WORKGROUP);
                        asm volatile("s_waitcnt lgkmcnt(0)" ::: "memory");
                        int B1c, above1c; hist_threshold(*(const LAS u32x4*)(H1 + 4 * lane), 256, lane, B1c, above1c);
                        *(LAS u32x4*)(H1 + 4 * lane) = zero4();
                        asm volatile("s_waitcnt lgkmcnt(0)" ::: "memory");
#pragma unroll
                        for (int j = 0; j < 9; ++j) if (j * 64 + lane < ncand && (int)(cu[j] >> 8) == B1c) __hip_atomic_fetch_add(H1 + (cu[j] & 255u), 1u, __ATOMIC_RELAXED, __HIP_MEMORY_SCOPE_WORKGROUP);
                        asm volatile("s_waitcnt lgkmcnt(0)" ::: "memory");
                        int B2c, above2c; hist_threshold(*(const LAS u32x4*)(H1 + 4 * lane), 256 - above1c, lane, B2c, above2c);
                        const unsigned tauc = ((unsigned)B1c << 8) | (unsigned)B2c;
                        if ((int)H1[B2c] == 256 - above1c - above2c) {
                            int c2 = 0;
#pragma unroll
                            for (int j = 0; j < 9; ++j) c2 += (j * 64 + lane < ncand && cu[j] >= tauc) ? 1 : 0;
                            int p2 = c2;
#pragma unroll
                            for (int o = 1; o < 64; o <<= 1) { const int t = __shfl_up(p2, o); if (lane >= o) p2 += t; }
                            p2 -= c2;
#pragma unroll
                            for (int j = 0; j < 9; ++j) { const bool sel = (j * 64 + lane < ncand) && cu[j] >= tauc; LAS unsigned short* pl = sel ? LSTw + p2 : ldum; *pl = CI[sel ? j * 64 + lane : 0]; p2 += sel ? 1 : 0; }
                            done = true;
                        }
                        *(LAS u32x4*)(H1 + 4 * lane) = zero4(); *(LAS u32x4*)(H2 + 4 * lane) = zero4();
                        asm volatile("s_waitcnt lgkmcnt(0)" ::: "memory");
                    }
                }
                if (!done) {
                int lo_bin = Bc, hi_bin = 256;
                for (;;) {
#pragma unroll 1
                    for (int hf = 0; 4 * hf < nblk; ++hf) {
                        DSA_LD8(hf);
#pragma unroll
                        for (int i = 0; i < 4; ++i) if (4 * hf + i < nblk) {
#pragma unroll
                            for (int e2 = 0; e2 < 4; ++e2) { const unsigned w = DSA_W(i, e2); const int b0 = (int)((w >> 8) & 255u), b1 = (int)(w >> 24);
                                LAS unsigned* p0 = ((unsigned)(b0 - lo_bin) < (unsigned)(hi_bin - lo_bin)) ? H1 + b0 : DUM; LAS unsigned* p1 = ((unsigned)(b1 - lo_bin) < (unsigned)(hi_bin - lo_bin)) ? H1 + b1 : DUM;
                                __hip_atomic_fetch_add(p0, 1u, __ATOMIC_RELAXED, __HIP_MEMORY_SCOPE_WORKGROUP); __hip_atomic_fetch_add(p1, 1u, __ATOMIC_RELAXED, __HIP_MEMORY_SCOPE_WORKGROUP); }
                        }
                    }
                    asm volatile("s_waitcnt lgkmcnt(0)" ::: "memory");
                    if (lo_bin == 0) break;
                    const u32x4 h4 = *(const LAS u32x4*)(H1 + 4 * lane); const int tot = __shfl(wave_suffix_sum((int)(h4.x + h4.y + h4.z + h4.w), lane), 0);
                    if (tot >= 256) break;
                    hi_bin = lo_bin; lo_bin = 0;
                }
                asm volatile("s_waitcnt lgkmcnt(0)" ::: "memory");
                int B1, above1; hist_threshold(*(const LAS u32x4*)(H1 + 4 * lane), 256, lane, B1, above1);
#pragma unroll 1
                for (int hf = 0; 4 * hf < nblk; ++hf) {
                    DSA_LD8(hf);
#pragma unroll
                    for (int i = 0; i < 4; ++i) if (4 * hf + i < nblk) {
#pragma unroll
                        for (int e2 = 0; e2 < 4; ++e2) { const unsigned w = DSA_W(i, e2);
                            LAS unsigned* p0 = ((int)((w >> 8) & 255u) == B1) ? H2 + (w & 255u) : DUM; LAS unsigned* p1 = ((int)(w >> 24) == B1) ? H2 + ((w >> 16) & 255u) : DUM;
                            __hip_atomic_fetch_add(p0, 1u, __ATOMIC_RELAXED, __HIP_MEMORY_SCOPE_WORKGROUP); __hip_atomic_fetch_add(p1, 1u, __ATOMIC_RELAXED, __HIP_MEMORY_SCOPE_WORKGROUP); }
                    }
                }
                asm volatile("s_waitcnt lgkmcnt(0)" ::: "memory");
                int B2, above2; hist_threshold(*(const LAS u32x4*)(H2 + 4 * lane), 256 - above1, lane, B2, above2);
                const unsigned tau = ((unsigned)B1 << 8) | (unsigned)B2;
                const int r = 256 - above1 - above2;
                const int neq = (int)H2[B2];
                if (neq == r) {
                    int cnt = 0;
#pragma unroll 1
                    for (int hf = 0; 4 * hf < nblk; ++hf) {
                        DSA_LD8(hf);
#pragma unroll
                        for (int i = 0; i < 4; ++i) if (4 * hf + i < nblk) {
#pragma unroll
                            for (int e = 0; e < 8; ++e) { const unsigned w = DSA_W(i, e >> 1); const unsigned u = (e & 1) ? (w >> 16) : (w & 0xffffu); cnt += (u >= tau) ? 1 : 0; }
                        }
                    }
                    int pos = cnt;
#pragma unroll
                    for (int o = 1; o < 64; o <<= 1) { const int t = __shfl_up(pos, o); if (lane >= o) pos += t; }
                    pos -= cnt;
                    LAS unsigned short* ldum = (LAS unsigned short*)DUM;
#pragma unroll 1
                    for (int hf = 0; 4 * hf < nblk; ++hf) {
                        DSA_LD8(hf);
#pragma unroll
                        for (int i = 0; i < 4; ++i) if (4 * hf + i < nblk) {
#pragma unroll
                            for (int e = 0; e < 8; ++e) { const unsigned w = DSA_W(i, e >> 1); const unsigned u = (e & 1) ? (w >> 16) : (w & 0xffffu);
                                const bool sel = u >= tau; LAS unsigned short* p = sel ? LSTw + pos : ldum;
                                *p = (unsigned short)(512 * (4 * hf + i) + 8 * lane + e); pos += sel ? 1 : 0; }
                        }
                    }
                } else {
                    int eq_base = 0, sel_base = 0;
#pragma unroll 1
                    for (int i = 0; i < nblk; ++i) {
                        const u32x4 w4 = *(const LAS u32x4*)(row + (512 * i + 8 * lane) * 2);
                        const unsigned ww[4] = {w4.x, w4.y, w4.z, w4.w};
                        int below_eq = 0, mine_eq = 0;
#pragma unroll
                        for (int e = 0; e < 8; ++e) { const unsigned u = (e & 1) ? (ww[e >> 1] >> 16) : (ww[e >> 1] & 0xffffu); below_eq += lanes_below(__ballot(u == tau)); }
                        int blk_eq = 0;
#pragma unroll
                        for (int e = 0; e < 8; ++e) {
                            const unsigned u = (e & 1) ? (ww[e >> 1] >> 16) : (ww[e >> 1] & 0xffffu);
                            const bool gt = u > tau, eq = (u == tau);
                            const bool sel = gt || (eq && (eq_base + below_eq + mine_eq < r));
                            mine_eq += eq ? 1 : 0;
                            const unsigned long long msel = __ballot(sel);
                            if (sel) LSTw[sel_base + lanes_below(msel)] = (unsigned short)(512 * i + 8 * lane + e);
                            sel_base += __popcll(msel); blk_eq += __popcll(__ballot(eq));
                        }
                        eq_base += blk_eq;
                    }
                }
                }
#undef DSA_W
#undef DSA_LD8
            } else {
#pragma unroll
                for (int jj = 0; jj < 4; ++jj) LSTw[lane + 64 * jj] = (unsigned short)(lane + 64 * jj);
            }
#endif
            asm volatile("s_waitcnt lgkmcnt(0)" ::: "memory");
            for (int repC = 0; repC < 1 + ((DSA_DUP >> 2) & 1); ++repC) {
                const int tq = tq0 + wave, n16 = lane & 15, kg = lane >> 4;
                bf16x8 qf[2];
                if (n16 < 6) { const bf16_t* qp = ZSp + (size_t)tq * ZSW + ZDQ + n16 * 64 + 8 * kg; qf[0] = *(const bf16x8*)qp; qf[1] = *(const bf16x8*)(qp + 32); }
                else { qf[0] = (bf16x8){0, 0, 0, 0, 0, 0, 0, 0}; qf[1] = qf[0]; }
                const int ntile = Keff >> 4;
                LAS unsigned char* vst = row;
#define DSA_VDMA(ch, buf) do { _Pragma("unroll") for (int i8 = 0; i8 < 8; ++i8) { const int rr = (lane >> 3) + 8 * i8; const int kidx = LSTw[(ch) * 64 + rr]; \
        const int sch = (lane & 7) ^ (2 * ((rr >> 1) & 3)); \
        __builtin_amdgcn_global_load_lds((const unsigned*)(ZSp + (size_t)(kb0 + kidx) * ZSW + ZDV + sch * 8), (LAS unsigned*)(vst + (buf) * 8192 + i8 * 1024), 16, 0, 0); } } while (0)
                DSA_VDMA(0, 0);
                if (ntile > 4) DSA_VDMA(1, 1);
                f32x4 sa[16];
                bf16x8 kf[2][4][2];
#define DSA_KLOAD(buf, tb) do { _Pragma("unroll") for (int t4 = 0; t4 < 4; ++t4) if (4 * (tb) + t4 < ntile) { const int kidx = LSTw[(4 * (tb) + t4) * 16 + n16]; \
        const bf16_t* kp = ZSp + (size_t)(kb0 + kidx) * ZSW + ZDK + 8 * kg; kf[buf][t4][0] = *(const bf16x8*)kp; kf[buf][t4][1] = *(const bf16x8*)(kp + 32); } } while (0)
#define DSA_KMMA(buf, tb) do { _Pragma("unroll") for (int t4 = 0; t4 < 4; ++t4) { \
        if (4 * (tb) + t4 < ntile) { f32x4 a = {0.f, 0.f, 0.f, 0.f}; \
            a = __builtin_amdgcn_mfma_f32_16x16x32_bf16(kf[buf][t4][0], qf[0], a, 0, 0, 0); a = __builtin_amdgcn_mfma_f32_16x16x32_bf16(kf[buf][t4][1], qf[1], a, 0, 0, 0); sa[4 * (tb) + t4] = a; } \
        else sa[4 * (tb) + t4] = (f32x4){-1e30f, -1e30f, -1e30f, -1e30f}; } } while (0)
                DSA_KLOAD(0, 0); DSA_KLOAD(1, 1);
                DSA_KMMA(0, 0); DSA_KLOAD(0, 2);
                DSA_KMMA(1, 1); DSA_KLOAD(1, 3);
                DSA_KMMA(0, 2);
                DSA_KMMA(1, 3);
#undef DSA_KLOAD
#undef DSA_KMMA
                float m = -1e30f;
#pragma unroll
                for (int t = 0; t < 16; ++t) m = fmaxf(m, fmaxf(fmaxf(sa[t].x, sa[t].y), fmaxf(sa[t].z, sa[t].w)));
                m = fmaxf(m, __shfl_xor(m, 16)); m = fmaxf(m, __shfl_xor(m, 32));
                const float sc2 = 0.125f * 1.4426950408889634f; float lsum = 0.f;
#pragma unroll
                for (int t = 0; t < 16; ++t) { sa[t].x = exp2f((sa[t].x - m) * sc2); sa[t].y = exp2f((sa[t].y - m) * sc2); sa[t].z = exp2f((sa[t].z - m) * sc2); sa[t].w = exp2f((sa[t].w - m) * sc2);
                    lsum += (sa[t].x + sa[t].y) + (sa[t].z + sa[t].w); }
                lsum += __shfl_xor(lsum, 16); lsum += __shfl_xor(lsum, 32);
                const float linv = __builtin_amdgcn_rcpf(lsum);
                f32x4 oacc[4] = {{0.f, 0.f, 0.f, 0.f}, {0.f, 0.f, 0.f, 0.f}, {0.f, 0.f, 0.f, 0.f}, {0.f, 0.f, 0.f, 0.f}};
                const int q4 = n16 >> 2, p4 = n16 & 3;
#pragma unroll
                for (int ch = 0; ch < 4; ++ch) {
                    if (ch * 4 < ntile) {
                        if ((ch + 1) * 4 < ntile) asm volatile("s_waitcnt vmcnt(8)" ::: "memory");
                        else asm volatile("s_waitcnt vmcnt(0)" ::: "memory");
#pragma unroll
                        for (int sl = 0; sl < 2; ++sl) {
                            const int s = ch * 2 + sl;
                            u32x4 pw; pw.x = pk2(sa[2 * s].x, sa[2 * s].y); pw.y = pk2(sa[2 * s].z, sa[2 * s].w); pw.z = pk2(sa[2 * s + 1].x, sa[2 * s + 1].y); pw.w = pk2(sa[2 * s + 1].z, sa[2 * s + 1].w);
                            const bf16x8 pb = __builtin_bit_cast(bf16x8, pw);
#pragma unroll
                            for (int mt = 0; mt < 4; ++mt) {
                                const int P0 = 32 * sl + 4 * kg + q4, P1 = P0 + 16;
                                const LAS unsigned char* a0 = vst + (ch & 1) * 8192 + P0 * 128 + (((2 * mt + (p4 >> 1)) ^ (2 * ((P0 >> 1) & 3))) * 16) + 8 * (p4 & 1);
                                const LAS unsigned char* a1 = vst + (ch & 1) * 8192 + P1 * 128 + (((2 * mt + (p4 >> 1)) ^ (2 * ((P1 >> 1) & 3))) * 16) + 8 * (p4 & 1);
                                const s16x4 lo = __builtin_bit_cast(s16x4, __builtin_amdgcn_ds_read_tr16_b64_v4i16((LAS s16x4*)a0));
                                const s16x4 hi4 = __builtin_bit_cast(s16x4, __builtin_amdgcn_ds_read_tr16_b64_v4i16((LAS s16x4*)a1));
                                const bf16x8 va = (bf16x8){lo[0], lo[1], lo[2], lo[3], hi4[0], hi4[1], hi4[2], hi4[3]};
                                oacc[mt] = __builtin_amdgcn_mfma_f32_16x16x32_bf16(va, pb, oacc[mt], 0, 0, 0);
                            }
                        }
                        asm volatile("s_waitcnt lgkmcnt(0)" ::: "memory");
                        if (ch + 2 < 4 && (ch + 2) * 4 < ntile) DSA_VDMA(ch + 2, ch & 1);
                    }
                }
#undef DSA_VDMA
                if (n16 < 6) {
                    bf16_t* op = F.H() + (size_t)tq * DM + 256 + n16 * 64 + 4 * kg;
#pragma unroll
                    for (int mt = 0; mt < 4; ++mt) { u32x2 o; o.x = pk2(oacc[mt].x * linv, oacc[mt].y * linv); o.y = pk2(oacc[mt].z * linv, oacc[mt].w * linv); *(u32x2*)(op + 16 * mt) = o; }
                }
            }
            __syncthreads();
        }
    }
}

__global__ void __launch_bounds__(NTHREADS, 2) mk_fwd(Args args) {
    extern __shared__ __attribute__((aligned(16))) unsigned char lds_raw[];
    Frame F;
    F.lds = (LAS unsigned char*)lds_raw;
    F.tid = threadIdx.x; F.lane = F.tid & 63; F.wave = __builtin_amdgcn_readfirstlane(F.tid >> 6);
    F.G = gridDim.x; F.bid = blockIdx.x; F.wsb = args.ws; F.zo = 0u; F.wl = 0u;
    unsigned char* ws = args.ws;
#define INF(k) ((const float*)args.in[k])

    volatile LAS unsigned* MISC = (volatile LAS unsigned*)(F.lds + MISC_OFF);
    if (F.tid < 64) MISC[F.tid] = 0u;
    __syncthreads();
    XcdBarrier bar = xcd_barrier_post((unsigned*)(ws + WS_CTL) + CW_BAR, MISC + 8);
    int ph = 0; const int lo = args.ph_lo, hi = args.ph_hi;
    unsigned long long* TSp = (unsigned long long*)(ws + WS_CTL + 32768); int nst = 0; (void)TSp; (void)nst;
    bool first_seam = true;
#ifndef DUP_MASK
#define DUP_MASK 0
#endif
#ifdef PROBE_LO
#define STAMP() do { if (F.bid == 0 && F.tid == 0) { TSp[nst] = __builtin_amdgcn_s_memrealtime(); } ++nst; } while (0)
#else
#define STAMP() do { } while (0)
#endif
#define GRIDSYNC() xcd_barrier(bar, F.wave == 0 && (int)__builtin_amdgcn_mbcnt_hi(~0u, __builtin_amdgcn_mbcnt_lo(~0u, 0u)) == 0)
#define RUN(...) do { if (ph >= lo && ph < hi) { F.lane = (int)__builtin_amdgcn_mbcnt_hi(~0u, __builtin_amdgcn_mbcnt_lo(~0u, 0u)); asm volatile("" : "+v"(F.lane), "+s"(F.zo), "+s"(F.bid), "+s"(F.G), "+s"(F.wave)); F.tid = F.wave * 64 + F.lane; __VA_ARGS__; } ++ph; } while (0)
#define SEAM() do { if (ph > lo && ph < hi) { if (first_seam) { GRIDSYNC(); first_seam = false; } else xcd_barrier(bar, F.wave == 0 && (int)__builtin_amdgcn_mbcnt_hi(~0u, __builtin_amdgcn_mbcnt_lo(~0u, 0u)) == 0); } STAMP(); } while (0)

    STAMP();
    RUN(phase_rope(F, (const int*)args.in[1])); STAMP();
#pragma unroll
    RUN({ const ProIn I{INF(0), INF(2), INF(3), INF(15), INF(16), INF(17), INF(18), INF(20), INF(21), INF(12), INF(4), INF(5), INF(6), INF(7), INF(8), (const int*)args.in[1]};
          phase_prologue(F, I); }); SEAM();
    for (int l = 0; l < DEPTH; ++l) {
        const float* xin = (l == 0) ? INF(0) : args.out;
        F.wl = l ? (unsigned)(WS_W1L - WS_W) : 0u;
        RUN({ pg8::Gemm g{F.H(), F.Win_t()}; pg8::StaticOrder<T, NINP> S; S.init(F.G, F.bid);
              pg8::EpiGen<FInProj> E{FInProj{F.ZS(), F.GB(), F.IW(), F.ROPE(), F.IKD()}}; pg8::gemm_phase<T, NINP, DM, DM, DM>(F.lds, g, S, E, F.tid); }); SEAM();
        RUN({ phase_s5_local(F, l); __syncthreads(); phase_ret_local(F); __syncthreads(); phase_dsa(F); __syncthreads(); }); SEAM();
        RUN(phase_carry(F, l)); SEAM();
        RUN({ phase_s5_out(F, l, INF(9), INF(10), INF(11)); __syncthreads(); phase_ret_out(F, l, INF(14)); __syncthreads(); }); SEAM();
        RUN({ pg8::Gemm g{F.H(), F.Wglu_t()}; pg8::StaticOrder<T, 256> S; S.init(F.G, F.bid);
              pg8::EpiGen<FGlu, 0> E{FGlu{F.H(), INF(13) + l * 256}}; pg8::gemm_phase<T, 256, 256, DM, 256>(F.lds, g, S, E, F.tid); }); SEAM();
        RUN({ pg8::Gemm g{F.H(), F.Wabc_t()}; pg8::StaticOrder<T, DM> S; S.init(F.G, F.bid);
              EpiMerge E{F.MG(), F.GB()}; pg8::gemm_phase<T, DM, DM, DM, DM>(F.lds, g, S, E, F.tid); }); SEAM();
        RUN({ pg8::Gemm g{F.MG(), F.Wout_t()}; pg8::StaticOrder<T, DM> S; S.init(F.G, F.bid);
              EpiResidNorm E{xin, args.out, F.H(), nullptr, INF(19) + l * DM, F.XB(), F.PANEL(2 * l)}; pg8::gemm_phase<T, DM, DM, DM, DM>(F.lds, g, S, E, F.tid); }); SEAM();
        RUN({ pg8::Gemm g{F.H(), F.W1_t()}; pg8::StaticOrder<T, FF> S; S.init(F.G, F.bid);
              pg8::EpiGen<FRelu2> E{FRelu2{F.FB()}}; pg8::gemm_phase<T, FF, DM, DM, DM>(F.lds, g, S, E, F.tid); }); SEAM();
        RUN({ pg8::Gemm g{F.FB(), F.W2_t()}; pg8::StaticOrder<T, DM> S; S.init(F.G, F.bid);
              const bool lastl = (l + 1 == DEPTH);
              EpiResidNorm E{args.out, lastl ? (float*)nullptr : args.out, lastl ? (bf16_t*)nullptr : F.H(), lastl ? args.out : (float*)nullptr, lastl ? INF(22) : INF(2) + (l + 1) * DM, F.XB(), F.PANEL(2 * l + 1)};
              pg8::gemm_phase<T, DM, FF, FF, FF>(F.lds, g, S, E, F.tid); }); if (l + 1 < DEPTH) SEAM();
    }
    STAMP();
#ifdef PROBE_LO
    if (F.bid == 0 && F.tid == 0) {
        const int sel[] = PROBE_SEL; unsigned long long tot = 0;
        for (unsigned i = 0; i < sizeof(sel) / sizeof(int); ++i) tot += TSp[sel[i] + 1] - TSp[sel[i]];
        const float us = (float)tot * 0.01f;
        asm volatile("s_waitcnt vmcnt(0)" ::: "memory");
        args.out[0] = sqrtf(us * (float)((size_t)T * DM));
    }
#endif
#undef RUN
#undef SEAM
}

extern "C" void kernel_launch(void* const* d_in, const int* in_sizes, int n_in, void* d_out, int out_size, void* d_ws, size_t ws_size, hipStream_t stream) {
    static int grid = 0;
    if (grid == 0) {
        if (n_in != 23 || out_size != T * DM || ws_size < WS_END) { fprintf(stderr, "kernel_launch: unexpected shapes (n_in %d out %d ws %zu)\n", n_in, out_size, ws_size); grid = -1; return; }
        int dev = 0, cus = 0, per_cu = 0;
        hipGetDevice(&dev); hipDeviceGetAttribute(&cus, hipDeviceAttributeMultiprocessorCount, dev);
        if (hipFuncSetAttribute((const void*)mk_fwd, hipFuncAttributeMaxDynamicSharedMemorySize, LDS_BYTES) != hipSuccess) { fprintf(stderr, "kernel_launch: hipFuncSetAttribute failed\n"); grid = -1; return; }
        if (hipOccupancyMaxActiveBlocksPerMultiprocessor(&per_cu, (const void*)mk_fwd, NTHREADS, LDS_BYTES) != hipSuccess || per_cu < 1) { fprintf(stderr, "kernel_launch: occupancy query says %d\n", per_cu); per_cu = 1; }
        (void)hipGetLastError();
        grid = cus;
    }
    if (grid < 0) return;
    hipMemsetAsync((char*)d_ws + WS_CTL, 0, CTL_ZERO_BYTES, stream);
    Args a{};
    for (int i = 0; i < 23; ++i) a.in[i] = d_in[i];
    a.out = (float*)d_out; a.ws = (unsigned char*)d_ws;
#ifndef MK_SPLIT
    a.ph_lo = 0; a.ph_hi = 1000;
    void* kargs[] = {&a};
    hipError_t e = hipLaunchCooperativeKernel((const void*)mk_fwd, dim3(grid), dim3(NTHREADS), kargs, LDS_BYTES, stream);
    if (e != hipSuccess) fprintf(stderr, "kernel_launch: cooperative launch failed: %s\n", hipGetErrorString(e));
#else
    for (int p = 0; p < 2 * 9 + 2; ++p) { a.ph_lo = p; a.ph_hi = p + 1; hipLaunchKernelGGL(mk_fwd, dim3(grid), dim3(NTHREADS), LDS_BYTES, stream, a); }
#endif
}
```

```cpp
#include <hip/hip_runtime.h>
#include <cstdio>
#include <cstdint>

#define LAS __attribute__((address_space(3)))
#define GAS __attribute__((address_space(1)))
typedef unsigned short bf16_t;
typedef short bf16x8 __attribute__((ext_vector_type(8)));
typedef float f32x4 __attribute__((ext_vector_type(4)));
typedef float f32x2 __attribute__((ext_vector_type(2)));
typedef unsigned u32x4 __attribute__((ext_vector_type(4)));
typedef unsigned u32x2 __attribute__((ext_vector_type(2)));

constexpr int NB = 4, SEQ = 8192, T = NB * SEQ, DM = 1024, DEPTH = 2, FF = 4096;
constexpr int NIN = 5156, NINP = 5376;
constexpr int ZSW = 2112, GW = 3072;
constexpr int ZU = 0, ZDQ = 256, ZDK = 640, ZDV = 704, ZIQ = 768, ZIK = 896, ZIWC = 928, ZRQ = 960, ZRK = 1152, ZRV = 1344, ZRG = 1728, ZGATE = 2112, ZEND = 5184;
constexpr int NFREQ = 36;
constexpr float EPS = 1e-6f;

constexpr size_t MiB = 1u << 20;
constexpr size_t WS_CTL = 0, CTL_ZERO_BYTES = 512 * 1024;
constexpr size_t WS_IW = 1 * MiB;
constexpr size_t WS_SP = 1 * MiB + 512 * 1024;
constexpr size_t WS_ROPE = 2 * MiB;
constexpr size_t WS_S5E = 11 * MiB;
constexpr size_t WS_RST = 15 * MiB;
constexpr size_t WS_W = 51 * MiB;
constexpr size_t WO_IN = 0, WO_ABC = WO_IN + (size_t)NINP * DM * 2, WO_OUT = WO_ABC + (size_t)DM * DM * 2, WO_W1 = WO_OUT + (size_t)DM * DM * 2,
                 WO_W2 = WO_W1 + (size_t)FF * DM * 2, WO_GLU = WO_W2 + (size_t)FF * DM * 2, WO_END = WO_GLU + 256 * 256 * 2;
static_assert(WO_END <= 31 * MiB, "weights");
constexpr size_t WS_H = 82 * MiB;
constexpr size_t WS_ZS = 146 * MiB;
constexpr size_t WS_G = 278 * MiB;
constexpr size_t WS_IKD = 470 * MiB;
constexpr size_t WS_XB = 472 * MiB;
constexpr size_t WS_W1L = 474 * MiB;
constexpr size_t WS_END = 505 * MiB;
static_assert(WS_ZS + (size_t)T * ZSW * 2 <= WS_G && WS_G + (size_t)T * GW * 2 <= WS_END && WS_ZS + (size_t)T * FF * 2 <= WS_END, "ws map");
constexpr int CW_BAR = 1024, CW_LOCAL = 8192, CW_PANEL = 32768;

constexpr int LDS_BYTES = 160 * 1024;
constexpr int RING_BYTES = 131072;
constexpr int MISC_OFF = LDS_BYTES - 256;

__device__ __forceinline__ unsigned f2bf(float f) { unsigned u = __builtin_bit_cast(unsigned, f); return (u + 0x7fffu + ((u >> 16) & 1u)) >> 16; }
__device__ __forceinline__ unsigned pk2(float lo, float hi) { unsigned r; asm("v_cvt_pk_bf16_f32 %0, %1, %2" : "=v"(r) : "v"(lo), "v"(hi)); return r; }
__device__ __forceinline__ float bf2f(unsigned short v) { return __builtin_bit_cast(float, (unsigned)v << 16); }
__device__ __forceinline__ float bflo(unsigned w) { return __builtin_bit_cast(float, w << 16); }
__device__ __forceinline__ float bfhi(unsigned w) { return __builtin_bit_cast(float, w & 0xffff0000u); }
__device__ __forceinline__ float sigmoidf_(float x) { return __builtin_amdgcn_rcpf(1.0f + __expf(-x)); }
__device__ __forceinline__ float wave_sum(float v) {
#pragma unroll
    for (int o = 1; o < 64; o <<= 1) v += __shfl_xor(v, o);
    return v;
}
__device__ __forceinline__ float wave_max(float v) {
#pragma unroll
    for (int o = 1; o < 64; o <<= 1) v = fmaxf(v, __shfl_xor(v, o));
    return v;
}

#define XB_TMO      128
#define XB_XCNT(j)  (256  + 64 * (j))
#define XB_XSUB(j)  (1280 + 64 * (j))
#define XB_XGEN(j)  (2304 + 64 * (j))
#define XB_TOP      3328
#define XB_TOPGEN   3392
#define XCD_BAR_WORDS 3456
#define XB_SPIN_CAP (1u << 18)
__device__ __forceinline__ unsigned xb_ld(unsigned* p)              { return __hip_atomic_load(p, __ATOMIC_RELAXED, __HIP_MEMORY_SCOPE_AGENT); }
__device__ __forceinline__ unsigned xb_add(unsigned* p, unsigned v) { return __hip_atomic_fetch_add(p, v, __ATOMIC_RELAXED, __HIP_MEMORY_SCOPE_AGENT); }
__device__ __forceinline__ unsigned xb_xcc_id() { return (unsigned)__builtin_amdgcn_s_getreg((3 << 11) | 20) & 0xFu; }
#define XB_SPIN(cond, bar) do { unsigned _sp = 0; while (cond) { __builtin_amdgcn_s_sleep(1); \
    if ((++_sp & 255u) == 0u) { if (xb_ld(&(bar)[XB_TMO])) break; if (_sp > XB_SPIN_CAP) { atomicAdd(&(bar)[XB_TMO], 1u); break; } } } } while (0)
struct XcdBarrier { unsigned* bar; unsigned x; volatile LAS unsigned* st; };
__device__ __forceinline__ XcdBarrier xcd_barrier_post(unsigned* bar, volatile LAS unsigned* st) {
    XcdBarrier b; b.bar = bar; b.x = xb_xcc_id(); b.st = st;
    if (threadIdx.x == 0) (void)xb_add(&bar[XB_XCNT(b.x)], 1u);
    return b;
}
__device__ __forceinline__ void xcd_barrier_complete(unsigned* bar, unsigned x, unsigned& nloc, unsigned& nx) {
    const unsigned G = gridDim.x * gridDim.y * gridDim.z;
    unsigned sum, cnt, mine, sp = 0u;
    for (;;) {
        sum = 0u; cnt = 0u; mine = 0u;
#pragma unroll
        for (unsigned j = 0; j < 16; ++j) { const unsigned c = xb_ld(&bar[XB_XCNT(j)]); sum += c; cnt += (c > 0u) ? 1u : 0u; mine = (j == x) ? c : mine; }
        if (sum == G) break;
        __builtin_amdgcn_s_sleep(1);
        if ((++sp & 255u) == 0u) { if (xb_ld(&bar[XB_TMO])) break; if (sp > XB_SPIN_CAP) { atomicAdd(&bar[XB_TMO], 1u); break; } }
    }
    nloc = mine > 0u ? mine : 1u; nx = cnt > 0u ? cnt : 1u;
}
__device__ __forceinline__ void xcd_barrier(const XcdBarrier& b, bool leader) {
    asm volatile("s_waitcnt vmcnt(0)" ::: "memory");
    __syncthreads();
    if (leader) {
        unsigned* bar = b.bar; unsigned bx = b.x;
        asm volatile("" : "+s"(bar), "+s"(bx));
        __builtin_amdgcn_s_waitcnt(0);
        unsigned nloc = b.st[0], nx = b.st[1];
        if (nloc == 0u) { xcd_barrier_complete(bar, bx, nloc, nx); b.st[0] = nloc; b.st[1] = nx; }
        const unsigned old = xb_add(&bar[XB_XSUB(bx)], 1u);
        const unsigned gen = old / nloc;
        if (old + 1u == (gen + 1u) * nloc) {
            __builtin_amdgcn_fence(__ATOMIC_RELEASE, "agent");
            asm volatile("s_waitcnt vmcnt(0)" ::: "memory");
            const unsigned og = xb_add(&bar[XB_TOP], 1u);
            const unsigned tg = og / nx;
            if (og + 1u == (tg + 1u) * nx) xb_add(&bar[XB_TOPGEN], 1u);
            else XB_SPIN(xb_ld(&bar[XB_TOPGEN]) == tg, bar);
            __builtin_amdgcn_fence(__ATOMIC_ACQUIRE, "agent");
            xb_add(&bar[XB_XGEN(bx)], 1u);
            asm volatile("s_waitcnt vmcnt(0)" ::: "memory");
        } else {
            XB_SPIN(xb_ld(&bar[XB_XGEN(bx)]) == gen, bar);
            __builtin_amdgcn_fence(__ATOMIC_ACQUIRE, "agent");
            asm volatile("s_waitcnt vmcnt(0)" ::: "memory");
        }
    }
    __syncthreads();
}

namespace pg8 {
constexpr int BM = 256, BK = 64, HALF = 128, HTB = HALF * BK * 2, STAGE_BYTES = 8 * HTB, NXCD = 8, WGM = 8;
__host__ __device__ __forceinline__ int lds_byte(int r, int c) { const int st = (r >> 4) * 2 + (c >> 5), rr = r & 15, cc = c & 31, ob = rr * 64 + cc * 2; return st * 1024 + (ob ^ (((ob >> 9) & 1) << 5)); }
__host__ __device__ __forceinline__ void stage_rc(int b, int& R, int& C) { const int st = b / 1024, sb = b % 1024, swz = sb ^ (((sb >> 9) & 1) << 5); R = (st >> 1) * 16 + swz / 64; C = (st & 1) * 32 + (swz % 64) / 2; }
__host__ __device__ __forceinline__ int perm32(int rho) { const int n = rho >> 4, i = rho & 15; return 8 * (i >> 2) + 4 * n + (i & 3); }

struct Unit { int pm, pn; };
struct Gemm { const bf16_t* A; const bf16_t* Bt; };

template <int M, int N> struct StaticOrder {
    static constexpr int nM = M / BM, nN = N / BM, nwg = nM * nN;
    int G, c;
    __host__ __device__ void init(int G_, int c_) { G = G_; c = c_; }
    __host__ __device__ bool next(int i, Unit& u) const {
        const long L = (long)i * G + c; if (L >= nwg) return false;
        int wgid = (int)L; { constexpr int q = nwg / NXCD, r = nwg % NXCD; const int xcd = wgid % NXCD, off = wgid / NXCD; wgid = (xcd < r ? xcd * (q + 1) : r * (q + 1) + (xcd - r) * q) + off; }
        constexpr int nig = WGM * nN; const int gid = wgid / nig, fm = gid * WGM, gsz = (nM - fm) < WGM ? (nM - fm) : WGM;
        u.pm = fm + ((wgid % nig) % gsz); u.pn = (wgid % nig) / gsz; return true;
    }
};

template <class F, int FENCE = 0> struct EpiGen {
    static constexpr bool PERM = true, HAS_MID = false, FUSED = false;
    F f;
    __device__ __forceinline__ void operator()(const f32x4 (&acc)[2][2][4][2], const Unit& u, int wr, int wc, int fr, int fq) const {
        const int row0 = u.pm * BM + wr * 64 + fr, col0 = u.pn * BM + wc * 32 + 8 * fq;
#pragma unroll
        for (int ai = 0; ai < 2; ++ai)
#pragma unroll
            for (int m = 0; m < 4; ++m)
#pragma unroll
                for (int bj = 0; bj < 2; ++bj) { f(row0 + ai * HALF + m * 16, col0 + bj * HALF, acc[ai][bj][m][0], acc[ai][bj][m][1]);
                    if constexpr (FENCE > 0) { if (((ai * 4 + m) * 2 + bj) % FENCE == FENCE - 1) asm volatile("" ::: "memory"); } }
    }
};

template <int M, int N, int K, int LDA, int LDB, class Epi, bool ALIGN_EPI = true>
__device__ __forceinline__ void gemm_phase(LAS unsigned char* lds, const Gemm g, const StaticOrder<M, N>& S, const Epi& E, int tid_in) {
    int tid = tid_in; asm volatile("" : "+v"(tid));
    const int wid = __builtin_amdgcn_readfirstlane(tid >> 6), lane = tid & 63, wr = wid >> 2, wc = wid & 3, fr = lane & 15, fq = lane >> 4;
    constexpr int nt = K / BK;
    unsigned voffA[2], voffB[2];
#pragma unroll
    for (int i = 0; i < 2; ++i) { int R, C; stage_rc(tid * 16 + i * 8192, R, C); const int Rb = Epi::PERM ? ((R & ~31) + perm32(R & 31)) : R;
        voffA[i] = (unsigned)(R * LDA + C) * 2u; voffB[i] = (unsigned)(Rb * LDB + C) * 2u; }
    constexpr size_t kstep = (size_t)(BK * 2);
    constexpr size_t hstepA = (size_t)HALF * LDA * 2, hstepB = (size_t)HALF * LDB * 2;
    constexpr size_t tstepA = 2 * hstepA, tstepB = 2 * hstepB;
    const unsigned ldsw = (unsigned)wid * 1024u;
    const int aoff = lds_byte(wr * 64 + fr, fq * 8), boff = lds_byte(wc * 32 + fr, fq * 8);
#define PG8_SA(b, h) (((b) * 2 + (h)) * HTB)
#define PG8_SB(b, h) ((4 + (b) * 2 + (h)) * HTB)
#define PG8_STAGE(bufoff, gbase, voff) do { _Pragma("unroll") for (int _i = 0; _i < 2; ++_i) \
        __builtin_amdgcn_global_load_lds((const unsigned*)((const char*)(gbase) + (voff)[_i]), (LAS unsigned*)(lds + (bufoff) + ldsw + _i * 8192), 16, 0, 0); } while (0)
#define PG8_LDA(dst, b, h) do { _Pragma("unroll") for (int m = 0; m < 4; ++m) _Pragma("unroll") for (int k = 0; k < 2; ++k) dst[m][k] = *(const LAS bf16x8*)(lds + PG8_SA(b, h) + aoff + m * 2048 + k * 1024); } while (0)
#define PG8_LDB(dst, b, h) do { _Pragma("unroll") for (int n = 0; n < 2; ++n) _Pragma("unroll") for (int k = 0; k < 2; ++k) dst[n][k] = *(const LAS bf16x8*)(lds + PG8_SB(b, h) + boff + n * 2048 + k * 1024); } while (0)
#define PG8_MMA(ai, bj, At, Bt) do { __builtin_amdgcn_s_setprio(1); _Pragma("unroll") for (int m = 0; m < 4; ++m) _Pragma("unroll") for (int n = 0; n < 2; ++n) _Pragma("unroll") for (int k = 0; k < 2; ++k) \
        acc[ai][bj][m][n] = __builtin_amdgcn_mfma_f32_16x16x32_bf16(Bt[n][k], At[m][k], acc[ai][bj][m][n], 0, 0, 0); __builtin_amdgcn_s_setprio(0); } while (0)
#define PG8_WAIT_V(n) asm volatile("s_waitcnt vmcnt(" #n ")" ::: "memory")
#define PG8_WAIT_L(n) asm volatile("s_waitcnt lgkmcnt(" #n ")" ::: "memory")
#define PG8_BAR __builtin_amdgcn_s_barrier()
#define PG8_SCHED __builtin_amdgcn_sched_barrier(0)
    Unit cur, nxt; int ui = 0;
    if (!S.next(0, cur)) return;
    f32x4 acc[2][2][4][2];
#pragma unroll
    for (int a = 0; a < 2; ++a)
#pragma unroll
        for (int b = 0; b < 2; ++b)
#pragma unroll
            for (int m = 0; m < 4; ++m)
#pragma unroll
                for (int n = 0; n < 2; ++n) acc[a][b][m][n] = (f32x4){0.f, 0.f, 0.f, 0.f};
    bf16x8 At[4][2], B0[2][2], B1[2][2];
    const char* cA = (const char*)g.A + (size_t)cur.pm * tstepA; const char* cB = (const char*)g.Bt + (size_t)cur.pn * tstepB;
    PG8_STAGE(PG8_SB(0, 0), cB, voffB); PG8_STAGE(PG8_SB(0, 1), cB + hstepB, voffB); PG8_STAGE(PG8_SA(0, 0), cA, voffA); PG8_STAGE(PG8_SA(0, 1), cA + hstepA, voffA);
    if (wr == 1) PG8_BAR;
    PG8_WAIT_V(2); PG8_BAR;
    PG8_STAGE(PG8_SB(1, 0), cB + kstep, voffB); PG8_STAGE(PG8_SA(1, 0), cA + kstep, voffA); PG8_STAGE(PG8_SB(1, 1), cB + hstepB + kstep, voffB);
    PG8_WAIT_V(6); PG8_BAR;
    for (;;) {
        const bool has_next = S.next(ui + 1, nxt);
        const char* nA = has_next ? (const char*)g.A + (size_t)nxt.pm * tstepA : cA; const char* nB = has_next ? (const char*)g.Bt + (size_t)nxt.pn * tstepB : cB;
#pragma unroll 1
        for (int t = 0; t < nt; t += 2) {
            const bool last = (t == nt - 2);
            const char* a1 = cA + (size_t)(t + 1) * kstep;
            const char* a2 = last ? nA : cA + (size_t)(t + 2) * kstep; const char* b2 = last ? nB : cB + (size_t)(t + 2) * kstep;
            const char* a3 = a2 + kstep; const char* b3 = b2 + kstep;
            if constexpr (Epi::HAS_MID) { if (t == Epi::MID0 || t == Epi::MID1) E.mid(acc, cur, t, wr, wc, fr, fq); }
            PG8_LDB(B0, 0, 0); PG8_LDB(B1, 0, 1); PG8_SCHED; PG8_LDA(At, 0, 0); PG8_STAGE(PG8_SA(1, 1), a1 + hstepA, voffA);
            PG8_WAIT_V(8); PG8_WAIT_L(0); PG8_BAR; PG8_MMA(0, 0, At, B0); PG8_MMA(0, 1, At, B1); PG8_BAR; PG8_SCHED;
            PG8_LDA(At, 0, 1); PG8_STAGE(PG8_SB(0, 0), b2, voffB); PG8_STAGE(PG8_SB(0, 1), b2 + hstepB, voffB); PG8_STAGE(PG8_SA(0, 0), a2, voffA);
            PG8_WAIT_V(8); PG8_WAIT_L(0); PG8_BAR; PG8_MMA(1, 0, At, B0); PG8_MMA(1, 1, At, B1); PG8_BAR; PG8_SCHED;
            PG8_LDB(B0, 1, 0); PG8_LDB(B1, 1, 1); PG8_SCHED; PG8_LDA(At, 1, 0); PG8_STAGE(PG8_SA(0, 1), a2 + hstepA, voffA);
            PG8_WAIT_V(8); PG8_WAIT_L(0); PG8_BAR; PG8_MMA(0, 0, At, B0); PG8_MMA(0, 1, At, B1); PG8_BAR; PG8_SCHED;
            PG8_LDA(At, 1, 1); PG8_STAGE(PG8_SB(1, 0), b3, voffB); PG8_STAGE(PG8_SB(1, 1), b3 + hstepB, voffB); PG8_STAGE(PG8_SA(1, 0), a3, voffA);
            PG8_WAIT_V(8); PG8_WAIT_L(0); PG8_BAR; PG8_MMA(1, 0, At, B0); PG8_MMA(1, 1, At, B1); PG8_BAR; PG8_SCHED;
        }
        if constexpr (ALIGN_EPI) { if (wr == 0) PG8_BAR; }
        if constexpr (Epi::FUSED) E.fused(acc, cur, wr, wc, fr, fq, lds, wid, lane); else E(acc, cur, wr, wc, fr, fq);
        if (!has_next) break;
#pragma unroll
        for (int a = 0; a < 2; ++a)
#pragma unroll
            for (int b = 0; b < 2; ++b)
#pragma unroll
                for (int m = 0; m < 4; ++m)
#pragma unroll
                    for (int n = 0; n < 2; ++n) acc[a][b][m][n] = (f32x4){0.f, 0.f, 0.f, 0.f};
        cur = nxt; cA = nA; cB = nB; ++ui;
        if constexpr (ALIGN_EPI) { if (wr == 1) PG8_BAR; }
    }
    PG8_WAIT_V(0);
    if constexpr (!ALIGN_EPI) { if (wr == 0) PG8_BAR; }
    PG8_BAR;
#undef PG8_SA
#undef PG8_SB
#undef PG8_STAGE
#undef PG8_LDA
#undef PG8_LDB
#undef PG8_MMA
#undef PG8_WAIT_V
#undef PG8_WAIT_L
#undef PG8_BAR
#undef PG8_SCHED
}
}

constexpr int NWAVES = 8, NTHREADS = 512;
struct Args { const void* in[23]; float* out; unsigned char* ws; int ph_lo, ph_hi; };
struct Frame {
    LAS unsigned char* lds;
    int tid, lane, wave, G, bid;
    unsigned char* wsb; unsigned zo; unsigned wl;
    __device__ __forceinline__ bf16_t* IKD() const { return (bf16_t*)(wsb + zo + WS_IKD); }
    __device__ __forceinline__ float* XB() const { return (float*)(wsb + zo + WS_XB); }
    __device__ __forceinline__ unsigned* PANEL(int bank) const { return (unsigned*)(wsb + zo + WS_CTL) + CW_PANEL + bank * 8192; }
    __device__ __forceinline__ float* IW() const { return (float*)(wsb + zo + WS_IW); }
    __device__ __forceinline__ float* SP(int l) const { return (float*)(wsb + zo + WS_SP) + l * 36864; }
    __device__ __forceinline__ f32x2* ROPE() const { return (f32x2*)(wsb + zo + WS_ROPE); }
    __device__ __forceinline__ f32x2* S5E() const { return (f32x2*)(wsb + zo + WS_S5E); }
    __device__ __forceinline__ float* RST() const { return (float*)(wsb + zo + WS_RST); }
    __device__ __forceinline__ bf16_t* Win_t() const { return (bf16_t*)(wsb + zo + wl + WS_W + WO_IN); }
    __device__ __forceinline__ bf16_t* Wabc_t() const { return (bf16_t*)(wsb + zo + wl + WS_W + WO_ABC); }
    __device__ __forceinline__ bf16_t* Wout_t() const { return (bf16_t*)(wsb + zo + wl + WS_W + WO_OUT); }
    __device__ __forceinline__ bf16_t* W1_t() const { return (bf16_t*)(wsb + zo + wl + WS_W + WO_W1); }
    __device__ __forceinline__ bf16_t* W2_t() const { return (bf16_t*)(wsb + zo + wl + WS_W + WO_W2); }
    __device__ __forceinline__ bf16_t* Wglu_t() const { return (bf16_t*)(wsb + zo + wl + WS_W + WO_GLU); }
    __device__ __forceinline__ bf16_t* H() const { return (bf16_t*)(wsb + zo + WS_H); }
    __device__ __forceinline__ bf16_t* ZS() const { return (bf16_t*)(wsb + zo + WS_ZS); }
    __device__ __forceinline__ unsigned char* GB() const { return wsb + zo + WS_G; }
    __device__ __forceinline__ bf16_t* MG() const { return (bf16_t*)(wsb + zo + WS_ZS); }
    __device__ __forceinline__ bf16_t* FB() const { return (bf16_t*)(wsb + zo + WS_ZS); }
};
constexpr int SP_LB = 0, SP_L64 = 2048, SP_BBR = 4096, SP_BBI = 4096 + 16384;

__device__ __forceinline__ int ropeperm(int j, int r) { const int half = r >> 1; return (j < r) ? ((j & 1) ? half + (j >> 1) : (j >> 1)) : j; }
__device__ __forceinline__ int zmap(int n) {
    if (n < ZDQ) return n;
    if (n < ZDK) { const int q = n - ZDQ, h = q >> 6, hc = q & 63; return 256 + h * 64 + ropeperm(hc, 16); }
    if (n < ZDV) return 640 + ropeperm(n - ZDK, 16);
    if (n < ZIQ) return 704 + (n - ZDV);
    if (n < ZIK) { const int q = n - ZIQ, h = q >> 5, hc = q & 31; return 768 + h * 32 + ropeperm(hc, 8); }
    if (n < ZIWC) return 896 + ropeperm(n - ZIK, 8);
    if (n < ZRQ) return (n - ZIWC) < 4 ? 928 + (n - ZIWC) : -1;
    if (n < ZRK) { const int q = n - ZRQ, h = q / 48, hc = q % 48; return 932 + h * 48 + ropeperm(hc, 48); }
    if (n < ZRV) { const int q = n - ZRK, h = q / 48, hc = q % 48; return 1124 + h * 48 + ropeperm(hc, 48); }
    if (n < ZRG) return 1316 + (n - ZRV);
    if (n < ZGATE) return 1700 + (n - ZRG);
    if (n < ZEND) return 2084 + (n - ZGATE);
    return -1;
}

__device__ __forceinline__ void tr_item(const float* W, int N, int kb, int nb, bf16_t* WT, int ldd, int koff, bool mapped, LAS float* scr, int lane) {
    const int k0 = 64 * kb, n0 = 32 * nb;
    const int c32 = lane & 31; int sc = n0 + c32; if (mapped) sc = zmap(sc);
#pragma unroll 8
    for (int i = 0; i < 32; ++i) { const int kk = 2 * i + (lane >> 5); scr[kk * 33 + c32] = (sc >= 0) ? W[(size_t)(k0 + kk) * N + sc] : 0.f; }
    asm volatile("s_waitcnt lgkmcnt(0)" ::: "memory");
    const int c = lane & 7;
#pragma unroll
    for (int j = 0; j < 4; ++j) { const int n = (lane >> 3) + 8 * j; const LAS float* s = scr + (8 * c) * 33 + n;
        u32x4 o; o.x = pk2(s[0 * 33], s[1 * 33]); o.y = pk2(s[2 * 33], s[3 * 33]); o.z = pk2(s[4 * 33], s[5 * 33]); o.w = pk2(s[6 * 33], s[7 * 33]);
        *(u32x4*)(WT + (size_t)(n0 + n) * ldd + koff + k0 + 8 * c) = o; }
    asm volatile("s_waitcnt lgkmcnt(0)" ::: "memory");
}

__device__ __forceinline__ void rms_row_bf16(const float* xrow, const float* gain, bf16_t* orow, int lane) {
    const f32x4* xr = (const f32x4*)xrow + lane; const f32x4* gr = (const f32x4*)gain + lane;
    f32x4 v[4]; float s = 0.f;
#pragma unroll
    for (int j = 0; j < 4; ++j) { v[j] = xr[64 * j]; s += (v[j].x * v[j].x + v[j].y * v[j].y) + (v[j].z * v[j].z + v[j].w * v[j].w); }
    const float rstd = rsqrtf(wave_sum(s) * (1.f / DM) + EPS);
    u32x2* o8 = (u32x2*)orow + lane;
#pragma unroll
    for (int j = 0; j < 4; ++j) { const f32x4 gg = gr[64 * j]; u32x2 w; w.x = pk2(v[j].x * rstd * gg.x, v[j].y * rstd * gg.y); w.y = pk2(v[j].z * rstd * gg.z, v[j].w * rstd * gg.w); o8[64 * j] = w; }
}
__device__ __forceinline__ void rms_row_f32(const float* xrow, const float* gain, float* orow, int lane) {
    const f32x4* xr = (const f32x4*)xrow + lane; const f32x4* gr = (const f32x4*)gain + lane;
    f32x4 v[4]; float s = 0.f;
#pragma unroll
    for (int j = 0; j < 4; ++j) { v[j] = xr[64 * j]; s += (v[j].x * v[j].x + v[j].y * v[j].y) + (v[j].z * v[j].z + v[j].w * v[j].w); }
    const float rstd = rsqrtf(wave_sum(s) * (1.f / DM) + EPS);
    f32x4* o = (f32x4*)orow + lane;
#pragma unroll
    for (int j = 0; j < 4; ++j) { const f32x4 gg = gr[64 * j]; o[64 * j] = v[j] * rstd * gg; }
}


__device__ __forceinline__ void phase_rope(Frame& F, const int* pos) {
    const int gt = F.bid * NTHREADS + F.tid, NT = F.G * NTHREADS;
    f32x2* RT = F.ROPE();
    for (int e = gt; e < T * NFREQ; e += NT) {
        const int tok = e / NFREQ, f = e % NFREQ;
        float lth, sc; int fi;
        if (f < 8) { lth = 13.122363377404328f; sc = 2.0f / 16.0f; fi = f; } else if (f < 12) { lth = 13.122363377404328f; sc = 2.0f / 8.0f; fi = f - 8; } else { lth = 9.210340371976184f; sc = 2.0f / 48.0f; fi = f - 12; }
        const float inv = expf(-lth * (float)fi * sc);
        const float p = (float)pos[tok];
        const float ang = p * inv;
        const float kq = rintf(ang * 0.15915494309189535f);
        float r = fmaf(-kq, 6.2831854820251465f, ang);
        r = fmaf(-kq, -1.7484555e-7f, r);
        RT[e] = (f32x2){cosf(r), sinf(r)};
    }
}

struct ProIn { const float *xin, *norm1_g, *w_in, *wa, *wb, *wc, *wo, *w1, *w2, *wg, *lam_re, *lam_im, *log_step, *b_re, *b_im; const int* pos; };
__device__ __forceinline__ void phase_prologue(Frame& F, const ProIn& I) {
#ifdef NO_PHASE_PROLOGUE
    return;
#endif
    LAS float* scr = (LAS float*)(F.lds + F.wave * 16384);
    const int gw = F.bid * NWAVES + F.wave, NGW = F.G * NWAVES;
#pragma unroll 1
    for (int l = 0; l < DEPTH; ++l) {
    F.wl = l ? (unsigned)(WS_W1L - WS_W) : 0u;
    constexpr int I_IN = 16 * (NINP / 32), I_A = 4 * 32, I_B = 6 * 32, I_C = 6 * 32, I_O = 16 * 32, I_1 = 16 * 128, I_2 = 64 * 32, I_G = 4 * 8;
    constexpr int NITEMS = I_IN + I_A + I_B + I_C + I_O + I_1 + I_2 + I_G;
    const float* w_in = I.w_in + (size_t)l * DM * NIN; const float* wa = I.wa + (size_t)l * 256 * DM; const float* wb = I.wb + (size_t)l * 384 * DM;
    const float* wc = I.wc + (size_t)l * 384 * DM; const float* wo = I.wo + (size_t)l * DM * DM; const float* w1 = I.w1 + (size_t)l * DM * FF;
    const float* w2 = I.w2 + (size_t)l * FF * DM; const float* wg = I.wg + (size_t)l * 256 * 256;
    for (int it = gw; it < NITEMS; it += NGW) {
        int r = it;
        if (r < I_IN) { tr_item(w_in, NIN, r / (NINP / 32), r % (NINP / 32), F.Win_t(), DM, 0, true, scr, F.lane); continue; } r -= I_IN;
        if (r < I_A) { tr_item(wa, DM, r / 32, r % 32, F.Wabc_t(), DM, 0, false, scr, F.lane); continue; } r -= I_A;
        if (r < I_B) { tr_item(wb, DM, r / 32, r % 32, F.Wabc_t(), DM, 256, false, scr, F.lane); continue; } r -= I_B;
        if (r < I_C) { tr_item(wc, DM, r / 32, r % 32, F.Wabc_t(), DM, 640, false, scr, F.lane); continue; } r -= I_C;
        if (r < I_O) { tr_item(wo, DM, r / 32, r % 32, F.Wout_t(), DM, 0, false, scr, F.lane); continue; } r -= I_O;
        if (r < I_1) { tr_item(w1, FF, r / 128, r % 128, F.W1_t(), DM, 0, false, scr, F.lane); continue; } r -= I_1;
        if (r < I_2) { tr_item(w2, DM, r / 32, r % 32, F.W2_t(), FF, 0, false, scr, F.lane); continue; } r -= I_2;
        tr_item(wg, 256, r / 8, r % 8, F.Wglu_t(), 256, 0, false, scr, F.lane);
    }
    {
        const int gt = F.bid * NTHREADS + F.tid;
        if (gt < 1024) {
            float* SPp = F.SP(l);
            const int g = gt >> 6, p = gt & 63;
            const float lr = I.lam_re[(l * 16 + g) * 64 + p], li = I.lam_im[(l * 16 + g) * 64 + p];
            const float step = expf(I.log_step[l * 16 + g]);
            const float mag = expf(lr * step); const float lbr = mag * cosf(li * step), lbi = mag * sinf(li * step);
            const float den = lr * lr + li * li;
            const float fr = ((lbr - 1.f) * lr + lbi * li) / den, fi = (lbi * lr - (lbr - 1.f) * li) / den;
            SPp[SP_LB + gt * 2] = lbr; SPp[SP_LB + gt * 2 + 1] = lbi;
            float pr = lbr, pi = lbi;
#pragma unroll
            for (int s = 0; s < 6; ++s) { const float nr = pr * pr - pi * pi, ni = 2.f * pr * pi; pr = nr; pi = ni; }
            SPp[SP_L64 + gt * 2] = pr; SPp[SP_L64 + gt * 2 + 1] = pi;
            const float* br = I.b_re + ((size_t)(l * 16 + g) * 64 + p) * 16; const float* bi = I.b_im + ((size_t)(l * 16 + g) * 64 + p) * 16;
#pragma unroll
            for (int c = 0; c < 16; ++c) { SPp[SP_BBR + gt * 16 + c] = fr * br[c] - fi * bi[c]; SPp[SP_BBI + gt * 16 + c] = fr * bi[c] + fi * br[c]; }
        }
    }
    }
    F.wl = 0u;
    for (int m = gw; m < T; m += NGW) rms_row_bf16(I.xin + (size_t)m * DM, I.norm1_g, F.H() + (size_t)m * DM, F.lane);
}

__device__ __forceinline__ u32x4 pack8(const f32x4& a, const f32x4& b) { u32x4 w; w.x = pk2(a.x, a.y); w.y = pk2(a.z, a.w); w.z = pk2(b.x, b.y); w.w = pk2(b.z, b.w); return w; }
__device__ __forceinline__ void unpack8(const u32x4& w, f32x4& a, f32x4& b) { a = (f32x4){bflo(w.x), bfhi(w.x), bflo(w.y), bfhi(w.y)}; b = (f32x4){bflo(w.z), bfhi(w.z), bflo(w.w), bfhi(w.w)}; }

__device__ __forceinline__ unsigned gate1_u8(float x) { const float s = 255.f * sigmoidf_(x) + 0.5f; const unsigned u = (unsigned)s; return u < 1u ? 1u : u; }
__device__ __forceinline__ unsigned gate4_u8(const f32x4& a) { return gate1_u8(a.x) | (gate1_u8(a.y) << 8) | (gate1_u8(a.z) << 16) | (gate1_u8(a.w) << 24); }
__device__ __forceinline__ void ungate8(const u32x2& w, f32x4& a, f32x4& b) {
    a = (f32x4){(float)(w.x & 255u), (float)((w.x >> 8) & 255u), (float)((w.x >> 16) & 255u), (float)(w.x >> 24)};
    b = (f32x4){(float)(w.y & 255u), (float)((w.y >> 8) & 255u), (float)((w.y >> 16) & 255u), (float)(w.y >> 24)};
}
struct FInProj {
    bf16_t* ZS; unsigned char* GB; float* IW; const f32x2* ROPE; bf16_t* IKD;
    __device__ __forceinline__ void rope8(f32x4& a, f32x4& b, int row, int f0) const {
        const f32x2* rt = ROPE + (size_t)row * NFREQ + f0;
        const f32x2 c0 = rt[0], c1 = rt[1], c2 = rt[2], c3 = rt[3];
        f32x4 oa, ob;
        oa.x = a.x * c0.x - a.y * c0.y; oa.y = a.y * c0.x + a.x * c0.y;
        oa.z = a.z * c1.x - a.w * c1.y; oa.w = a.w * c1.x + a.z * c1.y;
        ob.x = b.x * c2.x - b.y * c2.y; ob.y = b.y * c2.x + b.x * c2.y;
        ob.z = b.z * c3.x - b.w * c3.y; ob.w = b.w * c3.x + b.z * c3.y;
        a = oa; b = ob;
    }
    __device__ __forceinline__ void operator()(int row, int col, f32x4 a, f32x4 b) const {
        if (col >= ZEND) return;
        if (col >= ZGATE) {
            *(u32x2*)(GB + (size_t)row * GW + (col - ZGATE)) = (u32x2){gate4_u8(a), gate4_u8(b)}; return;
        }
        if (col >= ZIWC && col < ZRQ) { if (col == ZIWC) *(f32x4*)(IW + (size_t)row * 4) = a; return; }
        if (col >= ZDQ && col < ZDV) { const int hc = (col - ZDQ) & 63; if (hc < 16) rope8(a, b, row, hc >> 1); }
        else if (col >= ZIQ && col < ZIWC) { const int hc = (col - ZIQ) & 31; if (hc < 8) rope8(a, b, row, 8);
            if (col >= ZIK) { *(u32x4*)(IKD + ((size_t)((row >> 5) * 4 + ((col - ZIK) >> 3)) * 32 + (row & 31)) * 8) = pack8(a, b); return; } }
        else if (col >= ZRQ && col < ZRV) { const int hc = (col - ZRQ) % 48; rope8(a, b, row, 12 + (hc >> 1)); }
        *(u32x4*)(ZS + (size_t)row * ZSW + col) = pack8(a, b);
    }
};
struct FMerge {
    bf16_t* MG; const bf16_t* GB; int br;
    __device__ __forceinline__ void operator()(int row, int col, f32x4 a, f32x4 b) const {
        f32x4 ga, gb; unpack8(*(const u32x4*)(GB + (size_t)row * GW + br * DM + col), ga, gb);
        a = a * ga; b = b * gb;
        u32x4* mp = (u32x4*)(MG + (size_t)row * DM + col);
        if (br != 0) { f32x4 pa, pb; unpack8(*mp, pa, pb); a = a + pa; b = b + pb; }
        *mp = pack8(a, b);
    }
};
struct FResid {
    const float* base; float* out;
    __device__ __forceinline__ void operator()(int row, int col, f32x4 a, f32x4 b) const {
        const f32x4* bp = (const f32x4*)(base + (size_t)row * DM + col); f32x4* op = (f32x4*)(out + (size_t)row * DM + col);
        const f32x4 b0 = bp[0], b1 = bp[1]; op[0] = b0 + a; op[1] = b1 + b;
    }
};
struct FRelu2 {
    bf16_t* FB;
    __device__ __forceinline__ void operator()(int row, int col, f32x4 a, f32x4 b) const {
        a = (f32x4){fmaxf(a.x, 0.f), fmaxf(a.y, 0.f), fmaxf(a.z, 0.f), fmaxf(a.w, 0.f)}; b = (f32x4){fmaxf(b.x, 0.f), fmaxf(b.y, 0.f), fmaxf(b.z, 0.f), fmaxf(b.w, 0.f)};
        *(u32x4*)(FB + (size_t)row * FF + col) = pack8(a * a, b * b);
    }
};
struct FGlu {
    bf16_t* H; const float* bias;
    __device__ __forceinline__ void operator()(int row, int col, f32x4 a, f32x4 b) const {
        u32x4* hp = (u32x4*)(H + (size_t)row * DM + col); f32x4 ya, yb; unpack8(*hp, ya, yb);
        const f32x4 ba = *(const f32x4*)(bias + col), bb = *(const f32x4*)(bias + col + 4);
        a = a + ba; b = b + bb;
        a = (f32x4){ya.x * sigmoidf_(a.x), ya.y * sigmoidf_(a.y), ya.z * sigmoidf_(a.z), ya.w * sigmoidf_(a.w)};
        b = (f32x4){yb.x * sigmoidf_(b.x), yb.y * sigmoidf_(b.y), yb.z * sigmoidf_(b.z), yb.w * sigmoidf_(b.w)};
        *hp = pack8(a, b);
    }
};

struct EpiMerge {
    static constexpr bool PERM = true, HAS_MID = true, FUSED = false; static constexpr int MID0 = 4, MID1 = 10;
    bf16_t* MG; const unsigned char* GB;
    __device__ __forceinline__ void mid(f32x4 (&acc)[2][2][4][2], const pg8::Unit& u, int t, int wr, int wc, int fr, int fq) const {
        int zz = 0; asm volatile("" : "+v"(zz));
        const int row0 = u.pm * 256 + wr * 64 + fr + zz, col0 = u.pn * 256 + wc * 32 + 8 * fq, bp = (t == MID0) ? 0 : 1;
#pragma unroll
        for (int ai = 0; ai < 2; ++ai)
#pragma unroll
            for (int m = 0; m < 4; ++m) {
#pragma unroll
                for (int bj = 0; bj < 2; ++bj) {
                    const unsigned char* gp = GB + (size_t)(row0 + ai * 128 + m * 16) * GW + bp * DM + col0 + bj * 128;
                    f32x4 pa, pb, na, nb; ungate8(*(const u32x2*)gp, pa, pb); ungate8(*(const u32x2*)(gp + DM), na, nb);
                    const f32x4 fa = {pa.x * __builtin_amdgcn_rcpf(na.x), pa.y * __builtin_amdgcn_rcpf(na.y), pa.z * __builtin_amdgcn_rcpf(na.z), pa.w * __builtin_amdgcn_rcpf(na.w)};
                    const f32x4 fb = {pb.x * __builtin_amdgcn_rcpf(nb.x), pb.y * __builtin_amdgcn_rcpf(nb.y), pb.z * __builtin_amdgcn_rcpf(nb.z), pb.w * __builtin_amdgcn_rcpf(nb.w)};
                    acc[ai][bj][m][0] = acc[ai][bj][m][0] * fa; acc[ai][bj][m][1] = acc[ai][bj][m][1] * fb;
                }
                if (m == 3) asm volatile("" ::: "memory");
            }
    }
    __device__ __forceinline__ void operator()(const f32x4 (&acc)[2][2][4][2], const pg8::Unit& u, int wr, int wc, int fr, int fq) const {
        const int row0 = u.pm * 256 + wr * 64 + fr, col0 = u.pn * 256 + wc * 32 + 8 * fq;
#pragma unroll
        for (int ai = 0; ai < 2; ++ai)
#pragma unroll
            for (int m = 0; m < 4; ++m)
#pragma unroll
                for (int bj = 0; bj < 2; ++bj) {
                    const int row = row0 + ai * 128 + m * 16, col = col0 + bj * 128;
                    f32x4 ga, gb; ungate8(*(const u32x2*)(GB + (size_t)row * GW + 2 * DM + col), ga, gb);
                    *(u32x4*)(MG + (size_t)row * DM + col) = pack8(acc[ai][bj][m][0] * (ga * (1.f / 255.f)), acc[ai][bj][m][1] * (gb * (1.f / 255.f)));
                }
    }
};

struct EpiResidNorm {
    static constexpr bool PERM = true, HAS_MID = false, FUSED = true;
    const float* base; float* XOUT; bf16_t* HN; float* NOUT; const float* gain; float* xbuf; unsigned* cnt;
    __device__ __forceinline__ void fused(f32x4 (&acc)[2][2][4][2], const pg8::Unit& u, int wr, int wc, int fr, int fq, LAS unsigned char* lds, int wid, int lane) const {
        LAS float* P = (LAS float*)(lds + 131072);
        LAS float* S = (LAS float*)(lds + 131072 + 4096);
        LAS unsigned* flag = (LAS unsigned*)(lds + 131072 + 5120);
        int zz = 0; asm volatile("" : "+v"(zz));
        const int rl0 = wr * 64 + fr + zz, row0 = u.pm * 256 + rl0, col0 = u.pn * 256 + wc * 32 + 8 * fq;
#pragma unroll
        for (int ai = 0; ai < 2; ++ai) {
#pragma unroll
            for (int m = 0; m < 4; ++m) {
                float ss = 0.f;
#pragma unroll
                for (int bj = 0; bj < 2; ++bj) {
                    const size_t off = (size_t)(row0 + ai * 128 + m * 16) * DM + col0 + bj * 128;
                    const f32x4 x0 = *(const f32x4*)(base + off) + acc[ai][bj][m][0], x1 = *(const f32x4*)(base + off + 4) + acc[ai][bj][m][1];
                    acc[ai][bj][m][0] = x0; acc[ai][bj][m][1] = x1;
                    if (XOUT) { *(f32x4*)(XOUT + off) = x0; *(f32x4*)(XOUT + off + 4) = x1; }
                    ss += (x0.x * x0.x + x0.y * x0.y) + (x0.z * x0.z + x0.w * x0.w) + (x1.x * x1.x + x1.y * x1.y) + (x1.z * x1.z + x1.w * x1.w);
                }
                ss += __shfl_xor(ss, 16); ss += __shfl_xor(ss, 32);
                if (fq == 0) P[(rl0 + ai * 128 + m * 16) * 4 + wc] = ss;
            }
            asm volatile("" ::: "memory");
        }
        asm volatile("s_waitcnt lgkmcnt(0)" ::: "memory"); __builtin_amdgcn_s_barrier(); asm volatile("" ::: "memory");
        const int rowt = wid * 64 + lane;
        if (wid < 4) {
            const f32x4 p = *(const LAS f32x4*)(P + rowt * 4);
            __hip_atomic_store(xbuf + (size_t)(u.pm * 256 + rowt) * 4 + u.pn, (p.x + p.y) + (p.z + p.w), __ATOMIC_RELAXED, __HIP_MEMORY_SCOPE_AGENT);
        }
        asm volatile("s_waitcnt vmcnt(0)" ::: "memory");
        if (lane == 0) __hip_atomic_fetch_add(cnt + 64 * u.pm, 1u, __ATOMIC_RELAXED, __HIP_MEMORY_SCOPE_AGENT);
        if (wid == 0) {
            unsigned sp = 0u;
            for (;;) {
                if ((unsigned)__builtin_amdgcn_readfirstlane(__hip_atomic_load(cnt + 64 * u.pm, __ATOMIC_RELAXED, __HIP_MEMORY_SCOPE_AGENT)) >= 32u) break;
                __builtin_amdgcn_s_sleep(2);
                if (++sp > (1u << 20)) break;
            }
            __builtin_amdgcn_fence(__ATOMIC_ACQUIRE, "agent");
            if (lane == 0) flag[0] = 1u;
        }
        asm volatile("s_waitcnt vmcnt(0) lgkmcnt(0)" ::: "memory"); __builtin_amdgcn_s_barrier(); asm volatile("" ::: "memory");
        if (wid < 4) {
            const float* sl = xbuf + (size_t)(u.pm * 256 + rowt) * 4;
            const float s = (__hip_atomic_load(sl, __ATOMIC_RELAXED, __HIP_MEMORY_SCOPE_AGENT) + __hip_atomic_load(sl + 1, __ATOMIC_RELAXED, __HIP_MEMORY_SCOPE_AGENT))
                          + (__hip_atomic_load(sl + 2, __ATOMIC_RELAXED, __HIP_MEMORY_SCOPE_AGENT) + __hip_atomic_load(sl + 3, __ATOMIC_RELAXED, __HIP_MEMORY_SCOPE_AGENT));
            S[rowt] = rsqrtf(s * (1.f / DM) + EPS);
        }
        asm volatile("s_waitcnt vmcnt(0) lgkmcnt(0)" ::: "memory"); __builtin_amdgcn_s_barrier(); asm volatile("" ::: "memory");
#pragma unroll
        for (int bj = 0; bj < 2; ++bj) {
            const f32x4 g0 = *(const f32x4*)(gain + col0 + bj * 128), g1 = *(const f32x4*)(gain + col0 + bj * 128 + 4);
#pragma unroll
            for (int ai = 0; ai < 2; ++ai)
#pragma unroll
                for (int m = 0; m < 4; ++m) {
                    const float rs = S[rl0 + ai * 128 + m * 16];
                    const size_t off = (size_t)(row0 + ai * 128 + m * 16) * DM + col0 + bj * 128;
                    const f32x4 y0 = acc[ai][bj][m][0] * rs * g0, y1 = acc[ai][bj][m][1] * rs * g1;
                    if (HN) *(u32x4*)(HN + off) = pack8(y0, y1);
                    if (NOUT) { *(f32x4*)(NOUT + off) = y0; *(f32x4*)(NOUT + off + 4) = y1; }
                }
        }
        asm volatile("s_waitcnt lgkmcnt(0)" ::: "memory"); __builtin_amdgcn_s_barrier(); asm volatile("" ::: "memory");
    }
    __device__ __forceinline__ void operator()(const f32x4 (&)[2][2][4][2], const pg8::Unit&, int, int, int, int) const {}
};

typedef float f32x16 __attribute__((ext_vector_type(16)));
__device__ __forceinline__ float gelu_tanh(float x) { const float u = 0.7978845608028654f * (x + 0.044715f * x * x * x); const float e = __expf(2.f * u); const float th = 1.f - 2.f * __builtin_amdgcn_rcpf(e + 1.f); return 0.5f * x * (1.f + th); }
constexpr int S5_XSTR = 272;
constexpr int S5_WAVE_LDS = 2 * 16 * S5_XSTR;
template <bool OUT>
__device__ __forceinline__ void s5_pass(Frame& F, int l, const float* c_re, const float* c_im, const float* ssm_d) {
    const bf16_t* ZSp = F.ZS(); const float* SPp = F.SP(l); f32x2* S5Ep = F.S5E();
    LAS unsigned char* XL = F.lds + F.wave * S5_WAVE_LDS;
    for (int task = F.bid * NWAVES + F.wave; task < 256 * 16; task += F.G * NWAVES) {
        int lane = F.lane; asm volatile("" : "+v"(lane));
        const int n = lane & 31, hh = lane >> 5, l15 = lane & 15, kg = lane >> 4;
        const int g = task & 15, pp = task >> 4, cmine = 2 * pp + hh;
        bf16x8 bbf[2][2];
#pragma unroll
        for (int st = 0; st < 2; ++st) { const float* br = SPp + SP_BBR + (size_t)(g * 64 + 2 * n + st) * 16 + 8 * hh; const float* bi = SPp + SP_BBI + (size_t)(g * 64 + 2 * n + st) * 16 + 8 * hh;
            bbf[st][0] = __builtin_bit_cast(bf16x8, pack8(*(const f32x4*)br, *(const f32x4*)(br + 4))); bbf[st][1] = __builtin_bit_cast(bf16x8, pack8(*(const f32x4*)bi, *(const f32x4*)(bi + 4))); }
        const f32x4 lb = *(const f32x4*)(SPp + SP_LB + (g * 64 + 2 * n) * 2);
        f32x4 x = {0.f, 0.f, 0.f, 0.f};
        if constexpr (OUT) x = *(const f32x4*)(S5Ep + (size_t)(cmine * 16 + g) * 64 + 2 * n);
        bf16x8 cf[4]; f32x4 dsk = {0.f, 0.f, 0.f, 0.f};
        if constexpr (OUT) {
#pragma unroll
            for (int ks = 0; ks < 4; ++ks) { const float* cp = ((ks < 2) ? c_re : c_im) + ((size_t)(l * 16 + g) * 16 + l15) * 64 + 32 * (ks & 1) + 8 * kg;
                f32x4 a = *(const f32x4*)cp, b = *(const f32x4*)(cp + 4); if (ks >= 2) { a = -a; b = -b; }
                cf[ks] = __builtin_bit_cast(bf16x8, pack8(a, b)); }
            dsk = *(const f32x4*)(ssm_d + (l * 16 + g) * 16 + 4 * kg);
        }
        const bf16_t* urow = ZSp + (size_t)((2 * pp + ((n >> 2) & 1)) * 64 + 4 * (n >> 3) + (n & 3)) * ZSW + ZU + g * 16 + 8 * hh;
#pragma unroll 1
        for (int k = 0; k < 4; ++k) {
            const bf16x8 uf = *(const bf16x8*)(urow + (size_t)(16 * k) * ZSW);
            const f32x16 z16 = {0.f, 0.f, 0.f, 0.f, 0.f, 0.f, 0.f, 0.f, 0.f, 0.f, 0.f, 0.f, 0.f, 0.f, 0.f, 0.f};
            const f32x16 r0 = __builtin_amdgcn_mfma_f32_32x32x16_bf16(uf, bbf[0][0], z16, 0, 0, 0), i0 = __builtin_amdgcn_mfma_f32_32x32x16_bf16(uf, bbf[0][1], z16, 0, 0, 0);
            const f32x16 r1 = __builtin_amdgcn_mfma_f32_32x32x16_bf16(uf, bbf[1][0], z16, 0, 0, 0), i1 = __builtin_amdgcn_mfma_f32_32x32x16_bf16(uf, bbf[1][1], z16, 0, 0, 0);
#pragma unroll
            for (int t = 0; t < 16; ++t) {
                const float nr0 = lb.x * x.x - lb.y * x.y + r0[t], ni0 = lb.x * x.y + lb.y * x.x + i0[t];
                const float nr1 = lb.z * x.z - lb.w * x.w + r1[t], ni1 = lb.z * x.w + lb.w * x.z + i1[t];
                x = (f32x4){nr0, ni0, nr1, ni1};
                if constexpr (OUT) { LAS unsigned* xw = (LAS unsigned*)(XL + (hh * 16 + t) * S5_XSTR + 4 * n); xw[0] = pk2(nr0, nr1); xw[32] = pk2(ni0, ni1); }
            }
            if constexpr (OUT) {
                asm volatile("s_waitcnt lgkmcnt(0)" ::: "memory");
#pragma unroll
                for (int sel = 0; sel < 2; ++sel) {
                    f32x4 y = {0.f, 0.f, 0.f, 0.f};
#pragma unroll
                    for (int ks = 0; ks < 4; ++ks) { const bf16x8 xf = *(const LAS bf16x8*)(XL + (sel * 16 + l15) * S5_XSTR + (32 * ks + 8 * kg) * 2); y = __builtin_amdgcn_mfma_f32_16x16x32_bf16(cf[ks], xf, y, 0, 0, 0); }
                    const size_t tok = (size_t)(2 * pp + sel) * 64 + 16 * k + l15;
                    const u32x2 uw = *(const u32x2*)(ZSp + tok * ZSW + ZU + g * 16 + 4 * kg);
                    const float y0 = gelu_tanh(y.x + dsk.x * bflo(uw.x)), y1 = gelu_tanh(y.y + dsk.y * bfhi(uw.x)), y2 = gelu_tanh(y.z + dsk.z * bflo(uw.y)), y3 = gelu_tanh(y.w + dsk.w * bfhi(uw.y));
                    *(u32x2*)(F.H() + tok * DM + g * 16 + 4 * kg) = (u32x2){pk2(y0, y1), pk2(y2, y3)};
                }
                asm volatile("s_waitcnt lgkmcnt(0)" ::: "memory");
            }
        }
        if constexpr (!OUT) *(f32x4*)(S5Ep + (size_t)(cmine * 16 + g) * 64 + 2 * n) = x;
    }
}
__device__ __forceinline__ void phase_s5_local(Frame& F, int l) {
#ifdef NO_PHASE_S5_LOCAL
    return;
#endif
    s5_pass<false>(F, l, nullptr, nullptr, nullptr);
}
__device__ __forceinline__ void phase_s5_out(Frame& F, int l, const float* c_re, const float* c_im, const float* ssm_d) {
#ifdef NO_PHASE_S5_OUT
    return;
#endif
    s5_pass<true>(F, l, c_re, c_im, ssm_d);
}

__device__ __forceinline__ void phase_carry(Frame& F, int l) {
#ifdef NO_PHASE_CARRY
    return;
#endif
    const float* SPp = F.SP(l); f32x2* S5Ep = F.S5E(); float* RSTp = F.RST();
    const int gw = F.bid * NWAVES + F.wave, NGW = F.G * NWAVES;
    for (int task = gw; task < NB * 16; task += NGW) {
        const int b = task >> 4, g = task & 15, p = F.lane;
        const float ar = SPp[SP_L64 + (g * 64 + p) * 2], ai = SPp[SP_L64 + (g * 64 + p) * 2 + 1];
        float sr = 0.f, si = 0.f;
        for (int c0 = 0; c0 < 128; c0 += 16) {
            f32x2 e[16];
#pragma unroll
            for (int j = 0; j < 16; ++j) e[j] = S5Ep[(size_t)((b * 128 + c0 + j) * 16 + g) * 64 + p];
#pragma unroll
            for (int j = 0; j < 16; ++j) { S5Ep[(size_t)((b * 128 + c0 + j) * 16 + g) * 64 + p] = (f32x2){sr, si}; const float nr = ar * sr - ai * si + e[j].x, ni = ar * si + ai * sr + e[j].y; sr = nr; si = ni; }
        }
    }
    const int NT = F.G * NTHREADS;
    for (int gt = F.bid * NTHREADS + F.tid; gt < NB * 4 * 4608; gt += NT) {
        const int b = gt / (4 * 4608), h = (gt / 4608) & 3, el = gt % 4608;
        const float lg = log1pf(-exp2f(-5.f - (float)h));
        const float cdec = expf(lg * 64.f);
        float s = 0.f;
        for (int c0 = 0; c0 < 128; c0 += 16) {
            float d[16];
#pragma unroll
            for (int j = 0; j < 16; ++j) d[j] = RSTp[(size_t)((b * 128 + c0 + j) * 4 + h) * 4608 + el];
#pragma unroll
            for (int j = 0; j < 16; ++j) { RSTp[(size_t)((b * 128 + c0 + j) * 4 + h) * 4608 + el] = s; s = s * cdec + d[j]; }
        }
    }
}

typedef float f32x16 __attribute__((ext_vector_type(16)));
typedef short s16x4 __attribute__((ext_vector_type(4)));
__device__ __forceinline__ bf16x8 tr8(const LAS unsigned char* a0, const LAS unsigned char* a1) {
    const s16x4 lo = __builtin_bit_cast(s16x4, __builtin_amdgcn_ds_read_tr16_b64_v4i16((LAS s16x4*)a0));
    const s16x4 hi = __builtin_bit_cast(s16x4, __builtin_amdgcn_ds_read_tr16_b64_v4i16((LAS s16x4*)a1));
    return (bf16x8){lo[0], lo[1], lo[2], lo[3], hi[0], hi[1], hi[2], hi[3]};
}
__device__ __forceinline__ bf16x8 pack8f(const f32x4& a, const f32x4& b) { return __builtin_bit_cast(bf16x8, pack8(a, b)); }
__device__ __forceinline__ void ret_stage_v(const bf16_t* ZSp, LAS unsigned char* Vb, int tok0, int h, int lane) {
#pragma unroll
    for (int n = 0; n < 12; ++n) { const int o = n * 1024 + 16 * lane, r = o / 192, ch = (o % 192) >> 4;
        __builtin_amdgcn_global_load_lds((const unsigned*)(ZSp + (size_t)(tok0 + r) * ZSW + ZRV + h * 96 + ch * 8), (LAS unsigned*)(Vb + n * 1024), 16, 0, 0); }
}
constexpr int RET_VB = 12288, RET_KSTR = 112, RET_WAVE_LDS = RET_VB + 64 * RET_KSTR;
__device__ __forceinline__ void phase_ret_local(Frame& F) {
#ifdef NO_PHASE_RET_LOCAL
    return;
#endif
    const bf16_t* ZSp = F.ZS(); float* RSTp = F.RST();
    LAS unsigned char* Vb = F.lds + F.wave * RET_WAVE_LDS; LAS unsigned char* Kb = Vb + RET_VB;
    for (int item = F.bid * NWAVES + F.wave; item < 2048; item += F.G * NWAVES) {
        int lane = F.lane; asm volatile("" : "+v"(lane));
        const int l31 = lane & 31, hh = lane >> 5, g1 = (lane >> 4) & 1, q4 = (lane & 15) >> 2, p4 = lane & 3;
        const int h = item & 3, tok0 = (item >> 2) * 64;
        ret_stage_v(ZSp, Vb, tok0, h, lane);
        const float lg2 = log2f(1.f - exp2f(-5.f - (float)h));
#pragma unroll
        for (int n = 0; n < 6; ++n) { const int idx = n * 64 + lane, r = idx / 6, ch = idx % 6;
            f32x4 a, b; unpack8(*(const u32x4*)(ZSp + (size_t)(tok0 + r) * ZSW + ZRK + h * 48 + ch * 8), a, b);
            const float sc = 0.14433756729740643f * exp2f(lg2 * (float)(63 - r));
            *(LAS u32x4*)(Kb + r * RET_KSTR + ch * 16) = pack8(a * sc, b * sc); }
        asm volatile("s_waitcnt vmcnt(0) lgkmcnt(0)" ::: "memory");
        f32x16 acc[3][2];
#pragma unroll
        for (int me = 0; me < 3; ++me)
#pragma unroll
            for (int nt = 0; nt < 2; ++nt) acc[me][nt] = (f32x16){0.f, 0.f, 0.f, 0.f, 0.f, 0.f, 0.f, 0.f, 0.f, 0.f, 0.f, 0.f, 0.f, 0.f, 0.f, 0.f};
#pragma unroll
        for (int s = 0; s < 4; ++s) {
            const int r0 = 16 * s + 8 * hh + q4;
            bf16x8 kf[2], vf[3];
#pragma unroll
            for (int nt = 0; nt < 2; ++nt) { const LAS unsigned char* a0 = Kb + r0 * RET_KSTR + (32 * nt + 16 * g1 + 4 * p4) * 2; kf[nt] = tr8(a0, a0 + 4 * RET_KSTR); }
#pragma unroll
            for (int me = 0; me < 3; ++me) { const LAS unsigned char* a0 = Vb + r0 * 192 + (32 * me + 16 * g1 + 4 * p4) * 2; vf[me] = tr8(a0, a0 + 4 * 192); }
#pragma unroll
            for (int me = 0; me < 3; ++me)
#pragma unroll
                for (int nt = 0; nt < 2; ++nt) acc[me][nt] = __builtin_amdgcn_mfma_f32_32x32x16_bf16(vf[me], kf[nt], acc[me][nt], 0, 0, 0);
        }
        float* dst = RSTp + (size_t)item * 4608 + (4 * hh) * 48 + l31;
#pragma unroll
        for (int me = 0; me < 3; ++me)
#pragma unroll
            for (int r4 = 0; r4 < 4; ++r4) {
                int zz = 0; asm volatile("" : "+v"(zz)); float* dp = dst + (32 * me + 8 * r4) * 48 + zz;
#pragma unroll
                for (int k = 0; k < 4; ++k) { dp[k * 48] = acc[me][0][4 * r4 + k]; if (l31 < 16) dp[k * 48 + 32] = acc[me][1][4 * r4 + k]; }
            }
        asm volatile("s_waitcnt lgkmcnt(0)" ::: "memory");
    }
}
__device__ __forceinline__ void phase_ret_out(Frame& F, int l, const float* ret_norm_g) {
#ifdef NO_PHASE_RET_OUT
    return;
#endif
    const bf16_t* ZSp = F.ZS(); const float* RSTp = F.RST();
    LAS unsigned char* Vb = F.lds + F.wave * RET_WAVE_LDS;
    for (int item = F.bid * NWAVES + F.wave; item < 2048; item += F.G * NWAVES) {
        int lane = F.lane; asm volatile("" : "+v"(lane));
        const int l31 = lane & 31, hh = lane >> 5, g1 = (lane >> 4) & 1, q4 = (lane & 15) >> 2, p4 = lane & 3;
        const int h = item & 3, tok0 = (item >> 2) * 64;
        ret_stage_v(ZSp, Vb, tok0, h, lane);
        const float lg2 = log2f(1.f - exp2f(-5.f - (float)h));
        bf16x8 qf[2][3], kf[2][3];
#pragma unroll
        for (int t = 0; t < 2; ++t)
#pragma unroll
            for (int ks = 0; ks < 3; ++ks) { const size_t ro = (size_t)(tok0 + 32 * t + l31) * ZSW + h * 48 + 8 * hh + 16 * ks;
                qf[t][ks] = *(const bf16x8*)(ZSp + ro + ZRQ); kf[t][ks] = *(const bf16x8*)(ZSp + ro + ZRK); }
        bf16x8 pm[2][4];
#pragma unroll
        for (int mt = 0; mt < 2; ++mt)
#pragma unroll
            for (int nt = mt; nt < 2; ++nt) {
                f32x16 p = {0.f, 0.f, 0.f, 0.f, 0.f, 0.f, 0.f, 0.f, 0.f, 0.f, 0.f, 0.f, 0.f, 0.f, 0.f, 0.f};
#pragma unroll
                for (int ks = 0; ks < 3; ++ks) p = __builtin_amdgcn_mfma_f32_32x32x16_bf16(kf[mt][ks], qf[nt][ks], p, 0, 0, 0);
                const int i = 32 * nt + l31;
#pragma unroll
                for (int r = 0; r < 16; ++r) { const int j = 32 * mt + (r & 3) + 8 * (r >> 2) + 4 * hh;
                    p[r] = (i >= j) ? p[r] * (0.14433756729740643f * exp2f(lg2 * (float)(i - j))) : 0.f; }
                pm[nt][2 * mt + 0] = pack8f((f32x4){p[0], p[1], p[2], p[3]}, (f32x4){p[4], p[5], p[6], p[7]});
                pm[nt][2 * mt + 1] = pack8f((f32x4){p[8], p[9], p[10], p[11]}, (f32x4){p[12], p[13], p[14], p[15]});
            }
        f32x16 ot[3][2];
#pragma unroll
        for (int me = 0; me < 3; ++me) {
            bf16x8 sf[3];
            int zz = 0; asm volatile("" : "+v"(zz)); const float* sp0 = RSTp + (size_t)item * 4608 + (32 * me + l31) * 48 + 8 * hh + zz;
#pragma unroll
            for (int ks = 0; ks < 3; ++ks) { const float* sp = sp0 + 16 * ks; sf[ks] = pack8f(*(const f32x4*)sp, *(const f32x4*)(sp + 4)); }
#pragma unroll
            for (int nt = 0; nt < 2; ++nt) {
                f32x16 a = {0.f, 0.f, 0.f, 0.f, 0.f, 0.f, 0.f, 0.f, 0.f, 0.f, 0.f, 0.f, 0.f, 0.f, 0.f, 0.f};
#pragma unroll
                for (int ks = 0; ks < 3; ++ks) a = __builtin_amdgcn_mfma_f32_32x32x16_bf16(sf[ks], qf[nt][ks], a, 0, 0, 0);
                const float qd = exp2f(lg2 * (float)(32 * nt + l31 + 1));
                ot[me][nt] = a * qd;
            }
        }
        asm volatile("s_waitcnt vmcnt(0)" ::: "memory");
#pragma unroll
        for (int s = 0; s < 4; ++s) {
            const int r0 = 16 * s + 4 * hh + q4;
#pragma unroll
            for (int me = 0; me < 3; ++me) {
                const LAS unsigned char* a0 = Vb + r0 * 192 + (32 * me + 16 * g1 + 4 * p4) * 2;
                const bf16x8 vf = tr8(a0, a0 + 8 * 192);
                if (s < 2) ot[me][0] = __builtin_amdgcn_mfma_f32_32x32x16_bf16(vf, pm[0][s], ot[me][0], 0, 0, 0);
                ot[me][1] = __builtin_amdgcn_mfma_f32_32x32x16_bf16(vf, pm[1][s], ot[me][1], 0, 0, 0);
            }
        }
#pragma unroll
        for (int nt = 0; nt < 2; ++nt) {
            float sum = 0.f;
#pragma unroll
            for (int me = 0; me < 3; ++me)
#pragma unroll
                for (int r = 0; r < 16; ++r) sum += ot[me][nt][r];
            sum += __shfl_xor(sum, 32);
            const float mu = sum * (1.f / 96.f); float q2 = 0.f;
#pragma unroll
            for (int me = 0; me < 3; ++me)
#pragma unroll
                for (int r = 0; r < 16; ++r) { const float d = ot[me][nt][r] - mu; q2 += d * d; }
            q2 += __shfl_xor(q2, 32);
            const float rs = rsqrtf(q2 * (1.f / 96.f) + EPS);
            const int tok = tok0 + 32 * nt + l31;
            const bf16_t* gbase = ZSp + (size_t)tok * ZSW + ZRG + h * 96 + 4 * hh; const float* nbase = ret_norm_g + l * 384 + h * 96 + 4 * hh; bf16_t* obase = F.H() + (size_t)tok * DM + 640 + h * 96 + 4 * hh;
#pragma unroll
            for (int me = 0; me < 3; ++me) {
                int zz = 0; asm volatile("" : "+v"(zz));
                const bf16_t* gp = gbase + 32 * me + zz; const float* np = nbase + 32 * me + zz; bf16_t* op = obase + 32 * me + zz;
#pragma unroll
                for (int r4 = 0; r4 < 4; ++r4) {
                    const u32x2 gw = *(const u32x2*)(gp + 8 * r4);
                    const f32x4 ng = *(const f32x4*)(np + 8 * r4);
                    const float g0 = bflo(gw.x), g1f = bfhi(gw.x), g2 = bflo(gw.y), g3 = bfhi(gw.y);
                    const float y0 = (ot[me][nt][4 * r4 + 0] - mu) * rs * ng.x * (g0 * sigmoidf_(g0)), y1 = (ot[me][nt][4 * r4 + 1] - mu) * rs * ng.y * (g1f * sigmoidf_(g1f));
                    const float y2 = (ot[me][nt][4 * r4 + 2] - mu) * rs * ng.z * (g2 * sigmoidf_(g2)), y3 = (ot[me][nt][4 * r4 + 3] - mu) * rs * ng.w * (g3 * sigmoidf_(g3));
                    *(u32x2*)(op + 8 * r4) = (u32x2){pk2(y0, y1), pk2(y2, y3)};
                }
            }
        }
        asm volatile("s_waitcnt lgkmcnt(0)" ::: "memory");
    }
}

typedef _Float16 f16_t;
__device__ __forceinline__ u32x4 zero4() { unsigned z = 0u; asm volatile("" : "+v"(z)); return (u32x4){z, z, z, z}; }
__device__ __forceinline__ int lanes_below(unsigned long long m) { return (int)__builtin_amdgcn_mbcnt_hi((unsigned)(m >> 32), __builtin_amdgcn_mbcnt_lo((unsigned)m, 0u)); }
__device__ __forceinline__ float relu1(float x) { return __builtin_amdgcn_fmed3f(x, 0.f, __builtin_inff()); }
__device__ __forceinline__ unsigned sortable_f16(float sc) {
    const f16_t h = (f16_t)sc; const unsigned u = (unsigned)__builtin_bit_cast(unsigned short, h), mag = u & 0x7fffu;
    return (u & 0x8000u) ? (0x8000u - mag) : (0x8000u + mag);
}
__device__ __forceinline__ int sc_pos(int k) { return k; }
__device__ __forceinline__ int wave_suffix_sum(int v, int lane) {
#pragma unroll
    for (int o = 1; o < 64; o <<= 1) { const int t = __shfl_down(v, o); if (lane + o < 64) v += t; }
    return v;
}
__device__ __forceinline__ void hist_threshold(const u32x4 c, int need, int lane, int& B, int& above) {
    const int s = (int)(c.x + c.y + c.z + c.w);
    const int S = wave_suffix_sum(s, lane);
    int a = S - s;
    const bool found = (a < need) && (S >= need);
    int Bl = 0, al = 0;
    if (found) {
        if (a + (int)c.w >= need) { Bl = 4 * lane + 3; al = a; }
        else { a += (int)c.w; if (a + (int)c.z >= need) { Bl = 4 * lane + 2; al = a; }
        else { a += (int)c.z; if (a + (int)c.y >= need) { Bl = 4 * lane + 1; al = a; }
        else { a += (int)c.y; Bl = 4 * lane; al = a; } } }
    }
    const unsigned long long m = __ballot(found);
    const int src = m ? (int)__builtin_ctzll(m) : 0;
    B = __shfl(Bl, src); above = __shfl(al, src);
}

#ifndef DSA_CAND
#define DSA_CAND 0
#endif
#ifndef DSA_DUP
#define DSA_DUP 0
#endif
constexpr int DSA_ROW = 16384;
__device__ __forceinline__ void phase_dsa(Frame& F) {
#ifdef NO_PHASE_DSA
    return;
#endif
    const int wave = F.wave;
    const bf16_t* ZSp = F.ZS(); const float* IWp = F.IW(); const bf16_t* IKp = F.IKD();
    LAS unsigned char* SCb = F.lds;
    for (int it = F.bid; it < 512; it += F.G) {
        int lane = F.lane; asm volatile("" : "+v"(lane));
        const int hi = lane >> 5, n32 = lane & 31;
        LAS unsigned short* LSTw = (LAS unsigned short*)(F.lds + 131072) + wave * 256;
        LAS unsigned char* WB = F.lds + 135168 + wave * 3520;
        LAS unsigned* H1 = (LAS unsigned*)WB; LAS unsigned* H2 = H1 + 256;
        LAS unsigned* DUM = (LAS unsigned*)(WB + 3264) + lane;
        LAS unsigned short* CK = (LAS unsigned short*)(WB + 1024); LAS unsigned short* CI = (LAS unsigned short*)(WB + 2144);
        const int pr = it & 255, vcu = (pr & 7) * 32 + (pr >> 3);
        const int b = vcu >> 6, cc = vcu & 63, c = (it < 256) ? cc : 127 - cc;
        const int V = (c + 1) * 64, tokq0 = b * SEQ + c * 64, kb0 = b * SEQ;
        const int Keff = V < 256 ? V : 256;
        const int nblk = (V + 511) >> 9, ntile_all = nblk * 16, ntile_real = V >> 5;
        for (int qg = 0; qg < 8; ++qg) {
            const int tq0 = tokq0 + qg * 8;
#ifndef DSA_NO_A
            for (int repA = 0; repA < 1 + (DSA_DUP & 1); ++repA) {
                bf16x8 aq[2];
                { const int qq = n32 >> 2, hd = n32 & 3; const bf16_t* qp = ZSp + (size_t)(tq0 + qq) * ZSW + ZIQ + hd * 32 + 8 * hi;
                  aq[0] = *(const bf16x8*)qp; aq[1] = *(const bf16x8*)(qp + 16); }
                float wq[4][4];
#pragma unroll
                for (int jq = 0; jq < 4; ++jq) { const f32x4 w4 = *(const f32x4*)(IWp + (size_t)(tq0 + 2 * jq + hi) * 4);
                    wq[jq][0] = w4.x * 0.08838834764831845f; wq[jq][1] = w4.y * 0.08838834764831845f; wq[jq][2] = w4.z * 0.08838834764831845f; wq[jq][3] = w4.w * 0.08838834764831845f; }
                bf16x8 fr[2][4][2];
                const int nb = (ntile_all - wave + 31) >> 5;
#define DSA_ALOAD(buf, bt) do { int zz = 0; asm volatile("" : "+v"(zz)); _Pragma("unroll") for (int u = 0; u < 4; ++u) { const int tt = wave + 8 * (4 * (bt) + u); \
        if (tt < ntile_real) { const bf16_t* kp = IKp + ((size_t)(((kb0 >> 5) + tt) * 4 + hi) * 32 + n32 + zz) * 8; fr[buf][u][0] = *(const bf16x8*)kp; fr[buf][u][1] = *(const bf16x8*)(kp + 512); } } } while (0)
#define DSA_ACOMP(buf, bt) do { _Pragma("unroll") for (int u = 0; u < 4; ++u) { const int tt = wave + 8 * (4 * (bt) + u); \
        if (tt < ntile_all) { unsigned short us[4] = {0, 0, 0, 0}; \
            if (tt < ntile_real) { f32x16 acc = {0.f, 0.f, 0.f, 0.f, 0.f, 0.f, 0.f, 0.f, 0.f, 0.f, 0.f, 0.f, 0.f, 0.f, 0.f, 0.f}; \
                acc = __builtin_amdgcn_mfma_f32_32x32x16_bf16(aq[0], fr[buf][u][0], acc, 0, 0, 0); acc = __builtin_amdgcn_mfma_f32_32x32x16_bf16(aq[1], fr[buf][u][1], acc, 0, 0, 0); \
                _Pragma("unroll") for (int jq = 0; jq < 4; ++jq) { \
                    const float sc = relu1(acc[4 * jq + 0]) * wq[jq][0] + relu1(acc[4 * jq + 1]) * wq[jq][1] + relu1(acc[4 * jq + 2]) * wq[jq][2] + relu1(acc[4 * jq + 3]) * wq[jq][3]; \
                    us[jq] = (unsigned short)sortable_f16(sc); } } \
            const int pos = sc_pos(tt * 32 + n32); \
            _Pragma("unroll") for (int jq = 0; jq < 4; ++jq) *(LAS unsigned short*)(SCb + (2 * jq + hi) * DSA_ROW + pos * 2) = us[jq]; } } } while (0)
                DSA_ALOAD(0, 0);
                for (int bp = 0; bp < nb; bp += 2) {
                    if (bp + 1 < nb) DSA_ALOAD(1, bp + 1);
                    DSA_ACOMP(0, bp);
                    if (bp + 2 < nb) DSA_ALOAD(0, bp + 2);
                    if (bp + 1 < nb) DSA_ACOMP(1, bp + 1);
                }
#undef DSA_ALOAD
#undef DSA_ACOMP
            }
#endif
            __syncthreads();
            LAS unsigned char* row = SCb + wave * DSA_ROW;
#ifndef DSA_NO_B
            for (int repB = 0; repB < 1 + ((DSA_DUP >> 1) & 1); ++repB)
            if (V > 256) {
                *(LAS u32x4*)(H1 + 4 * lane) = zero4(); *(LAS u32x4*)(H2 + 4 * lane) = zero4();
                u32x4 rw[4];
#define DSA_LD8(hf) do { _Pragma("unroll") for (int i = 0; i < 4; ++i) if (4 * (hf) + i < nblk) rw[i] = *(const LAS u32x4*)(row + (512 * (4 * (hf) + i) + 8 * lane) * 2); \
        asm volatile("s_waitcnt lgkmcnt(0)" ::: "memory"); } while (0)
#define DSA_W(i, e2) ((e2) == 0 ? rw[i].x : (e2) == 1 ? rw[i].y : (e2) == 2 ? rw[i].z : rw[i].w)
                asm volatile("s_waitcnt lgkmcnt(0)" ::: "memory");
#pragma unroll 1
                for (int hf = 0; 4 * hf < nblk; ++hf) {
                    DSA_LD8(hf);
#pragma unroll
                    for (int i = 0; i < 4; ++i) if (4 * hf + i < nblk) __hip_atomic_fetch_add(H2 + ((rw[i].x >> 8) & 255u), 1u, __ATOMIC_RELAXED, __HIP_MEMORY_SCOPE_WORKGROUP);
                }
                asm volatile("s_waitcnt lgkmcnt(0)" ::: "memory");
                int Bc, abovec; hist_threshold(*(const LAS u32x4*)(H2 + 4 * lane), 40, lane, Bc, abovec);
                { const u32x4 hs = *(const LAS u32x4*)(H2 + 4 * lane); const int tot = wave_suffix_sum((int)(hs.x + hs.y + hs.z + hs.w), lane); if (__shfl(tot, 0) < 40) Bc = 0; }
                *(LAS u32x4*)(H2 + 4 * lane) = zero4();
                bool done = false;
                if (DSA_CAND && Bc > 0) {
                    const unsigned thr = (unsigned)Bc << 8;
                    int cnt = 0;
#pragma unroll 1
                    for (int hf = 0; 4 * hf < nblk; ++hf) {
                        DSA_LD8(hf);
#pragma unroll
                        for (int i = 0; i < 4; ++i) if (4 * hf + i < nblk) {
#pragma unroll
                            for (int e = 0; e < 8; ++e) { const unsigned w = DSA_W(i, e >> 1); const unsigned u = (e & 1) ? (w >> 16) : (w & 0xffffu); cnt += (u >= thr) ? 1 : 0; }
                        }
                    }
                    int pos = cnt;
#pragma unroll
                    for (int o = 1; o < 64; o <<= 1) { const int t = __shfl_up(pos, o); if (lane >= o) pos += t; }
                    const int ncand = __shfl(pos, 63); pos -= cnt;
                    if (ncand >= 256 && ncand <= 560) {
                        LAS unsigned short* ldum = (LAS unsigned short*)DUM;
#pragma unroll 1
                        for (int hf = 0; 4 * hf < nblk; ++hf) {
                            DSA_LD8(hf);
#pragma unroll
                            for (int i = 0; i < 4; ++i) if (4 * hf + i < nblk) {
#pragma unroll
                                for (int e = 0; e < 8; ++e) { const unsigned w = DSA_W(i, e >> 1); const unsigned u = (e & 1) ? (w >> 16) : (w & 0xffffu);
                                    const bool sel = u >= thr; LAS unsigned short* pk = sel ? CK + pos : ldum; LAS unsigned short* pi = sel ? CI + pos : ldum;
                                    *pk = (unsigned short)u; *pi = (unsigned short)(512 * (4 * hf + i) + 8 * lane + e); pos += sel ? 1 : 0; }
                            }
                        }
                        *(LAS u32x4*)(H1 + 4 * lane) = zero4();
                        asm volatile("s_waitcnt lgkmcnt(0)" ::: "memory");
                        unsigned cu[9];
#pragma unroll
                        for (int j = 0; j < 9; ++j) { const int p = j * 64 + lane; const bool v = p < ncand; cu[j] = v ? (unsigned)CK[v ? p : 0] : 0u; }
                        asm volatile("s_waitcnt lgkmcnt(0)" ::: "memory");
#pragma unroll
                        for (int j = 0; j < 9; ++j) if (j * 64 + lane < ncand) __hip_atomic_fetch_add(H1 + (cu[j] >> 8), 1u, __ATOMIC_RELAXED, __HIP_MEMORY_SCOPE_WORKGROUP);
                        asm volatile("s_waitcnt lgkmcnt(0)" ::: "memory");
                        int B1c, above1c; hist_threshold(*(const LAS u32x4*)(H1 + 4 * lane), 256, lane, B1c, above1c);
                        *(LAS u32x4*)(H1 + 4 * lane) = zero4();
                        asm volatile("s_waitcnt lgkmcnt(0)" ::: "memory");
#pragma unroll
                        for (int j = 0; j < 9; ++j) if (j * 64 + lane < ncand && (int)(cu[j] >> 8) == B1c) __hip_atomic_fetch_add(H1 + (cu[j] & 255u), 1u, __ATOMIC_RELAXED, __HIP_MEMORY_SCOPE_WORKGROUP);
                        asm volatile("s_waitcnt lgkmcnt(0)" ::: "memory");
                        int B2c, above2c; hist_threshold(*(const LAS u32x4*)(H1 + 4 * lane), 256 - above1c, lane, B2c, above2c);
                        const unsigned tauc = ((unsigned)B1c << 8) | (unsigned)B2c;
                        if ((int)H1[B2c] == 256 - above1c - above2c) {
                            int c2 = 0;
#pragma unroll
                            for (int j = 0; j < 9; ++j) c2 += (j * 64 + lane < ncand && cu[j] >= tauc) ? 1 : 0;
                            int p2 = c2;
#pragma unroll
                            for (int o = 1; o < 64; o <<= 1) { const int t = __shfl_up(p2, o); if (lane >= o) p2 += t; }
                            p2 -= c2;
#pragma unroll
                            for (int j = 0; j < 9; ++j) { const bool sel = (j * 64 + lane < ncand) && cu[j] >= tauc; LAS unsigned short* pl = sel ? LSTw + p2 : ldum; *pl = CI[sel ? j * 64 + lane : 0]; p2 += sel ? 1 : 0; }
                            done = true;
                        }
                        *(LAS u32x4*)(H1 + 4 * lane) = zero4(); *(LAS u32x4*)(H2 + 4 * lane) = zero4();
                        asm volatile("s_waitcnt lgkmcnt(0)" ::: "memory");
                    }
                }
                if (!done) {
                int lo_bin = Bc, hi_bin = 256;
                for (;;) {
#pragma unroll 1
                    for (int hf = 0; 4 * hf < nblk; ++hf) {
                        DSA_LD8(hf);
#pragma unroll
                        for (int i = 0; i < 4; ++i) if (4 * hf + i < nblk) {
#pragma unroll
                            for (int e2 = 0; e2 < 4; ++e2) { const unsigned w = DSA_W(i, e2); const int b0 = (int)((w >> 8) & 255u), b1 = (int)(w >> 24);
                                LAS unsigned* p0 = ((unsigned)(b0 - lo_bin) < (unsigned)(hi_bin - lo_bin)) ? H1 + b0 : DUM; LAS unsigned* p1 = ((unsigned)(b1 - lo_bin) < (unsigned)(hi_bin - lo_bin)) ? H1 + b1 : DUM;
                                __hip_atomic_fetch_add(p0, 1u, __ATOMIC_RELAXED, __HIP_MEMORY_SCOPE_WORKGROUP); __hip_atomic_fetch_add(p1, 1u, __ATOMIC_RELAXED, __HIP_MEMORY_SCOPE_WORKGROUP); }
                        }
                    }
                    asm volatile("s_waitcnt lgkmcnt(0)" ::: "memory");
                    if (lo_bin == 0) break;
                    const u32x4 h4 = *(const LAS u32x4*)(H1 + 4 * lane); const int tot = __shfl(wave_suffix_sum((int)(h4.x + h4.y + h4.z + h4.w), lane), 0);
                    if (tot >= 256) break;
                    hi_bin = lo_bin; lo_bin = 0;
                }
                asm volatile("s_waitcnt lgkmcnt(0)" ::: "memory");
                int B1, above1; hist_threshold(*(const LAS u32x4*)(H1 + 4 * lane), 256, lane, B1, above1);
#pragma unroll 1
                for (int hf = 0; 4 * hf < nblk; ++hf) {
                    DSA_LD8(hf);
#pragma unroll
                    for (int i = 0; i < 4; ++i) if (4 * hf + i < nblk) {
#pragma unroll
                        for (int e2 = 0; e2 < 4; ++e2) { const unsigned w = DSA_W(i, e2);
                            LAS unsigned* p0 = ((int)((w >> 8) & 255u) == B1) ? H2 + (w & 255u) : DUM; LAS unsigned* p1 = ((int)(w >> 24) == B1) ? H2 + ((w >> 16) & 255u) : DUM;
                            __hip_atomic_fetch_add(p0, 1u, __ATOMIC_RELAXED, __HIP_MEMORY_SCOPE_WORKGROUP); __hip_atomic_fetch_add(p1, 1u, __ATOMIC_RELAXED, __HIP_MEMORY_SCOPE_WORKGROUP); }
                    }
                }
                asm volatile("s_waitcnt lgkmcnt(0)" ::: "memory");
                int B2, above2; hist_threshold(*(const LAS u32x4*)(H2 + 4 * lane), 256 - above1, lane, B2, above2);
                const unsigned tau = ((unsigned)B1 << 8) | (unsigned)B2;
                const int r = 256 - above1 - above2;
                const int neq = (int)H2[B2];
                if (neq == r) {
                    int cnt = 0;
#pragma unroll 1
                    for (int hf = 0; 4 * hf < nblk; ++hf) {
                        DSA_LD8(hf);
#pragma unroll
                        for (int i = 0; i < 4; ++i) if (4 * hf + i < nblk) {
#pragma unroll
                            for (int e = 0; e < 8; ++e) { const unsigned w = DSA_W(i, e >> 1); const unsigned u = (e & 1) ? (w >> 16) : (w & 0xffffu); cnt += (u >= tau) ? 1 : 0; }
                        }
                    }
                    int pos = cnt;
#pragma unroll
                    for (int o = 1; o < 64; o <<= 1) { const int t = __shfl_up(pos, o); if (lane >= o) pos += t; }
                    pos -= cnt;
                    LAS unsigned short* ldum = (LAS unsigned short*)DUM;
#pragma unroll 1
                    for (int hf = 0; 4 * hf < nblk; ++hf) {
                        DSA_LD8(hf);
#pragma unroll
                        for (int i = 0; i < 4; ++i) if (4 * hf + i < nblk) {
#pragma unroll
                            for (int e = 0; e < 8; ++e) { const unsigned w = DSA_W(i, e >> 1); const unsigned u = (e & 1) ? (w >> 16) : (w & 0xffffu);
                                const bool sel = u >= tau; LAS unsigned short* p = sel ? LSTw + pos : ldum;
                                *p = (unsigned short)(512 * (4 * hf + i) + 8 * lane + e); pos += sel ? 1 : 0; }
                        }
                    }
                } else {
                    int eq_base = 0, sel_base = 0;
#pragma unroll 1
                    for (int i = 0; i < nblk; ++i) {
                        const u32x4 w4 = *(const LAS u32x4*)(row + (512 * i + 8 * lane) * 2);
                        const unsigned ww[4] = {w4.x, w4.y, w4.z, w4.w};
                        int below_eq = 0, mine_eq = 0;
#pragma unroll
                        for (int e = 0; e < 8; ++e) { const unsigned u = (e & 1) ? (ww[e >> 1] >> 16) : (ww[e >> 1] & 0xffffu); below_eq += lanes_below(__ballot(u == tau)); }
                        int blk_eq = 0;
#pragma unroll
                        for (int e = 0; e < 8; ++e) {
                            const unsigned u = (e & 1) ? (ww[e >> 1] >> 16) : (ww[e >> 1] & 0xffffu);
                            const bool gt = u > tau, eq = (u == tau);
                            const bool sel = gt || (eq && (eq_base + below_eq + mine_eq < r));
                            mine_eq += eq ? 1 : 0;
                            const unsigned long long msel = __ballot(sel);
                            if (sel) LSTw[sel_base + lanes_below(msel)] = (unsigned short)(512 * i + 8 * lane + e);
                            sel_base += __popcll(msel); blk_eq += __popcll(__ballot(eq));
                        }
                        eq_base += blk_eq;
                    }
                }
                }
#undef DSA_W
#undef DSA_LD8
            } else {
#pragma unroll
                for (int jj = 0; jj < 4; ++jj) LSTw[lane + 64 * jj] = (unsigned short)(lane + 64 * jj);
            }
#endif
            asm volatile("s_waitcnt lgkmcnt(0)" ::: "memory");
            for (int repC = 0; repC < 1 + ((DSA_DUP >> 2) & 1); ++repC) {
                const int tq = tq0 + wave, n16 = lane & 15, kg = lane >> 4;
                bf16x8 qf[2];
                if (n16 < 6) { const bf16_t* qp = ZSp + (size_t)tq * ZSW + ZDQ + n16 * 64 + 8 * kg; qf[0] = *(const bf16x8*)qp; qf[1] = *(const bf16x8*)(qp + 32); }
                else { qf[0] = (bf16x8){0, 0, 0, 0, 0, 0, 0, 0}; qf[1] = qf[0]; }
                const int ntile = Keff >> 4;
                LAS unsigned char* vst = row;
#define DSA_VDMA(ch, buf) do { _Pragma("unroll") for (int i8 = 0; i8 < 8; ++i8) { const int rr = (lane >> 3) + 8 * i8; const int kidx = LSTw[(ch) * 64 + rr]; \
        const int sch = (lane & 7) ^ (2 * ((rr >> 1) & 3)); \
        __builtin_amdgcn_global_load_lds((const unsigned*)(ZSp + (size_t)(kb0 + kidx) * ZSW + ZDV + sch * 8), (LAS unsigned*)(vst + (buf) * 8192 + i8 * 1024), 16, 0, 0); } } while (0)
                DSA_VDMA(0, 0);
                if (ntile > 4) DSA_VDMA(1, 1);
                f32x4 sa[16];
                bf16x8 kf[2][4][2];
#define DSA_KLOAD(buf, tb) do { _Pragma("unroll") for (int t4 = 0; t4 < 4; ++t4) if (4 * (tb) + t4 < ntile) { const int kidx = LSTw[(4 * (tb) + t4) * 16 + n16]; \
        const bf16_t* kp = ZSp + (size_t)(kb0 + kidx) * ZSW + ZDK + 8 * kg; kf[buf][t4][0] = *(const bf16x8*)kp; kf[buf][t4][1] = *(const bf16x8*)(kp + 32); } } while (0)
#define DSA_KMMA(buf, tb) do { _Pragma("unroll") for (int t4 = 0; t4 < 4; ++t4) { \
        if (4 * (tb) + t4 < ntile) { f32x4 a = {0.f, 0.f, 0.f, 0.f}; \
            a = __builtin_amdgcn_mfma_f32_16x16x32_bf16(kf[buf][t4][0], qf[0], a, 0, 0, 0); a = __builtin_amdgcn_mfma_f32_16x16x32_bf16(kf[buf][t4][1], qf[1], a, 0, 0, 0); sa[4 * (tb) + t4] = a; } \
        else sa[4 * (tb) + t4] = (f32x4){-1e30f, -1e30f, -1e30f, -1e30f}; } } while (0)
                DSA_KLOAD(0, 0); DSA_KLOAD(1, 1);
                DSA_KMMA(0, 0); DSA_KLOAD(0, 2);
                DSA_KMMA(1, 1); DSA_KLOAD(1, 3);
                DSA_KMMA(0, 2);
                DSA_KMMA(1, 3);
#undef DSA_KLOAD
#undef DSA_KMMA
                float m = -1e30f;
#pragma unroll
                for (int t = 0; t < 16; ++t) m = fmaxf(m, fmaxf(fmaxf(sa[t].x, sa[t].y), fmaxf(sa[t].z, sa[t].w)));
                m = fmaxf(m, __shfl_xor(m, 16)); m = fmaxf(m, __shfl_xor(m, 32));
                const float sc2 = 0.125f * 1.4426950408889634f; float lsum = 0.f;
#pragma unroll
                for (int t = 0; t < 16; ++t) { sa[t].x = exp2f((sa[t].x - m) * sc2); sa[t].y = exp2f((sa[t].y - m) * sc2); sa[t].z = exp2f((sa[t].z - m) * sc2); sa[t].w = exp2f((sa[t].w - m) * sc2);
                    lsum += (sa[t].x + sa[t].y) + (sa[t].z + sa[t].w); }
                lsum += __shfl_xor(lsum, 16); lsum += __shfl_xor(lsum, 32);
                const float linv = __builtin_amdgcn_rcpf(lsum);
                f32x4 oacc[4] = {{0.f, 0.f, 0.f, 0.f}, {0.f, 0.f, 0.f, 0.f}, {0.f, 0.f, 0.f, 0.f}, {0.f, 0.f, 0.f, 0.f}};
                const int q4 = n16 >> 2, p4 = n16 & 3;
#pragma unroll
                for (int ch = 0; ch < 4; ++ch) {
                    if (ch * 4 < ntile) {
                        if ((ch + 1) * 4 < ntile) asm volatile("s_waitcnt vmcnt(8)" ::: "memory");
                        else asm volatile("s_waitcnt vmcnt(0)" ::: "memory");
#pragma unroll
                        for (int sl = 0; sl < 2; ++sl) {
                            const int s = ch * 2 + sl;
                            u32x4 pw; pw.x = pk2(sa[2 * s].x, sa[2 * s].y); pw.y = pk2(sa[2 * s].z, sa[2 * s].w); pw.z = pk2(sa[2 * s + 1].x, sa[2 * s + 1].y); pw.w = pk2(sa[2 * s + 1].z, sa[2 * s + 1].w);
                            const bf16x8 pb = __builtin_bit_cast(bf16x8, pw);
#pragma unroll
                            for (int mt = 0; mt < 4; ++mt) {
                                const int P0 = 32 * sl + 4 * kg + q4, P1 = P0 + 16;
                                const LAS unsigned char* a0 = vst + (ch & 1) * 8192 + P0 * 128 + (((2 * mt + (p4 >> 1)) ^ (2 * ((P0 >> 1) & 3))) * 16) + 8 * (p4 & 1);
                                const LAS unsigned char* a1 = vst + (ch & 1) * 8192 + P1 * 128 + (((2 * mt + (p4 >> 1)) ^ (2 * ((P1 >> 1) & 3))) * 16) + 8 * (p4 & 1);
                                const s16x4 lo = __builtin_bit_cast(s16x4, __builtin_amdgcn_ds_read_tr16_b64_v4i16((LAS s16x4*)a0));
                                const s16x4 hi4 = __builtin_bit_cast(s16x4, __builtin_amdgcn_ds_read_tr16_b64_v4i16((LAS s16x4*)a1));
                                const bf16x8 va = (bf16x8){lo[0], lo[1], lo[2], lo[3], hi4[0], hi4[1], hi4[2], hi4[3]};
                                oacc[mt] = __builtin_amdgcn_mfma_f32_16x16x32_bf16(va, pb, oacc[mt], 0, 0, 0);
                            }
                        }
                        asm volatile("s_waitcnt lgkmcnt(0)" ::: "memory");
                        if (ch + 2 < 4 && (ch + 2) * 4 < ntile) DSA_VDMA(ch + 2, ch & 1);
                    }
                }
#undef DSA_VDMA
                if (n16 < 6) {
                    bf16_t* op = F.H() + (size_t)tq * DM + 256 + n16 * 64 + 4 * kg;
#pragma unroll
                    for (int mt = 0; mt < 4; ++mt) { u32x2 o; o.x = pk2(oacc[mt].x * linv, oacc[mt].y * linv); o.y = pk2(oacc[mt].z * linv, oacc[mt].w * linv); *(u32x2*)(op + 16 * mt) = o; }
                }
            }
            __syncthreads();
        }
    }
}

__global__ void __launch_bounds__(NTHREADS, 2) mk_fwd(Args args) {
    extern __shared__ __attribute__((aligned(16))) unsigned char lds_raw[];
    Frame F;
    F.lds = (LAS unsigned char*)lds_raw;
    F.tid = threadIdx.x; F.lane = F.tid & 63; F.wave = __builtin_amdgcn_readfirstlane(F.tid >> 6);
    F.G = gridDim.x; F.bid = blockIdx.x; F.wsb = args.ws; F.zo = 0u; F.wl = 0u;
    unsigned char* ws = args.ws;
#define INF(k) ((const float*)args.in[k])

    volatile LAS unsigned* MISC = (volatile LAS unsigned*)(F.lds + MISC_OFF);
    if (F.tid < 64) MISC[F.tid] = 0u;
    __syncthreads();
    XcdBarrier bar = xcd_barrier_post((unsigned*)(ws + WS_CTL) + CW_BAR, MISC + 8);
    int ph = 0; const int lo = args.ph_lo, hi = args.ph_hi;
    unsigned long long* TSp = (unsigned long long*)(ws + WS_CTL + 32768); int nst = 0; (void)TSp; (void)nst;
    bool first_seam = true;
#ifndef DUP_MASK
#define DUP_MASK 0
#endif
#ifdef PROBE_LO
#define STAMP() do { if (F.bid == 0 && F.tid == 0) { TSp[nst] = __builtin_amdgcn_s_memrealtime(); } ++nst; } while (0)
#else
#define STAMP() do { } while (0)
#endif
#define GRIDSYNC() xcd_barrier(bar, F.wave == 0 && F.lane == 0)
#define RUN(...) do { if (ph >= lo && ph < hi) { asm volatile("" : "+s"(F.zo), "+s"(F.bid), "+s"(F.G), "+s"(F.wave)); F.lane = (int)__builtin_amdgcn_mbcnt_hi(~0u, __builtin_amdgcn_mbcnt_lo(~0u, F.zo)); asm volatile("" : "+v"(F.lane)); F.tid = F.wave * 64 + F.lane; __VA_ARGS__; } ++ph; } while (0)
#define SEAM() do { if (ph > lo && ph < hi) { if (first_seam) { GRIDSYNC(); first_seam = false; } else xcd_barrier(bar, F.wave == 0 && F.lane == 0); } STAMP(); } while (0)

    STAMP();
    RUN(phase_rope(F, (const int*)args.in[1])); STAMP();
#pragma unroll
    RUN({ const ProIn I{INF(0), INF(2), INF(3), INF(15), INF(16), INF(17), INF(18), INF(20), INF(21), INF(12), INF(4), INF(5), INF(6), INF(7), INF(8), (const int*)args.in[1]};
          phase_prologue(F, I); }); SEAM();
    for (int l = 0; l < DEPTH; ++l) {
        const float* xin = (l == 0) ? INF(0) : args.out;
        F.wl = l ? (unsigned)(WS_W1L - WS_W) : 0u;
        RUN({ pg8::Gemm g{F.H(), F.Win_t()}; pg8::StaticOrder<T, NINP> S; S.init(F.G, F.bid);
              pg8::EpiGen<FInProj> E{FInProj{F.ZS(), F.GB(), F.IW(), F.ROPE(), F.IKD()}}; pg8::gemm_phase<T, NINP, DM, DM, DM>(F.lds, g, S, E, F.tid); }); SEAM();
        RUN({ phase_s5_local(F, l); __syncthreads(); phase_ret_local(F);
              asm volatile("s_waitcnt vmcnt(0)" ::: "memory"); __syncthreads();
              if (F.tid == 0) { unsigned* lc = (unsigned*)(F.wsb + F.zo + WS_CTL) + CW_LOCAL + 64 * l; __builtin_amdgcn_fence(__ATOMIC_RELEASE, "agent"); asm volatile("s_waitcnt vmcnt(0)" ::: "memory"); __hip_atomic_fetch_add(lc, 1u, __ATOMIC_RELAXED, __HIP_MEMORY_SCOPE_AGENT); }
              phase_dsa(F); __syncthreads();
              if (F.tid == 0) { unsigned* lc = (unsigned*)(F.wsb + F.zo + WS_CTL) + CW_LOCAL + 64 * l; unsigned sp = 0u;
                                while (__hip_atomic_load(lc, __ATOMIC_RELAXED, __HIP_MEMORY_SCOPE_AGENT) < (unsigned)F.G) { __builtin_amdgcn_s_sleep(2); if (++sp > (1u << 20)) break; }
                                __builtin_amdgcn_fence(__ATOMIC_ACQUIRE, "agent"); asm volatile("s_waitcnt vmcnt(0)" ::: "memory"); }
              __syncthreads();
              phase_carry(F, l); }); SEAM();
        RUN({ phase_s5_out(F, l, INF(9), INF(10), INF(11)); __syncthreads(); phase_ret_out(F, l, INF(14)); __syncthreads(); }); SEAM();
        RUN({ pg8::Gemm g{F.H(), F.Wglu_t()}; pg8::StaticOrder<T, 256> S; S.init(F.G, F.bid);
              pg8::EpiGen<FGlu, 0> E{FGlu{F.H(), INF(13) + l * 256}}; pg8::gemm_phase<T, 256, 256, DM, 256>(F.lds, g, S, E, F.tid); }); SEAM();
        RUN({ pg8::Gemm g{F.H(), F.Wabc_t()}; pg8::StaticOrder<T, DM> S; S.init(F.G, F.bid);
              EpiMerge E{F.MG(), F.GB()}; pg8::gemm_phase<T, DM, DM, DM, DM>(F.lds, g, S, E, F.tid); }); SEAM();
        RUN({ pg8::Gemm g{F.MG(), F.Wout_t()}; pg8::StaticOrder<T, DM> S; S.init(F.G, F.bid);
              EpiResidNorm E{xin, args.out, F.H(), nullptr, INF(19) + l * DM, F.XB(), F.PANEL(2 * l)}; pg8::gemm_phase<T, DM, DM, DM, DM>(F.lds, g, S, E, F.tid); }); SEAM();
        RUN({ pg8::Gemm g{F.H(), F.W1_t()}; pg8::StaticOrder<T, FF> S; S.init(F.G, F.bid);
              pg8::EpiGen<FRelu2> E{FRelu2{F.FB()}}; pg8::gemm_phase<T, FF, DM, DM, DM>(F.lds, g, S, E, F.tid); }); SEAM();
        RUN({ pg8::Gemm g{F.FB(), F.W2_t()}; pg8::StaticOrder<T, DM> S; S.init(F.G, F.bid);
              const bool lastl = (l + 1 == DEPTH);
              EpiResidNorm E{args.out, lastl ? (float*)nullptr : args.out, lastl ? (bf16_t*)nullptr : F.H(), lastl ? args.out : (float*)nullptr, lastl ? INF(22) : INF(2) + (l + 1) * DM, F.XB(), F.PANEL(2 * l + 1)};
              pg8::gemm_phase<T, DM, FF, FF, FF>(F.lds, g, S, E, F.tid); }); if (l + 1 < DEPTH) SEAM();
    }
    STAMP();
#ifdef PROBE_LO
    if (F.bid == 0 && F.tid == 0) {
        const int sel[] = PROBE_SEL; unsigned long long tot = 0;
        for (unsigned i = 0; i < sizeof(sel) / sizeof(int); ++i) tot += TSp[sel[i] + 1] - TSp[sel[i]];
        const float us = (float)tot * 0.01f;
        asm volatile("s_waitcnt vmcnt(0)" ::: "memory");
        args.out[0] = sqrtf(us * (float)((size_t)T * DM));
    }
#endif
#undef RUN
#undef SEAM
}

extern "C" void kernel_launch(void* const* d_in, const int* in_sizes, int n_in, void* d_out, int out_size, void* d_ws, size_t ws_size, hipStream_t stream) {
    static int grid = 0;
    if (grid == 0) {
        if (n_in != 23 || out_size != T * DM || ws_size < WS_END) { fprintf(stderr, "kernel_launch: unexpected shapes (n_in %d out %d ws %zu)\n", n_in, out_size, ws_size); grid = -1; return; }
        int dev = 0, cus = 0, per_cu = 0;
        hipGetDevice(&dev); hipDeviceGetAttribute(&cus, hipDeviceAttributeMultiprocessorCount, dev);
        if (hipFuncSetAttribute((const void*)mk_fwd, hipFuncAttributeMaxDynamicSharedMemorySize, LDS_BYTES) != hipSuccess) { fprintf(stderr, "kernel_launch: hipFuncSetAttribute failed\n"); grid = -1; return; }
        if (hipOccupancyMaxActiveBlocksPerMultiprocessor(&per_cu, (const void*)mk_fwd, NTHREADS, LDS_BYTES) != hipSuccess || per_cu < 1) { fprintf(stderr, "kernel_launch: occupancy query says %d\n", per_cu); per_cu = 1; }
        (void)hipGetLastError();
        grid = cus;
    }
    if (grid < 0) return;
    hipMemsetAsync((char*)d_ws + WS_CTL, 0, CTL_ZERO_BYTES, stream);
    Args a{};
    for (int i = 0; i < 23; ++i) a.in[i] = d_in[i];
    a.out = (float*)d_out; a.ws = (unsigned char*)d_ws;
#ifndef MK_SPLIT
    a.ph_lo = 0; a.ph_hi = 1000;
    void* kargs[] = {&a};
    hipError_t e = hipLaunchCooperativeKernel((const void*)mk_fwd, dim3(grid), dim3(NTHREADS), kargs, LDS_BYTES, stream);
    if (e != hipSuccess) fprintf(stderr, "kernel_launch: cooperative launch failed: %s\n", hipGetErrorString(e));
#else
    for (int p = 0; p < 2 * 9 + 2; ++p) { a.ph_lo = p; a.ph_hi = p + 1; hipLaunchKernelGGL(mk_fwd, dim3(grid), dim3(NTHREADS), LDS_BYTES, stream, a); }
#endif
}
```

```cpp
#include <hip/hip_runtime.h>
#include <cstdio>
#include <cstdint>

#define LAS __attribute__((address_space(3)))
#define GAS __attribute__((address_space(1)))
typedef unsigned short bf16_t;
typedef short bf16x8 __attribute__((ext_vector_type(8)));
typedef float f32x4 __attribute__((ext_vector_type(4)));
typedef float f32x2 __attribute__((ext_vector_type(2)));
typedef unsigned u32x4 __attribute__((ext_vector_type(4)));
typedef unsigned u32x2 __attribute__((ext_vector_type(2)));

constexpr int NB = 4, SEQ = 8192, T = NB * SEQ, DM = 1024, DEPTH = 2, FF = 4096;
constexpr int NIN = 5156, NINP = 5376;
constexpr int ZSW = 2112, GW = 3072;
constexpr int ZU = 0, ZDQ = 256, ZDK = 640, ZDV = 704, ZIQ = 768, ZIK = 896, ZIWC = 928, ZRQ = 960, ZRK = 1152, ZRV = 1344, ZRG = 1728, ZGATE = 2112, ZEND = 5184;
constexpr int NFREQ = 36;
constexpr float EPS = 1e-6f;

constexpr size_t MiB = 1u << 20;
constexpr size_t WS_CTL = 0, CTL_ZERO_BYTES = 512 * 1024;
constexpr size_t WS_IW = 1 * MiB;
constexpr size_t WS_SP = 1 * MiB + 512 * 1024;
constexpr size_t WS_ROPE = 2 * MiB;
constexpr size_t WS_S5E = 11 * MiB;
constexpr size_t WS_RST = 15 * MiB;
constexpr size_t WS_W = 51 * MiB;
constexpr size_t WO_IN = 0, WO_ABC = WO_IN + (size_t)NINP * DM * 2, WO_OUT = WO_ABC + (size_t)DM * DM * 2, WO_W1 = WO_OUT + (size_t)DM * DM * 2,
                 WO_W2 = WO_W1 + (size_t)FF * DM * 2, WO_GLU = WO_W2 + (size_t)FF * DM * 2, WO_END = WO_GLU + 256 * 256 * 2;
static_assert(WO_END <= 31 * MiB, "weights");
constexpr size_t WS_H = 82 * MiB;
constexpr size_t WS_ZS = 146 * MiB;
constexpr size_t WS_G = 278 * MiB;
constexpr size_t WS_IKD = 470 * MiB;
constexpr size_t WS_XB = 472 * MiB;
constexpr size_t WS_W1L = 474 * MiB;
constexpr size_t WS_END = 505 * MiB;
static_assert(WS_ZS + (size_t)T * ZSW * 2 <= WS_G && WS_G + (size_t)T * GW * 2 <= WS_END && WS_ZS + (size_t)T * FF * 2 <= WS_END, "ws map");
constexpr int CW_BAR = 1024, CW_LOCAL = 8192, CW_PANEL = 32768;

constexpr int LDS_BYTES = 160 * 1024;
constexpr int RING_BYTES = 131072;
constexpr int MISC_OFF = LDS_BYTES - 256;

__device__ __forceinline__ unsigned f2bf(float f) { unsigned u = __builtin_bit_cast(unsigned, f); return (u + 0x7fffu + ((u >> 16) & 1u)) >> 16; }
__device__ __forceinline__ unsigned pk2(float lo, float hi) { unsigned r; asm("v_cvt_pk_bf16_f32 %0, %1, %2" : "=v"(r) : "v"(lo), "v"(hi)); return r; }
__device__ __forceinline__ float bf2f(unsigned short v) { return __builtin_bit_cast(float, (unsigned)v << 16); }
__device__ __forceinline__ float bflo(unsigned w) { return __builtin_bit_cast(float, w << 16); }
__device__ __forceinline__ float bfhi(unsigned w) { return __builtin_bit_cast(float, w & 0xffff0000u); }
__device__ __forceinline__ float sigmoidf_(float x) { return __builtin_amdgcn_rcpf(1.0f + __expf(-x)); }
__device__ __forceinline__ float wave_sum(float v) {
#pragma unroll
    for (int o = 1; o < 64; o <<= 1) v += __shfl_xor(v, o);
    return v;
}
__device__ __forceinline__ float wave_max(float v) {
#pragma unroll
    for (int o = 1; o < 64; o <<= 1) v = fmaxf(v, __shfl_xor(v, o));
    return v;
}

#define XB_TMO      128
#define XB_XCNT(j)  (256  + 64 * (j))
#define XB_XSUB(j)  (1280 + 64 * (j))
#define XB_XGEN(j)  (2304 + 64 * (j))
#define XB_TOP      3328
#define XB_TOPGEN   3392
#define XCD_BAR_WORDS 3456
#define XB_SPIN_CAP (1u << 18)
__device__ __forceinline__ unsigned xb_ld(unsigned* p)              { return __hip_atomic_load(p, __ATOMIC_RELAXED, __HIP_MEMORY_SCOPE_AGENT); }
__device__ __forceinline__ unsigned xb_add(unsigned* p, unsigned v) { return __hip_atomic_fetch_add(p, v, __ATOMIC_RELAXED, __HIP_MEMORY_SCOPE_AGENT); }
__device__ __forceinline__ unsigned xb_xcc_id() { return (unsigned)__builtin_amdgcn_s_getreg((3 << 11) | 20) & 0xFu; }
#define XB_SPIN(cond, bar) do { unsigned _sp = 0; while (cond) { __builtin_amdgcn_s_sleep(1); \
    if ((++_sp & 255u) == 0u) { if (xb_ld(&(bar)[XB_TMO])) break; if (_sp > XB_SPIN_CAP) { atomicAdd(&(bar)[XB_TMO], 1u); break; } } } } while (0)
struct XcdBarrier { unsigned* bar; unsigned x; volatile LAS unsigned* st; };
__device__ __forceinline__ XcdBarrier xcd_barrier_post(unsigned* bar, volatile LAS unsigned* st) {
    XcdBarrier b; b.bar = bar; b.x = xb_xcc_id(); b.st = st;
    if (threadIdx.x == 0) (void)xb_add(&bar[XB_XCNT(b.x)], 1u);
    return b;
}
__device__ __forceinline__ void xcd_barrier_complete(unsigned* bar, unsigned x, unsigned& nloc, unsigned& nx) {
    const unsigned G = gridDim.x * gridDim.y * gridDim.z;
    unsigned sum, cnt, mine, sp = 0u;
    for (;;) {
        sum = 0u; cnt = 0u; mine = 0u;
#pragma unroll
        for (unsigned j = 0; j < 16; ++j) { const unsigned c = xb_ld(&bar[XB_XCNT(j)]); sum += c; cnt += (c > 0u) ? 1u : 0u; mine = (j == x) ? c : mine; }
        if (sum == G) break;
        __builtin_amdgcn_s_sleep(1);
        if ((++sp & 255u) == 0u) { if (xb_ld(&bar[XB_TMO])) break; if (sp > XB_SPIN_CAP) { atomicAdd(&bar[XB_TMO], 1u); break; } }
    }
    nloc = mine > 0u ? mine : 1u; nx = cnt > 0u ? cnt : 1u;
}
__device__ __forceinline__ void xcd_barrier(const XcdBarrier& b, bool leader) {
    asm volatile("s_waitcnt vmcnt(0)" ::: "memory");
    __syncthreads();
    if (leader) {
        unsigned* bar = b.bar; unsigned bx = b.x;
        asm volatile("" : "+s"(bar), "+s"(bx));
        __builtin_amdgcn_s_waitcnt(0);
        unsigned nloc = b.st[0], nx = b.st[1];
        if (nloc == 0u) { xcd_barrier_complete(bar, bx, nloc, nx); b.st[0] = nloc; b.st[1] = nx; }
        const unsigned old = xb_add(&bar[XB_XSUB(bx)], 1u);
        const unsigned gen = old / nloc;
        if (old + 1u == (gen + 1u) * nloc) {
            __builtin_amdgcn_fence(__ATOMIC_RELEASE, "agent");
            asm volatile("s_waitcnt vmcnt(0)" ::: "memory");
            const unsigned og = xb_add(&bar[XB_TOP], 1u);
            const unsigned tg = og / nx;
            if (og + 1u == (tg + 1u) * nx) xb_add(&bar[XB_TOPGEN], 1u);
            else XB_SPIN(xb_ld(&bar[XB_TOPGEN]) == tg, bar);
            __builtin_amdgcn_fence(__ATOMIC_ACQUIRE, "agent");
            xb_add(&bar[XB_XGEN(bx)], 1u);
            asm volatile("s_waitcnt vmcnt(0)" ::: "memory");
        } else {
            XB_SPIN(xb_ld(&bar[XB_XGEN(bx)]) == gen, bar);
            __builtin_amdgcn_fence(__ATOMIC_ACQUIRE, "agent");
            asm volatile("s_waitcnt vmcnt(0)" ::: "memory");
        }
    }
    __syncthreads();
}

namespace pg8 {
constexpr int BM = 256, BK = 64, HALF = 128, HTB = HALF * BK * 2, STAGE_BYTES = 8 * HTB, NXCD = 8, WGM = 8;
__host__ __device__ __forceinline__ int lds_byte(int r, int c) { const int st = (r >> 4) * 2 + (c >> 5), rr = r & 15, cc = c & 31, ob = rr * 64 + cc * 2; return st * 1024 + (ob ^ (((ob >> 9) & 1) << 5)); }
__host__ __device__ __forceinline__ void stage_rc(int b, int& R, int& C) { const int st = b / 1024, sb = b % 1024, swz = sb ^ (((sb >> 9) & 1) << 5); R = (st >> 1) * 16 + swz / 64; C = (st & 1) * 32 + (swz % 64) / 2; }
__host__ __device__ __forceinline__ int perm32(int rho) { const int n = rho >> 4, i = rho & 15; return 8 * (i >> 2) + 4 * n + (i & 3); }

struct Unit { int pm, pn; };
struct Gemm { const bf16_t* A; const bf16_t* Bt; };

template <int M, int N> struct StaticOrder {
    static constexpr int nM = M / BM, nN = N / BM, nwg = nM * nN;
    int G, c;
    __host__ __device__ void init(int G_, int c_) { G = G_; c = c_; }
    __host__ __device__ bool next(int i, Unit& u) const {
        const long L = (long)i * G + c; if (L >= nwg) return false;
        int wgid = (int)L; { constexpr int q = nwg / NXCD, r = nwg % NXCD; const int xcd = wgid % NXCD, off = wgid / NXCD; wgid = (xcd < r ? xcd * (q + 1) : r * (q + 1) + (xcd - r) * q) + off; }
        constexpr int nig = WGM * nN; const int gid = wgid / nig, fm = gid * WGM, gsz = (nM - fm) < WGM ? (nM - fm) : WGM;
        u.pm = fm + ((wgid % nig) % gsz); u.pn = (wgid % nig) / gsz; return true;
    }
};

template <class F, int FENCE = 0> struct EpiGen {
    static constexpr bool PERM = true, HAS_MID = false, FUSED = false;
    F f;
    __device__ __forceinline__ void operator()(const f32x4 (&acc)[2][2][4][2], const Unit& u, int wr, int wc, int fr, int fq) const {
        const int row0 = u.pm * BM + wr * 64 + fr, col0 = u.pn * BM + wc * 32 + 8 * fq;
#pragma unroll
        for (int ai = 0; ai < 2; ++ai)
#pragma unroll
            for (int m = 0; m < 4; ++m)
#pragma unroll
                for (int bj = 0; bj < 2; ++bj) { f(row0 + ai * HALF + m * 16, col0 + bj * HALF, acc[ai][bj][m][0], acc[ai][bj][m][1]);
                    if constexpr (FENCE > 0) { if (((ai * 4 + m) * 2 + bj) % FENCE == FENCE - 1) asm volatile("" ::: "memory"); } }
    }
};

template <int M, int N, int K, int LDA, int LDB, class Epi, bool ALIGN_EPI = true>
__device__ __forceinline__ void gemm_phase(LAS unsigned char* lds, const Gemm g, const StaticOrder<M, N>& S, const Epi& E, int tid_in) {
    int tid = tid_in; asm volatile("" : "+v"(tid));
    const int wid = __builtin_amdgcn_readfirstlane(tid >> 6), lane = tid & 63, wr = wid >> 2, wc = wid & 3, fr = lane & 15, fq = lane >> 4;
    constexpr int nt = K / BK;
    unsigned voffA[2], voffB[2];
#pragma unroll
    for (int i = 0; i < 2; ++i) { int R, C; stage_rc(tid * 16 + i * 8192, R, C); const int Rb = Epi::PERM ? ((R & ~31) + perm32(R & 31)) : R;
        voffA[i] = (unsigned)(R * LDA + C) * 2u; voffB[i] = (unsigned)(Rb * LDB + C) * 2u; }
    constexpr size_t kstep = (size_t)(BK * 2);
    constexpr size_t hstepA = (size_t)HALF * LDA * 2, hstepB = (size_t)HALF * LDB * 2;
    constexpr size_t tstepA = 2 * hstepA, tstepB = 2 * hstepB;
    const unsigned ldsw = (unsigned)wid * 1024u;
    const int aoff = lds_byte(wr * 64 + fr, fq * 8), boff = lds_byte(wc * 32 + fr, fq * 8);
#define PG8_SA(b, h) (((b) * 2 + (h)) * HTB)
#define PG8_SB(b, h) ((4 + (b) * 2 + (h)) * HTB)
#define PG8_STAGE(bufoff, gbase, voff) do { _Pragma("unroll") for (int _i = 0; _i < 2; ++_i) \
        __builtin_amdgcn_global_load_lds((const unsigned*)((const char*)(gbase) + (voff)[_i]), (LAS unsigned*)(lds + (bufoff) + ldsw + _i * 8192), 16, 0, 0); } while (0)
#define PG8_LDA(dst, b, h) do { _Pragma("unroll") for (int m = 0; m < 4; ++m) _Pragma("unroll") for (int k = 0; k < 2; ++k) dst[m][k] = *(const LAS bf16x8*)(lds + PG8_SA(b, h) + aoff + m * 2048 + k * 1024); } while (0)
#define PG8_LDB(dst, b, h) do { _Pragma("unroll") for (int n = 0; n < 2; ++n) _Pragma("unroll") for (int k = 0; k < 2; ++k) dst[n][k] = *(const LAS bf16x8*)(lds + PG8_SB(b, h) + boff + n * 2048 + k * 1024); } while (0)
#define PG8_MMA(ai, bj, At, Bt) do { __builtin_amdgcn_s_setprio(1); _Pragma("unroll") for (int m = 0; m < 4; ++m) _Pragma("unroll") for (int n = 0; n < 2; ++n) _Pragma("unroll") for (int k = 0; k < 2; ++k) \
        acc[ai][bj][m][n] = __builtin_amdgcn_mfma_f32_16x16x32_bf16(Bt[n][k], At[m][k], acc[ai][bj][m][n], 0, 0, 0); __builtin_amdgcn_s_setprio(0); } while (0)
#define PG8_WAIT_V(n) asm volatile("s_waitcnt vmcnt(" #n ")" ::: "memory")
#define PG8_WAIT_L(n) asm volatile("s_waitcnt lgkmcnt(" #n ")" ::: "memory")
#define PG8_BAR __builtin_amdgcn_s_barrier()
#define PG8_SCHED __builtin_amdgcn_sched_barrier(0)
    Unit cur, nxt; int ui = 0;
    if (!S.next(0, cur)) return;
    f32x4 acc[2][2][4][2];
#pragma unroll
    for (int a = 0; a < 2; ++a)
#pragma unroll
        for (int b = 0; b < 2; ++b)
#pragma unroll
            for (int m = 0; m < 4; ++m)
#pragma unroll
                for (int n = 0; n < 2; ++n) acc[a][b][m][n] = (f32x4){0.f, 0.f, 0.f, 0.f};
    bf16x8 At[4][2], B0[2][2], B1[2][2];
    const char* cA = (const char*)g.A + (size_t)cur.pm * tstepA; const char* cB = (const char*)g.Bt + (size_t)cur.pn * tstepB;
    PG8_STAGE(PG8_SB(0, 0), cB, voffB); PG8_STAGE(PG8_SB(0, 1), cB + hstepB, voffB); PG8_STAGE(PG8_SA(0, 0), cA, voffA); PG8_STAGE(PG8_SA(0, 1), cA + hstepA, voffA);
    if (wr == 1) PG8_BAR;
    PG8_WAIT_V(2); PG8_BAR;
    PG8_STAGE(PG8_SB(1, 0), cB + kstep, voffB); PG8_STAGE(PG8_SA(1, 0), cA + kstep, voffA); PG8_STAGE(PG8_SB(1, 1), cB + hstepB + kstep, voffB);
    PG8_WAIT_V(6); PG8_BAR;
    for (;;) {
        const bool has_next = S.next(ui + 1, nxt);
        const char* nA = has_next ? (const char*)g.A + (size_t)nxt.pm * tstepA : cA; const char* nB = has_next ? (const char*)g.Bt + (size_t)nxt.pn * tstepB : cB;
#pragma unroll 1
        for (int t = 0; t < nt; t += 2) {
            const bool last = (t == nt - 2);
            const char* a1 = cA + (size_t)(t + 1) * kstep;
            const char* a2 = last ? nA : cA + (size_t)(t + 2) * kstep; const char* b2 = last ? nB : cB + (size_t)(t + 2) * kstep;
            const char* a3 = a2 + kstep; const char* b3 = b2 + kstep;
            if constexpr (Epi::HAS_MID) { if (t == Epi::MID0 || t == Epi::MID1) E.mid(acc, cur, t, wr, wc, fr, fq); }
            PG8_LDB(B0, 0, 0); PG8_LDB(B1, 0, 1); PG8_SCHED; PG8_LDA(At, 0, 0); PG8_STAGE(PG8_SA(1, 1), a1 + hstepA, voffA);
            PG8_WAIT_V(8); PG8_WAIT_L(0); PG8_BAR; PG8_MMA(0, 0, At, B0); PG8_MMA(0, 1, At, B1); PG8_BAR; PG8_SCHED;
            PG8_LDA(At, 0, 1); PG8_STAGE(PG8_SB(0, 0), b2, voffB); PG8_STAGE(PG8_SB(0, 1), b2 + hstepB, voffB); PG8_STAGE(PG8_SA(0, 0), a2, voffA);
            PG8_WAIT_V(8); PG8_WAIT_L(0); PG8_BAR; PG8_MMA(1, 0, At, B0); PG8_MMA(1, 1, At, B1); PG8_BAR; PG8_SCHED;
            PG8_LDB(B0, 1, 0); PG8_LDB(B1, 1, 1); PG8_SCHED; PG8_LDA(At, 1, 0); PG8_STAGE(PG8_SA(0, 1), a2 + hstepA, voffA);
            PG8_WAIT_V(8); PG8_WAIT_L(0); PG8_BAR; PG8_MMA(0, 0, At, B0); PG8_MMA(0, 1, At, B1); PG8_BAR; PG8_SCHED;
            PG8_LDA(At, 1, 1); PG8_STAGE(PG8_SB(1, 0), b3, voffB); PG8_STAGE(PG8_SB(1, 1), b3 + hstepB, voffB); PG8_STAGE(PG8_SA(1, 0), a3, voffA);
            PG8_WAIT_V(8); PG8_WAIT_L(0); PG8_BAR; PG8_MMA(1, 0, At, B0); PG8_MMA(1, 1, At, B1); PG8_BAR; PG8_SCHED;
        }
        if constexpr (ALIGN_EPI) { if (wr == 0) PG8_BAR; }
        if constexpr (Epi::FUSED) E.fused(acc, cur, wr, wc, fr, fq, lds, wid, lane); else E(acc, cur, wr, wc, fr, fq);
        if (!has_next) break;
#pragma unroll
        for (int a = 0; a < 2; ++a)
#pragma unroll
            for (int b = 0; b < 2; ++b)
#pragma unroll
                for (int m = 0; m < 4; ++m)
#pragma unroll
                    for (int n = 0; n < 2; ++n) acc[a][b][m][n] = (f32x4){0.f, 0.f, 0.f, 0.f};
        cur = nxt; cA = nA; cB = nB; ++ui;
        if constexpr (ALIGN_EPI) { if (wr == 1) PG8_BAR; }
    }
    PG8_WAIT_V(0);
    if constexpr (!ALIGN_EPI) { if (wr == 0) PG8_BAR; }
    PG8_BAR;
#undef PG8_SA
#undef PG8_SB
#undef PG8_STAGE
#undef PG8_LDA
#undef PG8_LDB
#undef PG8_MMA
#undef PG8_WAIT_V
#undef PG8_WAIT_L
#undef PG8_BAR
#undef PG8_SCHED
}
}

constexpr int NWAVES = 8, NTHREADS = 512;
struct Args { const void* in[23]; float* out; unsigned char* ws; int ph_lo, ph_hi; };
struct Frame {
    LAS unsigned char* lds;
    int tid, lane, wave, G, bid;
    unsigned char* wsb; unsigned zo; unsigned wl;
    __device__ __forceinline__ bf16_t* IKD() const { return (bf16_t*)(wsb + zo + WS_IKD); }
    __device__ __forceinline__ float* XB() const { return (float*)(wsb + zo + WS_XB); }
    __device__ __forceinline__ unsigned* PANEL(int bank) const { return (unsigned*)(wsb + zo + WS_CTL) + CW_PANEL + bank * 8192; }
    __device__ __forceinline__ float* IW() const { return (float*)(wsb + zo + WS_IW); }
    __device__ __forceinline__ float* SP(int l) const { return (float*)(wsb + zo + WS_SP) + l * 36864; }
    __device__ __forceinline__ f32x2* ROPE() const { return (f32x2*)(wsb + zo + WS_ROPE); }
    __device__ __forceinline__ f32x2* S5E() const { return (f32x2*)(wsb + zo + WS_S5E); }
    __device__ __forceinline__ float* RST() const { return (float*)(wsb + zo + WS_RST); }
    __device__ __forceinline__ bf16_t* Win_t() const { return (bf16_t*)(wsb + zo + wl + WS_W + WO_IN); }
    __device__ __forceinline__ bf16_t* Wabc_t() const { return (bf16_t*)(wsb + zo + wl + WS_W + WO_ABC); }
    __device__ __forceinline__ bf16_t* Wout_t() const { return (bf16_t*)(wsb + zo + wl + WS_W + WO_OUT); }
    __device__ __forceinline__ bf16_t* W1_t() const { return (bf16_t*)(wsb + zo + wl + WS_W + WO_W1); }
    __device__ __forceinline__ bf16_t* W2_t() const { return (bf16_t*)(wsb + zo + wl + WS_W + WO_W2); }
    __device__ __forceinline__ bf16_t* Wglu_t() const { return (bf16_t*)(wsb + zo + wl + WS_W + WO_GLU); }
    __device__ __forceinline__ bf16_t* H() const { return (bf16_t*)(wsb + zo + WS_H); }
    __device__ __forceinline__ bf16_t* ZS() const { return (bf16_t*)(wsb + zo + WS_ZS); }
    __device__ __forceinline__ unsigned char* GB() const { return wsb + zo + WS_G; }
    __device__ __forceinline__ bf16_t* MG() const { return (bf16_t*)(wsb + zo + WS_ZS); }
    __device__ __forceinline__ bf16_t* FB() const { return (bf16_t*)(wsb + zo + WS_ZS); }
};
constexpr int SP_LB = 0, SP_L64 = 2048, SP_BBR = 4096, SP_BBI = 4096 + 16384;

__device__ __forceinline__ int ropeperm(int j, int r) { const int half = r >> 1; return (j < r) ? ((j & 1) ? half + (j >> 1) : (j >> 1)) : j; }
__device__ __forceinline__ int zmap(int n) {
    if (n < ZDQ) return n;
    if (n < ZDK) { const int q = n - ZDQ, h = q >> 6, hc = q & 63; return 256 + h * 64 + ropeperm(hc, 16); }
    if (n < ZDV) return 640 + ropeperm(n - ZDK, 16);
    if (n < ZIQ) return 704 + (n - ZDV);
    if (n < ZIK) { const int q = n - ZIQ, h = q >> 5, hc = q & 31; return 768 + h * 32 + ropeperm(hc, 8); }
    if (n < ZIWC) return 896 + ropeperm(n - ZIK, 8);
    if (n < ZRQ) return (n - ZIWC) < 4 ? 928 + (n - ZIWC) : -1;
    if (n < ZRK) { const int q = n - ZRQ, h = q / 48, hc = q % 48; return 932 + h * 48 + ropeperm(hc, 48); }
    if (n < ZRV) { const int q = n - ZRK, h = q / 48, hc = q % 48; return 1124 + h * 48 + ropeperm(hc, 48); }
    if (n < ZRG) return 1316 + (n - ZRV);
    if (n < ZGATE) return 1700 + (n - ZRG);
    if (n < ZEND) return 2084 + (n - ZGATE);
    return -1;
}

__device__ __forceinline__ void tr_item(const float* W, int N, int kb, int nb, bf16_t* WT, int ldd, int koff, bool mapped, LAS float* scr, int lane) {
    const int k0 = 64 * kb, n0 = 32 * nb;
    const int c32 = lane & 31; int sc = n0 + c32; if (mapped) sc = zmap(sc);
#pragma unroll 8
    for (int i = 0; i < 32; ++i) { const int kk = 2 * i + (lane >> 5); scr[kk * 33 + c32] = (sc >= 0) ? W[(size_t)(k0 + kk) * N + sc] : 0.f; }
    asm volatile("s_waitcnt lgkmcnt(0)" ::: "memory");
    const int c = lane & 7;
#pragma unroll
    for (int j = 0; j < 4; ++j) { const int n = (lane >> 3) + 8 * j; const LAS float* s = scr + (8 * c) * 33 + n;
        u32x4 o; o.x = pk2(s[0 * 33], s[1 * 33]); o.y = pk2(s[2 * 33], s[3 * 33]); o.z = pk2(s[4 * 33], s[5 * 33]); o.w = pk2(s[6 * 33], s[7 * 33]);
        *(u32x4*)(WT + (size_t)(n0 + n) * ldd + koff + k0 + 8 * c) = o; }
    asm volatile("s_waitcnt lgkmcnt(0)" ::: "memory");
}

__device__ __forceinline__ void rms_row_bf16(const float* xrow, const float* gain, bf16_t* orow, int lane) {
    const f32x4* xr = (const f32x4*)xrow + lane; const f32x4* gr = (const f32x4*)gain + lane;
    f32x4 v[4]; float s = 0.f;
#pragma unroll
    for (int j = 0; j < 4; ++j) { v[j] = xr[64 * j]; s += (v[j].x * v[j].x + v[j].y * v[j].y) + (v[j].z * v[j].z + v[j].w * v[j].w); }
    const float rstd = rsqrtf(wave_sum(s) * (1.f / DM) + EPS);
    u32x2* o8 = (u32x2*)orow + lane;
#pragma unroll
    for (int j = 0; j < 4; ++j) { const f32x4 gg = gr[64 * j]; u32x2 w; w.x = pk2(v[j].x * rstd * gg.x, v[j].y * rstd * gg.y); w.y = pk2(v[j].z * rstd * gg.z, v[j].w * rstd * gg.w); o8[64 * j] = w; }
}
__device__ __forceinline__ void rms_row_f32(const float* xrow, const float* gain, float* orow, int lane) {
    const f32x4* xr = (const f32x4*)xrow + lane; const f32x4* gr = (const f32x4*)gain + lane;
    f32x4 v[4]; float s = 0.f;
#pragma unroll
    for (int j = 0; j < 4; ++j) { v[j] = xr[64 * j]; s += (v[j].x * v[j].x + v[j].y * v[j].y) + (v[j].z * v[j].z + v[j].w * v[j].w); }
    const float rstd = rsqrtf(wave_sum(s) * (1.f / DM) + EPS);
    f32x4* o = (f32x4*)orow + lane;
#pragma unroll
    for (int j = 0; j < 4; ++j) { const f32x4 gg = gr[64 * j]; o[64 * j] = v[j] * rstd * gg; }
}


__device__ __forceinline__ void phase_rope(Frame& F, const int* pos) {
    const int gt = F.bid * NTHREADS + F.tid, NT = F.G * NTHREADS;
    f32x2* RT = F.ROPE();
    for (int e = gt; e < T * NFREQ; e += NT) {
        const int tok = e / NFREQ, f = e % NFREQ;
        float lth, sc; int fi;
        if (f < 8) { lth = 13.122363377404328f; sc = 2.0f / 16.0f; fi = f; } else if (f < 12) { lth = 13.122363377404328f; sc = 2.0f / 8.0f; fi = f - 8; } else { lth = 9.210340371976184f; sc = 2.0f / 48.0f; fi = f - 12; }
        const float inv = expf(-lth * (float)fi * sc);
        const float p = (float)pos[tok];
        const float ang = p * inv;
        const float kq = rintf(ang * 0.15915494309189535f);
        float r = fmaf(-kq, 6.2831854820251465f, ang);
        r = fmaf(-kq, -1.7484555e-7f, r);
        RT[e] = (f32x2){cosf(r), sinf(r)};
    }
}

struct ProIn { const float *xin, *norm1_g, *w_in, *wa, *wb, *wc, *wo, *w1, *w2, *wg, *lam_re, *lam_im, *log_step, *b_re, *b_im; const int* pos; };
__device__ __forceinline__ void phase_prologue(Frame& F, const ProIn& I) {
#ifdef NO_PHASE_PROLOGUE
    return;
#endif
    LAS float* scr = (LAS float*)(F.lds + F.wave * 16384);
    const int gw = F.bid * NWAVES + F.wave, NGW = F.G * NWAVES;
#pragma unroll 1
    for (int l = 0; l < DEPTH; ++l) {
    F.wl = l ? (unsigned)(WS_W1L - WS_W) : 0u;
    constexpr int I_IN = 16 * (NINP / 32), I_A = 4 * 32, I_B = 6 * 32, I_C = 6 * 32, I_O = 16 * 32, I_1 = 16 * 128, I_2 = 64 * 32, I_G = 4 * 8;
    constexpr int NITEMS = I_IN + I_A + I_B + I_C + I_O + I_1 + I_2 + I_G;
    const float* w_in = I.w_in + (size_t)l * DM * NIN; const float* wa = I.wa + (size_t)l * 256 * DM; const float* wb = I.wb + (size_t)l * 384 * DM;
    const float* wc = I.wc + (size_t)l * 384 * DM; const float* wo = I.wo + (size_t)l * DM * DM; const float* w1 = I.w1 + (size_t)l * DM * FF;
    const float* w2 = I.w2 + (size_t)l * FF * DM; const float* wg = I.wg + (size_t)l * 256 * 256;
    for (int it = gw; it < NITEMS; it += NGW) {
        int r = it;
        if (r < I_IN) { tr_item(w_in, NIN, r / (NINP / 32), r % (NINP / 32), F.Win_t(), DM, 0, true, scr, F.lane); continue; } r -= I_IN;
        if (r < I_A) { tr_item(wa, DM, r / 32, r % 32, F.Wabc_t(), DM, 0, false, scr, F.lane); continue; } r -= I_A;
        if (r < I_B) { tr_item(wb, DM, r / 32, r % 32, F.Wabc_t(), DM, 256, false, scr, F.lane); continue; } r -= I_B;
        if (r < I_C) { tr_item(wc, DM, r / 32, r % 32, F.Wabc_t(), DM, 640, false, scr, F.lane); continue; } r -= I_C;
        if (r < I_O) { tr_item(wo, DM, r / 32, r % 32, F.Wout_t(), DM, 0, false, scr, F.lane); continue; } r -= I_O;
        if (r < I_1) { tr_item(w1, FF, r / 128, r % 128, F.W1_t(), DM, 0, false, scr, F.lane); continue; } r -= I_1;
        if (r < I_2) { tr_item(w2, DM, r / 32, r % 32, F.W2_t(), FF, 0, false, scr, F.lane); continue; } r -= I_2;
        tr_item(wg, 256, r / 8, r % 8, F.Wglu_t(), 256, 0, false, scr, F.lane);
    }
    {
        const int gt = F.bid * NTHREADS + F.tid;
        if (gt < 1024) {
            float* SPp = F.SP(l);
            const int g = gt >> 6, p = gt & 63;
            const float lr = I.lam_re[(l * 16 + g) * 64 + p], li = I.lam_im[(l * 16 + g) * 64 + p];
            const float step = expf(I.log_step[l * 16 + g]);
            const float mag = expf(lr * step); const float lbr = mag * cosf(li * step), lbi = mag * sinf(li * step);
            const float den = lr * lr + li * li;
            const float fr = ((lbr - 1.f) * lr + lbi * li) / den, fi = (lbi * lr - (lbr - 1.f) * li) / den;
            SPp[SP_LB + gt * 2] = lbr; SPp[SP_LB + gt * 2 + 1] = lbi;
            float pr = lbr, pi = lbi;
#pragma unroll
            for (int s = 0; s < 6; ++s) { const float nr = pr * pr - pi * pi, ni = 2.f * pr * pi; pr = nr; pi = ni; }
            SPp[SP_L64 + gt * 2] = pr; SPp[SP_L64 + gt * 2 + 1] = pi;
            const float* br = I.b_re + ((size_t)(l * 16 + g) * 64 + p) * 16; const float* bi = I.b_im + ((size_t)(l * 16 + g) * 64 + p) * 16;
#pragma unroll
            for (int c = 0; c < 16; ++c) { SPp[SP_BBR + gt * 16 + c] = fr * br[c] - fi * bi[c]; SPp[SP_BBI + gt * 16 + c] = fr * bi[c] + fi * br[c]; }
        }
    }
    }
    F.wl = 0u;
    for (int m = gw; m < T; m += NGW) rms_row_bf16(I.xin + (size_t)m * DM, I.norm1_g, F.H() + (size_t)m * DM, F.lane);
}

__device__ __forceinline__ u32x4 pack8(const f32x4& a, const f32x4& b) { u32x4 w; w.x = pk2(a.x, a.y); w.y = pk2(a.z, a.w); w.z = pk2(b.x, b.y); w.w = pk2(b.z, b.w); return w; }
__device__ __forceinline__ void unpack8(const u32x4& w, f32x4& a, f32x4& b) { a = (f32x4){bflo(w.x), bfhi(w.x), bflo(w.y), bfhi(w.y)}; b = (f32x4){bflo(w.z), bfhi(w.z), bflo(w.w), bfhi(w.w)}; }

__device__ __forceinline__ unsigned gate1_u8(float x) { const float s = 255.f * sigmoidf_(x) + 0.5f; const unsigned u = (unsigned)s; return u < 1u ? 1u : u; }
__device__ __forceinline__ unsigned gate4_u8(const f32x4& a) { return gate1_u8(a.x) | (gate1_u8(a.y) << 8) | (gate1_u8(a.z) << 16) | (gate1_u8(a.w) << 24); }
__device__ __forceinline__ void ungate8(const u32x2& w, f32x4& a, f32x4& b) {
    a = (f32x4){(float)(w.x & 255u), (float)((w.x >> 8) & 255u), (float)((w.x >> 16) & 255u), (float)(w.x >> 24)};
    b = (f32x4){(float)(w.y & 255u), (float)((w.y >> 8) & 255u), (float)((w.y >> 16) & 255u), (float)(w.y >> 24)};
}
struct FInProj {
    bf16_t* ZS; unsigned char* GB; float* IW; const f32x2* ROPE; bf16_t* IKD;
    __device__ __forceinline__ void rope8(f32x4& a, f32x4& b, int row, int f0) const {
        const f32x2* rt = ROPE + (size_t)row * NFREQ + f0;
        const f32x2 c0 = rt[0], c1 = rt[1], c2 = rt[2], c3 = rt[3];
        f32x4 oa, ob;
        oa.x = a.x * c0.x - a.y * c0.y; oa.y = a.y * c0.x + a.x * c0.y;
        oa.z = a.z * c1.x - a.w * c1.y; oa.w = a.w * c1.x + a.z * c1.y;
        ob.x = b.x * c2.x - b.y * c2.y; ob.y = b.y * c2.x + b.x * c2.y;
        ob.z = b.z * c3.x - b.w * c3.y; ob.w = b.w * c3.x + b.z * c3.y;
        a = oa; b = ob;
    }
    __device__ __forceinline__ void operator()(int row, int col, f32x4 a, f32x4 b) const {
        if (col >= ZEND) return;
        if (col >= ZGATE) {
            *(u32x2*)(GB + (size_t)row * GW + (col - ZGATE)) = (u32x2){gate4_u8(a), gate4_u8(b)}; return;
        }
        if (col >= ZIWC && col < ZRQ) { if (col == ZIWC) *(f32x4*)(IW + (size_t)row * 4) = a; return; }
        if (col >= ZDQ && col < ZDV) { const int hc = (col - ZDQ) & 63; if (hc < 16) rope8(a, b, row, hc >> 1); }
        else if (col >= ZIQ && col < ZIWC) { const int hc = (col - ZIQ) & 31; if (hc < 8) rope8(a, b, row, 8);
            if (col >= ZIK) { *(u32x4*)(IKD + ((size_t)((row >> 5) * 4 + ((col - ZIK) >> 3)) * 32 + (row & 31)) * 8) = pack8(a, b); return; } }
        else if (col >= ZRQ && col < ZRV) { const int hc = (col - ZRQ) % 48; rope8(a, b, row, 12 + (hc >> 1)); }
        *(u32x4*)(ZS + (size_t)row * ZSW + col) = pack8(a, b);
    }
};
struct FMerge {
    bf16_t* MG; const bf16_t* GB; int br;
    __device__ __forceinline__ void operator()(int row, int col, f32x4 a, f32x4 b) const {
        f32x4 ga, gb; unpack8(*(const u32x4*)(GB + (size_t)row * GW + br * DM + col), ga, gb);
        a = a * ga; b = b * gb;
        u32x4* mp = (u32x4*)(MG + (size_t)row * DM + col);
        if (br != 0) { f32x4 pa, pb; unpack8(*mp, pa, pb); a = a + pa; b = b + pb; }
        *mp = pack8(a, b);
    }
};
struct FResid {
    const float* base; float* out;
    __device__ __forceinline__ void operator()(int row, int col, f32x4 a, f32x4 b) const {
        const f32x4* bp = (const f32x4*)(base + (size_t)row * DM + col); f32x4* op = (f32x4*)(out + (size_t)row * DM + col);
        const f32x4 b0 = bp[0], b1 = bp[1]; op[0] = b0 + a; op[1] = b1 + b;
    }
};
struct FRelu2 {
    bf16_t* FB;
    __device__ __forceinline__ void operator()(int row, int col, f32x4 a, f32x4 b) const {
        a = (f32x4){fmaxf(a.x, 0.f), fmaxf(a.y, 0.f), fmaxf(a.z, 0.f), fmaxf(a.w, 0.f)}; b = (f32x4){fmaxf(b.x, 0.f), fmaxf(b.y, 0.f), fmaxf(b.z, 0.f), fmaxf(b.w, 0.f)};
        *(u32x4*)(FB + (size_t)row * FF + col) = pack8(a * a, b * b);
    }
};
struct FGlu {
    bf16_t* H; const float* bias;
    __device__ __forceinline__ void operator()(int row, int col, f32x4 a, f32x4 b) const {
        u32x4* hp = (u32x4*)(H + (size_t)row * DM + col); f32x4 ya, yb; unpack8(*hp, ya, yb);
        const f32x4 ba = *(const f32x4*)(bias + col), bb = *(const f32x4*)(bias + col + 4);
        a = a + ba; b = b + bb;
        a = (f32x4){ya.x * sigmoidf_(a.x), ya.y * sigmoidf_(a.y), ya.z * sigmoidf_(a.z), ya.w * sigmoidf_(a.w)};
        b = (f32x4){yb.x * sigmoidf_(b.x), yb.y * sigmoidf_(b.y), yb.z * sigmoidf_(b.z), yb.w * sigmoidf_(b.w)};
        *hp = pack8(a, b);
    }
};

struct EpiMerge {
    static constexpr bool PERM = true, HAS_MID = true, FUSED = false; static constexpr int MID0 = 4, MID1 = 10;
    bf16_t* MG; const unsigned char* GB;
    __device__ __forceinline__ void mid(f32x4 (&acc)[2][2][4][2], const pg8::Unit& u, int t, int wr, int wc, int fr, int fq) const {
        int zz = 0; asm volatile("" : "+v"(zz));
        const int row0 = u.pm * 256 + wr * 64 + fr + zz, col0 = u.pn * 256 + wc * 32 + 8 * fq, bp = (t == MID0) ? 0 : 1;
#pragma unroll
        for (int ai = 0; ai < 2; ++ai)
#pragma unroll
            for (int m = 0; m < 4; ++m) {
#pragma unroll
                for (int bj = 0; bj < 2; ++bj) {
                    const unsigned char* gp = GB + (size_t)(row0 + ai * 128 + m * 16) * GW + bp * DM + col0 + bj * 128;
                    f32x4 pa, pb, na, nb; ungate8(*(const u32x2*)gp, pa, pb); ungate8(*(const u32x2*)(gp + DM), na, nb);
                    const f32x4 fa = {pa.x * __builtin_amdgcn_rcpf(na.x), pa.y * __builtin_amdgcn_rcpf(na.y), pa.z * __builtin_amdgcn_rcpf(na.z), pa.w * __builtin_amdgcn_rcpf(na.w)};
                    const f32x4 fb = {pb.x * __builtin_amdgcn_rcpf(nb.x), pb.y * __builtin_amdgcn_rcpf(nb.y), pb.z * __builtin_amdgcn_rcpf(nb.z), pb.w * __builtin_amdgcn_rcpf(nb.w)};
                    acc[ai][bj][m][0] = acc[ai][bj][m][0] * fa; acc[ai][bj][m][1] = acc[ai][bj][m][1] * fb;
                }
                if (m == 3) asm volatile("" ::: "memory");
            }
    }
    __device__ __forceinline__ void operator()(const f32x4 (&acc)[2][2][4][2], const pg8::Unit& u, int wr, int wc, int fr, int fq) const {
        const int row0 = u.pm * 256 + wr * 64 + fr, col0 = u.pn * 256 + wc * 32 + 8 * fq;
#pragma unroll
        for (int ai = 0; ai < 2; ++ai)
#pragma unroll
            for (int m = 0; m < 4; ++m)
#pragma unroll
                for (int bj = 0; bj < 2; ++bj) {
                    const int row = row0 + ai * 128 + m * 16, col = col0 + bj * 128;
                    f32x4 ga, gb; ungate8(*(const u32x2*)(GB + (size_t)row * GW + 2 * DM + col), ga, gb);
                    *(u32x4*)(MG + (size_t)row * DM + col) = pack8(acc[ai][bj][m][0] * (ga * (1.f / 255.f)), acc[ai][bj][m][1] * (gb * (1.f / 255.f)));
                }
    }
};

struct EpiResidNorm {
    static constexpr bool PERM = true, HAS_MID = false, FUSED = true;
    const float* base; float* XOUT; bf16_t* HN; float* NOUT; const float* gain; float* xbuf; unsigned* cnt;
    __device__ __forceinline__ void fused(f32x4 (&acc)[2][2][4][2], const pg8::Unit& u, int wr, int wc, int fr, int fq, LAS unsigned char* lds, int wid, int lane) const {
        LAS float* P = (LAS float*)(lds + 131072);
        LAS float* S = (LAS float*)(lds + 131072 + 4096);
        LAS unsigned* flag = (LAS unsigned*)(lds + 131072 + 5120);
        int zz = 0; asm volatile("" : "+v"(zz));
        const int rl0 = wr * 64 + fr + zz, row0 = u.pm * 256 + rl0, col0 = u.pn * 256 + wc * 32 + 8 * fq;
#pragma unroll
        for (int ai = 0; ai < 2; ++ai) {
#pragma unroll
            for (int m = 0; m < 4; ++m) {
                float ss = 0.f;
#pragma unroll
                for (int bj = 0; bj < 2; ++bj) {
                    const size_t off = (size_t)(row0 + ai * 128 + m * 16) * DM + col0 + bj * 128;
                    const f32x4 x0 = *(const f32x4*)(base + off) + acc[ai][bj][m][0], x1 = *(const f32x4*)(base + off + 4) + acc[ai][bj][m][1];
                    acc[ai][bj][m][0] = x0; acc[ai][bj][m][1] = x1;
                    if (XOUT) { *(f32x4*)(XOUT + off) = x0; *(f32x4*)(XOUT + off + 4) = x1; }
                    ss += (x0.x * x0.x + x0.y * x0.y) + (x0.z * x0.z + x0.w * x0.w) + (x1.x * x1.x + x1.y * x1.y) + (x1.z * x1.z + x1.w * x1.w);
                }
                ss += __shfl_xor(ss, 16); ss += __shfl_xor(ss, 32);
                if (fq == 0) P[(rl0 + ai * 128 + m * 16) * 4 + wc] = ss;
            }
            asm volatile("" ::: "memory");
        }
        asm volatile("s_waitcnt lgkmcnt(0)" ::: "memory"); __builtin_amdgcn_s_barrier(); asm volatile("" ::: "memory");
        const int rowt = wid * 64 + lane;
        if (wid < 4) {
            const f32x4 p = *(const LAS f32x4*)(P + rowt * 4);
            __hip_atomic_store(xbuf + (size_t)(u.pm * 256 + rowt) * 4 + u.pn, (p.x + p.y) + (p.z + p.w), __ATOMIC_RELAXED, __HIP_MEMORY_SCOPE_AGENT);
        }
        asm volatile("s_waitcnt vmcnt(0)" ::: "memory");
        if (lane == 0) __hip_atomic_fetch_add(cnt + 64 * u.pm, 1u, __ATOMIC_RELAXED, __HIP_MEMORY_SCOPE_AGENT);
        if (wid == 0) {
            unsigned sp = 0u;
            for (;;) {
                if ((unsigned)__builtin_amdgcn_readfirstlane(__hip_atomic_load(cnt + 64 * u.pm, __ATOMIC_RELAXED, __HIP_MEMORY_SCOPE_AGENT)) >= 32u) break;
                __builtin_amdgcn_s_sleep(2);
                if (++sp > (1u << 20)) break;
            }
            __builtin_amdgcn_fence(__ATOMIC_ACQUIRE, "agent");
            if (lane == 0) flag[0] = 1u;
        }
        asm volatile("s_waitcnt vmcnt(0) lgkmcnt(0)" ::: "memory"); __builtin_amdgcn_s_barrier(); asm volatile("" ::: "memory");
        if (wid < 4) {
            const float* sl = xbuf + (size_t)(u.pm * 256 + rowt) * 4;
            const float s = (__hip_atomic_load(sl, __ATOMIC_RELAXED, __HIP_MEMORY_SCOPE_AGENT) + __hip_atomic_load(sl + 1, __ATOMIC_RELAXED, __HIP_MEMORY_SCOPE_AGENT))
                          + (__hip_atomic_load(sl + 2, __ATOMIC_RELAXED, __HIP_MEMORY_SCOPE_AGENT) + __hip_atomic_load(sl + 3, __ATOMIC_RELAXED, __HIP_MEMORY_SCOPE_AGENT));
            S[rowt] = rsqrtf(s * (1.f / DM) + EPS);
        }
        asm volatile("s_waitcnt vmcnt(0) lgkmcnt(0)" ::: "memory"); __builtin_amdgcn_s_barrier(); asm volatile("" ::: "memory");
#pragma unroll
        for (int bj = 0; bj < 2; ++bj) {
            const f32x4 g0 = *(const f32x4*)(gain + col0 + bj * 128), g1 = *(const f32x4*)(gain + col0 + bj * 128 + 4);
#pragma unroll
            for (int ai = 0; ai < 2; ++ai)
#pragma unroll
                for (int m = 0; m < 4; ++m) {
                    const float rs = S[rl0 + ai * 128 + m * 16];
                    const size_t off = (size_t)(row0 + ai * 128 + m * 16) * DM + col0 + bj * 128;
                    const f32x4 y0 = acc[ai][bj][m][0] * rs * g0, y1 = acc[ai][bj][m][1] * rs * g1;
                    if (HN) *(u32x4*)(HN + off) = pack8(y0, y1);
                    if (NOUT) { *(f32x4*)(NOUT + off) = y0; *(f32x4*)(NOUT + off + 4) = y1; }
                }
        }
        asm volatile("s_waitcnt lgkmcnt(0)" ::: "memory"); __builtin_amdgcn_s_barrier(); asm volatile("" ::: "memory");
    }
    __device__ __forceinline__ void operator()(const f32x4 (&)[2][2][4][2], const pg8::Unit&, int, int, int, int) const {}
};

typedef float f32x16 __attribute__((ext_vector_type(16)));
__device__ __forceinline__ float gelu_tanh(float x) { const float u = 0.7978845608028654f * (x + 0.044715f * x * x * x); const float e = __expf(2.f * u); const float th = 1.f - 2.f * __builtin_amdgcn_rcpf(e + 1.f); return 0.5f * x * (1.f + th); }
constexpr int S5_XSTR = 272;
constexpr int S5_WAVE_LDS = 2 * 16 * S5_XSTR;
template <bool OUT>
__device__ __forceinline__ void s5_pass(Frame& F, int l, const float* c_re, const float* c_im, const float* ssm_d) {
    const bf16_t* ZSp = F.ZS(); const float* SPp = F.SP(l); f32x2* S5Ep = F.S5E();
    LAS unsigned char* XL = F.lds + F.wave * S5_WAVE_LDS;
    for (int task = F.bid * NWAVES + F.wave; task < 256 * 16; task += F.G * NWAVES) {
        int lane = F.lane; asm volatile("" : "+v"(lane));
        const int n = lane & 31, hh = lane >> 5, l15 = lane & 15, kg = lane >> 4;
        const int g = task & 15, pp = task >> 4, cmine = 2 * pp + hh;
        bf16x8 bbf[2][2];
#pragma unroll
        for (int st = 0; st < 2; ++st) { const float* br = SPp + SP_BBR + (size_t)(g * 64 + 2 * n + st) * 16 + 8 * hh; const float* bi = SPp + SP_BBI + (size_t)(g * 64 + 2 * n + st) * 16 + 8 * hh;
            bbf[st][0] = __builtin_bit_cast(bf16x8, pack8(*(const f32x4*)br, *(const f32x4*)(br + 4))); bbf[st][1] = __builtin_bit_cast(bf16x8, pack8(*(const f32x4*)bi, *(const f32x4*)(bi + 4))); }
        const f32x4 lb = *(const f32x4*)(SPp + SP_LB + (g * 64 + 2 * n) * 2);
        f32x4 x = {0.f, 0.f, 0.f, 0.f};
        if constexpr (OUT) x = *(const f32x4*)(S5Ep + (size_t)(cmine * 16 + g) * 64 + 2 * n);
        bf16x8 cf[4]; f32x4 dsk = {0.f, 0.f, 0.f, 0.f};
        if constexpr (OUT) {
#pragma unroll
            for (int ks = 0; ks < 4; ++ks) { const float* cp = ((ks < 2) ? c_re : c_im) + ((size_t)(l * 16 + g) * 16 + l15) * 64 + 32 * (ks & 1) + 8 * kg;
                f32x4 a = *(const f32x4*)cp, b = *(const f32x4*)(cp + 4); if (ks >= 2) { a = -a; b = -b; }
                cf[ks] = __builtin_bit_cast(bf16x8, pack8(a, b)); }
            dsk = *(const f32x4*)(ssm_d + (l * 16 + g) * 16 + 4 * kg);
        }
        const bf16_t* urow = ZSp + (size_t)((2 * pp + ((n >> 2) & 1)) * 64 + 4 * (n >> 3) + (n & 3)) * ZSW + ZU + g * 16 + 8 * hh;
#pragma unroll 1
        for (int k = 0; k < 4; ++k) {
            const bf16x8 uf = *(const bf16x8*)(urow + (size_t)(16 * k) * ZSW);
            const f32x16 z16 = {0.f, 0.f, 0.f, 0.f, 0.f, 0.f, 0.f, 0.f, 0.f, 0.f, 0.f, 0.f, 0.f, 0.f, 0.f, 0.f};
            const f32x16 r0 = __builtin_amdgcn_mfma_f32_32x32x16_bf16(uf, bbf[0][0], z16, 0, 0, 0), i0 = __builtin_amdgcn_mfma_f32_32x32x16_bf16(uf, bbf[0][1], z16, 0, 0, 0);
            const f32x16 r1 = __builtin_amdgcn_mfma_f32_32x32x16_bf16(uf, bbf[1][0], z16, 0, 0, 0), i1 = __builtin_amdgcn_mfma_f32_32x32x16_bf16(uf, bbf[1][1], z16, 0, 0, 0);
#pragma unroll
            for (int t = 0; t < 16; ++t) {
                const float nr0 = lb.x * x.x - lb.y * x.y + r0[t], ni0 = lb.x * x.y + lb.y * x.x + i0[t];
                const float nr1 = lb.z * x.z - lb.w * x.w + r1[t], ni1 = lb.z * x.w + lb.w * x.z + i1[t];
                x = (f32x4){nr0, ni0, nr1, ni1};
                if constexpr (OUT) { LAS unsigned* xw = (LAS unsigned*)(XL + (hh * 16 + t) * S5_XSTR + 4 * n); xw[0] = pk2(nr0, nr1); xw[32] = pk2(ni0, ni1); }
            }
            if constexpr (OUT) {
                asm volatile("s_waitcnt lgkmcnt(0)" ::: "memory");
#pragma unroll
                for (int sel = 0; sel < 2; ++sel) {
                    f32x4 y = {0.f, 0.f, 0.f, 0.f};
#pragma unroll
                    for (int ks = 0; ks < 4; ++ks) { const bf16x8 xf = *(const LAS bf16x8*)(XL + (sel * 16 + l15) * S5_XSTR + (32 * ks + 8 * kg) * 2); y = __builtin_amdgcn_mfma_f32_16x16x32_bf16(cf[ks], xf, y, 0, 0, 0); }
                    const size_t tok = (size_t)(2 * pp + sel) * 64 + 16 * k + l15;
                    const u32x2 uw = *(const u32x2*)(ZSp + tok * ZSW + ZU + g * 16 + 4 * kg);
                    const float y0 = gelu_tanh(y.x + dsk.x * bflo(uw.x)), y1 = gelu_tanh(y.y + dsk.y * bfhi(uw.x)), y2 = gelu_tanh(y.z + dsk.z * bflo(uw.y)), y3 = gelu_tanh(y.w + dsk.w * bfhi(uw.y));
                    *(u32x2*)(F.H() + tok * DM + g * 16 + 4 * kg) = (u32x2){pk2(y0, y1), pk2(y2, y3)};
                }
                asm volatile("s_waitcnt lgkmcnt(0)" ::: "memory");
            }
        }
        if constexpr (!OUT) *(f32x4*)(S5Ep + (size_t)(cmine * 16 + g) * 64 + 2 * n) = x;
    }
}
__device__ __forceinline__ void phase_s5_local(Frame& F, int l) {
#ifdef NO_PHASE_S5_LOCAL
    return;
#endif
    s5_pass<false>(F, l, nullptr, nullptr, nullptr);
}
__device__ __forceinline__ void phase_s5_out(Frame& F, int l, const float* c_re, const float* c_im, const float* ssm_d) {
#ifdef NO_PHASE_S5_OUT
    return;
#endif
    s5_pass<true>(F, l, c_re, c_im, ssm_d);
}

__device__ __forceinline__ void phase_carry(Frame& F, int l) {
#ifdef NO_PHASE_CARRY
    return;
#endif
    const float* SPp = F.SP(l); f32x2* S5Ep = F.S5E(); float* RSTp = F.RST();
    const int gw = F.bid * NWAVES + F.wave, NGW = F.G * NWAVES;
    for (int task = gw; task < NB * 16; task += NGW) {
        const int b = task >> 4, g = task & 15, p = F.lane;
        const float ar = SPp[SP_L64 + (g * 64 + p) * 2], ai = SPp[SP_L64 + (g * 64 + p) * 2 + 1];
        float sr = 0.f, si = 0.f;
        for (int c0 = 0; c0 < 128; c0 += 16) {
            f32x2 e[16];
#pragma unroll
            for (int j = 0; j < 16; ++j) e[j] = S5Ep[(size_t)((b * 128 + c0 + j) * 16 + g) * 64 + p];
#pragma unroll
            for (int j = 0; j < 16; ++j) { S5Ep[(size_t)((b * 128 + c0 + j) * 16 + g) * 64 + p] = (f32x2){sr, si}; const float nr = ar * sr - ai * si + e[j].x, ni = ar * si + ai * sr + e[j].y; sr = nr; si = ni; }
        }
    }
    const int NT = F.G * NTHREADS;
    for (int gt = F.bid * NTHREADS + F.tid; gt < NB * 4 * 4608; gt += NT) {
        const int b = gt / (4 * 4608), h = (gt / 4608) & 3, el = gt % 4608;
        const float lg = log1pf(-exp2f(-5.f - (float)h));
        const float cdec = expf(lg * 64.f);
        float s = 0.f;
        for (int c0 = 0; c0 < 128; c0 += 16) {
            float d[16];
#pragma unroll
            for (int j = 0; j < 16; ++j) d[j] = RSTp[(size_t)((b * 128 + c0 + j) * 4 + h) * 4608 + el];
#pragma unroll
            for (int j = 0; j < 16; ++j) { RSTp[(size_t)((b * 128 + c0 + j) * 4 + h) * 4608 + el] = s; s = s * cdec + d[j]; }
        }
    }
}

typedef float f32x16 __attribute__((ext_vector_type(16)));
typedef short s16x4 __attribute__((ext_vector_type(4)));
__device__ __forceinline__ bf16x8 tr8(const LAS unsigned char* a0, const LAS unsigned char* a1) {
    const s16x4 lo = __builtin_bit_cast(s16x4, __builtin_amdgcn_ds_read_tr16_b64_v4i16((LAS s16x4*)a0));
    const s16x4 hi = __builtin_bit_cast(s16x4, __builtin_amdgcn_ds_read_tr16_b64_v4i16((LAS s16x4*)a1));
    return (bf16x8){lo[0], lo[1], lo[2], lo[3], hi[0], hi[1], hi[2], hi[3]};
}
__device__ __forceinline__ bf16x8 pack8f(const f32x4& a, const f32x4& b) { return __builtin_bit_cast(bf16x8, pack8(a, b)); }
__device__ __forceinline__ void ret_stage_v(const bf16_t* ZSp, LAS unsigned char* Vb, int tok0, int h, int lane) {
#pragma unroll
    for (int n = 0; n < 12; ++n) { const int o = n * 1024 + 16 * lane, r = o / 192, ch = (o % 192) >> 4;
        __builtin_amdgcn_global_load_lds((const unsigned*)(ZSp + (size_t)(tok0 + r) * ZSW + ZRV + h * 96 + ch * 8), (LAS unsigned*)(Vb + n * 1024), 16, 0, 0); }
}
constexpr int RET_VB = 12288, RET_KSTR = 112, RET_WAVE_LDS = RET_VB + 64 * RET_KSTR;
__device__ __forceinline__ void phase_ret_local(Frame& F) {
#ifdef NO_PHASE_RET_LOCAL
    return;
#endif
    const bf16_t* ZSp = F.ZS(); float* RSTp = F.RST();
    LAS unsigned char* Vb = F.lds + F.wave * RET_WAVE_LDS; LAS unsigned char* Kb = Vb + RET_VB;
    for (int item = F.bid * NWAVES + F.wave; item < 2048; item += F.G * NWAVES) {
        int lane = F.lane; asm volatile("" : "+v"(lane));
        const int l31 = lane & 31, hh = lane >> 5, g1 = (lane >> 4) & 1, q4 = (lane & 15) >> 2, p4 = lane & 3;
        const int h = item & 3, tok0 = (item >> 2) * 64;
        ret_stage_v(ZSp, Vb, tok0, h, lane);
        const float lg2 = log2f(1.f - exp2f(-5.f - (float)h));
#pragma unroll
        for (int n = 0; n < 6; ++n) { const int idx = n * 64 + lane, r = idx / 6, ch = idx % 6;
            f32x4 a, b; unpack8(*(const u32x4*)(ZSp + (size_t)(tok0 + r) * ZSW + ZRK + h * 48 + ch * 8), a, b);
            const float sc = 0.14433756729740643f * exp2f(lg2 * (float)(63 - r));
            *(LAS u32x4*)(Kb + r * RET_KSTR + ch * 16) = pack8(a * sc, b * sc); }
        asm volatile("s_waitcnt vmcnt(0) lgkmcnt(0)" ::: "memory");
        f32x16 acc[3][2];
#pragma unroll
        for (int me = 0; me < 3; ++me)
#pragma unroll
            for (int nt = 0; nt < 2; ++nt) acc[me][nt] = (f32x16){0.f, 0.f, 0.f, 0.f, 0.f, 0.f, 0.f, 0.f, 0.f, 0.f, 0.f, 0.f, 0.f, 0.f, 0.f, 0.f};
#pragma unroll
        for (int s = 0; s < 4; ++s) {
            const int r0 = 16 * s + 8 * hh + q4;
            bf16x8 kf[2], vf[3];
#pragma unroll
            for (int nt = 0; nt < 2; ++nt) { const LAS unsigned char* a0 = Kb + r0 * RET_KSTR + (32 * nt + 16 * g1 + 4 * p4) * 2; kf[nt] = tr8(a0, a0 + 4 * RET_KSTR); }
#pragma unroll
            for (int me = 0; me < 3; ++me) { const LAS unsigned char* a0 = Vb + r0 * 192 + (32 * me + 16 * g1 + 4 * p4) * 2; vf[me] = tr8(a0, a0 + 4 * 192); }
#pragma unroll
            for (int me = 0; me < 3; ++me)
#pragma unroll
                for (int nt = 0; nt < 2; ++nt) acc[me][nt] = __builtin_amdgcn_mfma_f32_32x32x16_bf16(vf[me], kf[nt], acc[me][nt], 0, 0, 0);
        }
        float* dst = RSTp + (size_t)item * 4608 + (4 * hh) * 48 + l31;
#pragma unroll
        for (int me = 0; me < 3; ++me)
#pragma unroll
            for (int r4 = 0; r4 < 4; ++r4) {
                int zz = 0; asm volatile("" : "+v"(zz)); float* dp = dst + (32 * me + 8 * r4) * 48 + zz;
#pragma unroll
                for (int k = 0; k < 4; ++k) { dp[k * 48] = acc[me][0][4 * r4 + k]; if (l31 < 16) dp[k * 48 + 32] = acc[me][1][4 * r4 + k]; }
            }
        asm volatile("s_waitcnt lgkmcnt(0)" ::: "memory");
    }
}
__device__ __forceinline__ void phase_ret_out(Frame& F, int l, const float* ret_norm_g) {
#ifdef NO_PHASE_RET_OUT
    return;
#endif
    const bf16_t* ZSp = F.ZS(); const float* RSTp = F.RST();
    LAS unsigned char* Vb = F.lds + F.wave * RET_WAVE_LDS;
    for (int item = F.bid * NWAVES + F.wave; item < 2048; item += F.G * NWAVES) {
        int lane = F.lane; asm volatile("" : "+v"(lane));
        const int l31 = lane & 31, hh = lane >> 5, g1 = (lane >> 4) & 1, q4 = (lane & 15) >> 2, p4 = lane & 3;
        const int h = item & 3, tok0 = (item >> 2) * 64;
        ret_stage_v(ZSp, Vb, tok0, h, lane);
        const float lg2 = log2f(1.f - exp2f(-5.f - (float)h));
        bf16x8 qf[2][3], kf[2][3];
#pragma unroll
        for (int t = 0; t < 2; ++t)
#pragma unroll
            for (int ks = 0; ks < 3; ++ks) { const size_t ro = (size_t)(tok0 + 32 * t + l31) * ZSW + h * 48 + 8 * hh + 16 * ks;
                qf[t][ks] = *(const bf16x8*)(ZSp + ro + ZRQ); kf[t][ks] = *(const bf16x8*)(ZSp + ro + ZRK); }
        bf16x8 pm[2][4];
#pragma unroll
        for (int mt = 0; mt < 2; ++mt)
#pragma unroll
            for (int nt = mt; nt < 2; ++nt) {
                f32x16 p = {0.f, 0.f, 0.f, 0.f, 0.f, 0.f, 0.f, 0.f, 0.f, 0.f, 0.f, 0.f, 0.f, 0.f, 0.f, 0.f};
#pragma unroll
                for (int ks = 0; ks < 3; ++ks) p = __builtin_amdgcn_mfma_f32_32x32x16_bf16(kf[mt][ks], qf[nt][ks], p, 0, 0, 0);
                const int i = 32 * nt + l31;
#pragma unroll
                for (int r = 0; r < 16; ++r) { const int j = 32 * mt + (r & 3) + 8 * (r >> 2) + 4 * hh;
                    p[r] = (i >= j) ? p[r] * (0.14433756729740643f * exp2f(lg2 * (float)(i - j))) : 0.f; }
                pm[nt][2 * mt + 0] = pack8f((f32x4){p[0], p[1], p[2], p[3]}, (f32x4){p[4], p[5], p[6], p[7]});
                pm[nt][2 * mt + 1] = pack8f((f32x4){p[8], p[9], p[10], p[11]}, (f32x4){p[12], p[13], p[14], p[15]});
            }
        f32x16 ot[3][2];
#pragma unroll
        for (int me = 0; me < 3; ++me) {
            bf16x8 sf[3];
            int zz = 0; asm volatile("" : "+v"(zz)); const float* sp0 = RSTp + (size_t)item * 4608 + (32 * me + l31) * 48 + 8 * hh + zz;
#pragma unroll
            for (int ks = 0; ks < 3; ++ks) { const float* sp = sp0 + 16 * ks; sf[ks] = pack8f(*(const f32x4*)sp, *(const f32x4*)(sp + 4)); }
#pragma unroll
            for (int nt = 0; nt < 2; ++nt) {
                f32x16 a = {0.f, 0.f, 0.f, 0.f, 0.f, 0.f, 0.f, 0.f, 0.f, 0.f, 0.f, 0.f, 0.f, 0.f, 0.f, 0.f};
#pragma unroll
                for (int ks = 0; ks < 3; ++ks) a = __builtin_amdgcn_mfma_f32_32x32x16_bf16(sf[ks], qf[nt][ks], a, 0, 0, 0);
                const float qd = exp2f(lg2 * (float)(32 * nt + l31 + 1));
                ot[me][nt] = a * qd;
            }
        }
        asm volatile("s_waitcnt vmcnt(0)" ::: "memory");
#pragma unroll
        for (int s = 0; s < 4; ++s) {
            const int r0 = 16 * s + 4 * hh + q4;
#pragma unroll
            for (int me = 0; me < 3; ++me) {
                const LAS unsigned char* a0 = Vb + r0 * 192 + (32 * me + 16 * g1 + 4 * p4) * 2;
                const bf16x8 vf = tr8(a0, a0 + 8 * 192);
                if (s < 2) ot[me][0] = __builtin_amdgcn_mfma_f32_32x32x16_bf16(vf, pm[0][s], ot[me][0], 0, 0, 0);
                ot[me][1] = __builtin_amdgcn_mfma_f32_32x32x16_bf16(vf, pm[1][s], ot[me][1], 0, 0, 0);
            }
        }
#pragma unroll
        for (int nt = 0; nt < 2; ++nt) {
            float sum = 0.f;
#pragma unroll
            for (int me = 0; me < 3; ++me)
#pragma unroll
                for (int r = 0; r < 16; ++r) sum += ot[me][nt][r];
            sum += __shfl_xor(sum, 32);
            const float mu = sum * (1.f / 96.f); float q2 = 0.f;
#pragma unroll
            for (int me = 0; me < 3; ++me)
#pragma unroll
                for (int r = 0; r < 16; ++r) { const float d = ot[me][nt][r] - mu; q2 += d * d; }
            q2 += __shfl_xor(q2, 32);
            const float rs = rsqrtf(q2 * (1.f / 96.f) + EPS);
            const int tok = tok0 + 32 * nt + l31;
            const bf16_t* gbase = ZSp + (size_t)tok * ZSW + ZRG + h * 96 + 4 * hh; const float* nbase = ret_norm_g + l * 384 + h * 96 + 4 * hh; bf16_t* obase = F.H() + (size_t)tok * DM + 640 + h * 96 + 4 * hh;
#pragma unroll
            for (int me = 0; me < 3; ++me) {
                int zz = 0; asm volatile("" : "+v"(zz));
                const bf16_t* gp = gbase + 32 * me + zz; const float* np = nbase + 32 * me + zz; bf16_t* op = obase + 32 * me + zz;
#pragma unroll
                for (int r4 = 0; r4 < 4; ++r4) {
                    const u32x2 gw = *(const u32x2*)(gp + 8 * r4);
                    const f32x4 ng = *(const f32x4*)(np + 8 * r4);
                    const float g0 = bflo(gw.x), g1f = bfhi(gw.x), g2 = bflo(gw.y), g3 = bfhi(gw.y);
                    const float y0 = (ot[me][nt][4 * r4 + 0] - mu) * rs * ng.x * (g0 * sigmoidf_(g0)), y1 = (ot[me][nt][4 * r4 + 1] - mu) * rs * ng.y * (g1f * sigmoidf_(g1f));
                    const float y2 = (ot[me][nt][4 * r4 + 2] - mu) * rs * ng.z * (g2 * sigmoidf_(g2)), y3 = (ot[me][nt][4 * r4 + 3] - mu) * rs * ng.w * (g3 * sigmoidf_(g3));
                    *(u32x2*)(op + 8 * r4) = (u32x2){pk2(y0, y1), pk2(y2, y3)};
                }
            }
        }
        asm volatile("s_waitcnt lgkmcnt(0)" ::: "memory");
    }
}

typedef _Float16 f16_t;
__device__ __forceinline__ u32x4 zero4() { unsigned z = 0u; asm volatile("" : "+v"(z)); return (u32x4){z, z, z, z}; }
__device__ __forceinline__ int lanes_below(unsigned long long m) { return (int)__builtin_amdgcn_mbcnt_hi((unsigned)(m >> 32), __builtin_amdgcn_mbcnt_lo((unsigned)m, 0u)); }
__device__ __forceinline__ float relu1(float x) { return __builtin_amdgcn_fmed3f(x, 0.f, __builtin_inff()); }
__device__ __forceinline__ unsigned sortable_f16(float sc) {
    const f16_t h = (f16_t)sc; const unsigned u = (unsigned)__builtin_bit_cast(unsigned short, h), mag = u & 0x7fffu;
    return (u & 0x8000u) ? (0x8000u - mag) : (0x8000u + mag);
}
__device__ __forceinline__ int sc_pos(int k) { return k; }
__device__ __forceinline__ int wave_incl_scan(int x) {
    x += __builtin_amdgcn_update_dpp(0, x, 0x111, 0xf, 0xf, true);
    x += __builtin_amdgcn_update_dpp(0, x, 0x112, 0xf, 0xf, true);
    x += __builtin_amdgcn_update_dpp(0, x, 0x114, 0xf, 0xf, true);
    x += __builtin_amdgcn_update_dpp(0, x, 0x118, 0xf, 0xf, true);
    x += __builtin_amdgcn_update_dpp(0, x, 0x142, 0xa, 0xf, false);
    x += __builtin_amdgcn_update_dpp(0, x, 0x143, 0xc, 0xf, false);
    return x;
}
__device__ __forceinline__ int wave_suffix_sum(int v, int lane) { const int p = wave_incl_scan(v); return __builtin_amdgcn_readlane(p, 63) - p + v; }
__device__ __forceinline__ void hist_threshold(const u32x4 c, int need, int lane, int& B, int& above) {
    const int s = (int)(c.x + c.y + c.z + c.w);
    const int S = wave_suffix_sum(s, lane);
    int a = S - s;
    const bool found = (a < need) && (S >= need);
    int Bl = 0, al = 0;
    if (found) {
        if (a + (int)c.w >= need) { Bl = 4 * lane + 3; al = a; }
        else { a += (int)c.w; if (a + (int)c.z >= need) { Bl = 4 * lane + 2; al = a; }
        else { a += (int)c.z; if (a + (int)c.y >= need) { Bl = 4 * lane + 1; al = a; }
        else { a += (int)c.y; Bl = 4 * lane; al = a; } } }
    }
    const unsigned long long m = __ballot(found);
    const int src = m ? (int)__builtin_ctzll(m) : 0;
    B = __builtin_amdgcn_readlane(Bl, src); above = __builtin_amdgcn_readlane(al, src);
}

#ifndef DSA_CAND
#define DSA_CAND 0
#endif
#ifndef DSA_DUP
#define DSA_DUP 0
#endif
constexpr int DSA_ROW = 16384;
__device__ __forceinline__ void phase_dsa(Frame& F) {
#ifdef NO_PHASE_DSA
    return;
#endif
    const int wave = F.wave;
    const bf16_t* ZSp = F.ZS(); const float* IWp = F.IW(); const bf16_t* IKp = F.IKD();
    LAS unsigned char* SCb = F.lds;
    for (int it = F.bid; it < 512; it += F.G) {
        int lane = F.lane; asm volatile("" : "+v"(lane));
        const int hi = lane >> 5, n32 = lane & 31;
        LAS unsigned short* LSTw = (LAS unsigned short*)(F.lds + 131072) + wave * 256;
        LAS unsigned char* WB = F.lds + 135168 + wave * 3520;
        LAS unsigned* H1 = (LAS unsigned*)WB; LAS unsigned* H2 = H1 + 256;
        LAS unsigned* DUM = (LAS unsigned*)(WB + 3264) + lane;
        LAS unsigned short* CK = (LAS unsigned short*)(WB + 1024); LAS unsigned short* CI = (LAS unsigned short*)(WB + 2144);
        const int pr = it & 255, vcu = (pr & 7) * 32 + (pr >> 3);
        const int b = vcu >> 6, cc = vcu & 63, c = (it < 256) ? cc : 127 - cc;
        const int V = (c + 1) * 64, tokq0 = b * SEQ + c * 64, kb0 = b * SEQ;
        const int Keff = V < 256 ? V : 256;
        const int nblk = (V + 511) >> 9, ntile_all = nblk * 16, ntile_real = V >> 5;
        for (int qg = 0; qg < 8; ++qg) {
            const int tq0 = tokq0 + qg * 8;
#ifndef DSA_NO_A
            for (int repA = 0; repA < 1 + (DSA_DUP & 1); ++repA) {
                bf16x8 aq[2];
                { const int qq = n32 >> 2, hd = n32 & 3; const bf16_t* qp = ZSp + (size_t)(tq0 + qq) * ZSW + ZIQ + hd * 32 + 8 * hi;
                  aq[0] = *(const bf16x8*)qp; aq[1] = *(const bf16x8*)(qp + 16); }
                float wq[4][4];
#pragma unroll
                for (int jq = 0; jq < 4; ++jq) { const f32x4 w4 = *(const f32x4*)(IWp + (size_t)(tq0 + 2 * jq + hi) * 4);
                    wq[jq][0] = w4.x * 0.08838834764831845f; wq[jq][1] = w4.y * 0.08838834764831845f; wq[jq][2] = w4.z * 0.08838834764831845f; wq[jq][3] = w4.w * 0.08838834764831845f; }
                bf16x8 fr[2][4][2];
                const int nb = (ntile_all - wave + 31) >> 5;
#define DSA_ALOAD(buf, bt) do { int zz = 0; asm volatile("" : "+v"(zz)); _Pragma("unroll") for (int u = 0; u < 4; ++u) { const int tt = wave + 8 * (4 * (bt) + u); \
        if (tt < ntile_real) { const bf16_t* kp = IKp + ((size_t)(((kb0 >> 5) + tt) * 4 + hi) * 32 + n32 + zz) * 8; fr[buf][u][0] = *(const bf16x8*)kp; fr[buf][u][1] = *(const bf16x8*)(kp + 512); } } } while (0)
#define DSA_ACOMP(buf, bt) do { _Pragma("unroll") for (int u = 0; u < 4; ++u) { const int tt = wave + 8 * (4 * (bt) + u); \
        if (tt < ntile_all) { unsigned short us[4] = {0, 0, 0, 0}; \
            if (tt < ntile_real) { f32x16 acc = {0.f, 0.f, 0.f, 0.f, 0.f, 0.f, 0.f, 0.f, 0.f, 0.f, 0.f, 0.f, 0.f, 0.f, 0.f, 0.f}; \
                acc = __builtin_amdgcn_mfma_f32_32x32x16_bf16(aq[0], fr[buf][u][0], acc, 0, 0, 0); acc = __builtin_amdgcn_mfma_f32_32x32x16_bf16(aq[1], fr[buf][u][1], acc, 0, 0, 0); \
                _Pragma("unroll") for (int jq = 0; jq < 4; ++jq) { \
                    const float sc = relu1(acc[4 * jq + 0]) * wq[jq][0] + relu1(acc[4 * jq + 1]) * wq[jq][1] + relu1(acc[4 * jq + 2]) * wq[jq][2] + relu1(acc[4 * jq + 3]) * wq[jq][3]; \
                    us[jq] = (unsigned short)sortable_f16(sc); } } \
            const int pos = sc_pos(tt * 32 + n32); \
            _Pragma("unroll") for (int jq = 0; jq < 4; ++jq) *(LAS unsigned short*)(SCb + (2 * jq + hi) * DSA_ROW + pos * 2) = us[jq]; } } } while (0)
                DSA_ALOAD(0, 0);
                for (int bp = 0; bp < nb; bp += 2) {
                    if (bp + 1 < nb) DSA_ALOAD(1, bp + 1);
                    DSA_ACOMP(0, bp);
                    if (bp + 2 < nb) DSA_ALOAD(0, bp + 2);
                    if (bp + 1 < nb) DSA_ACOMP(1, bp + 1);
                }
#undef DSA_ALOAD
#undef DSA_ACOMP
            }
#endif
            __syncthreads();
            LAS unsigned char* row = SCb + wave * DSA_ROW;
#ifndef DSA_NO_B
            for (int repB = 0; repB < 1 + ((DSA_DUP >> 1) & 1); ++repB)
            if (V > 256) {
                *(LAS u32x4*)(H1 + 4 * lane) = zero4(); *(LAS u32x4*)(H2 + 4 * lane) = zero4();
                u32x4 rw[4];
#define DSA_LD8(hf) do { _Pragma("unroll") for (int i = 0; i < 4; ++i) if (4 * (hf) + i < nblk) rw[i] = *(const LAS u32x4*)(row + (512 * (4 * (hf) + i) + 8 * lane) * 2); \
        asm volatile("s_waitcnt lgkmcnt(0)" ::: "memory"); } while (0)
#define DSA_W(i, e2) ((e2) == 0 ? rw[i].x : (e2) == 1 ? rw[i].y : (e2) == 2 ? rw[i].z : rw[i].w)
                asm volatile("s_waitcnt lgkmcnt(0)" ::: "memory");
#pragma unroll 1
                for (int hf = 0; 4 * hf < nblk; ++hf) {
                    DSA_LD8(hf);
#pragma unroll
                    for (int i = 0; i < 4; ++i) if (4 * hf + i < nblk) __hip_atomic_fetch_add(H2 + ((rw[i].x >> 8) & 255u), 1u, __ATOMIC_RELAXED, __HIP_MEMORY_SCOPE_WORKGROUP);
                }
                asm volatile("s_waitcnt lgkmcnt(0)" ::: "memory");
                int Bc, abovec; hist_threshold(*(const LAS u32x4*)(H2 + 4 * lane), 40, lane, Bc, abovec);
                { const u32x4 hs = *(const LAS u32x4*)(H2 + 4 * lane); const int tot = wave_suffix_sum((int)(hs.x + hs.y + hs.z + hs.w), lane); if (__builtin_amdgcn_readlane(tot, 0) < 40) Bc = 0; }
                *(LAS u32x4*)(H2 + 4 * lane) = zero4();
                bool done = false;
                if (DSA_CAND && Bc > 0) {
                    const unsigned thr = (unsigned)Bc << 8;
                    int cnt = 0;
#pragma unroll 1
                    for (int hf = 0; 4 * hf < nblk; ++hf) {
                        DSA_LD8(hf);
#pragma unroll
                        for (int i = 0; i < 4; ++i) if (4 * hf + i < nblk) {
#pragma unroll
                            for (int e = 0; e < 8; ++e) { const unsigned w = DSA_W(i, e >> 1); const unsigned u = (e & 1) ? (w >> 16) : (w & 0xffffu); cnt += (u >= thr) ? 1 : 0; }
                        }
                    }
                    int pos = wave_incl_scan(cnt);
                    const int ncand = __builtin_amdgcn_readlane(pos, 63); pos -= cnt;
                    if (ncand >= 256 && ncand <= 560) {
                        LAS unsigned short* ldum = (LAS unsigned short*)DUM;
#pragma unroll 1
                        for (int hf = 0; 4 * hf < nblk; ++hf) {
                            DSA_LD8(hf);
#pragma unroll
                            for (int i = 0; i < 4; ++i) if (4 * hf + i < nblk) {
#pragma unroll
                                for (int e = 0; e < 8; ++e) { const unsigned w = DSA_W(i, e >> 1); const unsigned u = (e & 1) ? (w >> 16) : (w & 0xffffu);
                                    const bool sel = u >= thr; LAS unsigned short* pk = sel ? CK + pos : ldum; LAS unsigned short* pi = sel ? CI + pos : ldum;
                                    *pk = (unsigned short)u; *pi = (unsigned short)(512 * (4 * hf + i) + 8 * lane + e); pos += sel ? 1 : 0; }
                            }
                        }
                        *(LAS u32x4*)(H1 + 4 * lane) = zero4();
                        asm volatile("s_waitcnt lgkmcnt(0)" ::: "memory");
                        unsigned cu[9];
#pragma unroll
                        for (int j = 0; j < 9; ++j) { const int p = j * 64 + lane; const bool v = p < ncand; cu[j] = v ? (unsigned)CK[v ? p : 0] : 0u; }
                        asm volatile("s_waitcnt lgkmcnt(0)" ::: "memory");
#pragma unroll
                        for (int j = 0; j < 9; ++j) if (j * 64 + lane < ncand) __hip_atomic_fetch_add(H1 + (cu[j] >> 8), 1u, __ATOMIC_RELAXED, __HIP_MEMORY_SCOPE_WORKGROUP);
                        asm volatile("s_waitcnt lgkmcnt(0)" ::: "memory");
                        int B1c, above1c; hist_threshold(*(const LAS u32x4*)(H1 + 4 * lane), 256, lane, B1c, above1c);
                        *(LAS u32x4*)(H1 + 4 * lane) = zero4();
                        asm volatile("s_waitcnt lgkmcnt(0)" ::: "memory");
#pragma unroll
                        for (int j = 0; j < 9; ++j) if (j * 64 + lane < ncand && (int)(cu[j] >> 8) == B1c) __hip_atomic_fetch_add(H1 + (cu[j] & 255u), 1u, __ATOMIC_RELAXED, __HIP_MEMORY_SCOPE_WORKGROUP);
                        asm volatile("s_waitcnt lgkmcnt(0)" ::: "memory");
                        int B2c, above2c; hist_threshold(*(const LAS u32x4*)(H1 + 4 * lane), 256 - above1c, lane, B2c, above2c);
                        const unsigned tauc = ((unsigned)B1c << 8) | (unsigned)B2c;
                        if ((int)H1[B2c] == 256 - above1c - above2c) {
                            int c2 = 0;
#pragma unroll
                            for (int j = 0; j < 9; ++j) c2 += (j * 64 + lane < ncand && cu[j] >= tauc) ? 1 : 0;
                            int p2 = wave_incl_scan(c2) - c2;
#pragma unroll
                            for (int j = 0; j < 9; ++j) { const bool sel = (j * 64 + lane < ncand) && cu[j] >= tauc; LAS unsigned short* pl = sel ? LSTw + p2 : ldum; *pl = CI[sel ? j * 64 + lane : 0]; p2 += sel ? 1 : 0; }
                            done = true;
                        }
                        *(LAS u32x4*)(H1 + 4 * lane) = zero4(); *(LAS u32x4*)(H2 + 4 * lane) = zero4();
                        asm volatile("s_waitcnt lgkmcnt(0)" ::: "memory");
                    }
                }
                if (!done) {
                int lo_bin = Bc, hi_bin = 256;
                for (;;) {
#pragma unroll 1
                    for (int hf = 0; 4 * hf < nblk; ++hf) {
                        DSA_LD8(hf);
#pragma unroll
                        for (int i = 0; i < 4; ++i) if (4 * hf + i < nblk) {
#pragma unroll
                            for (int e2 = 0; e2 < 4; ++e2) { const unsigned w = DSA_W(i, e2); const int b0 = (int)((w >> 8) & 255u), b1 = (int)(w >> 24);
                                LAS unsigned* p0 = ((unsigned)(b0 - lo_bin) < (unsigned)(hi_bin - lo_bin)) ? H1 + b0 : DUM; LAS unsigned* p1 = ((unsigned)(b1 - lo_bin) < (unsigned)(hi_bin - lo_bin)) ? H1 + b1 : DUM;
                                __hip_atomic_fetch_add(p0, 1u, __ATOMIC_RELAXED, __HIP_MEMORY_SCOPE_WORKGROUP); __hip_atomic_fetch_add(p1, 1u, __ATOMIC_RELAXED, __HIP_MEMORY_SCOPE_WORKGROUP); }
                        }
                    }
                    asm volatile("s_waitcnt lgkmcnt(0)" ::: "memory");
                    if (lo_bin == 0) break;
                    const u32x4 h4 = *(const LAS u32x4*)(H1 + 4 * lane); const int tot = __builtin_amdgcn_readlane(wave_suffix_sum((int)(h4.x + h4.y + h4.z + h4.w), lane), 0);
                    if (tot >= 256) break;
                    hi_bin = lo_bin; lo_bin = 0;
                }
                asm volatile("s_waitcnt lgkmcnt(0)" ::: "memory");
                int B1, above1; hist_threshold(*(const LAS u32x4*)(H1 + 4 * lane), 256, lane, B1, above1);
#pragma unroll 1
                for (int hf = 0; 4 * hf < nblk; ++hf) {
                    DSA_LD8(hf);
#pragma unroll
                    for (int i = 0; i < 4; ++i) if (4 * hf + i < nblk) {
#pragma unroll
                        for (int e2 = 0; e2 < 4; ++e2) { const unsigned w = DSA_W(i, e2);
                            LAS unsigned* p0 = ((int)((w >> 8) & 255u) == B1) ? H2 + (w & 255u) : DUM; LAS unsigned* p1 = ((int)(w >> 24) == B1) ? H2 + ((w >> 16) & 255u) : DUM;
                            __hip_atomic_fetch_add(p0, 1u, __ATOMIC_RELAXED, __HIP_MEMORY_SCOPE_WORKGROUP); __hip_atomic_fetch_add(p1, 1u, __ATOMIC_RELAXED, __HIP_MEMORY_SCOPE_WORKGROUP); }
                    }
                }
                asm volatile("s_waitcnt lgkmcnt(0)" ::: "memory");
                int B2, above2; hist_threshold(*(const LAS u32x4*)(H2 + 4 * lane), 256 - above1, lane, B2, above2);
                const unsigned tau = ((unsigned)B1 << 8) | (unsigned)B2;
                const int r = 256 - above1 - above2;
                const int neq = (int)H2[B2];
                if (neq == r) {
                    int cnt = 0;
#pragma unroll 1
                    for (int hf = 0; 4 * hf < nblk; ++hf) {
                        DSA_LD8(hf);
#pragma unroll
                        for (int i = 0; i < 4; ++i) if (4 * hf + i < nblk) {
#pragma unroll
                            for (int e = 0; e < 8; ++e) { const unsigned w = DSA_W(i, e >> 1); const unsigned u = (e & 1) ? (w >> 16) : (w & 0xffffu); cnt += (u >= tau) ? 1 : 0; }
                        }
                    }
                    int pos = wave_incl_scan(cnt) - cnt;
                    LAS unsigned short* ldum = (LAS unsigned short*)DUM;
#pragma unroll 1
                    for (int hf = 0; 4 * hf < nblk; ++hf) {
                        DSA_LD8(hf);
#pragma unroll
                        for (int i = 0; i < 4; ++i) if (4 * hf + i < nblk) {
#pragma unroll
                            for (int e = 0; e < 8; ++e) { const unsigned w = DSA_W(i, e >> 1); const unsigned u = (e & 1) ? (w >> 16) : (w & 0xffffu);
                                const bool sel = u >= tau; LAS unsigned short* p = sel ? LSTw + pos : ldum;
                                *p = (unsigned short)(512 * (4 * hf + i) + 8 * lane + e); pos += sel ? 1 : 0; }
                        }
                    }
                } else {
                    int eq_base = 0, sel_base = 0;
#pragma unroll 1
                    for (int i = 0; i < nblk; ++i) {
                        const u32x4 w4 = *(const LAS u32x4*)(row + (512 * i + 8 * lane) * 2);
                        const unsigned ww[4] = {w4.x, w4.y, w4.z, w4.w};
                        int below_eq = 0, mine_eq = 0;
#pragma unroll
                        for (int e = 0; e < 8; ++e) { const unsigned u = (e & 1) ? (ww[e >> 1] >> 16) : (ww[e >> 1] & 0xffffu); below_eq += lanes_below(__ballot(u == tau)); }
                        int blk_eq = 0;
#pragma unroll
                        for (int e = 0; e < 8; ++e) {
                            const unsigned u = (e & 1) ? (ww[e >> 1] >> 16) : (ww[e >> 1] & 0xffffu);
                            const bool gt = u > tau, eq = (u == tau);
                            const bool sel = gt || (eq && (eq_base + below_eq + mine_eq < r));
                            mine_eq += eq ? 1 : 0;
                            const unsigned long long msel = __ballot(sel);
                            if (sel) LSTw[sel_base + lanes_below(msel)] = (unsigned short)(512 * i + 8 * lane + e);
                            sel_base += __popcll(msel); blk_eq += __popcll(__ballot(eq));
                        }
                        eq_base += blk_eq;
                    }
                }
                }
#undef DSA_W
#undef DSA_LD8
            } else {
#pragma unroll
                for (int jj = 0; jj < 4; ++jj) LSTw[lane + 64 * jj] = (unsigned short)(lane + 64 * jj);
            }
#endif
            asm volatile("s_waitcnt lgkmcnt(0)" ::: "memory");
            for (int repC = 0; repC < 1 + ((DSA_DUP >> 2) & 1); ++repC) {
                const int tq = tq0 + wave, n16 = lane & 15, kg = lane >> 4;
                bf16x8 qf[2];
                if (n16 < 6) { const bf16_t* qp = ZSp + (size_t)tq * ZSW + ZDQ + n16 * 64 + 8 * kg; qf[0] = *(const bf16x8*)qp; qf[1] = *(const bf16x8*)(qp + 32); }
                else { qf[0] = (bf16x8){0, 0, 0, 0, 0, 0, 0, 0}; qf[1] = qf[0]; }
                const int ntile = Keff >> 4;
                LAS unsigned char* vst = row;
#define DSA_VDMA(ch, buf) do { _Pragma("unroll") for (int i8 = 0; i8 < 8; ++i8) { const int rr = (lane >> 3) + 8 * i8; const int kidx = LSTw[(ch) * 64 + rr]; \
        const int sch = (lane & 7) ^ (2 * ((rr >> 1) & 3)); \
        __builtin_amdgcn_global_load_lds((const unsigned*)(ZSp + (size_t)(kb0 + kidx) * ZSW + ZDV + sch * 8), (LAS unsigned*)(vst + (buf) * 8192 + i8 * 1024), 16, 0, 0); } } while (0)
                DSA_VDMA(0, 0);
                if (ntile > 4) DSA_VDMA(1, 1);
                f32x4 sa[16];
                bf16x8 kf[2][4][2];
#define DSA_KLOAD(buf, tb) do { _Pragma("unroll") for (int t4 = 0; t4 < 4; ++t4) if (4 * (tb) + t4 < ntile) { const int kidx = LSTw[(4 * (tb) + t4) * 16 + n16]; \
        const bf16_t* kp = ZSp + (size_t)(kb0 + kidx) * ZSW + ZDK + 8 * kg; kf[buf][t4][0] = *(const bf16x8*)kp; kf[buf][t4][1] = *(const bf16x8*)(kp + 32); } } while (0)
#define DSA_KMMA(buf, tb) do { _Pragma("unroll") for (int t4 = 0; t4 < 4; ++t4) { \
        if (4 * (tb) + t4 < ntile) { f32x4 a = {0.f, 0.f, 0.f, 0.f}; \
            a = __builtin_amdgcn_mfma_f32_16x16x32_bf16(kf[buf][t4][0], qf[0], a, 0, 0, 0); a = __builtin_amdgcn_mfma_f32_16x16x32_bf16(kf[buf][t4][1], qf[1], a, 0, 0, 0); sa[4 * (tb) + t4] = a; } \
        else sa[4 * (tb) + t4] = (f32x4){-1e30f, -1e30f, -1e30f, -1e30f}; } } while (0)
                DSA_KLOAD(0, 0); DSA_KLOAD(1, 1);
                DSA_KMMA(0, 0); DSA_KLOAD(0, 2);
                DSA_KMMA(1, 1); DSA_KLOAD(1, 3);
                DSA_KMMA(0, 2);
                DSA_KMMA(1, 3);
#undef DSA_KLOAD
#undef DSA_KMMA
                float m = -1e30f;
#pragma unroll
                for (int t = 0; t < 16; ++t) m = fmaxf(m, fmaxf(fmaxf(sa[t].x, sa[t].y), fmaxf(sa[t].z, sa[t].w)));
                m = fmaxf(m, __shfl_xor(m, 16)); m = fmaxf(m, __shfl_xor(m, 32));
                const float sc2 = 0.125f * 1.4426950408889634f; float lsum = 0.f;
#pragma unroll
                for (int t = 0; t < 16; ++t) { sa[t].x = exp2f((sa[t].x - m) * sc2); sa[t].y = exp2f((sa[t].y - m) * sc2); sa[t].z = exp2f((sa[t].z - m) * sc2); sa[t].w = exp2f((sa[t].w - m) * sc2);
                    lsum += (sa[t].x + sa[t].y) + (sa[t].z + sa[t].w); }
                lsum += __shfl_xor(lsum, 16); lsum += __shfl_xor(lsum, 32);
                const float linv = __builtin_amdgcn_rcpf(lsum);
                f32x4 oacc[4] = {{0.f, 0.f, 0.f, 0.f}, {0.f, 0.f, 0.f, 0.f}, {0.f, 0.f, 0.f, 0.f}, {0.f, 0.f, 0.f, 0.f}};
                const int q4 = n16 >> 2, p4 = n16 & 3;
#pragma unroll
                for (int ch = 0; ch < 4; ++ch) {
                    if (ch * 4 < ntile) {
                        if ((ch + 1) * 4 < ntile) asm volatile("s_waitcnt vmcnt(8)" ::: "memory");
                        else asm volatile("s_waitcnt vmcnt(0)" ::: "memory");
#pragma unroll
                        for (int sl = 0; sl < 2; ++sl) {
                            const int s = ch * 2 + sl;
                            u32x4 pw; pw.x = pk2(sa[2 * s].x, sa[2 * s].y); pw.y = pk2(sa[2 * s].z, sa[2 * s].w); pw.z = pk2(sa[2 * s + 1].x, sa[2 * s + 1].y); pw.w = pk2(sa[2 * s + 1].z, sa[2 * s + 1].w);
                            const bf16x8 pb = __builtin_bit_cast(bf16x8, pw);
#pragma unroll
                            for (int mt = 0; mt < 4; ++mt) {
                                const int P0 = 32 * sl + 4 * kg + q4, P1 = P0 + 16;
                                const LAS unsigned char* a0 = vst + (ch & 1) * 8192 + P0 * 128 + (((2 * mt + (p4 >> 1)) ^ (2 * ((P0 >> 1) & 3))) * 16) + 8 * (p4 & 1);
                                const LAS unsigned char* a1 = vst + (ch & 1) * 8192 + P1 * 128 + (((2 * mt + (p4 >> 1)) ^ (2 * ((P1 >> 1) & 3))) * 16) + 8 * (p4 & 1);
                                const s16x4 lo = __builtin_bit_cast(s16x4, __builtin_amdgcn_ds_read_tr16_b64_v4i16((LAS s16x4*)a0));
                                const s16x4 hi4 = __builtin_bit_cast(s16x4, __builtin_amdgcn_ds_read_tr16_b64_v4i16((LAS s16x4*)a1));
                                const bf16x8 va = (bf16x8){lo[0], lo[1], lo[2], lo[3], hi4[0], hi4[1], hi4[2], hi4[3]};
                                oacc[mt] = __builtin_amdgcn_mfma_f32_16x16x32_bf16(va, pb, oacc[mt], 0, 0, 0);
                            }
                        }
                        asm volatile("s_waitcnt lgkmcnt(0)" ::: "memory");
                        if (ch + 2 < 4 && (ch + 2) * 4 < ntile) DSA_VDMA(ch + 2, ch & 1);
                    }
                }
#undef DSA_VDMA
                if (n16 < 6) {
                    bf16_t* op = F.H() + (size_t)tq * DM + 256 + n16 * 64 + 4 * kg;
#pragma unroll
                    for (int mt = 0; mt < 4; ++mt) { u32x2 o; o.x = pk2(oacc[mt].x * linv, oacc[mt].y * linv); o.y = pk2(oacc[mt].z * linv, oacc[mt].w * linv); *(u32x2*)(op + 16 * mt) = o; }
                }
            }
            __syncthreads();
        }
    }
}

__global__ void __launch_bounds__(NTHREADS, 2) mk_fwd(Args args) {
    extern __shared__ __attribute__((aligned(16))) unsigned char lds_raw[];
    Frame F;
    F.lds = (LAS unsigned char*)lds_raw;
    F.tid = threadIdx.x; F.lane = F.tid & 63; F.wave = __builtin_amdgcn_readfirstlane(F.tid >> 6);
    F.G = gridDim.x; F.bid = blockIdx.x; F.wsb = args.ws; F.zo = 0u; F.wl = 0u;
    unsigned char* ws = args.ws;
#define INF(k) ((const float*)args.in[k])

    volatile LAS unsigned* MISC = (volatile LAS unsigned*)(F.lds + MISC_OFF);
    if (F.tid < 64) MISC[F.tid] = 0u;
    __syncthreads();
    XcdBarrier bar = xcd_barrier_post((unsigned*)(ws + WS_CTL) + CW_BAR, MISC + 8);
    int ph = 0; const int lo = args.ph_lo, hi = args.ph_hi;
    unsigned long long* TSp = (unsigned long long*)(ws + WS_CTL + 32768); int nst = 0; (void)TSp; (void)nst;
    bool first_seam = true;
#ifndef DUP_MASK
#define DUP_MASK 0
#endif
#ifdef PROBE_LO
#define STAMP() do { if (F.bid == 0 && F.tid == 0) { TSp[nst] = __builtin_amdgcn_s_memrealtime(); } ++nst; } while (0)
#else
#define STAMP() do { } while (0)
#endif
#define GRIDSYNC() xcd_barrier(bar, F.wave == 0 && F.lane == 0)
#define RUN(...) do { if (ph >= lo && ph < hi) { asm volatile("" : "+s"(F.zo), "+s"(F.bid), "+s"(F.G), "+s"(F.wave)); F.lane = (int)__builtin_amdgcn_mbcnt_hi(~0u, __builtin_amdgcn_mbcnt_lo(~0u, F.zo)); asm volatile("" : "+v"(F.lane)); F.tid = F.wave * 64 + F.lane; __VA_ARGS__; } ++ph; } while (0)
#define SEAM() do { if (ph > lo && ph < hi) { if (first_seam) { GRIDSYNC(); first_seam = false; } else xcd_barrier(bar, F.wave == 0 && F.lane == 0); } STAMP(); } while (0)

    STAMP();
    RUN(phase_rope(F, (const int*)args.in[1])); STAMP();
#pragma unroll
    RUN({ const ProIn I{INF(0), INF(2), INF(3), INF(15), INF(16), INF(17), INF(18), INF(20), INF(21), INF(12), INF(4), INF(5), INF(6), INF(7), INF(8), (const int*)args.in[1]};
          phase_prologue(F, I); }); SEAM();
    for (int l = 0; l < DEPTH; ++l) {
        const float* xin = (l == 0) ? INF(0) : args.out;
        F.wl = l ? (unsigned)(WS_W1L - WS_W) : 0u;
        RUN({ pg8::Gemm g{F.H(), F.Win_t()}; pg8::StaticOrder<T, NINP> S; S.init(F.G, F.bid);
              pg8::EpiGen<FInProj> E{FInProj{F.ZS(), F.GB(), F.IW(), F.ROPE(), F.IKD()}}; pg8::gemm_phase<T, NINP, DM, DM, DM>(F.lds, g, S, E, F.tid); }); SEAM();
        RUN({ phase_s5_local(F, l); __syncthreads(); phase_ret_local(F);
              asm volatile("s_waitcnt vmcnt(0)" ::: "memory"); __syncthreads();
              if (F.tid == 0) { unsigned* lc = (unsigned*)(F.wsb + F.zo + WS_CTL) + CW_LOCAL + 64 * l; __builtin_amdgcn_fence(__ATOMIC_RELEASE, "agent"); asm volatile("s_waitcnt vmcnt(0)" ::: "memory"); __hip_atomic_fetch_add(lc, 1u, __ATOMIC_RELAXED, __HIP_MEMORY_SCOPE_AGENT); }
              phase_dsa(F); __syncthreads();
              if (F.tid == 0) { unsigned* lc = (unsigned*)(F.wsb + F.zo + WS_CTL) + CW_LOCAL + 64 * l; unsigned sp = 0u;
                                while (__hip_atomic_load(lc, __ATOMIC_RELAXED, __HIP_MEMORY_SCOPE_AGENT) < (unsigned)F.G) { __builtin_amdgcn_s_sleep(2); if (++sp > (1u << 20)) break; }
                                __builtin_amdgcn_fence(__ATOMIC_ACQUIRE, "agent"); asm volatile("s_waitcnt vmcnt(0)" ::: "memory"); }
              __syncthreads();
              phase_carry(F, l); }); SEAM();
        RUN({ phase_s5_out(F, l, INF(9), INF(10), INF(11)); __syncthreads(); phase_ret_out(F, l, INF(14)); __syncthreads(); }); SEAM();
        RUN({ pg8::Gemm g{F.H(), F.Wglu_t()}; pg8::StaticOrder<T, 256> S; S.init(F.G, F.bid);
              pg8::EpiGen<FGlu, 0> E{FGlu{F.H(), INF(13) + l * 256}}; pg8::gemm_phase<T, 256, 256, DM, 256>(F.lds, g, S, E, F.tid); }); SEAM();
        RUN({ pg8::Gemm g{F.H(), F.Wabc_t()}; pg8::StaticOrder<T, DM> S; S.init(F.G, F.bid);
              EpiMerge E{F.MG(), F.GB()}; pg8::gemm_phase<T, DM, DM, DM, DM>(F.lds, g, S, E, F.tid); }); SEAM();
        RUN({ pg8::Gemm g{F.MG(), F.Wout_t()}; pg8::StaticOrder<T, DM> S; S.init(F.G, F.bid);
              EpiResidNorm E{xin, args.out, F.H(), nullptr, INF(19) + l * DM, F.XB(), F.PANEL(2 * l)}; pg8::gemm_phase<T, DM, DM, DM, DM>(F.lds, g, S, E, F.tid); }); SEAM();
        RUN({ pg8::Gemm g{F.H(), F.W1_t()}; pg8::StaticOrder<T, FF> S; S.init(F.G, F.bid);
              pg8::EpiGen<FRelu2> E{FRelu2{F.FB()}}; pg8::gemm_phase<T, FF, DM, DM, DM>(F.lds, g, S, E, F.tid); }); SEAM();
        RUN({ pg8::Gemm g{F.FB(), F.W2_t()}; pg8::StaticOrder<T, DM> S; S.init(F.G, F.bid);
              const bool lastl = (l + 1 == DEPTH);
              EpiResidNorm E{args.out, lastl ? (float*)nullptr : args.out, lastl ? (bf16_t*)nullptr : F.H(), lastl ? args.out : (float*)nullptr, lastl ? INF(22) : INF(2) + (l + 1) * DM, F.XB(), F.PANEL(2 * l + 1)};
              pg8::gemm_phase<T, DM, FF, FF, FF>(F.lds, g, S, E, F.tid); }); if (l + 1 < DEPTH) SEAM();
    }
    STAMP();
#ifdef PROBE_LO
    if (F.bid == 0 && F.tid == 0) {
        const int sel[] = PROBE_SEL; unsigned long long tot = 0;
        for (unsigned i = 0; i < sizeof(sel) / sizeof(int); ++i) tot += TSp[sel[i] + 1] - TSp[sel[i]];
        const float us = (float)tot * 0.01f;
        asm volatile("s_waitcnt vmcnt(0)" ::: "memory");
        args.out[0] = sqrtf(us * (float)((size_t)T * DM));
    }
#endif
#undef RUN
#undef SEAM
}

extern "C" void kernel_launch(void* const* d_in, const int* in_sizes, int n_in, void* d_out, int out_size, void* d_ws, size_t ws_size, hipStream_t stream) {
    static int grid = 0;
    if (grid == 0) {
        if (n_in != 23 || out_size != T * DM || ws_size < WS_END) { fprintf(stderr, "kernel_launch: unexpected shapes (n_in %d out %d ws %zu)\n", n_in, out_size, ws_size); grid = -1; return; }
        int dev = 0, cus = 0, per_cu = 0;
        hipGetDevice(&dev); hipDeviceGetAttribute(&cus, hipDeviceAttributeMultiprocessorCount, dev);
        if (hipFuncSetAttribute((const void*)mk_fwd, hipFuncAttributeMaxDynamicSharedMemorySize, LDS_BYTES) != hipSuccess) { fprintf(stderr, "kernel_launch: hipFuncSetAttribute failed\n"); grid = -1; return; }
        if (hipOccupancyMaxActiveBlocksPerMultiprocessor(&per_cu, (const void*)mk_fwd, NTHREADS, LDS_BYTES) != hipSuccess || per_cu < 1) { fprintf(stderr, "kernel_launch: occupancy query says %d\n", per_cu); per_cu = 1; }
        (void)hipGetLastError();
        grid = cus;
    }
    if (grid < 0) return;
    hipMemsetAsync((char*)d_ws + WS_CTL, 0, CTL_ZERO_BYTES, stream);
    Args a{};
    for (int i = 0; i < 23; ++i) a.in[i] = d_in[i];
    a.out = (float*)d_out; a.ws = (unsigned char*)d_ws;
#ifndef MK_SPLIT
    a.ph_lo = 0; a.ph_hi = 1000;
    void* kargs[] = {&a};
    hipError_t e = hipLaunchCooperativeKernel((const void*)mk_fwd, dim3(grid), dim3(NTHREADS), kargs, LDS_BYTES, stream);
    if (e != hipSuccess) fprintf(stderr, "kernel_launch: cooperative launch failed: %s\n", hipGetErrorString(e));
#else
    for (int p = 0; p < 2 * 9 + 2; ++p) { a.ph_lo = p; a.ph_hi = p + 1; hipLaunchKernelGGL(mk_fwd, dim3(grid), dim3(NTHREADS), LDS_BYTES, stream, a); }
#endif
}
```

```cpp
#include <hip/hip_runtime.h>
#include <cstdio>
#include <cstdint>

#define LAS __attribute__((address_space(3)))
#define GAS __attribute__((address_space(1)))
typedef unsigned short bf16_t;
typedef short bf16x8 __attribute__((ext_vector_type(8)));
typedef float f32x4 __attribute__((ext_vector_type(4)));
typedef float f32x2 __attribute__((ext_vector_type(2)));
typedef unsigned u32x4 __attribute__((ext_vector_type(4)));
typedef unsigned u32x2 __attribute__((ext_vector_type(2)));

constexpr int NB = 4, SEQ = 8192, T = NB * SEQ, DM = 1024, DEPTH = 2, FF = 4096;
constexpr int NIN = 5156, NINP = 5376;
constexpr int ZSW = 2112, GW = 3072;
constexpr int ZU = 0, ZDQ = 256, ZDK = 640, ZDV = 704, ZIQ = 768, ZIK = 896, ZIWC = 928, ZRQ = 960, ZRK = 1152, ZRV = 1344, ZRG = 1728, ZGATE = 2112, ZEND = 5184;
constexpr int NFREQ = 36;
constexpr float EPS = 1e-6f;

constexpr size_t MiB = 1u << 20;
constexpr size_t WS_CTL = 0, CTL_ZERO_BYTES = 512 * 1024;
constexpr size_t WS_IW = 1 * MiB;
constexpr size_t WS_SP = 1 * MiB + 512 * 1024;
constexpr size_t WS_ROPE = 2 * MiB;
constexpr size_t WS_S5E = 11 * MiB;
constexpr size_t WS_RST = 15 * MiB;
constexpr size_t WS_W = 51 * MiB;
constexpr size_t WO_IN = 0, WO_ABC = WO_IN + (size_t)NINP * DM * 2, WO_OUT = WO_ABC + (size_t)DM * DM * 2, WO_W1 = WO_OUT + (size_t)DM * DM * 2,
                 WO_W2 = WO_W1 + (size_t)FF * DM * 2, WO_GLU = WO_W2 + (size_t)FF * DM * 2, WO_END = WO_GLU + 256 * 256 * 2;
static_assert(WO_END <= 31 * MiB, "weights");
constexpr size_t WS_H = 82 * MiB;
constexpr size_t WS_ZS = 146 * MiB;
constexpr size_t WS_G = 278 * MiB;
constexpr size_t WS_XR = 404 * MiB;
constexpr size_t WS_IKD = 470 * MiB;
constexpr size_t WS_XB = 472 * MiB;
constexpr size_t WS_W1L = 474 * MiB;
constexpr size_t WS_END = 505 * MiB;
static_assert(WS_ZS + (size_t)T * FF * 2 <= WS_XR && WS_XR + (size_t)T * DM * 2 <= WS_IKD, "ws map (residual)");
static_assert(WS_ZS + (size_t)T * ZSW * 2 <= WS_G && WS_G + (size_t)T * GW * 2 <= WS_END && WS_ZS + (size_t)T * FF * 2 <= WS_END, "ws map");
constexpr int CW_BAR = 1024, CW_LOCAL = 8192, CW_PANEL = 32768;

constexpr int LDS_BYTES = 160 * 1024;
constexpr int RING_BYTES = 131072;
constexpr int MISC_OFF = LDS_BYTES - 256;

__device__ __forceinline__ unsigned f2bf(float f) { unsigned u = __builtin_bit_cast(unsigned, f); return (u + 0x7fffu + ((u >> 16) & 1u)) >> 16; }
typedef __bf16 hwbf16x2 __attribute__((ext_vector_type(2)));
__device__ __forceinline__ unsigned pk2(float lo, float hi) { const f32x2 v = {lo, hi}; return __builtin_bit_cast(unsigned, __builtin_convertvector(v, hwbf16x2)); }
__device__ __forceinline__ float bf2f(unsigned short v) { return __builtin_bit_cast(float, (unsigned)v << 16); }
__device__ __forceinline__ float bflo(unsigned w) { return __builtin_bit_cast(float, w << 16); }
__device__ __forceinline__ float bfhi(unsigned w) { return __builtin_bit_cast(float, w & 0xffff0000u); }
__device__ __forceinline__ float sigmoidf_(float x) { return __builtin_amdgcn_rcpf(1.0f + __expf(-x)); }
__device__ __forceinline__ float wave_sum(float v) {
#pragma unroll
    for (int o = 1; o < 64; o <<= 1) v += __shfl_xor(v, o);
    return v;
}
__device__ __forceinline__ float wave_max(float v) {
#pragma unroll
    for (int o = 1; o < 64; o <<= 1) v = fmaxf(v, __shfl_xor(v, o));
    return v;
}

#define XB_TMO      128
#define XB_XCNT(j)  (256  + 64 * (j))
#define XB_XSUB(j)  (1280 + 64 * (j))
#define XB_XGEN(j)  (2304 + 64 * (j))
#define XB_TOP      3328
#define XB_TOPGEN   3392
#define XCD_BAR_WORDS 3456
#define XB_SPIN_CAP (1u << 18)
__device__ __forceinline__ unsigned xb_ld(unsigned* p)              { return __hip_atomic_load(p, __ATOMIC_RELAXED, __HIP_MEMORY_SCOPE_AGENT); }
__device__ __forceinline__ unsigned xb_add(unsigned* p, unsigned v) { return __hip_atomic_fetch_add(p, v, __ATOMIC_RELAXED, __HIP_MEMORY_SCOPE_AGENT); }
__device__ __forceinline__ unsigned xb_xcc_id() { return (unsigned)__builtin_amdgcn_s_getreg((3 << 11) | 20) & 0xFu; }
#define XB_SPIN(cond, bar) do { unsigned _sp = 0; while (cond) { __builtin_amdgcn_s_sleep(1); \
    if ((++_sp & 255u) == 0u) { if (xb_ld(&(bar)[XB_TMO])) break; if (_sp > XB_SPIN_CAP) { atomicAdd(&(bar)[XB_TMO], 1u); break; } } } } while (0)
struct XcdBarrier { unsigned* bar; unsigned x; volatile LAS unsigned* st; };
__device__ __forceinline__ XcdBarrier xcd_barrier_post(unsigned* bar, volatile LAS unsigned* st) {
    XcdBarrier b; b.bar = bar; b.x = xb_xcc_id(); b.st = st;
    if (threadIdx.x == 0) (void)xb_add(&bar[XB_XCNT(b.x)], 1u);
    return b;
}
__device__ __forceinline__ void xcd_barrier_complete(unsigned* bar, unsigned x, unsigned& nloc, unsigned& nx) {
    const unsigned G = gridDim.x * gridDim.y * gridDim.z;
    unsigned sum, cnt, mine, sp = 0u;
    for (;;) {
        sum = 0u; cnt = 0u; mine = 0u;
#pragma unroll
        for (unsigned j = 0; j < 16; ++j) { const unsigned c = xb_ld(&bar[XB_XCNT(j)]); sum += c; cnt += (c > 0u) ? 1u : 0u; mine = (j == x) ? c : mine; }
        if (sum == G) break;
        __builtin_amdgcn_s_sleep(1);
        if ((++sp & 255u) == 0u) { if (xb_ld(&bar[XB_TMO])) break; if (sp > XB_SPIN_CAP) { atomicAdd(&bar[XB_TMO], 1u); break; } }
    }
    nloc = mine > 0u ? mine : 1u; nx = cnt > 0u ? cnt : 1u;
}
__device__ __forceinline__ void xcd_barrier(const XcdBarrier& b, bool leader) {
    asm volatile("s_waitcnt vmcnt(0)" ::: "memory");
    __syncthreads();
    if (leader) {
        unsigned* bar = b.bar; unsigned bx = b.x;
        asm volatile("" : "+s"(bar), "+s"(bx));
        __builtin_amdgcn_s_waitcnt(0);
        unsigned nloc = b.st[0], nx = b.st[1];
        if (nloc == 0u) { xcd_barrier_complete(bar, bx, nloc, nx); b.st[0] = nloc; b.st[1] = nx; }
        const unsigned old = xb_add(&bar[XB_XSUB(bx)], 1u);
        const unsigned gen = old / nloc;
        if (old + 1u == (gen + 1u) * nloc) {
            __builtin_amdgcn_fence(__ATOMIC_RELEASE, "agent");
            asm volatile("s_waitcnt vmcnt(0)" ::: "memory");
            const unsigned og = xb_add(&bar[XB_TOP], 1u);
            const unsigned tg = og / nx;
            if (og + 1u == (tg + 1u) * nx) xb_add(&bar[XB_TOPGEN], 1u);
            else XB_SPIN(xb_ld(&bar[XB_TOPGEN]) == tg, bar);
            __builtin_amdgcn_fence(__ATOMIC_ACQUIRE, "agent");
            xb_add(&bar[XB_XGEN(bx)], 1u);
            asm volatile("s_waitcnt vmcnt(0)" ::: "memory");
        } else {
            XB_SPIN(xb_ld(&bar[XB_XGEN(bx)]) == gen, bar);
            __builtin_amdgcn_fence(__ATOMIC_ACQUIRE, "agent");
            asm volatile("s_waitcnt vmcnt(0)" ::: "memory");
        }
    }
    __syncthreads();
}

namespace pg8 {
constexpr int BM = 256, BK = 64, HALF = 128, HTB = HALF * BK * 2, STAGE_BYTES = 8 * HTB, NXCD = 8, WGM = 8;
__host__ __device__ __forceinline__ int lds_byte(int r, int c) { const int st = (r >> 4) * 2 + (c >> 5), rr = r & 15, cc = c & 31, ob = rr * 64 + cc * 2; return st * 1024 + (ob ^ (((ob >> 9) & 1) << 5)); }
__host__ __device__ __forceinline__ void stage_rc(int b, int& R, int& C) { const int st = b / 1024, sb = b % 1024, swz = sb ^ (((sb >> 9) & 1) << 5); R = (st >> 1) * 16 + swz / 64; C = (st & 1) * 32 + (swz % 64) / 2; }
__host__ __device__ __forceinline__ int perm32(int rho) { const int n = rho >> 4, i = rho & 15; return 8 * (i >> 2) + 4 * n + (i & 3); }

struct Unit { int pm, pn; };
struct Gemm { const bf16_t* A; const bf16_t* Bt; };

template <int M, int N> struct StaticOrder {
    static constexpr int nM = M / BM, nN = N / BM, nwg = nM * nN;
    int G, c;
    __host__ __device__ void init(int G_, int c_) { G = G_; c = c_; }
    __host__ __device__ bool next(int i, Unit& u) const {
        const long L = (long)i * G + c; if (L >= nwg) return false;
        int wgid = (int)L; { constexpr int q = nwg / NXCD, r = nwg % NXCD; const int xcd = wgid % NXCD, off = wgid / NXCD; wgid = (xcd < r ? xcd * (q + 1) : r * (q + 1) + (xcd - r) * q) + off; }
        constexpr int nig = WGM * nN; const int gid = wgid / nig, fm = gid * WGM, gsz = (nM - fm) < WGM ? (nM - fm) : WGM;
        u.pm = fm + ((wgid % nig) % gsz); u.pn = (wgid % nig) / gsz; return true;
    }
};

template <class F, int FENCE = 0> struct EpiGen {
    static constexpr bool PERM = true, HAS_MID = false, FUSED = false;
    F f;
    __device__ __forceinline__ void operator()(const f32x4 (&acc)[2][2][4][2], const Unit& u, int wr, int wc, int fr, int fq) const {
        const int row0 = u.pm * BM + wr * 64 + fr, col0 = u.pn * BM + wc * 32 + 8 * fq;
#pragma unroll
        for (int ai = 0; ai < 2; ++ai)
#pragma unroll
            for (int m = 0; m < 4; ++m)
#pragma unroll
                for (int bj = 0; bj < 2; ++bj) { f(row0 + ai * HALF + m * 16, col0 + bj * HALF, acc[ai][bj][m][0], acc[ai][bj][m][1]);
                    if constexpr (FENCE > 0) { if (((ai * 4 + m) * 2 + bj) % FENCE == FENCE - 1) asm volatile("" ::: "memory"); } }
    }
};

template <int M, int N, int K, int LDA, int LDB, class Epi, bool ALIGN_EPI = true>
__device__ __forceinline__ void gemm_phase(LAS unsigned char* lds, const Gemm g, const StaticOrder<M, N>& S, const Epi& E, int tid_in) {
    int tid = tid_in; asm volatile("" : "+v"(tid));
    const int wid = __builtin_amdgcn_readfirstlane(tid >> 6), lane = tid & 63, wr = wid >> 2, wc = wid & 3, fr = lane & 15, fq = lane >> 4;
    constexpr int nt = K / BK;
    unsigned voffA[2], voffB[2];
#pragma unroll
    for (int i = 0; i < 2; ++i) { int R, C; stage_rc(tid * 16 + i * 8192, R, C); const int Rb = Epi::PERM ? ((R & ~31) + perm32(R & 31)) : R;
        voffA[i] = (unsigned)(R * LDA + C) * 2u; voffB[i] = (unsigned)(Rb * LDB + C) * 2u; }
    constexpr size_t kstep = (size_t)(BK * 2);
    constexpr size_t hstepA = (size_t)HALF * LDA * 2, hstepB = (size_t)HALF * LDB * 2;
    constexpr size_t tstepA = 2 * hstepA, tstepB = 2 * hstepB;
    const unsigned ldsw = (unsigned)wid * 1024u;
    const int aoff = lds_byte(wr * 64 + fr, fq * 8), boff = lds_byte(wc * 32 + fr, fq * 8);
#define PG8_SA(b, h) (((b) * 2 + (h)) * HTB)
#define PG8_SB(b, h) ((4 + (b) * 2 + (h)) * HTB)
#define PG8_STAGE(bufoff, gbase, voff) do { _Pragma("unroll") for (int _i = 0; _i < 2; ++_i) \
        __builtin_amdgcn_global_load_lds((const unsigned*)((const char*)(gbase) + (voff)[_i]), (LAS unsigned*)(lds + (bufoff) + ldsw + _i * 8192), 16, 0, 0); } while (0)
#define PG8_LDA(dst, b, h) do { _Pragma("unroll") for (int m = 0; m < 4; ++m) _Pragma("unroll") for (int k = 0; k < 2; ++k) dst[m][k] = *(const LAS bf16x8*)(lds + PG8_SA(b, h) + aoff + m * 2048 + k * 1024); } while (0)
#define PG8_LDB(dst, b, h) do { _Pragma("unroll") for (int n = 0; n < 2; ++n) _Pragma("unroll") for (int k = 0; k < 2; ++k) dst[n][k] = *(const LAS bf16x8*)(lds + PG8_SB(b, h) + boff + n * 2048 + k * 1024); } while (0)
#define PG8_MMA(ai, bj, At, Bt) do { __builtin_amdgcn_s_setprio(1); _Pragma("unroll") for (int m = 0; m < 4; ++m) _Pragma("unroll") for (int n = 0; n < 2; ++n) _Pragma("unroll") for (int k = 0; k < 2; ++k) \
        acc[ai][bj][m][n] = __builtin_amdgcn_mfma_f32_16x16x32_bf16(Bt[n][k], At[m][k], acc[ai][bj][m][n], 0, 0, 0); __builtin_amdgcn_s_setprio(0); } while (0)
#define PG8_WAIT_V(n) asm volatile("s_waitcnt vmcnt(" #n ")" ::: "memory")
#define PG8_WAIT_L(n) asm volatile("s_waitcnt lgkmcnt(" #n ")" ::: "memory")
#define PG8_BAR __builtin_amdgcn_s_barrier()
#define PG8_SCHED __builtin_amdgcn_sched_barrier(0)
    Unit cur, nxt; int ui = 0;
    if (!S.next(0, cur)) return;
    f32x4 acc[2][2][4][2];
#pragma unroll
    for (int a = 0; a < 2; ++a)
#pragma unroll
        for (int b = 0; b < 2; ++b)
#pragma unroll
            for (int m = 0; m < 4; ++m)
#pragma unroll
                for (int n = 0; n < 2; ++n) acc[a][b][m][n] = (f32x4){0.f, 0.f, 0.f, 0.f};
    bf16x8 At[4][2], B0[2][2], B1[2][2];
    const char* cA = (const char*)g.A + (size_t)cur.pm * tstepA; const char* cB = (const char*)g.Bt + (size_t)cur.pn * tstepB;
    PG8_STAGE(PG8_SB(0, 0), cB, voffB); PG8_STAGE(PG8_SB(0, 1), cB + hstepB, voffB); PG8_STAGE(PG8_SA(0, 0), cA, voffA); PG8_STAGE(PG8_SA(0, 1), cA + hstepA, voffA);
    if (wr == 1) PG8_BAR;
    PG8_WAIT_V(2); PG8_BAR;
    PG8_STAGE(PG8_SB(1, 0), cB + kstep, voffB); PG8_STAGE(PG8_SA(1, 0), cA + kstep, voffA); PG8_STAGE(PG8_SB(1, 1), cB + hstepB + kstep, voffB);
    PG8_WAIT_V(6); PG8_BAR;
    for (;;) {
        const bool has_next = S.next(ui + 1, nxt);
        const char* nA = has_next ? (const char*)g.A + (size_t)nxt.pm * tstepA : cA; const char* nB = has_next ? (const char*)g.Bt + (size_t)nxt.pn * tstepB : cB;
#pragma unroll 1
        for (int t = 0; t < nt; t += 2) {
            const bool last = (t == nt - 2);
            const char* a1 = cA + (size_t)(t + 1) * kstep;
            const char* a2 = last ? nA : cA + (size_t)(t + 2) * kstep; const char* b2 = last ? nB : cB + (size_t)(t + 2) * kstep;
            const char* a3 = a2 + kstep; const char* b3 = b2 + kstep;
            if constexpr (Epi::HAS_MID) { if (t == Epi::MID0 || t == Epi::MID1) E.mid(acc, cur, t, wr, wc, fr, fq); }
            PG8_LDB(B0, 0, 0); PG8_LDB(B1, 0, 1); PG8_SCHED; PG8_LDA(At, 0, 0); PG8_STAGE(PG8_SA(1, 1), a1 + hstepA, voffA);
            PG8_WAIT_V(8); PG8_WAIT_L(0); PG8_BAR; PG8_MMA(0, 0, At, B0); PG8_MMA(0, 1, At, B1); PG8_BAR; PG8_SCHED;
            PG8_LDA(At, 0, 1); PG8_STAGE(PG8_SB(0, 0), b2, voffB); PG8_STAGE(PG8_SB(0, 1), b2 + hstepB, voffB); PG8_STAGE(PG8_SA(0, 0), a2, voffA);
            PG8_WAIT_V(8); PG8_WAIT_L(0); PG8_BAR; PG8_MMA(1, 0, At, B0); PG8_MMA(1, 1, At, B1); PG8_BAR; PG8_SCHED;
            PG8_LDB(B0, 1, 0); PG8_LDB(B1, 1, 1); PG8_SCHED; PG8_LDA(At, 1, 0); PG8_STAGE(PG8_SA(0, 1), a2 + hstepA, voffA);
            PG8_WAIT_V(8); PG8_WAIT_L(0); PG8_BAR; PG8_MMA(0, 0, At, B0); PG8_MMA(0, 1, At, B1); PG8_BAR; PG8_SCHED;
            PG8_LDA(At, 1, 1); PG8_STAGE(PG8_SB(1, 0), b3, voffB); PG8_STAGE(PG8_SB(1, 1), b3 + hstepB, voffB); PG8_STAGE(PG8_SA(1, 0), a3, voffA);
            PG8_WAIT_V(8); PG8_WAIT_L(0); PG8_BAR; PG8_MMA(1, 0, At, B0); PG8_MMA(1, 1, At, B1); PG8_BAR; PG8_SCHED;
        }
        if constexpr (ALIGN_EPI) { if (wr == 0) PG8_BAR; }
        if constexpr (Epi::FUSED) E.fused(acc, cur, wr, wc, fr, fq, lds, wid, lane); else E(acc, cur, wr, wc, fr, fq);
        if (!has_next) break;
#pragma unroll
        for (int a = 0; a < 2; ++a)
#pragma unroll
            for (int b = 0; b < 2; ++b)
#pragma unroll
                for (int m = 0; m < 4; ++m)
#pragma unroll
                    for (int n = 0; n < 2; ++n) acc[a][b][m][n] = (f32x4){0.f, 0.f, 0.f, 0.f};
        cur = nxt; cA = nA; cB = nB; ++ui;
        if constexpr (ALIGN_EPI) { if (wr == 1) PG8_BAR; }
    }
    PG8_WAIT_V(0);
    if constexpr (!ALIGN_EPI) { if (wr == 0) PG8_BAR; }
    PG8_BAR;
#undef PG8_SA
#undef PG8_SB
#undef PG8_STAGE
#undef PG8_LDA
#undef PG8_LDB
#undef PG8_MMA
#undef PG8_WAIT_V
#undef PG8_WAIT_L
#undef PG8_BAR
#undef PG8_SCHED
}
}

constexpr int NWAVES = 8, NTHREADS = 512;
struct Args { const void* in[23]; float* out; unsigned char* ws; int ph_lo, ph_hi; };
struct Frame {
    LAS unsigned char* lds;
    int tid, lane, wave, G, bid;
    unsigned char* wsb; unsigned zo; unsigned wl;
    __device__ __forceinline__ bf16_t* IKD() const { return (bf16_t*)(wsb + zo + WS_IKD); }
    __device__ __forceinline__ float* XB() const { return (float*)(wsb + zo + WS_XB); }
    __device__ __forceinline__ unsigned* PANEL(int bank) const { return (unsigned*)(wsb + zo + WS_CTL) + CW_PANEL + bank * 8192; }
    __device__ __forceinline__ float* IW() const { return (float*)(wsb + zo + WS_IW); }
    __device__ __forceinline__ bf16_t* XR() const { return (bf16_t*)(wsb + zo + WS_XR); }
    __device__ __forceinline__ float* SP(int l) const { return (float*)(wsb + zo + WS_SP) + l * 36864; }
    __device__ __forceinline__ f32x2* ROPE() const { return (f32x2*)(wsb + zo + WS_ROPE); }
    __device__ __forceinline__ f32x2* S5E() const { return (f32x2*)(wsb + zo + WS_S5E); }
    __device__ __forceinline__ float* RST() const { return (float*)(wsb + zo + WS_RST); }
    __device__ __forceinline__ bf16_t* Win_t() const { return (bf16_t*)(wsb + zo + wl + WS_W + WO_IN); }
    __device__ __forceinline__ bf16_t* Wabc_t() const { return (bf16_t*)(wsb + zo + wl + WS_W + WO_ABC); }
    __device__ __forceinline__ bf16_t* Wout_t() const { return (bf16_t*)(wsb + zo + wl + WS_W + WO_OUT); }
    __device__ __forceinline__ bf16_t* W1_t() const { return (bf16_t*)(wsb + zo + wl + WS_W + WO_W1); }
    __device__ __forceinline__ bf16_t* W2_t() const { return (bf16_t*)(wsb + zo + wl + WS_W + WO_W2); }
    __device__ __forceinline__ bf16_t* Wglu_t() const { return (bf16_t*)(wsb + zo + wl + WS_W + WO_GLU); }
    __device__ __forceinline__ bf16_t* H() const { return (bf16_t*)(wsb + zo + WS_H); }
    __device__ __forceinline__ bf16_t* ZS() const { return (bf16_t*)(wsb + zo + WS_ZS); }
    __device__ __forceinline__ unsigned char* GB() const { return wsb + zo + WS_G; }
    __device__ __forceinline__ bf16_t* MG() const { return (bf16_t*)(wsb + zo + WS_ZS); }
    __device__ __forceinline__ bf16_t* FB() const { return (bf16_t*)(wsb + zo + WS_ZS); }
};
constexpr int SP_LB = 0, SP_L64 = 2048, SP_BBR = 4096, SP_BBI = 4096 + 16384;

__device__ __forceinline__ int ropeperm(int j, int r) { const int half = r >> 1; return (j < r) ? ((j & 1) ? half + (j >> 1) : (j >> 1)) : j; }
__device__ __forceinline__ int zmap(int n) {
    if (n < ZDQ) return n;
    if (n < ZDK) { const int q = n - ZDQ, h = q >> 6, hc = q & 63; return 256 + h * 64 + ropeperm(hc, 16); }
    if (n < ZDV) return 640 + ropeperm(n - ZDK, 16);
    if (n < ZIQ) return 704 + (n - ZDV);
    if (n < ZIK) { const int q = n - ZIQ, h = q >> 5, hc = q & 31; return 768 + h * 32 + ropeperm(hc, 8); }
    if (n < ZIWC) return 896 + ropeperm(n - ZIK, 8);
    if (n < ZRQ) return (n - ZIWC) < 4 ? 928 + (n - ZIWC) : -1;
    if (n < ZRK) { const int q = n - ZRQ, h = q / 48, hc = q % 48; return 932 + h * 48 + ropeperm(hc, 48); }
    if (n < ZRV) { const int q = n - ZRK, h = q / 48, hc = q % 48; return 1124 + h * 48 + ropeperm(hc, 48); }
    if (n < ZRG) return 1316 + (n - ZRV);
    if (n < ZGATE) return 1700 + (n - ZRG);
    if (n < ZEND) return 2084 + (n - ZGATE);
    return -1;
}

__device__ __forceinline__ void tr_item(const float* W, int N, int kb, int nb, bf16_t* WT, int ldd, int koff, bool mapped, LAS float* scr, int lane) {
    const int k0 = 64 * kb, n0 = 32 * nb;
    const int c32 = lane & 31; int sc = n0 + c32; if (mapped) sc = zmap(sc);
#pragma unroll 8
    for (int i = 0; i < 32; ++i) { const int kk = 2 * i + (lane >> 5); scr[kk * 33 + c32] = (sc >= 0) ? W[(size_t)(k0 + kk) * N + sc] : 0.f; }
    asm volatile("s_waitcnt lgkmcnt(0)" ::: "memory");
    const int c = lane & 7;
#pragma unroll
    for (int j = 0; j < 4; ++j) { const int n = (lane >> 3) + 8 * j; const LAS float* s = scr + (8 * c) * 33 + n;
        u32x4 o; o.x = pk2(s[0 * 33], s[1 * 33]); o.y = pk2(s[2 * 33], s[3 * 33]); o.z = pk2(s[4 * 33], s[5 * 33]); o.w = pk2(s[6 * 33], s[7 * 33]);
        *(u32x4*)(WT + (size_t)(n0 + n) * ldd + koff + k0 + 8 * c) = o; }
    asm volatile("s_waitcnt lgkmcnt(0)" ::: "memory");
}

__device__ __forceinline__ void rms_row_bf16(const float* xrow, const float* gain, bf16_t* orow, int lane) {
    const f32x4* xr = (const f32x4*)xrow + lane; const f32x4* gr = (const f32x4*)gain + lane;
    f32x4 v[4]; float s = 0.f;
#pragma unroll
    for (int j = 0; j < 4; ++j) { v[j] = xr[64 * j]; s += (v[j].x * v[j].x + v[j].y * v[j].y) + (v[j].z * v[j].z + v[j].w * v[j].w); }
    const float rstd = rsqrtf(wave_sum(s) * (1.f / DM) + EPS);
    u32x2* o8 = (u32x2*)orow + lane;
#pragma unroll
    for (int j = 0; j < 4; ++j) { const f32x4 gg = gr[64 * j]; u32x2 w; w.x = pk2(v[j].x * rstd * gg.x, v[j].y * rstd * gg.y); w.y = pk2(v[j].z * rstd * gg.z, v[j].w * rstd * gg.w); o8[64 * j] = w; }
}
__device__ __forceinline__ void rms_row_f32(const float* xrow, const float* gain, float* orow, int lane) {
    const f32x4* xr = (const f32x4*)xrow + lane; const f32x4* gr = (const f32x4*)gain + lane;
    f32x4 v[4]; float s = 0.f;
#pragma unroll
    for (int j = 0; j < 4; ++j) { v[j] = xr[64 * j]; s += (v[j].x * v[j].x + v[j].y * v[j].y) + (v[j].z * v[j].z + v[j].w * v[j].w); }
    const float rstd = rsqrtf(wave_sum(s) * (1.f / DM) + EPS);
    f32x4* o = (f32x4*)orow + lane;
#pragma unroll
    for (int j = 0; j < 4; ++j) { const f32x4 gg = gr[64 * j]; o[64 * j] = v[j] * rstd * gg; }
}


__device__ __forceinline__ void phase_rope(Frame& F, const int* pos) {
    const int gt = F.bid * NTHREADS + F.tid, NT = F.G * NTHREADS;
    f32x2* RT = F.ROPE();
    for (int e = gt; e < T * NFREQ; e += NT) {
        const int tok = e / NFREQ, f = e % NFREQ;
        float lth, sc; int fi;
        if (f < 8) { lth = 13.122363377404328f; sc = 2.0f / 16.0f; fi = f; } else if (f < 12) { lth = 13.122363377404328f; sc = 2.0f / 8.0f; fi = f - 8; } else { lth = 9.210340371976184f; sc = 2.0f / 48.0f; fi = f - 12; }
        const float inv = expf(-lth * (float)fi * sc);
        const float p = (float)pos[tok];
        const float ang = p * inv;
        const float kq = rintf(ang * 0.15915494309189535f);
        float r = fmaf(-kq, 6.2831854820251465f, ang);
        r = fmaf(-kq, -1.7484555e-7f, r);
        RT[e] = (f32x2){cosf(r), sinf(r)};
    }
}

struct ProIn { const float *xin, *norm1_g, *w_in, *wa, *wb, *wc, *wo, *w1, *w2, *wg, *lam_re, *lam_im, *log_step, *b_re, *b_im; const int* pos; };
__device__ __forceinline__ void prologue_weights(Frame& F, const ProIn& I, int l, int gw, int NGW) {
    LAS float* scr = (LAS float*)(F.lds + F.wave * 16384);
    constexpr int I_IN = 16 * (NINP / 32), I_A = 4 * 32, I_B = 6 * 32, I_C = 6 * 32, I_O = 16 * 32, I_1 = 16 * 128, I_2 = 64 * 32, I_G = 4 * 8;
    constexpr int NITEMS = I_IN + I_A + I_B + I_C + I_O + I_1 + I_2 + I_G;
    const float* w_in = I.w_in + (size_t)l * DM * NIN; const float* wa = I.wa + (size_t)l * 256 * DM; const float* wb = I.wb + (size_t)l * 384 * DM;
    const float* wc = I.wc + (size_t)l * 384 * DM; const float* wo = I.wo + (size_t)l * DM * DM; const float* w1 = I.w1 + (size_t)l * DM * FF;
    const float* w2 = I.w2 + (size_t)l * FF * DM; const float* wg = I.wg + (size_t)l * 256 * 256;
    for (int it = gw; it < NITEMS; it += NGW) {
        int r = it;
        if (r < I_IN) { tr_item(w_in, NIN, r / (NINP / 32), r % (NINP / 32), F.Win_t(), DM, 0, true, scr, F.lane); continue; } r -= I_IN;
        if (r < I_A) { tr_item(wa, DM, r / 32, r % 32, F.Wabc_t(), DM, 0, false, scr, F.lane); continue; } r -= I_A;
        if (r < I_B) { tr_item(wb, DM, r / 32, r % 32, F.Wabc_t(), DM, 256, false, scr, F.lane); continue; } r -= I_B;
        if (r < I_C) { tr_item(wc, DM, r / 32, r % 32, F.Wabc_t(), DM, 640, false, scr, F.lane); continue; } r -= I_C;
        if (r < I_O) { tr_item(wo, DM, r / 32, r % 32, F.Wout_t(), DM, 0, false, scr, F.lane); continue; } r -= I_O;
        if (r < I_1) { tr_item(w1, FF, r / 128, r % 128, F.W1_t(), DM, 0, false, scr, F.lane); continue; } r -= I_1;
        if (r < I_2) { tr_item(w2, DM, r / 32, r % 32, F.W2_t(), FF, 0, false, scr, F.lane); continue; } r -= I_2;
        tr_item(wg, 256, r / 8, r % 8, F.Wglu_t(), 256, 0, false, scr, F.lane);
    }
}
__device__ __forceinline__ void phase_prologue(Frame& F, const ProIn& I) {
#ifdef NO_PHASE_PROLOGUE
    return;
#endif
    LAS float* scr = (LAS float*)(F.lds + F.wave * 16384);
    const int gw = F.bid * NWAVES + F.wave, NGW = F.G * NWAVES;
#pragma unroll 1
    for (int l = 0; l < DEPTH; ++l) {
    F.wl = l ? (unsigned)(WS_W1L - WS_W) : 0u;
    if (!(l >= 1 && F.G == 256)) prologue_weights(F, I, l, gw, NGW);
    {
        const int gt = F.bid * NTHREADS + F.tid;
        if (gt < 1024) {
            float* SPp = F.SP(l);
            const int g = gt >> 6, p = gt & 63;
            const float lr = I.lam_re[(l * 16 + g) * 64 + p], li = I.lam_im[(l * 16 + g) * 64 + p];
            const float step = expf(I.log_step[l * 16 + g]);
            const float mag = expf(lr * step); const float lbr = mag * cosf(li * step), lbi = mag * sinf(li * step);
            const float den = lr * lr + li * li;
            const float fr = ((lbr - 1.f) * lr + lbi * li) / den, fi = (lbi * lr - (lbr - 1.f) * li) / den;
            SPp[SP_LB + gt * 2] = lbr; SPp[SP_LB + gt * 2 + 1] = lbi;
            float pr = lbr, pi = lbi;
#pragma unroll
            for (int s = 0; s < 6; ++s) { const float nr = pr * pr - pi * pi, ni = 2.f * pr * pi; pr = nr; pi = ni; }
            SPp[SP_L64 + gt * 2] = pr; SPp[SP_L64 + gt * 2 + 1] = pi;
            const float* br = I.b_re + ((size_t)(l * 16 + g) * 64 + p) * 16; const float* bi = I.b_im + ((size_t)(l * 16 + g) * 64 + p) * 16;
#pragma unroll
            for (int c = 0; c < 16; ++c) { SPp[SP_BBR + gt * 16 + c] = fr * br[c] - fi * bi[c]; SPp[SP_BBI + gt * 16 + c] = fr * bi[c] + fi * br[c]; }
        }
    }
    }
    F.wl = 0u;
    for (int m = gw; m < T; m += NGW) rms_row_bf16(I.xin + (size_t)m * DM, I.norm1_g, F.H() + (size_t)m * DM, F.lane);
}

__device__ __forceinline__ u32x4 pack8(const f32x4& a, const f32x4& b) { u32x4 w; w.x = pk2(a.x, a.y); w.y = pk2(a.z, a.w); w.z = pk2(b.x, b.y); w.w = pk2(b.z, b.w); return w; }
__device__ __forceinline__ void unpack8(const u32x4& w, f32x4& a, f32x4& b) { a = (f32x4){bflo(w.x), bfhi(w.x), bflo(w.y), bfhi(w.y)}; b = (f32x4){bflo(w.z), bfhi(w.z), bflo(w.w), bfhi(w.w)}; }

__device__ __forceinline__ unsigned gate1_u8(float x) { const float s = 255.f * sigmoidf_(x) + 0.5f; const unsigned u = (unsigned)s; return u < 1u ? 1u : u; }
__device__ __forceinline__ unsigned gate4_u8(const f32x4& a) { return gate1_u8(a.x) | (gate1_u8(a.y) << 8) | (gate1_u8(a.z) << 16) | (gate1_u8(a.w) << 24); }
__device__ __forceinline__ void ungate8(const u32x2& w, f32x4& a, f32x4& b) {
    a = (f32x4){(float)(w.x & 255u), (float)((w.x >> 8) & 255u), (float)((w.x >> 16) & 255u), (float)(w.x >> 24)};
    b = (f32x4){(float)(w.y & 255u), (float)((w.y >> 8) & 255u), (float)((w.y >> 16) & 255u), (float)(w.y >> 24)};
}
struct FInProj {
    bf16_t* ZS; unsigned char* GB; float* IW; const f32x2* ROPE; bf16_t* IKD;
    __device__ __forceinline__ void rope8(f32x4& a, f32x4& b, int row, int f0) const {
        const f32x2* rt = ROPE + (size_t)row * NFREQ + f0;
        const f32x2 c0 = rt[0], c1 = rt[1], c2 = rt[2], c3 = rt[3];
        f32x4 oa, ob;
        oa.x = a.x * c0.x - a.y * c0.y; oa.y = a.y * c0.x + a.x * c0.y;
        oa.z = a.z * c1.x - a.w * c1.y; oa.w = a.w * c1.x + a.z * c1.y;
        ob.x = b.x * c2.x - b.y * c2.y; ob.y = b.y * c2.x + b.x * c2.y;
        ob.z = b.z * c3.x - b.w * c3.y; ob.w = b.w * c3.x + b.z * c3.y;
        a = oa; b = ob;
    }
    __device__ __forceinline__ void operator()(int row, int col, f32x4 a, f32x4 b) const {
        if (col >= ZEND) return;
        if (col >= ZGATE) {
            *(u32x2*)(GB + (size_t)row * GW + (col - ZGATE)) = (u32x2){gate4_u8(a), gate4_u8(b)}; return;
        }
        if (col >= ZIWC && col < ZRQ) { if (col == ZIWC) *(f32x4*)(IW + (size_t)row * 4) = a; return; }
        if (col >= ZDQ && col < ZDV) { const int hc = (col - ZDQ) & 63; if (hc < 16) rope8(a, b, row, hc >> 1); }
        else if (col >= ZIQ && col < ZIWC) { const int hc = (col - ZIQ) & 31; if (hc < 8) rope8(a, b, row, 8);
            if (col >= ZIK) { *(u32x4*)(IKD + ((size_t)((row >> 5) * 4 + ((col - ZIK) >> 3)) * 32 + (row & 31)) * 8) = pack8(a, b); return; } }
        else if (col >= ZRQ && col < ZRV) { const int hc = (col - ZRQ) % 48; rope8(a, b, row, 12 + (hc >> 1)); }
        *(u32x4*)(ZS + (size_t)row * ZSW + col) = pack8(a, b);
    }
};
struct FMerge {
    bf16_t* MG; const bf16_t* GB; int br;
    __device__ __forceinline__ void operator()(int row, int col, f32x4 a, f32x4 b) const {
        f32x4 ga, gb; unpack8(*(const u32x4*)(GB + (size_t)row * GW + br * DM + col), ga, gb);
        a = a * ga; b = b * gb;
        u32x4* mp = (u32x4*)(MG + (size_t)row * DM + col);
        if (br != 0) { f32x4 pa, pb; unpack8(*mp, pa, pb); a = a + pa; b = b + pb; }
        *mp = pack8(a, b);
    }
};
struct FResid {
    const float* base; float* out;
    __device__ __forceinline__ void operator()(int row, int col, f32x4 a, f32x4 b) const {
        const f32x4* bp = (const f32x4*)(base + (size_t)row * DM + col); f32x4* op = (f32x4*)(out + (size_t)row * DM + col);
        const f32x4 b0 = bp[0], b1 = bp[1]; op[0] = b0 + a; op[1] = b1 + b;
    }
};
struct FRelu2 {
    bf16_t* FB;
    __device__ __forceinline__ void operator()(int row, int col, f32x4 a, f32x4 b) const {
        a = (f32x4){fmaxf(a.x, 0.f), fmaxf(a.y, 0.f), fmaxf(a.z, 0.f), fmaxf(a.w, 0.f)}; b = (f32x4){fmaxf(b.x, 0.f), fmaxf(b.y, 0.f), fmaxf(b.z, 0.f), fmaxf(b.w, 0.f)};
        *(u32x4*)(FB + (size_t)row * FF + col) = pack8(a * a, b * b);
    }
};
struct FGlu {
    bf16_t* H; const float* bias;
    __device__ __forceinline__ void operator()(int row, int col, f32x4 a, f32x4 b) const {
        u32x4* hp = (u32x4*)(H + (size_t)row * DM + col); f32x4 ya, yb; unpack8(*hp, ya, yb);
        const f32x4 ba = *(const f32x4*)(bias + col), bb = *(const f32x4*)(bias + col + 4);
        a = a + ba; b = b + bb;
        a = (f32x4){ya.x * sigmoidf_(a.x), ya.y * sigmoidf_(a.y), ya.z * sigmoidf_(a.z), ya.w * sigmoidf_(a.w)};
        b = (f32x4){yb.x * sigmoidf_(b.x), yb.y * sigmoidf_(b.y), yb.z * sigmoidf_(b.z), yb.w * sigmoidf_(b.w)};
        *hp = pack8(a, b);
    }
};

struct EpiMerge {
    static constexpr bool PERM = true, HAS_MID = true, FUSED = false; static constexpr int MID0 = 4, MID1 = 10;
    bf16_t* MG; const unsigned char* GB;
    __device__ __forceinline__ void mid(f32x4 (&acc)[2][2][4][2], const pg8::Unit& u, int t, int wr, int wc, int fr, int fq) const {
        int zz = 0; asm volatile("" : "+v"(zz));
        const int row0 = u.pm * 256 + wr * 64 + fr + zz, col0 = u.pn * 256 + wc * 32 + 8 * fq, bp = (t == MID0) ? 0 : 1;
#pragma unroll
        for (int ai = 0; ai < 2; ++ai)
#pragma unroll
            for (int m = 0; m < 4; ++m) {
#pragma unroll
                for (int bj = 0; bj < 2; ++bj) {
                    const unsigned char* gp = GB + (size_t)(row0 + ai * 128 + m * 16) * GW + bp * DM + col0 + bj * 128;
                    f32x4 pa, pb, na, nb; ungate8(*(const u32x2*)gp, pa, pb); ungate8(*(const u32x2*)(gp + DM), na, nb);
                    const f32x4 fa = {pa.x * __builtin_amdgcn_rcpf(na.x), pa.y * __builtin_amdgcn_rcpf(na.y), pa.z * __builtin_amdgcn_rcpf(na.z), pa.w * __builtin_amdgcn_rcpf(na.w)};
                    const f32x4 fb = {pb.x * __builtin_amdgcn_rcpf(nb.x), pb.y * __builtin_amdgcn_rcpf(nb.y), pb.z * __builtin_amdgcn_rcpf(nb.z), pb.w * __builtin_amdgcn_rcpf(nb.w)};
                    acc[ai][bj][m][0] = acc[ai][bj][m][0] * fa; acc[ai][bj][m][1] = acc[ai][bj][m][1] * fb;
                }
                if (m == 3) asm volatile("" ::: "memory");
            }
    }
    __device__ __forceinline__ void operator()(const f32x4 (&acc)[2][2][4][2], const pg8::Unit& u, int wr, int wc, int fr, int fq) const {
        const int row0 = u.pm * 256 + wr * 64 + fr, col0 = u.pn * 256 + wc * 32 + 8 * fq;
#pragma unroll
        for (int ai = 0; ai < 2; ++ai)
#pragma unroll
            for (int m = 0; m < 4; ++m)
#pragma unroll
                for (int bj = 0; bj < 2; ++bj) {
                    const int row = row0 + ai * 128 + m * 16, col = col0 + bj * 128;
                    f32x4 ga, gb; ungate8(*(const u32x2*)(GB + (size_t)row * GW + 2 * DM + col), ga, gb);
                    *(u32x4*)(MG + (size_t)row * DM + col) = pack8(acc[ai][bj][m][0] * (ga * (1.f / 255.f)), acc[ai][bj][m][1] * (gb * (1.f / 255.f)));
                }
    }
};

struct EpiResidNorm {
    static constexpr bool PERM = true, HAS_MID = false, FUSED = true;
    const float* base; const bf16_t* base16; bf16_t* XOUT; bf16_t* HN; float* NOUT; const float* gain; float* xbuf; unsigned* cnt;
    __device__ __forceinline__ void fused(f32x4 (&acc)[2][2][4][2], const pg8::Unit& u, int wr, int wc, int fr, int fq, LAS unsigned char* lds, int wid, int lane) const {
        LAS float* P = (LAS float*)(lds + 131072);
        LAS float* S = (LAS float*)(lds + 131072 + 4096);
        LAS unsigned* flag = (LAS unsigned*)(lds + 131072 + 5120);
        int zz = 0; asm volatile("" : "+v"(zz));
        const int rl0 = wr * 64 + fr + zz, row0 = u.pm * 256 + rl0, col0 = u.pn * 256 + wc * 32 + 8 * fq;
#pragma unroll
        for (int ai = 0; ai < 2; ++ai) {
#pragma unroll
            for (int m = 0; m < 4; ++m) {
                float ss = 0.f;
#pragma unroll
                for (int bj = 0; bj < 2; ++bj) {
                    const size_t off = (size_t)(row0 + ai * 128 + m * 16) * DM + col0 + bj * 128;
                    f32x4 r0, r1;
                    if (base) { r0 = *(const f32x4*)(base + off); r1 = *(const f32x4*)(base + off + 4); } else unpack8(*(const u32x4*)(base16 + off), r0, r1);
                    const f32x4 x0 = r0 + acc[ai][bj][m][0], x1 = r1 + acc[ai][bj][m][1];
                    acc[ai][bj][m][0] = x0; acc[ai][bj][m][1] = x1;
                    ss += (x0.x * x0.x + x0.y * x0.y) + (x0.z * x0.z + x0.w * x0.w) + (x1.x * x1.x + x1.y * x1.y) + (x1.z * x1.z + x1.w * x1.w);
                }
                ss += __shfl_xor(ss, 16); ss += __shfl_xor(ss, 32);
                if (fq == 0) P[(rl0 + ai * 128 + m * 16) * 4 + wc] = ss;
            }
            asm volatile("" ::: "memory");
        }
        asm volatile("s_waitcnt lgkmcnt(0)" ::: "memory"); __builtin_amdgcn_s_barrier(); asm volatile("" ::: "memory");
        const int rowt = wid * 64 + lane;
        if (wid < 4) {
            const f32x4 p = *(const LAS f32x4*)(P + rowt * 4);
            __hip_atomic_store(xbuf + (size_t)(u.pm * 256 + rowt) * 4 + u.pn, (p.x + p.y) + (p.z + p.w), __ATOMIC_RELAXED, __HIP_MEMORY_SCOPE_AGENT);
        }
        asm volatile("s_waitcnt vmcnt(0)" ::: "memory");
        if (lane == 0) __hip_atomic_fetch_add(cnt + 64 * u.pm, 1u, __ATOMIC_RELAXED, __HIP_MEMORY_SCOPE_AGENT);
        if (wid == 0) {
            unsigned sp = 0u;
            for (;;) {
                if ((unsigned)__builtin_amdgcn_readfirstlane(__hip_atomic_load(cnt + 64 * u.pm, __ATOMIC_RELAXED, __HIP_MEMORY_SCOPE_AGENT)) >= 32u) break;
                __builtin_amdgcn_s_sleep(2);
                if (++sp > (1u << 20)) break;
            }
            __builtin_amdgcn_fence(__ATOMIC_ACQUIRE, "agent");
            if (lane == 0) flag[0] = 1u;
        }
        asm volatile("s_waitcnt vmcnt(0) lgkmcnt(0)" ::: "memory"); __builtin_amdgcn_s_barrier(); asm volatile("" ::: "memory");
        if (wid < 4) {
            const float* sl = xbuf + (size_t)(u.pm * 256 + rowt) * 4;
            const float s = (__hip_atomic_load(sl, __ATOMIC_RELAXED, __HIP_MEMORY_SCOPE_AGENT) + __hip_atomic_load(sl + 1, __ATOMIC_RELAXED, __HIP_MEMORY_SCOPE_AGENT))
                          + (__hip_atomic_load(sl + 2, __ATOMIC_RELAXED, __HIP_MEMORY_SCOPE_AGENT) + __hip_atomic_load(sl + 3, __ATOMIC_RELAXED, __HIP_MEMORY_SCOPE_AGENT));
            S[rowt] = rsqrtf(s * (1.f / DM) + EPS);
        }
        asm volatile("s_waitcnt vmcnt(0) lgkmcnt(0)" ::: "memory"); __builtin_amdgcn_s_barrier(); asm volatile("" ::: "memory");
#pragma unroll
        for (int bj = 0; bj < 2; ++bj) {
            const f32x4 g0 = *(const f32x4*)(gain + col0 + bj * 128), g1 = *(const f32x4*)(gain + col0 + bj * 128 + 4);
#pragma unroll
            for (int ai = 0; ai < 2; ++ai)
#pragma unroll
                for (int m = 0; m < 4; ++m) {
                    const float rs = S[rl0 + ai * 128 + m * 16];
                    const size_t off = (size_t)(row0 + ai * 128 + m * 16) * DM + col0 + bj * 128;
                    const f32x4 y0 = acc[ai][bj][m][0] * rs * g0, y1 = acc[ai][bj][m][1] * rs * g1;
                    if (XOUT) *(u32x4*)(XOUT + off) = pack8(acc[ai][bj][m][0], acc[ai][bj][m][1]);
                    if (HN) *(u32x4*)(HN + off) = pack8(y0, y1);
                    if (NOUT) { *(f32x4*)(NOUT + off) = y0; *(f32x4*)(NOUT + off + 4) = y1; }
                }
        }
        asm volatile("s_waitcnt lgkmcnt(0)" ::: "memory"); __builtin_amdgcn_s_barrier(); asm volatile("" ::: "memory");
    }
    __device__ __forceinline__ void operator()(const f32x4 (&)[2][2][4][2], const pg8::Unit&, int, int, int, int) const {}
};

typedef float f32x16 __attribute__((ext_vector_type(16)));
__device__ __forceinline__ float gelu_tanh(float x) { const float u = 0.7978845608028654f * (x + 0.044715f * x * x * x); const float e = __expf(2.f * u); const float th = 1.f - 2.f * __builtin_amdgcn_rcpf(e + 1.f); return 0.5f * x * (1.f + th); }
constexpr int S5_XSTR = 272;
constexpr int S5_WAVE_LDS = 2 * 16 * S5_XSTR;
constexpr int S5_YSTR = 528;
constexpr int S5_YOFF = NWAVES * S5_WAVE_LDS;
template <bool OUT, bool TOLDS>
__device__ __forceinline__ void s5_task(Frame& F, int l, int pp, int g, LAS unsigned char* XL, LAS unsigned char* YL, const bf16_t* ZSp, const float* SPp, f32x2* S5Ep,
                                        const float* c_re, const float* c_im, const float* ssm_d) {
    {
        int lane = F.lane; asm volatile("" : "+v"(lane));
        const int n = lane & 31, hh = lane >> 5, l15 = lane & 15, kg = lane >> 4;
        const int cmine = 2 * pp + hh;
        bf16x8 bbf[2][2];
#pragma unroll
        for (int st = 0; st < 2; ++st) { const float* br = SPp + SP_BBR + (size_t)(g * 64 + 2 * n + st) * 16 + 8 * hh; const float* bi = SPp + SP_BBI + (size_t)(g * 64 + 2 * n + st) * 16 + 8 * hh;
            bbf[st][0] = __builtin_bit_cast(bf16x8, pack8(*(const f32x4*)br, *(const f32x4*)(br + 4))); bbf[st][1] = __builtin_bit_cast(bf16x8, pack8(*(const f32x4*)bi, *(const f32x4*)(bi + 4))); }
        const f32x4 lb = *(const f32x4*)(SPp + SP_LB + (g * 64 + 2 * n) * 2);
        f32x4 x = {0.f, 0.f, 0.f, 0.f};
        if constexpr (OUT) x = *(const f32x4*)(S5Ep + (size_t)(cmine * 16 + g) * 64 + 2 * n);
        bf16x8 cf[4]; f32x4 dsk = {0.f, 0.f, 0.f, 0.f};
        if constexpr (OUT) {
#pragma unroll
            for (int ks = 0; ks < 4; ++ks) { const float* cp = ((ks < 2) ? c_re : c_im) + ((size_t)(l * 16 + g) * 16 + l15) * 64 + 32 * (ks & 1) + 8 * kg;
                f32x4 a = *(const f32x4*)cp, b = *(const f32x4*)(cp + 4); if (ks >= 2) { a = -a; b = -b; }
                cf[ks] = __builtin_bit_cast(bf16x8, pack8(a, b)); }
            dsk = *(const f32x4*)(ssm_d + (l * 16 + g) * 16 + 4 * kg);
        }
        const bf16_t* urow = ZSp + (size_t)((2 * pp + ((n >> 2) & 1)) * 64 + 4 * (n >> 3) + (n & 3)) * ZSW + ZU + g * 16 + 8 * hh;
#pragma unroll 1
        for (int k = 0; k < 4; ++k) {
            const bf16x8 uf = *(const bf16x8*)(urow + (size_t)(16 * k) * ZSW);
            const f32x16 z16 = {0.f, 0.f, 0.f, 0.f, 0.f, 0.f, 0.f, 0.f, 0.f, 0.f, 0.f, 0.f, 0.f, 0.f, 0.f, 0.f};
            const f32x16 r0 = __builtin_amdgcn_mfma_f32_32x32x16_bf16(uf, bbf[0][0], z16, 0, 0, 0), i0 = __builtin_amdgcn_mfma_f32_32x32x16_bf16(uf, bbf[0][1], z16, 0, 0, 0);
            const f32x16 r1 = __builtin_amdgcn_mfma_f32_32x32x16_bf16(uf, bbf[1][0], z16, 0, 0, 0), i1 = __builtin_amdgcn_mfma_f32_32x32x16_bf16(uf, bbf[1][1], z16, 0, 0, 0);
#pragma unroll
            for (int t = 0; t < 16; ++t) {
                const float nr0 = lb.x * x.x - lb.y * x.y + r0[t], ni0 = lb.x * x.y + lb.y * x.x + i0[t];
                const float nr1 = lb.z * x.z - lb.w * x.w + r1[t], ni1 = lb.z * x.w + lb.w * x.z + i1[t];
                x = (f32x4){nr0, ni0, nr1, ni1};
                if constexpr (OUT) { LAS unsigned* xw = (LAS unsigned*)(XL + (hh * 16 + t) * S5_XSTR + 4 * n); xw[0] = pk2(nr0, nr1); xw[32] = pk2(ni0, ni1); }
            }
            if constexpr (OUT) {
                asm volatile("s_waitcnt lgkmcnt(0)" ::: "memory");
#pragma unroll
                for (int sel = 0; sel < 2; ++sel) {
                    f32x4 y = {0.f, 0.f, 0.f, 0.f};
#pragma unroll
                    for (int ks = 0; ks < 4; ++ks) { const bf16x8 xf = *(const LAS bf16x8*)(XL + (sel * 16 + l15) * S5_XSTR + (32 * ks + 8 * kg) * 2); y = __builtin_amdgcn_mfma_f32_16x16x32_bf16(cf[ks], xf, y, 0, 0, 0); }
                    const size_t tok = (size_t)(2 * pp + sel) * 64 + 16 * k + l15;
                    const u32x2 uw = *(const u32x2*)(ZSp + tok * ZSW + ZU + g * 16 + 4 * kg);
                    const float y0 = gelu_tanh(y.x + dsk.x * bflo(uw.x)), y1 = gelu_tanh(y.y + dsk.y * bfhi(uw.x)), y2 = gelu_tanh(y.z + dsk.z * bflo(uw.y)), y3 = gelu_tanh(y.w + dsk.w * bfhi(uw.y));
                    if constexpr (TOLDS) *(LAS u32x2*)(YL + (sel * 64 + 16 * k + l15) * S5_YSTR + (g * 16 + 4 * kg) * 2) = (u32x2){pk2(y0, y1), pk2(y2, y3)};
                    else *(u32x2*)(F.H() + tok * DM + g * 16 + 4 * kg) = (u32x2){pk2(y0, y1), pk2(y2, y3)};
                }
                asm volatile("s_waitcnt lgkmcnt(0)" ::: "memory");
            }
        }
        if constexpr (!OUT) *(f32x4*)(S5Ep + (size_t)(cmine * 16 + g) * 64 + 2 * n) = x;
    }
}
template <bool OUT>
__device__ __forceinline__ void s5_pass(Frame& F, int l, const float* c_re, const float* c_im, const float* ssm_d) {
    const bf16_t* ZSp = F.ZS(); const float* SPp = F.SP(l); f32x2* S5Ep = F.S5E();
    LAS unsigned char* XL = F.lds + F.wave * S5_WAVE_LDS;
    for (int task = F.bid * NWAVES + F.wave; task < 256 * 16; task += F.G * NWAVES) s5_task<OUT, false>(F, l, task >> 4, task & 15, XL, nullptr, ZSp, SPp, S5Ep, c_re, c_im, ssm_d);
}
__device__ __forceinline__ void phase_s5_out_glu(Frame& F, int l, const float* c_re, const float* c_im, const float* ssm_d, const bf16_t* WgT, const float* gbias) {
    const bf16_t* ZSp = F.ZS(); const float* SPp = F.SP(l); f32x2* S5Ep = F.S5E();
    LAS unsigned char* XL = F.lds + F.wave * S5_WAVE_LDS;
    LAS unsigned char* YL = F.lds + S5_YOFF;
    for (int pp = F.bid; pp < 256; pp += F.G) {
        s5_task<true, true>(F, l, pp, F.wave, XL, YL, ZSp, SPp, S5Ep, c_re, c_im, ssm_d);
        s5_task<true, true>(F, l, pp, F.wave + 8, XL, YL, ZSp, SPp, S5Ep, c_re, c_im, ssm_d);
        asm volatile("s_waitcnt lgkmcnt(0)" ::: "memory"); __syncthreads();
        int lane = F.lane; asm volatile("" : "+v"(lane));
        const int l15 = lane & 15, kg = lane >> 4, w = F.wave;
        bf16x8 wf[2][8];
#pragma unroll
        for (int nt = 0; nt < 2; ++nt)
#pragma unroll
            for (int ks = 0; ks < 8; ++ks) wf[nt][ks] = *(const bf16x8*)(WgT + (size_t)(32 * w + 16 * nt + l15) * 256 + 32 * ks + 8 * kg);
        f32x4 bz[2];
#pragma unroll
        for (int nt = 0; nt < 2; ++nt) bz[nt] = *(const f32x4*)(gbias + 32 * w + 16 * nt + 4 * kg);
#pragma unroll 2
        for (int mt = 0; mt < 8; ++mt) {
            f32x4 acc[2] = {{0.f, 0.f, 0.f, 0.f}, {0.f, 0.f, 0.f, 0.f}};
#pragma unroll
            for (int ks = 0; ks < 8; ++ks) {
                const bf16x8 yf = *(const LAS bf16x8*)(YL + (16 * mt + l15) * S5_YSTR + (32 * ks + 8 * kg) * 2);
                acc[0] = __builtin_amdgcn_mfma_f32_16x16x32_bf16(wf[0][ks], yf, acc[0], 0, 0, 0);
                acc[1] = __builtin_amdgcn_mfma_f32_16x16x32_bf16(wf[1][ks], yf, acc[1], 0, 0, 0);
            }
            const size_t tok = (size_t)pp * 128 + 16 * mt + l15;
#pragma unroll
            for (int nt = 0; nt < 2; ++nt) {
                const int col = 32 * w + 16 * nt + 4 * kg;
                const u32x2 yw = *(const LAS u32x2*)(YL + (16 * mt + l15) * S5_YSTR + col * 2);
                const f32x4 z = acc[nt] + bz[nt];
                const float o0 = bflo(yw.x) * sigmoidf_(z.x), o1 = bfhi(yw.x) * sigmoidf_(z.y), o2 = bflo(yw.y) * sigmoidf_(z.z), o3 = bfhi(yw.y) * sigmoidf_(z.w);
                *(u32x2*)(F.H() + tok * DM + col) = (u32x2){pk2(o0, o1), pk2(o2, o3)};
            }
        }
        asm volatile("s_waitcnt lgkmcnt(0)" ::: "memory"); __syncthreads();
    }
}
__device__ __forceinline__ void phase_s5_local(Frame& F, int l) {
#ifdef NO_PHASE_S5_LOCAL
    return;
#endif
    s5_pass<false>(F, l, nullptr, nullptr, nullptr);
}
__device__ __forceinline__ void phase_s5_out(Frame& F, int l, const float* c_re, const float* c_im, const float* ssm_d) {
#ifdef NO_PHASE_S5_OUT
    return;
#endif
    s5_pass<true>(F, l, c_re, c_im, ssm_d);
}

__device__ __forceinline__ void phase_carry(Frame& F, int l) {
#ifdef NO_PHASE_CARRY
    return;
#endif
    const float* SPp = F.SP(l); f32x2* S5Ep = F.S5E(); float* RSTp = F.RST();
    const int gw = F.bid * NWAVES + F.wave, NGW = F.G * NWAVES;
    for (int task = gw; task < NB * 16; task += NGW) {
        const int b = task >> 4, g = task & 15, p = F.lane;
        const float ar = SPp[SP_L64 + (g * 64 + p) * 2], ai = SPp[SP_L64 + (g * 64 + p) * 2 + 1];
        float sr = 0.f, si = 0.f;
        for (int c0 = 0; c0 < 128; c0 += 16) {
            f32x2 e[16];
#pragma unroll
            for (int j = 0; j < 16; ++j) e[j] = S5Ep[(size_t)((b * 128 + c0 + j) * 16 + g) * 64 + p];
#pragma unroll
            for (int j = 0; j < 16; ++j) { S5Ep[(size_t)((b * 128 + c0 + j) * 16 + g) * 64 + p] = (f32x2){sr, si}; const float nr = ar * sr - ai * si + e[j].x, ni = ar * si + ai * sr + e[j].y; sr = nr; si = ni; }
        }
    }
    const int NT = F.G * NTHREADS;
    for (int gt = F.bid * NTHREADS + F.tid; gt < NB * 4 * 4608; gt += NT) {
        const int b = gt / (4 * 4608), h = (gt / 4608) & 3, el = gt % 4608;
        const float lg = log1pf(-exp2f(-5.f - (float)h));
        const float cdec = expf(lg * 64.f);
        float s = 0.f;
        for (int c0 = 0; c0 < 128; c0 += 16) {
            float d[16];
#pragma unroll
            for (int j = 0; j < 16; ++j) d[j] = RSTp[(size_t)((b * 128 + c0 + j) * 4 + h) * 4608 + el];
#pragma unroll
            for (int j = 0; j < 16; ++j) { RSTp[(size_t)((b * 128 + c0 + j) * 4 + h) * 4608 + el] = s; s = s * cdec + d[j]; }
        }
    }
}

typedef float f32x16 __attribute__((ext_vector_type(16)));
typedef short s16x4 __attribute__((ext_vector_type(4)));
__device__ __forceinline__ bf16x8 tr8(const LAS unsigned char* a0, const LAS unsigned char* a1) {
    const s16x4 lo = __builtin_bit_cast(s16x4, __builtin_amdgcn_ds_read_tr16_b64_v4i16((LAS s16x4*)a0));
    const s16x4 hi = __builtin_bit_cast(s16x4, __builtin_amdgcn_ds_read_tr16_b64_v4i16((LAS s16x4*)a1));
    return (bf16x8){lo[0], lo[1], lo[2], lo[3], hi[0], hi[1], hi[2], hi[3]};
}
__device__ __forceinline__ bf16x8 pack8f(const f32x4& a, const f32x4& b) { return __builtin_bit_cast(bf16x8, pack8(a, b)); }
__device__ __forceinline__ void ret_stage_v(const bf16_t* ZSp, LAS unsigned char* Vb, int tok0, int h, int lane) {
#pragma unroll
    for (int n = 0; n < 12; ++n) { const int o = n * 1024 + 16 * lane, r = o / 192, ch = (o % 192) >> 4;
        __builtin_amdgcn_global_load_lds((const unsigned*)(ZSp + (size_t)(tok0 + r) * ZSW + ZRV + h * 96 + ch * 8), (LAS unsigned*)(Vb + n * 1024), 16, 0, 0); }
}
constexpr int RET_VB = 12288, RET_KSTR = 112, RET_WAVE_LDS = RET_VB + 64 * RET_KSTR;
__device__ __forceinline__ void phase_ret_local(Frame& F) {
#ifdef NO_PHASE_RET_LOCAL
    return;
#endif
    const bf16_t* ZSp = F.ZS(); float* RSTp = F.RST();
    LAS unsigned char* Vb = F.lds + F.wave * RET_WAVE_LDS; LAS unsigned char* Kb = Vb + RET_VB;
    for (int item = F.bid * NWAVES + F.wave; item < 2048; item += F.G * NWAVES) {
        int lane = F.lane; asm volatile("" : "+v"(lane));
        const int l31 = lane & 31, hh = lane >> 5, g1 = (lane >> 4) & 1, q4 = (lane & 15) >> 2, p4 = lane & 3;
        const int h = item & 3, tok0 = (item >> 2) * 64;
        ret_stage_v(ZSp, Vb, tok0, h, lane);
        const float lg2 = log2f(1.f - exp2f(-5.f - (float)h));
#pragma unroll
        for (int n = 0; n < 6; ++n) { const int idx = n * 64 + lane, r = idx / 6, ch = idx % 6;
            f32x4 a, b; unpack8(*(const u32x4*)(ZSp + (size_t)(tok0 + r) * ZSW + ZRK + h * 48 + ch * 8), a, b);
            const float sc = 0.14433756729740643f * exp2f(lg2 * (float)(63 - r));
            *(LAS u32x4*)(Kb + r * RET_KSTR + ch * 16) = pack8(a * sc, b * sc); }
        asm volatile("s_waitcnt vmcnt(0) lgkmcnt(0)" ::: "memory");
        f32x16 acc[3][2];
#pragma unroll
        for (int me = 0; me < 3; ++me)
#pragma unroll
            for (int nt = 0; nt < 2; ++nt) acc[me][nt] = (f32x16){0.f, 0.f, 0.f, 0.f, 0.f, 0.f, 0.f, 0.f, 0.f, 0.f, 0.f, 0.f, 0.f, 0.f, 0.f, 0.f};
#pragma unroll
        for (int s = 0; s < 4; ++s) {
            const int r0 = 16 * s + 8 * hh + q4;
            bf16x8 kf[2], vf[3];
#pragma unroll
            for (int nt = 0; nt < 2; ++nt) { const LAS unsigned char* a0 = Kb + r0 * RET_KSTR + (32 * nt + 16 * g1 + 4 * p4) * 2; kf[nt] = tr8(a0, a0 + 4 * RET_KSTR); }
#pragma unroll
            for (int me = 0; me < 3; ++me) { const LAS unsigned char* a0 = Vb + r0 * 192 + (32 * me + 16 * g1 + 4 * p4) * 2; vf[me] = tr8(a0, a0 + 4 * 192); }
#pragma unroll
            for (int me = 0; me < 3; ++me)
#pragma unroll
                for (int nt = 0; nt < 2; ++nt) acc[me][nt] = __builtin_amdgcn_mfma_f32_32x32x16_bf16(vf[me], kf[nt], acc[me][nt], 0, 0, 0);
        }
        float* dst = RSTp + (size_t)item * 4608 + (4 * hh) * 48 + l31;
#pragma unroll
        for (int me = 0; me < 3; ++me)
#pragma unroll
            for (int r4 = 0; r4 < 4; ++r4) {
                int zz = 0; asm volatile("" : "+v"(zz)); float* dp = dst + (32 * me + 8 * r4) * 48 + zz;
#pragma unroll
                for (int k = 0; k < 4; ++k) { dp[k * 48] = acc[me][0][4 * r4 + k]; if (l31 < 16) dp[k * 48 + 32] = acc[me][1][4 * r4 + k]; }
            }
        asm volatile("s_waitcnt lgkmcnt(0)" ::: "memory");
    }
}
__device__ __forceinline__ void phase_ret_out(Frame& F, int l, const float* ret_norm_g) {
#ifdef NO_PHASE_RET_OUT
    return;
#endif
    const bf16_t* ZSp = F.ZS(); const float* RSTp = F.RST();
    LAS unsigned char* Vb = F.lds + F.wave * RET_WAVE_LDS;
    for (int item = F.bid * NWAVES + F.wave; item < 2048; item += F.G * NWAVES) {
        int lane = F.lane; asm volatile("" : "+v"(lane));
        const int l31 = lane & 31, hh = lane >> 5, g1 = (lane >> 4) & 1, q4 = (lane & 15) >> 2, p4 = lane & 3;
        const int h = item & 3, tok0 = (item >> 2) * 64;
        ret_stage_v(ZSp, Vb, tok0, h, lane);
        const float lg2 = log2f(1.f - exp2f(-5.f - (float)h));
        bf16x8 qf[2][3], kf[2][3];
#pragma unroll
        for (int t = 0; t < 2; ++t)
#pragma unroll
            for (int ks = 0; ks < 3; ++ks) { const size_t ro = (size_t)(tok0 + 32 * t + l31) * ZSW + h * 48 + 8 * hh + 16 * ks;
                qf[t][ks] = *(const bf16x8*)(ZSp + ro + ZRQ); kf[t][ks] = *(const bf16x8*)(ZSp + ro + ZRK); }
        bf16x8 pm[2][4];
#pragma unroll
        for (int mt = 0; mt < 2; ++mt)
#pragma unroll
            for (int nt = mt; nt < 2; ++nt) {
                f32x16 p = {0.f, 0.f, 0.f, 0.f, 0.f, 0.f, 0.f, 0.f, 0.f, 0.f, 0.f, 0.f, 0.f, 0.f, 0.f, 0.f};
#pragma unroll
                for (int ks = 0; ks < 3; ++ks) p = __builtin_amdgcn_mfma_f32_32x32x16_bf16(kf[mt][ks], qf[nt][ks], p, 0, 0, 0);
                const int i = 32 * nt + l31;
#pragma unroll
                for (int r = 0; r < 16; ++r) { const int j = 32 * mt + (r & 3) + 8 * (r >> 2) + 4 * hh;
                    p[r] = (i >= j) ? p[r] * (0.14433756729740643f * exp2f(lg2 * (float)(i - j))) : 0.f; }
                pm[nt][2 * mt + 0] = pack8f((f32x4){p[0], p[1], p[2], p[3]}, (f32x4){p[4], p[5], p[6], p[7]});
                pm[nt][2 * mt + 1] = pack8f((f32x4){p[8], p[9], p[10], p[11]}, (f32x4){p[12], p[13], p[14], p[15]});
            }
        f32x16 ot[3][2];
#pragma unroll
        for (int me = 0; me < 3; ++me) {
            bf16x8 sf[3];
            int zz = 0; asm volatile("" : "+v"(zz)); const float* sp0 = RSTp + (size_t)item * 4608 + (32 * me + l31) * 48 + 8 * hh + zz;
#pragma unroll
            for (int ks = 0; ks < 3; ++ks) { const float* sp = sp0 + 16 * ks; sf[ks] = pack8f(*(const f32x4*)sp, *(const f32x4*)(sp + 4)); }
#pragma unroll
            for (int nt = 0; nt < 2; ++nt) {
                f32x16 a = {0.f, 0.f, 0.f, 0.f, 0.f, 0.f, 0.f, 0.f, 0.f, 0.f, 0.f, 0.f, 0.f, 0.f, 0.f, 0.f};
#pragma unroll
                for (int ks = 0; ks < 3; ++ks) a = __builtin_amdgcn_mfma_f32_32x32x16_bf16(sf[ks], qf[nt][ks], a, 0, 0, 0);
                const float qd = exp2f(lg2 * (float)(32 * nt + l31 + 1));
                ot[me][nt] = a * qd;
            }
        }
        asm volatile("s_waitcnt vmcnt(0)" ::: "memory");
#pragma unroll
        for (int s = 0; s < 4; ++s) {
            const int r0 = 16 * s + 4 * hh + q4;
#pragma unroll
            for (int me = 0; me < 3; ++me) {
                const LAS unsigned char* a0 = Vb + r0 * 192 + (32 * me + 16 * g1 + 4 * p4) * 2;
                const bf16x8 vf = tr8(a0, a0 + 8 * 192);
                if (s < 2) ot[me][0] = __builtin_amdgcn_mfma_f32_32x32x16_bf16(vf, pm[0][s], ot[me][0], 0, 0, 0);
                ot[me][1] = __builtin_amdgcn_mfma_f32_32x32x16_bf16(vf, pm[1][s], ot[me][1], 0, 0, 0);
            }
        }
#pragma unroll
        for (int nt = 0; nt < 2; ++nt) {
            float sum = 0.f;
#pragma unroll
            for (int me = 0; me < 3; ++me)
#pragma unroll
                for (int r = 0; r < 16; ++r) sum += ot[me][nt][r];
            sum += __shfl_xor(sum, 32);
            const float mu = sum * (1.f / 96.f); float q2 = 0.f;
#pragma unroll
            for (int me = 0; me < 3; ++me)
#pragma unroll
                for (int r = 0; r < 16; ++r) { const float d = ot[me][nt][r] - mu; q2 += d * d; }
            q2 += __shfl_xor(q2, 32);
            const float rs = rsqrtf(q2 * (1.f / 96.f) + EPS);
            const int tok = tok0 + 32 * nt + l31;
            const bf16_t* gbase = ZSp + (size_t)tok * ZSW + ZRG + h * 96 + 4 * hh; const float* nbase = ret_norm_g + l * 384 + h * 96 + 4 * hh; bf16_t* obase = F.H() + (size_t)tok * DM + 640 + h * 96 + 4 * hh;
#pragma unroll
            for (int me = 0; me < 3; ++me) {
                int zz = 0; asm volatile("" : "+v"(zz));
                const bf16_t* gp = gbase + 32 * me + zz; const float* np = nbase + 32 * me + zz; bf16_t* op = obase + 32 * me + zz;
#pragma unroll
                for (int r4 = 0; r4 < 4; ++r4) {
                    const u32x2 gw = *(const u32x2*)(gp + 8 * r4);
                    const f32x4 ng = *(const f32x4*)(np + 8 * r4);
                    const float g0 = bflo(gw.x), g1f = bfhi(gw.x), g2 = bflo(gw.y), g3 = bfhi(gw.y);
                    const float y0 = (ot[me][nt][4 * r4 + 0] - mu) * rs * ng.x * (g0 * sigmoidf_(g0)), y1 = (ot[me][nt][4 * r4 + 1] - mu) * rs * ng.y * (g1f * sigmoidf_(g1f));
                    const float y2 = (ot[me][nt][4 * r4 + 2] - mu) * rs * ng.z * (g2 * sigmoidf_(g2)), y3 = (ot[me][nt][4 * r4 + 3] - mu) * rs * ng.w * (g3 * sigmoidf_(g3));
                    *(u32x2*)(op + 8 * r4) = (u32x2){pk2(y0, y1), pk2(y2, y3)};
                }
            }
        }
        asm volatile("s_waitcnt lgkmcnt(0)" ::: "memory");
    }
}

typedef _Float16 f16_t;
__device__ __forceinline__ u32x4 zero4() { unsigned z = 0u; asm volatile("" : "+v"(z)); return (u32x4){z, z, z, z}; }
__device__ __forceinline__ int lanes_below(unsigned long long m) { return (int)__builtin_amdgcn_mbcnt_hi((unsigned)(m >> 32), __builtin_amdgcn_mbcnt_lo((unsigned)m, 0u)); }
__device__ __forceinline__ float relu1(float x) { return __builtin_amdgcn_fmed3f(x, 0.f, __builtin_inff()); }
__device__ __forceinline__ unsigned sortable_f16(float sc) {
    const f16_t h = (f16_t)sc; const unsigned u = (unsigned)__builtin_bit_cast(unsigned short, h), mag = u & 0x7fffu;
    return (u & 0x8000u) ? (0x8000u - mag) : (0x8000u + mag);
}
__device__ __forceinline__ int sc_pos(int k) { return k; }
__device__ __forceinline__ int wave_incl_scan(int x) {
    x += __builtin_amdgcn_update_dpp(0, x, 0x111, 0xf, 0xf, true);
    x += __builtin_amdgcn_update_dpp(0, x, 0x112, 0xf, 0xf, true);
    x += __builtin_amdgcn_update_dpp(0, x, 0x114, 0xf, 0xf, true);
    x += __builtin_amdgcn_update_dpp(0, x, 0x118, 0xf, 0xf, true);
    x += __builtin_amdgcn_update_dpp(0, x, 0x142, 0xa, 0xf, false);
    x += __builtin_amdgcn_update_dpp(0, x, 0x143, 0xc, 0xf, false);
    return x;
}
__device__ __forceinline__ int wave_suffix_sum(int v, int lane) { const int p = wave_incl_scan(v); return __builtin_amdgcn_readlane(p, 63) - p + v; }
__device__ __forceinline__ void hist_threshold(const u32x4 c, int need, int lane, int& B, int& above) {
    const int s = (int)(c.x + c.y + c.z + c.w);
    const int S = wave_suffix_sum(s, lane);
    int a = S - s;
    const bool found = (a < need) && (S >= need);
    int Bl = 0, al = 0;
    if (found) {
        if (a + (int)c.w >= need) { Bl = 4 * lane + 3; al = a; }
        else { a += (int)c.w; if (a + (int)c.z >= need) { Bl = 4 * lane + 2; al = a; }
        else { a += (int)c.z; if (a + (int)c.y >= need) { Bl = 4 * lane + 1; al = a; }
        else { a += (int)c.y; Bl = 4 * lane; al = a; } } }
    }
    const unsigned long long m = __ballot(found);
    const int src = m ? (int)__builtin_ctzll(m) : 0;
    B = __builtin_amdgcn_readlane(Bl, src); above = __builtin_amdgcn_readlane(al, src);
}

#ifndef DSA_CAND
#define DSA_CAND 0
#endif
#ifndef DSA_DUP
#define DSA_DUP 0
#endif
constexpr int DSA_ROW = 16384;
__device__ __forceinline__ void phase_dsa(Frame& F) {
#ifdef NO_PHASE_DSA
    return;
#endif
    const int wave = F.wave;
    const bf16_t* ZSp = F.ZS(); const float* IWp = F.IW(); const bf16_t* IKp = F.IKD();
    LAS unsigned char* SCb = F.lds;
    for (int it = F.bid; it < 512; it += F.G) {
        int lane = F.lane; asm volatile("" : "+v"(lane));
        const int hi = lane >> 5, n32 = lane & 31;
        LAS unsigned short* LSTw = (LAS unsigned short*)(F.lds + 131072) + wave * 256;
        LAS unsigned char* WB = F.lds + 135168 + wave * 3520;
        LAS unsigned* H1 = (LAS unsigned*)WB; LAS unsigned* H2 = H1 + 256;
        LAS unsigned* DUM = (LAS unsigned*)(WB + 3264) + lane;
        LAS unsigned short* CK = (LAS unsigned short*)(WB + 1024); LAS unsigned short* CI = (LAS unsigned short*)(WB + 2144);
        const char* ZSu; { const unsigned long long zp = (unsigned long long)ZSp; const unsigned zl = __builtin_amdgcn_readfirstlane((unsigned)zp), zh = __builtin_amdgcn_readfirstlane((unsigned)(zp >> 32));
            ZSu = (const char*)(((unsigned long long)zh << 32) | zl); }
        LAS unsigned* OFFw = (LAS unsigned*)(WB + 2048);
        const int pr = it & 255, vcu = (pr & 7) * 32 + (pr >> 3);
        const int b = vcu >> 6, cc = vcu & 63, c = (it < 256) ? cc : 127 - cc;
        const int V = (c + 1) * 64, tokq0 = b * SEQ + c * 64, kb0 = b * SEQ;
        const int Keff = V < 256 ? V : 256;
        const int nblk = (V + 511) >> 9, ntile_all = nblk * 16, ntile_real = V >> 5;
        for (int qg = 0; qg < 8; ++qg) {
            const int tq0 = tokq0 + qg * 8;
#ifndef DSA_NO_A
            for (int repA = 0; repA < 1 + (DSA_DUP & 1); ++repA) {
                bf16x8 aq[2];
                { const int qq = n32 >> 2, hd = n32 & 3; const bf16_t* qp = ZSp + (size_t)(tq0 + qq) * ZSW + ZIQ + hd * 32 + 8 * hi;
                  aq[0] = *(const bf16x8*)qp; aq[1] = *(const bf16x8*)(qp + 16); }
                float wq[4][4];
#pragma unroll
                for (int jq = 0; jq < 4; ++jq) { const f32x4 w4 = *(const f32x4*)(IWp + (size_t)(tq0 + 2 * jq + hi) * 4);
                    wq[jq][0] = w4.x * 0.08838834764831845f; wq[jq][1] = w4.y * 0.08838834764831845f; wq[jq][2] = w4.z * 0.08838834764831845f; wq[jq][3] = w4.w * 0.08838834764831845f; }
                bf16x8 fr[2][4][2];
                const int nb = (ntile_all - wave + 31) >> 5;
#define DSA_ALOAD(buf, bt) do { int zz = 0; asm volatile("" : "+v"(zz)); _Pragma("unroll") for (int u = 0; u < 4; ++u) { const int tt = wave + 8 * (4 * (bt) + u); \
        if (tt < ntile_real) { const bf16_t* kp = IKp + ((size_t)(((kb0 >> 5) + tt) * 4 + hi) * 32 + n32 + zz) * 8; fr[buf][u][0] = *(const bf16x8*)kp; fr[buf][u][1] = *(const bf16x8*)(kp + 512); } } } while (0)
#define DSA_ACOMP(buf, bt) do { _Pragma("unroll") for (int u = 0; u < 4; ++u) { const int tt = wave + 8 * (4 * (bt) + u); \
        if (tt < ntile_all) { unsigned short us[4] = {0, 0, 0, 0}; \
            if (tt < ntile_real) { f32x16 acc = {0.f, 0.f, 0.f, 0.f, 0.f, 0.f, 0.f, 0.f, 0.f, 0.f, 0.f, 0.f, 0.f, 0.f, 0.f, 0.f}; \
                acc = __builtin_amdgcn_mfma_f32_32x32x16_bf16(aq[0], fr[buf][u][0], acc, 0, 0, 0); acc = __builtin_amdgcn_mfma_f32_32x32x16_bf16(aq[1], fr[buf][u][1], acc, 0, 0, 0); \
                _Pragma("unroll") for (int jq = 0; jq < 4; ++jq) { \
                    const float sc = relu1(acc[4 * jq + 0]) * wq[jq][0] + relu1(acc[4 * jq + 1]) * wq[jq][1] + relu1(acc[4 * jq + 2]) * wq[jq][2] + relu1(acc[4 * jq + 3]) * wq[jq][3]; \
                    us[jq] = (unsigned short)sortable_f16(sc); } } \
            const int pos = sc_pos(tt * 32 + n32); \
            _Pragma("unroll") for (int jq = 0; jq < 4; ++jq) *(LAS unsigned short*)(SCb + (2 * jq + hi) * DSA_ROW + pos * 2) = us[jq]; } } } while (0)
                DSA_ALOAD(0, 0);
                for (int bp = 0; bp < nb; bp += 2) {
                    if (bp + 1 < nb) DSA_ALOAD(1, bp + 1);
                    DSA_ACOMP(0, bp);
                    if (bp + 2 < nb) DSA_ALOAD(0, bp + 2);
                    if (bp + 1 < nb) DSA_ACOMP(1, bp + 1);
                }
#undef DSA_ALOAD
#undef DSA_ACOMP
            }
#endif
            __syncthreads();
            LAS unsigned char* row = SCb + wave * DSA_ROW;
#ifndef DSA_NO_B
            for (int repB = 0; repB < 1 + ((DSA_DUP >> 1) & 1); ++repB)
            if (V > 256) {
                *(LAS u32x4*)(H1 + 4 * lane) = zero4(); *(LAS u32x4*)(H2 + 4 * lane) = zero4();
                u32x4 rw[4];
#define DSA_LD8(hf) do { _Pragma("unroll") for (int i = 0; i < 4; ++i) if (4 * (hf) + i < nblk) rw[i] = *(const LAS u32x4*)(row + (512 * (4 * (hf) + i) + 8 * lane) * 2); \
        asm volatile("s_waitcnt lgkmcnt(0)" ::: "memory"); } while (0)
#define DSA_W(i, e2) ((e2) == 0 ? rw[i].x : (e2) == 1 ? rw[i].y : (e2) == 2 ? rw[i].z : rw[i].w)
                asm volatile("s_waitcnt lgkmcnt(0)" ::: "memory");
#pragma unroll 1
                for (int hf = 0; 4 * hf < nblk; ++hf) {
                    DSA_LD8(hf);
#pragma unroll
                    for (int i = 0; i < 4; ++i) if (4 * hf + i < nblk) __hip_atomic_fetch_add(H2 + ((rw[i].x >> 8) & 255u), 1u, __ATOMIC_RELAXED, __HIP_MEMORY_SCOPE_WORKGROUP);
                }
                asm volatile("s_waitcnt lgkmcnt(0)" ::: "memory");
                int Bc, abovec; hist_threshold(*(const LAS u32x4*)(H2 + 4 * lane), 40, lane, Bc, abovec);
                { const u32x4 hs = *(const LAS u32x4*)(H2 + 4 * lane); const int tot = wave_suffix_sum((int)(hs.x + hs.y + hs.z + hs.w), lane); if (__builtin_amdgcn_readlane(tot, 0) < 40) Bc = 0; }
                *(LAS u32x4*)(H2 + 4 * lane) = zero4();
                bool done = false;
                if (DSA_CAND && Bc > 0) {
                    const unsigned thr = (unsigned)Bc << 8;
                    int cnt = 0;
#pragma unroll 1
                    for (int hf = 0; 4 * hf < nblk; ++hf) {
                        DSA_LD8(hf);
#pragma unroll
                        for (int i = 0; i < 4; ++i) if (4 * hf + i < nblk) {
#pragma unroll
                            for (int e = 0; e < 8; ++e) { const unsigned w = DSA_W(i, e >> 1); const unsigned u = (e & 1) ? (w >> 16) : (w & 0xffffu); cnt += (u >= thr) ? 1 : 0; }
                        }
                    }
                    int pos = wave_incl_scan(cnt);
                    const int ncand = __builtin_amdgcn_readlane(pos, 63); pos -= cnt;
                    if (ncand >= 256 && ncand <= 560) {
                        LAS unsigned short* ldum = (LAS unsigned short*)DUM;
#pragma unroll 1
                        for (int hf = 0; 4 * hf < nblk; ++hf) {
                            DSA_LD8(hf);
#pragma unroll
                            for (int i = 0; i < 4; ++i) if (4 * hf + i < nblk) {
#pragma unroll
                                for (int e = 0; e < 8; ++e) { const unsigned w = DSA_W(i, e >> 1); const unsigned u = (e & 1) ? (w >> 16) : (w & 0xffffu);
                                    const bool sel = u >= thr; LAS unsigned short* pk = sel ? CK + pos : ldum; LAS unsigned short* pi = sel ? CI + pos : ldum;
                                    *pk = (unsigned short)u; *pi = (unsigned short)(512 * (4 * hf + i) + 8 * lane + e); pos += sel ? 1 : 0; }
                            }
                        }
                        *(LAS u32x4*)(H1 + 4 * lane) = zero4();
                        asm volatile("s_waitcnt lgkmcnt(0)" ::: "memory");
                        unsigned cu[9];
#pragma unroll
                        for (int j = 0; j < 9; ++j) { const int p = j * 64 + lane; const bool v = p < ncand; cu[j] = v ? (unsigned)CK[v ? p : 0] : 0u; }
                        asm volatile("s_waitcnt lgkmcnt(0)" ::: "memory");
#pragma unroll
                        for (int j = 0; j < 9; ++j) if (j * 64 + lane < ncand) __hip_atomic_fetch_add(H1 + (cu[j] >> 8), 1u, __ATOMIC_RELAXED, __HIP_MEMORY_SCOPE_WORKGROUP);
                        asm volatile("s_waitcnt lgkmcnt(0)" ::: "memory");
                        int B1c, above1c; hist_threshold(*(const LAS u32x4*)(H1 + 4 * lane), 256, lane, B1c, above1c);
                        *(LAS u32x4*)(H1 + 4 * lane) = zero4();
                        asm volatile("s_waitcnt lgkmcnt(0)" ::: "memory");
#pragma unroll
                        for (int j = 0; j < 9; ++j) if (j * 64 + lane < ncand && (int)(cu[j] >> 8) == B1c) __hip_atomic_fetch_add(H1 + (cu[j] & 255u), 1u, __ATOMIC_RELAXED, __HIP_MEMORY_SCOPE_WORKGROUP);
                        asm volatile("s_waitcnt lgkmcnt(0)" ::: "memory");
                        int B2c, above2c; hist_threshold(*(const LAS u32x4*)(H1 + 4 * lane), 256 - above1c, lane, B2c, above2c);
                        const unsigned tauc = ((unsigned)B1c << 8) | (unsigned)B2c;
                        if ((int)H1[B2c] == 256 - above1c - above2c) {
                            int c2 = 0;
#pragma unroll
                            for (int j = 0; j < 9; ++j) c2 += (j * 64 + lane < ncand && cu[j] >= tauc) ? 1 : 0;
                            int p2 = wave_incl_scan(c2) - c2;
#pragma unroll
                            for (int j = 0; j < 9; ++j) { const bool sel = (j * 64 + lane < ncand) && cu[j] >= tauc; LAS unsigned short* pl = sel ? LSTw + p2 : ldum; *pl = CI[sel ? j * 64 + lane : 0]; p2 += sel ? 1 : 0; }
                            done = true;
                        }
                        *(LAS u32x4*)(H1 + 4 * lane) = zero4(); *(LAS u32x4*)(H2 + 4 * lane) = zero4();
                        asm volatile("s_waitcnt lgkmcnt(0)" ::: "memory");
                    }
                }
                if (!done) {
                int lo_bin = Bc, hi_bin = 256;
                for (;;) {
#pragma unroll 1
                    for (int hf = 0; 4 * hf < nblk; ++hf) {
                        DSA_LD8(hf);
#pragma unroll
                        for (int i = 0; i < 4; ++i) if (4 * hf + i < nblk) {
#pragma unroll
                            for (int e2 = 0; e2 < 4; ++e2) { const unsigned w = DSA_W(i, e2); const int b0 = (int)((w >> 8) & 255u), b1 = (int)(w >> 24);
                                LAS unsigned* p0 = ((unsigned)(b0 - lo_bin) < (unsigned)(hi_bin - lo_bin)) ? H1 + b0 : DUM; LAS unsigned* p1 = ((unsigned)(b1 - lo_bin) < (unsigned)(hi_bin - lo_bin)) ? H1 + b1 : DUM;
                                __hip_atomic_fetch_add(p0, 1u, __ATOMIC_RELAXED, __HIP_MEMORY_SCOPE_WORKGROUP); __hip_atomic_fetch_add(p1, 1u, __ATOMIC_RELAXED, __HIP_MEMORY_SCOPE_WORKGROUP); }
                        }
                    }
                    asm volatile("s_waitcnt lgkmcnt(0)" ::: "memory");
                    if (lo_bin == 0) break;
                    const u32x4 h4 = *(const LAS u32x4*)(H1 + 4 * lane); const int tot = __builtin_amdgcn_readlane(wave_suffix_sum((int)(h4.x + h4.y + h4.z + h4.w), lane), 0);
                    if (tot >= 256) break;
                    hi_bin = lo_bin; lo_bin = 0;
                }
                asm volatile("s_waitcnt lgkmcnt(0)" ::: "memory");
                int B1, above1; hist_threshold(*(const LAS u32x4*)(H1 + 4 * lane), 256, lane, B1, above1);
#pragma unroll 1
                for (int hf = 0; 4 * hf < nblk; ++hf) {
                    DSA_LD8(hf);
#pragma unroll
                    for (int i = 0; i < 4; ++i) if (4 * hf + i < nblk) {
#pragma unroll
                        for (int e2 = 0; e2 < 4; ++e2) { const unsigned w = DSA_W(i, e2);
                            LAS unsigned* p0 = ((int)((w >> 8) & 255u) == B1) ? H2 + (w & 255u) : DUM; LAS unsigned* p1 = ((int)(w >> 24) == B1) ? H2 + ((w >> 16) & 255u) : DUM;
                            __hip_atomic_fetch_add(p0, 1u, __ATOMIC_RELAXED, __HIP_MEMORY_SCOPE_WORKGROUP); __hip_atomic_fetch_add(p1, 1u, __ATOMIC_RELAXED, __HIP_MEMORY_SCOPE_WORKGROUP); }
                    }
                }
                asm volatile("s_waitcnt lgkmcnt(0)" ::: "memory");
                int B2, above2; hist_threshold(*(const LAS u32x4*)(H2 + 4 * lane), 256 - above1, lane, B2, above2);
                const unsigned tau = ((unsigned)B1 << 8) | (unsigned)B2;
                const int r = 256 - above1 - above2;
                const int neq = (int)H2[B2];
                if (neq == r) {
                    int cnt = 0;
#pragma unroll 1
                    for (int hf = 0; 4 * hf < nblk; ++hf) {
                        DSA_LD8(hf);
#pragma unroll
                        for (int i = 0; i < 4; ++i) if (4 * hf + i < nblk) {
#pragma unroll
                            for (int e = 0; e < 8; ++e) { const unsigned w = DSA_W(i, e >> 1); const unsigned u = (e & 1) ? (w >> 16) : (w & 0xffffu); cnt += (u >= tau) ? 1 : 0; }
                        }
                    }
                    int pos = wave_incl_scan(cnt) - cnt;
                    LAS unsigned short* ldum = (LAS unsigned short*)DUM;
#pragma unroll 1
                    for (int hf = 0; 4 * hf < nblk; ++hf) {
                        DSA_LD8(hf);
#pragma unroll
                        for (int i = 0; i < 4; ++i) if (4 * hf + i < nblk) {
#pragma unroll
                            for (int e = 0; e < 8; ++e) { const unsigned w = DSA_W(i, e >> 1); const unsigned u = (e & 1) ? (w >> 16) : (w & 0xffffu);
                                const bool sel = u >= tau; LAS unsigned short* p = sel ? LSTw + pos : ldum;
                                *p = (unsigned short)(512 * (4 * hf + i) + 8 * lane + e); pos += sel ? 1 : 0; }
                        }
                    }
                } else {
                    int tot = 0, base_eq = 0;
#define DSA_TK(i) int cgt = 0, ceq = 0; _Pragma("unroll") for (int e = 0; e < 8; ++e) { const unsigned w = DSA_W(i, e >> 1); const unsigned u = (e & 1) ? (w >> 16) : (w & 0xffffu); cgt += (u > tau) ? 1 : 0; ceq += (u == tau) ? 1 : 0; } \
        int tk = 0; if (__ballot(ceq != 0)) { const int inc = wave_incl_scan(ceq); int t = r - base_eq - (inc - ceq); t = t < 0 ? 0 : t; tk = t > ceq ? ceq : t; base_eq += __builtin_amdgcn_readlane(inc, 63); }
#pragma unroll 1
                    for (int hf = 0; 4 * hf < nblk; ++hf) {
                        DSA_LD8(hf);
#pragma unroll
                        for (int i = 0; i < 4; ++i) if (4 * hf + i < nblk) { DSA_TK(i); tot += cgt + tk; }
                    }
                    int pos = wave_incl_scan(tot) - tot;
                    LAS unsigned short* ldum = (LAS unsigned short*)DUM;
                    base_eq = 0;
#pragma unroll 1
                    for (int hf = 0; 4 * hf < nblk; ++hf) {
                        DSA_LD8(hf);
#pragma unroll
                        for (int i = 0; i < 4; ++i) if (4 * hf + i < nblk) {
                            DSA_TK(i);
                            int seen = 0;
#pragma unroll
                            for (int e = 0; e < 8; ++e) { const unsigned w = DSA_W(i, e >> 1); const unsigned u = (e & 1) ? (w >> 16) : (w & 0xffffu);
                                const bool eq = (u == tau); const bool sel = (u > tau) || (eq && seen < tk); seen += eq ? 1 : 0;
                                LAS unsigned short* p = sel ? LSTw + pos : ldum;
                                *p = (unsigned short)(512 * (4 * hf + i) + 8 * lane + e); pos += sel ? 1 : 0; }
                        }
                    }
#undef DSA_TK
                }
                }
#undef DSA_W
#undef DSA_LD8
            } else {
#pragma unroll
                for (int jj = 0; jj < 4; ++jj) LSTw[lane + 64 * jj] = (unsigned short)(lane + 64 * jj);
            }
#endif
            asm volatile("s_waitcnt lgkmcnt(0)" ::: "memory");
            for (int repC = 0; repC < 1 + ((DSA_DUP >> 2) & 1); ++repC) {
                int lc = lane; asm volatile("" : "+v"(lc));
                const int tq = tq0 + wave, n16 = lc & 15, kg = lc >> 4;
#pragma unroll
                for (int jj = 0; jj < 4; ++jj) OFFw[lc + 64 * jj] = (unsigned)(kb0 + (int)LSTw[lc + 64 * jj]) * (unsigned)(ZSW * 2);
                asm volatile("s_waitcnt lgkmcnt(0)" ::: "memory");
                const unsigned vcol = (unsigned)((ZDV + ((lc & 7) ^ (2 * ((lc >> 4) & 3))) * 8) * 2), kcol = (unsigned)((ZDK + 8 * kg) * 2);
                bf16x8 qf[2];
                if (n16 < 6) { const bf16_t* qp = ZSp + (size_t)tq * ZSW + ZDQ + n16 * 64 + 8 * kg; qf[0] = *(const bf16x8*)qp; qf[1] = *(const bf16x8*)(qp + 32); }
                else { qf[0] = (bf16x8){0, 0, 0, 0, 0, 0, 0, 0}; qf[1] = qf[0]; }
                const int ntile = Keff >> 4;
                LAS unsigned char* vst = row;
#define DSA_VDMA(ch, buf) do { unsigned vo[8]; _Pragma("unroll") for (int i8 = 0; i8 < 8; ++i8) vo[i8] = OFFw[(ch) * 64 + (lc >> 3) + 8 * i8] + vcol; \
        _Pragma("unroll") for (int i8 = 0; i8 < 8; ++i8) { const unsigned lb = (unsigned)(size_t)(vst + (buf) * 8192 + i8 * 1024); \
        asm volatile("s_mov_b32 m0, %2\n\ts_nop 0\n\tglobal_load_lds_dwordx4 %0, %1" :: "v"(vo[i8]), "s"(ZSu), "s"(__builtin_amdgcn_readfirstlane(lb)) : "memory", "m0"); } } while (0)
                DSA_VDMA(0, 0);
                if (ntile > 4) DSA_VDMA(1, 1);
                f32x4 sa[8];
                bf16x8 kf[2][4][2];
#define DSA_KLOAD(buf, tb) do { _Pragma("unroll") for (int t4 = 0; t4 < 4; ++t4) if (4 * (tb) + t4 < ntile) { const unsigned ko = OFFw[(4 * (tb) + t4) * 16 + n16] + kcol; \
        const bf16_t* kp = (const bf16_t*)(ZSu + ko); kf[buf][t4][0] = *(const bf16x8*)kp; kf[buf][t4][1] = *(const bf16x8*)(kp + 32); } } while (0)
#define DSA_KMMA(buf, tb) do { _Pragma("unroll") for (int t4 = 0; t4 < 4; ++t4) { \
        if (4 * (tb) + t4 < ntile) { f32x4 a = {0.f, 0.f, 0.f, 0.f}; \
            a = __builtin_amdgcn_mfma_f32_16x16x32_bf16(kf[buf][t4][0], qf[0], a, 0, 0, 0); a = __builtin_amdgcn_mfma_f32_16x16x32_bf16(kf[buf][t4][1], qf[1], a, 0, 0, 0); sa[4 * ((tb) & 1) + t4] = a; } \
        else sa[4 * ((tb) & 1) + t4] = (f32x4){-1e30f, -1e30f, -1e30f, -1e30f}; } } while (0)
#define DSA_PV(ch) do { _Pragma("unroll") for (int sl = 0; sl < 2; ++sl) { const int s = ((ch) & 1) * 2 + sl; \
        u32x4 pw; pw.x = pk2(sa[2 * s].x, sa[2 * s].y); pw.y = pk2(sa[2 * s].z, sa[2 * s].w); pw.z = pk2(sa[2 * s + 1].x, sa[2 * s + 1].y); pw.w = pk2(sa[2 * s + 1].z, sa[2 * s + 1].w); \
        const bf16x8 pb = __builtin_bit_cast(bf16x8, pw); \
        _Pragma("unroll") for (int mt = 0; mt < 4; ++mt) { \
            const int P0 = 32 * sl + 4 * kg + q4, P1 = P0 + 16; \
            const LAS unsigned char* a0 = vst + ((ch) & 1) * 8192 + P0 * 128 + (((2 * mt + (p4 >> 1)) ^ (2 * ((P0 >> 1) & 3))) * 16) + 8 * (p4 & 1); \
            const LAS unsigned char* a1 = vst + ((ch) & 1) * 8192 + P1 * 128 + (((2 * mt + (p4 >> 1)) ^ (2 * ((P1 >> 1) & 3))) * 16) + 8 * (p4 & 1); \
            const s16x4 lo = __builtin_bit_cast(s16x4, __builtin_amdgcn_ds_read_tr16_b64_v4i16((LAS s16x4*)a0)); \
            const s16x4 hi4 = __builtin_bit_cast(s16x4, __builtin_amdgcn_ds_read_tr16_b64_v4i16((LAS s16x4*)a1)); \
            const bf16x8 va = (bf16x8){lo[0], lo[1], lo[2], lo[3], hi4[0], hi4[1], hi4[2], hi4[3]}; \
            oacc[mt] = __builtin_amdgcn_mfma_f32_16x16x32_bf16(va, pb, oacc[mt], 0, 0, 0); } } \
        asm volatile("s_waitcnt lgkmcnt(0)" ::: "memory"); } while (0)
                DSA_KLOAD(0, 0); DSA_KLOAD(1, 1);
                asm volatile("s_waitcnt vmcnt(0)" ::: "memory");
                DSA_KMMA(0, 0); DSA_KLOAD(0, 2);
                DSA_KMMA(1, 1); DSA_KLOAD(1, 3);
                const float sc2 = 0.125f * 1.4426950408889634f;
                const int q4 = n16 >> 2, p4 = n16 & 3;
                f32x4 oacc[4] = {{0.f, 0.f, 0.f, 0.f}, {0.f, 0.f, 0.f, 0.f}, {0.f, 0.f, 0.f, 0.f}, {0.f, 0.f, 0.f, 0.f}};
                float m = -1e30f;
#pragma unroll
                for (int t = 0; t < 8; ++t) m = fmaxf(m, fmaxf(fmaxf(sa[t].x, sa[t].y), fmaxf(sa[t].z, sa[t].w)));
                m = fmaxf(m, __shfl_xor(m, 16)); m = fmaxf(m, __shfl_xor(m, 32));
                float lsum = 0.f;
#pragma unroll
                for (int t = 0; t < 8; ++t) { sa[t].x = __builtin_amdgcn_exp2f((sa[t].x - m) * sc2); sa[t].y = __builtin_amdgcn_exp2f((sa[t].y - m) * sc2); sa[t].z = __builtin_amdgcn_exp2f((sa[t].z - m) * sc2); sa[t].w = __builtin_amdgcn_exp2f((sa[t].w - m) * sc2);
                    lsum += (sa[t].x + sa[t].y) + (sa[t].z + sa[t].w); }
                DSA_PV(0);
                if (ntile > 8) DSA_VDMA(2, 0);
                if (ntile > 4) DSA_PV(1);
                if (ntile > 12) DSA_VDMA(3, 1);
                if (ntile > 8) {
                    DSA_KMMA(0, 2);
                    DSA_KMMA(1, 3);
                    float m1 = -1e30f;
#pragma unroll
                    for (int t = 0; t < 8; ++t) m1 = fmaxf(m1, fmaxf(fmaxf(sa[t].x, sa[t].y), fmaxf(sa[t].z, sa[t].w)));
                    m1 = fmaxf(m1, __shfl_xor(m1, 16)); m1 = fmaxf(m1, __shfl_xor(m1, 32));
                    const float mn = fmaxf(m, m1), alpha = __builtin_amdgcn_exp2f((m - mn) * sc2);
#pragma unroll
                    for (int mt = 0; mt < 4; ++mt) { oacc[mt].x *= alpha; oacc[mt].y *= alpha; oacc[mt].z *= alpha; oacc[mt].w *= alpha; }
                    lsum *= alpha;
#pragma unroll
                    for (int t = 0; t < 8; ++t) { sa[t].x = __builtin_amdgcn_exp2f((sa[t].x - mn) * sc2); sa[t].y = __builtin_amdgcn_exp2f((sa[t].y - mn) * sc2); sa[t].z = __builtin_amdgcn_exp2f((sa[t].z - mn) * sc2); sa[t].w = __builtin_amdgcn_exp2f((sa[t].w - mn) * sc2);
                        lsum += (sa[t].x + sa[t].y) + (sa[t].z + sa[t].w); }
                    if (ntile > 12) asm volatile("s_waitcnt vmcnt(8)" ::: "memory");
                    else asm volatile("s_waitcnt vmcnt(0)" ::: "memory");
                    DSA_PV(2);
                    if (ntile > 12) { asm volatile("s_waitcnt vmcnt(0)" ::: "memory"); DSA_PV(3); }
                }
                lsum += __shfl_xor(lsum, 16); lsum += __shfl_xor(lsum, 32);
                const float linv = __builtin_amdgcn_rcpf(lsum);
#undef DSA_KLOAD
#undef DSA_KMMA
#undef DSA_PV
#undef DSA_VDMA
                if (n16 < 6) {
                    bf16_t* op = F.H() + (size_t)tq * DM + 256 + n16 * 64 + 4 * kg;
#pragma unroll
                    for (int mt = 0; mt < 4; ++mt) { u32x2 o; o.x = pk2(oacc[mt].x * linv, oacc[mt].y * linv); o.y = pk2(oacc[mt].z * linv, oacc[mt].w * linv); *(u32x2*)(op + 16 * mt) = o; }
                }
            }
            __syncthreads();
        }
    }
}

__global__ void __launch_bounds__(NTHREADS, 2) mk_fwd(Args args) {
    extern __shared__ __attribute__((aligned(16))) unsigned char lds_raw[];
    Frame F;
    F.lds = (LAS unsigned char*)lds_raw;
    F.tid = threadIdx.x; F.lane = F.tid & 63; F.wave = __builtin_amdgcn_readfirstlane(F.tid >> 6);
    F.G = gridDim.x; F.bid = blockIdx.x; F.wsb = args.ws; F.zo = 0u; F.wl = 0u;
    unsigned char* ws = args.ws;
#define INF(k) ((const float*)args.in[k])

    volatile LAS unsigned* MISC = (volatile LAS unsigned*)(F.lds + MISC_OFF);
    if (F.tid < 64) MISC[F.tid] = 0u;
    __syncthreads();
    XcdBarrier bar = xcd_barrier_post((unsigned*)(ws + WS_CTL) + CW_BAR, MISC + 8);
    int ph = 0; const int lo = args.ph_lo, hi = args.ph_hi;
    unsigned long long* TSp = (unsigned long long*)(ws + WS_CTL + 32768); int nst = 0; (void)TSp; (void)nst;
    bool first_seam = true;
#ifndef DUP_MASK
#define DUP_MASK 0
#endif
#ifdef PROBE_LO
#define STAMP() do { if (F.bid == 0 && F.tid == 0) { TSp[nst] = __builtin_amdgcn_s_memrealtime(); } ++nst; } while (0)
#else
#define STAMP() do { } while (0)
#endif
#define GRIDSYNC() xcd_barrier(bar, F.wave == 0 && F.lane == 0)
#define RUN(...) do { if (ph >= lo && ph < hi) { asm volatile("" : "+s"(F.zo), "+s"(F.bid), "+s"(F.G), "+s"(F.wave)); F.lane = (int)__builtin_amdgcn_mbcnt_hi(~0u, __builtin_amdgcn_mbcnt_lo(~0u, F.zo)); asm volatile("" : "+v"(F.lane)); F.tid = F.wave * 64 + F.lane; __VA_ARGS__; } ++ph; } while (0)
#define SEAM() do { if (ph > lo && ph < hi) { if (first_seam) { GRIDSYNC(); first_seam = false; } else xcd_barrier(bar, F.wave == 0 && F.lane == 0); } STAMP(); } while (0)

    STAMP();
    RUN(phase_rope(F, (const int*)args.in[1])); STAMP();
    const ProIn PI{INF(0), INF(2), INF(3), INF(15), INF(16), INF(17), INF(18), INF(20), INF(21), INF(12), INF(4), INF(5), INF(6), INF(7), INF(8), (const int*)args.in[1]};
    RUN({ phase_prologue(F, PI); }); SEAM();
    for (int l = 0; l < DEPTH; ++l) {
        const float* xin = (l == 0) ? INF(0) : args.out;
        F.wl = l ? (unsigned)(WS_W1L - WS_W) : 0u;
        RUN({ pg8::Gemm g{F.H(), F.Win_t()}; pg8::StaticOrder<T, NINP> S; S.init(F.G, F.bid);
              pg8::EpiGen<FInProj> E{FInProj{F.ZS(), F.GB(), F.IW(), F.ROPE(), F.IKD()}}; pg8::gemm_phase<T, NINP, DM, DM, DM>(F.lds, g, S, E, F.tid);
              if (l == 0 && F.G == 256 && F.bid >= 128) { F.wl = (unsigned)(WS_W1L - WS_W); prologue_weights(F, PI, 1, (F.bid - 128) * NWAVES + F.wave, 128 * NWAVES); F.wl = 0u; } }); SEAM();
        RUN({ phase_s5_local(F, l); __syncthreads(); phase_ret_local(F);
              asm volatile("s_waitcnt vmcnt(0)" ::: "memory"); __syncthreads();
              if (F.tid == 0) { unsigned* lc = (unsigned*)(F.wsb + F.zo + WS_CTL) + CW_LOCAL + 64 * l; __builtin_amdgcn_fence(__ATOMIC_RELEASE, "agent"); asm volatile("s_waitcnt vmcnt(0)" ::: "memory"); __hip_atomic_fetch_add(lc, 1u, __ATOMIC_RELAXED, __HIP_MEMORY_SCOPE_AGENT); }
              phase_dsa(F); __syncthreads();
              if (F.tid == 0) { unsigned* lc = (unsigned*)(F.wsb + F.zo + WS_CTL) + CW_LOCAL + 64 * l; unsigned sp = 0u;
                                while (__hip_atomic_load(lc, __ATOMIC_RELAXED, __HIP_MEMORY_SCOPE_AGENT) < (unsigned)F.G) { __builtin_amdgcn_s_sleep(2); if (++sp > (1u << 20)) break; }
                                __builtin_amdgcn_fence(__ATOMIC_ACQUIRE, "agent"); asm volatile("s_waitcnt vmcnt(0)" ::: "memory"); }
              __syncthreads();
              phase_carry(F, l); }); SEAM();
        RUN({ phase_s5_out_glu(F, l, INF(9), INF(10), INF(11), F.Wglu_t(), INF(13) + l * 256); __syncthreads(); phase_ret_out(F, l, INF(14)); __syncthreads(); }); SEAM();
        RUN({ pg8::Gemm g{F.H(), F.Wabc_t()}; pg8::StaticOrder<T, DM> S; S.init(F.G, F.bid);
              EpiMerge E{F.MG(), F.GB()}; pg8::gemm_phase<T, DM, DM, DM, DM>(F.lds, g, S, E, F.tid); }); SEAM();
        RUN({ pg8::Gemm g{F.MG(), F.Wout_t()}; pg8::StaticOrder<T, DM> S; S.init(F.G, F.bid);
              EpiResidNorm E{l == 0 ? xin : (const float*)nullptr, F.XR(), F.XR(), F.H(), nullptr, INF(19) + l * DM, F.XB(), F.PANEL(2 * l)}; pg8::gemm_phase<T, DM, DM, DM, DM>(F.lds, g, S, E, F.tid); }); SEAM();
        RUN({ pg8::Gemm g{F.H(), F.W1_t()}; pg8::StaticOrder<T, FF> S; S.init(F.G, F.bid);
              pg8::EpiGen<FRelu2> E{FRelu2{F.FB()}}; pg8::gemm_phase<T, FF, DM, DM, DM>(F.lds, g, S, E, F.tid); }); SEAM();
        RUN({ pg8::Gemm g{F.FB(), F.W2_t()}; pg8::StaticOrder<T, DM> S; S.init(F.G, F.bid);
              const bool lastl = (l + 1 == DEPTH);
              EpiResidNorm E{(const float*)nullptr, F.XR(), lastl ? (bf16_t*)nullptr : F.XR(), lastl ? (bf16_t*)nullptr : F.H(), lastl ? args.out : (float*)nullptr, lastl ? INF(22) : INF(2) + (l + 1) * DM, F.XB(), F.PANEL(2 * l + 1)};
              pg8::gemm_phase<T, DM, FF, FF, FF>(F.lds, g, S, E, F.tid); }); if (l + 1 < DEPTH) SEAM();
    }
    STAMP();
#ifdef PROBE_LO
    if (F.bid == 0 && F.tid == 0) {
        const int sel[] = PROBE_SEL; unsigned long long tot = 0;
        for (unsigned i = 0; i < sizeof(sel) / sizeof(int); ++i) tot += TSp[sel[i] + 1] - TSp[sel[i]];
        const float us = (float)tot * 0.01f;
        asm volatile("s_waitcnt vmcnt(0)" ::: "memory");
        args.out[0] = sqrtf(us * (float)((size_t)T * DM));
    }
#endif
#undef RUN
#undef SEAM
}

extern "C" void kernel_launch(void* const* d_in, const int* in_sizes, int n_in, void* d_out, int out_size, void* d_ws, size_t ws_size, hipStream_t stream) {
    static int grid = 0;
    if (grid == 0) {
        if (n_in != 23 || out_size != T * DM || ws_size < WS_END) { fprintf(stderr, "kernel_launch: unexpected shapes (n_in %d out %d ws %zu)\n", n_in, out_size, ws_size); grid = -1; return; }
        int dev = 0, cus = 0, per_cu = 0;
        hipGetDevice(&dev); hipDeviceGetAttribute(&cus, hipDeviceAttributeMultiprocessorCount, dev);
        if (hipFuncSetAttribute((const void*)mk_fwd, hipFuncAttributeMaxDynamicSharedMemorySize, LDS_BYTES) != hipSuccess) { fprintf(stderr, "kernel_launch: hipFuncSetAttribute failed\n"); grid = -1; return; }
        if (hipOccupancyMaxActiveBlocksPerMultiprocessor(&per_cu, (const void*)mk_fwd, NTHREADS, LDS_BYTES) != hipSuccess || per_cu < 1) { fprintf(stderr, "kernel_launch: occupancy query says %d\n", per_cu); per_cu = 1; }
        (void)hipGetLastError();
        grid = cus;
        if (cus != 256) fprintf(stderr, "kernel_launch: built for a 256-CU device (got %d CUs): the fused-norm row-statistics exchange needs a panel's four column tiles in one round\n", cus);
    }
    if (grid < 0) return;
    hipMemsetAsync((char*)d_ws + WS_CTL, 0, CTL_ZERO_BYTES, stream);
    Args a{};
    for (int i = 0; i < 23; ++i) a.in[i] = d_in[i];
    a.out = (float*)d_out; a.ws = (unsigned char*)d_ws;
#ifndef MK_SPLIT
    a.ph_lo = 0; a.ph_hi = 1000;
    void* kargs[] = {&a};
    hipError_t e = hipLaunchCooperativeKernel((const void*)mk_fwd, dim3(grid), dim3(NTHREADS), kargs, LDS_BYTES, stream);
    if (e != hipSuccess) fprintf(stderr, "kernel_launch: cooperative launch failed: %s\n", hipGetErrorString(e));
#else
    for (int p = 0; p < 2 * 9 + 2; ++p) { a.ph_lo = p; a.ph_hi = p + 1; hipLaunchKernelGGL(mk_fwd, dim3(grid), dim3(NTHREADS), LDS_BYTES, stream, a); }
#endif
}
```

```cpp
#include <hip/hip_runtime.h>
#include <cstdio>
#include <cstdint>

#define LAS __attribute__((address_space(3)))
#define GAS __attribute__((address_space(1)))
typedef unsigned short bf16_t;
typedef short bf16x8 __attribute__((ext_vector_type(8)));
typedef float f32x4 __attribute__((ext_vector_type(4)));
typedef float f32x2 __attribute__((ext_vector_type(2)));
typedef unsigned u32x4 __attribute__((ext_vector_type(4)));
typedef unsigned u32x2 __attribute__((ext_vector_type(2)));

constexpr int NB = 4, SEQ = 8192, T = NB * SEQ, DM = 1024, DEPTH = 2, FF = 4096;
constexpr int NIN = 5156, NINP = 5376;
constexpr int ZSW = 2112, GW = 3072;
constexpr int ZU = 0, ZDQ = 256, ZDK = 640, ZDV = 704, ZIQ = 768, ZIK = 896, ZIWC = 928, ZRQ = 960, ZRK = 1152, ZRV = 1344, ZRG = 1728, ZGATE = 2112, ZEND = 5184;
constexpr int NFREQ = 36;
constexpr float EPS = 1e-6f;

constexpr size_t MiB = 1u << 20;
constexpr size_t WS_CTL = 0, CTL_ZERO_BYTES = 512 * 1024;
constexpr size_t WS_IW = 1 * MiB;
constexpr size_t WS_SP = 1 * MiB + 512 * 1024;
constexpr size_t WS_ROPE = 2 * MiB;
constexpr size_t WS_S5E = 11 * MiB;
constexpr size_t WS_RST = 15 * MiB;
constexpr size_t WS_W = 51 * MiB;
constexpr size_t WO_IN = 0, WO_ABC = WO_IN + (size_t)NINP * DM * 2, WO_OUT = WO_ABC + (size_t)DM * DM * 2, WO_W1 = WO_OUT + (size_t)DM * DM * 2,
                 WO_W2 = WO_W1 + (size_t)FF * DM * 2, WO_GLU = WO_W2 + (size_t)FF * DM * 2, WO_END = WO_GLU + 256 * 256 * 2;
static_assert(WO_END <= 31 * MiB, "weights");
constexpr size_t WS_H = 82 * MiB;
constexpr size_t WS_ZS = 146 * MiB;
constexpr size_t WS_G = 278 * MiB;
constexpr size_t WS_XR = 404 * MiB;
constexpr size_t WS_IKD = 470 * MiB;
constexpr size_t WS_XB = 472 * MiB;
constexpr size_t WS_W1L = 474 * MiB;
constexpr size_t WS_END = 505 * MiB;
static_assert(WS_ZS + (size_t)T * FF * 2 <= WS_XR && WS_XR + (size_t)T * DM * 2 <= WS_IKD, "ws map (residual)");
static_assert(WS_ZS + (size_t)T * ZSW * 2 <= WS_G && WS_G + (size_t)T * GW * 2 <= WS_END && WS_ZS + (size_t)T * FF * 2 <= WS_END, "ws map");
constexpr int CW_BAR = 1024, CW_LOCAL = 8192, CW_PANEL = 32768;

constexpr int LDS_BYTES = 160 * 1024;
constexpr int RING_BYTES = 131072;
constexpr int MISC_OFF = LDS_BYTES - 256;

__device__ __forceinline__ unsigned f2bf(float f) { unsigned u = __builtin_bit_cast(unsigned, f); return (u + 0x7fffu + ((u >> 16) & 1u)) >> 16; }
typedef __bf16 hwbf16x2 __attribute__((ext_vector_type(2)));
__device__ __forceinline__ unsigned pk2(float lo, float hi) { const f32x2 v = {lo, hi}; return __builtin_bit_cast(unsigned, __builtin_convertvector(v, hwbf16x2)); }
__device__ __forceinline__ float bf2f(unsigned short v) { return __builtin_bit_cast(float, (unsigned)v << 16); }
__device__ __forceinline__ float bflo(unsigned w) { return __builtin_bit_cast(float, w << 16); }
__device__ __forceinline__ float bfhi(unsigned w) { return __builtin_bit_cast(float, w & 0xffff0000u); }
__device__ __forceinline__ float sigmoidf_(float x) { return __builtin_amdgcn_rcpf(1.0f + __expf(-x)); }
__device__ __forceinline__ float wave_sum(float v) {
#pragma unroll
    for (int o = 1; o < 64; o <<= 1) v += __shfl_xor(v, o);
    return v;
}
__device__ __forceinline__ float wave_max(float v) {
#pragma unroll
    for (int o = 1; o < 64; o <<= 1) v = fmaxf(v, __shfl_xor(v, o));
    return v;
}

#define XB_TMO      128
#define XB_XCNT(j)  (256  + 64 * (j))
#define XB_XSUB(j)  (1280 + 64 * (j))
#define XB_XGEN(j)  (2304 + 64 * (j))
#define XB_TOP      3328
#define XB_TOPGEN   3392
#define XCD_BAR_WORDS 3456
#define XB_SPIN_CAP (1u << 18)
__device__ __forceinline__ unsigned xb_ld(unsigned* p)              { return __hip_atomic_load(p, __ATOMIC_RELAXED, __HIP_MEMORY_SCOPE_AGENT); }
__device__ __forceinline__ unsigned xb_add(unsigned* p, unsigned v) { return __hip_atomic_fetch_add(p, v, __ATOMIC_RELAXED, __HIP_MEMORY_SCOPE_AGENT); }
__device__ __forceinline__ unsigned xb_xcc_id() { return (unsigned)__builtin_amdgcn_s_getreg((3 << 11) | 20) & 0xFu; }
#define XB_SPIN(cond, bar) do { unsigned _sp = 0; while (cond) { __builtin_amdgcn_s_sleep(1); \
    if ((++_sp & 255u) == 0u) { if (xb_ld(&(bar)[XB_TMO])) break; if (_sp > XB_SPIN_CAP) { atomicAdd(&(bar)[XB_TMO], 1u); break; } } } } while (0)
struct XcdBarrier { unsigned* bar; unsigned x; volatile LAS unsigned* st; };
__device__ __forceinline__ XcdBarrier xcd_barrier_post(unsigned* bar, volatile LAS unsigned* st) {
    XcdBarrier b; b.bar = bar; b.x = xb_xcc_id(); b.st = st;
    if (threadIdx.x == 0) (void)xb_add(&bar[XB_XCNT(b.x)], 1u);
    return b;
}
__device__ __forceinline__ void xcd_barrier_complete(unsigned* bar, unsigned x, unsigned& nloc, unsigned& nx) {
    const unsigned G = gridDim.x * gridDim.y * gridDim.z;
    unsigned sum, cnt, mine, sp = 0u;
    for (;;) {
        sum = 0u; cnt = 0u; mine = 0u;
#pragma unroll
        for (unsigned j = 0; j < 16; ++j) { const unsigned c = xb_ld(&bar[XB_XCNT(j)]); sum += c; cnt += (c > 0u) ? 1u : 0u; mine = (j == x) ? c : mine; }
        if (sum == G) break;
        __builtin_amdgcn_s_sleep(1);
        if ((++sp & 255u) == 0u) { if (xb_ld(&bar[XB_TMO])) break; if (sp > XB_SPIN_CAP) { atomicAdd(&bar[XB_TMO], 1u); break; } }
    }
    nloc = mine > 0u ? mine : 1u; nx = cnt > 0u ? cnt : 1u;
}
__device__ __forceinline__ void xcd_barrier(const XcdBarrier& b, bool leader) {
    asm volatile("s_waitcnt vmcnt(0)" ::: "memory");
    __syncthreads();
    if (leader) {
        unsigned* bar = b.bar; unsigned bx = b.x;
        asm volatile("" : "+s"(bar), "+s"(bx));
        __builtin_amdgcn_s_waitcnt(0);
        unsigned nloc = b.st[0], nx = b.st[1];
        if (nloc == 0u) { xcd_barrier_complete(bar, bx, nloc, nx); b.st[0] = nloc; b.st[1] = nx; }
        const unsigned old = xb_add(&bar[XB_XSUB(bx)], 1u);
        const unsigned gen = old / nloc;
        if (old + 1u == (gen + 1u) * nloc) {
            __builtin_amdgcn_fence(__ATOMIC_RELEASE, "agent");
            asm volatile("s_waitcnt vmcnt(0)" ::: "memory");
            const unsigned og = xb_add(&bar[XB_TOP], 1u);
            const unsigned tg = og / nx;
            if (og + 1u == (tg + 1u) * nx) xb_add(&bar[XB_TOPGEN], 1u);
            else XB_SPIN(xb_ld(&bar[XB_TOPGEN]) == tg, bar);
            __builtin_amdgcn_fence(__ATOMIC_ACQUIRE, "agent");
            xb_add(&bar[XB_XGEN(bx)], 1u);
            asm volatile("s_waitcnt vmcnt(0)" ::: "memory");
        } else {
            XB_SPIN(xb_ld(&bar[XB_XGEN(bx)]) == gen, bar);
            __builtin_amdgcn_fence(__ATOMIC_ACQUIRE, "agent");
            asm volatile("s_waitcnt vmcnt(0)" ::: "memory");
        }
    }
    __syncthreads();
}

namespace pg8 {
constexpr int BM = 256, BK = 64, HALF = 128, HTB = HALF * BK * 2, STAGE_BYTES = 8 * HTB, NXCD = 8, WGM = 8;
__host__ __device__ __forceinline__ int lds_byte(int r, int c) { const int st = (r >> 4) * 2 + (c >> 5), rr = r & 15, cc = c & 31, ob = rr * 64 + cc * 2; return st * 1024 + (ob ^ (((ob >> 9) & 1) << 5)); }
__host__ __device__ __forceinline__ void stage_rc(int b, int& R, int& C) { const int st = b / 1024, sb = b % 1024, swz = sb ^ (((sb >> 9) & 1) << 5); R = (st >> 1) * 16 + swz / 64; C = (st & 1) * 32 + (swz % 64) / 2; }
__host__ __device__ __forceinline__ int perm32(int rho) { const int n = rho >> 4, i = rho & 15; return 8 * (i >> 2) + 4 * n + (i & 3); }

struct Unit { int pm, pn; };
struct Gemm { const bf16_t* A; const bf16_t* Bt; };

template <int M, int N> struct StaticOrder {
    static constexpr int nM = M / BM, nN = N / BM, nwg = nM * nN;
    int G, c;
    __host__ __device__ void init(int G_, int c_) { G = G_; c = c_; }
    __host__ __device__ bool next(int i, Unit& u) const {
        const long L = (long)i * G + c; if (L >= nwg) return false;
        int wgid = (int)L; { constexpr int q = nwg / NXCD, r = nwg % NXCD; const int xcd = wgid % NXCD, off = wgid / NXCD; wgid = (xcd < r ? xcd * (q + 1) : r * (q + 1) + (xcd - r) * q) + off; }
        constexpr int nig = WGM * nN; const int gid = wgid / nig, fm = gid * WGM, gsz = (nM - fm) < WGM ? (nM - fm) : WGM;
        u.pm = fm + ((wgid % nig) % gsz); u.pn = (wgid % nig) / gsz; return true;
    }
};

template <class F, int FENCE = 0> struct EpiGen {
    static constexpr bool PERM = true, HAS_MID = false, FUSED = false;
    F f;
    __device__ __forceinline__ void operator()(const f32x4 (&acc)[2][2][4][2], const Unit& u, int wr, int wc, int fr, int fq) const {
        const int row0 = u.pm * BM + wr * 64 + fr, col0 = u.pn * BM + wc * 32 + 8 * fq;
#pragma unroll
        for (int ai = 0; ai < 2; ++ai)
#pragma unroll
            for (int m = 0; m < 4; ++m)
#pragma unroll
                for (int bj = 0; bj < 2; ++bj) { f(row0 + ai * HALF + m * 16, col0 + bj * HALF, acc[ai][bj][m][0], acc[ai][bj][m][1]);
                    if constexpr (FENCE > 0) { if (((ai * 4 + m) * 2 + bj) % FENCE == FENCE - 1) asm volatile("" ::: "memory"); } }
    }
};

template <int M, int N, int K, int LDA, int LDB, class Epi, bool ALIGN_EPI = true>
__device__ __forceinline__ void gemm_phase(LAS unsigned char* lds, const Gemm g, const StaticOrder<M, N>& S, const Epi& E, int tid_in) {
    int tid = tid_in; asm volatile("" : "+v"(tid));
    const int wid = __builtin_amdgcn_readfirstlane(tid >> 6), lane = tid & 63, wr = wid >> 2, wc = wid & 3, fr = lane & 15, fq = lane >> 4;
    constexpr int nt = K / BK;
    unsigned voffA[2], voffB[2];
#pragma unroll
    for (int i = 0; i < 2; ++i) { int R, C; stage_rc(tid * 16 + i * 8192, R, C); const int Rb = Epi::PERM ? ((R & ~31) + perm32(R & 31)) : R;
        voffA[i] = (unsigned)(R * LDA + C) * 2u; voffB[i] = (unsigned)(Rb * LDB + C) * 2u; }
    constexpr size_t kstep = (size_t)(BK * 2);
    constexpr size_t hstepA = (size_t)HALF * LDA * 2, hstepB = (size_t)HALF * LDB * 2;
    constexpr size_t tstepA = 2 * hstepA, tstepB = 2 * hstepB;
    const unsigned ldsw = (unsigned)wid * 1024u;
    const int aoff = lds_byte(wr * 64 + fr, fq * 8), boff = lds_byte(wc * 32 + fr, fq * 8);
#define PG8_SA(b, h) (((b) * 2 + (h)) * HTB)
#define PG8_SB(b, h) ((4 + (b) * 2 + (h)) * HTB)
#define PG8_STAGE(bufoff, gbase, voff) do { _Pragma("unroll") for (int _i = 0; _i < 2; ++_i) \
        __builtin_amdgcn_global_load_lds((const unsigned*)((const char*)(gbase) + (voff)[_i]), (LAS unsigned*)(lds + (bufoff) + ldsw + _i * 8192), 16, 0, 0); } while (0)
#define PG8_LDA(dst, b, h) do { _Pragma("unroll") for (int m = 0; m < 4; ++m) _Pragma("unroll") for (int k = 0; k < 2; ++k) dst[m][k] = *(const LAS bf16x8*)(lds + PG8_SA(b, h) + aoff + m * 2048 + k * 1024); } while (0)
#define PG8_LDB(dst, b, h) do { _Pragma("unroll") for (int n = 0; n < 2; ++n) _Pragma("unroll") for (int k = 0; k < 2; ++k) dst[n][k] = *(const LAS bf16x8*)(lds + PG8_SB(b, h) + boff + n * 2048 + k * 1024); } while (0)
#define PG8_MMA(ai, bj, At, Bt) do { __builtin_amdgcn_s_setprio(1); _Pragma("unroll") for (int m = 0; m < 4; ++m) _Pragma("unroll") for (int n = 0; n < 2; ++n) _Pragma("unroll") for (int k = 0; k < 2; ++k) \
        acc[ai][bj][m][n] = __builtin_amdgcn_mfma_f32_16x16x32_bf16(Bt[n][k], At[m][k], acc[ai][bj][m][n], 0, 0, 0); __builtin_amdgcn_s_setprio(0); } while (0)
#define PG8_WAIT_V(n) asm volatile("s_waitcnt vmcnt(" #n ")" ::: "memory")
#define PG8_WAIT_L(n) asm volatile("s_waitcnt lgkmcnt(" #n ")" ::: "memory")
#define PG8_BAR __builtin_amdgcn_s_barrier()
#define PG8_SCHED __builtin_amdgcn_sched_barrier(0)
    Unit cur, nxt; int ui = 0;
    if (!S.next(0, cur)) return;
    f32x4 acc[2][2][4][2];
#pragma unroll
    for (int a = 0; a < 2; ++a)
#pragma unroll
        for (int b = 0; b < 2; ++b)
#pragma unroll
            for (int m = 0; m < 4; ++m)
#pragma unroll
                for (int n = 0; n < 2; ++n) acc[a][b][m][n] = (f32x4){0.f, 0.f, 0.f, 0.f};
    bf16x8 At[4][2], B0[2][2], B1[2][2];
    const char* cA = (const char*)g.A + (size_t)cur.pm * tstepA; const char* cB = (const char*)g.Bt + (size_t)cur.pn * tstepB;
    PG8_STAGE(PG8_SB(0, 0), cB, voffB); PG8_STAGE(PG8_SB(0, 1), cB + hstepB, voffB); PG8_STAGE(PG8_SA(0, 0), cA, voffA); PG8_STAGE(PG8_SA(0, 1), cA + hstepA, voffA);
    if (wr == 1) PG8_BAR;
    PG8_WAIT_V(2); PG8_BAR;
    PG8_STAGE(PG8_SB(1, 0), cB + kstep, voffB); PG8_STAGE(PG8_SA(1, 0), cA + kstep, voffA); PG8_STAGE(PG8_SB(1, 1), cB + hstepB + kstep, voffB);
    PG8_WAIT_V(6); PG8_BAR;
    for (;;) {
        const bool has_next = S.next(ui + 1, nxt);
        const char* nA = has_next ? (const char*)g.A + (size_t)nxt.pm * tstepA : cA; const char* nB = has_next ? (const char*)g.Bt + (size_t)nxt.pn * tstepB : cB;
#pragma unroll 1
        for (int t = 0; t < nt; t += 2) {
            const bool last = (t == nt - 2);
            const char* a1 = cA + (size_t)(t + 1) * kstep;
            const char* a2 = last ? nA : cA + (size_t)(t + 2) * kstep; const char* b2 = last ? nB : cB + (size_t)(t + 2) * kstep;
            const char* a3 = a2 + kstep; const char* b3 = b2 + kstep;
            if constexpr (Epi::HAS_MID) { if (t == Epi::MID0 || t == Epi::MID1) E.mid(acc, cur, t, wr, wc, fr, fq); }
            PG8_LDB(B0, 0, 0); PG8_LDB(B1, 0, 1); PG8_SCHED; PG8_LDA(At, 0, 0); PG8_STAGE(PG8_SA(1, 1), a1 + hstepA, voffA);
            PG8_WAIT_V(8); PG8_WAIT_L(0); PG8_BAR; PG8_MMA(0, 0, At, B0); PG8_MMA(0, 1, At, B1); PG8_BAR; PG8_SCHED;
            PG8_LDA(At, 0, 1); PG8_STAGE(PG8_SB(0, 0), b2, voffB); PG8_STAGE(PG8_SB(0, 1), b2 + hstepB, voffB); PG8_STAGE(PG8_SA(0, 0), a2, voffA);
            PG8_WAIT_V(8); PG8_WAIT_L(0); PG8_BAR; PG8_MMA(1, 0, At, B0); PG8_MMA(1, 1, At, B1); PG8_BAR; PG8_SCHED;
            PG8_LDB(B0, 1, 0); PG8_LDB(B1, 1, 1); PG8_SCHED; PG8_LDA(At, 1, 0); PG8_STAGE(PG8_SA(0, 1), a2 + hstepA, voffA);
            PG8_WAIT_V(8); PG8_WAIT_L(0); PG8_BAR; PG8_MMA(0, 0, At, B0); PG8_MMA(0, 1, At, B1); PG8_BAR; PG8_SCHED;
            PG8_LDA(At, 1, 1); PG8_STAGE(PG8_SB(1, 0), b3, voffB); PG8_STAGE(PG8_SB(1, 1), b3 + hstepB, voffB); PG8_STAGE(PG8_SA(1, 0), a3, voffA);
            PG8_WAIT_V(8); PG8_WAIT_L(0); PG8_BAR; PG8_MMA(1, 0, At, B0); PG8_MMA(1, 1, At, B1); PG8_BAR; PG8_SCHED;
        }
        if constexpr (ALIGN_EPI) { if (wr == 0) PG8_BAR; }
        if constexpr (Epi::FUSED) E.fused(acc, cur, wr, wc, fr, fq, lds, wid, lane); else E(acc, cur, wr, wc, fr, fq);
        if (!has_next) break;
#pragma unroll
        for (int a = 0; a < 2; ++a)
#pragma unroll
            for (int b = 0; b < 2; ++b)
#pragma unroll
                for (int m = 0; m < 4; ++m)
#pragma unroll
                    for (int n = 0; n < 2; ++n) acc[a][b][m][n] = (f32x4){0.f, 0.f, 0.f, 0.f};
        cur = nxt; cA = nA; cB = nB; ++ui;
        if constexpr (ALIGN_EPI) { if (wr == 1) PG8_BAR; }
    }
    PG8_WAIT_V(0);
    if constexpr (!ALIGN_EPI) { if (wr == 0) PG8_BAR; }
    PG8_BAR;
#undef PG8_SA
#undef PG8_SB
#undef PG8_STAGE
#undef PG8_LDA
#undef PG8_LDB
#undef PG8_MMA
#undef PG8_WAIT_V
#undef PG8_WAIT_L
#undef PG8_BAR
#undef PG8_SCHED
}
}

constexpr int NWAVES = 8, NTHREADS = 512;
struct Args { const void* in[23]; float* out; unsigned char* ws; int ph_lo, ph_hi; };
struct Frame {
    LAS unsigned char* lds;
    int tid, lane, wave, G, bid;
    unsigned char* wsb; unsigned zo; unsigned wl;
    __device__ __forceinline__ bf16_t* IKD() const { return (bf16_t*)(wsb + zo + WS_IKD); }
    __device__ __forceinline__ float* XB() const { return (float*)(wsb + zo + WS_XB); }
    __device__ __forceinline__ unsigned* PANEL(int bank) const { return (unsigned*)(wsb + zo + WS_CTL) + CW_PANEL + bank * 8192; }
    __device__ __forceinline__ float* IW() const { return (float*)(wsb + zo + WS_IW); }
    __device__ __forceinline__ bf16_t* XR() const { return (bf16_t*)(wsb + zo + WS_XR); }
    __device__ __forceinline__ float* SP(int l) const { return (float*)(wsb + zo + WS_SP) + l * 36864; }
    __device__ __forceinline__ f32x2* ROPE() const { return (f32x2*)(wsb + zo + WS_ROPE); }
    __device__ __forceinline__ f32x2* S5E() const { return (f32x2*)(wsb + zo + WS_S5E); }
    __device__ __forceinline__ float* RST() const { return (float*)(wsb + zo + WS_RST); }
    __device__ __forceinline__ bf16_t* Win_t() const { return (bf16_t*)(wsb + zo + wl + WS_W + WO_IN); }
    __device__ __forceinline__ bf16_t* Wabc_t() const { return (bf16_t*)(wsb + zo + wl + WS_W + WO_ABC); }
    __device__ __forceinline__ bf16_t* Wout_t() const { return (bf16_t*)(wsb + zo + wl + WS_W + WO_OUT); }
    __device__ __forceinline__ bf16_t* W1_t() const { return (bf16_t*)(wsb + zo + wl + WS_W + WO_W1); }
    __device__ __forceinline__ bf16_t* W2_t() const { return (bf16_t*)(wsb + zo + wl + WS_W + WO_W2); }
    __device__ __forceinline__ bf16_t* Wglu_t() const { return (bf16_t*)(wsb + zo + wl + WS_W + WO_GLU); }
    __device__ __forceinline__ bf16_t* H() const { return (bf16_t*)(wsb + zo + WS_H); }
    __device__ __forceinline__ bf16_t* ZS() const { return (bf16_t*)(wsb + zo + WS_ZS); }
    __device__ __forceinline__ unsigned char* GB() const { return wsb + zo + WS_G; }
    __device__ __forceinline__ bf16_t* MG() const { return (bf16_t*)(wsb + zo + WS_ZS); }
    __device__ __forceinline__ bf16_t* FB() const { return (bf16_t*)(wsb + zo + WS_ZS); }
};
constexpr int SP_LB = 0, SP_L64 = 2048, SP_BBR = 4096, SP_BBI = 4096 + 16384;

__device__ __forceinline__ int ropeperm(int j, int r) { const int half = r >> 1; return (j < r) ? ((j & 1) ? half + (j >> 1) : (j >> 1)) : j; }
__device__ __forceinline__ int zmap(int n) {
    if (n < ZDQ) return n;
    if (n < ZDK) { const int q = n - ZDQ, h = q >> 6, hc = q & 63; return 256 + h * 64 + ropeperm(hc, 16); }
    if (n < ZDV) return 640 + ropeperm(n - ZDK, 16);
    if (n < ZIQ) return 704 + (n - ZDV);
    if (n < ZIK) { const int q = n - ZIQ, h = q >> 5, hc = q & 31; return 768 + h * 32 + ropeperm(hc, 8); }
    if (n < ZIWC) return 896 + ropeperm(n - ZIK, 8);
    if (n < ZRQ) return (n - ZIWC) < 4 ? 928 + (n - ZIWC) : -1;
    if (n < ZRK) { const int q = n - ZRQ, h = q / 48, hc = q % 48; return 932 + h * 48 + ropeperm(hc, 48); }
    if (n < ZRV) { const int q = n - ZRK, h = q / 48, hc = q % 48; return 1124 + h * 48 + ropeperm(hc, 48); }
    if (n < ZRG) return 1316 + (n - ZRV);
    if (n < ZGATE) return 1700 + (n - ZRG);
    if (n < ZEND) return 2084 + (n - ZGATE);
    return -1;
}

__device__ __forceinline__ void tr_item(const float* W, int N, int kb, int nb, bf16_t* WT, int ldd, int koff, bool mapped, LAS float* scr, int lane) {
    const int k0 = 64 * kb, n0 = 32 * nb;
    const int c32 = lane & 31; int sc = n0 + c32; if (mapped) sc = zmap(sc);
#pragma unroll 8
    for (int i = 0; i < 32; ++i) { const int kk = 2 * i + (lane >> 5); scr[kk * 33 + c32] = (sc >= 0) ? W[(size_t)(k0 + kk) * N + sc] : 0.f; }
    asm volatile("s_waitcnt lgkmcnt(0)" ::: "memory");
    const int c = lane & 7;
#pragma unroll
    for (int j = 0; j < 4; ++j) { const int n = (lane >> 3) + 8 * j; const LAS float* s = scr + (8 * c) * 33 + n;
        u32x4 o; o.x = pk2(s[0 * 33], s[1 * 33]); o.y = pk2(s[2 * 33], s[3 * 33]); o.z = pk2(s[4 * 33], s[5 * 33]); o.w = pk2(s[6 * 33], s[7 * 33]);
        *(u32x4*)(WT + (size_t)(n0 + n) * ldd + koff + k0 + 8 * c) = o; }
    asm volatile("s_waitcnt lgkmcnt(0)" ::: "memory");
}

struct TrJob { const float* W; int N, kb, nb; bf16_t* WT; int ldd, koff; bool mapped; };
__device__ __forceinline__ void tr_load(const TrJob& J, float (&v)[32], int lane) {
    const int k0 = 64 * J.kb, n0 = 32 * J.nb, c32 = lane & 31; int sc = n0 + c32; if (J.mapped) sc = zmap(sc);
    const float* wp = J.W + (size_t)(k0 + (lane >> 5)) * J.N + (sc >= 0 ? sc : 0);
#pragma unroll
    for (int i = 0; i < 32; ++i) v[i] = wp[(size_t)(2 * i) * J.N];
    if (sc < 0) {
#pragma unroll
        for (int i = 0; i < 32; ++i) v[i] = 0.f;
    }
}
__device__ __forceinline__ void tr_store(const TrJob& J, const float (&v)[32], LAS float* scr, int lane) {
    const int k0 = 64 * J.kb, n0 = 32 * J.nb, c32 = lane & 31;
#pragma unroll
    for (int i = 0; i < 32; ++i) scr[(2 * i + (lane >> 5)) * 33 + c32] = v[i];
    asm volatile("s_waitcnt lgkmcnt(0)" ::: "memory");
    const int c = lane & 7;
#pragma unroll
    for (int j = 0; j < 4; ++j) { const int n = (lane >> 3) + 8 * j; const LAS float* s = scr + (8 * c) * 33 + n;
        u32x4 o; o.x = pk2(s[0 * 33], s[1 * 33]); o.y = pk2(s[2 * 33], s[3 * 33]); o.z = pk2(s[4 * 33], s[5 * 33]); o.w = pk2(s[6 * 33], s[7 * 33]);
        *(u32x4*)(J.WT + (size_t)(n0 + n) * J.ldd + J.koff + k0 + 8 * c) = o; }
    asm volatile("s_waitcnt lgkmcnt(0)" ::: "memory");
}
__device__ __forceinline__ void rms_rows4_bf16(const float* x0, size_t rstride, int nrows, const float* gain, bf16_t* o0, size_t ostride, int lane) {
    f32x4 v[4][4];
#pragma unroll
    for (int r = 0; r < 4; ++r) if (r < nrows) {
#pragma unroll
        for (int j = 0; j < 4; ++j) v[r][j] = ((const f32x4*)(x0 + r * rstride) + lane)[64 * j];
    }
    f32x4 gg[4];
#pragma unroll
    for (int j = 0; j < 4; ++j) gg[j] = ((const f32x4*)gain + lane)[64 * j];
#pragma unroll
    for (int r = 0; r < 4; ++r) if (r < nrows) {
        float s = 0.f;
#pragma unroll
        for (int j = 0; j < 4; ++j) s += (v[r][j].x * v[r][j].x + v[r][j].y * v[r][j].y) + (v[r][j].z * v[r][j].z + v[r][j].w * v[r][j].w);
        const float rstd = rsqrtf(wave_sum(s) * (1.f / DM) + EPS);
        u32x2* o8 = (u32x2*)(o0 + r * ostride) + lane;
#pragma unroll
        for (int j = 0; j < 4; ++j) { u32x2 w; w.x = pk2(v[r][j].x * rstd * gg[j].x, v[r][j].y * rstd * gg[j].y); w.y = pk2(v[r][j].z * rstd * gg[j].z, v[r][j].w * rstd * gg[j].w); o8[64 * j] = w; }
    }
}
__device__ __forceinline__ void rms_row_bf16(const float* xrow, const float* gain, bf16_t* orow, int lane) {
    const f32x4* xr = (const f32x4*)xrow + lane; const f32x4* gr = (const f32x4*)gain + lane;
    f32x4 v[4]; float s = 0.f;
#pragma unroll
    for (int j = 0; j < 4; ++j) { v[j] = xr[64 * j]; s += (v[j].x * v[j].x + v[j].y * v[j].y) + (v[j].z * v[j].z + v[j].w * v[j].w); }
    const float rstd = rsqrtf(wave_sum(s) * (1.f / DM) + EPS);
    u32x2* o8 = (u32x2*)orow + lane;
#pragma unroll
    for (int j = 0; j < 4; ++j) { const f32x4 gg = gr[64 * j]; u32x2 w; w.x = pk2(v[j].x * rstd * gg.x, v[j].y * rstd * gg.y); w.y = pk2(v[j].z * rstd * gg.z, v[j].w * rstd * gg.w); o8[64 * j] = w; }
}
__device__ __forceinline__ void rms_row_f32(const float* xrow, const float* gain, float* orow, int lane) {
    const f32x4* xr = (const f32x4*)xrow + lane; const f32x4* gr = (const f32x4*)gain + lane;
    f32x4 v[4]; float s = 0.f;
#pragma unroll
    for (int j = 0; j < 4; ++j) { v[j] = xr[64 * j]; s += (v[j].x * v[j].x + v[j].y * v[j].y) + (v[j].z * v[j].z + v[j].w * v[j].w); }
    const float rstd = rsqrtf(wave_sum(s) * (1.f / DM) + EPS);
    f32x4* o = (f32x4*)orow + lane;
#pragma unroll
    for (int j = 0; j < 4; ++j) { const f32x4 gg = gr[64 * j]; o[64 * j] = v[j] * rstd * gg; }
}


__device__ __forceinline__ void phase_rope(Frame& F, const int* pos) {
    const int gt = F.bid * NTHREADS + F.tid, NT = F.G * NTHREADS;
    f32x2* RT = F.ROPE();
    for (int e = gt; e < T * NFREQ; e += NT) {
        const int tok = e / NFREQ, f = e % NFREQ;
        float lth, sc; int fi;
        if (f < 8) { lth = 13.122363377404328f; sc = 2.0f / 16.0f; fi = f; } else if (f < 12) { lth = 13.122363377404328f; sc = 2.0f / 8.0f; fi = f - 8; } else { lth = 9.210340371976184f; sc = 2.0f / 48.0f; fi = f - 12; }
        const float inv = expf(-lth * (float)fi * sc);
        const float p = (float)pos[tok];
        const float ang = p * inv;
        const float kq = rintf(ang * 0.15915494309189535f);
        float r = fmaf(-kq, 6.2831854820251465f, ang);
        r = fmaf(-kq, -1.7484555e-7f, r);
        RT[e] = (f32x2){cosf(r), sinf(r)};
    }
}

struct ProIn { const float *xin, *norm1_g, *w_in, *wa, *wb, *wc, *wo, *w1, *w2, *wg, *lam_re, *lam_im, *log_step, *b_re, *b_im; const int* pos; };
__device__ __forceinline__ void phase_prologue(Frame& F, const ProIn& I) {
#ifdef NO_PHASE_PROLOGUE
    return;
#endif
    LAS float* scr = (LAS float*)(F.lds + F.wave * 16384);
    const int gw = F.bid * NWAVES + F.wave, NGW = F.G * NWAVES;
#pragma unroll 1
    for (int l = 0; l < DEPTH; ++l) {
    F.wl = l ? (unsigned)(WS_W1L - WS_W) : 0u;
    constexpr int I_IN = 16 * (NINP / 32), I_A = 4 * 32, I_B = 6 * 32, I_C = 6 * 32, I_O = 16 * 32, I_1 = 16 * 128, I_2 = 64 * 32, I_G = 4 * 8;
    constexpr int NITEMS = I_IN + I_A + I_B + I_C + I_O + I_1 + I_2 + I_G;
    const float* w_in = I.w_in + (size_t)l * DM * NIN; const float* wa = I.wa + (size_t)l * 256 * DM; const float* wb = I.wb + (size_t)l * 384 * DM;
    const float* wc = I.wc + (size_t)l * 384 * DM; const float* wo = I.wo + (size_t)l * DM * DM; const float* w1 = I.w1 + (size_t)l * DM * FF;
    const float* w2 = I.w2 + (size_t)l * FF * DM; const float* wg = I.wg + (size_t)l * 256 * 256;
    auto decode = [&](int r, TrJob& J) {
        if (r < I_IN) { J = TrJob{w_in, NIN, r / (NINP / 32), r % (NINP / 32), F.Win_t(), DM, 0, true}; return; } r -= I_IN;
        if (r < I_A) { J = TrJob{wa, DM, r / 32, r % 32, F.Wabc_t(), DM, 0, false}; return; } r -= I_A;
        if (r < I_B) { J = TrJob{wb, DM, r / 32, r % 32, F.Wabc_t(), DM, 256, false}; return; } r -= I_B;
        if (r < I_C) { J = TrJob{wc, DM, r / 32, r % 32, F.Wabc_t(), DM, 640, false}; return; } r -= I_C;
        if (r < I_O) { J = TrJob{wo, DM, r / 32, r % 32, F.Wout_t(), DM, 0, false}; return; } r -= I_O;
        if (r < I_1) { J = TrJob{w1, FF, r / 128, r % 128, F.W1_t(), DM, 0, false}; return; } r -= I_1;
        if (r < I_2) { J = TrJob{w2, DM, r / 32, r % 32, F.W2_t(), FF, 0, false}; return; } r -= I_2;
        J = TrJob{wg, 256, r / 8, r % 8, F.Wglu_t(), 256, 0, false};
    };
#pragma unroll 1
    for (int it = gw; it < NITEMS; it += 2 * NGW) {
        const bool hb = it + NGW < NITEMS;
        TrJob JA, JB; decode(it, JA); decode(hb ? it + NGW : it, JB);
        float va[32], vb[32];
        tr_load(JA, va, F.lane); if (hb) tr_load(JB, vb, F.lane);
        tr_store(JA, va, scr, F.lane); if (hb) tr_store(JB, vb, scr, F.lane);
    }
    {
        const int gt = F.bid * NTHREADS + F.tid;
        if (gt < 1024) {
            float* SPp = F.SP(l);
            const int g = gt >> 6, p = gt & 63;
            const float lr = I.lam_re[(l * 16 + g) * 64 + p], li = I.lam_im[(l * 16 + g) * 64 + p];
            const float step = expf(I.log_step[l * 16 + g]);
            const float mag = expf(lr * step); const float lbr = mag * cosf(li * step), lbi = mag * sinf(li * step);
            const float den = lr * lr + li * li;
            const float fr = ((lbr - 1.f) * lr + lbi * li) / den, fi = (lbi * lr - (lbr - 1.f) * li) / den;
            SPp[SP_LB + gt * 2] = lbr; SPp[SP_LB + gt * 2 + 1] = lbi;
            float pr = lbr, pi = lbi;
#pragma unroll
            for (int s = 0; s < 6; ++s) { const float nr = pr * pr - pi * pi, ni = 2.f * pr * pi; pr = nr; pi = ni; }
            SPp[SP_L64 + gt * 2] = pr; SPp[SP_L64 + gt * 2 + 1] = pi;
            const float* br = I.b_re + ((size_t)(l * 16 + g) * 64 + p) * 16; const float* bi = I.b_im + ((size_t)(l * 16 + g) * 64 + p) * 16;
#pragma unroll
            for (int c = 0; c < 16; ++c) { SPp[SP_BBR + gt * 16 + c] = fr * br[c] - fi * bi[c]; SPp[SP_BBI + gt * 16 + c] = fr * bi[c] + fi * br[c]; }
        }
    }
    }
    F.wl = 0u;
    for (int m = gw; m < T; m += 4 * NGW) { const int left = (T - m + NGW - 1) / NGW; rms_rows4_bf16(I.xin + (size_t)m * DM, (size_t)NGW * DM, left < 4 ? left : 4, I.norm1_g, F.H() + (size_t)m * DM, (size_t)NGW * DM, F.lane); }
}

__device__ __forceinline__ u32x4 pack8(const f32x4& a, const f32x4& b) { u32x4 w; w.x = pk2(a.x, a.y); w.y = pk2(a.z, a.w); w.z = pk2(b.x, b.y); w.w = pk2(b.z, b.w); return w; }
__device__ __forceinline__ void unpack8(const u32x4& w, f32x4& a, f32x4& b) { a = (f32x4){bflo(w.x), bfhi(w.x), bflo(w.y), bfhi(w.y)}; b = (f32x4){bflo(w.z), bfhi(w.z), bflo(w.w), bfhi(w.w)}; }

__device__ __forceinline__ unsigned gate1_u8(float x) { const float s = 255.f * sigmoidf_(x) + 0.5f; const unsigned u = (unsigned)s; return u < 1u ? 1u : u; }
__device__ __forceinline__ unsigned gate4_u8(const f32x4& a) { return gate1_u8(a.x) | (gate1_u8(a.y) << 8) | (gate1_u8(a.z) << 16) | (gate1_u8(a.w) << 24); }
__device__ __forceinline__ void ungate8(const u32x2& w, f32x4& a, f32x4& b) {
    a = (f32x4){(float)(w.x & 255u), (float)((w.x >> 8) & 255u), (float)((w.x >> 16) & 255u), (float)(w.x >> 24)};
    b = (f32x4){(float)(w.y & 255u), (float)((w.y >> 8) & 255u), (float)((w.y >> 16) & 255u), (float)(w.y >> 24)};
}
struct FInProj {
    bf16_t* ZS; unsigned char* GB; float* IW; const f32x2* ROPE; bf16_t* IKD;
    __device__ __forceinline__ void rope8(f32x4& a, f32x4& b, int row, int f0) const {
        const f32x2* rt = ROPE + (size_t)row * NFREQ + f0;
        const f32x2 c0 = rt[0], c1 = rt[1], c2 = rt[2], c3 = rt[3];
        f32x4 oa, ob;
        oa.x = a.x * c0.x - a.y * c0.y; oa.y = a.y * c0.x + a.x * c0.y;
        oa.z = a.z * c1.x - a.w * c1.y; oa.w = a.w * c1.x + a.z * c1.y;
        ob.x = b.x * c2.x - b.y * c2.y; ob.y = b.y * c2.x + b.x * c2.y;
        ob.z = b.z * c3.x - b.w * c3.y; ob.w = b.w * c3.x + b.z * c3.y;
        a = oa; b = ob;
    }
    __device__ __forceinline__ void operator()(int row, int col, f32x4 a, f32x4 b) const {
        if (col >= ZEND) return;
        if (col >= ZGATE) {
            *(u32x2*)(GB + (size_t)row * GW + (col - ZGATE)) = (u32x2){gate4_u8(a), gate4_u8(b)}; return;
        }
        if (col >= ZIWC && col < ZRQ) { if (col == ZIWC) *(f32x4*)(IW + (size_t)row * 4) = a; return; }
        if (col >= ZDQ && col < ZDV) { const int hc = (col - ZDQ) & 63; if (hc < 16) rope8(a, b, row, hc >> 1); }
        else if (col >= ZIQ && col < ZIWC) { const int hc = (col - ZIQ) & 31; if (hc < 8) rope8(a, b, row, 8);
            if (col >= ZIK) { *(u32x4*)(IKD + ((size_t)((row >> 5) * 4 + ((col - ZIK) >> 3)) * 32 + (row & 31)) * 8) = pack8(a, b); return; } }
        else if (col >= ZRQ && col < ZRV) { const int hc = (col - ZRQ) % 48; rope8(a, b, row, 12 + (hc >> 1)); }
        *(u32x4*)(ZS + (size_t)row * ZSW + col) = pack8(a, b);
    }
};
struct FMerge {
    bf16_t* MG; const bf16_t* GB; int br;
    __device__ __forceinline__ void operator()(int row, int col, f32x4 a, f32x4 b) const {
        f32x4 ga, gb; unpack8(*(const u32x4*)(GB + (size_t)row * GW + br * DM + col), ga, gb);
        a = a * ga; b = b * gb;
        u32x4* mp = (u32x4*)(MG + (size_t)row * DM + col);
        if (br != 0) { f32x4 pa, pb; unpack8(*mp, pa, pb); a = a + pa; b = b + pb; }
        *mp = pack8(a, b);
    }
};
struct FResid {
    const float* base; float* out;
    __device__ __forceinline__ void operator()(int row, int col, f32x4 a, f32x4 b) const {
        const f32x4* bp = (const f32x4*)(base + (size_t)row * DM + col); f32x4* op = (f32x4*)(out + (size_t)row * DM + col);
        const f32x4 b0 = bp[0], b1 = bp[1]; op[0] = b0 + a; op[1] = b1 + b;
    }
};
struct FRelu2 {
    bf16_t* FB;
    __device__ __forceinline__ void operator()(int row, int col, f32x4 a, f32x4 b) const {
        a = (f32x4){fmaxf(a.x, 0.f), fmaxf(a.y, 0.f), fmaxf(a.z, 0.f), fmaxf(a.w, 0.f)}; b = (f32x4){fmaxf(b.x, 0.f), fmaxf(b.y, 0.f), fmaxf(b.z, 0.f), fmaxf(b.w, 0.f)};
        *(u32x4*)(FB + (size_t)row * FF + col) = pack8(a * a, b * b);
    }
};
struct FGlu {
    bf16_t* H; const float* bias;
    __device__ __forceinline__ void operator()(int row, int col, f32x4 a, f32x4 b) const {
        u32x4* hp = (u32x4*)(H + (size_t)row * DM + col); f32x4 ya, yb; unpack8(*hp, ya, yb);
        const f32x4 ba = *(const f32x4*)(bias + col), bb = *(const f32x4*)(bias + col + 4);
        a = a + ba; b = b + bb;
        a = (f32x4){ya.x * sigmoidf_(a.x), ya.y * sigmoidf_(a.y), ya.z * sigmoidf_(a.z), ya.w * sigmoidf_(a.w)};
        b = (f32x4){yb.x * sigmoidf_(b.x), yb.y * sigmoidf_(b.y), yb.z * sigmoidf_(b.z), yb.w * sigmoidf_(b.w)};
        *hp = pack8(a, b);
    }
};

struct EpiMerge {
    static constexpr bool PERM = true, HAS_MID = true, FUSED = false; static constexpr int MID0 = 4, MID1 = 10;
    bf16_t* MG; const unsigned char* GB;
    __device__ __forceinline__ void mid(f32x4 (&acc)[2][2][4][2], const pg8::Unit& u, int t, int wr, int wc, int fr, int fq) const {
        int zz = 0; asm volatile("" : "+v"(zz));
        const int row0 = u.pm * 256 + wr * 64 + fr + zz, col0 = u.pn * 256 + wc * 32 + 8 * fq, bp = (t == MID0) ? 0 : 1;
#pragma unroll
        for (int ai = 0; ai < 2; ++ai)
#pragma unroll
            for (int m = 0; m < 4; ++m) {
#pragma unroll
                for (int bj = 0; bj < 2; ++bj) {
                    const unsigned char* gp = GB + (size_t)(row0 + ai * 128 + m * 16) * GW + bp * DM + col0 + bj * 128;
                    f32x4 pa, pb, na, nb; ungate8(*(const u32x2*)gp, pa, pb); ungate8(*(const u32x2*)(gp + DM), na, nb);
                    const f32x4 fa = {pa.x * __builtin_amdgcn_rcpf(na.x), pa.y * __builtin_amdgcn_rcpf(na.y), pa.z * __builtin_amdgcn_rcpf(na.z), pa.w * __builtin_amdgcn_rcpf(na.w)};
                    const f32x4 fb = {pb.x * __builtin_amdgcn_rcpf(nb.x), pb.y * __builtin_amdgcn_rcpf(nb.y), pb.z * __builtin_amdgcn_rcpf(nb.z), pb.w * __builtin_amdgcn_rcpf(nb.w)};
                    acc[ai][bj][m][0] = acc[ai][bj][m][0] * fa; acc[ai][bj][m][1] = acc[ai][bj][m][1] * fb;
                }
                if (m == 3) asm volatile("" ::: "memory");
            }
    }
    __device__ __forceinline__ void operator()(const f32x4 (&acc)[2][2][4][2], const pg8::Unit& u, int wr, int wc, int fr, int fq) const {
        const int row0 = u.pm * 256 + wr * 64 + fr, col0 = u.pn * 256 + wc * 32 + 8 * fq;
#pragma unroll
        for (int ai = 0; ai < 2; ++ai)
#pragma unroll
            for (int m = 0; m < 4; ++m)
#pragma unroll
                for (int bj = 0; bj < 2; ++bj) {
                    const int row = row0 + ai * 128 + m * 16, col = col0 + bj * 128;
                    f32x4 ga, gb; ungate8(*(const u32x2*)(GB + (size_t)row * GW + 2 * DM + col), ga, gb);
                    *(u32x4*)(MG + (size_t)row * DM + col) = pack8(acc[ai][bj][m][0] * (ga * (1.f / 255.f)), acc[ai][bj][m][1] * (gb * (1.f / 255.f)));
                }
    }
};

struct EpiResidNorm {
    static constexpr bool PERM = true, HAS_MID = false, FUSED = true;
    const float* base; const bf16_t* base16; bf16_t* XOUT; bf16_t* HN; float* NOUT; const float* gain; float* xbuf; unsigned* cnt;
    __device__ __forceinline__ void fused(f32x4 (&acc)[2][2][4][2], const pg8::Unit& u, int wr, int wc, int fr, int fq, LAS unsigned char* lds, int wid, int lane) const {
        LAS float* P = (LAS float*)(lds + 131072);
        LAS float* S = (LAS float*)(lds + 131072 + 4096);
        LAS unsigned* flag = (LAS unsigned*)(lds + 131072 + 5120);
        int zz = 0; asm volatile("" : "+v"(zz));
        const int rl0 = wr * 64 + fr + zz, row0 = u.pm * 256 + rl0, col0 = u.pn * 256 + wc * 32 + 8 * fq;
#pragma unroll
        for (int ai = 0; ai < 2; ++ai) {
#pragma unroll
            for (int m = 0; m < 4; ++m) {
                float ss = 0.f;
#pragma unroll
                for (int bj = 0; bj < 2; ++bj) {
                    const size_t off = (size_t)(row0 + ai * 128 + m * 16) * DM + col0 + bj * 128;
                    f32x4 r0, r1;
                    if (base) { r0 = *(const f32x4*)(base + off); r1 = *(const f32x4*)(base + off + 4); } else unpack8(*(const u32x4*)(base16 + off), r0, r1);
                    const f32x4 x0 = r0 + acc[ai][bj][m][0], x1 = r1 + acc[ai][bj][m][1];
                    acc[ai][bj][m][0] = x0; acc[ai][bj][m][1] = x1;
                    ss += (x0.x * x0.x + x0.y * x0.y) + (x0.z * x0.z + x0.w * x0.w) + (x1.x * x1.x + x1.y * x1.y) + (x1.z * x1.z + x1.w * x1.w);
                }
                ss += __shfl_xor(ss, 16); ss += __shfl_xor(ss, 32);
                if (fq == 0) P[(rl0 + ai * 128 + m * 16) * 4 + wc] = ss;
            }
            asm volatile("" ::: "memory");
        }
        asm volatile("s_waitcnt lgkmcnt(0)" ::: "memory"); __builtin_amdgcn_s_barrier(); asm volatile("" ::: "memory");
        const int rowt = wid * 64 + lane;
        if (wid < 4) {
            const f32x4 p = *(const LAS f32x4*)(P + rowt * 4);
            __hip_atomic_store(xbuf + (size_t)(u.pm * 256 + rowt) * 4 + u.pn, (p.x + p.y) + (p.z + p.w), __ATOMIC_RELAXED, __HIP_MEMORY_SCOPE_AGENT);
        }
        asm volatile("s_waitcnt vmcnt(0)" ::: "memory");
        if (lane == 0) __hip_atomic_fetch_add(cnt + 64 * u.pm, 1u, __ATOMIC_RELAXED, __HIP_MEMORY_SCOPE_AGENT);
        if (wid == 0) {
            unsigned sp = 0u;
            for (;;) {
                if ((unsigned)__builtin_amdgcn_readfirstlane(__hip_atomic_load(cnt + 64 * u.pm, __ATOMIC_RELAXED, __HIP_MEMORY_SCOPE_AGENT)) >= 32u) break;
                __builtin_amdgcn_s_sleep(2);
                if (++sp > (1u << 20)) break;
            }
            __builtin_amdgcn_fence(__ATOMIC_ACQUIRE, "agent");
            if (lane == 0) flag[0] = 1u;
        }
        asm volatile("s_waitcnt vmcnt(0) lgkmcnt(0)" ::: "memory"); __builtin_amdgcn_s_barrier(); asm volatile("" ::: "memory");
        if (wid < 4) {
            const float* sl = xbuf + (size_t)(u.pm * 256 + rowt) * 4;
            const float s = (__hip_atomic_load(sl, __ATOMIC_RELAXED, __HIP_MEMORY_SCOPE_AGENT) + __hip_atomic_load(sl + 1, __ATOMIC_RELAXED, __HIP_MEMORY_SCOPE_AGENT))
                          + (__hip_atomic_load(sl + 2, __ATOMIC_RELAXED, __HIP_MEMORY_SCOPE_AGENT) + __hip_atomic_load(sl + 3, __ATOMIC_RELAXED, __HIP_MEMORY_SCOPE_AGENT));
            S[rowt] = rsqrtf(s * (1.f / DM) + EPS);
        }
        asm volatile("s_waitcnt vmcnt(0) lgkmcnt(0)" ::: "memory"); __builtin_amdgcn_s_barrier(); asm volatile("" ::: "memory");
#pragma unroll
        for (int bj = 0; bj < 2; ++bj) {
            const f32x4 g0 = *(const f32x4*)(gain + col0 + bj * 128), g1 = *(const f32x4*)(gain + col0 + bj * 128 + 4);
#pragma unroll
            for (int ai = 0; ai < 2; ++ai)
#pragma unroll
                for (int m = 0; m < 4; ++m) {
                    const float rs = S[rl0 + ai * 128 + m * 16];
                    const size_t off = (size_t)(row0 + ai * 128 + m * 16) * DM + col0 + bj * 128;
                    const f32x4 y0 = acc[ai][bj][m][0] * rs * g0, y1 = acc[ai][bj][m][1] * rs * g1;
                    if (XOUT) *(u32x4*)(XOUT + off) = pack8(acc[ai][bj][m][0], acc[ai][bj][m][1]);
                    if (HN) *(u32x4*)(HN + off) = pack8(y0, y1);
                    if (NOUT) { *(f32x4*)(NOUT + off) = y0; *(f32x4*)(NOUT + off + 4) = y1; }
                }
        }
        asm volatile("s_waitcnt lgkmcnt(0)" ::: "memory"); __builtin_amdgcn_s_barrier(); asm volatile("" ::: "memory");
    }
    __device__ __forceinline__ void operator()(const f32x4 (&)[2][2][4][2], const pg8::Unit&, int, int, int, int) const {}
};

typedef float f32x16 __attribute__((ext_vector_type(16)));
__device__ __forceinline__ float gelu_tanh(float x) { const float u = 0.7978845608028654f * (x + 0.044715f * x * x * x); const float e = __expf(2.f * u); const float th = 1.f - 2.f * __builtin_amdgcn_rcpf(e + 1.f); return 0.5f * x * (1.f + th); }
constexpr int S5_XSTR = 272;
constexpr int S5_WAVE_LDS = 2 * 16 * S5_XSTR;
constexpr int S5_YSTR = 528;
constexpr int S5_YOFF = NWAVES * S5_WAVE_LDS;
template <bool OUT, bool TOLDS>
__device__ __forceinline__ void s5_task(Frame& F, int l, int pp, int g, LAS unsigned char* XL, LAS unsigned char* YL, const bf16_t* ZSp, const float* SPp, f32x2* S5Ep,
                                        const float* c_re, const float* c_im, const float* ssm_d) {
    {
        int lane = F.lane; asm volatile("" : "+v"(lane));
        const int n = lane & 31, hh = lane >> 5, l15 = lane & 15, kg = lane >> 4;
        const int cmine = 2 * pp + hh;
        bf16x8 bbf[2][2];
#pragma unroll
        for (int st = 0; st < 2; ++st) { const float* br = SPp + SP_BBR + (size_t)(g * 64 + 2 * n + st) * 16 + 8 * hh; const float* bi = SPp + SP_BBI + (size_t)(g * 64 + 2 * n + st) * 16 + 8 * hh;
            bbf[st][0] = __builtin_bit_cast(bf16x8, pack8(*(const f32x4*)br, *(const f32x4*)(br + 4))); bbf[st][1] = __builtin_bit_cast(bf16x8, pack8(*(const f32x4*)bi, *(const f32x4*)(bi + 4))); }
        const f32x4 lb = *(const f32x4*)(SPp + SP_LB + (g * 64 + 2 * n) * 2);
        f32x4 x = {0.f, 0.f, 0.f, 0.f};
        if constexpr (OUT) x = *(const f32x4*)(S5Ep + (size_t)(cmine * 16 + g) * 64 + 2 * n);
        bf16x8 cf[4]; f32x4 dsk = {0.f, 0.f, 0.f, 0.f};
        if constexpr (OUT) {
#pragma unroll
            for (int ks = 0; ks < 4; ++ks) { const float* cp = ((ks < 2) ? c_re : c_im) + ((size_t)(l * 16 + g) * 16 + l15) * 64 + 32 * (ks & 1) + 8 * kg;
                f32x4 a = *(const f32x4*)cp, b = *(const f32x4*)(cp + 4); if (ks >= 2) { a = -a; b = -b; }
                cf[ks] = __builtin_bit_cast(bf16x8, pack8(a, b)); }
            dsk = *(const f32x4*)(ssm_d + (l * 16 + g) * 16 + 4 * kg);
        }
        const bf16_t* urow = ZSp + (size_t)((2 * pp + ((n >> 2) & 1)) * 64 + 4 * (n >> 3) + (n & 3)) * ZSW + ZU + g * 16 + 8 * hh;
#pragma unroll 1
        for (int k = 0; k < 4; ++k) {
            const bf16x8 uf = *(const bf16x8*)(urow + (size_t)(16 * k) * ZSW);
            const f32x16 z16 = {0.f, 0.f, 0.f, 0.f, 0.f, 0.f, 0.f, 0.f, 0.f, 0.f, 0.f, 0.f, 0.f, 0.f, 0.f, 0.f};
            const f32x16 r0 = __builtin_amdgcn_mfma_f32_32x32x16_bf16(uf, bbf[0][0], z16, 0, 0, 0), i0 = __builtin_amdgcn_mfma_f32_32x32x16_bf16(uf, bbf[0][1], z16, 0, 0, 0);
            const f32x16 r1 = __builtin_amdgcn_mfma_f32_32x32x16_bf16(uf, bbf[1][0], z16, 0, 0, 0), i1 = __builtin_amdgcn_mfma_f32_32x32x16_bf16(uf, bbf[1][1], z16, 0, 0, 0);
#pragma unroll
            for (int t = 0; t < 16; ++t) {
                const float nr0 = lb.x * x.x - lb.y * x.y + r0[t], ni0 = lb.x * x.y + lb.y * x.x + i0[t];
                const float nr1 = lb.z * x.z - lb.w * x.w + r1[t], ni1 = lb.z * x.w + lb.w * x.z + i1[t];
                x = (f32x4){nr0, ni0, nr1, ni1};
                if constexpr (OUT) { LAS unsigned* xw = (LAS unsigned*)(XL + (hh * 16 + t) * S5_XSTR + 4 * n); xw[0] = pk2(nr0, nr1); xw[32] = pk2(ni0, ni1); }
            }
            if constexpr (OUT) {
                asm volatile("s_waitcnt lgkmcnt(0)" ::: "memory");
#pragma unroll
                for (int sel = 0; sel < 2; ++sel) {
                    f32x4 y = {0.f, 0.f, 0.f, 0.f};
#pragma unroll
                    for (int ks = 0; ks < 4; ++ks) { const bf16x8 xf = *(const LAS bf16x8*)(XL + (sel * 16 + l15) * S5_XSTR + (32 * ks + 8 * kg) * 2); y = __builtin_amdgcn_mfma_f32_16x16x32_bf16(cf[ks], xf, y, 0, 0, 0); }
                    const size_t tok = (size_t)(2 * pp + sel) * 64 + 16 * k + l15;
                    const u32x2 uw = *(const u32x2*)(ZSp + tok * ZSW + ZU + g * 16 + 4 * kg);
                    const float y0 = gelu_tanh(y.x + dsk.x * bflo(uw.x)), y1 = gelu_tanh(y.y + dsk.y * bfhi(uw.x)), y2 = gelu_tanh(y.z + dsk.z * bflo(uw.y)), y3 = gelu_tanh(y.w + dsk.w * bfhi(uw.y));
                    if constexpr (TOLDS) *(LAS u32x2*)(YL + (sel * 64 + 16 * k + l15) * S5_YSTR + (g * 16 + 4 * kg) * 2) = (u32x2){pk2(y0, y1), pk2(y2, y3)};
                    else *(u32x2*)(F.H() + tok * DM + g * 16 + 4 * kg) = (u32x2){pk2(y0, y1), pk2(y2, y3)};
                }
                asm volatile("s_waitcnt lgkmcnt(0)" ::: "memory");
            }
        }
        if constexpr (!OUT) *(f32x4*)(S5Ep + (size_t)(cmine * 16 + g) * 64 + 2 * n) = x;
    }
}
template <bool OUT>
__device__ __forceinline__ void s5_pass(Frame& F, int l, const float* c_re, const float* c_im, const float* ssm_d) {
    const bf16_t* ZSp = F.ZS(); const float* SPp = F.SP(l); f32x2* S5Ep = F.S5E();
    LAS unsigned char* XL = F.lds + F.wave * S5_WAVE_LDS;
    for (int task = F.bid * NWAVES + F.wave; task < 256 * 16; task += F.G * NWAVES) s5_task<OUT, false>(F, l, task >> 4, task & 15, XL, nullptr, ZSp, SPp, S5Ep, c_re, c_im, ssm_d);
}
__device__ __forceinline__ void phase_s5_out_glu(Frame& F, int l, const float* c_re, const float* c_im, const float* ssm_d, const bf16_t* WgT, const float* gbias) {
    const bf16_t* ZSp = F.ZS(); const float* SPp = F.SP(l); f32x2* S5Ep = F.S5E();
    LAS unsigned char* XL = F.lds + F.wave * S5_WAVE_LDS;
    LAS unsigned char* YL = F.lds + S5_YOFF;
    for (int pp = F.bid; pp < 256; pp += F.G) {
        s5_task<true, true>(F, l, pp, F.wave, XL, YL, ZSp, SPp, S5Ep, c_re, c_im, ssm_d);
        s5_task<true, true>(F, l, pp, F.wave + 8, XL, YL, ZSp, SPp, S5Ep, c_re, c_im, ssm_d);
        asm volatile("s_waitcnt lgkmcnt(0)" ::: "memory"); __syncthreads();
        int lane = F.lane; asm volatile("" : "+v"(lane));
        const int l15 = lane & 15, kg = lane >> 4, w = F.wave;
        bf16x8 wf[2][8];
#pragma unroll
        for (int nt = 0; nt < 2; ++nt)
#pragma unroll
            for (int ks = 0; ks < 8; ++ks) wf[nt][ks] = *(const bf16x8*)(WgT + (size_t)(32 * w + 16 * nt + l15) * 256 + 32 * ks + 8 * kg);
        f32x4 bz[2];
#pragma unroll
        for (int nt = 0; nt < 2; ++nt) bz[nt] = *(const f32x4*)(gbias + 32 * w + 16 * nt + 4 * kg);
#pragma unroll 2
        for (int mt = 0; mt < 8; ++mt) {
            f32x4 acc[2] = {{0.f, 0.f, 0.f, 0.f}, {0.f, 0.f, 0.f, 0.f}};
#pragma unroll
            for (int ks = 0; ks < 8; ++ks) {
                const bf16x8 yf = *(const LAS bf16x8*)(YL + (16 * mt + l15) * S5_YSTR + (32 * ks + 8 * kg) * 2);
                acc[0] = __builtin_amdgcn_mfma_f32_16x16x32_bf16(wf[0][ks], yf, acc[0], 0, 0, 0);
                acc[1] = __builtin_amdgcn_mfma_f32_16x16x32_bf16(wf[1][ks], yf, acc[1], 0, 0, 0);
            }
            const size_t tok = (size_t)pp * 128 + 16 * mt + l15;
#pragma unroll
            for (int nt = 0; nt < 2; ++nt) {
                const int col = 32 * w + 16 * nt + 4 * kg;
                const u32x2 yw = *(const LAS u32x2*)(YL + (16 * mt + l15) * S5_YSTR + col * 2);
                const f32x4 z = acc[nt] + bz[nt];
                const float o0 = bflo(yw.x) * sigmoidf_(z.x), o1 = bfhi(yw.x) * sigmoidf_(z.y), o2 = bflo(yw.y) * sigmoidf_(z.z), o3 = bfhi(yw.y) * sigmoidf_(z.w);
                *(u32x2*)(F.H() + tok * DM + col) = (u32x2){pk2(o0, o1), pk2(o2, o3)};
            }
        }
        asm volatile("s_waitcnt lgkmcnt(0)" ::: "memory"); __syncthreads();
    }
}
__device__ __forceinline__ void phase_s5_local(Frame& F, int l) {
#ifdef NO_PHASE_S5_LOCAL
    return;
#endif
    s5_pass<false>(F, l, nullptr, nullptr, nullptr);
}
__device__ __forceinline__ void phase_s5_out(Frame& F, int l, const float* c_re, const float* c_im, const float* ssm_d) {
#ifdef NO_PHASE_S5_OUT
    return;
#endif
    s5_pass<true>(F, l, c_re, c_im, ssm_d);
}

__device__ __forceinline__ void phase_carry(Frame& F, int l) {
#ifdef NO_PHASE_CARRY
    return;
#endif
    const float* SPp = F.SP(l); f32x2* S5Ep = F.S5E(); float* RSTp = F.RST();
    const int gw = F.bid * NWAVES + F.wave, NGW = F.G * NWAVES;
    for (int task = gw; task < NB * 16; task += NGW) {
        const int b = task >> 4, g = task & 15, p = F.lane;
        const float ar = SPp[SP_L64 + (g * 64 + p) * 2], ai = SPp[SP_L64 + (g * 64 + p) * 2 + 1];
        float sr = 0.f, si = 0.f;
        for (int c0 = 0; c0 < 128; c0 += 16) {
            f32x2 e[16];
#pragma unroll
            for (int j = 0; j < 16; ++j) e[j] = S5Ep[(size_t)((b * 128 + c0 + j) * 16 + g) * 64 + p];
#pragma unroll
            for (int j = 0; j < 16; ++j) { S5Ep[(size_t)((b * 128 + c0 + j) * 16 + g) * 64 + p] = (f32x2){sr, si}; const float nr = ar * sr - ai * si + e[j].x, ni = ar * si + ai * sr + e[j].y; sr = nr; si = ni; }
        }
    }
    const int NT = F.G * NTHREADS;
    for (int gt = F.bid * NTHREADS + F.tid; gt < NB * 4 * 4608; gt += NT) {
        const int b = gt / (4 * 4608), h = (gt / 4608) & 3, el = gt % 4608;
        const float lg = log1pf(-exp2f(-5.f - (float)h));
        const float cdec = expf(lg * 64.f);
        float s = 0.f;
        for (int c0 = 0; c0 < 128; c0 += 16) {
            float d[16];
#pragma unroll
            for (int j = 0; j < 16; ++j) d[j] = RSTp[(size_t)((b * 128 + c0 + j) * 4 + h) * 4608 + el];
#pragma unroll
            for (int j = 0; j < 16; ++j) { RSTp[(size_t)((b * 128 + c0 + j) * 4 + h) * 4608 + el] = s; s = s * cdec + d[j]; }
        }
    }
}

typedef float f32x16 __attribute__((ext_vector_type(16)));
typedef short s16x4 __attribute__((ext_vector_type(4)));
__device__ __forceinline__ bf16x8 tr8(const LAS unsigned char* a0, const LAS unsigned char* a1) {
    const s16x4 lo = __builtin_bit_cast(s16x4, __builtin_amdgcn_ds_read_tr16_b64_v4i16((LAS s16x4*)a0));
    const s16x4 hi = __builtin_bit_cast(s16x4, __builtin_amdgcn_ds_read_tr16_b64_v4i16((LAS s16x4*)a1));
    return (bf16x8){lo[0], lo[1], lo[2], lo[3], hi[0], hi[1], hi[2], hi[3]};
}
__device__ __forceinline__ bf16x8 pack8f(const f32x4& a, const f32x4& b) { return __builtin_bit_cast(bf16x8, pack8(a, b)); }
__device__ __forceinline__ void ret_stage_v(const bf16_t* ZSp, LAS unsigned char* Vb, int tok0, int h, int lane) {
#pragma unroll
    for (int n = 0; n < 12; ++n) { const int o = n * 1024 + 16 * lane, r = o / 192, ch = (o % 192) >> 4;
        __builtin_amdgcn_global_load_lds((const unsigned*)(ZSp + (size_t)(tok0 + r) * ZSW + ZRV + h * 96 + ch * 8), (LAS unsigned*)(Vb + n * 1024), 16, 0, 0); }
}
constexpr int RET_VB = 12288, RET_KSTR = 112, RET_WAVE_LDS = RET_VB + 64 * RET_KSTR;
__device__ __forceinline__ void phase_ret_local(Frame& F) {
#ifdef NO_PHASE_RET_LOCAL
    return;
#endif
    const bf16_t* ZSp = F.ZS(); float* RSTp = F.RST();
    LAS unsigned char* Vb = F.lds + F.wave * RET_WAVE_LDS; LAS unsigned char* Kb = Vb + RET_VB;
    for (int item = F.bid * NWAVES + F.wave; item < 2048; item += F.G * NWAVES) {
        int lane = F.lane; asm volatile("" : "+v"(lane));
        const int l31 = lane & 31, hh = lane >> 5, g1 = (lane >> 4) & 1, q4 = (lane & 15) >> 2, p4 = lane & 3;
        const int h = item & 3, tok0 = (item >> 2) * 64;
        ret_stage_v(ZSp, Vb, tok0, h, lane);
        const float lg2 = log2f(1.f - exp2f(-5.f - (float)h));
#pragma unroll
        for (int n = 0; n < 6; ++n) { const int idx = n * 64 + lane, r = idx / 6, ch = idx % 6;
            f32x4 a, b; unpack8(*(const u32x4*)(ZSp + (size_t)(tok0 + r) * ZSW + ZRK + h * 48 + ch * 8), a, b);
            const float sc = 0.14433756729740643f * exp2f(lg2 * (float)(63 - r));
            *(LAS u32x4*)(Kb + r * RET_KSTR + ch * 16) = pack8(a * sc, b * sc); }
        asm volatile("s_waitcnt vmcnt(0) lgkmcnt(0)" ::: "memory");
        f32x16 acc[3][2];
#pragma unroll
        for (int me = 0; me < 3; ++me)
#pragma unroll
            for (int nt = 0; nt < 2; ++nt) acc[me][nt] = (f32x16){0.f, 0.f, 0.f, 0.f, 0.f, 0.f, 0.f, 0.f, 0.f, 0.f, 0.f, 0.f, 0.f, 0.f, 0.f, 0.f};
#pragma unroll
        for (int s = 0; s < 4; ++s) {
            const int r0 = 16 * s + 8 * hh + q4;
            bf16x8 kf[2], vf[3];
#pragma unroll
            for (int nt = 0; nt < 2; ++nt) { const LAS unsigned char* a0 = Kb + r0 * RET_KSTR + (32 * nt + 16 * g1 + 4 * p4) * 2; kf[nt] = tr8(a0, a0 + 4 * RET_KSTR); }
#pragma unroll
            for (int me = 0; me < 3; ++me) { const LAS unsigned char* a0 = Vb + r0 * 192 + (32 * me + 16 * g1 + 4 * p4) * 2; vf[me] = tr8(a0, a0 + 4 * 192); }
#pragma unroll
            for (int me = 0; me < 3; ++me)
#pragma unroll
                for (int nt = 0; nt < 2; ++nt) acc[me][nt] = __builtin_amdgcn_mfma_f32_32x32x16_bf16(vf[me], kf[nt], acc[me][nt], 0, 0, 0);
        }
        float* dst = RSTp + (size_t)item * 4608 + (4 * hh) * 48 + l31;
#pragma unroll
        for (int me = 0; me < 3; ++me)
#pragma unroll
            for (int r4 = 0; r4 < 4; ++r4) {
                int zz = 0; asm volatile("" : "+v"(zz)); float* dp = dst + (32 * me + 8 * r4) * 48 + zz;
#pragma unroll
                for (int k = 0; k < 4; ++k) { dp[k * 48] = acc[me][0][4 * r4 + k]; if (l31 < 16) dp[k * 48 + 32] = acc[me][1][4 * r4 + k]; }
            }
        asm volatile("s_waitcnt lgkmcnt(0)" ::: "memory");
    }
}
__device__ __forceinline__ void phase_ret_out(Frame& F, int l, const float* ret_norm_g) {
#ifdef NO_PHASE_RET_OUT
    return;
#endif
    const bf16_t* ZSp = F.ZS(); const float* RSTp = F.RST();
    LAS unsigned char* Vb = F.lds + F.wave * RET_WAVE_LDS;
    for (int item = F.bid * NWAVES + F.wave; item < 2048; item += F.G * NWAVES) {
        int lane = F.lane; asm volatile("" : "+v"(lane));
        const int l31 = lane & 31, hh = lane >> 5, g1 = (lane >> 4) & 1, q4 = (lane & 15) >> 2, p4 = lane & 3;
        const int h = item & 3, tok0 = (item >> 2) * 64;
        ret_stage_v(ZSp, Vb, tok0, h, lane);
        const float lg2 = log2f(1.f - exp2f(-5.f - (float)h));
        bf16x8 qf[2][3], kf[2][3];
#pragma unroll
        for (int t = 0; t < 2; ++t)
#pragma unroll
            for (int ks = 0; ks < 3; ++ks) { const size_t ro = (size_t)(tok0 + 32 * t + l31) * ZSW + h * 48 + 8 * hh + 16 * ks;
                qf[t][ks] = *(const bf16x8*)(ZSp + ro + ZRQ); kf[t][ks] = *(const bf16x8*)(ZSp + ro + ZRK); }
        bf16x8 pm[2][4];
#pragma unroll
        for (int mt = 0; mt < 2; ++mt)
#pragma unroll
            for (int nt = mt; nt < 2; ++nt) {
                f32x16 p = {0.f, 0.f, 0.f, 0.f, 0.f, 0.f, 0.f, 0.f, 0.f, 0.f, 0.f, 0.f, 0.f, 0.f, 0.f, 0.f};
#pragma unroll
                for (int ks = 0; ks < 3; ++ks) p = __builtin_amdgcn_mfma_f32_32x32x16_bf16(kf[mt][ks], qf[nt][ks], p, 0, 0, 0);
                const int i = 32 * nt + l31;
#pragma unroll
                for (int r = 0; r < 16; ++r) { const int j = 32 * mt + (r & 3) + 8 * (r >> 2) + 4 * hh;
                    p[r] = (i >= j) ? p[r] * (0.14433756729740643f * exp2f(lg2 * (float)(i - j))) : 0.f; }
                pm[nt][2 * mt + 0] = pack8f((f32x4){p[0], p[1], p[2], p[3]}, (f32x4){p[4], p[5], p[6], p[7]});
                pm[nt][2 * mt + 1] = pack8f((f32x4){p[8], p[9], p[10], p[11]}, (f32x4){p[12], p[13], p[14], p[15]});
            }
        f32x16 ot[3][2];
#pragma unroll
        for (int me = 0; me < 3; ++me) {
            bf16x8 sf[3];
            int zz = 0; asm volatile("" : "+v"(zz)); const float* sp0 = RSTp + (size_t)item * 4608 + (32 * me + l31) * 48 + 8 * hh + zz;
#pragma unroll
            for (int ks = 0; ks < 3; ++ks) { const float* sp = sp0 + 16 * ks; sf[ks] = pack8f(*(const f32x4*)sp, *(const f32x4*)(sp + 4)); }
#pragma unroll
            for (int nt = 0; nt < 2; ++nt) {
                f32x16 a = {0.f, 0.f, 0.f, 0.f, 0.f, 0.f, 0.f, 0.f, 0.f, 0.f, 0.f, 0.f, 0.f, 0.f, 0.f, 0.f};
#pragma unroll
                for (int ks = 0; ks < 3; ++ks) a = __builtin_amdgcn_mfma_f32_32x32x16_bf16(sf[ks], qf[nt][ks], a, 0, 0, 0);
                const float qd = exp2f(lg2 * (float)(32 * nt + l31 + 1));
                ot[me][nt] = a * qd;
            }
        }
        asm volatile("s_waitcnt vmcnt(0)" ::: "memory");
#pragma unroll
        for (int s = 0; s < 4; ++s) {
            const int r0 = 16 * s + 4 * hh + q4;
#pragma unroll
            for (int me = 0; me < 3; ++me) {
                const LAS unsigned char* a0 = Vb + r0 * 192 + (32 * me + 16 * g1 + 4 * p4) * 2;
                const bf16x8 vf = tr8(a0, a0 + 8 * 192);
                if (s < 2) ot[me][0] = __builtin_amdgcn_mfma_f32_32x32x16_bf16(vf, pm[0][s], ot[me][0], 0, 0, 0);
                ot[me][1] = __builtin_amdgcn_mfma_f32_32x32x16_bf16(vf, pm[1][s], ot[me][1], 0, 0, 0);
            }
        }
#pragma unroll
        for (int nt = 0; nt < 2; ++nt) {
            float sum = 0.f;
#pragma unroll
            for (int me = 0; me < 3; ++me)
#pragma unroll
                for (int r = 0; r < 16; ++r) sum += ot[me][nt][r];
            sum += __shfl_xor(sum, 32);
            const float mu = sum * (1.f / 96.f); float q2 = 0.f;
#pragma unroll
            for (int me = 0; me < 3; ++me)
#pragma unroll
                for (int r = 0; r < 16; ++r) { const float d = ot[me][nt][r] - mu; q2 += d * d; }
            q2 += __shfl_xor(q2, 32);
            const float rs = rsqrtf(q2 * (1.f / 96.f) + EPS);
            const int tok = tok0 + 32 * nt + l31;
            const bf16_t* gbase = ZSp + (size_t)tok * ZSW + ZRG + h * 96 + 4 * hh; const float* nbase = ret_norm_g + l * 384 + h * 96 + 4 * hh; bf16_t* obase = F.H() + (size_t)tok * DM + 640 + h * 96 + 4 * hh;
#pragma unroll
            for (int me = 0; me < 3; ++me) {
                int zz = 0; asm volatile("" : "+v"(zz));
                const bf16_t* gp = gbase + 32 * me + zz; const float* np = nbase + 32 * me + zz; bf16_t* op = obase + 32 * me + zz;
#pragma unroll
                for (int r4 = 0; r4 < 4; ++r4) {
                    const u32x2 gw = *(const u32x2*)(gp + 8 * r4);
                    const f32x4 ng = *(const f32x4*)(np + 8 * r4);
                    const float g0 = bflo(gw.x), g1f = bfhi(gw.x), g2 = bflo(gw.y), g3 = bfhi(gw.y);
                    const float y0 = (ot[me][nt][4 * r4 + 0] - mu) * rs * ng.x * (g0 * sigmoidf_(g0)), y1 = (ot[me][nt][4 * r4 + 1] - mu) * rs * ng.y * (g1f * sigmoidf_(g1f));
                    const float y2 = (ot[me][nt][4 * r4 + 2] - mu) * rs * ng.z * (g2 * sigmoidf_(g2)), y3 = (ot[me][nt][4 * r4 + 3] - mu) * rs * ng.w * (g3 * sigmoidf_(g3));
                    *(u32x2*)(op + 8 * r4) = (u32x2){pk2(y0, y1), pk2(y2, y3)};
                }
            }
        }
        asm volatile("s_waitcnt lgkmcnt(0)" ::: "memory");
    }
}

typedef _Float16 f16_t;
__device__ __forceinline__ u32x4 zero4() { unsigned z = 0u; asm volatile("" : "+v"(z)); return (u32x4){z, z, z, z}; }
__device__ __forceinline__ int lanes_below(unsigned long long m) { return (int)__builtin_amdgcn_mbcnt_hi((unsigned)(m >> 32), __builtin_amdgcn_mbcnt_lo((unsigned)m, 0u)); }
__device__ __forceinline__ float relu1(float x) { return __builtin_amdgcn_fmed3f(x, 0.f, __builtin_inff()); }
__device__ __forceinline__ unsigned sortable_f16(float sc) {
    const f16_t h = (f16_t)sc; const unsigned u = (unsigned)__builtin_bit_cast(unsigned short, h), mag = u & 0x7fffu;
    return (u & 0x8000u) ? (0x8000u - mag) : (0x8000u + mag);
}
__device__ __forceinline__ int sc_pos(int k) { return k; }
__device__ __forceinline__ int wave_incl_scan(int x) {
    x += __builtin_amdgcn_update_dpp(0, x, 0x111, 0xf, 0xf, true);
    x += __builtin_amdgcn_update_dpp(0, x, 0x112, 0xf, 0xf, true);
    x += __builtin_amdgcn_update_dpp(0, x, 0x114, 0xf, 0xf, true);
    x += __builtin_amdgcn_update_dpp(0, x, 0x118, 0xf, 0xf, true);
    x += __builtin_amdgcn_update_dpp(0, x, 0x142, 0xa, 0xf, false);
    x += __builtin_amdgcn_update_dpp(0, x, 0x143, 0xc, 0xf, false);
    return x;
}
__device__ __forceinline__ int wave_suffix_sum(int v, int lane) { const int p = wave_incl_scan(v); return __builtin_amdgcn_readlane(p, 63) - p + v; }
__device__ __forceinline__ void hist_threshold(const u32x4 c, int need, int lane, int& B, int& above) {
    const int s = (int)(c.x + c.y + c.z + c.w);
    const int S = wave_suffix_sum(s, lane);
    int a = S - s;
    const bool found = (a < need) && (S >= need);
    int Bl = 0, al = 0;
    if (found) {
        if (a + (int)c.w >= need) { Bl = 4 * lane + 3; al = a; }
        else { a += (int)c.w; if (a + (int)c.z >= need) { Bl = 4 * lane + 2; al = a; }
        else { a += (int)c.z; if (a + (int)c.y >= need) { Bl = 4 * lane + 1; al = a; }
        else { a += (int)c.y; Bl = 4 * lane; al = a; } } }
    }
    const unsigned long long m = __ballot(found);
    const int src = m ? (int)__builtin_ctzll(m) : 0;
    B = __builtin_amdgcn_readlane(Bl, src); above = __builtin_amdgcn_readlane(al, src);
}

#ifndef DSA_CAND
#define DSA_CAND 0
#endif
#ifndef DSA_DUP
#define DSA_DUP 0
#endif
constexpr int DSA_ROW = 16384;
__device__ __forceinline__ void phase_dsa(Frame& F) {
#ifdef NO_PHASE_DSA
    return;
#endif
    const int wave = F.wave;
    const bf16_t* ZSp = F.ZS(); const float* IWp = F.IW(); const bf16_t* IKp = F.IKD();
    LAS unsigned char* SCb = F.lds;
    for (int it = F.bid; it < 512; it += F.G) {
        int lane = F.lane; asm volatile("" : "+v"(lane));
        const int hi = lane >> 5, n32 = lane & 31;
        LAS unsigned short* LSTw = (LAS unsigned short*)(F.lds + 131072) + wave * 256;
        LAS unsigned char* WB = F.lds + 135168 + wave * 3520;
        LAS unsigned* H1 = (LAS unsigned*)WB; LAS unsigned* H2 = H1 + 256;
        LAS unsigned* DUM = (LAS unsigned*)(WB + 3264) + lane;
        LAS unsigned short* CK = (LAS unsigned short*)(WB + 1024); LAS unsigned short* CI = (LAS unsigned short*)(WB + 2144);
        const char* ZSu; { const unsigned long long zp = (unsigned long long)ZSp; const unsigned zl = __builtin_amdgcn_readfirstlane((unsigned)zp), zh = __builtin_amdgcn_readfirstlane((unsigned)(zp >> 32));
            ZSu = (const char*)(((unsigned long long)zh << 32) | zl); }
        LAS unsigned* OFFw = (LAS unsigned*)(WB + 2048);
        const int pr = it & 255, vcu = (pr & 7) * 32 + (pr >> 3);
        const int b = vcu >> 6, cc = vcu & 63, c = (it < 256) ? cc : 127 - cc;
        const int V = (c + 1) * 64, tokq0 = b * SEQ + c * 64, kb0 = b * SEQ;
        const int Keff = V < 256 ? V : 256;
        const int nblk = (V + 511) >> 9, ntile_all = nblk * 16, ntile_real = V >> 5;
        for (int qg = 0; qg < 8; ++qg) {
            const int tq0 = tokq0 + qg * 8;
#ifndef DSA_NO_A
            for (int repA = 0; repA < 1 + (DSA_DUP & 1); ++repA) {
                bf16x8 aq[2];
                { const int qq = n32 >> 2, hd = n32 & 3; const bf16_t* qp = ZSp + (size_t)(tq0 + qq) * ZSW + ZIQ + hd * 32 + 8 * hi;
                  aq[0] = *(const bf16x8*)qp; aq[1] = *(const bf16x8*)(qp + 16); }
                float wq[4][4];
#pragma unroll
                for (int jq = 0; jq < 4; ++jq) { const f32x4 w4 = *(const f32x4*)(IWp + (size_t)(tq0 + 2 * jq + hi) * 4);
                    wq[jq][0] = w4.x * 0.08838834764831845f; wq[jq][1] = w4.y * 0.08838834764831845f; wq[jq][2] = w4.z * 0.08838834764831845f; wq[jq][3] = w4.w * 0.08838834764831845f; }
                bf16x8 fr[2][4][2];
                const int nb = (ntile_all - wave + 31) >> 5;
#define DSA_ALOAD(buf, bt) do { int zz = 0; asm volatile("" : "+v"(zz)); _Pragma("unroll") for (int u = 0; u < 4; ++u) { const int tt = wave + 8 * (4 * (bt) + u); \
        if (tt < ntile_real) { const bf16_t* kp = IKp + ((size_t)(((kb0 >> 5) + tt) * 4 + hi) * 32 + n32 + zz) * 8; fr[buf][u][0] = *(const bf16x8*)kp; fr[buf][u][1] = *(const bf16x8*)(kp + 512); } } } while (0)
#define DSA_ACOMP(buf, bt) do { _Pragma("unroll") for (int u = 0; u < 4; ++u) { const int tt = wave + 8 * (4 * (bt) + u); \
        if (tt < ntile_all) { unsigned short us[4] = {0, 0, 0, 0}; \
            if (tt < ntile_real) { f32x16 acc = {0.f, 0.f, 0.f, 0.f, 0.f, 0.f, 0.f, 0.f, 0.f, 0.f, 0.f, 0.f, 0.f, 0.f, 0.f, 0.f}; \
                acc = __builtin_amdgcn_mfma_f32_32x32x16_bf16(aq[0], fr[buf][u][0], acc, 0, 0, 0); acc = __builtin_amdgcn_mfma_f32_32x32x16_bf16(aq[1], fr[buf][u][1], acc, 0, 0, 0); \
                _Pragma("unroll") for (int jq = 0; jq < 4; ++jq) { \
                    const float sc = relu1(acc[4 * jq + 0]) * wq[jq][0] + relu1(acc[4 * jq + 1]) * wq[jq][1] + relu1(acc[4 * jq + 2]) * wq[jq][2] + relu1(acc[4 * jq + 3]) * wq[jq][3]; \
                    us[jq] = (unsigned short)sortable_f16(sc); } } \
            const int pos = sc_pos(tt * 32 + n32); \
            _Pragma("unroll") for (int jq = 0; jq < 4; ++jq) *(LAS unsigned short*)(SCb + (2 * jq + hi) * DSA_ROW + pos * 2) = us[jq]; } } } while (0)
                DSA_ALOAD(0, 0);
                for (int bp = 0; bp < nb; bp += 2) {
                    if (bp + 1 < nb) DSA_ALOAD(1, bp + 1);
                    DSA_ACOMP(0, bp);
                    if (bp + 2 < nb) DSA_ALOAD(0, bp + 2);
                    if (bp + 1 < nb) DSA_ACOMP(1, bp + 1);
                }
#undef DSA_ALOAD
#undef DSA_ACOMP
            }
#endif
            __syncthreads();
            LAS unsigned char* row = SCb + wave * DSA_ROW;
#ifndef DSA_NO_B
            for (int repB = 0; repB < 1 + ((DSA_DUP >> 1) & 1); ++repB)
            if (V > 256) {
                *(LAS u32x4*)(H1 + 4 * lane) = zero4(); *(LAS u32x4*)(H2 + 4 * lane) = zero4();
                u32x4 rw[4];
#define DSA_LD8(hf) do { _Pragma("unroll") for (int i = 0; i < 4; ++i) if (4 * (hf) + i < nblk) rw[i] = *(const LAS u32x4*)(row + (512 * (4 * (hf) + i) + 8 * lane) * 2); \
        asm volatile("s_waitcnt lgkmcnt(0)" ::: "memory"); } while (0)
#define DSA_W(i, e2) ((e2) == 0 ? rw[i].x : (e2) == 1 ? rw[i].y : (e2) == 2 ? rw[i].z : rw[i].w)
                asm volatile("s_waitcnt lgkmcnt(0)" ::: "memory");
#pragma unroll 1
                for (int hf = 0; 4 * hf < nblk; ++hf) {
                    DSA_LD8(hf);
#pragma unroll
                    for (int i = 0; i < 4; ++i) if (4 * hf + i < nblk) __hip_atomic_fetch_add(H2 + ((rw[i].x >> 8) & 255u), 1u, __ATOMIC_RELAXED, __HIP_MEMORY_SCOPE_WORKGROUP);
                }
                asm volatile("s_waitcnt lgkmcnt(0)" ::: "memory");
                int Bc, abovec; hist_threshold(*(const LAS u32x4*)(H2 + 4 * lane), 40, lane, Bc, abovec);
                { const u32x4 hs = *(const LAS u32x4*)(H2 + 4 * lane); const int tot = wave_suffix_sum((int)(hs.x + hs.y + hs.z + hs.w), lane); if (__builtin_amdgcn_readlane(tot, 0) < 40) Bc = 0; }
                *(LAS u32x4*)(H2 + 4 * lane) = zero4();
                bool done = false;
                if (DSA_CAND && Bc > 0) {
                    const unsigned thr = (unsigned)Bc << 8;
                    int cnt = 0;
#pragma unroll 1
                    for (int hf = 0; 4 * hf < nblk; ++hf) {
                        DSA_LD8(hf);
#pragma unroll
                        for (int i = 0; i < 4; ++i) if (4 * hf + i < nblk) {
#pragma unroll
                            for (int e = 0; e < 8; ++e) { const unsigned w = DSA_W(i, e >> 1); const unsigned u = (e & 1) ? (w >> 16) : (w & 0xffffu); cnt += (u >= thr) ? 1 : 0; }
                        }
                    }
                    int pos = wave_incl_scan(cnt);
                    const int ncand = __builtin_amdgcn_readlane(pos, 63); pos -= cnt;
                    if (ncand >= 256 && ncand <= 560) {
                        LAS unsigned short* ldum = (LAS unsigned short*)DUM;
#pragma unroll 1
                        for (int hf = 0; 4 * hf < nblk; ++hf) {
                            DSA_LD8(hf);
#pragma unroll
                            for (int i = 0; i < 4; ++i) if (4 * hf + i < nblk) {
#pragma unroll
                                for (int e = 0; e < 8; ++e) { const unsigned w = DSA_W(i, e >> 1); const unsigned u = (e & 1) ? (w >> 16) : (w & 0xffffu);
                                    const bool sel = u >= thr; LAS unsigned short* pk = sel ? CK + pos : ldum; LAS unsigned short* pi = sel ? CI + pos : ldum;
                                    *pk = (unsigned short)u; *pi = (unsigned short)(512 * (4 * hf + i) + 8 * lane + e); pos += sel ? 1 : 0; }
                            }
                        }
                        *(LAS u32x4*)(H1 + 4 * lane) = zero4();
                        asm volatile("s_waitcnt lgkmcnt(0)" ::: "memory");
                        unsigned cu[9];
#pragma unroll
                        for (int j = 0; j < 9; ++j) { const int p = j * 64 + lane; const bool v = p < ncand; cu[j] = v ? (unsigned)CK[v ? p : 0] : 0u; }
                        asm volatile("s_waitcnt lgkmcnt(0)" ::: "memory");
#pragma unroll
                        for (int j = 0; j < 9; ++j) if (j * 64 + lane < ncand) __hip_atomic_fetch_add(H1 + (cu[j] >> 8), 1u, __ATOMIC_RELAXED, __HIP_MEMORY_SCOPE_WORKGROUP);
                        asm volatile("s_waitcnt lgkmcnt(0)" ::: "memory");
                        int B1c, above1c; hist_threshold(*(const LAS u32x4*)(H1 + 4 * lane), 256, lane, B1c, above1c);
                        *(LAS u32x4*)(H1 + 4 * lane) = zero4();
                        asm volatile("s_waitcnt lgkmcnt(0)" ::: "memory");
#pragma unroll
                        for (int j = 0; j < 9; ++j) if (j * 64 + lane < ncand && (int)(cu[j] >> 8) == B1c) __hip_atomic_fetch_add(H1 + (cu[j] & 255u), 1u, __ATOMIC_RELAXED, __HIP_MEMORY_SCOPE_WORKGROUP);
                        asm volatile("s_waitcnt lgkmcnt(0)" ::: "memory");
                        int B2c, above2c; hist_threshold(*(const LAS u32x4*)(H1 + 4 * lane), 256 - above1c, lane, B2c, above2c);
                        const unsigned tauc = ((unsigned)B1c << 8) | (unsigned)B2c;
                        if ((int)H1[B2c] == 256 - above1c - above2c) {
                            int c2 = 0;
#pragma unroll
                            for (int j = 0; j < 9; ++j) c2 += (j * 64 + lane < ncand && cu[j] >= tauc) ? 1 : 0;
                            int p2 = wave_incl_scan(c2) - c2;
#pragma unroll
                            for (int j = 0; j < 9; ++j) { const bool sel = (j * 64 + lane < ncand) && cu[j] >= tauc; LAS unsigned short* pl = sel ? LSTw + p2 : ldum; *pl = CI[sel ? j * 64 + lane : 0]; p2 += sel ? 1 : 0; }
                            done = true;
                        }
                        *(LAS u32x4*)(H1 + 4 * lane) = zero4(); *(LAS u32x4*)(H2 + 4 * lane) = zero4();
                        asm volatile("s_waitcnt lgkmcnt(0)" ::: "memory");
                    }
                }
                if (!done) {
                int lo_bin = Bc, hi_bin = 256;
                for (;;) {
#pragma unroll 1
                    for (int hf = 0; 4 * hf < nblk; ++hf) {
                        DSA_LD8(hf);
#pragma unroll
                        for (int i = 0; i < 4; ++i) if (4 * hf + i < nblk) {
#pragma unroll
                            for (int e2 = 0; e2 < 4; ++e2) { const unsigned w = DSA_W(i, e2); const int b0 = (int)((w >> 8) & 255u), b1 = (int)(w >> 24);
                                LAS unsigned* p0 = ((unsigned)(b0 - lo_bin) < (unsigned)(hi_bin - lo_bin)) ? H1 + b0 : DUM; LAS unsigned* p1 = ((unsigned)(b1 - lo_bin) < (unsigned)(hi_bin - lo_bin)) ? H1 + b1 : DUM;
                                __hip_atomic_fetch_add(p0, 1u, __ATOMIC_RELAXED, __HIP_MEMORY_SCOPE_WORKGROUP); __hip_atomic_fetch_add(p1, 1u, __ATOMIC_RELAXED, __HIP_MEMORY_SCOPE_WORKGROUP); }
                        }
                    }
                    asm volatile("s_waitcnt lgkmcnt(0)" ::: "memory");
                    if (lo_bin == 0) break;
                    const u32x4 h4 = *(const LAS u32x4*)(H1 + 4 * lane); const int tot = __builtin_amdgcn_readlane(wave_suffix_sum((int)(h4.x + h4.y + h4.z + h4.w), lane), 0);
                    if (tot >= 256) break;
                    hi_bin = lo_bin; lo_bin = 0;
                }
                asm volatile("s_waitcnt lgkmcnt(0)" ::: "memory");
                int B1, above1; hist_threshold(*(const LAS u32x4*)(H1 + 4 * lane), 256, lane, B1, above1);
#pragma unroll 1
                for (int hf = 0; 4 * hf < nblk; ++hf) {
                    DSA_LD8(hf);
#pragma unroll
                    for (int i = 0; i < 4; ++i) if (4 * hf + i < nblk) {
#pragma unroll
                        for (int e2 = 0; e2 < 4; ++e2) { const unsigned w = DSA_W(i, e2);
                            LAS unsigned* p0 = ((int)((w >> 8) & 255u) == B1) ? H2 + (w & 255u) : DUM; LAS unsigned* p1 = ((int)(w >> 24) == B1) ? H2 + ((w >> 16) & 255u) : DUM;
                            __hip_atomic_fetch_add(p0, 1u, __ATOMIC_RELAXED, __HIP_MEMORY_SCOPE_WORKGROUP); __hip_atomic_fetch_add(p1, 1u, __ATOMIC_RELAXED, __HIP_MEMORY_SCOPE_WORKGROUP); }
                    }
                }
                asm volatile("s_waitcnt lgkmcnt(0)" ::: "memory");
                int B2, above2; hist_threshold(*(const LAS u32x4*)(H2 + 4 * lane), 256 - above1, lane, B2, above2);
                const unsigned tau = ((unsigned)B1 << 8) | (unsigned)B2;
                const int r = 256 - above1 - above2;
                const int neq = (int)H2[B2];
                if (neq == r) {
                    int cnt = 0;
#pragma unroll 1
                    for (int hf = 0; 4 * hf < nblk; ++hf) {
                        DSA_LD8(hf);
#pragma unroll
                        for (int i = 0; i < 4; ++i) if (4 * hf + i < nblk) {
#pragma unroll
                            for (int e = 0; e < 8; ++e) { const unsigned w = DSA_W(i, e >> 1); const unsigned u = (e & 1) ? (w >> 16) : (w & 0xffffu); cnt += (u >= tau) ? 1 : 0; }
                        }
                    }
                    int pos = wave_incl_scan(cnt) - cnt;
                    LAS unsigned short* ldum = (LAS unsigned short*)DUM;
#pragma unroll 1
                    for (int hf = 0; 4 * hf < nblk; ++hf) {
                        DSA_LD8(hf);
#pragma unroll
                        for (int i = 0; i < 4; ++i) if (4 * hf + i < nblk) {
#pragma unroll
                            for (int e = 0; e < 8; ++e) { const unsigned w = DSA_W(i, e >> 1); const unsigned u = (e & 1) ? (w >> 16) : (w & 0xffffu);
                                const bool sel = u >= tau; LAS unsigned short* p = sel ? LSTw + pos : ldum;
                                *p = (unsigned short)(512 * (4 * hf + i) + 8 * lane + e); pos += sel ? 1 : 0; }
                        }
                    }
                } else {
                    int tot = 0, base_eq = 0;
#define DSA_TK(i) int cgt = 0, ceq = 0; _Pragma("unroll") for (int e = 0; e < 8; ++e) { const unsigned w = DSA_W(i, e >> 1); const unsigned u = (e & 1) ? (w >> 16) : (w & 0xffffu); cgt += (u > tau) ? 1 : 0; ceq += (u == tau) ? 1 : 0; } \
        int tk = 0; if (__ballot(ceq != 0)) { const int inc = wave_incl_scan(ceq); int t = r - base_eq - (inc - ceq); t = t < 0 ? 0 : t; tk = t > ceq ? ceq : t; base_eq += __builtin_amdgcn_readlane(inc, 63); }
#pragma unroll 1
                    for (int hf = 0; 4 * hf < nblk; ++hf) {
                        DSA_LD8(hf);
#pragma unroll
                        for (int i = 0; i < 4; ++i) if (4 * hf + i < nblk) { DSA_TK(i); tot += cgt + tk; }
                    }
                    int pos = wave_incl_scan(tot) - tot;
                    LAS unsigned short* ldum = (LAS unsigned short*)DUM;
                    base_eq = 0;
#pragma unroll 1
                    for (int hf = 0; 4 * hf < nblk; ++hf) {
                        DSA_LD8(hf);
#pragma unroll
                        for (int i = 0; i < 4; ++i) if (4 * hf + i < nblk) {
                            DSA_TK(i);
                            int seen = 0;
#pragma unroll
                            for (int e = 0; e < 8; ++e) { const unsigned w = DSA_W(i, e >> 1); const unsigned u = (e & 1) ? (w >> 16) : (w & 0xffffu);
                                const bool eq = (u == tau); const bool sel = (u > tau) || (eq && seen < tk); seen += eq ? 1 : 0;
                                LAS unsigned short* p = sel ? LSTw + pos : ldum;
                                *p = (unsigned short)(512 * (4 * hf + i) + 8 * lane + e); pos += sel ? 1 : 0; }
                        }
                    }
#undef DSA_TK
                }
                }
#undef DSA_W
#undef DSA_LD8
            } else {
#pragma unroll
                for (int jj = 0; jj < 4; ++jj) LSTw[lane + 64 * jj] = (unsigned short)(lane + 64 * jj);
            }
#endif
            asm volatile("s_waitcnt lgkmcnt(0)" ::: "memory");
            for (int repC = 0; repC < 1 + ((DSA_DUP >> 2) & 1); ++repC) {
                int lc = lane; asm volatile("" : "+v"(lc));
                const int tq = tq0 + wave, n16 = lc & 15, kg = lc >> 4;
#pragma unroll
                for (int jj = 0; jj < 4; ++jj) OFFw[lc + 64 * jj] = (unsigned)(kb0 + (int)LSTw[lc + 64 * jj]) * (unsigned)(ZSW * 2);
                asm volatile("s_waitcnt lgkmcnt(0)" ::: "memory");
                const unsigned vcol = (unsigned)((ZDV + ((lc & 7) ^ (2 * ((lc >> 4) & 3))) * 8) * 2), kcol = (unsigned)((ZDK + 8 * kg) * 2);
                bf16x8 qf[2];
                if (n16 < 6) { const bf16_t* qp = ZSp + (size_t)tq * ZSW + ZDQ + n16 * 64 + 8 * kg; qf[0] = *(const bf16x8*)qp; qf[1] = *(const bf16x8*)(qp + 32); }
                else { qf[0] = (bf16x8){0, 0, 0, 0, 0, 0, 0, 0}; qf[1] = qf[0]; }
                const int ntile = Keff >> 4;
                LAS unsigned char* vst = row;
#define DSA_VDMA(ch, buf) do { unsigned vo[8]; _Pragma("unroll") for (int i8 = 0; i8 < 8; ++i8) vo[i8] = OFFw[(ch) * 64 + (lc >> 3) + 8 * i8] + vcol; \
        _Pragma("unroll") for (int i8 = 0; i8 < 8; ++i8) { const unsigned lb = (unsigned)(size_t)(vst + (buf) * 8192 + i8 * 1024); \
        asm volatile("s_mov_b32 m0, %2\n\ts_nop 0\n\tglobal_load_lds_dwordx4 %0, %1" :: "v"(vo[i8]), "s"(ZSu), "s"(__builtin_amdgcn_readfirstlane(lb)) : "memory", "m0"); } } while (0)
                DSA_VDMA(0, 0);
                if (ntile > 4) DSA_VDMA(1, 1);
                f32x4 sa[8];
                bf16x8 kf[2][4][2];
#define DSA_KLOAD(buf, tb) do { _Pragma("unroll") for (int t4 = 0; t4 < 4; ++t4) if (4 * (tb) + t4 < ntile) { const unsigned ko = OFFw[(4 * (tb) + t4) * 16 + n16] + kcol; \
        const bf16_t* kp = (const bf16_t*)(ZSu + ko); kf[buf][t4][0] = *(const bf16x8*)kp; kf[buf][t4][1] = *(const bf16x8*)(kp + 32); } } while (0)
#define DSA_KMMA(buf, tb) do { _Pragma("unroll") for (int t4 = 0; t4 < 4; ++t4) { \
        if (4 * (tb) + t4 < ntile) { f32x4 a = {0.f, 0.f, 0.f, 0.f}; \
            a = __builtin_amdgcn_mfma_f32_16x16x32_bf16(kf[buf][t4][0], qf[0], a, 0, 0, 0); a = __builtin_amdgcn_mfma_f32_16x16x32_bf16(kf[buf][t4][1], qf[1], a, 0, 0, 0); sa[4 * ((tb) & 1) + t4] = a; } \
        else sa[4 * ((tb) & 1) + t4] = (f32x4){-1e30f, -1e30f, -1e30f, -1e30f}; } } while (0)
#define DSA_PV(ch) do { _Pragma("unroll") for (int sl = 0; sl < 2; ++sl) { const int s = ((ch) & 1) * 2 + sl; \
        u32x4 pw; pw.x = pk2(sa[2 * s].x, sa[2 * s].y); pw.y = pk2(sa[2 * s].z, sa[2 * s].w); pw.z = pk2(sa[2 * s + 1].x, sa[2 * s + 1].y); pw.w = pk2(sa[2 * s + 1].z, sa[2 * s + 1].w); \
        const bf16x8 pb = __builtin_bit_cast(bf16x8, pw); \
        _Pragma("unroll") for (int mt = 0; mt < 4; ++mt) { \
            const int P0 = 32 * sl + 4 * kg + q4, P1 = P0 + 16; \
            const LAS unsigned char* a0 = vst + ((ch) & 1) * 8192 + P0 * 128 + (((2 * mt + (p4 >> 1)) ^ (2 * ((P0 >> 1) & 3))) * 16) + 8 * (p4 & 1); \
            const LAS unsigned char* a1 = vst + ((ch) & 1) * 8192 + P1 * 128 + (((2 * mt + (p4 >> 1)) ^ (2 * ((P1 >> 1) & 3))) * 16) + 8 * (p4 & 1); \
            const s16x4 lo = __builtin_bit_cast(s16x4, __builtin_amdgcn_ds_read_tr16_b64_v4i16((LAS s16x4*)a0)); \
            const s16x4 hi4 = __builtin_bit_cast(s16x4, __builtin_amdgcn_ds_read_tr16_b64_v4i16((LAS s16x4*)a1)); \
            const bf16x8 va = (bf16x8){lo[0], lo[1], lo[2], lo[3], hi4[0], hi4[1], hi4[2], hi4[3]}; \
            oacc[mt] = __builtin_amdgcn_mfma_f32_16x16x32_bf16(va, pb, oacc[mt], 0, 0, 0); } } \
        asm volatile("s_waitcnt lgkmcnt(0)" ::: "memory"); } while (0)
                DSA_KLOAD(0, 0); DSA_KLOAD(1, 1);
                asm volatile("s_waitcnt vmcnt(0)" ::: "memory");
                DSA_KMMA(0, 0); DSA_KLOAD(0, 2);
                DSA_KMMA(1, 1); DSA_KLOAD(1, 3);
                const float sc2 = 0.125f * 1.4426950408889634f;
                const int q4 = n16 >> 2, p4 = n16 & 3;
                f32x4 oacc[4] = {{0.f, 0.f, 0.f, 0.f}, {0.f, 0.f, 0.f, 0.f}, {0.f, 0.f, 0.f, 0.f}, {0.f, 0.f, 0.f, 0.f}};
                float m = -1e30f;
#pragma unroll
                for (int t = 0; t < 8; ++t) m = fmaxf(m, fmaxf(fmaxf(sa[t].x, sa[t].y), fmaxf(sa[t].z, sa[t].w)));
                m = fmaxf(m, __shfl_xor(m, 16)); m = fmaxf(m, __shfl_xor(m, 32));
                float lsum = 0.f;
#pragma unroll
                for (int t = 0; t < 8; ++t) { sa[t].x = __builtin_amdgcn_exp2f((sa[t].x - m) * sc2); sa[t].y = __builtin_amdgcn_exp2f((sa[t].y - m) * sc2); sa[t].z = __builtin_amdgcn_exp2f((sa[t].z - m) * sc2); sa[t].w = __builtin_amdgcn_exp2f((sa[t].w - m) * sc2);
                    lsum += (sa[t].x + sa[t].y) + (sa[t].z + sa[t].w); }
                DSA_PV(0);
                if (ntile > 8) DSA_VDMA(2, 0);
                if (ntile > 4) DSA_PV(1);
                if (ntile > 12) DSA_VDMA(3, 1);
                if (ntile > 8) {
                    DSA_KMMA(0, 2);
                    DSA_KMMA(1, 3);
                    float m1 = -1e30f;
#pragma unroll
                    for (int t = 0; t < 8; ++t) m1 = fmaxf(m1, fmaxf(fmaxf(sa[t].x, sa[t].y), fmaxf(sa[t].z, sa[t].w)));
                    m1 = fmaxf(m1, __shfl_xor(m1, 16)); m1 = fmaxf(m1, __shfl_xor(m1, 32));
                    const float mn = fmaxf(m, m1), alpha = __builtin_amdgcn_exp2f((m - mn) * sc2);
#pragma unroll
                    for (int mt = 0; mt < 4; ++mt) { oacc[mt].x *= alpha; oacc[mt].y *= alpha; oacc[mt].z *= alpha; oacc[mt].w *= alpha; }
                    lsum *= alpha;
#pragma unroll
                    for (int t = 0; t < 8; ++t) { sa[t].x = __builtin_amdgcn_exp2f((sa[t].x - mn) * sc2); sa[t].y = __builtin_amdgcn_exp2f((sa[t].y - mn) * sc2); sa[t].z = __builtin_amdgcn_exp2f((sa[t].z - mn) * sc2); sa[t].w = __builtin_amdgcn_exp2f((sa[t].w - mn) * sc2);
                        lsum += (sa[t].x + sa[t].y) + (sa[t].z + sa[t].w); }
                    if (ntile > 12) asm volatile("s_waitcnt vmcnt(8)" ::: "memory");
                    else asm volatile("s_waitcnt vmcnt(0)" ::: "memory");
                    DSA_PV(2);
                    if (ntile > 12) { asm volatile("s_waitcnt vmcnt(0)" ::: "memory"); DSA_PV(3); }
                }
                lsum += __shfl_xor(lsum, 16); lsum += __shfl_xor(lsum, 32);
                const float linv = __builtin_amdgcn_rcpf(lsum);
#undef DSA_KLOAD
#undef DSA_KMMA
#undef DSA_PV
#undef DSA_VDMA
                if (n16 < 6) {
                    bf16_t* op = F.H() + (size_t)tq * DM + 256 + n16 * 64 + 4 * kg;
#pragma unroll
                    for (int mt = 0; mt < 4; ++mt) { u32x2 o; o.x = pk2(oacc[mt].x * linv, oacc[mt].y * linv); o.y = pk2(oacc[mt].z * linv, oacc[mt].w * linv); *(u32x2*)(op + 16 * mt) = o; }
                }
            }
            __syncthreads();
        }
    }
}

__global__ void __launch_bounds__(NTHREADS, 2) mk_fwd(Args args) {
    extern __shared__ __attribute__((aligned(16))) unsigned char lds_raw[];
    Frame F;
    F.lds = (LAS unsigned char*)lds_raw;
    F.tid = threadIdx.x; F.lane = F.tid & 63; F.wave = __builtin_amdgcn_readfirstlane(F.tid >> 6);
    F.G = gridDim.x; F.bid = blockIdx.x; F.wsb = args.ws; F.zo = 0u; F.wl = 0u;
    unsigned char* ws = args.ws;
#define INF(k) ((const float*)args.in[k])

    volatile LAS unsigned* MISC = (volatile LAS unsigned*)(F.lds + MISC_OFF);
    if (F.tid < 64) MISC[F.tid] = 0u;
    __syncthreads();
    XcdBarrier bar = xcd_barrier_post((unsigned*)(ws + WS_CTL) + CW_BAR, MISC + 8);
    int ph = 0; const int lo = args.ph_lo, hi = args.ph_hi;
    unsigned long long* TSp = (unsigned long long*)(ws + WS_CTL + 32768); int nst = 0; (void)TSp; (void)nst;
    bool first_seam = true;
#ifndef DUP_MASK
#define DUP_MASK 0
#endif
#ifdef PROBE_LO
#define STAMP() do { if (F.bid == 0 && F.tid == 0) { TSp[nst] = __builtin_amdgcn_s_memrealtime(); } ++nst; } while (0)
#else
#define STAMP() do { } while (0)
#endif
#define GRIDSYNC() xcd_barrier(bar, F.wave == 0 && F.lane == 0)
#define RUN(...) do { if (ph >= lo && ph < hi) { asm volatile("" : "+s"(F.zo), "+s"(F.bid), "+s"(F.G), "+s"(F.wave)); F.lane = (int)__builtin_amdgcn_mbcnt_hi(~0u, __builtin_amdgcn_mbcnt_lo(~0u, F.zo)); asm volatile("" : "+v"(F.lane)); F.tid = F.wave * 64 + F.lane; __VA_ARGS__; } ++ph; } while (0)
#define SEAM() do { if (ph > lo && ph < hi) { if (first_seam) { GRIDSYNC(); first_seam = false; } else xcd_barrier(bar, F.wave == 0 && F.lane == 0); } STAMP(); } while (0)

    STAMP();
    RUN(phase_rope(F, (const int*)args.in[1])); STAMP();
#pragma unroll
    RUN({ const ProIn I{INF(0), INF(2), INF(3), INF(15), INF(16), INF(17), INF(18), INF(20), INF(21), INF(12), INF(4), INF(5), INF(6), INF(7), INF(8), (const int*)args.in[1]};
          phase_prologue(F, I); }); SEAM();
    for (int l = 0; l < DEPTH; ++l) {
        const float* xin = (l == 0) ? INF(0) : args.out;
        F.wl = l ? (unsigned)(WS_W1L - WS_W) : 0u;
        RUN({ pg8::Gemm g{F.H(), F.Win_t()}; pg8::StaticOrder<T, NINP> S; S.init(F.G, F.bid);
              pg8::EpiGen<FInProj> E{FInProj{F.ZS(), F.GB(), F.IW(), F.ROPE(), F.IKD()}}; pg8::gemm_phase<T, NINP, DM, DM, DM>(F.lds, g, S, E, F.tid); }); SEAM();
        RUN({ phase_s5_local(F, l); __syncthreads(); phase_ret_local(F);
              asm volatile("s_waitcnt vmcnt(0)" ::: "memory"); __syncthreads();
              if (F.tid == 0) { unsigned* lc = (unsigned*)(F.wsb + F.zo + WS_CTL) + CW_LOCAL + 64 * l; __builtin_amdgcn_fence(__ATOMIC_RELEASE, "agent"); asm volatile("s_waitcnt vmcnt(0)" ::: "memory"); __hip_atomic_fetch_add(lc, 1u, __ATOMIC_RELAXED, __HIP_MEMORY_SCOPE_AGENT); }
              phase_dsa(F); __syncthreads();
              if (F.tid == 0) { unsigned* lc = (unsigned*)(F.wsb + F.zo + WS_CTL) + CW_LOCAL + 64 * l; unsigned sp = 0u;
                                while (__hip_atomic_load(lc, __ATOMIC_RELAXED, __HIP_MEMORY_SCOPE_AGENT) < (unsigned)F.G) { __builtin_amdgcn_s_sleep(2); if (++sp > (1u << 20)) break; }
                                __builtin_amdgcn_fence(__ATOMIC_ACQUIRE, "agent"); asm volatile("s_waitcnt vmcnt(0)" ::: "memory"); }
              __syncthreads();
              phase_carry(F, l); }); SEAM();
        RUN({ phase_s5_out_glu(F, l, INF(9), INF(10), INF(11), F.Wglu_t(), INF(13) + l * 256); __syncthreads(); phase_ret_out(F, l, INF(14)); __syncthreads(); }); SEAM();
        RUN({ pg8::Gemm g{F.H(), F.Wabc_t()}; pg8::StaticOrder<T, DM> S; S.init(F.G, F.bid);
              EpiMerge E{F.MG(), F.GB()}; pg8::gemm_phase<T, DM, DM, DM, DM>(F.lds, g, S, E, F.tid); }); SEAM();
        RUN({ pg8::Gemm g{F.MG(), F.Wout_t()}; pg8::StaticOrder<T, DM> S; S.init(F.G, F.bid);
              EpiResidNorm E{l == 0 ? xin : (const float*)nullptr, F.XR(), F.XR(), F.H(), nullptr, INF(19) + l * DM, F.XB(), F.PANEL(2 * l)}; pg8::gemm_phase<T, DM, DM, DM, DM>(F.lds, g, S, E, F.tid); }); SEAM();
        RUN({ pg8::Gemm g{F.H(), F.W1_t()}; pg8::StaticOrder<T, FF> S; S.init(F.G, F.bid);
              pg8::EpiGen<FRelu2> E{FRelu2{F.FB()}}; pg8::gemm_phase<T, FF, DM, DM, DM>(F.lds, g, S, E, F.tid); }); SEAM();
        RUN({ pg8::Gemm g{F.FB(), F.W2_t()}; pg8::StaticOrder<T, DM> S; S.init(F.G, F.bid);
              const bool lastl = (l + 1 == DEPTH);
              EpiResidNorm E{(const float*)nullptr, F.XR(), lastl ? (bf16_t*)nullptr : F.XR(), lastl ? (bf16_t*)nullptr : F.H(), lastl ? args.out : (float*)nullptr, lastl ? INF(22) : INF(2) + (l + 1) * DM, F.XB(), F.PANEL(2 * l + 1)};
              pg8::gemm_phase<T, DM, FF, FF, FF>(F.lds, g, S, E, F.tid); }); if (l + 1 < DEPTH) SEAM();
    }
    STAMP();
#ifdef PROBE_LO
    if (F.bid == 0 && F.tid == 0) {
        const int sel[] = PROBE_SEL; unsigned long long tot = 0;
        for (unsigned i = 0; i < sizeof(sel) / sizeof(int); ++i) tot += TSp[sel[i] + 1] - TSp[sel[i]];
        const float us = (float)tot * 0.01f;
        asm volatile("s_waitcnt vmcnt(0)" ::: "memory");
        args.out[0] = sqrtf(us * (float)((size_t)T * DM));
    }
#endif
#undef RUN
#undef SEAM
}

extern "C" void kernel_launch(void* const* d_in, const int* in_sizes, int n_in, void* d_out, int out_size, void* d_ws, size_t ws_size, hipStream_t stream) {
    static int grid = 0;
    if (grid == 0) {
        if (n_in != 23 || out_size != T * DM || ws_size < WS_END) { fprintf(stderr, "kernel_launch: unexpected shapes (n_in %d out %d ws %zu)\n", n_in, out_size, ws_size); grid = -1; return; }
        int dev = 0, cus = 0, per_cu = 0;
        hipGetDevice(&dev); hipDeviceGetAttribute(&cus, hipDeviceAttributeMultiprocessorCount, dev);
        if (hipFuncSetAttribute((const void*)mk_fwd, hipFuncAttributeMaxDynamicSharedMemorySize, LDS_BYTES) != hipSuccess) { fprintf(stderr, "kernel_launch: hipFuncSetAttribute failed\n"); grid = -1; return; }
        if (hipOccupancyMaxActiveBlocksPerMultiprocessor(&per_cu, (const void*)mk_fwd, NTHREADS, LDS_BYTES) != hipSuccess || per_cu < 1) { fprintf(stderr, "kernel_launch: occupancy query says %d\n", per_cu); per_cu = 1; }
        (void)hipGetLastError();
        grid = cus;
        if (cus != 256) fprintf(stderr, "kernel_launch: built for a 256-CU device (got %d CUs): the fused-norm row-statistics exchange needs a panel's four column tiles in one round\n", cus);
    }
    if (grid < 0) return;
    hipMemsetAsync((char*)d_ws + WS_CTL, 0, CTL_ZERO_BYTES, stream);
    Args a{};
    for (int i = 0; i < 23; ++i) a.in[i] = d_in[i];
    a.out = (float*)d_out; a.ws = (unsigned char*)d_ws;
#ifndef MK_SPLIT
    a.ph_lo = 0; a.ph_hi = 1000;
    void* kargs[] = {&a};
    hipError_t e = hipLaunchCooperativeKernel((const void*)mk_fwd, dim3(grid), dim3(NTHREADS), kargs, LDS_BYTES, stream);
    if (e != hipSuccess) fprintf(stderr, "kernel_launch: cooperative launch failed: %s\n", hipGetErrorString(e));
#else
    for (int p = 0; p < 2 * 9 + 2; ++p) { a.ph_lo = p; a.ph_hi = p + 1; hipLaunchKernelGGL(mk_fwd, dim3(grid), dim3(NTHREADS), LDS_BYTES, stream, a); }
#endif
}
```

```cpp
#include <hip/hip_runtime.h>
#include <cstdio>
#include <cstdint>

#define LAS __attribute__((address_space(3)))
#define GAS __attribute__((address_space(1)))
typedef unsigned short bf16_t;
typedef short bf16x8 __attribute__((ext_vector_type(8)));
typedef float f32x4 __attribute__((ext_vector_type(4)));
typedef float f32x2 __attribute__((ext_vector_type(2)));
typedef unsigned u32x4 __attribute__((ext_vector_type(4)));
typedef unsigned u32x2 __attribute__((ext_vector_type(2)));

constexpr int NB = 4, SEQ = 8192, T = NB * SEQ, DM = 1024, DEPTH = 2, FF = 4096;
constexpr int NIN = 5156, NINP = 5376;
constexpr int ZSW = 2112, GW = 3072;
constexpr int ZU = 0, ZDQ = 256, ZDK = 640, ZDV = 704, ZIQ = 768, ZIK = 896, ZIWC = 928, ZRQ = 960, ZRK = 1152, ZRV = 1344, ZRG = 1728, ZGATE = 2112, ZEND = 5184;
constexpr int NFREQ = 36;
constexpr float EPS = 1e-6f;

constexpr size_t MiB = 1u << 20;
constexpr size_t WS_CTL = 0, CTL_ZERO_BYTES = 512 * 1024;
constexpr size_t WS_IW = 1 * MiB;
constexpr size_t WS_SP = 1 * MiB + 512 * 1024;
constexpr size_t WS_ROPE = 2 * MiB;
constexpr size_t WS_S5E = 11 * MiB;
constexpr size_t WS_RST = 15 * MiB;
constexpr size_t WS_W = 51 * MiB;
constexpr size_t WO_IN = 0, WO_ABC = WO_IN + (size_t)NINP * DM * 2, WO_OUT = WO_ABC + (size_t)DM * DM * 2, WO_W1 = WO_OUT + (size_t)DM * DM * 2,
                 WO_W2 = WO_W1 + (size_t)FF * DM * 2, WO_GLU = WO_W2 + (size_t)FF * DM * 2, WO_END = WO_GLU + 256 * 256 * 2;
static_assert(WO_END <= 31 * MiB, "weights");
constexpr size_t WS_H = 82 * MiB;
constexpr size_t WS_ZS = 146 * MiB;
constexpr size_t WS_G = 278 * MiB;
constexpr size_t WS_XR = 404 * MiB;
constexpr size_t WS_IKD = 470 * MiB;
constexpr size_t WS_XB = 472 * MiB;
constexpr size_t WS_W1L = 474 * MiB;
constexpr size_t WS_END = 505 * MiB;
static_assert(WS_ZS + (size_t)T * FF * 2 <= WS_XR && WS_XR + (size_t)T * DM * 2 <= WS_IKD, "ws map (residual)");
static_assert(WS_ZS + (size_t)T * ZSW * 2 <= WS_G && WS_G + (size_t)T * GW * 2 <= WS_END && WS_ZS + (size_t)T * FF * 2 <= WS_END, "ws map");
constexpr int CW_BAR = 1024, CW_LOCAL = 8192, CW_PANEL = 32768;

constexpr int LDS_BYTES = 160 * 1024;
constexpr int RING_BYTES = 131072;
constexpr int MISC_OFF = LDS_BYTES - 256;

__device__ __forceinline__ unsigned f2bf(float f) { unsigned u = __builtin_bit_cast(unsigned, f); return (u + 0x7fffu + ((u >> 16) & 1u)) >> 16; }
typedef __bf16 hwbf16x2 __attribute__((ext_vector_type(2)));
__device__ __forceinline__ unsigned pk2(float lo, float hi) { const f32x2 v = {lo, hi}; return __builtin_bit_cast(unsigned, __builtin_convertvector(v, hwbf16x2)); }
__device__ __forceinline__ float bf2f(unsigned short v) { return __builtin_bit_cast(float, (unsigned)v << 16); }
__device__ __forceinline__ float bflo(unsigned w) { return __builtin_bit_cast(float, w << 16); }
__device__ __forceinline__ float bfhi(unsigned w) { return __builtin_bit_cast(float, w & 0xffff0000u); }
__device__ __forceinline__ float sigmoidf_(float x) { return __builtin_amdgcn_rcpf(1.0f + __expf(-x)); }
__device__ __forceinline__ float wave_sum(float v) {
#pragma unroll
    for (int o = 1; o < 64; o <<= 1) v += __shfl_xor(v, o);
    return v;
}
__device__ __forceinline__ float wave_max(float v) {
#pragma unroll
    for (int o = 1; o < 64; o <<= 1) v = fmaxf(v, __shfl_xor(v, o));
    return v;
}

#define XB_TMO      128
#define XB_XCNT(j)  (256  + 64 * (j))
#define XB_XSUB(j)  (1280 + 64 * (j))
#define XB_XGEN(j)  (2304 + 64 * (j))
#define XB_TOP      3328
#define XB_TOPGEN   3392
#define XCD_BAR_WORDS 3456
#define XB_SPIN_CAP (1u << 18)
__device__ __forceinline__ unsigned xb_ld(unsigned* p)              { return __hip_atomic_load(p, __ATOMIC_RELAXED, __HIP_MEMORY_SCOPE_AGENT); }
__device__ __forceinline__ unsigned xb_add(unsigned* p, unsigned v) { return __hip_atomic_fetch_add(p, v, __ATOMIC_RELAXED, __HIP_MEMORY_SCOPE_AGENT); }
__device__ __forceinline__ unsigned xb_xcc_id() { return (unsigned)__builtin_amdgcn_s_getreg((3 << 11) | 20) & 0xFu; }
#define XB_SPIN(cond, bar) do { unsigned _sp = 0; while (cond) { __builtin_amdgcn_s_sleep(1); \
    if ((++_sp & 255u) == 0u) { if (xb_ld(&(bar)[XB_TMO])) break; if (_sp > XB_SPIN_CAP) { atomicAdd(&(bar)[XB_TMO], 1u); break; } } } } while (0)
struct XcdBarrier { unsigned* bar; unsigned x; volatile LAS unsigned* st; };
__device__ __forceinline__ XcdBarrier xcd_barrier_post(unsigned* bar, volatile LAS unsigned* st) {
    XcdBarrier b; b.bar = bar; b.x = xb_xcc_id(); b.st = st;
    if (threadIdx.x == 0) (void)xb_add(&bar[XB_XCNT(b.x)], 1u);
    return b;
}
__device__ __forceinline__ void xcd_barrier_complete(unsigned* bar, unsigned x, unsigned& nloc, unsigned& nx) {
    const unsigned G = gridDim.x * gridDim.y * gridDim.z;
    unsigned sum, cnt, mine, sp = 0u;
    for (;;) {
        sum = 0u; cnt = 0u; mine = 0u;
#pragma unroll
        for (unsigned j = 0; j < 16; ++j) { const unsigned c = xb_ld(&bar[XB_XCNT(j)]); sum += c; cnt += (c > 0u) ? 1u : 0u; mine = (j == x) ? c : mine; }
        if (sum == G) break;
        __builtin_amdgcn_s_sleep(1);
        if ((++sp & 255u) == 0u) { if (xb_ld(&bar[XB_TMO])) break; if (sp > XB_SPIN_CAP) { atomicAdd(&bar[XB_TMO], 1u); break; } }
    }
    nloc = mine > 0u ? mine : 1u; nx = cnt > 0u ? cnt : 1u;
}
__device__ __forceinline__ void xcd_barrier(const XcdBarrier& b, bool leader) {
    asm volatile("s_waitcnt vmcnt(0)" ::: "memory");
    __syncthreads();
    if (leader) {
        unsigned* bar = b.bar; unsigned bx = b.x;
        asm volatile("" : "+s"(bar), "+s"(bx));
        __builtin_amdgcn_s_waitcnt(0);
        unsigned nloc = b.st[0], nx = b.st[1];
        if (nloc == 0u) { xcd_barrier_complete(bar, bx, nloc, nx); b.st[0] = nloc; b.st[1] = nx; }
        const unsigned old = xb_add(&bar[XB_XSUB(bx)], 1u);
        const unsigned gen = old / nloc;
        if (old + 1u == (gen + 1u) * nloc) {
            __builtin_amdgcn_fence(__ATOMIC_RELEASE, "agent");
            asm volatile("s_waitcnt vmcnt(0)" ::: "memory");
            const unsigned og = xb_add(&bar[XB_TOP], 1u);
            const unsigned tg = og / nx;
            if (og + 1u == (tg + 1u) * nx) xb_add(&bar[XB_TOPGEN], 1u);
            else XB_SPIN(xb_ld(&bar[XB_TOPGEN]) == tg, bar);
            __builtin_amdgcn_fence(__ATOMIC_ACQUIRE, "agent");
            xb_add(&bar[XB_XGEN(bx)], 1u);
            asm volatile("s_waitcnt vmcnt(0)" ::: "memory");
        } else {
            XB_SPIN(xb_ld(&bar[XB_XGEN(bx)]) == gen, bar);
            __builtin_amdgcn_fence(__ATOMIC_ACQUIRE, "agent");
            asm volatile("s_waitcnt vmcnt(0)" ::: "memory");
        }
    }
    __syncthreads();
}

namespace pg8 {
constexpr int BM = 256, BK = 64, HALF = 128, HTB = HALF * BK * 2, STAGE_BYTES = 8 * HTB, NXCD = 8, WGM = 8;
__host__ __device__ __forceinline__ int lds_byte(int r, int c) { const int st = (r >> 4) * 2 + (c >> 5), rr = r & 15, cc = c & 31, ob = rr * 64 + cc * 2; return st * 1024 + (ob ^ (((ob >> 9) & 1) << 5)); }
__host__ __device__ __forceinline__ void stage_rc(int b, int& R, int& C) { const int st = b / 1024, sb = b % 1024, swz = sb ^ (((sb >> 9) & 1) << 5); R = (st >> 1) * 16 + swz / 64; C = (st & 1) * 32 + (swz % 64) / 2; }
__host__ __device__ __forceinline__ int perm32(int rho) { const int n = rho >> 4, i = rho & 15; return 8 * (i >> 2) + 4 * n + (i & 3); }

struct Unit { int pm, pn; };
struct Gemm { const bf16_t* A; const bf16_t* Bt; };

template <int M, int N> struct StaticOrder {
    static constexpr int nM = M / BM, nN = N / BM, nwg = nM * nN;
    int G, c;
    __host__ __device__ void init(int G_, int c_) { G = G_; c = c_; }
    __host__ __device__ bool next(int i, Unit& u) const {
        const long L = (long)i * G + c; if (L >= nwg) return false;
        int wgid = (int)L; { constexpr int q = nwg / NXCD, r = nwg % NXCD; const int xcd = wgid % NXCD, off = wgid / NXCD; wgid = (xcd < r ? xcd * (q + 1) : r * (q + 1) + (xcd - r) * q) + off; }
        constexpr int nig = WGM * nN; const int gid = wgid / nig, fm = gid * WGM, gsz = (nM - fm) < WGM ? (nM - fm) : WGM;
        u.pm = fm + ((wgid % nig) % gsz); u.pn = (wgid % nig) / gsz; return true;
    }
};

template <class F, int FENCE = 0> struct EpiGen {
    static constexpr bool PERM = true, HAS_MID = false, FUSED = false;
    F f;
    __device__ __forceinline__ void operator()(const f32x4 (&acc)[2][2][4][2], const Unit& u, int wr, int wc, int fr, int fq) const {
        const int row0 = u.pm * BM + wr * 64 + fr, col0 = u.pn * BM + wc * 32 + 8 * fq;
#pragma unroll
        for (int ai = 0; ai < 2; ++ai)
#pragma unroll
            for (int m = 0; m < 4; ++m)
#pragma unroll
                for (int bj = 0; bj < 2; ++bj) { f(row0 + ai * HALF + m * 16, col0 + bj * HALF, acc[ai][bj][m][0], acc[ai][bj][m][1]);
                    if constexpr (FENCE > 0) { if (((ai * 4 + m) * 2 + bj) % FENCE == FENCE - 1) asm volatile("" ::: "memory"); } }
    }
};

template <int M, int N, int K, int LDA, int LDB, class Epi, bool ALIGN_EPI = true>
__device__ __forceinline__ void gemm_phase(LAS unsigned char* lds, const Gemm g, const StaticOrder<M, N>& S, const Epi& E, int tid_in) {
    int tid = tid_in; asm volatile("" : "+v"(tid));
    const int wid = __builtin_amdgcn_readfirstlane(tid >> 6), lane = tid & 63, wr = wid >> 2, wc = wid & 3, fr = lane & 15, fq = lane >> 4;
    constexpr int nt = K / BK;
    unsigned voffA[2], voffB[2];
#pragma unroll
    for (int i = 0; i < 2; ++i) { int R, C; stage_rc(tid * 16 + i * 8192, R, C); const int Rb = Epi::PERM ? ((R & ~31) + perm32(R & 31)) : R;
        voffA[i] = (unsigned)(R * LDA + C) * 2u; voffB[i] = (unsigned)(Rb * LDB + C) * 2u; }
    constexpr size_t kstep = (size_t)(BK * 2);
    constexpr size_t hstepA = (size_t)HALF * LDA * 2, hstepB = (size_t)HALF * LDB * 2;
    constexpr size_t tstepA = 2 * hstepA, tstepB = 2 * hstepB;
    const unsigned ldsw = (unsigned)wid * 1024u;
    const int aoff = lds_byte(wr * 64 + fr, fq * 8), boff = lds_byte(wc * 32 + fr, fq * 8);
#define PG8_SA(b, h) (((b) * 2 + (h)) * HTB)
#define PG8_SB(b, h) ((4 + (b) * 2 + (h)) * HTB)
#define PG8_STAGE(bufoff, gbase, voff) do { _Pragma("unroll") for (int _i = 0; _i < 2; ++_i) \
        __builtin_amdgcn_global_load_lds((const unsigned*)((const char*)(gbase) + (voff)[_i]), (LAS unsigned*)(lds + (bufoff) + ldsw + _i * 8192), 16, 0, 0); } while (0)
#define PG8_LDA(dst, b, h) do { _Pragma("unroll") for (int m = 0; m < 4; ++m) _Pragma("unroll") for (int k = 0; k < 2; ++k) dst[m][k] = *(const LAS bf16x8*)(lds + PG8_SA(b, h) + aoff + m * 2048 + k * 1024); } while (0)
#define PG8_LDB(dst, b, h) do { _Pragma("unroll") for (int n = 0; n < 2; ++n) _Pragma("unroll") for (int k = 0; k < 2; ++k) dst[n][k] = *(const LAS bf16x8*)(lds + PG8_SB(b, h) + boff + n * 2048 + k * 1024); } while (0)
#define PG8_MMA(ai, bj, At, Bt) do { __builtin_amdgcn_s_setprio(1); _Pragma("unroll") for (int m = 0; m < 4; ++m) _Pragma("unroll") for (int n = 0; n < 2; ++n) _Pragma("unroll") for (int k = 0; k < 2; ++k) \
        acc[ai][bj][m][n] = __builtin_amdgcn_mfma_f32_16x16x32_bf16(Bt[n][k], At[m][k], acc[ai][bj][m][n], 0, 0, 0); __builtin_amdgcn_s_setprio(0); } while (0)
#define PG8_WAIT_V(n) asm volatile("s_waitcnt vmcnt(" #n ")" ::: "memory")
#define PG8_WAIT_L(n) asm volatile("s_waitcnt lgkmcnt(" #n ")" ::: "memory")
#define PG8_BAR __builtin_amdgcn_s_barrier()
#define PG8_SCHED __builtin_amdgcn_sched_barrier(0)
    Unit cur, nxt; int ui = 0;
    if (!S.next(0, cur)) return;
    f32x4 acc[2][2][4][2];
#pragma unroll
    for (int a = 0; a < 2; ++a)
#pragma unroll
        for (int b = 0; b < 2; ++b)
#pragma unroll
            for (int m = 0; m < 4; ++m)
#pragma unroll
                for (int n = 0; n < 2; ++n) acc[a][b][m][n] = (f32x4){0.f, 0.f, 0.f, 0.f};
    bf16x8 At[4][2], B0[2][2], B1[2][2];
    const char* cA = (const char*)g.A + (size_t)cur.pm * tstepA; const char* cB = (const char*)g.Bt + (size_t)cur.pn * tstepB;
    PG8_STAGE(PG8_SB(0, 0), cB, voffB); PG8_STAGE(PG8_SB(0, 1), cB + hstepB, voffB); PG8_STAGE(PG8_SA(0, 0), cA, voffA); PG8_STAGE(PG8_SA(0, 1), cA + hstepA, voffA);
    if (wr == 1) PG8_BAR;
    PG8_WAIT_V(2); PG8_BAR;
    PG8_STAGE(PG8_SB(1, 0), cB + kstep, voffB); PG8_STAGE(PG8_SA(1, 0), cA + kstep, voffA); PG8_STAGE(PG8_SB(1, 1), cB + hstepB + kstep, voffB);
    PG8_WAIT_V(6); PG8_BAR;
    for (;;) {
        const bool has_next = S.next(ui + 1, nxt);
        const char* nA = has_next ? (const char*)g.A + (size_t)nxt.pm * tstepA : cA; const char* nB = has_next ? (const char*)g.Bt + (size_t)nxt.pn * tstepB : cB;
#pragma unroll 1
        for (int t = 0; t < nt; t += 2) {
            const bool last = (t == nt - 2);
            const char* a1 = cA + (size_t)(t + 1) * kstep;
            const char* a2 = last ? nA : cA + (size_t)(t + 2) * kstep; const char* b2 = last ? nB : cB + (size_t)(t + 2) * kstep;
            const char* a3 = a2 + kstep; const char* b3 = b2 + kstep;
            if constexpr (Epi::HAS_MID) { if (t == Epi::MID0 || t == Epi::MID1) E.mid(acc, cur, t, wr, wc, fr, fq); }
            PG8_LDB(B0, 0, 0); PG8_LDB(B1, 0, 1); PG8_SCHED; PG8_LDA(At, 0, 0); PG8_STAGE(PG8_SA(1, 1), a1 + hstepA, voffA);
            PG8_WAIT_V(8); PG8_WAIT_L(0); PG8_BAR; PG8_MMA(0, 0, At, B0); PG8_MMA(0, 1, At, B1); PG8_BAR; PG8_SCHED;
            PG8_LDA(At, 0, 1); PG8_STAGE(PG8_SB(0, 0), b2, voffB); PG8_STAGE(PG8_SB(0, 1), b2 + hstepB, voffB); PG8_STAGE(PG8_SA(0, 0), a2, voffA);
            PG8_WAIT_V(8); PG8_WAIT_L(0); PG8_BAR; PG8_MMA(1, 0, At, B0); PG8_MMA(1, 1, At, B1); PG8_BAR; PG8_SCHED;
            PG8_LDB(B0, 1, 0); PG8_LDB(B1, 1, 1); PG8_SCHED; PG8_LDA(At, 1, 0); PG8_STAGE(PG8_SA(0, 1), a2 + hstepA, voffA);
            PG8_WAIT_V(8); PG8_WAIT_L(0); PG8_BAR; PG8_MMA(0, 0, At, B0); PG8_MMA(0, 1, At, B1); PG8_BAR; PG8_SCHED;
            PG8_LDA(At, 1, 1); PG8_STAGE(PG8_SB(1, 0), b3, voffB); PG8_STAGE(PG8_SB(1, 1), b3 + hstepB, voffB); PG8_STAGE(PG8_SA(1, 0), a3, voffA);
            PG8_WAIT_V(8); PG8_WAIT_L(0); PG8_BAR; PG8_MMA(1, 0, At, B0); PG8_MMA(1, 1, At, B1); PG8_BAR; PG8_SCHED;
        }
        if constexpr (ALIGN_EPI) { if (wr == 0) PG8_BAR; }
        if constexpr (Epi::FUSED) E.fused(acc, cur, wr, wc, fr, fq, lds, wid, lane); else E(acc, cur, wr, wc, fr, fq);
        if (!has_next) break;
#pragma unroll
        for (int a = 0; a < 2; ++a)
#pragma unroll
            for (int b = 0; b < 2; ++b)
#pragma unroll
                for (int m = 0; m < 4; ++m)
#pragma unroll
                    for (int n = 0; n < 2; ++n) acc[a][b][m][n] = (f32x4){0.f, 0.f, 0.f, 0.f};
        cur = nxt; cA = nA; cB = nB; ++ui;
        if constexpr (ALIGN_EPI) { if (wr == 1) PG8_BAR; }
    }
    PG8_WAIT_V(0);
    if constexpr (!ALIGN_EPI) { if (wr == 0) PG8_BAR; }
    PG8_BAR;
#undef PG8_SA
#undef PG8_SB
#undef PG8_STAGE
#undef PG8_LDA
#undef PG8_LDB
#undef PG8_MMA
#undef PG8_WAIT_V
#undef PG8_WAIT_L
#undef PG8_BAR
#undef PG8_SCHED
}
}

constexpr int NWAVES = 8, NTHREADS = 512;
struct Args { const void* in[23]; float* out; unsigned char* ws; int ph_lo, ph_hi; };
struct Frame {
    LAS unsigned char* lds;
    int tid, lane, wave, G, bid;
    unsigned char* wsb; unsigned zo; unsigned wl;
    __device__ __forceinline__ bf16_t* IKD() const { return (bf16_t*)(wsb + zo + WS_IKD); }
    __device__ __forceinline__ float* XB() const { return (float*)(wsb + zo + WS_XB); }
    __device__ __forceinline__ unsigned* PANEL(int bank) const { return (unsigned*)(wsb + zo + WS_CTL) + CW_PANEL + bank * 8192; }
    __device__ __forceinline__ float* IW() const { return (float*)(wsb + zo + WS_IW); }
    __device__ __forceinline__ bf16_t* XR() const { return (bf16_t*)(wsb + zo + WS_XR); }
    __device__ __forceinline__ float* SP(int l) const { return (float*)(wsb + zo + WS_SP) + l * 36864; }
    __device__ __forceinline__ f32x2* ROPE() const { return (f32x2*)(wsb + zo + WS_ROPE); }
    __device__ __forceinline__ f32x2* S5E() const { return (f32x2*)(wsb + zo + WS_S5E); }
    __device__ __forceinline__ float* RST() const { return (float*)(wsb + zo + WS_RST); }
    __device__ __forceinline__ bf16_t* Win_t() const { return (bf16_t*)(wsb + zo + wl + WS_W + WO_IN); }
    __device__ __forceinline__ bf16_t* Wabc_t() const { return (bf16_t*)(wsb + zo + wl + WS_W + WO_ABC); }
    __device__ __forceinline__ bf16_t* Wout_t() const { return (bf16_t*)(wsb + zo + wl + WS_W + WO_OUT); }
    __device__ __forceinline__ bf16_t* W1_t() const { return (bf16_t*)(wsb + zo + wl + WS_W + WO_W1); }
    __device__ __forceinline__ bf16_t* W2_t() const { return (bf16_t*)(wsb + zo + wl + WS_W + WO_W2); }
    __device__ __forceinline__ bf16_t* Wglu_t() const { return (bf16_t*)(wsb + zo + wl + WS_W + WO_GLU); }
    __device__ __forceinline__ bf16_t* H() const { return (bf16_t*)(wsb + zo + WS_H); }
    __device__ __forceinline__ bf16_t* ZS() const { return (bf16_t*)(wsb + zo + WS_ZS); }
    __device__ __forceinline__ unsigned char* GB() const { return wsb + zo + WS_G; }
    __device__ __forceinline__ bf16_t* MG() const { return (bf16_t*)(wsb + zo + WS_ZS); }
    __device__ __forceinline__ bf16_t* FB() const { return (bf16_t*)(wsb + zo + WS_ZS); }
};
constexpr int SP_LB = 0, SP_L64 = 2048, SP_BBR = 4096, SP_BBI = 4096 + 16384;

__device__ __forceinline__ int ropeperm(int j, int r) { const int half = r >> 1; return (j < r) ? ((j & 1) ? half + (j >> 1) : (j >> 1)) : j; }
__device__ __forceinline__ int zmap(int n) {
    if (n < ZDQ) return n;
    if (n < ZDK) { const int q = n - ZDQ, h = q >> 6, hc = q & 63; return 256 + h * 64 + ropeperm(hc, 16); }
    if (n < ZDV) return 640 + ropeperm(n - ZDK, 16);
    if (n < ZIQ) return 704 + (n - ZDV);
    if (n < ZIK) { const int q = n - ZIQ, h = q >> 5, hc = q & 31; return 768 + h * 32 + ropeperm(hc, 8); }
    if (n < ZIWC) return 896 + ropeperm(n - ZIK, 8);
    if (n < ZRQ) return (n - ZIWC) < 4 ? 928 + (n - ZIWC) : -1;
    if (n < ZRK) { const int q = n - ZRQ, h = q / 48, hc = q % 48; return 932 + h * 48 + ropeperm(hc, 48); }
    if (n < ZRV) { const int q = n - ZRK, h = q / 48, hc = q % 48; return 1124 + h * 48 + ropeperm(hc, 48); }
    if (n < ZRG) return 1316 + (n - ZRV);
    if (n < ZGATE) return 1700 + (n - ZRG);
    if (n < ZEND) return 2084 + (n - ZGATE);
    return -1;
}

__device__ __forceinline__ void tr_item(const float* W, int N, int kb, int nb, bf16_t* WT, int ldd, int koff, bool mapped, LAS float* scr, int lane) {
    const int k0 = 64 * kb, n0 = 32 * nb;
    const int c32 = lane & 31; int sc = n0 + c32; if (mapped) sc = zmap(sc);
#pragma unroll 8
    for (int i = 0; i < 32; ++i) { const int kk = 2 * i + (lane >> 5); scr[kk * 33 + c32] = (sc >= 0) ? W[(size_t)(k0 + kk) * N + sc] : 0.f; }
    asm volatile("s_waitcnt lgkmcnt(0)" ::: "memory");
    const int c = lane & 7;
#pragma unroll
    for (int j = 0; j < 4; ++j) { const int n = (lane >> 3) + 8 * j; const LAS float* s = scr + (8 * c) * 33 + n;
        u32x4 o; o.x = pk2(s[0 * 33], s[1 * 33]); o.y = pk2(s[2 * 33], s[3 * 33]); o.z = pk2(s[4 * 33], s[5 * 33]); o.w = pk2(s[6 * 33], s[7 * 33]);
        *(u32x4*)(WT + (size_t)(n0 + n) * ldd + koff + k0 + 8 * c) = o; }
    asm volatile("s_waitcnt lgkmcnt(0)" ::: "memory");
}

struct TrJob { const float* W; int N, kb, nb; bf16_t* WT; int ldd, koff; bool mapped; };
__device__ __forceinline__ void tr_load(const TrJob& J, float (&v)[32], int lane) {
    const int k0 = 64 * J.kb, n0 = 32 * J.nb, c32 = lane & 31; int sc = n0 + c32; if (J.mapped) sc = zmap(sc);
    const float* wp = J.W + (size_t)(k0 + (lane >> 5)) * J.N + (sc >= 0 ? sc : 0);
#pragma unroll
    for (int i = 0; i < 32; ++i) v[i] = wp[(size_t)(2 * i) * J.N];
    if (sc < 0) {
#pragma unroll
        for (int i = 0; i < 32; ++i) v[i] = 0.f;
    }
}
__device__ __forceinline__ void tr_store(const TrJob& J, const float (&v)[32], LAS float* scr, int lane) {
    const int k0 = 64 * J.kb, n0 = 32 * J.nb, c32 = lane & 31;
#pragma unroll
    for (int i = 0; i < 32; ++i) scr[(2 * i + (lane >> 5)) * 33 + c32] = v[i];
    asm volatile("s_waitcnt lgkmcnt(0)" ::: "memory");
    const int c = lane & 7;
#pragma unroll
    for (int j = 0; j < 4; ++j) { const int n = (lane >> 3) + 8 * j; const LAS float* s = scr + (8 * c) * 33 + n;
        u32x4 o; o.x = pk2(s[0 * 33], s[1 * 33]); o.y = pk2(s[2 * 33], s[3 * 33]); o.z = pk2(s[4 * 33], s[5 * 33]); o.w = pk2(s[6 * 33], s[7 * 33]);
        *(u32x4*)(J.WT + (size_t)(n0 + n) * J.ldd + J.koff + k0 + 8 * c) = o; }
    asm volatile("s_waitcnt lgkmcnt(0)" ::: "memory");
}
__device__ __forceinline__ void rms_rows4_bf16(const float* x0, size_t rstride, int nrows, const float* gain, bf16_t* o0, size_t ostride, int lane) {
    f32x4 v[4][4];
#pragma unroll
    for (int r = 0; r < 4; ++r) if (r < nrows) {
#pragma unroll
        for (int j = 0; j < 4; ++j) v[r][j] = ((const f32x4*)(x0 + r * rstride) + lane)[64 * j];
    }
    f32x4 gg[4];
#pragma unroll
    for (int j = 0; j < 4; ++j) gg[j] = ((const f32x4*)gain + lane)[64 * j];
#pragma unroll
    for (int r = 0; r < 4; ++r) if (r < nrows) {
        float s = 0.f;
#pragma unroll
        for (int j = 0; j < 4; ++j) s += (v[r][j].x * v[r][j].x + v[r][j].y * v[r][j].y) + (v[r][j].z * v[r][j].z + v[r][j].w * v[r][j].w);
        const float rstd = rsqrtf(wave_sum(s) * (1.f / DM) + EPS);
        u32x2* o8 = (u32x2*)(o0 + r * ostride) + lane;
#pragma unroll
        for (int j = 0; j < 4; ++j) { u32x2 w; w.x = pk2(v[r][j].x * rstd * gg[j].x, v[r][j].y * rstd * gg[j].y); w.y = pk2(v[r][j].z * rstd * gg[j].z, v[r][j].w * rstd * gg[j].w); o8[64 * j] = w; }
    }
}
__device__ __forceinline__ void rms_row_bf16(const float* xrow, const float* gain, bf16_t* orow, int lane) {
    const f32x4* xr = (const f32x4*)xrow + lane; const f32x4* gr = (const f32x4*)gain + lane;
    f32x4 v[4]; float s = 0.f;
#pragma unroll
    for (int j = 0; j < 4; ++j) { v[j] = xr[64 * j]; s += (v[j].x * v[j].x + v[j].y * v[j].y) + (v[j].z * v[j].z + v[j].w * v[j].w); }
    const float rstd = rsqrtf(wave_sum(s) * (1.f / DM) + EPS);
    u32x2* o8 = (u32x2*)orow + lane;
#pragma unroll
    for (int j = 0; j < 4; ++j) { const f32x4 gg = gr[64 * j]; u32x2 w; w.x = pk2(v[j].x * rstd * gg.x, v[j].y * rstd * gg.y); w.y = pk2(v[j].z * rstd * gg.z, v[j].w * rstd * gg.w); o8[64 * j] = w; }
}
__device__ __forceinline__ void rms_row_f32(const float* xrow, const float* gain, float* orow, int lane) {
    const f32x4* xr = (const f32x4*)xrow + lane; const f32x4* gr = (const f32x4*)gain + lane;
    f32x4 v[4]; float s = 0.f;
#pragma unroll
    for (int j = 0; j < 4; ++j) { v[j] = xr[64 * j]; s += (v[j].x * v[j].x + v[j].y * v[j].y) + (v[j].z * v[j].z + v[j].w * v[j].w); }
    const float rstd = rsqrtf(wave_sum(s) * (1.f / DM) + EPS);
    f32x4* o = (f32x4*)orow + lane;
#pragma unroll
    for (int j = 0; j < 4; ++j) { const f32x4 gg = gr[64 * j]; o[64 * j] = v[j] * rstd * gg; }
}


__device__ __forceinline__ void phase_rope(Frame& F, const int* pos) {
    const int gt = F.bid * NTHREADS + F.tid, NT = F.G * NTHREADS;
    f32x2* RT = F.ROPE();
    for (int e = gt; e < T * NFREQ; e += NT) {
        const int tok = e / NFREQ, f = e % NFREQ;
        float lth, sc; int fi;
        if (f < 8) { lth = 13.122363377404328f; sc = 2.0f / 16.0f; fi = f; } else if (f < 12) { lth = 13.122363377404328f; sc = 2.0f / 8.0f; fi = f - 8; } else { lth = 9.210340371976184f; sc = 2.0f / 48.0f; fi = f - 12; }
        const float inv = expf(-lth * (float)fi * sc);
        const float p = (float)pos[tok];
        const float ang = p * inv;
        const float kq = rintf(ang * 0.15915494309189535f);
        float r = fmaf(-kq, 6.2831854820251465f, ang);
        r = fmaf(-kq, -1.7484555e-7f, r);
        RT[e] = (f32x2){cosf(r), sinf(r)};
    }
}

struct ProIn { const float *xin, *norm1_g, *w_in, *wa, *wb, *wc, *wo, *w1, *w2, *wg, *lam_re, *lam_im, *log_step, *b_re, *b_im; const int* pos; };
__device__ __forceinline__ void phase_prologue(Frame& F, const ProIn& I) {
#ifdef NO_PHASE_PROLOGUE
    return;
#endif
    LAS float* scr = (LAS float*)(F.lds + F.wave * 16384);
    const int gw = F.bid * NWAVES + F.wave, NGW = F.G * NWAVES;
#pragma unroll 1
    for (int l = 0; l < DEPTH; ++l) {
    F.wl = l ? (unsigned)(WS_W1L - WS_W) : 0u;
    constexpr int I_IN = 16 * (NINP / 32), I_A = 4 * 32, I_B = 6 * 32, I_C = 6 * 32, I_O = 16 * 32, I_1 = 16 * 128, I_2 = 64 * 32, I_G = 4 * 8;
    constexpr int NITEMS = I_IN + I_A + I_B + I_C + I_O + I_1 + I_2 + I_G;
    const float* w_in = I.w_in + (size_t)l * DM * NIN; const float* wa = I.wa + (size_t)l * 256 * DM; const float* wb = I.wb + (size_t)l * 384 * DM;
    const float* wc = I.wc + (size_t)l * 384 * DM; const float* wo = I.wo + (size_t)l * DM * DM; const float* w1 = I.w1 + (size_t)l * DM * FF;
    const float* w2 = I.w2 + (size_t)l * FF * DM; const float* wg = I.wg + (size_t)l * 256 * 256;
    auto decode = [&](int r, TrJob& J) {
        if (r < I_IN) { J = TrJob{w_in, NIN, r / (NINP / 32), r % (NINP / 32), F.Win_t(), DM, 0, true}; return; } r -= I_IN;
        if (r < I_A) { J = TrJob{wa, DM, r / 32, r % 32, F.Wabc_t(), DM, 0, false}; return; } r -= I_A;
        if (r < I_B) { J = TrJob{wb, DM, r / 32, r % 32, F.Wabc_t(), DM, 256, false}; return; } r -= I_B;
        if (r < I_C) { J = TrJob{wc, DM, r / 32, r % 32, F.Wabc_t(), DM, 640, false}; return; } r -= I_C;
        if (r < I_O) { J = TrJob{wo, DM, r / 32, r % 32, F.Wout_t(), DM, 0, false}; return; } r -= I_O;
        if (r < I_1) { J = TrJob{w1, FF, r / 128, r % 128, F.W1_t(), DM, 0, false}; return; } r -= I_1;
        if (r < I_2) { J = TrJob{w2, DM, r / 32, r % 32, F.W2_t(), FF, 0, false}; return; } r -= I_2;
        J = TrJob{wg, 256, r / 8, r % 8, F.Wglu_t(), 256, 0, false};
    };
#pragma unroll 1
    for (int it = gw; it < NITEMS; it += 2 * NGW) {
        const bool hb = it + NGW < NITEMS;
        TrJob JA, JB; decode(it, JA); decode(hb ? it + NGW : it, JB);
        float va[32], vb[32];
        tr_load(JA, va, F.lane); if (hb) tr_load(JB, vb, F.lane);
        tr_store(JA, va, scr, F.lane); if (hb) tr_store(JB, vb, scr, F.lane);
    }
    {
        const int gt = F.bid * NTHREADS + F.tid;
        if (gt < 1024) {
            float* SPp = F.SP(l);
            const int g = gt >> 6, p = gt & 63;
            const float lr = I.lam_re[(l * 16 + g) * 64 + p], li = I.lam_im[(l * 16 + g) * 64 + p];
            const float step = expf(I.log_step[l * 16 + g]);
            const float mag = expf(lr * step); const float lbr = mag * cosf(li * step), lbi = mag * sinf(li * step);
            const float den = lr * lr + li * li;
            const float fr = ((lbr - 1.f) * lr + lbi * li) / den, fi = (lbi * lr - (lbr - 1.f) * li) / den;
            SPp[SP_LB + gt * 2] = lbr; SPp[SP_LB + gt * 2 + 1] = lbi;
            float pr = lbr, pi = lbi;
#pragma unroll
            for (int s = 0; s < 6; ++s) { const float nr = pr * pr - pi * pi, ni = 2.f * pr * pi; pr = nr; pi = ni; }
            SPp[SP_L64 + gt * 2] = pr; SPp[SP_L64 + gt * 2 + 1] = pi;
            const float* br = I.b_re + ((size_t)(l * 16 + g) * 64 + p) * 16; const float* bi = I.b_im + ((size_t)(l * 16 + g) * 64 + p) * 16;
#pragma unroll
            for (int c = 0; c < 16; ++c) { SPp[SP_BBR + gt * 16 + c] = fr * br[c] - fi * bi[c]; SPp[SP_BBI + gt * 16 + c] = fr * bi[c] + fi * br[c]; }
        }
    }
    }
    F.wl = 0u;
    for (int m = gw; m < T; m += 4 * NGW) { const int left = (T - m + NGW - 1) / NGW; rms_rows4_bf16(I.xin + (size_t)m * DM, (size_t)NGW * DM, left < 4 ? left : 4, I.norm1_g, F.H() + (size_t)m * DM, (size_t)NGW * DM, F.lane); }
}

__device__ __forceinline__ u32x4 pack8(const f32x4& a, const f32x4& b) { u32x4 w; w.x = pk2(a.x, a.y); w.y = pk2(a.z, a.w); w.z = pk2(b.x, b.y); w.w = pk2(b.z, b.w); return w; }
__device__ __forceinline__ void unpack8(const u32x4& w, f32x4& a, f32x4& b) { a = (f32x4){bflo(w.x), bfhi(w.x), bflo(w.y), bfhi(w.y)}; b = (f32x4){bflo(w.z), bfhi(w.z), bflo(w.w), bfhi(w.w)}; }

__device__ __forceinline__ unsigned gate1_u8(float x) { const float s = 255.f * sigmoidf_(x) + 0.5f; const unsigned u = (unsigned)s; return u < 1u ? 1u : u; }
__device__ __forceinline__ unsigned gate4_u8(const f32x4& a) { return gate1_u8(a.x) | (gate1_u8(a.y) << 8) | (gate1_u8(a.z) << 16) | (gate1_u8(a.w) << 24); }
__device__ __forceinline__ void ungate8(const u32x2& w, f32x4& a, f32x4& b) {
    a = (f32x4){(float)(w.x & 255u), (float)((w.x >> 8) & 255u), (float)((w.x >> 16) & 255u), (float)(w.x >> 24)};
    b = (f32x4){(float)(w.y & 255u), (float)((w.y >> 8) & 255u), (float)((w.y >> 16) & 255u), (float)(w.y >> 24)};
}
struct FInProj {
    bf16_t* ZS; unsigned char* GB; float* IW; const f32x2* ROPE; bf16_t* IKD;
    __device__ __forceinline__ void rope8(f32x4& a, f32x4& b, int row, int f0) const {
        const f32x2* rt = ROPE + (size_t)row * NFREQ + f0;
        const f32x2 c0 = rt[0], c1 = rt[1], c2 = rt[2], c3 = rt[3];
        f32x4 oa, ob;
        oa.x = a.x * c0.x - a.y * c0.y; oa.y = a.y * c0.x + a.x * c0.y;
        oa.z = a.z * c1.x - a.w * c1.y; oa.w = a.w * c1.x + a.z * c1.y;
        ob.x = b.x * c2.x - b.y * c2.y; ob.y = b.y * c2.x + b.x * c2.y;
        ob.z = b.z * c3.x - b.w * c3.y; ob.w = b.w * c3.x + b.z * c3.y;
        a = oa; b = ob;
    }
    __device__ __forceinline__ void operator()(int row, int col, f32x4 a, f32x4 b) const {
        if (col >= ZEND) return;
        if (col >= ZGATE) {
            *(u32x2*)(GB + (size_t)row * GW + (col - ZGATE)) = (u32x2){gate4_u8(a), gate4_u8(b)}; return;
        }
        if (col >= ZIWC && col < ZRQ) { if (col == ZIWC) *(f32x4*)(IW + (size_t)row * 4) = a; return; }
        if (col >= ZDQ && col < ZDV) { const int hc = (col - ZDQ) & 63; if (hc < 16) rope8(a, b, row, hc >> 1); }
        else if (col >= ZIQ && col < ZIWC) { const int hc = (col - ZIQ) & 31; if (hc < 8) rope8(a, b, row, 8);
            if (col >= ZIK) { *(u32x4*)(IKD + ((size_t)((row >> 5) * 4 + ((col - ZIK) >> 3)) * 32 + (row & 31)) * 8) = pack8(a, b); return; } }
        else if (col >= ZRQ && col < ZRV) { const int hc = (col - ZRQ) % 48; rope8(a, b, row, 12 + (hc >> 1)); }
        *(u32x4*)(ZS + (size_t)row * ZSW + col) = pack8(a, b);
    }
};
struct FMerge {
    bf16_t* MG; const bf16_t* GB; int br;
    __device__ __forceinline__ void operator()(int row, int col, f32x4 a, f32x4 b) const {
        f32x4 ga, gb; unpack8(*(const u32x4*)(GB + (size_t)row * GW + br * DM + col), ga, gb);
        a = a * ga; b = b * gb;
        u32x4* mp = (u32x4*)(MG + (size_t)row * DM + col);
        if (br != 0) { f32x4 pa, pb; unpack8(*mp, pa, pb); a = a + pa; b = b + pb; }
        *mp = pack8(a, b);
    }
};
struct FResid {
    const float* base; float* out;
    __device__ __forceinline__ void operator()(int row, int col, f32x4 a, f32x4 b) const {
        const f32x4* bp = (const f32x4*)(base + (size_t)row * DM + col); f32x4* op = (f32x4*)(out + (size_t)row * DM + col);
        const f32x4 b0 = bp[0], b1 = bp[1]; op[0] = b0 + a; op[1] = b1 + b;
    }
};
struct FRelu2 {
    bf16_t* FB;
    __device__ __forceinline__ void operator()(int row, int col, f32x4 a, f32x4 b) const {
        a = (f32x4){fmaxf(a.x, 0.f), fmaxf(a.y, 0.f), fmaxf(a.z, 0.f), fmaxf(a.w, 0.f)}; b = (f32x4){fmaxf(b.x, 0.f), fmaxf(b.y, 0.f), fmaxf(b.z, 0.f), fmaxf(b.w, 0.f)};
        *(u32x4*)(FB + (size_t)row * FF + col) = pack8(a * a, b * b);
    }
};
struct FGlu {
    bf16_t* H; const float* bias;
    __device__ __forceinline__ void operator()(int row, int col, f32x4 a, f32x4 b) const {
        u32x4* hp = (u32x4*)(H + (size_t)row * DM + col); f32x4 ya, yb; unpack8(*hp, ya, yb);
        const f32x4 ba = *(const f32x4*)(bias + col), bb = *(const f32x4*)(bias + col + 4);
        a = a + ba; b = b + bb;
        a = (f32x4){ya.x * sigmoidf_(a.x), ya.y * sigmoidf_(a.y), ya.z * sigmoidf_(a.z), ya.w * sigmoidf_(a.w)};
        b = (f32x4){yb.x * sigmoidf_(b.x), yb.y * sigmoidf_(b.y), yb.z * sigmoidf_(b.z), yb.w * sigmoidf_(b.w)};
        *hp = pack8(a, b);
    }
};

struct EpiMerge {
    static constexpr bool PERM = true, HAS_MID = true, FUSED = false; static constexpr int MID0 = 4, MID1 = 10;
    bf16_t* MG; const unsigned char* GB;
    __device__ __forceinline__ void mid(f32x4 (&acc)[2][2][4][2], const pg8::Unit& u, int t, int wr, int wc, int fr, int fq) const {
        int zz = 0; asm volatile("" : "+v"(zz));
        const int row0 = u.pm * 256 + wr * 64 + fr + zz, col0 = u.pn * 256 + wc * 32 + 8 * fq, bp = (t == MID0) ? 0 : 1;
#pragma unroll
        for (int ai = 0; ai < 2; ++ai)
#pragma unroll
            for (int m = 0; m < 4; ++m) {
#pragma unroll
                for (int bj = 0; bj < 2; ++bj) {
                    const unsigned char* gp = GB + (size_t)(row0 + ai * 128 + m * 16) * GW + bp * DM + col0 + bj * 128;
                    f32x4 pa, pb, na, nb; ungate8(*(const u32x2*)gp, pa, pb); ungate8(*(const u32x2*)(gp + DM), na, nb);
                    const f32x4 fa = {pa.x * __builtin_amdgcn_rcpf(na.x), pa.y * __builtin_amdgcn_rcpf(na.y), pa.z * __builtin_amdgcn_rcpf(na.z), pa.w * __builtin_amdgcn_rcpf(na.w)};
                    const f32x4 fb = {pb.x * __builtin_amdgcn_rcpf(nb.x), pb.y * __builtin_amdgcn_rcpf(nb.y), pb.z * __builtin_amdgcn_rcpf(nb.z), pb.w * __builtin_amdgcn_rcpf(nb.w)};
                    acc[ai][bj][m][0] = acc[ai][bj][m][0] * fa; acc[ai][bj][m][1] = acc[ai][bj][m][1] * fb;
                }
                if (m == 3) asm volatile("" ::: "memory");
            }
    }
    __device__ __forceinline__ void operator()(const f32x4 (&acc)[2][2][4][2], const pg8::Unit& u, int wr, int wc, int fr, int fq) const {
        const int row0 = u.pm * 256 + wr * 64 + fr, col0 = u.pn * 256 + wc * 32 + 8 * fq;
#pragma unroll
        for (int ai = 0; ai < 2; ++ai)
#pragma unroll
            for (int m = 0; m < 4; ++m)
#pragma unroll
                for (int bj = 0; bj < 2; ++bj) {
                    const int row = row0 + ai * 128 + m * 16, col = col0 + bj * 128;
                    f32x4 ga, gb; ungate8(*(const u32x2*)(GB + (size_t)row * GW + 2 * DM + col), ga, gb);
                    *(u32x4*)(MG + (size_t)row * DM + col) = pack8(acc[ai][bj][m][0] * (ga * (1.f / 255.f)), acc[ai][bj][m][1] * (gb * (1.f / 255.f)));
                }
    }
};

struct EpiResidNorm {
    static constexpr bool PERM = true, HAS_MID = false, FUSED = true;
    const float* base; const bf16_t* base16; bf16_t* XOUT; bf16_t* HN; float* NOUT; const float* gain; float* xbuf; unsigned* cnt;
    __device__ __forceinline__ void fused(f32x4 (&acc)[2][2][4][2], const pg8::Unit& u, int wr, int wc, int fr, int fq, LAS unsigned char* lds, int wid, int lane) const {
        LAS float* P = (LAS float*)(lds + 131072);
        LAS float* S = (LAS float*)(lds + 131072 + 4096);
        LAS unsigned* flag = (LAS unsigned*)(lds + 131072 + 5120);
        int zz = 0; asm volatile("" : "+v"(zz));
        const int rl0 = wr * 64 + fr + zz, row0 = u.pm * 256 + rl0, col0 = u.pn * 256 + wc * 32 + 8 * fq;
#pragma unroll
        for (int ai = 0; ai < 2; ++ai) {
#pragma unroll
            for (int m = 0; m < 4; ++m) {
                float ss = 0.f;
#pragma unroll
                for (int bj = 0; bj < 2; ++bj) {
                    const size_t off = (size_t)(row0 + ai * 128 + m * 16) * DM + col0 + bj * 128;
                    f32x4 r0, r1;
                    if (base) { r0 = *(const f32x4*)(base + off); r1 = *(const f32x4*)(base + off + 4); } else unpack8(*(const u32x4*)(base16 + off), r0, r1);
                    const f32x4 x0 = r0 + acc[ai][bj][m][0], x1 = r1 + acc[ai][bj][m][1];
                    acc[ai][bj][m][0] = x0; acc[ai][bj][m][1] = x1;
                    ss += (x0.x * x0.x + x0.y * x0.y) + (x0.z * x0.z + x0.w * x0.w) + (x1.x * x1.x + x1.y * x1.y) + (x1.z * x1.z + x1.w * x1.w);
                }
                ss += __shfl_xor(ss, 16); ss += __shfl_xor(ss, 32);
                if (fq == 0) P[(rl0 + ai * 128 + m * 16) * 4 + wc] = ss;
            }
            asm volatile("" ::: "memory");
        }
        asm volatile("s_waitcnt lgkmcnt(0)" ::: "memory"); __builtin_amdgcn_s_barrier(); asm volatile("" ::: "memory");
        const int rowt = wid * 64 + lane;
        if (wid < 4) {
            const f32x4 p = *(const LAS f32x4*)(P + rowt * 4);
            __hip_atomic_store(xbuf + (size_t)(u.pm * 256 + rowt) * 4 + u.pn, (p.x + p.y) + (p.z + p.w), __ATOMIC_RELAXED, __HIP_MEMORY_SCOPE_AGENT);
        }
        asm volatile("s_waitcnt vmcnt(0)" ::: "memory");
        if (lane == 0) __hip_atomic_fetch_add(cnt + 64 * u.pm, 1u, __ATOMIC_RELAXED, __HIP_MEMORY_SCOPE_AGENT);
        if (wid == 0) {
            unsigned sp = 0u;
            for (;;) {
                if ((unsigned)__builtin_amdgcn_readfirstlane(__hip_atomic_load(cnt + 64 * u.pm, __ATOMIC_RELAXED, __HIP_MEMORY_SCOPE_AGENT)) >= 32u) break;
                __builtin_amdgcn_s_sleep(2);
                if (++sp > (1u << 20)) break;
            }
            __builtin_amdgcn_fence(__ATOMIC_ACQUIRE, "agent");
            if (lane == 0) flag[0] = 1u;
        }
        asm volatile("s_waitcnt vmcnt(0) lgkmcnt(0)" ::: "memory"); __builtin_amdgcn_s_barrier(); asm volatile("" ::: "memory");
        if (wid < 4) {
            const float* sl = xbuf + (size_t)(u.pm * 256 + rowt) * 4;
            const float s = (__hip_atomic_load(sl, __ATOMIC_RELAXED, __HIP_MEMORY_SCOPE_AGENT) + __hip_atomic_load(sl + 1, __ATOMIC_RELAXED, __HIP_MEMORY_SCOPE_AGENT))
                          + (__hip_atomic_load(sl + 2, __ATOMIC_RELAXED, __HIP_MEMORY_SCOPE_AGENT) + __hip_atomic_load(sl + 3, __ATOMIC_RELAXED, __HIP_MEMORY_SCOPE_AGENT));
            S[rowt] = rsqrtf(s * (1.f / DM) + EPS);
        }
        asm volatile("s_waitcnt vmcnt(0) lgkmcnt(0)" ::: "memory"); __builtin_amdgcn_s_barrier(); asm volatile("" ::: "memory");
#pragma unroll
        for (int bj = 0; bj < 2; ++bj) {
            const f32x4 g0 = *(const f32x4*)(gain + col0 + bj * 128), g1 = *(const f32x4*)(gain + col0 + bj * 128 + 4);
#pragma unroll
            for (int ai = 0; ai < 2; ++ai)
#pragma unroll
                for (int m = 0; m < 4; ++m) {
                    const float rs = S[rl0 + ai * 128 + m * 16];
                    const size_t off = (size_t)(row0 + ai * 128 + m * 16) * DM + col0 + bj * 128;
                    const f32x4 y0 = acc[ai][bj][m][0] * rs * g0, y1 = acc[ai][bj][m][1] * rs * g1;
                    if (XOUT) *(u32x4*)(XOUT + off) = pack8(acc[ai][bj][m][0], acc[ai][bj][m][1]);
                    if (HN) *(u32x4*)(HN + off) = pack8(y0, y1);
                    if (NOUT) { *(f32x4*)(NOUT + off) = y0; *(f32x4*)(NOUT + off + 4) = y1; }
                }
        }
        asm volatile("s_waitcnt lgkmcnt(0)" ::: "memory"); __builtin_amdgcn_s_barrier(); asm volatile("" ::: "memory");
    }
    __device__ __forceinline__ void operator()(const f32x4 (&)[2][2][4][2], const pg8::Unit&, int, int, int, int) const {}
};

typedef float f32x16 __attribute__((ext_vector_type(16)));
__device__ __forceinline__ float gelu_tanh(float x) { const float u = 0.7978845608028654f * (x + 0.044715f * x * x * x); const float e = __expf(2.f * u); const float th = 1.f - 2.f * __builtin_amdgcn_rcpf(e + 1.f); return 0.5f * x * (1.f + th); }
constexpr int S5_XSTR = 272;
constexpr int S5_WAVE_LDS = 2 * 16 * S5_XSTR;
constexpr int S5_YSTR = 528;
constexpr int S5_YOFF = NWAVES * S5_WAVE_LDS;
template <bool OUT, bool TOLDS>
__device__ __forceinline__ void s5_task(Frame& F, int l, int pp, int g, LAS unsigned char* XL, LAS unsigned char* YL, const bf16_t* ZSp, const float* SPp, f32x2* S5Ep,
                                        const float* c_re, const float* c_im, const float* ssm_d) {
    {
        int lane = F.lane; asm volatile("" : "+v"(lane));
        const int n = lane & 31, hh = lane >> 5, l15 = lane & 15, kg = lane >> 4;
        const int cmine = 2 * pp + hh;
        bf16x8 bbf[2][2];
#pragma unroll
        for (int st = 0; st < 2; ++st) { const float* br = SPp + SP_BBR + (size_t)(g * 64 + 2 * n + st) * 16 + 8 * hh; const float* bi = SPp + SP_BBI + (size_t)(g * 64 + 2 * n + st) * 16 + 8 * hh;
            bbf[st][0] = __builtin_bit_cast(bf16x8, pack8(*(const f32x4*)br, *(const f32x4*)(br + 4))); bbf[st][1] = __builtin_bit_cast(bf16x8, pack8(*(const f32x4*)bi, *(const f32x4*)(bi + 4))); }
        const f32x4 lb = *(const f32x4*)(SPp + SP_LB + (g * 64 + 2 * n) * 2);
        f32x4 x = {0.f, 0.f, 0.f, 0.f};
        if constexpr (OUT) x = *(const f32x4*)(S5Ep + (size_t)(cmine * 16 + g) * 64 + 2 * n);
        bf16x8 cf[4]; f32x4 dsk = {0.f, 0.f, 0.f, 0.f};
        if constexpr (OUT) {
#pragma unroll
            for (int ks = 0; ks < 4; ++ks) { const float* cp = ((ks < 2) ? c_re : c_im) + ((size_t)(l * 16 + g) * 16 + l15) * 64 + 32 * (ks & 1) + 8 * kg;
                f32x4 a = *(const f32x4*)cp, b = *(const f32x4*)(cp + 4); if (ks >= 2) { a = -a; b = -b; }
                cf[ks] = __builtin_bit_cast(bf16x8, pack8(a, b)); }
            dsk = *(const f32x4*)(ssm_d + (l * 16 + g) * 16 + 4 * kg);
        }
        const bf16_t* urow = ZSp + (size_t)((2 * pp + ((n >> 2) & 1)) * 64 + 4 * (n >> 3) + (n & 3)) * ZSW + ZU + g * 16 + 8 * hh;
#pragma unroll 1
        for (int k = 0; k < 4; ++k) {
            const bf16x8 uf = *(const bf16x8*)(urow + (size_t)(16 * k) * ZSW);
            const f32x16 z16 = {0.f, 0.f, 0.f, 0.f, 0.f, 0.f, 0.f, 0.f, 0.f, 0.f, 0.f, 0.f, 0.f, 0.f, 0.f, 0.f};
            const f32x16 r0 = __builtin_amdgcn_mfma_f32_32x32x16_bf16(uf, bbf[0][0], z16, 0, 0, 0), i0 = __builtin_amdgcn_mfma_f32_32x32x16_bf16(uf, bbf[0][1], z16, 0, 0, 0);
            const f32x16 r1 = __builtin_amdgcn_mfma_f32_32x32x16_bf16(uf, bbf[1][0], z16, 0, 0, 0), i1 = __builtin_amdgcn_mfma_f32_32x32x16_bf16(uf, bbf[1][1], z16, 0, 0, 0);
#pragma unroll
            for (int t = 0; t < 16; ++t) {
                const float nr0 = lb.x * x.x - lb.y * x.y + r0[t], ni0 = lb.x * x.y + lb.y * x.x + i0[t];
                const float nr1 = lb.z * x.z - lb.w * x.w + r1[t], ni1 = lb.z * x.w + lb.w * x.z + i1[t];
                x = (f32x4){nr0, ni0, nr1, ni1};
                if constexpr (OUT) { LAS unsigned* xw = (LAS unsigned*)(XL + (hh * 16 + t) * S5_XSTR + 4 * n); xw[0] = pk2(nr0, nr1); xw[32] = pk2(ni0, ni1); }
            }
            if constexpr (OUT) {
                asm volatile("s_waitcnt lgkmcnt(0)" ::: "memory");
#pragma unroll
                for (int sel = 0; sel < 2; ++sel) {
                    f32x4 y = {0.f, 0.f, 0.f, 0.f};
#pragma unroll
                    for (int ks = 0; ks < 4; ++ks) { const bf16x8 xf = *(const LAS bf16x8*)(XL + (sel * 16 + l15) * S5_XSTR + (32 * ks + 8 * kg) * 2); y = __builtin_amdgcn_mfma_f32_16x16x32_bf16(cf[ks], xf, y, 0, 0, 0); }
                    const size_t tok = (size_t)(2 * pp + sel) * 64 + 16 * k + l15;
                    const u32x2 uw = *(const u32x2*)(ZSp + tok * ZSW + ZU + g * 16 + 4 * kg);
                    const float y0 = gelu_tanh(y.x + dsk.x * bflo(uw.x)), y1 = gelu_tanh(y.y + dsk.y * bfhi(uw.x)), y2 = gelu_tanh(y.z + dsk.z * bflo(uw.y)), y3 = gelu_tanh(y.w + dsk.w * bfhi(uw.y));
                    if constexpr (TOLDS) *(LAS u32x2*)(YL + (sel * 64 + 16 * k + l15) * S5_YSTR + (g * 16 + 4 * kg) * 2) = (u32x2){pk2(y0, y1), pk2(y2, y3)};
                    else *(u32x2*)(F.H() + tok * DM + g * 16 + 4 * kg) = (u32x2){pk2(y0, y1), pk2(y2, y3)};
                }
                asm volatile("s_waitcnt lgkmcnt(0)" ::: "memory");
            }
        }
        if constexpr (!OUT) *(f32x4*)(S5Ep + (size_t)(cmine * 16 + g) * 64 + 2 * n) = x;
    }
}
template <bool OUT>
__device__ __forceinline__ void s5_pass(Frame& F, int l, const float* c_re, const float* c_im, const float* ssm_d) {
    const bf16_t* ZSp = F.ZS(); const float* SPp = F.SP(l); f32x2* S5Ep = F.S5E();
    LAS unsigned char* XL = F.lds + F.wave * S5_WAVE_LDS;
    for (int task = F.bid * NWAVES + F.wave; task < 256 * 16; task += F.G * NWAVES) s5_task<OUT, false>(F, l, task >> 4, task & 15, XL, nullptr, ZSp, SPp, S5Ep, c_re, c_im, ssm_d);
}
__device__ __forceinline__ void phase_s5_out_glu(Frame& F, int l, const float* c_re, const float* c_im, const float* ssm_d, const bf16_t* WgT, const float* gbias) {
    const bf16_t* ZSp = F.ZS(); const float* SPp = F.SP(l); f32x2* S5Ep = F.S5E();
    LAS unsigned char* XL = F.lds + F.wave * S5_WAVE_LDS;
    LAS unsigned char* YL = F.lds + S5_YOFF;
    for (int pp = F.bid; pp < 256; pp += F.G) {
        s5_task<true, true>(F, l, pp, F.wave, XL, YL, ZSp, SPp, S5Ep, c_re, c_im, ssm_d);
        s5_task<true, true>(F, l, pp, F.wave + 8, XL, YL, ZSp, SPp, S5Ep, c_re, c_im, ssm_d);
        asm volatile("s_waitcnt lgkmcnt(0)" ::: "memory"); __syncthreads();
        int lane = F.lane; asm volatile("" : "+v"(lane));
        const int l15 = lane & 15, kg = lane >> 4, w = F.wave;
        bf16x8 wf[2][8];
#pragma unroll
        for (int nt = 0; nt < 2; ++nt)
#pragma unroll
            for (int ks = 0; ks < 8; ++ks) wf[nt][ks] = *(const bf16x8*)(WgT + (size_t)(32 * w + 16 * nt + l15) * 256 + 32 * ks + 8 * kg);
        f32x4 bz[2];
#pragma unroll
        for (int nt = 0; nt < 2; ++nt) bz[nt] = *(const f32x4*)(gbias + 32 * w + 16 * nt + 4 * kg);
#pragma unroll 2
        for (int mt = 0; mt < 8; ++mt) {
            f32x4 acc[2] = {{0.f, 0.f, 0.f, 0.f}, {0.f, 0.f, 0.f, 0.f}};
#pragma unroll
            for (int ks = 0; ks < 8; ++ks) {
                const bf16x8 yf = *(const LAS bf16x8*)(YL + (16 * mt + l15) * S5_YSTR + (32 * ks + 8 * kg) * 2);
                acc[0] = __builtin_amdgcn_mfma_f32_16x16x32_bf16(wf[0][ks], yf, acc[0], 0, 0, 0);
                acc[1] = __builtin_amdgcn_mfma_f32_16x16x32_bf16(wf[1][ks], yf, acc[1], 0, 0, 0);
            }
            const size_t tok = (size_t)pp * 128 + 16 * mt + l15;
#pragma unroll
            for (int nt = 0; nt < 2; ++nt) {
                const int col = 32 * w + 16 * nt + 4 * kg;
                const u32x2 yw = *(const LAS u32x2*)(YL + (16 * mt + l15) * S5_YSTR + col * 2);
                const f32x4 z = acc[nt] + bz[nt];
                const float o0 = bflo(yw.x) * sigmoidf_(z.x), o1 = bfhi(yw.x) * sigmoidf_(z.y), o2 = bflo(yw.y) * sigmoidf_(z.z), o3 = bfhi(yw.y) * sigmoidf_(z.w);
                *(u32x2*)(F.H() + tok * DM + col) = (u32x2){pk2(o0, o1), pk2(o2, o3)};
            }
        }
        asm volatile("s_waitcnt lgkmcnt(0)" ::: "memory"); __syncthreads();
    }
}
__device__ __forceinline__ void phase_s5_local(Frame& F, int l) {
#ifdef NO_PHASE_S5_LOCAL
    return;
#endif
    s5_pass<false>(F, l, nullptr, nullptr, nullptr);
}
__device__ __forceinline__ void phase_s5_out(Frame& F, int l, const float* c_re, const float* c_im, const float* ssm_d) {
#ifdef NO_PHASE_S5_OUT
    return;
#endif
    s5_pass<true>(F, l, c_re, c_im, ssm_d);
}

__device__ __forceinline__ void phase_carry(Frame& F, int l) {
#ifdef NO_PHASE_CARRY
    return;
#endif
    const float* SPp = F.SP(l); f32x2* S5Ep = F.S5E(); float* RSTp = F.RST();
    const int gw = F.bid * NWAVES + F.wave, NGW = F.G * NWAVES;
    for (int task = NGW - 1 - gw; task < NB * 16; task += NGW) {
        const int b = task >> 4, g = task & 15, p = F.lane;
        const float ar = SPp[SP_L64 + (g * 64 + p) * 2], ai = SPp[SP_L64 + (g * 64 + p) * 2 + 1];
        float sr = 0.f, si = 0.f;
#pragma unroll 1
        for (int c0 = 0; c0 < 128; c0 += 32) {
            f32x2 e[32];
#pragma unroll
            for (int j = 0; j < 32; ++j) e[j] = S5Ep[(size_t)((b * 128 + c0 + j) * 16 + g) * 64 + p];
#pragma unroll
            for (int j = 0; j < 32; ++j) { S5Ep[(size_t)((b * 128 + c0 + j) * 16 + g) * 64 + p] = (f32x2){sr, si}; const float nr = ar * sr - ai * si + e[j].x, ni = ar * si + ai * sr + e[j].y; sr = nr; si = ni; }
        }
    }
    const int NT = F.G * NTHREADS;
    for (int gt = F.bid * NTHREADS + F.tid; gt < NB * 4 * 4608; gt += NT) {
        const int b = gt / (4 * 4608), h = (gt / 4608) & 3, el = gt % 4608;
        const float lg = log1pf(-exp2f(-5.f - (float)h));
        const float cdec = expf(lg * 64.f);
        float s = 0.f;
#pragma unroll 1
        for (int c0 = 0; c0 < 128; c0 += 32) {
            float d[32];
#pragma unroll
            for (int j = 0; j < 32; ++j) d[j] = RSTp[(size_t)((b * 128 + c0 + j) * 4 + h) * 4608 + el];
#pragma unroll
            for (int j = 0; j < 32; ++j) { RSTp[(size_t)((b * 128 + c0 + j) * 4 + h) * 4608 + el] = s; s = s * cdec + d[j]; }
        }
    }
}

typedef float f32x16 __attribute__((ext_vector_type(16)));
typedef short s16x4 __attribute__((ext_vector_type(4)));
__device__ __forceinline__ bf16x8 tr8(const LAS unsigned char* a0, const LAS unsigned char* a1) {
    const s16x4 lo = __builtin_bit_cast(s16x4, __builtin_amdgcn_ds_read_tr16_b64_v4i16((LAS s16x4*)a0));
    const s16x4 hi = __builtin_bit_cast(s16x4, __builtin_amdgcn_ds_read_tr16_b64_v4i16((LAS s16x4*)a1));
    return (bf16x8){lo[0], lo[1], lo[2], lo[3], hi[0], hi[1], hi[2], hi[3]};
}
__device__ __forceinline__ bf16x8 pack8f(const f32x4& a, const f32x4& b) { return __builtin_bit_cast(bf16x8, pack8(a, b)); }
__device__ __forceinline__ void ret_stage_v(const bf16_t* ZSp, LAS unsigned char* Vb, int tok0, int h, int lane) {
#pragma unroll
    for (int n = 0; n < 12; ++n) { const int o = n * 1024 + 16 * lane, r = o / 192, ch = (o % 192) >> 4;
        __builtin_amdgcn_global_load_lds((const unsigned*)(ZSp + (size_t)(tok0 + r) * ZSW + ZRV + h * 96 + ch * 8), (LAS unsigned*)(Vb + n * 1024), 16, 0, 0); }
}
constexpr int RET_VB = 12288, RET_KSTR = 112, RET_WAVE_LDS = RET_VB + 64 * RET_KSTR;
__device__ __forceinline__ void phase_ret_local(Frame& F) {
#ifdef NO_PHASE_RET_LOCAL
    return;
#endif
    const bf16_t* ZSp = F.ZS(); float* RSTp = F.RST();
    LAS unsigned char* Vb = F.lds + F.wave * RET_WAVE_LDS; LAS unsigned char* Kb = Vb + RET_VB;
    for (int item = F.bid * NWAVES + F.wave; item < 2048; item += F.G * NWAVES) {
        int lane = F.lane; asm volatile("" : "+v"(lane));
        const int l31 = lane & 31, hh = lane >> 5, g1 = (lane >> 4) & 1, q4 = (lane & 15) >> 2, p4 = lane & 3;
        const int h = item & 3, tok0 = (item >> 2) * 64;
        ret_stage_v(ZSp, Vb, tok0, h, lane);
        const float lg2 = log2f(1.f - exp2f(-5.f - (float)h));
#pragma unroll
        for (int n = 0; n < 6; ++n) { const int idx = n * 64 + lane, r = idx / 6, ch = idx % 6;
            f32x4 a, b; unpack8(*(const u32x4*)(ZSp + (size_t)(tok0 + r) * ZSW + ZRK + h * 48 + ch * 8), a, b);
            const float sc = 0.14433756729740643f * exp2f(lg2 * (float)(63 - r));
            *(LAS u32x4*)(Kb + r * RET_KSTR + ch * 16) = pack8(a * sc, b * sc); }
        asm volatile("s_waitcnt vmcnt(0) lgkmcnt(0)" ::: "memory");
        f32x16 acc[3][2];
#pragma unroll
        for (int me = 0; me < 3; ++me)
#pragma unroll
            for (int nt = 0; nt < 2; ++nt) acc[me][nt] = (f32x16){0.f, 0.f, 0.f, 0.f, 0.f, 0.f, 0.f, 0.f, 0.f, 0.f, 0.f, 0.f, 0.f, 0.f, 0.f, 0.f};
#pragma unroll
        for (int s = 0; s < 4; ++s) {
            const int r0 = 16 * s + 8 * hh + q4;
            bf16x8 kf[2], vf[3];
#pragma unroll
            for (int nt = 0; nt < 2; ++nt) { const LAS unsigned char* a0 = Kb + r0 * RET_KSTR + (32 * nt + 16 * g1 + 4 * p4) * 2; kf[nt] = tr8(a0, a0 + 4 * RET_KSTR); }
#pragma unroll
            for (int me = 0; me < 3; ++me) { const LAS unsigned char* a0 = Vb + r0 * 192 + (32 * me + 16 * g1 + 4 * p4) * 2; vf[me] = tr8(a0, a0 + 4 * 192); }
#pragma unroll
            for (int me = 0; me < 3; ++me)
#pragma unroll
                for (int nt = 0; nt < 2; ++nt) acc[me][nt] = __builtin_amdgcn_mfma_f32_32x32x16_bf16(vf[me], kf[nt], acc[me][nt], 0, 0, 0);
        }
        float* dst = RSTp + (size_t)item * 4608 + (4 * hh) * 48 + l31;
#pragma unroll
        for (int me = 0; me < 3; ++me)
#pragma unroll
            for (int r4 = 0; r4 < 4; ++r4) {
                int zz = 0; asm volatile("" : "+v"(zz)); float* dp = dst + (32 * me + 8 * r4) * 48 + zz;
#pragma unroll
                for (int k = 0; k < 4; ++k) { dp[k * 48] = acc[me][0][4 * r4 + k]; if (l31 < 16) dp[k * 48 + 32] = acc[me][1][4 * r4 + k]; }
            }
        asm volatile("s_waitcnt lgkmcnt(0)" ::: "memory");
    }
}
__device__ __forceinline__ void phase_ret_out(Frame& F, int l, const float* ret_norm_g) {
#ifdef NO_PHASE_RET_OUT
    return;
#endif
    const bf16_t* ZSp = F.ZS(); const float* RSTp = F.RST();
    LAS unsigned char* Vb = F.lds + F.wave * RET_WAVE_LDS;
    for (int item = F.bid * NWAVES + F.wave; item < 2048; item += F.G * NWAVES) {
        int lane = F.lane; asm volatile("" : "+v"(lane));
        const int l31 = lane & 31, hh = lane >> 5, g1 = (lane >> 4) & 1, q4 = (lane & 15) >> 2, p4 = lane & 3;
        const int h = item & 3, tok0 = (item >> 2) * 64;
        ret_stage_v(ZSp, Vb, tok0, h, lane);
        const float lg2 = log2f(1.f - exp2f(-5.f - (float)h));
        bf16x8 qf[2][3], kf[2][3];
#pragma unroll
        for (int t = 0; t < 2; ++t)
#pragma unroll
            for (int ks = 0; ks < 3; ++ks) { const size_t ro = (size_t)(tok0 + 32 * t + l31) * ZSW + h * 48 + 8 * hh + 16 * ks;
                qf[t][ks] = *(const bf16x8*)(ZSp + ro + ZRQ); kf[t][ks] = *(const bf16x8*)(ZSp + ro + ZRK); }
        bf16x8 pm[2][4];
#pragma unroll
        for (int mt = 0; mt < 2; ++mt)
#pragma unroll
            for (int nt = mt; nt < 2; ++nt) {
                f32x16 p = {0.f, 0.f, 0.f, 0.f, 0.f, 0.f, 0.f, 0.f, 0.f, 0.f, 0.f, 0.f, 0.f, 0.f, 0.f, 0.f};
#pragma unroll
                for (int ks = 0; ks < 3; ++ks) p = __builtin_amdgcn_mfma_f32_32x32x16_bf16(kf[mt][ks], qf[nt][ks], p, 0, 0, 0);
                const int i = 32 * nt + l31;
#pragma unroll
                for (int r = 0; r < 16; ++r) { const int j = 32 * mt + (r & 3) + 8 * (r >> 2) + 4 * hh;
                    p[r] = (i >= j) ? p[r] * (0.14433756729740643f * exp2f(lg2 * (float)(i - j))) : 0.f; }
                pm[nt][2 * mt + 0] = pack8f((f32x4){p[0], p[1], p[2], p[3]}, (f32x4){p[4], p[5], p[6], p[7]});
                pm[nt][2 * mt + 1] = pack8f((f32x4){p[8], p[9], p[10], p[11]}, (f32x4){p[12], p[13], p[14], p[15]});
            }
        f32x16 ot[3][2];
#pragma unroll
        for (int me = 0; me < 3; ++me) {
            bf16x8 sf[3];
            int zz = 0; asm volatile("" : "+v"(zz)); const float* sp0 = RSTp + (size_t)item * 4608 + (32 * me + l31) * 48 + 8 * hh + zz;
#pragma unroll
            for (int ks = 0; ks < 3; ++ks) { const float* sp = sp0 + 16 * ks; sf[ks] = pack8f(*(const f32x4*)sp, *(const f32x4*)(sp + 4)); }
#pragma unroll
            for (int nt = 0; nt < 2; ++nt) {
                f32x16 a = {0.f, 0.f, 0.f, 0.f, 0.f, 0.f, 0.f, 0.f, 0.f, 0.f, 0.f, 0.f, 0.f, 0.f, 0.f, 0.f};
#pragma unroll
                for (int ks = 0; ks < 3; ++ks) a = __builtin_amdgcn_mfma_f32_32x32x16_bf16(sf[ks], qf[nt][ks], a, 0, 0, 0);
                const float qd = exp2f(lg2 * (float)(32 * nt + l31 + 1));
                ot[me][nt] = a * qd;
            }
        }
        asm volatile("s_waitcnt vmcnt(0)" ::: "memory");
#pragma unroll
        for (int s = 0; s < 4; ++s) {
            const int r0 = 16 * s + 4 * hh + q4;
#pragma unroll
            for (int me = 0; me < 3; ++me) {
                const LAS unsigned char* a0 = Vb + r0 * 192 + (32 * me + 16 * g1 + 4 * p4) * 2;
                const bf16x8 vf = tr8(a0, a0 + 8 * 192);
                if (s < 2) ot[me][0] = __builtin_amdgcn_mfma_f32_32x32x16_bf16(vf, pm[0][s], ot[me][0], 0, 0, 0);
                ot[me][1] = __builtin_amdgcn_mfma_f32_32x32x16_bf16(vf, pm[1][s], ot[me][1], 0, 0, 0);
            }
        }
#pragma unroll
        for (int nt = 0; nt < 2; ++nt) {
            float sum = 0.f;
#pragma unroll
            for (int me = 0; me < 3; ++me)
#pragma unroll
                for (int r = 0; r < 16; ++r) sum += ot[me][nt][r];
            sum += __shfl_xor(sum, 32);
            const float mu = sum * (1.f / 96.f); float q2 = 0.f;
#pragma unroll
            for (int me = 0; me < 3; ++me)
#pragma unroll
                for (int r = 0; r < 16; ++r) { const float d = ot[me][nt][r] - mu; q2 += d * d; }
            q2 += __shfl_xor(q2, 32);
            const float rs = rsqrtf(q2 * (1.f / 96.f) + EPS);
            const int tok = tok0 + 32 * nt + l31;
            const bf16_t* gbase = ZSp + (size_t)tok * ZSW + ZRG + h * 96 + 4 * hh; const float* nbase = ret_norm_g + l * 384 + h * 96 + 4 * hh; bf16_t* obase = F.H() + (size_t)tok * DM + 640 + h * 96 + 4 * hh;
#pragma unroll
            for (int me = 0; me < 3; ++me) {
                int zz = 0; asm volatile("" : "+v"(zz));
                const bf16_t* gp = gbase + 32 * me + zz; const float* np = nbase + 32 * me + zz; bf16_t* op = obase + 32 * me + zz;
#pragma unroll
                for (int r4 = 0; r4 < 4; ++r4) {
                    const u32x2 gw = *(const u32x2*)(gp + 8 * r4);
                    const f32x4 ng = *(const f32x4*)(np + 8 * r4);
                    const float g0 = bflo(gw.x), g1f = bfhi(gw.x), g2 = bflo(gw.y), g3 = bfhi(gw.y);
                    const float y0 = (ot[me][nt][4 * r4 + 0] - mu) * rs * ng.x * (g0 * sigmoidf_(g0)), y1 = (ot[me][nt][4 * r4 + 1] - mu) * rs * ng.y * (g1f * sigmoidf_(g1f));
                    const float y2 = (ot[me][nt][4 * r4 + 2] - mu) * rs * ng.z * (g2 * sigmoidf_(g2)), y3 = (ot[me][nt][4 * r4 + 3] - mu) * rs * ng.w * (g3 * sigmoidf_(g3));
                    *(u32x2*)(op + 8 * r4) = (u32x2){pk2(y0, y1), pk2(y2, y3)};
                }
            }
        }
        asm volatile("s_waitcnt lgkmcnt(0)" ::: "memory");
    }
}

typedef _Float16 f16_t;
__device__ __forceinline__ u32x4 zero4() { unsigned z = 0u; asm volatile("" : "+v"(z)); return (u32x4){z, z, z, z}; }
__device__ __forceinline__ int lanes_below(unsigned long long m) { return (int)__builtin_amdgcn_mbcnt_hi((unsigned)(m >> 32), __builtin_amdgcn_mbcnt_lo((unsigned)m, 0u)); }
__device__ __forceinline__ float relu1(float x) { return __builtin_amdgcn_fmed3f(x, 0.f, __builtin_inff()); }
__device__ __forceinline__ unsigned sortable_f16(float sc) {
    const f16_t h = (f16_t)sc; const unsigned u = (unsigned)__builtin_bit_cast(unsigned short, h), mag = u & 0x7fffu;
    return (u & 0x8000u) ? (0x8000u - mag) : (0x8000u + mag);
}
__device__ __forceinline__ int sc_pos(int k) { return k; }
__device__ __forceinline__ int wave_incl_scan(int x) {
    x += __builtin_amdgcn_update_dpp(0, x, 0x111, 0xf, 0xf, true);
    x += __builtin_amdgcn_update_dpp(0, x, 0x112, 0xf, 0xf, true);
    x += __builtin_amdgcn_update_dpp(0, x, 0x114, 0xf, 0xf, true);
    x += __builtin_amdgcn_update_dpp(0, x, 0x118, 0xf, 0xf, true);
    x += __builtin_amdgcn_update_dpp(0, x, 0x142, 0xa, 0xf, false);
    x += __builtin_amdgcn_update_dpp(0, x, 0x143, 0xc, 0xf, false);
    return x;
}
__device__ __forceinline__ int wave_suffix_sum(int v, int lane) { const int p = wave_incl_scan(v); return __builtin_amdgcn_readlane(p, 63) - p + v; }
__device__ __forceinline__ void hist_threshold(const u32x4 c, int need, int lane, int& B, int& above) {
    const int s = (int)(c.x + c.y + c.z + c.w);
    const int S = wave_suffix_sum(s, lane);
    int a = S - s;
    const bool found = (a < need) && (S >= need);
    int Bl = 0, al = 0;
    if (found) {
        if (a + (int)c.w >= need) { Bl = 4 * lane + 3; al = a; }
        else { a += (int)c.w; if (a + (int)c.z >= need) { Bl = 4 * lane + 2; al = a; }
        else { a += (int)c.z; if (a + (int)c.y >= need) { Bl = 4 * lane + 1; al = a; }
        else { a += (int)c.y; Bl = 4 * lane; al = a; } } }
    }
    const unsigned long long m = __ballot(found);
    const int src = m ? (int)__builtin_ctzll(m) : 0;
    B = __builtin_amdgcn_readlane(Bl, src); above = __builtin_amdgcn_readlane(al, src);
}

#ifndef DSA_CAND
#define DSA_CAND 0
#endif
#ifndef DSA_DUP
#define DSA_DUP 0
#endif
constexpr int DSA_ROW = 16384;
__device__ __forceinline__ void phase_dsa(Frame& F) {
#ifdef NO_PHASE_DSA
    return;
#endif
    const int wave = F.wave;
    const bf16_t* ZSp = F.ZS(); const float* IWp = F.IW(); const bf16_t* IKp = F.IKD();
    LAS unsigned char* SCb = F.lds;
    for (int it = F.bid; it < 512; it += F.G) {
        int lane = F.lane; asm volatile("" : "+v"(lane));
        const int hi = lane >> 5, n32 = lane & 31;
        LAS unsigned short* LSTw = (LAS unsigned short*)(F.lds + 131072) + wave * 256;
        LAS unsigned char* WB = F.lds + 135168 + wave * 3520;
        LAS unsigned* H1 = (LAS unsigned*)WB; LAS unsigned* H2 = H1 + 256;
        LAS unsigned* DUM = (LAS unsigned*)(WB + 3264) + lane;
        LAS unsigned short* CK = (LAS unsigned short*)(WB + 1024); LAS unsigned short* CI = (LAS unsigned short*)(WB + 2144);
        const char* ZSu; { const unsigned long long zp = (unsigned long long)ZSp; const unsigned zl = __builtin_amdgcn_readfirstlane((unsigned)zp), zh = __builtin_amdgcn_readfirstlane((unsigned)(zp >> 32));
            ZSu = (const char*)(((unsigned long long)zh << 32) | zl); }
        LAS unsigned* OFFw = (LAS unsigned*)(WB + 2048);
        const int pr = it & 255, vcu = (pr & 7) * 32 + (pr >> 3);
        const int b = vcu >> 6, cc = vcu & 63, c = (it < 256) ? cc : 127 - cc;
        const int V = (c + 1) * 64, tokq0 = b * SEQ + c * 64, kb0 = b * SEQ;
        const int Keff = V < 256 ? V : 256;
        const int nblk = (V + 511) >> 9, ntile_all = nblk * 16, ntile_real = V >> 5;
        for (int qg = 0; qg < 8; ++qg) {
            const int tq0 = tokq0 + qg * 8;
#ifndef DSA_NO_A
            for (int repA = 0; repA < 1 + (DSA_DUP & 1); ++repA) {
                bf16x8 aq[2];
                { const int qq = n32 >> 2, hd = n32 & 3; const bf16_t* qp = ZSp + (size_t)(tq0 + qq) * ZSW + ZIQ + hd * 32 + 8 * hi;
                  aq[0] = *(const bf16x8*)qp; aq[1] = *(const bf16x8*)(qp + 16); }
                float wq[4][4];
#pragma unroll
                for (int jq = 0; jq < 4; ++jq) { const f32x4 w4 = *(const f32x4*)(IWp + (size_t)(tq0 + 2 * jq + hi) * 4);
                    wq[jq][0] = w4.x * 0.08838834764831845f; wq[jq][1] = w4.y * 0.08838834764831845f; wq[jq][2] = w4.z * 0.08838834764831845f; wq[jq][3] = w4.w * 0.08838834764831845f; }
                bf16x8 fr[2][4][2];
                const int nb = (ntile_all - wave + 31) >> 5;
#define DSA_ALOAD(buf, bt) do { int zz = 0; asm volatile("" : "+v"(zz)); _Pragma("unroll") for (int u = 0; u < 4; ++u) { const int tt = wave + 8 * (4 * (bt) + u); \
        if (tt < ntile_real) { const bf16_t* kp = IKp + ((size_t)(((kb0 >> 5) + tt) * 4 + hi) * 32 + n32 + zz) * 8; fr[buf][u][0] = *(const bf16x8*)kp; fr[buf][u][1] = *(const bf16x8*)(kp + 512); } } } while (0)
#define DSA_ACOMP(buf, bt) do { _Pragma("unroll") for (int u = 0; u < 4; ++u) { const int tt = wave + 8 * (4 * (bt) + u); \
        if (tt < ntile_all) { unsigned short us[4] = {0, 0, 0, 0}; \
            if (tt < ntile_real) { f32x16 acc = {0.f, 0.f, 0.f, 0.f, 0.f, 0.f, 0.f, 0.f, 0.f, 0.f, 0.f, 0.f, 0.f, 0.f, 0.f, 0.f}; \
                acc = __builtin_amdgcn_mfma_f32_32x32x16_bf16(aq[0], fr[buf][u][0], acc, 0, 0, 0); acc = __builtin_amdgcn_mfma_f32_32x32x16_bf16(aq[1], fr[buf][u][1], acc, 0, 0, 0); \
                _Pragma("unroll") for (int jq = 0; jq < 4; ++jq) { \
                    const float sc = relu1(acc[4 * jq + 0]) * wq[jq][0] + relu1(acc[4 * jq + 1]) * wq[jq][1] + relu1(acc[4 * jq + 2]) * wq[jq][2] + relu1(acc[4 * jq + 3]) * wq[jq][3]; \
                    us[jq] = (unsigned short)sortable_f16(sc); } } \
            const int pos = sc_pos(tt * 32 + n32); \
            _Pragma("unroll") for (int jq = 0; jq < 4; ++jq) *(LAS unsigned short*)(SCb + (2 * jq + hi) * DSA_ROW + pos * 2) = us[jq]; } } } while (0)
                DSA_ALOAD(0, 0);
                for (int bp = 0; bp < nb; bp += 2) {
                    if (bp + 1 < nb) DSA_ALOAD(1, bp + 1);
                    DSA_ACOMP(0, bp);
                    if (bp + 2 < nb) DSA_ALOAD(0, bp + 2);
                    if (bp + 1 < nb) DSA_ACOMP(1, bp + 1);
                }
#undef DSA_ALOAD
#undef DSA_ACOMP
            }
#endif
            __syncthreads();
            LAS unsigned char* row = SCb + wave * DSA_ROW;
#ifndef DSA_NO_B
            for (int repB = 0; repB < 1 + ((DSA_DUP >> 1) & 1); ++repB)
            if (V > 256) {
                *(LAS u32x4*)(H1 + 4 * lane) = zero4(); *(LAS u32x4*)(H2 + 4 * lane) = zero4();
                u32x4 rw[4];
#define DSA_LD8(hf) do { _Pragma("unroll") for (int i = 0; i < 4; ++i) if (4 * (hf) + i < nblk) rw[i] = *(const LAS u32x4*)(row + (512 * (4 * (hf) + i) + 8 * lane) * 2); \
        asm volatile("s_waitcnt lgkmcnt(0)" ::: "memory"); } while (0)
#define DSA_W(i, e2) ((e2) == 0 ? rw[i].x : (e2) == 1 ? rw[i].y : (e2) == 2 ? rw[i].z : rw[i].w)
                asm volatile("s_waitcnt lgkmcnt(0)" ::: "memory");
#pragma unroll 1
                for (int hf = 0; 4 * hf < nblk; ++hf) {
                    DSA_LD8(hf);
#pragma unroll
                    for (int i = 0; i < 4; ++i) if (4 * hf + i < nblk) __hip_atomic_fetch_add(H2 + ((rw[i].x >> 8) & 255u), 1u, __ATOMIC_RELAXED, __HIP_MEMORY_SCOPE_WORKGROUP);
                }
                asm volatile("s_waitcnt lgkmcnt(0)" ::: "memory");
                int Bc, abovec; hist_threshold(*(const LAS u32x4*)(H2 + 4 * lane), 40, lane, Bc, abovec);
                { const u32x4 hs = *(const LAS u32x4*)(H2 + 4 * lane); const int tot = wave_suffix_sum((int)(hs.x + hs.y + hs.z + hs.w), lane); if (__builtin_amdgcn_readlane(tot, 0) < 40) Bc = 0; }
                *(LAS u32x4*)(H2 + 4 * lane) = zero4();
                bool done = false;
                if (DSA_CAND && Bc > 0) {
                    const unsigned thr = (unsigned)Bc << 8;
                    int cnt = 0;
#pragma unroll 1
                    for (int hf = 0; 4 * hf < nblk; ++hf) {
                        DSA_LD8(hf);
#pragma unroll
                        for (int i = 0; i < 4; ++i) if (4 * hf + i < nblk) {
#pragma unroll
                            for (int e = 0; e < 8; ++e) { const unsigned w = DSA_W(i, e >> 1); const unsigned u = (e & 1) ? (w >> 16) : (w & 0xffffu); cnt += (u >= thr) ? 1 : 0; }
                        }
                    }
                    int pos = wave_incl_scan(cnt);
                    const int ncand = __builtin_amdgcn_readlane(pos, 63); pos -= cnt;
                    if (ncand >= 256 && ncand <= 560) {
                        LAS unsigned short* ldum = (LAS unsigned short*)DUM;
#pragma unroll 1
                        for (int hf = 0; 4 * hf < nblk; ++hf) {
                            DSA_LD8(hf);
#pragma unroll
                            for (int i = 0; i < 4; ++i) if (4 * hf + i < nblk) {
#pragma unroll
                                for (int e = 0; e < 8; ++e) { const unsigned w = DSA_W(i, e >> 1); const unsigned u = (e & 1) ? (w >> 16) : (w & 0xffffu);
                                    const bool sel = u >= thr; LAS unsigned short* pk = sel ? CK + pos : ldum; LAS unsigned short* pi = sel ? CI + pos : ldum;
                                    *pk = (unsigned short)u; *pi = (unsigned short)(512 * (4 * hf + i) + 8 * lane + e); pos += sel ? 1 : 0; }
                            }
                        }
                        *(LAS u32x4*)(H1 + 4 * lane) = zero4();
                        asm volatile("s_waitcnt lgkmcnt(0)" ::: "memory");
                        unsigned cu[9];
#pragma unroll
                        for (int j = 0; j < 9; ++j) { const int p = j * 64 + lane; const bool v = p < ncand; cu[j] = v ? (unsigned)CK[v ? p : 0] : 0u; }
                        asm volatile("s_waitcnt lgkmcnt(0)" ::: "memory");
#pragma unroll
                        for (int j = 0; j < 9; ++j) if (j * 64 + lane < ncand) __hip_atomic_fetch_add(H1 + (cu[j] >> 8), 1u, __ATOMIC_RELAXED, __HIP_MEMORY_SCOPE_WORKGROUP);
                        asm volatile("s_waitcnt lgkmcnt(0)" ::: "memory");
                        int B1c, above1c; hist_threshold(*(const LAS u32x4*)(H1 + 4 * lane), 256, lane, B1c, above1c);
                        *(LAS u32x4*)(H1 + 4 * lane) = zero4();
                        asm volatile("s_waitcnt lgkmcnt(0)" ::: "memory");
#pragma unroll
                        for (int j = 0; j < 9; ++j) if (j * 64 + lane < ncand && (int)(cu[j] >> 8) == B1c) __hip_atomic_fetch_add(H1 + (cu[j] & 255u), 1u, __ATOMIC_RELAXED, __HIP_MEMORY_SCOPE_WORKGROUP);
                        asm volatile("s_waitcnt lgkmcnt(0)" ::: "memory");
                        int B2c, above2c; hist_threshold(*(const LAS u32x4*)(H1 + 4 * lane), 256 - above1c, lane, B2c, above2c);
                        const unsigned tauc = ((unsigned)B1c << 8) | (unsigned)B2c;
                        if ((int)H1[B2c] == 256 - above1c - above2c) {
                            int c2 = 0;
#pragma unroll
                            for (int j = 0; j < 9; ++j) c2 += (j * 64 + lane < ncand && cu[j] >= tauc) ? 1 : 0;
                            int p2 = wave_incl_scan(c2) - c2;
#pragma unroll
                            for (int j = 0; j < 9; ++j) { const bool sel = (j * 64 + lane < ncand) && cu[j] >= tauc; LAS unsigned short* pl = sel ? LSTw + p2 : ldum; *pl = CI[sel ? j * 64 + lane : 0]; p2 += sel ? 1 : 0; }
                            done = true;
                        }
                        *(LAS u32x4*)(H1 + 4 * lane) = zero4(); *(LAS u32x4*)(H2 + 4 * lane) = zero4();
                        asm volatile("s_waitcnt lgkmcnt(0)" ::: "memory");
                    }
                }
                if (!done) {
                int lo_bin = Bc, hi_bin = 256;
                for (;;) {
#pragma unroll 1
                    for (int hf = 0; 4 * hf < nblk; ++hf) {
                        DSA_LD8(hf);
#pragma unroll
                        for (int i = 0; i < 4; ++i) if (4 * hf + i < nblk) {
#pragma unroll
                            for (int e2 = 0; e2 < 4; ++e2) { const unsigned w = DSA_W(i, e2); const int b0 = (int)((w >> 8) & 255u), b1 = (int)(w >> 24);
                                LAS unsigned* p0 = ((unsigned)(b0 - lo_bin) < (unsigned)(hi_bin - lo_bin)) ? H1 + b0 : DUM; LAS unsigned* p1 = ((unsigned)(b1 - lo_bin) < (unsigned)(hi_bin - lo_bin)) ? H1 + b1 : DUM;
                                __hip_atomic_fetch_add(p0, 1u, __ATOMIC_RELAXED, __HIP_MEMORY_SCOPE_WORKGROUP); __hip_atomic_fetch_add(p1, 1u, __ATOMIC_RELAXED, __HIP_MEMORY_SCOPE_WORKGROUP); }
                        }
                    }
                    asm volatile("s_waitcnt lgkmcnt(0)" ::: "memory");
                    if (lo_bin == 0) break;
                    const u32x4 h4 = *(const LAS u32x4*)(H1 + 4 * lane); const int tot = __builtin_amdgcn_readlane(wave_suffix_sum((int)(h4.x + h4.y + h4.z + h4.w), lane), 0);
                    if (tot >= 256) break;
                    hi_bin = lo_bin; lo_bin = 0;
                }
                asm volatile("s_waitcnt lgkmcnt(0)" ::: "memory");
                int B1, above1; hist_threshold(*(const LAS u32x4*)(H1 + 4 * lane), 256, lane, B1, above1);
#pragma unroll 1
                for (int hf = 0; 4 * hf < nblk; ++hf) {
                    DSA_LD8(hf);
#pragma unroll
                    for (int i = 0; i < 4; ++i) if (4 * hf + i < nblk) {
#pragma unroll
                        for (int e2 = 0; e2 < 4; ++e2) { const unsigned w = DSA_W(i, e2);
                            LAS unsigned* p0 = ((int)((w >> 8) & 255u) == B1) ? H2 + (w & 255u) : DUM; LAS unsigned* p1 = ((int)(w >> 24) == B1) ? H2 + ((w >> 16) & 255u) : DUM;
                            __hip_atomic_fetch_add(p0, 1u, __ATOMIC_RELAXED, __HIP_MEMORY_SCOPE_WORKGROUP); __hip_atomic_fetch_add(p1, 1u, __ATOMIC_RELAXED, __HIP_MEMORY_SCOPE_WORKGROUP); }
                    }
                }
                asm volatile("s_waitcnt lgkmcnt(0)" ::: "memory");
                int B2, above2; hist_threshold(*(const LAS u32x4*)(H2 + 4 * lane), 256 - above1, lane, B2, above2);
                const unsigned tau = ((unsigned)B1 << 8) | (unsigned)B2;
                const int r = 256 - above1 - above2;
                const int neq = (int)H2[B2];
                if (neq == r) {
                    int cnt = 0;
#pragma unroll 1
                    for (int hf = 0; 4 * hf < nblk; ++hf) {
                        DSA_LD8(hf);
#pragma unroll
                        for (int i = 0; i < 4; ++i) if (4 * hf + i < nblk) {
#pragma unroll
                            for (int e = 0; e < 8; ++e) { const unsigned w = DSA_W(i, e >> 1); const unsigned u = (e & 1) ? (w >> 16) : (w & 0xffffu); cnt += (u >= tau) ? 1 : 0; }
                        }
                    }
                    int pos = wave_incl_scan(cnt) - cnt;
                    LAS unsigned short* ldum = (LAS unsigned short*)DUM;
#pragma unroll 1
                    for (int hf = 0; 4 * hf < nblk; ++hf) {
                        DSA_LD8(hf);
#pragma unroll
                        for (int i = 0; i < 4; ++i) if (4 * hf + i < nblk) {
#pragma unroll
                            for (int e = 0; e < 8; ++e) { const unsigned w = DSA_W(i, e >> 1); const unsigned u = (e & 1) ? (w >> 16) : (w & 0xffffu);
                                const bool sel = u >= tau; LAS unsigned short* p = sel ? LSTw + pos : ldum;
                                *p = (unsigned short)(512 * (4 * hf + i) + 8 * lane + e); pos += sel ? 1 : 0; }
                        }
                    }
                } else {
                    int tot = 0, base_eq = 0;
#define DSA_TK(i) int cgt = 0, ceq = 0; _Pragma("unroll") for (int e = 0; e < 8; ++e) { const unsigned w = DSA_W(i, e >> 1); const unsigned u = (e & 1) ? (w >> 16) : (w & 0xffffu); cgt += (u > tau) ? 1 : 0; ceq += (u == tau) ? 1 : 0; } \
        int tk = 0; if (__ballot(ceq != 0)) { const int inc = wave_incl_scan(ceq); int t = r - base_eq - (inc - ceq); t = t < 0 ? 0 : t; tk = t > ceq ? ceq : t; base_eq += __builtin_amdgcn_readlane(inc, 63); }
#pragma unroll 1
                    for (int hf = 0; 4 * hf < nblk; ++hf) {
                        DSA_LD8(hf);
#pragma unroll
                        for (int i = 0; i < 4; ++i) if (4 * hf + i < nblk) { DSA_TK(i); tot += cgt + tk; }
                    }
                    int pos = wave_incl_scan(tot) - tot;
                    LAS unsigned short* ldum = (LAS unsigned short*)DUM;
                    base_eq = 0;
#pragma unroll 1
                    for (int hf = 0; 4 * hf < nblk; ++hf) {
                        DSA_LD8(hf);
#pragma unroll
                        for (int i = 0; i < 4; ++i) if (4 * hf + i < nblk) {
                            DSA_TK(i);
                            int seen = 0;
#pragma unroll
                            for (int e = 0; e < 8; ++e) { const unsigned w = DSA_W(i, e >> 1); const unsigned u = (e & 1) ? (w >> 16) : (w & 0xffffu);
                                const bool eq = (u == tau); const bool sel = (u > tau) || (eq && seen < tk); seen += eq ? 1 : 0;
                                LAS unsigned short* p = sel ? LSTw + pos : ldum;
                                *p = (unsigned short)(512 * (4 * hf + i) + 8 * lane + e); pos += sel ? 1 : 0; }
                        }
                    }
#undef DSA_TK
                }
                }
#undef DSA_W
#undef DSA_LD8
            } else {
#pragma unroll
                for (int jj = 0; jj < 4; ++jj) LSTw[lane + 64 * jj] = (unsigned short)(lane + 64 * jj);
            }
#endif
            asm volatile("s_waitcnt lgkmcnt(0)" ::: "memory");
            for (int repC = 0; repC < 1 + ((DSA_DUP >> 2) & 1); ++repC) {
                int lc = lane; asm volatile("" : "+v"(lc));
                const int tq = tq0 + wave, n16 = lc & 15, kg = lc >> 4;
#pragma unroll
                for (int jj = 0; jj < 4; ++jj) OFFw[lc + 64 * jj] = (unsigned)(kb0 + (int)LSTw[lc + 64 * jj]) * (unsigned)(ZSW * 2);
                asm volatile("s_waitcnt lgkmcnt(0)" ::: "memory");
                const unsigned vcol = (unsigned)((ZDV + ((lc & 7) ^ (2 * ((lc >> 4) & 3))) * 8) * 2), kcol = (unsigned)((ZDK + 8 * kg) * 2);
                bf16x8 qf[2];
                if (n16 < 6) { const bf16_t* qp = ZSp + (size_t)tq * ZSW + ZDQ + n16 * 64 + 8 * kg; qf[0] = *(const bf16x8*)qp; qf[1] = *(const bf16x8*)(qp + 32); }
                else { qf[0] = (bf16x8){0, 0, 0, 0, 0, 0, 0, 0}; qf[1] = qf[0]; }
                const int ntile = Keff >> 4;
                LAS unsigned char* vst = row;
#define DSA_VDMA(ch, buf) do { unsigned vo[8]; _Pragma("unroll") for (int i8 = 0; i8 < 8; ++i8) vo[i8] = OFFw[(ch) * 64 + (lc >> 3) + 8 * i8] + vcol; \
        _Pragma("unroll") for (int i8 = 0; i8 < 8; ++i8) { const unsigned lb = (unsigned)(size_t)(vst + (buf) * 8192 + i8 * 1024); \
        asm volatile("s_mov_b32 m0, %2\n\ts_nop 0\n\tglobal_load_lds_dwordx4 %0, %1" :: "v"(vo[i8]), "s"(ZSu), "s"(__builtin_amdgcn_readfirstlane(lb)) : "memory", "m0"); } } while (0)
                DSA_VDMA(0, 0);
                if (ntile > 4) DSA_VDMA(1, 1);
                f32x4 sa[8];
                bf16x8 kf[2][4][2];
#define DSA_KLOAD(buf, tb) do { _Pragma("unroll") for (int t4 = 0; t4 < 4; ++t4) if (4 * (tb) + t4 < ntile) { const unsigned ko = OFFw[(4 * (tb) + t4) * 16 + n16] + kcol; \
        const bf16_t* kp = (const bf16_t*)(ZSu + ko); kf[buf][t4][0] = *(const bf16x8*)kp; kf[buf][t4][1] = *(const bf16x8*)(kp + 32); } } while (0)
#define DSA_KMMA(buf, tb) do { _Pragma("unroll") for (int t4 = 0; t4 < 4; ++t4) { \
        if (4 * (tb) + t4 < ntile) { f32x4 a = {0.f, 0.f, 0.f, 0.f}; \
            a = __builtin_amdgcn_mfma_f32_16x16x32_bf16(kf[buf][t4][0], qf[0], a, 0, 0, 0); a = __builtin_amdgcn_mfma_f32_16x16x32_bf16(kf[buf][t4][1], qf[1], a, 0, 0, 0); sa[4 * ((tb) & 1) + t4] = a; } \
        else sa[4 * ((tb) & 1) + t4] = (f32x4){-1e30f, -1e30f, -1e30f, -1e30f}; } } while (0)
#define DSA_PV(ch) do { _Pragma("unroll") for (int sl = 0; sl < 2; ++sl) { const int s = ((ch) & 1) * 2 + sl; \
        u32x4 pw; pw.x = pk2(sa[2 * s].x, sa[2 * s].y); pw.y = pk2(sa[2 * s].z, sa[2 * s].w); pw.z = pk2(sa[2 * s + 1].x, sa[2 * s + 1].y); pw.w = pk2(sa[2 * s + 1].z, sa[2 * s + 1].w); \
        const bf16x8 pb = __builtin_bit_cast(bf16x8, pw); \
        _Pragma("unroll") for (int mt = 0; mt < 4; ++mt) { \
            const int P0 = 32 * sl + 4 * kg + q4, P1 = P0 + 16; \
            const LAS unsigned char* a0 = vst + ((ch) & 1) * 8192 + P0 * 128 + (((2 * mt + (p4 >> 1)) ^ (2 * ((P0 >> 1) & 3))) * 16) + 8 * (p4 & 1); \
            const LAS unsigned char* a1 = vst + ((ch) & 1) * 8192 + P1 * 128 + (((2 * mt + (p4 >> 1)) ^ (2 * ((P1 >> 1) & 3))) * 16) + 8 * (p4 & 1); \
            const s16x4 lo = __builtin_bit_cast(s16x4, __builtin_amdgcn_ds_read_tr16_b64_v4i16((LAS s16x4*)a0)); \
            const s16x4 hi4 = __builtin_bit_cast(s16x4, __builtin_amdgcn_ds_read_tr16_b64_v4i16((LAS s16x4*)a1)); \
            const bf16x8 va = (bf16x8){lo[0], lo[1], lo[2], lo[3], hi4[0], hi4[1], hi4[2], hi4[3]}; \
            oacc[mt] = __builtin_amdgcn_mfma_f32_16x16x32_bf16(va, pb, oacc[mt], 0, 0, 0); } } \
        asm volatile("s_waitcnt lgkmcnt(0)" ::: "memory"); } while (0)
                DSA_KLOAD(0, 0); DSA_KLOAD(1, 1);
                asm volatile("s_waitcnt vmcnt(0)" ::: "memory");
                DSA_KMMA(0, 0); DSA_KLOAD(0, 2);
                DSA_KMMA(1, 1); DSA_KLOAD(1, 3);
                const float sc2 = 0.125f * 1.4426950408889634f;
                const int q4 = n16 >> 2, p4 = n16 & 3;
                f32x4 oacc[4] = {{0.f, 0.f, 0.f, 0.f}, {0.f, 0.f, 0.f, 0.f}, {0.f, 0.f, 0.f, 0.f}, {0.f, 0.f, 0.f, 0.f}};
                float m = -1e30f;
#pragma unroll
                for (int t = 0; t < 8; ++t) m = fmaxf(m, fmaxf(fmaxf(sa[t].x, sa[t].y), fmaxf(sa[t].z, sa[t].w)));
                m = fmaxf(m, __shfl_xor(m, 16)); m = fmaxf(m, __shfl_xor(m, 32));
                float lsum = 0.f;
#pragma unroll
                for (int t = 0; t < 8; ++t) { sa[t].x = __builtin_amdgcn_exp2f((sa[t].x - m) * sc2); sa[t].y = __builtin_amdgcn_exp2f((sa[t].y - m) * sc2); sa[t].z = __builtin_amdgcn_exp2f((sa[t].z - m) * sc2); sa[t].w = __builtin_amdgcn_exp2f((sa[t].w - m) * sc2);
                    lsum += (sa[t].x + sa[t].y) + (sa[t].z + sa[t].w); }
                DSA_PV(0);
                if (ntile > 8) DSA_VDMA(2, 0);
                if (ntile > 4) DSA_PV(1);
                if (ntile > 12) DSA_VDMA(3, 1);
                if (ntile > 8) {
                    DSA_KMMA(0, 2);
                    DSA_KMMA(1, 3);
                    float m1 = -1e30f;
#pragma unroll
                    for (int t = 0; t < 8; ++t) m1 = fmaxf(m1, fmaxf(fmaxf(sa[t].x, sa[t].y), fmaxf(sa[t].z, sa[t].w)));
                    m1 = fmaxf(m1, __shfl_xor(m1, 16)); m1 = fmaxf(m1, __shfl_xor(m1, 32));
                    const float mn = fmaxf(m, m1), alpha = __builtin_amdgcn_exp2f((m - mn) * sc2);
#pragma unroll
                    for (int mt = 0; mt < 4; ++mt) { oacc[mt].x *= alpha; oacc[mt].y *= alpha; oacc[mt].z *= alpha; oacc[mt].w *= alpha; }
                    lsum *= alpha;
#pragma unroll
                    for (int t = 0; t < 8; ++t) { sa[t].x = __builtin_amdgcn_exp2f((sa[t].x - mn) * sc2); sa[t].y = __builtin_amdgcn_exp2f((sa[t].y - mn) * sc2); sa[t].z = __builtin_amdgcn_exp2f((sa[t].z - mn) * sc2); sa[t].w = __builtin_amdgcn_exp2f((sa[t].w - mn) * sc2);
                        lsum += (sa[t].x + sa[t].y) + (sa[t].z + sa[t].w); }
                    if (ntile > 12) asm volatile("s_waitcnt vmcnt(8)" ::: "memory");
                    else asm volatile("s_waitcnt vmcnt(0)" ::: "memory");
                    DSA_PV(2);
                    if (ntile > 12) { asm volatile("s_waitcnt vmcnt(0)" ::: "memory"); DSA_PV(3); }
                }
                lsum += __shfl_xor(lsum, 16); lsum += __shfl_xor(lsum, 32);
                const float linv = __builtin_amdgcn_rcpf(lsum);
#undef DSA_KLOAD
#undef DSA_KMMA
#undef DSA_PV
#undef DSA_VDMA
                if (n16 < 6) {
                    bf16_t* op = F.H() + (size_t)tq * DM + 256 + n16 * 64 + 4 * kg;
#pragma unroll
                    for (int mt = 0; mt < 4; ++mt) { u32x2 o; o.x = pk2(oacc[mt].x * linv, oacc[mt].y * linv); o.y = pk2(oacc[mt].z * linv, oacc[mt].w * linv); *(u32x2*)(op + 16 * mt) = o; }
                }
            }
            __syncthreads();
        }
    }
}

__global__ void __launch_bounds__(NTHREADS, 2) mk_fwd(Args args) {
    extern __shared__ __attribute__((aligned(16))) unsigned char lds_raw[];
    Frame F;
    F.lds = (LAS unsigned char*)lds_raw;
    F.tid = threadIdx.x; F.lane = F.tid & 63; F.wave = __builtin_amdgcn_readfirstlane(F.tid >> 6);
    F.G = gridDim.x; F.bid = blockIdx.x; F.wsb = args.ws; F.zo = 0u; F.wl = 0u;
    unsigned char* ws = args.ws;
#define INF(k) ((const float*)args.in[k])

    volatile LAS unsigned* MISC = (volatile LAS unsigned*)(F.lds + MISC_OFF);
    if (F.tid < 64) MISC[F.tid] = 0u;
    __syncthreads();
    XcdBarrier bar = xcd_barrier_post((unsigned*)(ws + WS_CTL) + CW_BAR, MISC + 8);
    int ph = 0; const int lo = args.ph_lo, hi = args.ph_hi;
    unsigned long long* TSp = (unsigned long long*)(ws + WS_CTL + 32768); int nst = 0; (void)TSp; (void)nst;
    bool first_seam = true;
#ifndef DUP_MASK
#define DUP_MASK 0
#endif
#ifdef PROBE_LO
#define STAMP() do { if (F.bid == 0 && F.tid == 0) { TSp[nst] = __builtin_amdgcn_s_memrealtime(); } ++nst; } while (0)
#else
#define STAMP() do { } while (0)
#endif
#define GRIDSYNC() xcd_barrier(bar, F.wave == 0 && F.lane == 0)
#define RUN(...) do { if (ph >= lo && ph < hi) { asm volatile("" : "+s"(F.zo), "+s"(F.bid), "+s"(F.G), "+s"(F.wave)); F.lane = (int)__builtin_amdgcn_mbcnt_hi(~0u, __builtin_amdgcn_mbcnt_lo(~0u, F.zo)); asm volatile("" : "+v"(F.lane)); F.tid = F.wave * 64 + F.lane; __VA_ARGS__; } ++ph; } while (0)
#define SEAM() do { if (ph > lo && ph < hi) { if (first_seam) { GRIDSYNC(); first_seam = false; } else xcd_barrier(bar, F.wave == 0 && F.lane == 0); } STAMP(); } while (0)

    STAMP();
    RUN(phase_rope(F, (const int*)args.in[1])); STAMP();
#pragma unroll
    RUN({ const ProIn I{INF(0), INF(2), INF(3), INF(15), INF(16), INF(17), INF(18), INF(20), INF(21), INF(12), INF(4), INF(5), INF(6), INF(7), INF(8), (const int*)args.in[1]};
          phase_prologue(F, I); }); SEAM();
    for (int l = 0; l < DEPTH; ++l) {
        const float* xin = (l == 0) ? INF(0) : args.out;
        F.wl = l ? (unsigned)(WS_W1L - WS_W) : 0u;
        RUN({ pg8::Gemm g{F.H(), F.Win_t()}; pg8::StaticOrder<T, NINP> S; S.init(F.G, F.bid);
              pg8::EpiGen<FInProj> E{FInProj{F.ZS(), F.GB(), F.IW(), F.ROPE(), F.IKD()}}; pg8::gemm_phase<T, NINP, DM, DM, DM>(F.lds, g, S, E, F.tid); }); SEAM();
        RUN({ phase_s5_local(F, l); __syncthreads(); phase_ret_local(F);
              asm volatile("s_waitcnt vmcnt(0)" ::: "memory"); __syncthreads();
              if (F.tid == 0) { unsigned* lc = (unsigned*)(F.wsb + F.zo + WS_CTL) + CW_LOCAL + 64 * l; __builtin_amdgcn_fence(__ATOMIC_RELEASE, "agent"); asm volatile("s_waitcnt vmcnt(0)" ::: "memory"); __hip_atomic_fetch_add(lc, 1u, __ATOMIC_RELAXED, __HIP_MEMORY_SCOPE_AGENT); }
              phase_dsa(F); __syncthreads();
              if (F.tid == 0) { unsigned* lc = (unsigned*)(F.wsb + F.zo + WS_CTL) + CW_LOCAL + 64 * l; unsigned sp = 0u;
                                while (__hip_atomic_load(lc, __ATOMIC_RELAXED, __HIP_MEMORY_SCOPE_AGENT) < (unsigned)F.G) { __builtin_amdgcn_s_sleep(2); if (++sp > (1u << 20)) break; }
                                __builtin_amdgcn_fence(__ATOMIC_ACQUIRE, "agent"); asm volatile("s_waitcnt vmcnt(0)" ::: "memory"); }
              __syncthreads();
              phase_carry(F, l); }); SEAM();
        RUN({ phase_s5_out_glu(F, l, INF(9), INF(10), INF(11), F.Wglu_t(), INF(13) + l * 256); __syncthreads(); phase_ret_out(F, l, INF(14)); __syncthreads(); }); SEAM();
        RUN({ pg8::Gemm g{F.H(), F.Wabc_t()}; pg8::StaticOrder<T, DM> S; S.init(F.G, F.bid);
              EpiMerge E{F.MG(), F.GB()}; pg8::gemm_phase<T, DM, DM, DM, DM>(F.lds, g, S, E, F.tid); }); SEAM();
        RUN({ pg8::Gemm g{F.MG(), F.Wout_t()}; pg8::StaticOrder<T, DM> S; S.init(F.G, F.bid);
              EpiResidNorm E{l == 0 ? xin : (const float*)nullptr, F.XR(), F.XR(), F.H(), nullptr, INF(19) + l * DM, F.XB(), F.PANEL(2 * l)}; pg8::gemm_phase<T, DM, DM, DM, DM>(F.lds, g, S, E, F.tid); }); SEAM();
        RUN({ pg8::Gemm g{F.H(), F.W1_t()}; pg8::StaticOrder<T, FF> S; S.init(F.G, F.bid);
              pg8::EpiGen<FRelu2> E{FRelu2{F.FB()}}; pg8::gemm_phase<T, FF, DM, DM, DM>(F.lds, g, S, E, F.tid); }); SEAM();
        RUN({ pg8::Gemm g{F.FB(), F.W2_t()}; pg8::StaticOrder<T, DM> S; S.init(F.G, F.bid);
              const bool lastl = (l + 1 == DEPTH);
              EpiResidNorm E{(const float*)nullptr, F.XR(), lastl ? (bf16_t*)nullptr : F.XR(), lastl ? (bf16_t*)nullptr : F.H(), lastl ? args.out : (float*)nullptr, lastl ? INF(22) : INF(2) + (l + 1) * DM, F.XB(), F.PANEL(2 * l + 1)};
              pg8::gemm_phase<T, DM, FF, FF, FF>(F.lds, g, S, E, F.tid); }); if (l + 1 < DEPTH) SEAM();
    }
    STAMP();
#ifdef PROBE_LO
    if (F.bid == 0 && F.tid == 0) {
        const int sel[] = PROBE_SEL; unsigned long long tot = 0;
        for (unsigned i = 0; i < sizeof(sel) / sizeof(int); ++i) tot += TSp[sel[i] + 1] - TSp[sel[i]];
        const float us = (float)tot * 0.01f;
        asm volatile("s_waitcnt vmcnt(0)" ::: "memory");
        args.out[0] = sqrtf(us * (float)((size_t)T * DM));
    }
#endif
#undef RUN
#undef SEAM
}

extern "C" void kernel_launch(void* const* d_in, const int* in_sizes, int n_in, void* d_out, int out_size, void* d_ws, size_t ws_size, hipStream_t stream) {
    static int grid = 0;
    if (grid == 0) {
        if (n_in != 23 || out_size != T * DM || ws_size < WS_END) { fprintf(stderr, "kernel_launch: unexpected shapes (n_in %d out %d ws %zu)\n", n_in, out_size, ws_size); grid = -1; return; }
        int dev = 0, cus = 0, per_cu = 0;
        hipGetDevice(&dev); hipDeviceGetAttribute(&cus, hipDeviceAttributeMultiprocessorCount, dev);
        if (hipFuncSetAttribute((const void*)mk_fwd, hipFuncAttributeMaxDynamicSharedMemorySize, LDS_BYTES) != hipSuccess) { fprintf(stderr, "kernel_launch: hipFuncSetAttribute failed\n"); grid = -1; return; }
        if (hipOccupancyMaxActiveBlocksPerMultiprocessor(&per_cu, (const void*)mk_fwd, NTHREADS, LDS_BYTES) != hipSuccess || per_cu < 1) { fprintf(stderr, "kernel_launch: occupancy query says %d\n", per_cu); per_cu = 1; }
        (void)hipGetLastError();
        grid = cus;
        if (cus != 256) fprintf(stderr, "kernel_launch: built for a 256-CU device (got %d CUs): the fused-norm row-statistics exchange needs a panel's four column tiles in one round\n", cus);
    }
    if (grid < 0) return;
    hipMemsetAsync((char*)d_ws + WS_CTL, 0, CTL_ZERO_BYTES, stream);
    Args a{};
    for (int i = 0; i < 23; ++i) a.in[i] = d_in[i];
    a.out = (float*)d_out; a.ws = (unsigned char*)d_ws;
#ifndef MK_SPLIT
    a.ph_lo = 0; a.ph_hi = 1000;
    void* kargs[] = {&a};
    hipError_t e = hipLaunchCooperativeKernel((const void*)mk_fwd, dim3(grid), dim3(NTHREADS), kargs, LDS_BYTES, stream);
    if (e != hipSuccess) fprintf(stderr, "kernel_launch: cooperative launch failed: %s\n", hipGetErrorString(e));
#else
    for (int p = 0; p < 2 * 9 + 2; ++p) { a.ph_lo = p; a.ph_hi = p + 1; hipLaunchKernelGGL(mk_fwd, dim3(grid), dim3(NTHREADS), LDS_BYTES, stream, a); }
#endif
}
```
